# Optimizing an MI355X kernel written in HIP

```python
import jax, jax.numpy as jnp
from jax import lax
import numpy as np

D_MODEL = 1024
BATCH = 4
SEQ = 8192
DEPTH = 2

CHUNK = 64
N_EVEN = (DEPTH + 1) // 2
N_ODD = DEPTH // 2
RMS_EPS = 1e-6

RWKV_WIDTH = D_MODEL // 2
RWKV_HEAD_DIM = 64
RWKV_HEADS = RWKV_WIDTH // RWKV_HEAD_DIM
RWKV_DECAY_RANK = 64
RWKV_A_RANK = 64
RWKV_GATE_RANK = 128
RWKV_COLS = 3 * RWKV_WIDTH + RWKV_DECAY_RANK + RWKV_A_RANK + RWKV_GATE_RANK
RWKV_GN_EPS = 64e-5

LRU_WIDTH = D_MODEL // 2
LRU_BLOCKS = 8
LRU_BLOCK_DIM = LRU_WIDTH // LRU_BLOCKS
CONV_WIDTH = 4
LRU_C = 8.0
LRU_COLS = 2 * LRU_WIDTH
AB_COLS = RWKV_COLS + LRU_COLS
AB_MIX_WIDTH = RWKV_WIDTH + LRU_WIDTH

HGRN_WIDTH = D_MODEL
HGRN_EXPAND = 128
HGRN_HEADS = HGRN_WIDTH // HGRN_EXPAND
HGRN_COLS = 4 * HGRN_WIDTH

N_GROUPS = 4
EXPERTS_PER_GROUP = 8
N_EXPERTS = N_GROUPS * EXPERTS_PER_GROUP
TOP_K = 2
EXPERT_FF = 512
ROUTE_BLOCK = 128

kernel_name = "hybrid_rwkv7_rglru_hgrn2_hmoe"


def rmsnorm(x, g):
    xf = x.astype(jnp.float32)
    y = xf * lax.rsqrt(jnp.mean(xf * xf, -1, keepdims=True) + RMS_EPS)
    return (y * g.astype(jnp.float32)).astype(x.dtype)


def token_shift(p, mu):
    prev = jnp.pad(p, ((0, 0), (1, 0), (0, 0)))[:, :-1]
    return p + (prev - p) * mu


def split_heads(t, heads):
    b, s, w = t.shape
    return t.reshape(b, s, heads, w // heads).astype(jnp.float32)


def rwkv7_recurrence(r, w, k, v, kk, a):
    b, _, h, n = r.shape

    def step(S, inp):
        r_t, w_t, k_t, v_t, kk_t, a_t = inp
        sa = jnp.einsum('bhvk,bhk->bhv', S, -kk_t)
        S = (S * w_t[:, :, None, :] + sa[..., None] * (kk_t * a_t)[:, :, None, :]
             + v_t[..., None] * k_t[:, :, None, :])
        return S, jnp.einsum('bhvk,bhk->bhv', S, r_t)

    xs = tuple(jnp.moveaxis(t, 1, 0) for t in (r, w, k, v, kk, a))
    _, y = lax.scan(step, jnp.zeros((b, h, n, n), jnp.float32), xs)
    return jnp.moveaxis(y, 0, 1)


def rwkv7_mixer(p, mu, w0, w2, a0, a2, g2, k_k, k_a, r_k, ln_w, ln_b):
    b, s, _ = p.shape
    p = token_shift(p, mu)
    idx = [RWKV_WIDTH, 2 * RWKV_WIDTH, 3 * RWKV_WIDTH,
           3 * RWKV_WIDTH + RWKV_DECAY_RANK, 3 * RWKV_WIDTH + RWKV_DECAY_RANK + RWKV_A_RANK]
    r, k, v, wl, al, gl = jnp.split(p, idx, axis=-1)
    w = -jax.nn.softplus(-(w0 + jnp.tanh(wl) @ w2)) - 0.5
    decay = jnp.exp(-jnp.exp(w.astype(jnp.float32)))
    a = jax.nn.sigmoid(a0 + al @ a2)
    g = jax.nn.sigmoid(gl) @ g2
    kk = split_heads(k * k_k, RWKV_HEADS)
    kk = kk / jnp.maximum(jnp.linalg.norm(kk, axis=-1, keepdims=True), 1e-12)
    k = k * (1.0 + (a - 1.0) * k_a)
    rh, kh, vh = (split_heads(t, RWKV_HEADS) for t in (r, k, v))
    y = rwkv7_recurrence(rh, split_heads(decay, RWKV_HEADS), kh, vh, kk,
                         split_heads(a, RWKV_HEADS))
    mean = jnp.mean(y, -1, keepdims=True)
    var = jnp.mean(jnp.square(y - mean), -1, keepdims=True)
    y = ((y - mean) * lax.rsqrt(var + RWKV_GN_EPS)).reshape(b, s, RWKV_WIDTH)
    y = y * ln_w + ln_b
    bonus = jnp.sum(rh * kh * r_k.astype(jnp.float32), -1, keepdims=True) * vh
    return ((y + bonus.reshape(b, s, RWKV_WIDTH)) * g).astype(p.dtype)


def rglru_mixer(p, conv_w, conv_b, w_a, b_a, w_x, b_x, lam):
    b, s, _ = p.shape
    gate, xb = jnp.split(p, [LRU_WIDTH], axis=-1)
    xc = lax.conv_general_dilated(xb, conv_w[:, None, :], window_strides=(1,),
                                  padding=[(CONV_WIDTH - 1, 0)],
                                  dimension_numbers=('NWC', 'WIO', 'NWC'),
                                  feature_group_count=LRU_WIDTH) + conv_b
    xg = xc.reshape(b, s, LRU_BLOCKS, LRU_BLOCK_DIM)
    r = jax.nn.sigmoid(jnp.einsum('btnd,nde->btne', xg, w_a).reshape(b, s, LRU_WIDTH) + b_a)
    i = jax.nn.sigmoid(jnp.einsum('btnd,nde->btne', xg, w_x).reshape(b, s, LRU_WIDTH) + b_x)
    log_a = -LRU_C * r.astype(jnp.float32) * jax.nn.softplus(-lam.astype(jnp.float32))
    a = jnp.exp(log_a)
    u = jnp.sqrt(-jnp.expm1(2.0 * log_a)) * i.astype(jnp.float32) * xc.astype(jnp.float32)

    def combine(c1, c2):
        return c1[0] * c2[0], c2[0] * c1[1] + c2[1]

    _, h = lax.associative_scan(combine, (a, u), axis=1)
    return (h * jax.nn.gelu(gate.astype(jnp.float32))).astype(p.dtype)


def gla_chunkwise(q, k, v, log_f):
    b, s, h, dk = q.shape
    dv = v.shape[-1]
    n_chunks = s // CHUNK

    def to_chunks(t):
        return t.reshape(b, n_chunks, CHUNK, h, t.shape[-1]).transpose(1, 0, 3, 2, 4)

    mask = jnp.tril(jnp.ones((CHUNK, CHUNK), dtype=bool))[:, :, None]

    def step(S, inp):
        q_c, k_c, v_c, lf_c = inp
        bc = jnp.cumsum(lf_c, axis=2)
        diff = bc[:, :, :, None, :] - bc[:, :, None, :, :]
        dec = jnp.exp(jnp.where(mask, diff, -jnp.inf))
        scores = jnp.einsum('bhtd,bhsd,bhtsd->bhts', q_c, k_c, dec)
        o = (jnp.einsum('bhts,bhsv->bhtv', scores, v_c)
             + jnp.einsum('bhtd,bhdv->bhtv', q_c * jnp.exp(bc), S))
        bl = bc[:, :, -1:, :]
        S = (jnp.exp(bl[:, :, 0, :])[..., None] * S
             + jnp.einsum('bhsd,bhsv->bhdv', k_c * jnp.exp(bl - bc), v_c))
        return S, o

    xs = tuple(to_chunks(t) for t in (q, k, v, log_f))
    _, o = lax.scan(step, jnp.zeros((b, h, dk, dv), jnp.float32), xs)
    return o.transpose(1, 0, 3, 2, 4).reshape(b, s, h, dv)


def hgrn2_mixer(hn, w_in, lower_bound, norm_w, w_out):
    b, s, _ = hn.shape
    q, f, i, g = jnp.split(hn @ w_in, 4, axis=-1)
    q = jax.nn.silu(q.astype(jnp.float32))
    fg = lower_bound + (1.0 - lower_bound) * jax.nn.sigmoid(f.astype(jnp.float32))
    k = 1.0 - fg
    log_f = jnp.log(fg)
    o = gla_chunkwise(split_heads(q, HGRN_HEADS), split_heads(k, HGRN_HEADS),
                      split_heads(i, HGRN_HEADS), split_heads(log_f, HGRN_HEADS))
    o = o * lax.rsqrt(jnp.mean(o * o, -1, keepdims=True) + RMS_EPS)
    o = o.reshape(b, s, HGRN_WIDTH) * norm_w * jax.nn.silu(g.astype(jnp.float32))
    return o.astype(hn.dtype) @ w_out


def hier_moe(hn, w_group, b_group, w_expert, b_expert, w_gate, w_up, w_down):
    b, s, d = hn.shape
    n_tok = b * s
    xf = hn.reshape(n_tok, d)
    g_logits = (xf @ w_group + b_group).astype(jnp.float32)
    g_sel = jnp.argmax(g_logits, -1)
    g_gate = jnp.take_along_axis(jax.nn.softmax(g_logits, -1), g_sel[:, None], 1)
    e_logits = (xf @ w_expert + b_expert).astype(jnp.float32).reshape(n_tok, N_GROUPS, EXPERTS_PER_GROUP)
    e_logits = jnp.take_along_axis(e_logits, g_sel[:, None, None], 1)[:, 0]
    top_v, top_i = lax.top_k(jax.nn.softmax(e_logits, -1), TOP_K)
    gates = (g_gate * top_v / jnp.sum(top_v, -1, keepdims=True)).reshape(-1)
    e_flat = (g_sel[:, None] * EXPERTS_PER_GROUP + top_i).reshape(-1).astype(jnp.int32)
    n_assign = n_tok * TOP_K
    tok = jnp.arange(n_assign, dtype=jnp.int32) // TOP_K
    order = jnp.argsort(e_flat)
    e_sorted = e_flat[order]
    counts = jnp.zeros((N_EXPERTS,), jnp.int32).at[e_flat].add(1)
    padded = (counts + ROUTE_BLOCK - 1) // ROUTE_BLOCK * ROUTE_BLOCK
    start = jnp.cumsum(counts) - counts
    pend = jnp.cumsum(padded)
    pstart = pend - padded
    dest = pstart[e_sorted] + jnp.arange(n_assign, dtype=jnp.int32) - start[e_sorted]
    n_blocks = (n_assign + ROUTE_BLOCK - 1) // ROUTE_BLOCK + N_EXPERTS
    n_rows = n_blocks * ROUTE_BLOCK
    row_tok = jnp.full((n_rows,), n_tok, jnp.int32).at[dest].set(tok[order])
    row_gate = jnp.zeros((n_rows,), hn.dtype).at[dest].set(gates[order].astype(hn.dtype))
    block_e = jnp.clip(jnp.searchsorted(pend, jnp.arange(n_blocks, dtype=jnp.int32) * ROUTE_BLOCK,
                                        side='right'), 0, N_EXPERTS - 1)
    x_pad = jnp.concatenate([xf, jnp.zeros((1, d), xf.dtype)], 0)
    xs = x_pad[row_tok].reshape(n_blocks, ROUTE_BLOCK, d)

    def expert_block(args):
        xb, e = args
        hid = jax.nn.silu(xb @ w_gate[e]) * (xb @ w_up[e])
        return hid @ w_down[e]

    ys = lax.map(expert_block, (xs, block_e)).reshape(n_rows, d)
    out = jax.ops.segment_sum(ys * row_gate[:, None], row_tok, num_segments=n_tok + 1)[:n_tok]
    return out.reshape(b, s, d)


def setup_inputs(seed: int = 0) -> dict:
    key = jax.random.key(seed)
    keys = iter(jax.random.split(key, 48))

    def nrm(shape, scale):
        return jax.random.normal(next(keys), shape, jnp.float32) * scale

    def gain(shape, base=1.0):
        return base + nrm(shape, 0.01)

    lam_u = jax.random.uniform(next(keys), (N_EVEN, LRU_WIDTH), jnp.float32, 0.9, 0.999)
    lam_a = lam_u ** (1.0 / LRU_C)
    return {
        "x": nrm((BATCH, SEQ, D_MODEL), 1.0),
        "norm_mix": gain((DEPTH, D_MODEL)),
        "norm_ffn": gain((DEPTH, D_MODEL)),
        "norm_final": gain((D_MODEL,)),
        "ab_w_in": nrm((N_EVEN, D_MODEL, AB_COLS), D_MODEL ** -0.5),
        "rw_mu": jax.random.uniform(next(keys), (N_EVEN, RWKV_COLS), jnp.float32),
        "rw_w0": jax.random.uniform(next(keys), (N_EVEN, RWKV_WIDTH), jnp.float32, -6.0, -0.5),
        "rw_w2": nrm((N_EVEN, RWKV_DECAY_RANK, RWKV_WIDTH), 0.5 * RWKV_DECAY_RANK ** -0.5),
        "rw_a0": nrm((N_EVEN, RWKV_WIDTH), 0.1),
        "rw_a2": nrm((N_EVEN, RWKV_A_RANK, RWKV_WIDTH), RWKV_A_RANK ** -0.5),
        "rw_g2": nrm((N_EVEN, RWKV_GATE_RANK, RWKV_WIDTH), RWKV_GATE_RANK ** -0.5),
        "rw_k_k": gain((N_EVEN, RWKV_WIDTH), 0.85),
        "rw_k_a": gain((N_EVEN, RWKV_WIDTH)),
        "rw_r_k": nrm((N_EVEN, RWKV_HEADS, RWKV_HEAD_DIM), 0.1),
        "rw_ln_w": gain((N_EVEN, RWKV_WIDTH)),
        "rw_ln_b": nrm((N_EVEN, RWKV_WIDTH), 0.01),
        "lru_conv_w": nrm((N_EVEN, CONV_WIDTH, LRU_WIDTH), CONV_WIDTH ** -0.5),
        "lru_conv_b": nrm((N_EVEN, LRU_WIDTH), 0.01),
        "lru_w_a": nrm((N_EVEN, LRU_BLOCKS, LRU_BLOCK_DIM, LRU_BLOCK_DIM), LRU_BLOCK_DIM ** -0.5),
        "lru_b_a": nrm((N_EVEN, LRU_WIDTH), 0.01),
        "lru_w_x": nrm((N_EVEN, LRU_BLOCKS, LRU_BLOCK_DIM, LRU_BLOCK_DIM), LRU_BLOCK_DIM ** -0.5),
        "lru_b_x": nrm((N_EVEN, LRU_WIDTH), 0.01),
        "lru_lambda": jnp.log(lam_a) - jnp.log1p(-lam_a),
        "ab_w_out": nrm((N_EVEN, AB_MIX_WIDTH, D_MODEL), AB_MIX_WIDTH ** -0.5),
        "c_w_in": nrm((N_ODD, D_MODEL, HGRN_COLS), D_MODEL ** -0.5),
        "c_lower_bound": nrm((DEPTH, HGRN_WIDTH), 0.1),
        "c_norm_w": gain((N_ODD, HGRN_WIDTH)),
        "c_w_out": nrm((N_ODD, HGRN_WIDTH, D_MODEL), HGRN_WIDTH ** -0.5),
        "moe_w_group": nrm((DEPTH, D_MODEL, N_GROUPS), D_MODEL ** -0.5),
        "moe_b_group": nrm((DEPTH, N_GROUPS), 0.01),
        "moe_w_expert": nrm((DEPTH, D_MODEL, N_EXPERTS), D_MODEL ** -0.5),
        "moe_b_expert": nrm((DEPTH, N_EXPERTS), 0.01),
        "moe_w_gate": nrm((DEPTH, N_EXPERTS, D_MODEL, EXPERT_FF), D_MODEL ** -0.5),
        "moe_w_up": nrm((DEPTH, N_EXPERTS, D_MODEL, EXPERT_FF), D_MODEL ** -0.5),
        "moe_w_down": nrm((DEPTH, N_EXPERTS, EXPERT_FF, D_MODEL), EXPERT_FF ** -0.5),
    }


def reference(x, norm_mix, norm_ffn, norm_final,
              ab_w_in, rw_mu, rw_w0, rw_w2, rw_a0, rw_a2, rw_g2, rw_k_k, rw_k_a, rw_r_k,
              rw_ln_w, rw_ln_b,
              lru_conv_w, lru_conv_b, lru_w_a, lru_b_a, lru_w_x, lru_b_x, lru_lambda, ab_w_out,
              c_w_in, c_lower_bound, c_norm_w, c_w_out,
              moe_w_group, moe_b_group, moe_w_expert, moe_b_expert, moe_w_gate, moe_w_up,
              moe_w_down):
    lbs = jnp.cumsum(jax.nn.softmax(c_lower_bound.astype(jnp.float32), axis=0), axis=0)
    lbs = lbs - lbs[0]
    for layer in range(DEPTH):
        j = layer // 2
        hn = rmsnorm(x, norm_mix[layer])
        if layer % 2 == 0:
            p = hn @ ab_w_in[j]
            ya = rwkv7_mixer(p[..., :RWKV_COLS], rw_mu[j], rw_w0[j], rw_w2[j], rw_a0[j],
                             rw_a2[j], rw_g2[j], rw_k_k[j], rw_k_a[j], rw_r_k[j],
                             rw_ln_w[j], rw_ln_b[j])
            yb = rglru_mixer(p[..., RWKV_COLS:], lru_conv_w[j], lru_conv_b[j], lru_w_a[j],
                             lru_b_a[j], lru_w_x[j], lru_b_x[j], lru_lambda[j])
            x = x + jnp.concatenate([ya, yb], axis=-1) @ ab_w_out[j]
        else:
            x = x + hgrn2_mixer(hn, c_w_in[j], lbs[layer], c_norm_w[j], c_w_out[j])
        hn = rmsnorm(x, norm_ffn[layer])
        x = x + hier_moe(hn, moe_w_group[layer], moe_b_group[layer], moe_w_expert[layer],
                         moe_b_expert[layer], moe_w_gate[layer], moe_w_up[layer],
                         moe_w_down[layer])
    return rmsnorm(x, norm_final)
```

```cpp
#include <hip/hip_runtime.h>
#include <cstdio>
#include <cstdint>

typedef unsigned short bf16_t;
#define LAS __attribute__((address_space(3)))
typedef float f32x4 __attribute__((ext_vector_type(4)));
typedef short bf16x8_t __attribute__((ext_vector_type(8)));
typedef unsigned u32x4_t __attribute__((ext_vector_type(4)));
typedef unsigned u32x2_t __attribute__((ext_vector_type(2)));

constexpr int NTOK = 32768, SEQ = 8192, NBATCH = 4, DM = 1024;
constexpr int ABC = 2816, RWC = 1792;
constexpr int NEXP = 32, FF = 512;
constexpr int NASG = NTOK * 2;
constexpr int MOE_TM = 256;
constexpr int MAXROWS = NASG + NEXP * MOE_TM;
constexpr int NTHREADS = 512;
constexpr int LDS_BYTES = 156 * 1024;
constexpr int LDS_MISC = 155 * 1024;

constexpr size_t MiB = 1024ull * 1024ull;
constexpr size_t WS_CTL = 0;
constexpr size_t CTL_ZERO_BYTES = 64 * 1024;
constexpr size_t WS_ROUTE = 64 * 1024;
constexpr size_t WS_WD = 8 * MiB;
constexpr size_t WD_ABIN = WS_WD, WD_ABOUT = WD_ABIN + (size_t)ABC * DM * 2, WD_CIN = WD_ABOUT + (size_t)DM * DM * 2, WD_COUT = WD_CIN + (size_t)4096 * DM * 2;
constexpr size_t WS_AR = 26 * MiB;
constexpr size_t WS_A = WS_AR;
constexpr size_t WS_B = WS_AR + 64 * MiB;
constexpr size_t WS_C = WS_B + 176 * MiB;
constexpr size_t WS_D = WS_C + 212 * MiB;
constexpr size_t DO_LRU = 112 * MiB;
constexpr size_t WS_XR = WS_AR + 360 * MiB;
constexpr size_t WS_WM = WS_AR + 64 * MiB;
constexpr size_t WM_GU1 = WS_A + 32 * MiB;
constexpr size_t WM_GU = WS_WM, WM_DN = WS_WM + (size_t)NEXP * DM * DM;
constexpr size_t WS_H = WS_WM + 96 * MiB;
constexpr size_t WS_Y = WS_H + 72 * MiB;
constexpr size_t WS_QFIG = WS_AR + 64 * MiB;
constexpr size_t WS_O = WS_QFIG + 256 * MiB;
constexpr size_t WS_MIX1 = WS_O + 128 * MiB;
constexpr size_t WS_END = WS_AR + 516 * MiB;
static_assert(WS_D + 64 * MiB <= WS_END && WS_Y + 128 * MiB <= WS_END && WS_MIX1 + 64 * MiB <= WS_END, "arena");

constexpr size_t DO_VB = 0, DO_BON = 32 * MiB, DO_SG = 34 * MiB, DO_YR = 48 * MiB;

constexpr int CW_CNT = 8192;
constexpr int CW_WMAX = CW_CNT + 512;
constexpr int CW_COLMAX = CW_WMAX + 192;
constexpr float ACT_Q = 127.f / 6.f;
constexpr size_t RT_ASG_E = 0;
constexpr size_t RT_ASG_RANK = RT_ASG_E + NASG * 4;
constexpr size_t RT_ASG_GATE = RT_ASG_RANK + NASG * 4;
constexpr size_t RT_ROW_TOK = RT_ASG_GATE + NASG * 4;
constexpr size_t RT_ROW_SLOT = RT_ROW_TOK + MAXROWS * 4;
constexpr size_t RT_ROW_GATE = RT_ROW_SLOT + MAXROWS * 4;
constexpr size_t RT_LRU_CH = RT_ROW_GATE + MAXROWS * 4;
constexpr size_t RT_LRU_CA = RT_LRU_CH + 512 * 512 * 4;
constexpr size_t RT_LRU_CIN = RT_LRU_CA + 512 * 512 * 4;
constexpr size_t RT_END = RT_LRU_CIN + 512 * 512 * 4;
constexpr size_t WS_FRAG = 6 * MiB;
constexpr size_t FG_RT = WS_FRAG + 393216;
constexpr size_t FG_W2 = WS_FRAG, FG_A2 = FG_W2 + 65536, FG_WA = FG_A2 + 65536, FG_WX = FG_WA + 65536, FG_G2 = FG_WX + 65536;
static_assert(WS_ROUTE + RT_END <= 6 * MiB, "routing arrays overflow");

__device__ __forceinline__ float bf2f(bf16_t v) { return __uint_as_float(((unsigned)v) << 16); }
typedef __bf16 bf16x2_hw __attribute__((ext_vector_type(2)));
typedef float f32x2_hw __attribute__((ext_vector_type(2)));
__device__ __forceinline__ unsigned pk2(float lo, float hi) { const f32x2_hw v = {lo, hi}; const bf16x2_hw b = __builtin_convertvector(v, bf16x2_hw); return __builtin_bit_cast(unsigned, b); }
__device__ __forceinline__ bf16_t f2bf(float f) { const __bf16 b = (__bf16)f; return __builtin_bit_cast(bf16_t, b); }
template <int CTRL> __device__ __forceinline__ float dpp_(float x) { return __builtin_bit_cast(float, __builtin_amdgcn_mov_dpp(__builtin_bit_cast(int, x), CTRL, 0xf, 0xf, true)); }
__device__ __forceinline__ float row16_sum(float v) {
    v += dpp_<0xB1>(v); v += dpp_<0x4E>(v); v += dpp_<0x124>(v); v += dpp_<0x128>(v); return v; }
__device__ __forceinline__ float xrow16_sum(float x) {
    auto s = __builtin_amdgcn_permlane16_swap(__float_as_uint(x), __float_as_uint(x), false, false);
    x = __uint_as_float(s[0]) + __uint_as_float(s[1]);
    auto t = __builtin_amdgcn_permlane32_swap(__float_as_uint(x), __float_as_uint(x), false, false);
    return __uint_as_float(t[0]) + __uint_as_float(t[1]); }
__device__ __forceinline__ float xrow32_sum(float x) {
    auto s = __builtin_amdgcn_permlane16_swap(__float_as_uint(x), __float_as_uint(x), false, false);
    return __uint_as_float(s[0]) + __uint_as_float(s[1]); }
__device__ __forceinline__ float wave_sum(float v) { return xrow16_sum(row16_sum(v)); }
__device__ __forceinline__ float sigmoidf_(float x) { return 1.f / (1.f + __expf(-x)); }
__device__ __forceinline__ float softplusf_(float x) { return fmaxf(x, 0.f) + log1pf(__expf(-fabsf(x))); }
__device__ __forceinline__ float siluf_(float x) { return x * sigmoidf_(x); }
__device__ __forceinline__ float gelu_tanhf_(float x) { const float c = 0.7978845608028654f; return 0.5f * x * (1.f + tanhf(c * (x + 0.044715f * x * x * x))); }

struct Args {
    const float* in[35];
    float* out;
    unsigned char* ws;
    int ph_lo, ph_hi;
};

#define XB_TMO      128
#define XB_XCNT(j)  (256  + 64 * (j))
#define XB_XSUB(j)  (1280 + 64 * (j))
#define XB_XGEN(j)  (2304 + 64 * (j))
#define XB_TOP      3328
#define XB_TOPGEN   3392
#define XCD_BAR_WORDS 3456
#define XB_SPIN_CAP (1u << 18)
__device__ __forceinline__ unsigned xb_ld(unsigned* p)              { return __hip_atomic_load(p, __ATOMIC_RELAXED, __HIP_MEMORY_SCOPE_AGENT); }
__device__ __forceinline__ unsigned xb_add(unsigned* p, unsigned v) { return __hip_atomic_fetch_add(p, v, __ATOMIC_RELAXED, __HIP_MEMORY_SCOPE_AGENT); }
__device__ __forceinline__ unsigned xb_xcc_id() { return (unsigned)__builtin_amdgcn_s_getreg((3 << 11) | 20) & 0xFu; }
#define XB_SPIN(cond, bar) do { unsigned _sp = 0; while (cond) { __builtin_amdgcn_s_sleep(1); \
    if ((++_sp & 255u) == 0u) { if (xb_ld(&(bar)[XB_TMO])) break; if (_sp > XB_SPIN_CAP) { atomicAdd(&(bar)[XB_TMO], 1u); break; } } } } while (0)
struct XcdBarrier { unsigned* bar; unsigned x; volatile LAS unsigned* st; };
__device__ __forceinline__ XcdBarrier xcd_barrier_post(unsigned* bar, volatile LAS unsigned* st) {
    XcdBarrier b; b.bar = bar; b.x = xb_xcc_id(); b.st = st;
    if (threadIdx.x == 0) (void)xb_add(&bar[XB_XCNT(b.x)], 1u);
    return b;
}
__device__ __forceinline__ void xcd_barrier_complete(unsigned* bar, unsigned x, unsigned& nloc, unsigned& nx) {
    const unsigned G = gridDim.x * gridDim.y * gridDim.z;
    unsigned sum, cnt, mine, sp = 0u;
    for (;;) {
        sum = 0u; cnt = 0u; mine = 0u;
#pragma unroll
        for (unsigned j = 0; j < 16; ++j) { const unsigned c = xb_ld(&bar[XB_XCNT(j)]); sum += c; cnt += (c > 0u) ? 1u : 0u; mine = (j == x) ? c : mine; }
        if (sum == G) break;
        __builtin_amdgcn_s_sleep(1);
        if ((++sp & 255u) == 0u) { if (xb_ld(&bar[XB_TMO])) break; if (sp > XB_SPIN_CAP) { atomicAdd(&bar[XB_TMO], 1u); break; } }
    }
    nloc = mine > 0u ? mine : 1u; nx = cnt > 0u ? cnt : 1u;
}
__device__ __forceinline__ void xcd_barrier(const XcdBarrier& b) {
    asm volatile("s_waitcnt vmcnt(0)" ::: "memory");
    __syncthreads();
    if (threadIdx.x == 0) {
        unsigned* bar = b.bar;
        __builtin_amdgcn_s_waitcnt(0);
        unsigned nloc = b.st[0], nx = b.st[1];
        if (nloc == 0u) { xcd_barrier_complete(bar, b.x, nloc, nx); b.st[0] = nloc; b.st[1] = nx; }
        const unsigned old = xb_add(&bar[XB_XSUB(b.x)], 1u);
        const unsigned gen = old / nloc;
        if (old + 1u == (gen + 1u) * nloc) {
            __builtin_amdgcn_fence(__ATOMIC_RELEASE, "agent");
            asm volatile("s_waitcnt vmcnt(0)" ::: "memory");
            const unsigned og = xb_add(&bar[XB_TOP], 1u);
            const unsigned tg = og / nx;
            if (og + 1u == (tg + 1u) * nx) xb_add(&bar[XB_TOPGEN], 1u);
            else XB_SPIN(xb_ld(&bar[XB_TOPGEN]) == tg, bar);
            __builtin_amdgcn_fence(__ATOMIC_ACQUIRE, "agent");
            xb_add(&bar[XB_XGEN(b.x)], 1u);
            asm volatile("s_waitcnt vmcnt(0)" ::: "memory");
        } else {
            XB_SPIN(xb_ld(&bar[XB_XGEN(b.x)]) == gen, bar);
            __builtin_amdgcn_fence(__ATOMIC_ACQUIRE, "agent");
            asm volatile("s_waitcnt vmcnt(0)" ::: "memory");
        }
    }
    __syncthreads();
}

namespace pg8 {
typedef short bf16x8 __attribute__((ext_vector_type(8)));
typedef unsigned u32x4 __attribute__((ext_vector_type(4)));
typedef int v4i_t __attribute__((ext_vector_type(4)));
constexpr int BM = 256, BK = 64, HALF = 128, HTB = HALF * BK * 2, STAGE_BYTES = 8 * HTB, NXCD = 8, WGM = 8;
__device__ __forceinline__ int lds_byte(int r, int c) { const int st = (r >> 4) * 2 + (c >> 5), rr = r & 15, cc = c & 31, ob = rr * 64 + cc * 2; return st * 1024 + (ob ^ (((ob >> 9) & 1) << 5)); }
__device__ __forceinline__ void stage_rc(int b, int& R, int& C) { const int st = b / 1024, sb = b % 1024, swz = sb ^ (((sb >> 9) & 1) << 5); R = (st >> 1) * 16 + swz / 64; C = (st & 1) * 32 + (swz % 64) / 2; }
__device__ __forceinline__ int perm32(int rho) { const int n = rho >> 4, i = rho & 15; return 8 * (i >> 2) + 4 * n + (i & 3); }
__device__ __forceinline__ unsigned cvt_pk_bf16(float lo, float hi) { unsigned r; asm volatile("v_cvt_pk_bf16_f32 %0, %1, %2" : "=v"(r) : "v"(lo), "v"(hi)); return r; }

struct Unit { int pm, pn; const char* B; };

struct DenseOrder {
    int nM, nN, nwg, G, c; const char* Bt; size_t bstep;
    __device__ void init(int M, int N, int K, int G_, int c_, const void* Bt_) { nM = M / BM; nN = N / BM; nwg = nM * nN; G = G_; c = c_; Bt = (const char*)Bt_; bstep = (size_t)BM * K * 2; }
    __device__ bool next(int i, Unit& u) const {
        const long L = (long)i * G + c; if (L >= nwg) return false;
        int wgid = (int)L; { const int q = nwg / NXCD, r = nwg % NXCD, xcd = wgid % NXCD, off = wgid / NXCD; wgid = (xcd < r ? xcd * (q + 1) : r * (q + 1) + (xcd - r) * q) + off; }
        const int nig = WGM * nN, gid = wgid / nig, fm = gid * WGM, gsz = (nM - fm) < WGM ? (nM - fm) : WGM;
        u.pm = fm + ((wgid % nig) % gsz); u.pn = (wgid % nig) / gsz; u.B = Bt + (size_t)u.pn * bstep; return true;
    }
    __device__ __forceinline__ int arow(const Unit& u, int r) const { return u.pm * BM + r; }
};
struct MoeOrder {
    int G, c, nN, ntiles; const LAS int* pst; const int* rowidx; const char* Bt; size_t estep, bstep;
    __device__ bool next(int i, Unit& u) const {
        const int cc = (G % NXCD == 0) ? (c % NXCD) * (G / NXCD) + c / NXCD : c;
        const int L = i * G + cc; if (L >= ntiles * nN) return false;
        u.pm = L / nN; u.pn = L % nN; const int row0 = u.pm * BM; int e = 0;
#pragma unroll
        for (int st = NEXP / 2; st > 0; st >>= 1) if (row0 >= pst[e + st]) e += st;
        u.B = Bt + (size_t)e * estep + (size_t)u.pn * bstep; return true;
    }
    __device__ __forceinline__ int arow(const Unit& u, int r) const { if (!rowidx) return u.pm * BM + r; const int t = rowidx[u.pm * BM + r]; return t < 0 ? 0 : t; }
};

struct EpiBf16I { static constexpr bool PERM = true; bf16_t* O; int ldc; const float* rowscale; const unsigned* colmax;
    __device__ __forceinline__ void operator()(const f32x4 (&acc)[2][2][4][2], const Unit& u, int wr, int wc, int fr, int fq) const {
        const int row0 = u.pm * BM + wr * 64 + fr, col0 = u.pn * BM + wc * 32 + 8 * fq;
        float rsc[8]; f32x4 cs[2][2];
#pragma unroll
        for (int q = 0; q < 8; ++q) rsc[q] = rowscale[row0 + (q >> 2) * HALF + (q & 3) * 16] * (1.f / 127.f);
#pragma unroll
        for (int bj = 0; bj < 2; ++bj)
#pragma unroll
            for (int n = 0; n < 2; ++n) { const u32x4 c4 = *(const u32x4*)(colmax + col0 + bj * HALF + 4 * n); cs[bj][n] = (f32x4){__uint_as_float(c4.x), __uint_as_float(c4.y), __uint_as_float(c4.z), __uint_as_float(c4.w)} * (1.f / 127.f); }
#pragma unroll
        for (int ai = 0; ai < 2; ++ai)
#pragma unroll
            for (int m = 0; m < 4; ++m) { bf16_t* rowp = O + (size_t)(row0 + ai * HALF + m * 16) * ldc + col0; const float rs = rsc[ai * 4 + m];
#pragma unroll
                for (int bj = 0; bj < 2; ++bj) { const v4i_t i0 = __builtin_bit_cast(v4i_t, acc[ai][bj][m][0]), i1 = __builtin_bit_cast(v4i_t, acc[ai][bj][m][1]);
                    const f32x4 s0 = cs[bj][0] * rs, s1 = cs[bj][1] * rs;
                    u32x4 w; w.x = cvt_pk_bf16((float)i0[0] * s0[0], (float)i0[1] * s0[1]); w.y = cvt_pk_bf16((float)i0[2] * s0[2], (float)i0[3] * s0[3]);
                    w.z = cvt_pk_bf16((float)i1[0] * s1[0], (float)i1[1] * s1[1]); w.w = cvt_pk_bf16((float)i1[2] * s1[2], (float)i1[3] * s1[3]);
                    *(u32x4*)(rowp + bj * HALF) = w; } }
    } };
struct EpiBf16 { static constexpr bool PERM = true; bf16_t* O; int ldc;
    __device__ __forceinline__ void operator()(const f32x4 (&acc)[2][2][4][2], const Unit& u, int wr, int wc, int fr, int fq) const {
        const int row0 = u.pm * BM + wr * 64 + fr, col0 = u.pn * BM + wc * 32 + 8 * fq;
#pragma unroll
        for (int ai = 0; ai < 2; ++ai)
#pragma unroll
            for (int m = 0; m < 4; ++m) { bf16_t* rowp = O + (size_t)(row0 + ai * HALF + m * 16) * ldc + col0;
#pragma unroll
                for (int bj = 0; bj < 2; ++bj) { const f32x4 v0 = acc[ai][bj][m][0], v1 = acc[ai][bj][m][1];
                    u32x4 w; w.x = cvt_pk_bf16(v0[0], v0[1]); w.y = cvt_pk_bf16(v0[2], v0[3]); w.z = cvt_pk_bf16(v1[0], v1[1]); w.w = cvt_pk_bf16(v1[2], v1[3]);
                    *(u32x4*)(rowp + bj * HALF) = w; } }
    } };
template <bool XF32> struct EpiResid { static constexpr bool PERM = true; const void* __restrict__ X; bf16_t* __restrict__ O;
    __device__ __forceinline__ void operator()(const f32x4 (&acc)[2][2][4][2], const Unit& u, int wr, int wc, int fr, int fq) const {
        const int row0 = u.pm * BM + wr * 64 + fr, col0 = u.pn * BM + wc * 32 + 8 * fq;
        if constexpr (XF32) {
#pragma unroll
            for (int ai = 0; ai < 2; ++ai)
#pragma unroll
                for (int mp = 0; mp < 2; ++mp) { f32x4 x[2][2][2];
#pragma unroll
                    for (int mm = 0; mm < 2; ++mm)
#pragma unroll
                        for (int bj = 0; bj < 2; ++bj) { const float* xp = (const float*)X + (size_t)(row0 + ai * HALF + (mp * 2 + mm) * 16) * DM + col0 + bj * HALF; x[mm][bj][0] = *(const f32x4*)xp; x[mm][bj][1] = *(const f32x4*)(xp + 4); }
#pragma unroll
                    for (int mm = 0; mm < 2; ++mm)
#pragma unroll
                        for (int bj = 0; bj < 2; ++bj) { const f32x4 v0 = x[mm][bj][0] + acc[ai][bj][mp * 2 + mm][0], v1 = x[mm][bj][1] + acc[ai][bj][mp * 2 + mm][1];
                            u32x4 w; w.x = cvt_pk_bf16(v0[0], v0[1]); w.y = cvt_pk_bf16(v0[2], v0[3]); w.z = cvt_pk_bf16(v1[0], v1[1]); w.w = cvt_pk_bf16(v1[2], v1[3]);
                            *(u32x4*)(O + (size_t)(row0 + ai * HALF + (mp * 2 + mm) * 16) * DM + col0 + bj * HALF) = w; } }
        } else {
#pragma unroll
            for (int ai = 0; ai < 2; ++ai) { u32x4 x[4][2];
#pragma unroll
                for (int m = 0; m < 4; ++m)
#pragma unroll
                    for (int bj = 0; bj < 2; ++bj) x[m][bj] = *(const u32x4*)((const bf16_t*)X + (size_t)(row0 + ai * HALF + m * 16) * DM + col0 + bj * HALF);
#pragma unroll
                for (int m = 0; m < 4; ++m)
#pragma unroll
                    for (int bj = 0; bj < 2; ++bj) { const u32x4 o = x[m][bj];
                        const f32x4 v0 = (f32x4){__uint_as_float(o.x << 16), __uint_as_float(o.x & 0xffff0000u), __uint_as_float(o.y << 16), __uint_as_float(o.y & 0xffff0000u)} + acc[ai][bj][m][0];
                        const f32x4 v1 = (f32x4){__uint_as_float(o.z << 16), __uint_as_float(o.z & 0xffff0000u), __uint_as_float(o.w << 16), __uint_as_float(o.w & 0xffff0000u)} + acc[ai][bj][m][1];
                        u32x4 w; w.x = cvt_pk_bf16(v0[0], v0[1]); w.y = cvt_pk_bf16(v0[2], v0[3]); w.z = cvt_pk_bf16(v1[0], v1[1]); w.w = cvt_pk_bf16(v1[2], v1[3]);
                        *(u32x4*)(O + (size_t)(row0 + ai * HALF + m * 16) * DM + col0 + bj * HALF) = w; } }
        }
    } };
struct EpiSwiGLU { static constexpr bool PERM = true; bf16_t* H; const float* tscale;
    __device__ __forceinline__ void operator()(const f32x4 (&acc)[2][2][4][2], const Unit& u, int wr, int wc, int fr, int fq) const {
        const int row0 = u.pm * BM + wr * 64 + fr, col0 = u.pn * HALF + wc * 32 + 8 * fq;
        const float s0 = tscale[2 * u.pm], s1 = tscale[2 * u.pm + 1];
#pragma unroll
        for (int ai = 0; ai < 2; ++ai)
#pragma unroll
            for (int m = 0; m < 4; ++m) { float h[8];
#pragma unroll
                for (int n = 0; n < 2; ++n) { const v4i_t gi = __builtin_bit_cast(v4i_t, acc[ai][0][m][n]), ui = __builtin_bit_cast(v4i_t, acc[ai][1][m][n]);
#pragma unroll
                    for (int j = 0; j < 4; ++j) { const float g = (float)gi[j] * s0; h[n * 4 + j] = g * __builtin_amdgcn_rcpf(1.f + __expf(-g)) * ((float)ui[j] * s1); } }
                u32x4 w; w.x = cvt_pk_bf16(h[0], h[1]); w.y = cvt_pk_bf16(h[2], h[3]); w.z = cvt_pk_bf16(h[4], h[5]); w.w = cvt_pk_bf16(h[6], h[7]);
                *(u32x4*)(H + (size_t)(row0 + ai * HALF + m * 16) * FF + col0) = w; }
    } };
struct EpiDown { static constexpr bool PERM = true; bf16_t* Y; const int* row_tok; const int* row_slot; const float* row_gate;
    __device__ __forceinline__ void operator()(const f32x4 (&acc)[2][2][4][2], const Unit& u, int wr, int wc, int fr, int fq) const {
        const int row0 = u.pm * BM + wr * 64 + fr, col0 = u.pn * BM + wc * 32 + 8 * fq;
        int tk[8], sl[8]; float gt[8];
#pragma unroll
        for (int q = 0; q < 8; ++q) { const int r = row0 + (q >> 2) * HALF + (q & 3) * 16; tk[q] = row_tok[r]; sl[q] = row_slot[r]; gt[q] = row_gate[r]; }
#pragma unroll
        for (int ai = 0; ai < 2; ++ai)
#pragma unroll
            for (int m = 0; m < 4; ++m) { const int q = ai * 4 + m;
                if (tk[q] < 0) continue;
                bf16_t* rowp = Y + (size_t)sl[q] * DM + col0;
#pragma unroll
                for (int bj = 0; bj < 2; ++bj) { const f32x4 v0 = acc[ai][bj][m][0] * gt[q], v1 = acc[ai][bj][m][1] * gt[q];
                    u32x4 w; w.x = cvt_pk_bf16(v0[0], v0[1]); w.y = cvt_pk_bf16(v0[2], v0[3]); w.z = cvt_pk_bf16(v1[0], v1[1]); w.w = cvt_pk_bf16(v1[2], v1[3]);
                    *(u32x4*)(rowp + bj * HALF) = w; } }
    } };

template <class Epi, class Sched, bool I8 = false>
__device__ __forceinline__ void gemm_phase(LAS unsigned char* lds, const char* A, const unsigned lda_b, const int K, const Sched& S, const Epi& E) {
    const int tid = threadIdx.x, wid = __builtin_amdgcn_readfirstlane(tid >> 6), lane = tid & 63, wr = wid >> 2, wc = wid & 3, fr = lane & 15, fq = lane >> 4;
    const int nt = K / BK;
    unsigned voffB[2];
#pragma unroll
    for (int i = 0; i < 2; ++i) { int R, C; stage_rc(tid * 16 + i * 8192, R, C); const int Rb = Epi::PERM ? ((R & ~31) + perm32(R & 31)) : R; voffB[i] = (unsigned)(Rb * K + C) * 2u; }
    const size_t kstep = (size_t)(BK * 2);
    const size_t hstepB = (size_t)HALF * K * 2;
    const unsigned ldsw = (unsigned)wid * 1024u;
    const int aoff = lds_byte(wr * 64 + fr, fq * 8), boff = lds_byte(wc * 32 + fr, fq * 8);
#define PG8_SA(b, h) (((b) * 2 + (h)) * HTB)
#define PG8_SB(b, h) ((4 + (b) * 2 + (h)) * HTB)
#define PG8_STAGE(bufoff, gbase, voff) do { _Pragma("unroll") for (int _i = 0; _i < 2; ++_i) \
        __builtin_amdgcn_global_load_lds((const unsigned*)((const char*)(gbase) + (voff)[_i]), (LAS unsigned*)(lds + (bufoff) + ldsw + _i * 8192), 16, 0, 0); } while (0)
#define PG8_LDA(dst, b, h) do { _Pragma("unroll") for (int m = 0; m < 4; ++m) _Pragma("unroll") for (int k = 0; k < 2; ++k) dst[m][k] = *(const LAS bf16x8*)(lds + PG8_SA(b, h) + aoff + m * 2048 + k * 1024); } while (0)
#define PG8_LDB(dst, b, h) do { _Pragma("unroll") for (int n = 0; n < 2; ++n) _Pragma("unroll") for (int k = 0; k < 2; ++k) dst[n][k] = *(const LAS bf16x8*)(lds + PG8_SB(b, h) + boff + n * 2048 + k * 1024); } while (0)
#define PG8_MMA(ai, bj, At, Bt) do { __builtin_amdgcn_s_setprio(1); _Pragma("unroll") for (int m = 0; m < 4; ++m) _Pragma("unroll") for (int n = 0; n < 2; ++n) _Pragma("unroll") for (int k = 0; k < 2; ++k) { \
        if constexpr (I8) acc[ai][bj][m][n] = __builtin_bit_cast(f32x4, __builtin_amdgcn_mfma_i32_16x16x64_i8(__builtin_bit_cast(v4i_t, Bt[n][k]), __builtin_bit_cast(v4i_t, At[m][k]), __builtin_bit_cast(v4i_t, acc[ai][bj][m][n]), 0, 0, 0)); \
        else acc[ai][bj][m][n] = __builtin_amdgcn_mfma_f32_16x16x32_bf16(Bt[n][k], At[m][k], acc[ai][bj][m][n], 0, 0, 0); } __builtin_amdgcn_s_setprio(0); } while (0)
#define PG8_WAIT_V(n) asm volatile("s_waitcnt vmcnt(" #n ")" ::: "memory")
#define PG8_WAIT_L(n) asm volatile("s_waitcnt lgkmcnt(" #n ")" ::: "memory")
#define PG8_BAR __builtin_amdgcn_s_barrier()
#define PG8_SCHED __builtin_amdgcn_sched_barrier(0)
#define PG8_AOFF(dst, u) do { int _tz = threadIdx.x; asm volatile("" : "+v"(_tz)); _Pragma("unroll") for (int _i = 0; _i < 2; ++_i) { int _R, _C; stage_rc(_tz * 16 + _i * 8192, _R, _C); \
        _Pragma("unroll") for (int _h = 0; _h < 2; ++_h) dst[_h][_i] = (unsigned)S.arow(u, _h * HALF + _R) * lda_b + (unsigned)_C * 2u; } } while (0)
    Unit cur, nxt; int ui = 0;
    if (!S.next(0, cur)) return;
    f32x4 acc[2][2][4][2];
#pragma unroll
    for (int a = 0; a < 2; ++a)
#pragma unroll
        for (int b = 0; b < 2; ++b)
#pragma unroll
            for (int m = 0; m < 4; ++m)
#pragma unroll
                for (int n = 0; n < 2; ++n) acc[a][b][m][n] = (f32x4){0.f, 0.f, 0.f, 0.f};
    bf16x8 At[4][2], B0[2][2], B1[2][2];
    unsigned vA[2][2], vAn[2][2];
    PG8_AOFF(vA, cur);
    const char* cB = cur.B;
    PG8_STAGE(PG8_SB(0, 0), cB, voffB); PG8_STAGE(PG8_SA(0, 0), A, vA[0]); PG8_STAGE(PG8_SB(0, 1), cB + hstepB, voffB); PG8_STAGE(PG8_SA(0, 1), A, vA[1]);
    if (wr == 1) PG8_BAR;
    PG8_WAIT_V(4); PG8_BAR;
    PG8_STAGE(PG8_SB(1, 0), cB + kstep, voffB); PG8_STAGE(PG8_SA(1, 0), A + kstep, vA[0]); PG8_STAGE(PG8_SB(1, 1), cB + hstepB + kstep, voffB);
    PG8_WAIT_V(6); PG8_BAR;
    for (;;) {
        const bool has_next = S.next(ui + 1, nxt);
        if (has_next) { PG8_AOFF(vAn, nxt); } else {
#pragma unroll
            for (int h = 0; h < 2; ++h)
#pragma unroll
                for (int i = 0; i < 2; ++i) vAn[h][i] = vA[h][i]; }
        const char* nB = has_next ? nxt.B : cB;
        for (int t = 0; t < nt; t += 2) {
            const bool last = (t == nt - 2);
            const char* a1 = A + (size_t)(t + 1) * kstep;
            const char* a2 = last ? A : A + (size_t)(t + 2) * kstep; const char* b2 = last ? nB : cB + (size_t)(t + 2) * kstep;
            const char* a3 = a2 + kstep; const char* b3 = b2 + kstep;
            unsigned o2[2][2];
#pragma unroll
            for (int h = 0; h < 2; ++h)
#pragma unroll
                for (int i = 0; i < 2; ++i) o2[h][i] = last ? vAn[h][i] : vA[h][i];
            PG8_LDB(B0, 0, 0); PG8_SCHED; PG8_LDA(At, 0, 0); PG8_STAGE(PG8_SA(1, 1), a1, vA[1]);
            PG8_WAIT_L(8); PG8_BAR; PG8_WAIT_L(0); PG8_MMA(0, 0, At, B0); PG8_BAR; PG8_SCHED;
            PG8_LDB(B1, 0, 1); PG8_STAGE(PG8_SB(0, 0), b2, voffB);
            PG8_BAR; PG8_WAIT_L(0); PG8_MMA(0, 1, At, B1); PG8_BAR;
            PG8_LDA(At, 0, 1); PG8_STAGE(PG8_SA(0, 0), a2, o2[0]);
            PG8_BAR; PG8_WAIT_L(0); PG8_MMA(1, 0, At, B0); PG8_BAR; PG8_SCHED;
            PG8_STAGE(PG8_SB(0, 1), b2 + hstepB, voffB);
            PG8_WAIT_V(6); PG8_BAR; PG8_MMA(1, 1, At, B1); PG8_BAR;
            PG8_LDB(B0, 1, 0); PG8_SCHED; PG8_LDA(At, 1, 0); PG8_STAGE(PG8_SA(0, 1), a2, o2[1]);
            PG8_WAIT_L(8); PG8_BAR; PG8_WAIT_L(0); PG8_MMA(0, 0, At, B0); PG8_BAR; PG8_SCHED;
            PG8_LDB(B1, 1, 1); PG8_STAGE(PG8_SB(1, 0), b3, voffB);
            PG8_BAR; PG8_WAIT_L(0); PG8_MMA(0, 1, At, B1); PG8_BAR;
            PG8_LDA(At, 1, 1); PG8_STAGE(PG8_SA(1, 0), a3, o2[0]);
            PG8_BAR; PG8_WAIT_L(0); PG8_MMA(1, 0, At, B0); PG8_BAR; PG8_SCHED;
            PG8_STAGE(PG8_SB(1, 1), b3 + hstepB, voffB);
            PG8_WAIT_V(6); PG8_BAR; PG8_MMA(1, 1, At, B1); PG8_BAR;
        }
        E(acc, cur, wr, wc, fr, fq);
        if (!has_next) break;
#pragma unroll
        for (int a = 0; a < 2; ++a)
#pragma unroll
            for (int b = 0; b < 2; ++b)
#pragma unroll
                for (int m = 0; m < 4; ++m)
#pragma unroll
                    for (int n = 0; n < 2; ++n) acc[a][b][m][n] = (f32x4){0.f, 0.f, 0.f, 0.f};
        cur = nxt; cB = nB; ++ui;
#pragma unroll
        for (int h = 0; h < 2; ++h)
#pragma unroll
            for (int i = 0; i < 2; ++i) vA[h][i] = vAn[h][i];
    }
    PG8_WAIT_V(0);
    if (wr == 0) PG8_BAR;
    PG8_BAR;
#undef PG8_SA
#undef PG8_SB
#undef PG8_STAGE
#undef PG8_LDA
#undef PG8_LDB
#undef PG8_MMA
#undef PG8_WAIT_V
#undef PG8_WAIT_L
#undef PG8_BAR
#undef PG8_SCHED
#undef PG8_AOFF
}
}

template <int MODE>
__device__ __forceinline__ void transpose_item(const float* W, int K, int N, bf16_t* WT, LAS float* scr, int item, int lane) {
    const int nblk = N / 64, kb = item / nblk, nb = item % nblk, k0 = 64 * kb, n0 = 64 * nb;
    const int lr = lane >> 4, lc = (lane & 15) * 4;
    float4 v[16];
#pragma unroll
    for (int i = 0; i < 16; ++i) v[i] = *(const float4*)(W + (size_t)(k0 + 4 * i + lr) * N + n0 + lc);
#pragma unroll
    for (int i = 0; i < 16; ++i) { LAS float* d = scr + (4 * i + lr) * 66 + lc; *(LAS f32x2_hw*)d = (f32x2_hw){v[i].x, v[i].y}; *(LAS f32x2_hw*)(d + 2) = (f32x2_hw){v[i].z, v[i].w}; }
    asm volatile("s_waitcnt lgkmcnt(0)" ::: "memory");
    const int c = lane & 7;
#pragma unroll
    for (int j = 0; j < 8; ++j) { const int n = (lane >> 3) + 8 * j; const LAS float* sp = scr + (8 * c) * 66 + n;
        pg8::u32x4 o; o.x = pk2(sp[0 * 66], sp[1 * 66]); o.y = pk2(sp[2 * 66], sp[3 * 66]); o.z = pk2(sp[4 * 66], sp[5 * 66]); o.w = pk2(sp[6 * 66], sp[7 * 66]);
        const int nn = n0 + n; const int dr = MODE == 0 ? nn : (256 * (nn >> 7) + (nn & 127) + (MODE == 2 ? 128 : 0));
        *(pg8::u32x4*)(WT + (size_t)dr * K + k0 + 8 * c) = o; }
    asm volatile("s_waitcnt lgkmcnt(0)" ::: "memory");
}
__device__ __forceinline__ float wave_max(float v) {
    v = fmaxf(v, dpp_<0xB1>(v)); v = fmaxf(v, dpp_<0x4E>(v)); v = fmaxf(v, dpp_<0x124>(v)); v = fmaxf(v, dpp_<0x128>(v));
    auto s = __builtin_amdgcn_permlane16_swap(__float_as_uint(v), __float_as_uint(v), false, false); v = fmaxf(__uint_as_float(s[0]), __uint_as_float(s[1]));
    auto t = __builtin_amdgcn_permlane32_swap(__float_as_uint(v), __float_as_uint(v), false, false); return fmaxf(__uint_as_float(t[0]), __uint_as_float(t[1])); }
__device__ __forceinline__ unsigned q8x4(float a, float b, float c, float d, float qs) {
    const int ia = (int)rintf(fminf(fmaxf(a * qs, -127.f), 127.f)), ib = (int)rintf(fminf(fmaxf(b * qs, -127.f), 127.f)), ic = (int)rintf(fminf(fmaxf(c * qs, -127.f), 127.f)), id = (int)rintf(fminf(fmaxf(d * qs, -127.f), 127.f));
    return (unsigned)(ia & 255) | ((unsigned)(ib & 255) << 8) | ((unsigned)(ic & 255) << 16) | ((unsigned)(id & 255) << 24); }
__device__ __noinline__ void ph_wmax(const float* wg, const float* wu, unsigned* wmax, int bid, int nblk) {
    const int wave = threadIdx.x >> 6, lane = threadIdx.x & 63, gw = bid * 8 + wave, NGW = nblk * 8;
    constexpr int IT = (DM / 64) * (FF / 64);
    for (int it = gw; it < 2 * NEXP * 2 * IT; it += NGW) { const int mat = it / IT, tl = it % IT; const int le = mat >> 1, gu = mat & 1;
        const float* W = (gu ? wu : wg) + (size_t)le * DM * FF; const int k0 = 64 * (tl / (FF / 64)), n0 = 64 * (tl % (FF / 64));
        float m = 0.f;
#pragma unroll 4
        for (int i = 0; i < 16; ++i) { const float4 v = *(const float4*)(W + (size_t)(k0 + 4 * i + (lane >> 4)) * FF + n0 + (lane & 15) * 4); m = fmaxf(fmaxf(m, fmaxf(fabsf(v.x), fabsf(v.y))), fmaxf(fabsf(v.z), fabsf(v.w))); }
        m = wave_max(m);
        if (lane == 0) atomicMax(wmax + le * 2 + gu, __float_as_uint(m)); }
}
template <int MODE>
__device__ __forceinline__ void transpose_item_i8(const float* W, int K, int N, unsigned char* WT, LAS float* scr, int item, int lane, float qs) {
    const int nblk = N / 64, kb = item / nblk, nb = item % nblk, k0 = 64 * kb, n0 = 64 * nb;
    const int lr = lane >> 4, lc = (lane & 15) * 4;
    float4 v[16];
#pragma unroll
    for (int i = 0; i < 16; ++i) v[i] = *(const float4*)(W + (size_t)(k0 + 4 * i + lr) * N + n0 + lc);
#pragma unroll
    for (int i = 0; i < 16; ++i) { LAS float* d = scr + (4 * i + lr) * 66 + lc; *(LAS f32x2_hw*)d = (f32x2_hw){v[i].x, v[i].y}; *(LAS f32x2_hw*)(d + 2) = (f32x2_hw){v[i].z, v[i].w}; }
    asm volatile("s_waitcnt lgkmcnt(0)" ::: "memory");
    const int c = lane & 3;
#pragma unroll
    for (int j = 0; j < 4; ++j) { const int n = (lane >> 2) + 16 * j; const LAS float* sp = scr + (16 * c) * 66 + n;
        pg8::u32x4 o;
        o.x = q8x4(sp[0 * 66], sp[1 * 66], sp[2 * 66], sp[3 * 66], qs); o.y = q8x4(sp[4 * 66], sp[5 * 66], sp[6 * 66], sp[7 * 66], qs);
        o.z = q8x4(sp[8 * 66], sp[9 * 66], sp[10 * 66], sp[11 * 66], qs); o.w = q8x4(sp[12 * 66], sp[13 * 66], sp[14 * 66], sp[15 * 66], qs);
        const int nn = n0 + n; const int dr = MODE == 0 ? nn : (256 * (nn >> 7) + (nn & 127) + (MODE == 2 ? 128 : 0));
        *(pg8::u32x4*)(WT + (size_t)dr * K + k0 + 16 * c) = o; }
    asm volatile("s_waitcnt lgkmcnt(0)" ::: "memory");
}
__device__ __forceinline__ void transpose_item_i8c(const float* W, int K, int N, unsigned char* WT, LAS float* scr, int item, int lane, const unsigned* colmax) {
    const int nblk = N / 64, kb = item / nblk, nb = item % nblk, k0 = 64 * kb, n0 = 64 * nb;
    const int lr = lane >> 4, lc = (lane & 15) * 4;
    float4 v[16];
#pragma unroll
    for (int i = 0; i < 16; ++i) v[i] = *(const float4*)(W + (size_t)(k0 + 4 * i + lr) * N + n0 + lc);
#pragma unroll
    for (int i = 0; i < 16; ++i) { LAS float* d = scr + (4 * i + lr) * 66 + lc; *(LAS f32x2_hw*)d = (f32x2_hw){v[i].x, v[i].y}; *(LAS f32x2_hw*)(d + 2) = (f32x2_hw){v[i].z, v[i].w}; }
    asm volatile("s_waitcnt lgkmcnt(0)" ::: "memory");
    const int c = lane & 3;
#pragma unroll
    for (int j = 0; j < 4; ++j) { const int n = (lane >> 2) + 16 * j; const LAS float* sp = scr + (16 * c) * 66 + n;
        const float qs = 127.f / fmaxf(__uint_as_float(colmax[n0 + n]), 1e-30f);
        pg8::u32x4 o;
        o.x = q8x4(sp[0 * 66], sp[1 * 66], sp[2 * 66], sp[3 * 66], qs); o.y = q8x4(sp[4 * 66], sp[5 * 66], sp[6 * 66], sp[7 * 66], qs);
        o.z = q8x4(sp[8 * 66], sp[9 * 66], sp[10 * 66], sp[11 * 66], qs); o.w = q8x4(sp[12 * 66], sp[13 * 66], sp[14 * 66], sp[15 * 66], qs);
        *(pg8::u32x4*)(WT + (size_t)(n0 + n) * K + k0 + 16 * c) = o; }
    asm volatile("s_waitcnt lgkmcnt(0)" ::: "memory");
}
__device__ __forceinline__ void frag_build(const float* W, int ldw, int col0, int nks, bf16_t* dst, int lane) {
    const int q4 = lane >> 4, c16 = lane & 15;
    for (int ct = 0; ct < 4; ++ct) for (int ks = 0; ks < nks; ++ks) { float v[8];
#pragma unroll
        for (int jj = 0; jj < 8; ++jj) v[jj] = W[(size_t)(32 * ks + 8 * q4 + jj) * ldw + col0 + 16 * ct + c16];
        *(pg8::u32x4*)(dst + ((size_t)(ct * nks + ks) * 64 + lane) * 8) = (pg8::u32x4){pk2(v[0], v[1]), pk2(v[2], v[3]), pk2(v[4], v[5]), pk2(v[6], v[7])}; }
}
__device__ __forceinline__ void ph_cvt_frags(const Args& a) {
    const int wave = threadIdx.x >> 6, lane = threadIdx.x & 63, gw = blockIdx.x * 8 + wave;
    if (gw >= 40) {
        const int it = gw - 40; if (it >= 64) return;
        const int L = it >> 5, ks = it & 31, q4 = lane >> 4, c16 = lane & 15;
        const float* gain = a.in[2] + L * DM; const float* wg = a.in[28] + (size_t)L * DM * 4; const float* we = a.in[30] + (size_t)L * DM * 32;
        bf16_t* dh = (bf16_t*)(a.ws + FG_RT) + (size_t)L * 2 * 49152; bf16_t* dl = dh + 49152;
        for (int ct = 0; ct < 3; ++ct) { const int col = 16 * ct + c16; float hi[8], lo[8];
#pragma unroll
            for (int jj = 0; jj < 8; ++jj) { const int k = 32 * ks + 8 * q4 + jj; const float w = col < 4 ? wg[k * 4 + col] : (col < 36 ? we[k * 32 + col - 4] : 0.f); const float v = gain[k] * w;
                hi[jj] = bf2f(f2bf(v)); lo[jj] = v - hi[jj]; }
            const size_t o = ((size_t)(ks * 3 + ct) * 64 + lane) * 8;
            *(pg8::u32x4*)(dh + o) = (pg8::u32x4){pk2(hi[0], hi[1]), pk2(hi[2], hi[3]), pk2(hi[4], hi[5]), pk2(hi[6], hi[7])};
            *(pg8::u32x4*)(dl + o) = (pg8::u32x4){pk2(lo[0], lo[1]), pk2(lo[2], lo[3]), pk2(lo[4], lo[5]), pk2(lo[6], lo[7])}; }
        return; }
    const int arr = gw >> 3, h = gw & 7;
    if (arr == 0) frag_build(a.in[7], 512, 64 * h, 2, (bf16_t*)(a.ws + FG_W2) + h * 4096, lane);
    else if (arr == 1) frag_build(a.in[9], 512, 64 * h, 2, (bf16_t*)(a.ws + FG_A2) + h * 4096, lane);
    else if (arr == 2) frag_build(a.in[18] + h * 4096, 64, 0, 2, (bf16_t*)(a.ws + FG_WA) + h * 4096, lane);
    else if (arr == 3) frag_build(a.in[20] + h * 4096, 64, 0, 2, (bf16_t*)(a.ws + FG_WX) + h * 4096, lane);
    else frag_build(a.in[10], 512, 64 * h, 4, (bf16_t*)(a.ws + FG_G2) + h * 8192, lane);
}
__device__ __forceinline__ void ph_cvt_dense_a(const Args& a, LAS float* lds, unsigned* colmax) {
    const int wave = threadIdx.x >> 6, lane = threadIdx.x & 63, gw = blockIdx.x * 8 + wave, NGW = gridDim.x * 8;
    LAS float* scr = lds + wave * (64 * 66);
    constexpr int I0 = (DM / 64) * (ABC / 64), I1 = (DM / 64) * (DM / 64), I2 = (DM / 64) * (4096 / 64), I3 = I1;
    for (int it = gw; it < I0 + I1 + I2 + I3; it += NGW) { int r = it;
        if (r < I1) { transpose_item<0>(a.in[23], DM, DM, (bf16_t*)(a.ws + WD_ABOUT), scr, r, lane); continue; } r -= I1;
        if (r < I3) { transpose_item<0>(a.in[27], DM, DM, (bf16_t*)(a.ws + WD_COUT), scr, r, lane); continue; } r -= I3;
        const int m = r < I0 ? 0 : 1; if (m) r -= I0; const int N = m ? 4096 : ABC; const float* W = m ? a.in[24] : a.in[4];
        const int k0 = 64 * (r / (N / 64)), n0 = 64 * (r % (N / 64)); float mx[4] = {0.f, 0.f, 0.f, 0.f};
#pragma unroll 4
        for (int i = 0; i < 16; ++i) { const float4 v = *(const float4*)(W + (size_t)(k0 + 4 * i + (lane >> 4)) * N + n0 + (lane & 15) * 4);
            mx[0] = fmaxf(mx[0], fabsf(v.x)); mx[1] = fmaxf(mx[1], fabsf(v.y)); mx[2] = fmaxf(mx[2], fabsf(v.z)); mx[3] = fmaxf(mx[3], fabsf(v.w)); }
#pragma unroll
        for (int q = 0; q < 4; ++q) { float t = mx[q];
            auto s1 = __builtin_amdgcn_permlane16_swap(__float_as_uint(t), __float_as_uint(t), false, false); t = fmaxf(__uint_as_float(s1[0]), __uint_as_float(s1[1]));
            auto s2 = __builtin_amdgcn_permlane32_swap(__float_as_uint(t), __float_as_uint(t), false, false); t = fmaxf(__uint_as_float(s2[0]), __uint_as_float(s2[1]));
            if (lane < 16) atomicMax(colmax + (m ? ABC : 0) + n0 + lane * 4 + q, __float_as_uint(t)); } }
}
__device__ __forceinline__ void ph_cvt_dense_b(const Args& a, LAS float* lds, const unsigned* colmax, int m) {
    const int wave = threadIdx.x >> 6, lane = threadIdx.x & 63, gw = blockIdx.x * 8 + wave, NGW = gridDim.x * 8;
    LAS float* scr = lds + wave * (64 * 66);
    const int N = m ? 4096 : ABC; const int NI = (DM / 64) * (N / 64);
    for (int it = gw; it < NI; it += NGW) transpose_item_i8c(m ? a.in[24] : a.in[4], DM, N, a.ws + (m ? WD_CIN : WD_ABIN), scr, it, lane, colmax + (m ? ABC : 0));
}
__device__ __forceinline__ void ph_cvt_moe(const Args& a, int L, LAS float* lds, int bid, int nblk, int which) {
    const int wave = threadIdx.x >> 6, lane = threadIdx.x & 63, gw = bid * 8 + wave, NGW = nblk * 8;
    LAS float* scr = lds + wave * (64 * 66);
    constexpr int IG = (DM / 64) * (FF / 64), ID = (FF / 64) * (DM / 64);
    const int i0 = (which & 1) ? 0 : 2 * IG, IE = ((which & 1) ? 2 * IG : 0) + ((which & 2) ? ID : 0);
    unsigned char* gub = a.ws + (L ? WM_GU1 : WM_GU);
    for (int it = gw; it < NEXP * IE; it += NGW) { const int e = it / IE; int r = i0 + it % IE;
        unsigned char* gu = gub + (size_t)e * DM * DM; bf16_t* dn = (bf16_t*)(a.ws + WM_DN) + (size_t)e * DM * FF;
        const unsigned* wm = (const unsigned*)(a.ws + WS_CTL) + CW_WMAX + (L * NEXP + e) * 2;
        const size_t wo = ((size_t)L * NEXP + e) * DM * FF;
        if (r < IG) { transpose_item_i8<1>(a.in[32] + wo, DM, FF, gu, scr, r, lane, 127.f / fmaxf(__uint_as_float(wm[0]), 1e-30f)); continue; } r -= IG;
        if (r < IG) { transpose_item_i8<2>(a.in[33] + wo, DM, FF, gu, scr, r, lane, 127.f / fmaxf(__uint_as_float(wm[1]), 1e-30f)); continue; } r -= IG;
        transpose_item<0>(a.in[34] + wo, FF, DM, dn, scr, r, lane); }
}

__device__ __forceinline__ void load_row16(const float* row, int lane, float4 (&v)[4]) {
#pragma unroll
    for (int j = 0; j < 4; ++j) v[j] = *(const float4*)(row + lane * 4 + 256 * j);
}
__device__ __forceinline__ float row_sumsq(const float4 (&v)[4]) {
    float s = 0.f;
#pragma unroll
    for (int j = 0; j < 4; ++j) s += v[j].x * v[j].x + v[j].y * v[j].y + v[j].z * v[j].z + v[j].w * v[j].w;
    return wave_sum(s);
}
__device__ __forceinline__ void norm_row(float4 (&v)[4], const float* gain, int lane) {
    const float rs = rsqrtf(row_sumsq(v) * (1.f / DM) + 1e-6f);
#pragma unroll
    for (int j = 0; j < 4; ++j) { const float4 g = *(const float4*)(gain + lane * 4 + 256 * j);
        v[j].x *= rs * g.x; v[j].y *= rs * g.y; v[j].z *= rs * g.z; v[j].w *= rs * g.w; }
}
__device__ __forceinline__ void store_row_bf16(bf16_t* row, int lane, const float4 (&v)[4]) {
#pragma unroll
    for (int j = 0; j < 4; ++j) { uint2 o; o.x = f2bf(v[j].x) | ((unsigned)f2bf(v[j].y) << 16); o.y = f2bf(v[j].z) | ((unsigned)f2bf(v[j].w) << 16);
        *(uint2*)(row + lane * 4 + 256 * j) = o; }
}
__device__ __forceinline__ void add_row_bf16(const bf16_t* row, int lane, float4 (&v)[4]) {
#pragma unroll
    for (int j = 0; j < 4; ++j) { const uint2 o = *(const uint2*)(row + lane * 4 + 256 * j);
        v[j].x += __uint_as_float(o.x << 16); v[j].y += __uint_as_float(o.x & 0xffff0000u); v[j].z += __uint_as_float(o.y << 16); v[j].w += __uint_as_float(o.y & 0xffff0000u); }
}

__device__ __forceinline__ void ph_norm0(const float* x, const float* gain, unsigned char* HN8, float* rowscale) {
    const int lane = threadIdx.x & 63, gw = blockIdx.x * 8 + (threadIdx.x >> 6), NGW = gridDim.x * 8;
    for (int n = gw; n < NTOK; n += NGW) { float4 v[4]; load_row16(x + (size_t)n * DM, lane, v); norm_row(v, gain, lane);
        float mx = 0.f;
#pragma unroll
        for (int j = 0; j < 4; ++j) mx = fmaxf(fmaxf(mx, fmaxf(fabsf(v[j].x), fabsf(v[j].y))), fmaxf(fabsf(v[j].z), fabsf(v[j].w)));
        mx = fmaxf(wave_max(mx), 1e-30f); const float qs = 127.f / mx;
        if (lane == 0) rowscale[n] = mx;
#pragma unroll
        for (int j = 0; j < 4; ++j) *(unsigned*)(HN8 + (size_t)n * DM + lane * 4 + 256 * j) = q8x4(v[j].x, v[j].y, v[j].z, v[j].w, qs); }
}
__device__ __forceinline__ void ld8bf(const bf16_t* p, float (&v)[8]) { const u32x4_t o = *(const u32x4_t*)p;
    v[0] = __uint_as_float(o.x << 16); v[1] = __uint_as_float(o.x & 0xffff0000u); v[2] = __uint_as_float(o.y << 16); v[3] = __uint_as_float(o.y & 0xffff0000u);
    v[4] = __uint_as_float(o.z << 16); v[5] = __uint_as_float(o.z & 0xffff0000u); v[6] = __uint_as_float(o.w << 16); v[7] = __uint_as_float(o.w & 0xffff0000u); }
__device__ __forceinline__ void st8bf(bf16_t* p, const float (&v)[8]) { *(u32x4_t*)p = (u32x4_t){pk2(v[0], v[1]), pk2(v[2], v[3]), pk2(v[4], v[5]), pk2(v[6], v[7])}; }
__device__ __forceinline__ void ph_combine_norm(bf16_t* XR, const bf16_t* Y, const float* gain, unsigned char* HN8, float* rowscale) {
    const int lane = threadIdx.x & 63, gw = blockIdx.x * 8 + (threadIdx.x >> 6), NGW = gridDim.x * 8;
    for (int n = gw; n < NTOK; n += NGW) { float x[2][8], y0[2][8], y1[2][8]; float ss = 0.f;
#pragma unroll
        for (int j = 0; j < 2; ++j) { const int o = lane * 8 + 512 * j; ld8bf(XR + (size_t)n * DM + o, x[j]); ld8bf(Y + (size_t)(2 * n) * DM + o, y0[j]); ld8bf(Y + (size_t)(2 * n + 1) * DM + o, y1[j]); }
#pragma unroll
        for (int j = 0; j < 2; ++j) {
#pragma unroll
            for (int i = 0; i < 8; ++i) x[j][i] = bf2f(f2bf(x[j][i] + y0[j][i] + y1[j][i]));
            st8bf(XR + (size_t)n * DM + lane * 8 + 512 * j, x[j]);
#pragma unroll
            for (int i = 0; i < 8; ++i) ss += x[j][i] * x[j][i]; }
        const float rs = rsqrtf(wave_sum(ss) * (1.f / DM) + 1e-6f);
#pragma unroll
        for (int j = 0; j < 2; ++j) { const int o = lane * 8 + 512 * j; const float4 g0 = *(const float4*)(gain + o), g1 = *(const float4*)(gain + o + 4);
            const float gg[8] = {g0.x, g0.y, g0.z, g0.w, g1.x, g1.y, g1.z, g1.w};
#pragma unroll
            for (int i = 0; i < 8; ++i) x[j][i] *= rs * gg[i]; }
        float mx = 0.f;
#pragma unroll
        for (int j = 0; j < 2; ++j)
#pragma unroll
            for (int i = 0; i < 8; ++i) mx = fmaxf(mx, fabsf(x[j][i]));
        mx = fmaxf(wave_max(mx), 1e-30f); const float qs = 127.f / mx;
        if (lane == 0) rowscale[n] = mx;
#pragma unroll
        for (int j = 0; j < 2; ++j) { const int o = lane * 8 + 512 * j;
            *(u32x2_t*)(HN8 + (size_t)n * DM + o) = (u32x2_t){q8x4(x[j][0], x[j][1], x[j][2], x[j][3], qs), q8x4(x[j][4], x[j][5], x[j][6], x[j][7], qs)}; } }
}
__device__ __forceinline__ void ph_final(const bf16_t* XR, const bf16_t* Y, const float* gain, float* out) {
    const int lane = threadIdx.x & 63, gw = blockIdx.x * 8 + (threadIdx.x >> 6), NGW = gridDim.x * 8;
    for (int n = gw; n < NTOK; n += NGW) { float x[2][8], y0[2][8], y1[2][8]; float ss = 0.f;
#pragma unroll
        for (int j = 0; j < 2; ++j) { const int o = lane * 8 + 512 * j; ld8bf(XR + (size_t)n * DM + o, x[j]); ld8bf(Y + (size_t)(2 * n) * DM + o, y0[j]); ld8bf(Y + (size_t)(2 * n + 1) * DM + o, y1[j]); }
#pragma unroll
        for (int j = 0; j < 2; ++j)
#pragma unroll
            for (int i = 0; i < 8; ++i) { x[j][i] = x[j][i] + y0[j][i] + y1[j][i]; ss += x[j][i] * x[j][i]; }
        const float rs = rsqrtf(wave_sum(ss) * (1.f / DM) + 1e-6f);
#pragma unroll
        for (int j = 0; j < 2; ++j) { const int o = lane * 8 + 512 * j; const float4 g0 = *(const float4*)(gain + o), g1 = *(const float4*)(gain + o + 4);
            *(float4*)(out + (size_t)n * DM + o) = make_float4(x[j][0] * rs * g0.x, x[j][1] * rs * g0.y, x[j][2] * rs * g0.z, x[j][3] * rs * g0.w);
            *(float4*)(out + (size_t)n * DM + o + 4) = make_float4(x[j][4] * rs * g1.x, x[j][5] * rs * g1.y, x[j][6] * rs * g1.z, x[j][7] * rs * g1.w); } }
}
__device__ __forceinline__ void ph_route(const Args& a, int Lyr, const bf16_t* XR, bf16_t* HN, float* RS, unsigned* cnt, int* asg_e, int* asg_rank, float* asg_gate, LAS float* lds) {
    const float* gain = a.in[2] + Lyr * DM; const float* bg = a.in[29] + Lyr * 4; const float* be = a.in[31] + Lyr * 32;
    const bf16_t* FRh = (const bf16_t*)(a.ws + FG_RT) + (size_t)Lyr * 2 * 49152; const bf16_t* FRl = FRh + 49152;
    const int lane = threadIdx.x & 63, wave = threadIdx.x >> 6, q4 = lane >> 4, c16 = lane & 15, r4 = lane >> 4, cidx = lane & 15;
    LAS unsigned char* Lb = (LAS unsigned char*)lds;
    LAS unsigned char* W = Lb + wave * 12288;
    LAS float* SS = (LAS float*)(W + 8704); LAS float* LG = (LAS float*)(W + 8768);
    LAS unsigned* lcnt = (LAS unsigned*)(Lb + 8 * 12288); LAS unsigned* lbase = lcnt + 32;
    const int NGW = gridDim.x * 8, gw = blockIdx.x * 8 + wave;
    for (int rnd = 0; rnd * NGW < NTOK / 16; ++rnd) {
        const int tile = rnd * NGW + gw; const bool act = tile < NTOK / 16; const int n0 = tile * 16;
        if (threadIdx.x < 32) lcnt[threadIdx.x] = 0u;
        __syncthreads();
        int e0 = 0, e1 = 0, lr0 = 0, lr1 = 0; float g0 = 0.f, g1 = 0.f;
        if (act) {
            f32x4 acc[3], accs = (f32x4){0.f, 0.f, 0.f, 0.f};
#pragma unroll
            for (int ct = 0; ct < 3; ++ct) acc[ct] = accs;
#pragma unroll 1
            for (int kc = 0; kc < 8; ++kc) {
                bf16x8_t bh[4][3], bl[4][3];
#pragma unroll
                for (int ks = 0; ks < 4; ++ks)
#pragma unroll
                    for (int ct = 0; ct < 3; ++ct) { const size_t o = ((size_t)((kc * 4 + ks) * 3 + ct) * 64 + lane) * 8; bh[ks][ct] = *(const bf16x8_t*)(FRh + o); bl[ks][ct] = *(const bf16x8_t*)(FRl + o); }
                u32x4_t xv[4];
#pragma unroll
                for (int j = 0; j < 4; ++j) xv[j] = *(const u32x4_t*)(XR + (size_t)(n0 + 4 * j + r4) * DM + kc * 128 + 8 * cidx);
                __builtin_amdgcn_sched_barrier(0);
#pragma unroll
                for (int j = 0; j < 4; ++j) *(LAS u32x4_t*)(W + (4 * j + r4) * 272 + cidx * 16) = xv[j];
#pragma unroll
                for (int ks = 0; ks < 4; ++ks) { const bf16x8_t ahi = *(const LAS bf16x8_t*)(W + c16 * 272 + ks * 64 + q4 * 16);
                    accs = __builtin_amdgcn_mfma_f32_16x16x32_bf16(ahi, ahi, accs, 0, 0, 0);
#pragma unroll
                    for (int ct = 0; ct < 3; ++ct) { acc[ct] = __builtin_amdgcn_mfma_f32_16x16x32_bf16(ahi, bh[ks][ct], acc[ct], 0, 0, 0); acc[ct] = __builtin_amdgcn_mfma_f32_16x16x32_bf16(ahi, bl[ks][ct], acc[ct], 0, 0, 0); } }
            }
#pragma unroll
            for (int r = 0; r < 4; ++r) if (c16 == 4 * q4 + r) { const float rsv = rsqrtf(accs[r] * (1.f / DM) + 1e-6f); SS[c16] = rsv; RS[n0 + c16] = rsv; }
            const f32x4 s4 = *(const LAS f32x4*)(SS + 4 * q4);
#pragma unroll
            for (int ct = 0; ct < 3; ++ct) { const int col = 16 * ct + c16; const float bias = col < 4 ? bg[col] : (col < 36 ? be[col - 4] : 0.f);
#pragma unroll
                for (int r = 0; r < 4; ++r) LG[(4 * q4 + r) * 48 + col] = acc[ct][r] * s4[r] + bias; }
            if (lane < 16) {
                const LAS float* lg = LG + lane * 48;
                int gs = 0; float gm = lg[0];
#pragma unroll
                for (int i = 1; i < 4; ++i) { const float v = lg[i]; if (v > gm) { gm = v; gs = i; } }
                float gden = 0.f;
#pragma unroll
                for (int i = 0; i < 4; ++i) gden += __expf(lg[i] - gm);
                const float ggate = 1.f / gden;
                const LAS float* l8 = lg + 4 + gs * 8;
                int i0 = 0; float m0 = l8[0];
#pragma unroll
                for (int i = 1; i < 8; ++i) { const float v = l8[i]; if (v > m0) { m0 = v; i0 = i; } }
                int i1 = (i0 == 0) ? 1 : 0; float m1 = l8[i1];
#pragma unroll
                for (int i = 0; i < 8; ++i) { const float v = l8[i]; if (i != i0 && v > m1) { m1 = v; i1 = i; } }
                const float ex = __expf(m1 - m0);
                g0 = ggate / (1.f + ex); g1 = ggate * ex / (1.f + ex);
                e0 = gs * 8 + i0; e1 = gs * 8 + i1;
                lr0 = (int)__hip_atomic_fetch_add(lcnt + e0, 1u, __ATOMIC_RELAXED, __HIP_MEMORY_SCOPE_WORKGROUP); lr1 = (int)__hip_atomic_fetch_add(lcnt + e1, 1u, __ATOMIC_RELAXED, __HIP_MEMORY_SCOPE_WORKGROUP);
            }
        }
        __syncthreads();
        if (threadIdx.x < 32) { const unsigned c = lcnt[threadIdx.x]; lbase[threadIdx.x] = c ? atomicAdd(&cnt[threadIdx.x], c) : 0u; }
        __syncthreads();
        if (act) {
            if (lane < 16) { const int n = n0 + lane;
                asg_e[2 * n] = e0; asg_e[2 * n + 1] = e1; asg_rank[2 * n] = (int)lbase[e0] + lr0; asg_rank[2 * n + 1] = (int)lbase[e1] + lr1; asg_gate[2 * n] = g0; asg_gate[2 * n + 1] = g1; }
            unsigned char* H8 = (unsigned char*)HN;
            float rsr[4];
#pragma unroll
            for (int j = 0; j < 4; ++j) rsr[j] = SS[4 * j + r4] * ACT_Q;
#pragma unroll 2
            for (int kc = 0; kc < 8; ++kc) { const float4 gn0 = *(const float4*)(gain + kc * 128 + 8 * cidx), gn1 = *(const float4*)(gain + kc * 128 + 8 * cidx + 4);
                u32x4_t xv[4];
#pragma unroll
                for (int j = 0; j < 4; ++j) xv[j] = *(const u32x4_t*)(XR + (size_t)(n0 + 4 * j + r4) * DM + kc * 128 + 8 * cidx);
#pragma unroll
                for (int j = 0; j < 4; ++j) { const u32x4_t o = xv[j]; const float q = rsr[j];
                    *(u32x2_t*)(H8 + (size_t)(n0 + 4 * j + r4) * DM + kc * 128 + 8 * cidx) = (u32x2_t){
                        q8x4(__uint_as_float(o.x << 16) * gn0.x, __uint_as_float(o.x & 0xffff0000u) * gn0.y, __uint_as_float(o.y << 16) * gn0.z, __uint_as_float(o.y & 0xffff0000u) * gn0.w, q),
                        q8x4(__uint_as_float(o.z << 16) * gn1.x, __uint_as_float(o.z & 0xffff0000u) * gn1.y, __uint_as_float(o.w << 16) * gn1.z, __uint_as_float(o.w & 0xffff0000u) * gn1.w, q)}; } }
        }
        __syncthreads();
    }
}
__device__ __forceinline__ void moe_prefix(const unsigned* cnt, LAS int* pst) {
    if (threadIdx.x == 0) { int acc = 0; for (int e = 0; e < NEXP; ++e) { pst[e] = acc; const int c = (int)cnt[e]; acc += (c + MOE_TM - 1) / MOE_TM * MOE_TM; } pst[NEXP] = acc; }
    __syncthreads();
}
__device__ __forceinline__ void ph_dispatch(const unsigned* cnt, const int* asg_e, const int* asg_rank, const float* asg_gate, const float* RS, int* row_tok, int* row_slot, float* row_gate, float* row_rs, LAS int* pst, const unsigned* wmax, float* tscale) {
    moe_prefix(cnt, pst);
    for (int t = blockIdx.x * NTHREADS + threadIdx.x; t < pst[NEXP] / 256; t += gridDim.x * NTHREADS) { int e = 0;
        for (int k = 1; k < NEXP; ++k) if (t * 256 >= pst[k]) e = k;
        tscale[2 * t] = __uint_as_float(wmax[2 * e]) * (1.f / (127.f * ACT_Q)); tscale[2 * t + 1] = __uint_as_float(wmax[2 * e + 1]) * (1.f / (127.f * ACT_Q)); }
    for (int i = blockIdx.x * NTHREADS + threadIdx.x; i < NASG; i += gridDim.x * NTHREADS) {
        const int e = asg_e[i], d = pst[e] + asg_rank[i];
        row_tok[d] = i >> 1; row_slot[d] = i; row_gate[d] = asg_gate[i]; row_rs[d] = RS[i >> 1];
    }
    for (int e = blockIdx.x; e < NEXP; e += gridDim.x) {
        const int c = (int)cnt[e], lo = pst[e] + c, hi = pst[e + 1];
        for (int r = lo + threadIdx.x; r < hi; r += NTHREADS) { row_tok[r] = -1; row_slot[r] = 0; row_gate[r] = 0.f; row_rs[r] = 0.f; }
    }
    __syncthreads();
}
__device__ __forceinline__ int moe_tile_expert(const LAS int* pst, int row0) { int e = 0;
    for (int i = 1; i < NEXP; ++i) if (row0 >= pst[i]) e = i;
    return e; }

__device__ __forceinline__ float shiftcol(const bf16_t* P, int n, int t, int col, const float* mu) {
    const float cur = bf2f(P[(size_t)n * ABC + col]); const float prev = t > 0 ? bf2f(P[(size_t)(n - 1) * ABC + col]) : 0.f;
    return cur + (prev - cur) * mu[col];
}
constexpr int RW_WMF = 0, RW_RF = 2048, RW_BKF = 4096, RW_ARF = 8192, RW_U = 9216, RW_V = 11264, RW_G = 13312, RW_REC = 13568;
__device__ __forceinline__ float fast_sigmoid(float x) { return __builtin_amdgcn_rcpf(1.f + __expf(-x)); }
__device__ __forceinline__ float fast_softplus(float x) { return fmaxf(x, 0.f) + __logf(1.f + __expf(-fabsf(x))); }
__device__ __forceinline__ void tr_acc(LAS float* TBf, const f32x4 (&acc)[4], int lane, float (&out)[16]) {
    const int q4 = lane >> 4, c16 = lane & 15;
#pragma unroll
    for (int ct = 0; ct < 4; ++ct)
#pragma unroll
        for (int r = 0; r < 4; ++r) TBf[(16 * ct + 4 * q4 + r) * 20 + c16] = acc[ct][r];
#pragma unroll
    for (int j = 0; j < 4; ++j) { const f32x4 v = *(const LAS f32x4*)(TBf + lane * 20 + 4 * j); out[4 * j] = v[0]; out[4 * j + 1] = v[1]; out[4 * j + 2] = v[2]; out[4 * j + 3] = v[3]; }
}
__device__ __forceinline__ void ph_l0_prep(const Args& a, LAS float* lds) {
    const bf16_t* P = (const bf16_t*)(a.ws + WS_B);
    unsigned char* FR = a.ws + WS_C;
    bf16_t* Vb = (bf16_t*)a.out; float* Bon = (float*)((unsigned char*)a.out + 32 * MiB);
    bf16_t* LA = (bf16_t*)(a.ws + WS_A); bf16_t* U = LA + (size_t)NTOK * 512;
    const float* mu = a.in[5]; const float* w0 = a.in[6]; const float* a0 = a.in[8];
    const float* k_k = a.in[11]; const float* k_a = a.in[12]; const float* r_k = a.in[13];
    const float* conv_w = a.in[16]; const float* conv_b = a.in[17]; const float* b_a = a.in[19]; const float* b_x = a.in[21]; const float* lam = a.in[22];
    const int lane = threadIdx.x & 63, wave = threadIdx.x >> 6, q4 = lane >> 4, c16 = lane & 15;
    LAS unsigned char* W = (LAS unsigned char*)lds + wave * 15360;
    constexpr int KAP = 0, BT = 2304, KT = 4608, RT = 6912, BTT = 9216, KTT = 11264, AKB = 13312, AKK = 14336, RS = 144;
    constexpr int XS = 0, XS2 = 2304, TB = 4608;
    LAS float* TBf = (LAS float*)(W + TB);
    for (int u = blockIdx.x * 8 + wave; u < (NTOK / 16) * 8; u += gridDim.x * 8) {
        const int tile = u >> 3, h = u & 7, n0 = tile * 16, c = h * 64 + lane;
        const bool first = (n0 & (SEQ - 1)) == 0;
        const bf16_t* Pn = P + (size_t)n0 * ABC;
        float xb[19]; unsigned pwp[9], pap[9], qrp[9], qkp[9], qvp[9];
#pragma unroll
        for (int i = 0; i < 19; ++i) xb[i] = (first && i < 3) ? 0.f : bf2f(Pn[(long)(i - 3) * ABC + 2304 + c]);
#pragma unroll
        for (int i = 0; i < 18; ++i) { const bool z = (first && i == 0) || i == 17; const long ro = (long)(i - 1) * ABC;
            const unsigned vw = z ? 0u : (unsigned)Pn[ro + 1536 + lane], va = z ? 0u : (unsigned)Pn[ro + 1600 + lane];
            if (i & 1) { pwp[i >> 1] |= vw << 16; pap[i >> 1] |= va << 16; } else { pwp[i >> 1] = vw; pap[i >> 1] = va; } }
        asm volatile("" ::: "memory");
#define UNPK(arr, i) __uint_as_float(((i) & 1) ? ((arr)[(i) >> 1] & 0xffff0000u) : ((arr)[(i) >> 1] << 16))
        {
            bf16_t* SG = (bf16_t*)((unsigned char*)a.out + DO_SG);
#pragma unroll
            for (int i = 0; i < 4; ++i) { const int idx = lane * 4 + i, tk = idx >> 4, col = 1664 + 16 * h + (idx & 15);
                const float cur = bf2f(Pn[(long)tk * ABC + col]); const float prev = (first && tk == 0) ? 0.f : bf2f(Pn[(long)(tk - 1) * ABC + col]);
                SG[(size_t)(n0 + tk) * 128 + 16 * h + (idx & 15)] = f2bf(fast_sigmoid(cur + (prev - cur) * mu[col])); }
        }
        {
            const float cw0 = conv_w[c], cw1 = conv_w[512 + c], cw2 = conv_w[1024 + c], cw3 = conv_w[1536 + c], cb = conv_b[c];
            float xcv[16];
#pragma unroll
            for (int tk = 0; tk < 16; ++tk) { xcv[tk] = cb + cw0 * xb[tk] + cw1 * xb[tk + 1] + cw2 * xb[tk + 2] + cw3 * xb[tk + 3]; *(LAS bf16_t*)(W + XS + tk * RS + lane * 2) = f2bf(xcv[tk]); }
            f32x4 accr[4], acci[4];
            const bf16_t* FA = (const bf16_t*)(a.ws + FG_WA) + h * 4096; const bf16_t* FX = (const bf16_t*)(a.ws + FG_WX) + h * 4096;
            bf16x8_t xf[2];
#pragma unroll
            for (int ks = 0; ks < 2; ++ks) xf[ks] = *(const LAS bf16x8_t*)(W + XS + c16 * RS + ks * 64 + q4 * 16);
#pragma unroll
            for (int ct = 0; ct < 4; ++ct) { asm volatile("" ::: "memory"); accr[ct] = (f32x4){0.f, 0.f, 0.f, 0.f}; acci[ct] = accr[ct];
#pragma unroll
                for (int ks = 0; ks < 2; ++ks) { accr[ct] = __builtin_amdgcn_mfma_f32_16x16x32_bf16(*(const bf16x8_t*)(FA + ((ct * 2 + ks) * 64 + lane) * 8), xf[ks], accr[ct], 0, 0, 0);
                    acci[ct] = __builtin_amdgcn_mfma_f32_16x16x32_bf16(*(const bf16x8_t*)(FX + ((ct * 2 + ks) * 64 + lane) * 8), xf[ks], acci[ct], 0, 0, 0); } }
            float rp[16], ip[16];
            tr_acc(TBf, accr, lane, rp); tr_acc(TBf, acci, lane, ip);
            const float bac = b_a[c], bxc = b_x[c], sp = fast_softplus(-lam[c]);
            float hloc = 0.f, sla = 0.f;
#pragma unroll
            for (int tk = 0; tk < 16; ++tk) { const float r = fast_sigmoid(rp[tk] + bac), i = fast_sigmoid(ip[tk] + bxc);
                const float la = -8.f * r * sp; const float uu = __builtin_amdgcn_sqrtf(fmaxf(1.f - __expf(2.f * la), 0.f)) * i * xcv[tk];
                const bf16_t lab = f2bf(la), uub = f2bf(uu); const float lar = bf2f(lab);
                LA[(size_t)(n0 + tk) * 512 + c] = lab; U[(size_t)(n0 + tk) * 512 + c] = uub; hloc = __expf(lar) * hloc + bf2f(uub); sla += lar; }
            ((float*)((unsigned char*)a.out + DO_LRU))[(size_t)tile * 512 + c] = hloc; ((float*)((unsigned char*)a.out + DO_LRU))[(size_t)(2048 + tile) * 512 + c] = sla;
        }
        asm volatile("" ::: "memory");
#pragma unroll
        for (int i = 0; i < 18; ++i) { const bool z = (first && i == 0) || i == 17; const long ro = (long)(i - 1) * ABC;
            const unsigned vr = z ? 0u : (unsigned)Pn[ro + c], vk = z ? 0u : (unsigned)Pn[ro + 512 + c], vv = z ? 0u : (unsigned)Pn[ro + 1024 + c];
            if (i & 1) { qrp[i >> 1] |= vr << 16; qkp[i >> 1] |= vk << 16; qvp[i >> 1] |= vv << 16; } else { qrp[i >> 1] = vr; qkp[i >> 1] = vk; qvp[i >> 1] = vv; } }
        asm volatile("" ::: "memory");
        float wpre[16], apre[16];
        {
            const float muw = mu[1536 + lane], mua = mu[1600 + lane];
#pragma unroll
            for (int tk = 0; tk < 16; ++tk) { const float pw1 = UNPK(pwp, tk + 1), pw0 = UNPK(pwp, tk), pa1 = UNPK(pap, tk + 1), pa0 = UNPK(pap, tk);
                const float wl = pw1 + (pw0 - pw1) * muw, al = pa1 + (pa0 - pa1) * mua;
                const float th = 1.f - 2.f * __builtin_amdgcn_rcpf(1.f + __expf(2.f * wl));
                *(LAS bf16_t*)(W + XS + tk * RS + lane * 2) = f2bf(th); *(LAS bf16_t*)(W + XS2 + tk * RS + lane * 2) = f2bf(al); }
            f32x4 accw[4], acca[4];
            const bf16_t* F2 = (const bf16_t*)(a.ws + FG_W2) + h * 4096; const bf16_t* FA2 = (const bf16_t*)(a.ws + FG_A2) + h * 4096;
            bf16x8_t wf[2], af[2];
#pragma unroll
            for (int ks = 0; ks < 2; ++ks) { wf[ks] = *(const LAS bf16x8_t*)(W + XS + c16 * RS + ks * 64 + q4 * 16); af[ks] = *(const LAS bf16x8_t*)(W + XS2 + c16 * RS + ks * 64 + q4 * 16); }
#pragma unroll
            for (int ct = 0; ct < 4; ++ct) { asm volatile("" ::: "memory"); accw[ct] = (f32x4){0.f, 0.f, 0.f, 0.f}; acca[ct] = accw[ct];
#pragma unroll
                for (int ks = 0; ks < 2; ++ks) { accw[ct] = __builtin_amdgcn_mfma_f32_16x16x32_bf16(*(const bf16x8_t*)(F2 + ((ct * 2 + ks) * 64 + lane) * 8), wf[ks], accw[ct], 0, 0, 0);
                    acca[ct] = __builtin_amdgcn_mfma_f32_16x16x32_bf16(*(const bf16x8_t*)(FA2 + ((ct * 2 + ks) * 64 + lane) * 8), af[ks], acca[ct], 0, 0, 0); } }
            tr_acc(TBf, accw, lane, wpre); tr_acc(TBf, acca, lane, apre);
        }
        const float w0c = w0[c], a0c = a0[c], kkc = k_k[c], kac = k_a[c], rkc = r_k[c];
        const float mur = mu[c], muk = mu[512 + c], muv = mu[1024 + c];
        unsigned char* rec = FR + ((size_t)tile * 8 + h) * RW_REC;
        float vsv[16];
        unsigned btp[8], ktp[8];
        float cum = 0.f, gC = 1.f;
#pragma unroll
        for (int tk = 0; tk < 16; ++tk) { const int n = n0 + tk;
            const float cr = UNPK(qrp, tk + 1), ck = UNPK(qkp, tk + 1), cv = UNPK(qvp, tk + 1), pr = UNPK(qrp, tk), pk = UNPK(qkp, tk), pv = UNPK(qvp, tk);
            const float rs = cr + (pr - cr) * mur, ks = ck + (pk - ck) * muk, vs = cv + (pv - cv) * muv;
            const float wv = -fast_softplus(-(w0c + wpre[tk])) - 0.5f; const float logdec = -__expf(wv);
            const float av = fast_sigmoid(a0c + apre[tk]);
            const float kkr = ks * kkc; const float ss = wave_sum(kkr * kkr); const float kkn = kkr * rsqrtf(fmaxf(ss, 1e-24f));
            const float kp = ks * (1.f + (av - 1.f) * kac);
            const float bsum = wave_sum(rs * kp * rkc);
            if (lane == 0) Bon[(size_t)n * 8 + h] = bsum;
            Vb[(size_t)n * 512 + c] = f2bf(vs); vsv[tk] = vs;
            const float gprev = __expf(cum); cum += logdec; const float g = __expf(cum), gi = __builtin_amdgcn_rcpf(g); gC = g;
            const float kapv = kkn * gprev, btv = av * kkn * gi, ktv = kp * gi, rtv = rs * g;
            const bf16_t kb = f2bf(kapv), bb = f2bf(btv), kb2 = f2bf(ktv), rb = f2bf(rtv);
            *(LAS bf16_t*)(W + KAP + tk * RS + lane * 2) = kb; *(LAS bf16_t*)(W + BT + tk * RS + lane * 2) = bb;
            *(LAS bf16_t*)(W + KT + tk * RS + lane * 2) = kb2; *(LAS bf16_t*)(W + RT + tk * RS + lane * 2) = rb;
            if (tk & 1) { btp[tk >> 1] |= (unsigned)bb << 16; ktp[tk >> 1] |= (unsigned)kb2 << 16; } else { btp[tk >> 1] = bb; ktp[tk >> 1] = kb2; } }
        *(LAS u32x4_t*)(W + BTT + lane * 32) = (u32x4_t){btp[0], btp[1], btp[2], btp[3]}; *(LAS u32x4_t*)(W + BTT + lane * 32 + 16) = (u32x4_t){btp[4], btp[5], btp[6], btp[7]};
        *(LAS u32x4_t*)(W + KTT + lane * 32) = (u32x4_t){ktp[0], ktp[1], ktp[2], ktp[3]}; *(LAS u32x4_t*)(W + KTT + lane * 32 + 16) = (u32x4_t){ktp[4], ktp[5], ktp[6], ktp[7]};
        *(float*)(rec + RW_G + lane * 4) = gC;
        f32x4 akb = (f32x4){0.f, 0.f, 0.f, 0.f}, akk = akb, arbT = akb, arkT = akb;
#pragma unroll
        for (int ks = 0; ks < 2; ++ks) { const int fo = c16 * RS + ks * 64 + q4 * 16;
            const bf16x8_t fkap = *(const LAS bf16x8_t*)(W + KAP + fo), fbt = *(const LAS bf16x8_t*)(W + BT + fo), fkt = *(const LAS bf16x8_t*)(W + KT + fo), frt = *(const LAS bf16x8_t*)(W + RT + fo);
            akb = __builtin_amdgcn_mfma_f32_16x16x32_bf16(fkap, fbt, akb, 0, 0, 0); akk = __builtin_amdgcn_mfma_f32_16x16x32_bf16(fkap, fkt, akk, 0, 0, 0);
            arbT = __builtin_amdgcn_mfma_f32_16x16x32_bf16(fbt, frt, arbT, 0, 0, 0); arkT = __builtin_amdgcn_mfma_f32_16x16x32_bf16(fkt, frt, arkT, 0, 0, 0); }
#pragma unroll
        for (int r = 0; r < 4; ++r) { const int t = 4 * q4 + r; ((LAS float*)(W + AKB))[t * 16 + c16] = (c16 < t) ? akb[r] : 0.f; ((LAS float*)(W + AKK))[t * 16 + c16] = (c16 < t) ? akk[r] : 0.f;
            const int sidx = 4 * q4 + r; if (sidx > c16) { arbT[r] = 0.f; arkT[r] = 0.f; } }
        *(u32x4_t*)(rec + RW_ARF + lane * 16) = (u32x4_t){pk2(arbT[0], arbT[1]), pk2(arbT[2], arbT[3]), pk2(arkT[0], arkT[1]), pk2(arkT[2], arkT[3])};
#pragma unroll
        for (int i = 0; i < 4; ++i) { const u32x2_t b2 = *(const LAS u32x2_t*)(W + BTT + (16 * i + c16) * 32 + q4 * 8), k2 = *(const LAS u32x2_t*)(W + KTT + (16 * i + c16) * 32 + q4 * 8);
            *(u32x4_t*)(rec + RW_BKF + i * 1024 + lane * 16) = (u32x4_t){b2.x, b2.y, k2.x, k2.y}; }
#pragma unroll
        for (int sx = 0; sx < 2; ++sx) { const u32x2_t lo = *(const LAS u32x2_t*)(W + RT + c16 * RS + (32 * sx + 4 * q4) * 2), hi = *(const LAS u32x2_t*)(W + RT + c16 * RS + (32 * sx + 16 + 4 * q4) * 2);
            *(u32x4_t*)(rec + RW_RF + sx * 1024 + lane * 16) = (u32x4_t){lo.x, lo.y, hi.x, hi.y}; }
        float Wm[16], Uu[16];
#pragma unroll
        for (int t = 0; t < 16; ++t) { float wacc = bf2f(*(const LAS bf16_t*)(W + KAP + t * RS + lane * 2)), uacc = 0.f;
#pragma unroll
            for (int s4 = 0; s4 < 4; ++s4) if (4 * s4 < t) { const f32x4 b4 = *(const LAS f32x4*)(W + AKB + (t * 16 + 4 * s4) * 4), k4 = *(const LAS f32x4*)(W + AKK + (t * 16 + 4 * s4) * 4);
#pragma unroll
                for (int e = 0; e < 4; ++e) { const int sidx = 4 * s4 + e; if (sidx < t) { wacc -= b4[e] * Wm[sidx]; uacc += k4[e] * vsv[sidx] - b4[e] * Uu[sidx]; } } }
            Wm[t] = wacc; Uu[t] = uacc;
            *(LAS bf16_t*)(W + KAP + t * RS + lane * 2) = f2bf(wacc);
        }
        {
            const int ub = ((lane >> 4) * 64 + (lane & 15)) * 8;
#pragma unroll
            for (int q = 0; q < 4; ++q) { *(u32x2_t*)(rec + RW_U + ub + q * 128) = (u32x2_t){pk2(Uu[4 * q], Uu[4 * q + 1]), pk2(Uu[4 * q + 2], Uu[4 * q + 3])};
                *(u32x2_t*)(rec + RW_V + ub + q * 128) = (u32x2_t){pk2(vsv[4 * q], vsv[4 * q + 1]), pk2(vsv[4 * q + 2], vsv[4 * q + 3])}; }
        }
#pragma unroll
        for (int sx = 0; sx < 2; ++sx) { const u32x2_t lo = *(const LAS u32x2_t*)(W + KAP + c16 * RS + (32 * sx + 4 * q4) * 2), hi = *(const LAS u32x2_t*)(W + KAP + c16 * RS + (32 * sx + 16 + 4 * q4) * 2);
            *(u32x4_t*)(rec + RW_WMF + sx * 1024 + lane * 16) = (u32x4_t){lo.x, lo.y, hi.x, hi.y}; }
    }
}
__device__ __forceinline__ void sub_barrier(unsigned* ctr, unsigned target) {
    asm volatile("s_waitcnt vmcnt(0)" ::: "memory");
    __syncthreads();
    if (threadIdx.x == 0) {
        (void)xb_add(ctr, 1u);
        unsigned sp = 0;
        while (xb_ld(ctr) < target) { __builtin_amdgcn_s_sleep(2); if (++sp > (1u << 22)) break; }
        __builtin_amdgcn_fence(__ATOMIC_ACQUIRE, "agent");
        asm volatile("s_waitcnt vmcnt(0)" ::: "memory");
    }
    __syncthreads();
}
__device__ __forceinline__ void st_wt(float* p, float v) { __hip_atomic_store((unsigned*)p, __float_as_uint(v), __ATOMIC_RELAXED, __HIP_MEMORY_SCOPE_AGENT); }
__device__ __forceinline__ void ph_lru_b(const Args& a, int bid, LAS float* lds) {
    if (bid >= 64) return;
    const float* CH = (const float*)((unsigned char*)a.out + DO_LRU); const float* CA = CH + (size_t)2048 * 512; float* CIN = (float*)((unsigned char*)a.out + DO_LRU) + (size_t)4096 * 512;
    const int b = bid >> 4, cg = bid & 15, cl = threadIdx.x & 31, seg = threadIdx.x >> 5, c = cg * 32 + cl;
    float ca[32], chv[32];
#pragma unroll
    for (int i = 0; i < 32; ++i) { const size_t o = (size_t)(b * 512 + seg * 32 + i) * 512 + c; ca[i] = CA[o]; chv[i] = CH[o]; }
    float h = 0.f, sa = 0.f;
#pragma unroll
    for (int i = 0; i < 32; ++i) { h = __expf(ca[i]) * h + chv[i]; sa += ca[i]; }
    lds[seg * 32 + cl] = sa; lds[512 + seg * 32 + cl] = h;
    __syncthreads();
    float hin = 0.f;
    for (int sg = 0; sg < seg; ++sg) hin = __expf(lds[sg * 32 + cl]) * hin + lds[512 + sg * 32 + cl];
    h = hin;
#pragma unroll
    for (int i = 0; i < 32; ++i) { st_wt(CIN + (size_t)(b * 512 + seg * 32 + i) * 512 + c, h); h = __expf(ca[i]) * h + chv[i]; }
}
__device__ __forceinline__ void ph_lru_c(const Args& a, int bid, int nblk) {
    const bf16_t* LA = (const bf16_t*)(a.ws + WS_A); const bf16_t* U = LA + (size_t)NTOK * 512; const bf16_t* P = (const bf16_t*)(a.ws + WS_B);
    const float* CIN = (const float*)((unsigned char*)a.out + DO_LRU) + (size_t)4096 * 512; bf16_t* MIX = (bf16_t*)(a.ws + WS_D);
    const int c = threadIdx.x;
    for (int u = bid; u < NTOK / 16; u += nblk) { float la[16], uv[16], gt[16];
        float h = CIN[(size_t)u * 512 + c];
#pragma unroll
        for (int s = 0; s < 16; ++s) { const int n = u * 16 + s; const size_t o = (size_t)n * 512 + c; la[s] = bf2f(LA[o]); uv[s] = bf2f(U[o]); gt[s] = bf2f(P[(size_t)n * ABC + 1792 + c]); }
#pragma unroll
        for (int s = 0; s < 16; ++s) { const int n = u * 16 + s; h = __expf(la[s]) * h + uv[s];
            const float x = gt[s], t2 = 0.7978845608028654f * (x + 0.044715f * x * x * x); const float th = 1.f - 2.f * __builtin_amdgcn_rcpf(1.f + __expf(2.f * t2));
            MIX[(size_t)n * DM + 512 + c] = f2bf(h * 0.5f * x * (1.f + th)); } }
}
__device__ __forceinline__ void ph_rwkv_scan(const Args& a, LAS unsigned char* L) {
    if (blockIdx.x >= 32) return;
    constexpr int SLOT = 9472, GOFF = 9216, NS = 14, NCH = SEQ / 16; constexpr size_t CSTR = (size_t)8 * RW_REC;
    const unsigned char* FR = a.ws + WS_C; float* Yr = (float*)((unsigned char*)a.out + DO_YR);
    const int b = blockIdx.x >> 3, h = blockIdx.x & 7, lane = threadIdx.x & 63, wave = __builtin_amdgcn_readfirstlane(threadIdx.x >> 6), q4 = lane >> 4, c16 = lane & 15;
    const unsigned char* FRb = FR + ((size_t)(b * NCH) * 8 + h) * RW_REC;
#define RW_BARRIER() do { asm volatile("" ::: "memory"); __builtin_amdgcn_s_barrier(); asm volatile("" ::: "memory"); } while (0)
    if (wave >= 4) {
        const int lw = wave - 4;
        const unsigned char* rp = FRb + lane * 16; int so = 0;
#define RW_ISSUE() do { LAS unsigned char* _slot = L + so; \
            if (lw < 2) { _Pragma("unroll") for (int _j = 0; _j < 3; ++_j) __builtin_amdgcn_global_load_lds((const unsigned*)(rp + (lw * 3 + _j) * 1024), (LAS unsigned*)(_slot + (lw * 3 + _j) * 1024), 16, 0, 0); } \
            else if (lw == 2) { _Pragma("unroll") for (int _j = 0; _j < 2; ++_j) __builtin_amdgcn_global_load_lds((const unsigned*)(rp + (6 + _j) * 1024), (LAS unsigned*)(_slot + (6 + _j) * 1024), 16, 0, 0); } \
            else { __builtin_amdgcn_global_load_lds((const unsigned*)(rp + 8 * 1024), (LAS unsigned*)(_slot + 8 * 1024), 16, 0, 0); \
                   __builtin_amdgcn_global_load_lds((const unsigned*)(rp - lane * 12 + RW_G), (LAS unsigned*)(_slot + GOFF), 4, 0, 0); } \
            rp += CSTR; so += SLOT; if (so == NS * SLOT) so = 0; } while (0)
#define RW_LWAIT() do { if (lw < 2) asm volatile("s_waitcnt vmcnt(27)" ::: "memory"); else asm volatile("s_waitcnt vmcnt(18)" ::: "memory"); } while (0)
        for (int p = 0; p < NS - 2; ++p) RW_ISSUE();
        RW_LWAIT();
        RW_BARRIER();
#pragma unroll 1
        for (int it = 0; it < NCH / 2; ++it) { RW_ISSUE(); RW_ISSUE(); RW_LWAIT(); RW_BARRIER(); }
        asm volatile("s_waitcnt vmcnt(0)" ::: "memory");
#undef RW_ISSUE
#undef RW_LWAIT
    } else {
        const int vs = wave;
        f32x4 T[4];
#pragma unroll
        for (int i = 0; i < 4; ++i) T[i] = (f32x4){0.f, 0.f, 0.f, 0.f};
        struct Ops { bf16x8_t wmf[2], rf[2], bkf[4], arf; f32x4 g4[4]; };
        const LAS unsigned char* lp = L + lane * 16; const LAS unsigned char* lg = L + GOFF + q4 * 16; int so = 0;
        const unsigned char* up = FRb + RW_U + (vs * 64 + lane) * 8;
        float* yp = Yr + (size_t)(b * SEQ + 4 * q4) * 512 + h * 64 + 16 * vs + c16;
#define RW_LOAD(O) do { const LAS unsigned char* _r = lp + so; const LAS unsigned char* _g = lg + so; \
            _Pragma("unroll") for (int _s = 0; _s < 2; ++_s) { O.wmf[_s] = *(const LAS bf16x8_t*)(_r + RW_WMF + _s * 1024); O.rf[_s] = *(const LAS bf16x8_t*)(_r + RW_RF + _s * 1024); } \
            _Pragma("unroll") for (int _i = 0; _i < 4; ++_i) O.bkf[_i] = *(const LAS bf16x8_t*)(_r + RW_BKF + _i * 1024); \
            O.arf = *(const LAS bf16x8_t*)(_r + RW_ARF); \
            _Pragma("unroll") for (int _i = 0; _i < 4; ++_i) O.g4[_i] = *(const LAS f32x4*)(_g + _i * 64); \
            so += SLOT; if (so == NS * SLOT) so = 0; \
            __builtin_amdgcn_sched_barrier(0); } while (0)
#define RW_UV(dst) do { dst[0] = *(const u32x2_t*)up; dst[1] = *(const u32x2_t*)(up + 2048); up += CSTR; } while (0)
#define RW_STEP(O, uv) do { \
            bf16x8_t _bS[2]; \
            _Pragma("unroll") for (int _s = 0; _s < 2; ++_s) { const u32x4_t _pk = (u32x4_t){pk2(T[2 * _s][0], T[2 * _s][1]), pk2(T[2 * _s][2], T[2 * _s][3]), pk2(T[2 * _s + 1][0], T[2 * _s + 1][1]), pk2(T[2 * _s + 1][2], T[2 * _s + 1][3])}; \
                _bS[_s] = __builtin_bit_cast(bf16x8_t, _pk); } \
            f32x4 _z = (f32x4){__uint_as_float(uv[0].x << 16), __uint_as_float(uv[0].x & 0xffff0000u), __uint_as_float(uv[0].y << 16), __uint_as_float(uv[0].y & 0xffff0000u)}; \
            _z = __builtin_amdgcn_mfma_f32_16x16x32_bf16(O.wmf[0], _bS[0], _z, 0, 0, 0); _z = __builtin_amdgcn_mfma_f32_16x16x32_bf16(O.wmf[1], _bS[1], _z, 0, 0, 0); \
            f32x4 _y = (f32x4){0.f, 0.f, 0.f, 0.f}; \
            _y = __builtin_amdgcn_mfma_f32_16x16x32_bf16(O.rf[0], _bS[0], _y, 0, 0, 0); _y = __builtin_amdgcn_mfma_f32_16x16x32_bf16(O.rf[1], _bS[1], _y, 0, 0, 0); \
            const u32x4_t _zvp = (u32x4_t){pk2(-_z[0], -_z[1]), pk2(-_z[2], -_z[3]), uv[1].x, uv[1].y}; \
            const bf16x8_t _bZV = __builtin_bit_cast(bf16x8_t, _zvp); \
            _Pragma("unroll") for (int _i = 0; _i < 4; ++_i) { T[_i] = __builtin_amdgcn_mfma_f32_16x16x32_bf16(O.bkf[_i], _bZV, T[_i], 0, 0, 0); T[_i] = T[_i] * O.g4[_i]; } \
            _y = __builtin_amdgcn_mfma_f32_16x16x32_bf16(O.arf, _bZV, _y, 0, 0, 0); \
            yp[0] = _y[0]; yp[512] = _y[1]; yp[1024] = _y[2]; yp[1536] = _y[3]; yp += 16 * 512; } while (0)
#define RW_SYNC() do { asm volatile("s_waitcnt lgkmcnt(0)" ::: "memory"); RW_BARRIER(); } while (0)
        Ops A, B;
        u32x2_t uv0[2], uv1[2], uv2[2], uv3[2];
        RW_UV(uv0); RW_UV(uv1); RW_UV(uv2); RW_UV(uv3);
        RW_BARRIER();
        RW_LOAD(A);
#pragma unroll 1
        for (int ch = 0; ch < NCH; ch += 4) {
            RW_LOAD(B); RW_STEP(A, uv0); RW_UV(uv0);
            RW_LOAD(A); RW_STEP(B, uv1); RW_UV(uv1); RW_SYNC();
            RW_LOAD(B); RW_STEP(A, uv2); RW_UV(uv2);
            RW_LOAD(A); RW_STEP(B, uv3); RW_UV(uv3); RW_SYNC(); }
#undef RW_SYNC
#undef RW_LOAD
#undef RW_STEP
#undef RW_UV
    }
#undef RW_BARRIER
}
__device__ __forceinline__ void ph_rwkv_post(const Args& a, LAS float* lds) {
    const bf16_t* V = (const bf16_t*)a.out; const float* Bon = (const float*)((const unsigned char*)a.out + DO_BON); const bf16_t* SG = (const bf16_t*)((const unsigned char*)a.out + DO_SG);
    const float* Yr = (const float*)((const unsigned char*)a.out + DO_YR); bf16_t* MIX = (bf16_t*)(a.ws + WS_D);
    const float* ln_w = a.in[14]; const float* ln_b = a.in[15];
    LAS unsigned char* L = (LAS unsigned char*)lds;
    const int c = threadIdx.x, lane = c & 63, h = c >> 6, q4 = lane >> 4, c16 = lane & 15;
    const bf16_t* FG = (const bf16_t*)(a.ws + FG_G2) + h * 8192;
    for (int tile = blockIdx.x; tile < NTOK / 16; tile += gridDim.x) {
        const int n0 = tile * 16;
        __syncthreads();
        { const int tk = c >> 5, j4 = (c & 31) * 4; *(LAS u32x2_t*)(L + tk * 272 + j4 * 2) = *(const u32x2_t*)(SG + (size_t)(n0 + tk) * 128 + j4); }
        __syncthreads();
        const int n = n0 + c16;
        f32x4 g[4], y[4];
#pragma unroll
        for (int ct = 0; ct < 4; ++ct) { g[ct] = (f32x4){0.f, 0.f, 0.f, 0.f};
#pragma unroll
            for (int ks = 0; ks < 4; ++ks) { const bf16x8_t af = *(const bf16x8_t*)(FG + ((size_t)(ct * 4 + ks) * 64 + lane) * 8); const bf16x8_t bfr = *(const LAS bf16x8_t*)(L + c16 * 272 + ks * 64 + q4 * 16);
                g[ct] = __builtin_amdgcn_mfma_f32_16x16x32_bf16(af, bfr, g[ct], 0, 0, 0); }
            y[ct] = *(const f32x4*)(Yr + (size_t)n * 512 + 64 * h + 16 * ct + 4 * q4); }
        float sm = 0.f;
#pragma unroll
        for (int ct = 0; ct < 4; ++ct) sm += (y[ct][0] + y[ct][1]) + (y[ct][2] + y[ct][3]);
        sm = xrow16_sum(sm);
        const float mean = sm * (1.f / 64.f);
        float sv = 0.f;
#pragma unroll
        for (int ct = 0; ct < 4; ++ct) { y[ct] = y[ct] - mean; sv += (y[ct][0] * y[ct][0] + y[ct][1] * y[ct][1]) + (y[ct][2] * y[ct][2] + y[ct][3] * y[ct][3]); }
        sv = xrow16_sum(sv);
        const float rstd = rsqrtf(sv * (1.f / 64.f) + 64e-5f), bsc = Bon[(size_t)n * 8 + h];
#pragma unroll
        for (int ct = 0; ct < 4; ++ct) { const int ch = 64 * h + 16 * ct + 4 * q4;
            const f32x4 lw = *(const f32x4*)(ln_w + ch), lb = *(const f32x4*)(ln_b + ch);
            const u32x2_t vv = *(const u32x2_t*)(V + (size_t)n * 512 + ch);
            const float v0 = __uint_as_float(vv.x << 16), v1 = __uint_as_float(vv.x & 0xffff0000u), v2 = __uint_as_float(vv.y << 16), v3 = __uint_as_float(vv.y & 0xffff0000u);
            const float o0 = (y[ct][0] * rstd * lw[0] + lb[0] + bsc * v0) * g[ct][0], o1 = (y[ct][1] * rstd * lw[1] + lb[1] + bsc * v1) * g[ct][1];
            const float o2 = (y[ct][2] * rstd * lw[2] + lb[2] + bsc * v2) * g[ct][2], o3 = (y[ct][3] * rstd * lw[3] + lb[3] + bsc * v3) * g[ct][3];
            *(u32x2_t*)(MIX + (size_t)n * DM + ch) = (u32x2_t){pk2(o0, o1), pk2(o2, o3)}; }
    }
}

namespace gla {
typedef short bf16x8 __attribute__((ext_vector_type(8)));
typedef float f32x16 __attribute__((ext_vector_type(16)));
typedef unsigned u32x4 __attribute__((ext_vector_type(4)));
typedef unsigned u32x2 __attribute__((ext_vector_type(2)));
constexpr int QH_OFF = 0, KH_OFF = 17408, KT_OFF = 34816, VT_OFF = 53248, ST_OFF = 71680, AM_OFF = 106496, EB_OFF = 115712, ER_OFF = 116224, PS_OFF = 116736, SSQ_OFF = 118784;
constexpr int QS = 272, TS = 144;
#define GLA_BAR() do { asm volatile("s_waitcnt lgkmcnt(0)" ::: "memory"); __builtin_amdgcn_s_barrier(); asm volatile("" ::: "memory"); } while (0)
template <bool OUT>
__device__ __forceinline__ void unit(const Args& a, LAS unsigned char* L, int u) {
    const int tid = threadIdx.x, lane = tid & 63, w = tid >> 6;
    const int b = u >> 6, h = (u >> 3) & 7, j = u & 7;
    const bf16_t* Q = (const bf16_t*)(a.ws + WS_QFIG) + ((size_t)b * SEQ + (size_t)j * 1024) * 4096 + h * 128;
    float* Lb = (float*)(a.ws + WS_O); float* Db = Lb + (size_t)256 * 16384;
    const int dk = tid & 127, tg = tid >> 7;
    const float c0 = a.in[25][h * 128 + dk], c1 = a.in[25][1024 + h * 128 + dk];
    const float lbv = __builtin_amdgcn_rcpf(1.f + __expf(c0 - c1)), omlb = 1.f - lbv;
    LAS float* PS = (LAS float*)(L + PS_OFF); LAS float* EB = (LAS float*)(L + EB_OFF); LAS float* ER = (LAS float*)(L + ER_OFF); LAS float* SSQ = (LAS float*)(L + SSQ_OFF);
    const int si = w >> 1, sj0 = (w & 1) * 2, l31 = lane & 31, l5 = lane >> 5;
    const int ri = w >> 2, cj = w & 3, odv = 32 * cj + l31;
    f32x16 S[2];
#pragma unroll
    for (int jj = 0; jj < 2; ++jj)
#pragma unroll
        for (int r = 0; r < 16; ++r) S[jj][r] = 0.f;
    if (OUT) {
#pragma unroll 1
        for (int i = 0; i < j; ++i) { const int ui = u - j + i;
#pragma unroll
            for (int jj = 0; jj < 2; ++jj)
#pragma unroll
                for (int rg = 0; rg < 4; ++rg) { const int sdk0 = 32 * si + 8 * rg + 4 * l5, sdv = 32 * (sj0 + jj) + l31; const f32x4 dd = *(const f32x4*)(Db + ui * 128 + sdk0);
#pragma unroll
                    for (int e = 0; e < 4; ++e) S[jj][4 * rg + e] = dd[e] * S[jj][4 * rg + e] + Lb[(size_t)ui * 16384 + (sdk0 + e) * 128 + sdv]; } } }
    float dsum = 1.f;
    const int prow = tid >> 4, ppc = tid & 15;
    u32x4 pf[2], pv[2], pq[2];
#define GLA_PREFETCH(cx) do { const bf16_t* _q = Q + (size_t)((cx) * 64 + prow) * 4096 + ppc * 8; \
        _Pragma("unroll") for (int _r = 0; _r < 2; ++_r) { pf[_r] = *(const u32x4*)(_q + (size_t)_r * 32 * 4096 + 1024); pv[_r] = *(const u32x4*)(_q + (size_t)_r * 32 * 4096 + 2048); if (OUT) pq[_r] = *(const u32x4*)(_q + (size_t)_r * 32 * 4096); } } while (0)
    GLA_PREFETCH(0);
#pragma unroll 1
    for (int c = 0; c < 16; ++c) {
        int cc = c; asm volatile("" : "+s"(cc));
#pragma unroll
        for (int r = 0; r < 2; ++r) { *(LAS u32x4*)(L + KH_OFF + (prow + 32 * r) * QS + ppc * 16) = pf[r]; *(LAS u32x4*)(L + ST_OFF + (prow + 32 * r) * QS + ppc * 16) = pv[r];
            if (OUT) *(LAS u32x4*)(L + QH_OFF + (prow + 32 * r) * QS + ppc * 16) = pq[r]; }
        if (c + 1 < 16) GLA_PREFETCH(cc + 1);
        unsigned gp[8];
        if (OUT) { const bf16_t* G = Q + (size_t)(cc * 64) * 4096 + 3072;
            unsigned go = (unsigned)((32 * ri + 4 * l5) * 4096 + odv); asm volatile("" : "+v"(go));
#pragma unroll
            for (int r = 0; r < 16; r += 2) { const unsigned t0 = (unsigned)(((r & 3) + 8 * (r >> 2)) * 4096); gp[r >> 1] = (unsigned)G[go + t0] | ((unsigned)G[go + t0 + 4096u] << 16); } }
        GLA_BAR();
        float lf[16], kk[16];
#pragma unroll
        for (int i = 0; i < 16; ++i) { const float fv = bf2f(*(const LAS bf16_t*)(L + KH_OFF + (tg * 16 + i) * QS + dk * 2)); const float sg = __builtin_amdgcn_rcpf(1.f + __expf(-fv));
            lf[i] = lbv + omlb * sg; kk[i] = omlb * (1.f - sg); }
#pragma unroll
        for (int i = 1; i < 16; ++i) lf[i] *= lf[i - 1];
        PS[tg * 128 + dk] = lf[15];
        GLA_BAR();
        const float p0 = PS[dk], p1 = PS[128 + dk], p2 = PS[256 + dk], p3 = PS[384 + dk];
        const float off = (tg > 0 ? p0 : 1.f) * (tg > 1 ? p1 : 1.f) * (tg > 2 ? p2 : 1.f);
        const float pref = p0 * p1, pbl = pref * (p2 * p3), ebr = p2 * p3;
        const float ioff = off * __builtin_amdgcn_rcpf(pref);
        unsigned ktp[8], vtp[8];
#pragma unroll
        for (int i = 0; i < 16; i += 2) {
            float kb[2]; unsigned vv[2];
#pragma unroll
            for (int q = 0; q < 2; ++q) { const float e1 = ioff * lf[i + q]; const float e2 = __builtin_amdgcn_rcpf(e1);
                const float khat = kk[i + q] * e2; kb[q] = khat * ebr; vv[q] = *(const LAS bf16_t*)(L + ST_OFF + (tg * 16 + i + q) * QS + dk * 2);
                if (OUT) { LAS bf16_t* qp = (LAS bf16_t*)(L + QH_OFF + (tg * 16 + i + q) * QS + dk * 2); const float qr = bf2f(*qp); const float qv = qr * __builtin_amdgcn_rcpf(1.f + __expf(-qr));
                    *qp = f2bf(qv * e1); *(LAS bf16_t*)(L + KH_OFF + (tg * 16 + i + q) * QS + dk * 2) = f2bf(khat); } }
            ktp[i >> 1] = pk2(kb[0], kb[1]); vtp[i >> 1] = vv[0] | (vv[1] << 16);
        }
        *(LAS u32x4*)(L + KT_OFF + dk * TS + tg * 32) = (u32x4){ktp[0], ktp[1], ktp[2], ktp[3]}; *(LAS u32x4*)(L + KT_OFF + dk * TS + tg * 32 + 16) = (u32x4){ktp[4], ktp[5], ktp[6], ktp[7]};
        *(LAS u32x4*)(L + VT_OFF + dk * TS + tg * 32) = (u32x4){vtp[0], vtp[1], vtp[2], vtp[3]}; *(LAS u32x4*)(L + VT_OFF + dk * TS + tg * 32 + 16) = (u32x4){vtp[4], vtp[5], vtp[6], vtp[7]};
        if (tg == 0) { EB[dk] = pbl; ER[dk] = pref; dsum *= pbl; }
        GLA_BAR();
        f32x16 o;
        if (OUT) {
#pragma unroll
            for (int jj = 0; jj < 2; ++jj)
#pragma unroll
                for (int rg = 0; rg < 4; ++rg) { const int dk0 = 32 * si + 8 * rg + 4 * l5; const f32x4 er = *(const LAS f32x4*)(ER + dk0);
                    u32x2 pk; pk.x = pk2(S[jj][4 * rg] * er[0], S[jj][4 * rg + 1] * er[1]); pk.y = pk2(S[jj][4 * rg + 2] * er[2], S[jj][4 * rg + 3] * er[3]);
                    *(LAS u32x2*)(L + ST_OFF + (32 * (sj0 + jj) + l31) * QS + dk0 * 2) = pk; }
#pragma unroll
            for (int q = 0; q < 2; ++q) { const int ti = w >> 1, tj = (w & 1) * 2 + q;
                f32x4 sc = (f32x4){0.f, 0.f, 0.f, 0.f};
                if (tj <= ti) {
#pragma unroll
                    for (int ks = 0; ks < 4; ++ks) { const bf16x8 af = *(const LAS bf16x8*)(L + QH_OFF + (16 * ti + (lane & 15)) * QS + ks * 64 + (lane >> 4) * 16);
                        const bf16x8 bfr = *(const LAS bf16x8*)(L + KH_OFF + (16 * tj + (lane & 15)) * QS + ks * 64 + (lane >> 4) * 16);
                        sc = __builtin_amdgcn_mfma_f32_16x16x32_bf16(af, bfr, sc, 0, 0, 0); } }
                const int scol = 16 * tj + (lane & 15);
#pragma unroll
                for (int r = 0; r < 4; ++r) { const int trow = 16 * ti + 4 * (lane >> 4) + r; const float v = (scol <= trow) ? sc[r] : 0.f;
                    *(LAS bf16_t*)(L + AM_OFF + trow * TS + scol * 2) = f2bf(v); } }
            GLA_BAR();
#pragma unroll
            for (int r = 0; r < 16; ++r) o[r] = 0.f;
#pragma unroll
            for (int ks = 0; ks < 4; ++ks) if (ks < 2 * (ri + 1)) {
                const bf16x8 af = *(const LAS bf16x8*)(L + AM_OFF + (32 * ri + l31) * TS + ks * 32 + l5 * 16);
                const bf16x8 bfr = *(const LAS bf16x8*)(L + VT_OFF + (32 * cj + l31) * TS + ks * 32 + l5 * 16);
                o = __builtin_amdgcn_mfma_f32_32x32x16_bf16(af, bfr, o, 0, 0, 0); }
#pragma unroll
            for (int ks = 0; ks < 8; ++ks) { if ((ks & 3) == 0) asm volatile("" ::: "memory");
                const bf16x8 af = *(const LAS bf16x8*)(L + QH_OFF + (32 * ri + l31) * QS + ks * 32 + l5 * 16);
                const bf16x8 bfr = *(const LAS bf16x8*)(L + ST_OFF + (32 * cj + l31) * QS + ks * 32 + l5 * 16);
                o = __builtin_amdgcn_mfma_f32_32x32x16_bf16(af, bfr, o, 0, 0, 0); }
#pragma unroll
            for (int r = 0; r < 16; ++r) { const float q2 = xrow32_sum(row16_sum(o[r] * o[r]));
                if (l31 == 0) SSQ[(32 * ri + (r & 3) + 8 * (r >> 2) + 4 * l5) * 4 + cj] = q2; }
        }
        {
            bf16x8 af[4];
#pragma unroll
            for (int ks = 0; ks < 4; ++ks) af[ks] = *(const LAS bf16x8*)(L + KT_OFF + (32 * si + l31) * TS + ks * 32 + l5 * 16);
#pragma unroll
            for (int jj = 0; jj < 2; ++jj) {
#pragma unroll
                for (int rg = 0; rg < 4; ++rg) { const f32x4 eb = *(const LAS f32x4*)(EB + 32 * si + 8 * rg + 4 * l5);
                    S[jj][4 * rg] *= eb[0]; S[jj][4 * rg + 1] *= eb[1]; S[jj][4 * rg + 2] *= eb[2]; S[jj][4 * rg + 3] *= eb[3]; }
#pragma unroll
                for (int ks = 0; ks < 4; ++ks) { const bf16x8 bfr = *(const LAS bf16x8*)(L + VT_OFF + (32 * (sj0 + jj) + l31) * TS + ks * 32 + l5 * 16);
                    S[jj] = __builtin_amdgcn_mfma_f32_32x32x16_bf16(af[ks], bfr, S[jj], 0, 0, 0); } }
        }
        GLA_BAR();
        if (OUT) {
            const float nwv = a.in[26][h * 128 + odv];
            bf16_t* MIX = (bf16_t*)(a.ws + WS_MIX1) + ((size_t)b * SEQ + (size_t)j * 1024 + cc * 64) * DM + h * 128;
            unsigned mo = (unsigned)((32 * ri + 4 * l5) * DM + odv); asm volatile("" : "+v"(mo));
#pragma unroll
            for (int r = 0; r < 16; ++r) { const int t = 32 * ri + (r & 3) + 8 * (r >> 2) + 4 * l5; const f32x4 q4 = *(const LAS f32x4*)(SSQ + t * 4);
                const float rs = rsqrtf(((q4[0] + q4[1]) + (q4[2] + q4[3])) * (1.f / 128.f) + 1e-6f);
                const float gv = __uint_as_float((r & 1) ? (gp[r >> 1] & 0xffff0000u) : (gp[r >> 1] << 16)); const float y = o[r] * rs * nwv * gv * __builtin_amdgcn_rcpf(1.f + __expf(-gv));
                MIX[mo + (unsigned)(((r & 3) + 8 * (r >> 2)) * DM)] = f2bf(y); }
        }
    }
    if (!OUT) {
#pragma unroll
        for (int jj = 0; jj < 2; ++jj)
#pragma unroll
            for (int r = 0; r < 16; ++r) { const int sdk = 32 * si + (r & 3) + 8 * (r >> 2) + 4 * l5, sdv = 32 * (sj0 + jj) + l31; Lb[(size_t)u * 16384 + sdk * 128 + sdv] = S[jj][r]; }
        if (tg == 0) Db[u * 128 + dk] = dsum;
    }
    GLA_BAR();
#undef GLA_PREFETCH
}
__device__ __forceinline__ void pass2(const Args& a) {
    float* Lb = (float*)(a.ws + WS_O); const float* Db = Lb + (size_t)256 * 16384;
    for (int idx = blockIdx.x * NTHREADS + threadIdx.x; idx < 32 * 16384; idx += gridDim.x * NTHREADS) { const int bh = idx >> 14, el = idx & 16383, dkk = el >> 7; float sacc = 0.f;
        for (int j = 0; j < 8; ++j) { const int u = bh * 8 + j; const size_t o = (size_t)u * 16384 + el;
            if (j < 7) { const float tmp = Lb[o]; Lb[o] = sacc; sacc = Db[u * 128 + dkk] * sacc + tmp; } else Lb[o] = sacc; } }
}
}

constexpr int NPHASE = 24;
__global__ void __launch_bounds__(NTHREADS, 2) fwd(Args a) {
    extern __shared__ __attribute__((aligned(16))) unsigned char lds_raw[];
    LAS unsigned char* ldsb = (LAS unsigned char*)lds_raw;
    LAS float* lds = (LAS float*)ldsb;
    LAS int* pst = (LAS int*)(ldsb + LDS_MISC);
    volatile LAS unsigned* xbw = (volatile LAS unsigned*)(ldsb + LDS_MISC + 256);
    if (threadIdx.x == 0) { xbw[0] = 0u; xbw[1] = 0u; }
    __syncthreads();
    unsigned* ctl = (unsigned*)(a.ws + WS_CTL);
    const bool multi = (a.ph_hi - a.ph_lo) > 1;
    XcdBarrier bar; bar.bar = ctl; bar.x = 0; bar.st = xbw;
    if (multi) bar = xcd_barrier_post(ctl, xbw);
    unsigned char* ws = a.ws;
    bf16_t* HN = (bf16_t*)(ws + WS_A);
    bf16_t* XR = (bf16_t*)(ws + WS_XR); float* RSv = (float*)(ws + WS_ROUTE + RT_LRU_CH);
    int* asg_e = (int*)(ws + WS_ROUTE + RT_ASG_E); int* asg_rank = (int*)(ws + WS_ROUTE + RT_ASG_RANK); float* asg_gate = (float*)(ws + WS_ROUTE + RT_ASG_GATE);
    int* row_tok = (int*)(ws + WS_ROUTE + RT_ROW_TOK); int* row_slot = (int*)(ws + WS_ROUTE + RT_ROW_SLOT); float* row_gate = (float*)(ws + WS_ROUTE + RT_ROW_GATE); float* row_rs = (float*)(ws + WS_ROUTE + RT_LRU_CA); float* tscale = (float*)(ws + WS_ROUTE + RT_LRU_CIN);
#ifndef PHSEL
#define PHSEL(k) true
#endif
#ifndef REPMASK
#define REPMASK 0u
#endif
#define NREP(k) (((REPMASK >> (k)) & 1u) ? 2 : 1)
#define IN(k) (PHSEL(k) && a.ph_lo <= (k) && (k) < a.ph_hi)
#define SEAM(k) do { if (IN((k) + 1) && multi) xcd_barrier(bar); } while (0)
    if (IN(0)) { ph_cvt_frags(a); ph_cvt_dense_a(a, lds, ctl + CW_COLMAX); ph_norm0(a.in[0], a.in[1], (unsigned char*)HN, (float*)(ws + WS_ROUTE + RT_LRU_CH + 262144)); xcd_barrier(bar); ph_cvt_dense_b(a, lds, ctl + CW_COLMAX, 0); }
#if (REPMASK >> 0) & 1
    if (IN(0)) { xcd_barrier(bar);  ph_cvt_frags(a); ph_cvt_dense_a(a, lds, ctl + CW_COLMAX); ph_norm0(a.in[0], a.in[1], (unsigned char*)HN, (float*)(ws + WS_ROUTE + RT_LRU_CH + 262144)); xcd_barrier(bar); ph_cvt_dense_b(a, lds, ctl + CW_COLMAX, 0); }
#endif
    if (IN(0)) { SEAM(0); }
    if (IN(1)) { pg8::DenseOrder S; S.init(NTOK, ABC, DM / 2, gridDim.x, blockIdx.x, ws + WD_ABIN); pg8::EpiBf16I E{(bf16_t*)(ws + WS_B), ABC, (float*)(ws + WS_ROUTE + RT_LRU_CH + 262144), ctl + CW_COLMAX};
        pg8::gemm_phase<pg8::EpiBf16I, pg8::DenseOrder, true>(ldsb, (const char*)HN, DM, DM / 2, S, E); }
#if (REPMASK >> 1) & 1
    if (IN(1)) { xcd_barrier(bar);  pg8::DenseOrder S; S.init(NTOK, ABC, DM / 2, gridDim.x, blockIdx.x, ws + WD_ABIN); pg8::EpiBf16I E{(bf16_t*)(ws + WS_B), ABC, (float*)(ws + WS_ROUTE + RT_LRU_CH + 262144), ctl + CW_COLMAX};
        pg8::gemm_phase<pg8::EpiBf16I, pg8::DenseOrder, true>(ldsb, (const char*)HN, DM, DM / 2, S, E);  }
#endif
    if (IN(1)) { SEAM(1); }
    if (IN(2)) { ph_l0_prep(a, lds); }
#if (REPMASK >> 2) & 1
    if (IN(2)) { xcd_barrier(bar);  ph_l0_prep(a, lds);  }
#endif
    if (IN(2)) { SEAM(2); }
    if (IN(6)) {
        if (blockIdx.x < 32) ph_rwkv_scan(a, ldsb);
        else { const int gb = (int)blockIdx.x - 32, gn = (int)gridDim.x - 32; unsigned* sctr = ctl + CW_CNT + 256;
            ph_lru_b(a, gb, lds); sub_barrier(sctr, (unsigned)gn);
            ph_lru_c(a, gb, gn); ph_wmax(a.in[32], a.in[33], ctl + CW_WMAX, gb, gn); sub_barrier(sctr, 2u * (unsigned)gn);
            ph_cvt_moe(a, 0, lds, gb, gn, 3); ph_cvt_moe(a, 1, lds, gb, gn, 1); }
        SEAM(6); }
    if (IN(7)) { ph_rwkv_post(a, lds); }
#if (REPMASK >> 7) & 1
    if (IN(7)) { xcd_barrier(bar);  ph_rwkv_post(a, lds);  }
#endif
    if (IN(7)) { SEAM(7); }
    if (IN(8)) { pg8::DenseOrder S; S.init(NTOK, DM, DM, gridDim.x, blockIdx.x, ws + WD_ABOUT); pg8::EpiResid<true> E{a.in[0], XR};
        pg8::gemm_phase(ldsb, (const char*)(ws + WS_D), DM * 2, DM, S, E); }
#if (REPMASK >> 8) & 1
    if (IN(8)) { xcd_barrier(bar);  pg8::DenseOrder S; S.init(NTOK, DM, DM, gridDim.x, blockIdx.x, ws + WD_ABOUT); pg8::EpiResid<true> E{a.in[0], XR};
        pg8::gemm_phase(ldsb, (const char*)(ws + WS_D), DM * 2, DM, S, E);  }
#endif
    if (IN(8)) { SEAM(8); }
    if (IN(9)) { ph_route(a, 0, XR, HN, RSv, ctl + CW_CNT, asg_e, asg_rank, asg_gate, lds); SEAM(9); }
    if (IN(10)) { ph_dispatch(ctl + CW_CNT, asg_e, asg_rank, asg_gate, RSv, row_tok, row_slot, row_gate, row_rs, pst, ctl + CW_WMAX, tscale); ph_cvt_dense_b(a, lds, ctl + CW_COLMAX, 1); }
#if (REPMASK >> 10) & 1
    if (IN(10)) { xcd_barrier(bar);  ph_dispatch(ctl + CW_CNT, asg_e, asg_rank, asg_gate, RSv, row_tok, row_slot, row_gate, row_rs, pst, ctl + CW_WMAX, tscale);  }
#endif
    if (IN(10)) { SEAM(10); }
    if (IN(11)) { moe_prefix(ctl + CW_CNT, pst);
        pg8::MoeOrder S{(int)gridDim.x, (int)blockIdx.x, 4, pst[NEXP] / 256, pst, row_tok, (const char*)(ws + WM_GU), (size_t)DM * DM, (size_t)256 * DM}; pg8::EpiSwiGLU E{(bf16_t*)(ws + WS_H), tscale};
        pg8::gemm_phase<pg8::EpiSwiGLU, pg8::MoeOrder, true>(ldsb, (const char*)HN, DM, DM / 2, S, E); }
#if (REPMASK >> 11) & 1
    if (IN(11)) { xcd_barrier(bar);  moe_prefix(ctl + CW_CNT, pst);
        pg8::MoeOrder S{(int)gridDim.x, (int)blockIdx.x, 4, pst[NEXP] / 256, pst, row_tok, (const char*)(ws + WM_GU), (size_t)DM * DM, (size_t)256 * DM}; pg8::EpiSwiGLU E{(bf16_t*)(ws + WS_H), tscale};
        pg8::gemm_phase<pg8::EpiSwiGLU, pg8::MoeOrder, true>(ldsb, (const char*)HN, DM, DM / 2, S, E);  }
#endif
    if (IN(11)) { SEAM(11); }
    if (IN(12)) { moe_prefix(ctl + CW_CNT, pst);
        pg8::MoeOrder S{(int)gridDim.x, (int)blockIdx.x, 4, pst[NEXP] / 256, pst, nullptr, (const char*)(ws + WM_DN), (size_t)DM * FF * 2, (size_t)256 * FF * 2}; pg8::EpiDown E{(bf16_t*)(ws + WS_Y), row_tok, row_slot, row_gate};
        pg8::gemm_phase(ldsb, (const char*)(ws + WS_H), FF * 2, FF, S, E); }
#if (REPMASK >> 12) & 1
    if (IN(12)) { xcd_barrier(bar);  moe_prefix(ctl + CW_CNT, pst);
        pg8::MoeOrder S{(int)gridDim.x, (int)blockIdx.x, 4, pst[NEXP] / 256, pst, nullptr, (const char*)(ws + WM_DN), (size_t)DM * FF * 2, (size_t)256 * FF * 2}; pg8::EpiDown E{(bf16_t*)(ws + WS_Y), row_tok, row_slot, row_gate};
        pg8::gemm_phase(ldsb, (const char*)(ws + WS_H), FF * 2, FF, S, E);  }
#endif
    if (IN(12)) { SEAM(12); }
    if (IN(13)) { ph_combine_norm(XR, (const bf16_t*)(ws + WS_Y), a.in[1] + DM, (unsigned char*)HN, (float*)(ws + WS_ROUTE + RT_LRU_CH + 262144)); SEAM(13); }
    if (IN(14)) { pg8::DenseOrder S; S.init(NTOK, 4096, DM / 2, gridDim.x, blockIdx.x, ws + WD_CIN); pg8::EpiBf16I E{(bf16_t*)(ws + WS_QFIG), 4096, (float*)(ws + WS_ROUTE + RT_LRU_CH + 262144), ctl + CW_COLMAX + ABC};
        pg8::gemm_phase<pg8::EpiBf16I, pg8::DenseOrder, true>(ldsb, (const char*)HN, DM, DM / 2, S, E); }
#if (REPMASK >> 14) & 1
    if (IN(14)) { xcd_barrier(bar);  pg8::DenseOrder S; S.init(NTOK, 4096, DM / 2, gridDim.x, blockIdx.x, ws + WD_CIN); pg8::EpiBf16I E{(bf16_t*)(ws + WS_QFIG), 4096, (float*)(ws + WS_ROUTE + RT_LRU_CH + 262144), ctl + CW_COLMAX + ABC};
        pg8::gemm_phase<pg8::EpiBf16I, pg8::DenseOrder, true>(ldsb, (const char*)HN, DM, DM / 2, S, E);  }
#endif
    if (IN(14)) { SEAM(14); }
    if (IN(15)) { for (int u = blockIdx.x; u < 256; u += gridDim.x) if ((u & 7) != 7) gla::unit<false>(a, ldsb, u); }
#if (REPMASK >> 15) & 1
    if (IN(15)) { xcd_barrier(bar);  for (int u = blockIdx.x; u < 256; u += gridDim.x) if ((u & 7) != 7) gla::unit<false>(a, ldsb, u);  }
#endif
    if (IN(15)) { SEAM(15); }
    if (IN(17)) { for (int u = blockIdx.x; u < 256; u += gridDim.x) gla::unit<true>(a, ldsb, u); }
#if (REPMASK >> 17) & 1
    if (IN(17)) { xcd_barrier(bar);  for (int u = blockIdx.x; u < 256; u += gridDim.x) gla::unit<true>(a, ldsb, u);  }
#endif
    if (IN(17)) { SEAM(17); }
    if (IN(18)) { pg8::DenseOrder S; S.init(NTOK, DM, DM, gridDim.x, blockIdx.x, ws + WD_COUT); pg8::EpiResid<false> E{XR, XR};
        pg8::gemm_phase(ldsb, (const char*)(ws + WS_MIX1), DM * 2, DM, S, E); SEAM(18); }
    if (IN(19)) { ph_route(a, 1, XR, HN, RSv, ctl + CW_CNT + 64, asg_e, asg_rank, asg_gate, lds); SEAM(19); }
    if (IN(20)) { ph_dispatch(ctl + CW_CNT + 64, asg_e, asg_rank, asg_gate, RSv, row_tok, row_slot, row_gate, row_rs, pst, ctl + CW_WMAX + 64, tscale); ph_cvt_moe(a, 1, lds, blockIdx.x, gridDim.x, 2); }
#if (REPMASK >> 20) & 1
    if (IN(20)) { xcd_barrier(bar);  ph_dispatch(ctl + CW_CNT + 64, asg_e, asg_rank, asg_gate, RSv, row_tok, row_slot, row_gate, row_rs, pst, ctl + CW_WMAX + 64, tscale); ph_cvt_moe(a, 1, lds, blockIdx.x, gridDim.x, 2);  }
#endif
    if (IN(20)) { SEAM(20); }
    if (IN(21)) { moe_prefix(ctl + CW_CNT + 64, pst);
        pg8::MoeOrder S{(int)gridDim.x, (int)blockIdx.x, 4, pst[NEXP] / 256, pst, row_tok, (const char*)(ws + WM_GU1), (size_t)DM * DM, (size_t)256 * DM}; pg8::EpiSwiGLU E{(bf16_t*)(ws + WS_H), tscale};
        pg8::gemm_phase<pg8::EpiSwiGLU, pg8::MoeOrder, true>(ldsb, (const char*)HN, DM, DM / 2, S, E); }
#if (REPMASK >> 21) & 1
    if (IN(21)) { xcd_barrier(bar);  moe_prefix(ctl + CW_CNT + 64, pst);
        pg8::MoeOrder S{(int)gridDim.x, (int)blockIdx.x, 4, pst[NEXP] / 256, pst, row_tok, (const char*)(ws + WM_GU1), (size_t)DM * DM, (size_t)256 * DM}; pg8::EpiSwiGLU E{(bf16_t*)(ws + WS_H), tscale};
        pg8::gemm_phase<pg8::EpiSwiGLU, pg8::MoeOrder, true>(ldsb, (const char*)HN, DM, DM / 2, S, E);  }
#endif
    if (IN(21)) { SEAM(21); }
    if (IN(22)) { moe_prefix(ctl + CW_CNT + 64, pst);
        pg8::MoeOrder S{(int)gridDim.x, (int)blockIdx.x, 4, pst[NEXP] / 256, pst, nullptr, (const char*)(ws + WM_DN), (size_t)DM * FF * 2, (size_t)256 * FF * 2}; pg8::EpiDown E{(bf16_t*)(ws + WS_Y), row_tok, row_slot, row_gate};
        pg8::gemm_phase(ldsb, (const char*)(ws + WS_H), FF * 2, FF, S, E); }
#if (REPMASK >> 22) & 1
    if (IN(22)) { xcd_barrier(bar);  moe_prefix(ctl + CW_CNT + 64, pst);
        pg8::MoeOrder S{(int)gridDim.x, (int)blockIdx.x, 4, pst[NEXP] / 256, pst, nullptr, (const char*)(ws + WM_DN), (size_t)DM * FF * 2, (size_t)256 * FF * 2}; pg8::EpiDown E{(bf16_t*)(ws + WS_Y), row_tok, row_slot, row_gate};
        pg8::gemm_phase(ldsb, (const char*)(ws + WS_H), FF * 2, FF, S, E);  }
#endif
    if (IN(22)) { SEAM(22); }
    if (IN(23)) { ph_final(XR, (const bf16_t*)(ws + WS_Y), a.in[3], a.out); }
#undef IN
#undef SEAM
}

extern "C" void kernel_launch(void* const* d_in, const int* in_sizes, int n_in, void* d_out, int out_size, void* d_ws, size_t ws_size, hipStream_t stream) {
    static int grid = 0;
    if (grid == 0) {
        if (n_in != 35 || out_size != NTOK * DM || ws_size < WS_END) { fprintf(stderr, "kernel_launch: unexpected shapes (n_in %d out %d ws %zu)\n", n_in, out_size, ws_size); grid = -1; return; }
        int dev = 0, cus = 0;
        if (hipGetDevice(&dev) != hipSuccess || hipDeviceGetAttribute(&cus, hipDeviceAttributeMultiprocessorCount, dev) != hipSuccess) { grid = -1; return; }
        if (hipFuncSetAttribute((const void*)fwd, hipFuncAttributeMaxDynamicSharedMemorySize, LDS_BYTES) != hipSuccess) { fprintf(stderr, "kernel_launch: hipFuncSetAttribute failed\n"); grid = -1; return; }
        int per_cu = 0;
        (void)hipOccupancyMaxActiveBlocksPerMultiprocessor(&per_cu, (const void*)fwd, NTHREADS, LDS_BYTES);
        (void)hipGetLastError();
        grid = cus;
        if (grid < 64) { fprintf(stderr, "kernel_launch: needs >= 64 CUs\n"); grid = -1; return; }
    }
    if (grid < 0) return;
    (void)hipMemsetAsync((char*)d_ws + WS_CTL, 0, CTL_ZERO_BYTES, stream);
    Args a{};
    for (int i = 0; i < 35; ++i) a.in[i] = (const float*)d_in[i];
    a.out = (float*)d_out; a.ws = (unsigned char*)d_ws;
#if 0
    for (int p = 0; p < NPHASE; ++p) { a.ph_lo = p; a.ph_hi = p + 1; hipLaunchKernelGGL(fwd, dim3(grid), dim3(NTHREADS), LDS_BYTES, stream, a); }
#else
    a.ph_lo = 0; a.ph_hi = NPHASE; hipLaunchKernelGGL(fwd, dim3(grid), dim3(NTHREADS), LDS_BYTES, stream, a);
#endif
}
```

```cpp
#include <hip/hip_runtime.h>
#include <cstdio>
#include <cstdint>

typedef unsigned short bf16_t;
#define LAS __attribute__((address_space(3)))
typedef float f32x4 __attribute__((ext_vector_type(4)));
typedef short bf16x8_t __attribute__((ext_vector_type(8)));
typedef unsigned u32x4_t __attribute__((ext_vector_type(4)));
typedef unsigned u32x2_t __attribute__((ext_vector_type(2)));

constexpr int NTOK = 32768, SEQ = 8192, NBATCH = 4, DM = 1024;
constexpr int ABC = 2816, RWC = 1792;
constexpr int NEXP = 32, FF = 512;
constexpr int NASG = NTOK * 2;
constexpr int MOE_TM = 256;
constexpr int MAXROWS = NASG + NEXP * MOE_TM;
constexpr int NTHREADS = 512;
constexpr int LDS_BYTES = 156 * 1024;
constexpr int LDS_MISC = 155 * 1024;

constexpr size_t MiB = 1024ull * 1024ull;
constexpr size_t WS_CTL = 0;
constexpr size_t CTL_ZERO_BYTES = 64 * 1024;
constexpr size_t WS_ROUTE = 64 * 1024;
constexpr size_t WS_WD = 8 * MiB;
constexpr size_t WD_ABIN = WS_WD, WD_ABOUT = WD_ABIN + (size_t)ABC * DM * 2, WD_CIN = WD_ABOUT + (size_t)DM * DM * 2, WD_COUT = WD_CIN + (size_t)4096 * DM * 2;
constexpr size_t WS_AR = 26 * MiB;
constexpr size_t WS_A = WS_AR;
constexpr size_t WS_B = WS_AR + 64 * MiB;
constexpr size_t WS_C = WS_B + 176 * MiB;
constexpr size_t WS_D = WS_C + 212 * MiB;
constexpr size_t DO_LRU = 112 * MiB;
constexpr size_t WS_XR = WS_AR + 360 * MiB;
constexpr size_t WS_WM = WS_AR + 64 * MiB;
constexpr size_t WM_GU1 = WS_A + 32 * MiB;
constexpr size_t WM_GU = WS_WM, WM_DN = WS_WM + (size_t)NEXP * DM * DM;
constexpr size_t WS_H = WS_WM + 96 * MiB;
constexpr size_t WS_Y = WS_H + 72 * MiB;
constexpr size_t WS_QFIG = WS_AR + 64 * MiB;
constexpr size_t WS_O = WS_QFIG + 256 * MiB;
constexpr size_t WS_MIX1 = WS_O + 128 * MiB;
constexpr size_t WS_END = WS_AR + 516 * MiB;
static_assert(WS_D + 64 * MiB <= WS_END && WS_Y + 128 * MiB <= WS_END && WS_MIX1 + 64 * MiB <= WS_END, "arena");

constexpr size_t DO_VB = 0, DO_BON = 32 * MiB, DO_SG = 34 * MiB, DO_YR = 48 * MiB;

constexpr int CW_CNT = 8192;
constexpr int CW_WMAX = CW_CNT + 512;
constexpr int CW_COLMAX = CW_WMAX + 192;
constexpr float ACT_Q = 127.f / 6.f;
constexpr size_t RT_ASG_E = 0;
constexpr size_t RT_ASG_RANK = RT_ASG_E + NASG * 4;
constexpr size_t RT_ASG_GATE = RT_ASG_RANK + NASG * 4;
constexpr size_t RT_ROW_TOK = RT_ASG_GATE + NASG * 4;
constexpr size_t RT_ROW_SLOT = RT_ROW_TOK + MAXROWS * 4;
constexpr size_t RT_ROW_GATE = RT_ROW_SLOT + MAXROWS * 4;
constexpr size_t RT_LRU_CH = RT_ROW_GATE + MAXROWS * 4;
constexpr size_t RT_LRU_CA = RT_LRU_CH + 512 * 512 * 4;
constexpr size_t RT_LRU_CIN = RT_LRU_CA + 512 * 512 * 4;
constexpr size_t RT_END = RT_LRU_CIN + 512 * 512 * 4;
constexpr size_t WS_FRAG = 6 * MiB;
constexpr size_t FG_RT = WS_FRAG + 393216;
constexpr size_t FG_W2 = WS_FRAG, FG_A2 = FG_W2 + 65536, FG_WA = FG_A2 + 65536, FG_WX = FG_WA + 65536, FG_G2 = FG_WX + 65536;
static_assert(WS_ROUTE + RT_END <= 6 * MiB, "routing arrays overflow");

__device__ __forceinline__ float bf2f(bf16_t v) { return __uint_as_float(((unsigned)v) << 16); }
typedef __bf16 bf16x2_hw __attribute__((ext_vector_type(2)));
typedef float f32x2_hw __attribute__((ext_vector_type(2)));
__device__ __forceinline__ unsigned pk2(float lo, float hi) { const f32x2_hw v = {lo, hi}; const bf16x2_hw b = __builtin_convertvector(v, bf16x2_hw); return __builtin_bit_cast(unsigned, b); }
__device__ __forceinline__ bf16_t f2bf(float f) { const __bf16 b = (__bf16)f; return __builtin_bit_cast(bf16_t, b); }
template <int CTRL> __device__ __forceinline__ float dpp_(float x) { return __builtin_bit_cast(float, __builtin_amdgcn_mov_dpp(__builtin_bit_cast(int, x), CTRL, 0xf, 0xf, true)); }
__device__ __forceinline__ float row16_sum(float v) {
    v += dpp_<0xB1>(v); v += dpp_<0x4E>(v); v += dpp_<0x124>(v); v += dpp_<0x128>(v); return v; }
__device__ __forceinline__ float xrow16_sum(float x) {
    auto s = __builtin_amdgcn_permlane16_swap(__float_as_uint(x), __float_as_uint(x), false, false);
    x = __uint_as_float(s[0]) + __uint_as_float(s[1]);
    auto t = __builtin_amdgcn_permlane32_swap(__float_as_uint(x), __float_as_uint(x), false, false);
    return __uint_as_float(t[0]) + __uint_as_float(t[1]); }
__device__ __forceinline__ float xrow32_sum(float x) {
    auto s = __builtin_amdgcn_permlane16_swap(__float_as_uint(x), __float_as_uint(x), false, false);
    return __uint_as_float(s[0]) + __uint_as_float(s[1]); }
__device__ __forceinline__ float wave_sum(float v) { return xrow16_sum(row16_sum(v)); }
__device__ __forceinline__ float sigmoidf_(float x) { return 1.f / (1.f + __expf(-x)); }
__device__ __forceinline__ float softplusf_(float x) { return fmaxf(x, 0.f) + log1pf(__expf(-fabsf(x))); }
__device__ __forceinline__ float siluf_(float x) { return x * sigmoidf_(x); }
__device__ __forceinline__ float gelu_tanhf_(float x) { const float c = 0.7978845608028654f; return 0.5f * x * (1.f + tanhf(c * (x + 0.044715f * x * x * x))); }

struct Args {
    const float* in[35];
    float* out;
    unsigned char* ws;
    int ph_lo, ph_hi;
};

#define XB_TMO      128
#define XB_XCNT(j)  (256  + 64 * (j))
#define XB_XSUB(j)  (1280 + 64 * (j))
#define XB_XGEN(j)  (2304 + 64 * (j))
#define XB_TOP      3328
#define XB_TOPGEN   3392
#define XCD_BAR_WORDS 3456
#define XB_SPIN_CAP (1u << 18)
__device__ __forceinline__ unsigned xb_ld(unsigned* p)              { return __hip_atomic_load(p, __ATOMIC_RELAXED, __HIP_MEMORY_SCOPE_AGENT); }
__device__ __forceinline__ unsigned xb_add(unsigned* p, unsigned v) { return __hip_atomic_fetch_add(p, v, __ATOMIC_RELAXED, __HIP_MEMORY_SCOPE_AGENT); }
__device__ __forceinline__ unsigned xb_xcc_id() { return (unsigned)__builtin_amdgcn_s_getreg((3 << 11) | 20) & 0xFu; }
#define XB_SPIN(cond, bar) do { unsigned _sp = 0; while (cond) { __builtin_amdgcn_s_sleep(1); \
    if ((++_sp & 255u) == 0u) { if (xb_ld(&(bar)[XB_TMO])) break; if (_sp > XB_SPIN_CAP) { atomicAdd(&(bar)[XB_TMO], 1u); break; } } } } while (0)
struct XcdBarrier { unsigned* bar; unsigned x; volatile LAS unsigned* st; };
__device__ __forceinline__ XcdBarrier xcd_barrier_post(unsigned* bar, volatile LAS unsigned* st) {
    XcdBarrier b; b.bar = bar; b.x = xb_xcc_id(); b.st = st;
    if (threadIdx.x == 0) (void)xb_add(&bar[XB_XCNT(b.x)], 1u);
    return b;
}
__device__ __forceinline__ void xcd_barrier_complete(unsigned* bar, unsigned x, unsigned& nloc, unsigned& nx) {
    const unsigned G = gridDim.x * gridDim.y * gridDim.z;
    unsigned sum, cnt, mine, sp = 0u;
    for (;;) {
        sum = 0u; cnt = 0u; mine = 0u;
#pragma unroll
        for (unsigned j = 0; j < 16; ++j) { const unsigned c = xb_ld(&bar[XB_XCNT(j)]); sum += c; cnt += (c > 0u) ? 1u : 0u; mine = (j == x) ? c : mine; }
        if (sum == G) break;
        __builtin_amdgcn_s_sleep(1);
        if ((++sp & 255u) == 0u) { if (xb_ld(&bar[XB_TMO])) break; if (sp > XB_SPIN_CAP) { atomicAdd(&bar[XB_TMO], 1u); break; } }
    }
    nloc = mine > 0u ? mine : 1u; nx = cnt > 0u ? cnt : 1u;
}
__device__ __forceinline__ void xcd_barrier(const XcdBarrier& b) {
    asm volatile("s_waitcnt vmcnt(0)" ::: "memory");
    __syncthreads();
    if (threadIdx.x == 0) {
        unsigned* bar = b.bar;
        __builtin_amdgcn_s_waitcnt(0);
        unsigned nloc = b.st[0], nx = b.st[1];
        if (nloc == 0u) { xcd_barrier_complete(bar, b.x, nloc, nx); b.st[0] = nloc; b.st[1] = nx; }
        const unsigned old = xb_add(&bar[XB_XSUB(b.x)], 1u);
        const unsigned gen = old / nloc;
        if (old + 1u == (gen + 1u) * nloc) {
            __builtin_amdgcn_fence(__ATOMIC_RELEASE, "agent");
            asm volatile("s_waitcnt vmcnt(0)" ::: "memory");
            const unsigned og = xb_add(&bar[XB_TOP], 1u);
            const unsigned tg = og / nx;
            if (og + 1u == (tg + 1u) * nx) xb_add(&bar[XB_TOPGEN], 1u);
            else XB_SPIN(xb_ld(&bar[XB_TOPGEN]) == tg, bar);
            __builtin_amdgcn_fence(__ATOMIC_ACQUIRE, "agent");
            xb_add(&bar[XB_XGEN(b.x)], 1u);
            asm volatile("s_waitcnt vmcnt(0)" ::: "memory");
        } else {
            XB_SPIN(xb_ld(&bar[XB_XGEN(b.x)]) == gen, bar);
            __builtin_amdgcn_fence(__ATOMIC_ACQUIRE, "agent");
            asm volatile("s_waitcnt vmcnt(0)" ::: "memory");
        }
    }
    __syncthreads();
}

namespace pg8 {
typedef short bf16x8 __attribute__((ext_vector_type(8)));
typedef unsigned u32x4 __attribute__((ext_vector_type(4)));
typedef int v4i_t __attribute__((ext_vector_type(4)));
constexpr int BM = 256, BK = 64, HALF = 128, HTB = HALF * BK * 2, STAGE_BYTES = 8 * HTB, NXCD = 8, WGM = 8;
__device__ __forceinline__ int lds_byte(int r, int c) { const int st = (r >> 4) * 2 + (c >> 5), rr = r & 15, cc = c & 31, ob = rr * 64 + cc * 2; return st * 1024 + (ob ^ (((ob >> 9) & 1) << 5)); }
__device__ __forceinline__ void stage_rc(int b, int& R, int& C) { const int st = b / 1024, sb = b % 1024, swz = sb ^ (((sb >> 9) & 1) << 5); R = (st >> 1) * 16 + swz / 64; C = (st & 1) * 32 + (swz % 64) / 2; }
__device__ __forceinline__ int perm32(int rho) { const int n = rho >> 4, i = rho & 15; return 8 * (i >> 2) + 4 * n + (i & 3); }
__device__ __forceinline__ unsigned cvt_pk_bf16(float lo, float hi) { unsigned r; asm volatile("v_cvt_pk_bf16_f32 %0, %1, %2" : "=v"(r) : "v"(lo), "v"(hi)); return r; }

struct Unit { int pm, pn; const char* B; };

struct DenseOrder {
    int nM, nN, nwg, G, c; const char* Bt; size_t bstep;
    __device__ void init(int M, int N, int K, int G_, int c_, const void* Bt_) { nM = M / BM; nN = N / BM; nwg = nM * nN; G = G_; c = c_; Bt = (const char*)Bt_; bstep = (size_t)BM * K * 2; }
    __device__ bool next(int i, Unit& u) const {
        const long L = (long)i * G + c; if (L >= nwg) return false;
        int wgid = (int)L; { const int q = nwg / NXCD, r = nwg % NXCD, xcd = wgid % NXCD, off = wgid / NXCD; wgid = (xcd < r ? xcd * (q + 1) : r * (q + 1) + (xcd - r) * q) + off; }
        const int nig = WGM * nN, gid = wgid / nig, fm = gid * WGM, gsz = (nM - fm) < WGM ? (nM - fm) : WGM;
        u.pm = fm + ((wgid % nig) % gsz); u.pn = (wgid % nig) / gsz; u.B = Bt + (size_t)u.pn * bstep; return true;
    }
    __device__ __forceinline__ int arow(const Unit& u, int r) const { return u.pm * BM + r; }
};
struct MoeOrder {
    int G, c, nN, ntiles; const LAS int* pst; const int* rowidx; const char* Bt; size_t estep, bstep;
    __device__ bool next(int i, Unit& u) const {
        const int cc = (G % NXCD == 0) ? (c % NXCD) * (G / NXCD) + c / NXCD : c;
        const int L = i * G + cc; if (L >= ntiles * nN) return false;
        u.pm = L / nN; u.pn = L % nN; const int row0 = u.pm * BM; int e = 0;
#pragma unroll
        for (int st = NEXP / 2; st > 0; st >>= 1) if (row0 >= pst[e + st]) e += st;
        u.B = Bt + (size_t)e * estep + (size_t)u.pn * bstep; return true;
    }
    __device__ __forceinline__ int arow(const Unit& u, int r) const { if (!rowidx) return u.pm * BM + r; const int t = rowidx[u.pm * BM + r]; return t < 0 ? 0 : t; }
};

struct EpiBf16I { static constexpr bool PERM = true; bf16_t* O; int ldc; const float* rowscale; const unsigned* colmax;
    __device__ __forceinline__ void operator()(const f32x4 (&acc)[2][2][4][2], const Unit& u, int wr, int wc, int fr, int fq) const {
        const int row0 = u.pm * BM + wr * 64 + fr, col0 = u.pn * BM + wc * 32 + 8 * fq;
        float rsc[8]; f32x4 cs[2][2];
#pragma unroll
        for (int q = 0; q < 8; ++q) rsc[q] = rowscale[row0 + (q >> 2) * HALF + (q & 3) * 16] * (1.f / 127.f);
#pragma unroll
        for (int bj = 0; bj < 2; ++bj)
#pragma unroll
            for (int n = 0; n < 2; ++n) { const u32x4 c4 = *(const u32x4*)(colmax + col0 + bj * HALF + 4 * n); cs[bj][n] = (f32x4){__uint_as_float(c4.x), __uint_as_float(c4.y), __uint_as_float(c4.z), __uint_as_float(c4.w)} * (1.f / 127.f); }
#pragma unroll
        for (int ai = 0; ai < 2; ++ai)
#pragma unroll
            for (int m = 0; m < 4; ++m) { bf16_t* rowp = O + (size_t)(row0 + ai * HALF + m * 16) * ldc + col0; const float rs = rsc[ai * 4 + m];
#pragma unroll
                for (int bj = 0; bj < 2; ++bj) { const v4i_t i0 = __builtin_bit_cast(v4i_t, acc[ai][bj][m][0]), i1 = __builtin_bit_cast(v4i_t, acc[ai][bj][m][1]);
                    const f32x4 s0 = cs[bj][0] * rs, s1 = cs[bj][1] * rs;
                    u32x4 w; w.x = cvt_pk_bf16((float)i0[0] * s0[0], (float)i0[1] * s0[1]); w.y = cvt_pk_bf16((float)i0[2] * s0[2], (float)i0[3] * s0[3]);
                    w.z = cvt_pk_bf16((float)i1[0] * s1[0], (float)i1[1] * s1[1]); w.w = cvt_pk_bf16((float)i1[2] * s1[2], (float)i1[3] * s1[3]);
                    *(u32x4*)(rowp + bj * HALF) = w; } }
    } };
struct EpiBf16 { static constexpr bool PERM = true; bf16_t* O; int ldc;
    __device__ __forceinline__ void operator()(const f32x4 (&acc)[2][2][4][2], const Unit& u, int wr, int wc, int fr, int fq) const {
        const int row0 = u.pm * BM + wr * 64 + fr, col0 = u.pn * BM + wc * 32 + 8 * fq;
#pragma unroll
        for (int ai = 0; ai < 2; ++ai)
#pragma unroll
            for (int m = 0; m < 4; ++m) { bf16_t* rowp = O + (size_t)(row0 + ai * HALF + m * 16) * ldc + col0;
#pragma unroll
                for (int bj = 0; bj < 2; ++bj) { const f32x4 v0 = acc[ai][bj][m][0], v1 = acc[ai][bj][m][1];
                    u32x4 w; w.x = cvt_pk_bf16(v0[0], v0[1]); w.y = cvt_pk_bf16(v0[2], v0[3]); w.z = cvt_pk_bf16(v1[0], v1[1]); w.w = cvt_pk_bf16(v1[2], v1[3]);
                    *(u32x4*)(rowp + bj * HALF) = w; } }
    } };
template <bool XF32> struct EpiResid { static constexpr bool PERM = true; const void* __restrict__ X; bf16_t* __restrict__ O;
    __device__ __forceinline__ void operator()(const f32x4 (&acc)[2][2][4][2], const Unit& u, int wr, int wc, int fr, int fq) const {
        const int row0 = u.pm * BM + wr * 64 + fr, col0 = u.pn * BM + wc * 32 + 8 * fq;
        if constexpr (XF32) {
#pragma unroll
            for (int ai = 0; ai < 2; ++ai)
#pragma unroll
                for (int mp = 0; mp < 2; ++mp) { f32x4 x[2][2][2];
#pragma unroll
                    for (int mm = 0; mm < 2; ++mm)
#pragma unroll
                        for (int bj = 0; bj < 2; ++bj) { const float* xp = (const float*)X + (size_t)(row0 + ai * HALF + (mp * 2 + mm) * 16) * DM + col0 + bj * HALF; x[mm][bj][0] = *(const f32x4*)xp; x[mm][bj][1] = *(const f32x4*)(xp + 4); }
#pragma unroll
                    for (int mm = 0; mm < 2; ++mm)
#pragma unroll
                        for (int bj = 0; bj < 2; ++bj) { const f32x4 v0 = x[mm][bj][0] + acc[ai][bj][mp * 2 + mm][0], v1 = x[mm][bj][1] + acc[ai][bj][mp * 2 + mm][1];
                            u32x4 w; w.x = cvt_pk_bf16(v0[0], v0[1]); w.y = cvt_pk_bf16(v0[2], v0[3]); w.z = cvt_pk_bf16(v1[0], v1[1]); w.w = cvt_pk_bf16(v1[2], v1[3]);
                            *(u32x4*)(O + (size_t)(row0 + ai * HALF + (mp * 2 + mm) * 16) * DM + col0 + bj * HALF) = w; } }
        } else {
#pragma unroll
            for (int ai = 0; ai < 2; ++ai) { u32x4 x[4][2];
#pragma unroll
                for (int m = 0; m < 4; ++m)
#pragma unroll
                    for (int bj = 0; bj < 2; ++bj) x[m][bj] = *(const u32x4*)((const bf16_t*)X + (size_t)(row0 + ai * HALF + m * 16) * DM + col0 + bj * HALF);
#pragma unroll
                for (int m = 0; m < 4; ++m)
#pragma unroll
                    for (int bj = 0; bj < 2; ++bj) { const u32x4 o = x[m][bj];
                        const f32x4 v0 = (f32x4){__uint_as_float(o.x << 16), __uint_as_float(o.x & 0xffff0000u), __uint_as_float(o.y << 16), __uint_as_float(o.y & 0xffff0000u)} + acc[ai][bj][m][0];
                        const f32x4 v1 = (f32x4){__uint_as_float(o.z << 16), __uint_as_float(o.z & 0xffff0000u), __uint_as_float(o.w << 16), __uint_as_float(o.w & 0xffff0000u)} + acc[ai][bj][m][1];
                        u32x4 w; w.x = cvt_pk_bf16(v0[0], v0[1]); w.y = cvt_pk_bf16(v0[2], v0[3]); w.z = cvt_pk_bf16(v1[0], v1[1]); w.w = cvt_pk_bf16(v1[2], v1[3]);
                        *(u32x4*)(O + (size_t)(row0 + ai * HALF + m * 16) * DM + col0 + bj * HALF) = w; } }
        }
    } };
struct EpiSwiGLU { static constexpr bool PERM = true; bf16_t* H; const float* tscale;
    __device__ __forceinline__ void operator()(const f32x4 (&acc)[2][2][4][2], const Unit& u, int wr, int wc, int fr, int fq) const {
        const int row0 = u.pm * BM + wr * 64 + fr, col0 = u.pn * HALF + wc * 32 + 8 * fq;
        const float s0 = tscale[2 * u.pm], s1 = tscale[2 * u.pm + 1];
#pragma unroll
        for (int ai = 0; ai < 2; ++ai)
#pragma unroll
            for (int m = 0; m < 4; ++m) { float h[8];
#pragma unroll
                for (int n = 0; n < 2; ++n) { const v4i_t gi = __builtin_bit_cast(v4i_t, acc[ai][0][m][n]), ui = __builtin_bit_cast(v4i_t, acc[ai][1][m][n]);
#pragma unroll
                    for (int j = 0; j < 4; ++j) { const float g = (float)gi[j] * s0; h[n * 4 + j] = g * __builtin_amdgcn_rcpf(1.f + __expf(-g)) * ((float)ui[j] * s1); } }
                u32x4 w; w.x = cvt_pk_bf16(h[0], h[1]); w.y = cvt_pk_bf16(h[2], h[3]); w.z = cvt_pk_bf16(h[4], h[5]); w.w = cvt_pk_bf16(h[6], h[7]);
                *(u32x4*)(H + (size_t)(row0 + ai * HALF + m * 16) * FF + col0) = w; }
    } };
struct EpiDown { static constexpr bool PERM = true; bf16_t* Y; const int* row_tok; const int* row_slot; const float* row_gate;
    __device__ __forceinline__ void operator()(const f32x4 (&acc)[2][2][4][2], const Unit& u, int wr, int wc, int fr, int fq) const {
        const int row0 = u.pm * BM + wr * 64 + fr, col0 = u.pn * BM + wc * 32 + 8 * fq;
        int tk[8], sl[8]; float gt[8];
#pragma unroll
        for (int q = 0; q < 8; ++q) { const int r = row0 + (q >> 2) * HALF + (q & 3) * 16; tk[q] = row_tok[r]; sl[q] = row_slot[r]; gt[q] = row_gate[r]; }
#pragma unroll
        for (int ai = 0; ai < 2; ++ai)
#pragma unroll
            for (int m = 0; m < 4; ++m) { const int q = ai * 4 + m;
                if (tk[q] < 0) continue;
                bf16_t* rowp = Y + (size_t)sl[q] * DM + col0;
#pragma unroll
                for (int bj = 0; bj < 2; ++bj) { const f32x4 v0 = acc[ai][bj][m][0] * gt[q], v1 = acc[ai][bj][m][1] * gt[q];
                    u32x4 w; w.x = cvt_pk_bf16(v0[0], v0[1]); w.y = cvt_pk_bf16(v0[2], v0[3]); w.z = cvt_pk_bf16(v1[0], v1[1]); w.w = cvt_pk_bf16(v1[2], v1[3]);
                    *(u32x4*)(rowp + bj * HALF) = w; } }
    } };

template <class Epi, class Sched, bool I8 = false>
__device__ __forceinline__ void gemm_phase(LAS unsigned char* lds, const char* A, const unsigned lda_b, const int K, const Sched& S, const Epi& E) {
    const int tid = threadIdx.x, wid = __builtin_amdgcn_readfirstlane(tid >> 6), lane = tid & 63, wr = wid >> 2, wc = wid & 3, fr = lane & 15, fq = lane >> 4;
    const int nt = K / BK;
    unsigned voffB[2];
#pragma unroll
    for (int i = 0; i < 2; ++i) { int R, C; stage_rc(tid * 16 + i * 8192, R, C); const int Rb = Epi::PERM ? ((R & ~31) + perm32(R & 31)) : R; voffB[i] = (unsigned)(Rb * K + C) * 2u; }
    const size_t kstep = (size_t)(BK * 2);
    const size_t hstepB = (size_t)HALF * K * 2;
    const unsigned ldsw = (unsigned)wid * 1024u;
    const int aoff = lds_byte(wr * 64 + fr, fq * 8), boff = lds_byte(wc * 32 + fr, fq * 8);
#define PG8_SA(b, h) (((b) * 2 + (h)) * HTB)
#define PG8_SB(b, h) ((4 + (b) * 2 + (h)) * HTB)
#define PG8_STAGE(bufoff, gbase, voff) do { _Pragma("unroll") for (int _i = 0; _i < 2; ++_i) \
        __builtin_amdgcn_global_load_lds((const unsigned*)((const char*)(gbase) + (voff)[_i]), (LAS unsigned*)(lds + (bufoff) + ldsw + _i * 8192), 16, 0, 0); } while (0)
#define PG8_LDA(dst, b, h) do { _Pragma("unroll") for (int m = 0; m < 4; ++m) _Pragma("unroll") for (int k = 0; k < 2; ++k) dst[m][k] = *(const LAS bf16x8*)(lds + PG8_SA(b, h) + aoff + m * 2048 + k * 1024); } while (0)
#define PG8_LDB(dst, b, h) do { _Pragma("unroll") for (int n = 0; n < 2; ++n) _Pragma("unroll") for (int k = 0; k < 2; ++k) dst[n][k] = *(const LAS bf16x8*)(lds + PG8_SB(b, h) + boff + n * 2048 + k * 1024); } while (0)
#define PG8_MMA(ai, bj, At, Bt) do { __builtin_amdgcn_s_setprio(1); _Pragma("unroll") for (int m = 0; m < 4; ++m) _Pragma("unroll") for (int n = 0; n < 2; ++n) _Pragma("unroll") for (int k = 0; k < 2; ++k) { \
        if constexpr (I8) acc[ai][bj][m][n] = __builtin_bit_cast(f32x4, __builtin_amdgcn_mfma_i32_16x16x64_i8(__builtin_bit_cast(v4i_t, Bt[n][k]), __builtin_bit_cast(v4i_t, At[m][k]), __builtin_bit_cast(v4i_t, acc[ai][bj][m][n]), 0, 0, 0)); \
        else acc[ai][bj][m][n] = __builtin_amdgcn_mfma_f32_16x16x32_bf16(Bt[n][k], At[m][k], acc[ai][bj][m][n], 0, 0, 0); } __builtin_amdgcn_s_setprio(0); } while (0)
#define PG8_WAIT_V(n) asm volatile("s_waitcnt vmcnt(" #n ")" ::: "memory")
#define PG8_WAIT_L(n) asm volatile("s_waitcnt lgkmcnt(" #n ")" ::: "memory")
#define PG8_BAR __builtin_amdgcn_s_barrier()
#define PG8_SCHED __builtin_amdgcn_sched_barrier(0)
#define PG8_AOFF(dst, u) do { int _tz = threadIdx.x; asm volatile("" : "+v"(_tz)); _Pragma("unroll") for (int _i = 0; _i < 2; ++_i) { int _R, _C; stage_rc(_tz * 16 + _i * 8192, _R, _C); \
        _Pragma("unroll") for (int _h = 0; _h < 2; ++_h) dst[_h][_i] = (unsigned)S.arow(u, _h * HALF + _R) * lda_b + (unsigned)_C * 2u; } } while (0)
    Unit cur, nxt; int ui = 0;
    if (!S.next(0, cur)) return;
    f32x4 acc[2][2][4][2];
#pragma unroll
    for (int a = 0; a < 2; ++a)
#pragma unroll
        for (int b = 0; b < 2; ++b)
#pragma unroll
            for (int m = 0; m < 4; ++m)
#pragma unroll
                for (int n = 0; n < 2; ++n) acc[a][b][m][n] = (f32x4){0.f, 0.f, 0.f, 0.f};
    bf16x8 At[4][2], B0[2][2], B1[2][2];
    unsigned vA[2][2], vAn[2][2];
    PG8_AOFF(vA, cur);
    const char* cB = cur.B;
    PG8_STAGE(PG8_SB(0, 0), cB, voffB); PG8_STAGE(PG8_SA(0, 0), A, vA[0]); PG8_STAGE(PG8_SB(0, 1), cB + hstepB, voffB); PG8_STAGE(PG8_SA(0, 1), A, vA[1]);
    if (wr == 1) PG8_BAR;
    PG8_WAIT_V(4); PG8_BAR;
    PG8_STAGE(PG8_SB(1, 0), cB + kstep, voffB); PG8_STAGE(PG8_SA(1, 0), A + kstep, vA[0]); PG8_STAGE(PG8_SB(1, 1), cB + hstepB + kstep, voffB);
    PG8_WAIT_V(6); PG8_BAR;
    for (;;) {
        const bool has_next = S.next(ui + 1, nxt);
        if (has_next) { PG8_AOFF(vAn, nxt); } else {
#pragma unroll
            for (int h = 0; h < 2; ++h)
#pragma unroll
                for (int i = 0; i < 2; ++i) vAn[h][i] = vA[h][i]; }
        const char* nB = has_next ? nxt.B : cB;
        for (int t = 0; t < nt; t += 2) {
            const bool last = (t == nt - 2);
            const char* a1 = A + (size_t)(t + 1) * kstep;
            const char* a2 = last ? A : A + (size_t)(t + 2) * kstep; const char* b2 = last ? nB : cB + (size_t)(t + 2) * kstep;
            const char* a3 = a2 + kstep; const char* b3 = b2 + kstep;
            unsigned o2[2][2];
#pragma unroll
            for (int h = 0; h < 2; ++h)
#pragma unroll
                for (int i = 0; i < 2; ++i) o2[h][i] = last ? vAn[h][i] : vA[h][i];
            PG8_LDB(B0, 0, 0); PG8_SCHED; PG8_LDA(At, 0, 0); PG8_STAGE(PG8_SA(1, 1), a1, vA[1]);
            PG8_WAIT_L(8); PG8_BAR; PG8_WAIT_L(0); PG8_MMA(0, 0, At, B0); PG8_BAR; PG8_SCHED;
            PG8_LDB(B1, 0, 1); PG8_STAGE(PG8_SB(0, 0), b2, voffB);
            PG8_BAR; PG8_WAIT_L(0); PG8_MMA(0, 1, At, B1); PG8_BAR;
            PG8_LDA(At, 0, 1); PG8_STAGE(PG8_SA(0, 0), a2, o2[0]);
            PG8_BAR; PG8_WAIT_L(0); PG8_MMA(1, 0, At, B0); PG8_BAR; PG8_SCHED;
            PG8_STAGE(PG8_SB(0, 1), b2 + hstepB, voffB);
            PG8_WAIT_V(6); PG8_BAR; PG8_MMA(1, 1, At, B1); PG8_BAR;
            PG8_LDB(B0, 1, 0); PG8_SCHED; PG8_LDA(At, 1, 0); PG8_STAGE(PG8_SA(0, 1), a2, o2[1]);
            PG8_WAIT_L(8); PG8_BAR; PG8_WAIT_L(0); PG8_MMA(0, 0, At, B0); PG8_BAR; PG8_SCHED;
            PG8_LDB(B1, 1, 1); PG8_STAGE(PG8_SB(1, 0), b3, voffB);
            PG8_BAR; PG8_WAIT_L(0); PG8_MMA(0, 1, At, B1); PG8_BAR;
            PG8_LDA(At, 1, 1); PG8_STAGE(PG8_SA(1, 0), a3, o2[0]);
            PG8_BAR; PG8_WAIT_L(0); PG8_MMA(1, 0, At, B0); PG8_BAR; PG8_SCHED;
            PG8_STAGE(PG8_SB(1, 1), b3 + hstepB, voffB);
            PG8_WAIT_V(6); PG8_BAR; PG8_MMA(1, 1, At, B1); PG8_BAR;
        }
        E(acc, cur, wr, wc, fr, fq);
        if (!has_next) break;
#pragma unroll
        for (int a = 0; a < 2; ++a)
#pragma unroll
            for (int b = 0; b < 2; ++b)
#pragma unroll
                for (int m = 0; m < 4; ++m)
#pragma unroll
                    for (int n = 0; n < 2; ++n) acc[a][b][m][n] = (f32x4){0.f, 0.f, 0.f, 0.f};
        cur = nxt; cB = nB; ++ui;
#pragma unroll
        for (int h = 0; h < 2; ++h)
#pragma unroll
            for (int i = 0; i < 2; ++i) vA[h][i] = vAn[h][i];
    }
    PG8_WAIT_V(0);
    if (wr == 0) PG8_BAR;
    PG8_BAR;
#undef PG8_SA
#undef PG8_SB
#undef PG8_STAGE
#undef PG8_LDA
#undef PG8_LDB
#undef PG8_MMA
#undef PG8_WAIT_V
#undef PG8_WAIT_L
#undef PG8_BAR
#undef PG8_SCHED
#undef PG8_AOFF
}
}

template <int MODE>
__device__ __forceinline__ void transpose_item(const float* W, int K, int N, bf16_t* WT, LAS float* scr, int item, int lane) {
    const int nblk = N / 64, kb = item / nblk, nb = item % nblk, k0 = 64 * kb, n0 = 64 * nb;
    const int lr = lane >> 4, lc = (lane & 15) * 4;
    float4 v[16];
#pragma unroll
    for (int i = 0; i < 16; ++i) v[i] = *(const float4*)(W + (size_t)(k0 + 4 * i + lr) * N + n0 + lc);
#pragma unroll
    for (int i = 0; i < 16; ++i) { LAS float* d = scr + (4 * i + lr) * 66 + lc; *(LAS f32x2_hw*)d = (f32x2_hw){v[i].x, v[i].y}; *(LAS f32x2_hw*)(d + 2) = (f32x2_hw){v[i].z, v[i].w}; }
    asm volatile("s_waitcnt lgkmcnt(0)" ::: "memory");
    const int c = lane & 7;
#pragma unroll
    for (int j = 0; j < 8; ++j) { const int n = (lane >> 3) + 8 * j; const LAS float* sp = scr + (8 * c) * 66 + n;
        pg8::u32x4 o; o.x = pk2(sp[0 * 66], sp[1 * 66]); o.y = pk2(sp[2 * 66], sp[3 * 66]); o.z = pk2(sp[4 * 66], sp[5 * 66]); o.w = pk2(sp[6 * 66], sp[7 * 66]);
        const int nn = n0 + n; const int dr = MODE == 0 ? nn : (256 * (nn >> 7) + (nn & 127) + (MODE == 2 ? 128 : 0));
        *(pg8::u32x4*)(WT + (size_t)dr * K + k0 + 8 * c) = o; }
    asm volatile("s_waitcnt lgkmcnt(0)" ::: "memory");
}
__device__ __forceinline__ float wave_max(float v) {
    v = fmaxf(v, dpp_<0xB1>(v)); v = fmaxf(v, dpp_<0x4E>(v)); v = fmaxf(v, dpp_<0x124>(v)); v = fmaxf(v, dpp_<0x128>(v));
    auto s = __builtin_amdgcn_permlane16_swap(__float_as_uint(v), __float_as_uint(v), false, false); v = fmaxf(__uint_as_float(s[0]), __uint_as_float(s[1]));
    auto t = __builtin_amdgcn_permlane32_swap(__float_as_uint(v), __float_as_uint(v), false, false); return fmaxf(__uint_as_float(t[0]), __uint_as_float(t[1])); }
__device__ __forceinline__ unsigned q8x4(float a, float b, float c, float d, float qs) {
    const int ia = (int)rintf(fminf(fmaxf(a * qs, -127.f), 127.f)), ib = (int)rintf(fminf(fmaxf(b * qs, -127.f), 127.f)), ic = (int)rintf(fminf(fmaxf(c * qs, -127.f), 127.f)), id = (int)rintf(fminf(fmaxf(d * qs, -127.f), 127.f));
    return (unsigned)(ia & 255) | ((unsigned)(ib & 255) << 8) | ((unsigned)(ic & 255) << 16) | ((unsigned)(id & 255) << 24); }
__device__ __noinline__ void ph_wmax(const float* wg, const float* wu, unsigned* wmax, int bid, int nblk) {
    const int wave = threadIdx.x >> 6, lane = threadIdx.x & 63, gw = bid * 8 + wave, NGW = nblk * 8;
    constexpr int IT = (DM / 64) * (FF / 64);
    for (int it = gw; it < 2 * NEXP * 2 * IT; it += NGW) { const int mat = it / IT, tl = it % IT; const int le = mat >> 1, gu = mat & 1;
        const float* W = (gu ? wu : wg) + (size_t)le * DM * FF; const int k0 = 64 * (tl / (FF / 64)), n0 = 64 * (tl % (FF / 64));
        float m = 0.f;
#pragma unroll 4
        for (int i = 0; i < 16; ++i) { const float4 v = *(const float4*)(W + (size_t)(k0 + 4 * i + (lane >> 4)) * FF + n0 + (lane & 15) * 4); m = fmaxf(fmaxf(m, fmaxf(fabsf(v.x), fabsf(v.y))), fmaxf(fabsf(v.z), fabsf(v.w))); }
        m = wave_max(m);
        if (lane == 0) atomicMax(wmax + le * 2 + gu, __float_as_uint(m)); }
}
template <int MODE>
__device__ __forceinline__ void transpose_item_i8(const float* W, int K, int N, unsigned char* WT, LAS float* scr, int item, int lane, float qs) {
    const int nblk = N / 64, kb = item / nblk, nb = item % nblk, k0 = 64 * kb, n0 = 64 * nb;
    const int lr = lane >> 4, lc = (lane & 15) * 4;
    float4 v[16];
#pragma unroll
    for (int i = 0; i < 16; ++i) v[i] = *(const float4*)(W + (size_t)(k0 + 4 * i + lr) * N + n0 + lc);
#pragma unroll
    for (int i = 0; i < 16; ++i) { LAS float* d = scr + (4 * i + lr) * 66 + lc; *(LAS f32x2_hw*)d = (f32x2_hw){v[i].x, v[i].y}; *(LAS f32x2_hw*)(d + 2) = (f32x2_hw){v[i].z, v[i].w}; }
    asm volatile("s_waitcnt lgkmcnt(0)" ::: "memory");
    const int c = lane & 3;
#pragma unroll
    for (int j = 0; j < 4; ++j) { const int n = (lane >> 2) + 16 * j; const LAS float* sp = scr + (16 * c) * 66 + n;
        pg8::u32x4 o;
        o.x = q8x4(sp[0 * 66], sp[1 * 66], sp[2 * 66], sp[3 * 66], qs); o.y = q8x4(sp[4 * 66], sp[5 * 66], sp[6 * 66], sp[7 * 66], qs);
        o.z = q8x4(sp[8 * 66], sp[9 * 66], sp[10 * 66], sp[11 * 66], qs); o.w = q8x4(sp[12 * 66], sp[13 * 66], sp[14 * 66], sp[15 * 66], qs);
        const int nn = n0 + n; const int dr = MODE == 0 ? nn : (256 * (nn >> 7) + (nn & 127) + (MODE == 2 ? 128 : 0));
        *(pg8::u32x4*)(WT + (size_t)dr * K + k0 + 16 * c) = o; }
    asm volatile("s_waitcnt lgkmcnt(0)" ::: "memory");
}
__device__ __forceinline__ void transpose_item_i8c(const float* W, int K, int N, unsigned char* WT, LAS float* scr, int item, int lane, const unsigned* colmax) {
    const int nblk = N / 64, kb = item / nblk, nb = item % nblk, k0 = 64 * kb, n0 = 64 * nb;
    const int lr = lane >> 4, lc = (lane & 15) * 4;
    float4 v[16];
#pragma unroll
    for (int i = 0; i < 16; ++i) v[i] = *(const float4*)(W + (size_t)(k0 + 4 * i + lr) * N + n0 + lc);
#pragma unroll
    for (int i = 0; i < 16; ++i) { LAS float* d = scr + (4 * i + lr) * 66 + lc; *(LAS f32x2_hw*)d = (f32x2_hw){v[i].x, v[i].y}; *(LAS f32x2_hw*)(d + 2) = (f32x2_hw){v[i].z, v[i].w}; }
    asm volatile("s_waitcnt lgkmcnt(0)" ::: "memory");
    const int c = lane & 3;
#pragma unroll
    for (int j = 0; j < 4; ++j) { const int n = (lane >> 2) + 16 * j; const LAS float* sp = scr + (16 * c) * 66 + n;
        const float qs = 127.f / fmaxf(__uint_as_float(colmax[n0 + n]), 1e-30f);
        pg8::u32x4 o;
        o.x = q8x4(sp[0 * 66], sp[1 * 66], sp[2 * 66], sp[3 * 66], qs); o.y = q8x4(sp[4 * 66], sp[5 * 66], sp[6 * 66], sp[7 * 66], qs);
        o.z = q8x4(sp[8 * 66], sp[9 * 66], sp[10 * 66], sp[11 * 66], qs); o.w = q8x4(sp[12 * 66], sp[13 * 66], sp[14 * 66], sp[15 * 66], qs);
        *(pg8::u32x4*)(WT + (size_t)(n0 + n) * K + k0 + 16 * c) = o; }
    asm volatile("s_waitcnt lgkmcnt(0)" ::: "memory");
}
__device__ __forceinline__ void frag_build(const float* W, int ldw, int col0, int nks, bf16_t* dst, int lane) {
    const int q4 = lane >> 4, c16 = lane & 15;
    for (int ct = 0; ct < 4; ++ct) for (int ks = 0; ks < nks; ++ks) { float v[8];
#pragma unroll
        for (int jj = 0; jj < 8; ++jj) v[jj] = W[(size_t)(32 * ks + 8 * q4 + jj) * ldw + col0 + 16 * ct + c16];
        *(pg8::u32x4*)(dst + ((size_t)(ct * nks + ks) * 64 + lane) * 8) = (pg8::u32x4){pk2(v[0], v[1]), pk2(v[2], v[3]), pk2(v[4], v[5]), pk2(v[6], v[7])}; }
}
__device__ __forceinline__ void ph_cvt_frags(const Args& a) {
    const int wave = threadIdx.x >> 6, lane = threadIdx.x & 63, gw = blockIdx.x * 8 + wave;
    if (gw >= 40) {
        const int it = gw - 40; if (it >= 64) return;
        const int L = it >> 5, ks = it & 31, q4 = lane >> 4, c16 = lane & 15;
        const float* gain = a.in[2] + L * DM; const float* wg = a.in[28] + (size_t)L * DM * 4; const float* we = a.in[30] + (size_t)L * DM * 32;
        bf16_t* dh = (bf16_t*)(a.ws + FG_RT) + (size_t)L * 2 * 49152; bf16_t* dl = dh + 49152;
        for (int ct = 0; ct < 3; ++ct) { const int col = 16 * ct + c16; float hi[8], lo[8];
#pragma unroll
            for (int jj = 0; jj < 8; ++jj) { const int k = 32 * ks + 8 * q4 + jj; const float w = col < 4 ? wg[k * 4 + col] : (col < 36 ? we[k * 32 + col - 4] : 0.f); const float v = gain[k] * w;
                hi[jj] = bf2f(f2bf(v)); lo[jj] = v - hi[jj]; }
            const size_t o = ((size_t)(ks * 3 + ct) * 64 + lane) * 8;
            *(pg8::u32x4*)(dh + o) = (pg8::u32x4){pk2(hi[0], hi[1]), pk2(hi[2], hi[3]), pk2(hi[4], hi[5]), pk2(hi[6], hi[7])};
            *(pg8::u32x4*)(dl + o) = (pg8::u32x4){pk2(lo[0], lo[1]), pk2(lo[2], lo[3]), pk2(lo[4], lo[5]), pk2(lo[6], lo[7])}; }
        return; }
    const int arr = gw >> 3, h = gw & 7;
    if (arr == 0) frag_build(a.in[7], 512, 64 * h, 2, (bf16_t*)(a.ws + FG_W2) + h * 4096, lane);
    else if (arr == 1) frag_build(a.in[9], 512, 64 * h, 2, (bf16_t*)(a.ws + FG_A2) + h * 4096, lane);
    else if (arr == 2) frag_build(a.in[18] + h * 4096, 64, 0, 2, (bf16_t*)(a.ws + FG_WA) + h * 4096, lane);
    else if (arr == 3) frag_build(a.in[20] + h * 4096, 64, 0, 2, (bf16_t*)(a.ws + FG_WX) + h * 4096, lane);
    else frag_build(a.in[10], 512, 64 * h, 4, (bf16_t*)(a.ws + FG_G2) + h * 8192, lane);
}
__device__ __forceinline__ void ph_cvt_dense_a(const Args& a, LAS float* lds, unsigned* colmax) {
    const int wave = threadIdx.x >> 6, lane = threadIdx.x & 63, gw = blockIdx.x * 8 + wave, NGW = gridDim.x * 8;
    LAS float* scr = lds + wave * (64 * 66);
    constexpr int I0 = (DM / 64) * (ABC / 64), I1 = (DM / 64) * (DM / 64), I2 = (DM / 64) * (4096 / 64), I3 = I1;
    for (int it = gw; it < I0 + I1 + I2 + I3; it += NGW) { int r = it;
        if (r < I1) { transpose_item<0>(a.in[23], DM, DM, (bf16_t*)(a.ws + WD_ABOUT), scr, r, lane); continue; } r -= I1;
        if (r < I3) { transpose_item<0>(a.in[27], DM, DM, (bf16_t*)(a.ws + WD_COUT), scr, r, lane); continue; } r -= I3;
        const int m = r < I0 ? 0 : 1; if (m) r -= I0; const int N = m ? 4096 : ABC; const float* W = m ? a.in[24] : a.in[4];
        const int k0 = 64 * (r / (N / 64)), n0 = 64 * (r % (N / 64)); float mx[4] = {0.f, 0.f, 0.f, 0.f};
#pragma unroll 4
        for (int i = 0; i < 16; ++i) { const float4 v = *(const float4*)(W + (size_t)(k0 + 4 * i + (lane >> 4)) * N + n0 + (lane & 15) * 4);
            mx[0] = fmaxf(mx[0], fabsf(v.x)); mx[1] = fmaxf(mx[1], fabsf(v.y)); mx[2] = fmaxf(mx[2], fabsf(v.z)); mx[3] = fmaxf(mx[3], fabsf(v.w)); }
#pragma unroll
        for (int q = 0; q < 4; ++q) { float t = mx[q];
            auto s1 = __builtin_amdgcn_permlane16_swap(__float_as_uint(t), __float_as_uint(t), false, false); t = fmaxf(__uint_as_float(s1[0]), __uint_as_float(s1[1]));
            auto s2 = __builtin_amdgcn_permlane32_swap(__float_as_uint(t), __float_as_uint(t), false, false); t = fmaxf(__uint_as_float(s2[0]), __uint_as_float(s2[1]));
            if (lane < 16) atomicMax(colmax + (m ? ABC : 0) + n0 + lane * 4 + q, __float_as_uint(t)); } }
}
__device__ __forceinline__ void ph_cvt_dense_b(const Args& a, LAS float* lds, const unsigned* colmax, int m) {
    const int wave = threadIdx.x >> 6, lane = threadIdx.x & 63, gw = blockIdx.x * 8 + wave, NGW = gridDim.x * 8;
    LAS float* scr = lds + wave * (64 * 66);
    const int N = m ? 4096 : ABC; const int NI = (DM / 64) * (N / 64);
    for (int it = gw; it < NI; it += NGW) transpose_item_i8c(m ? a.in[24] : a.in[4], DM, N, a.ws + (m ? WD_CIN : WD_ABIN), scr, it, lane, colmax + (m ? ABC : 0));
}
__device__ __forceinline__ void ph_cvt_moe(const Args& a, int L, LAS float* lds, int bid, int nblk, int which) {
    const int wave = threadIdx.x >> 6, lane = threadIdx.x & 63, gw = bid * 8 + wave, NGW = nblk * 8;
    LAS float* scr = lds + wave * (64 * 66);
    constexpr int IG = (DM / 64) * (FF / 64), ID = (FF / 64) * (DM / 64);
    const int i0 = (which & 1) ? 0 : 2 * IG, IE = ((which & 1) ? 2 * IG : 0) + ((which & 2) ? ID : 0);
    unsigned char* gub = a.ws + (L ? WM_GU1 : WM_GU);
    for (int it = gw; it < NEXP * IE; it += NGW) { const int e = it / IE; int r = i0 + it % IE;
        unsigned char* gu = gub + (size_t)e * DM * DM; bf16_t* dn = (bf16_t*)(a.ws + WM_DN) + (size_t)e * DM * FF;
        const unsigned* wm = (const unsigned*)(a.ws + WS_CTL) + CW_WMAX + (L * NEXP + e) * 2;
        const size_t wo = ((size_t)L * NEXP + e) * DM * FF;
        if (r < IG) { transpose_item_i8<1>(a.in[32] + wo, DM, FF, gu, scr, r, lane, 127.f / fmaxf(__uint_as_float(wm[0]), 1e-30f)); continue; } r -= IG;
        if (r < IG) { transpose_item_i8<2>(a.in[33] + wo, DM, FF, gu, scr, r, lane, 127.f / fmaxf(__uint_as_float(wm[1]), 1e-30f)); continue; } r -= IG;
        transpose_item<0>(a.in[34] + wo, FF, DM, dn, scr, r, lane); }
}

__device__ __forceinline__ void load_row16(const float* row, int lane, float4 (&v)[4]) {
#pragma unroll
    for (int j = 0; j < 4; ++j) v[j] = *(const float4*)(row + lane * 4 + 256 * j);
}
__device__ __forceinline__ float row_sumsq(const float4 (&v)[4]) {
    float s = 0.f;
#pragma unroll
    for (int j = 0; j < 4; ++j) s += v[j].x * v[j].x + v[j].y * v[j].y + v[j].z * v[j].z + v[j].w * v[j].w;
    return wave_sum(s);
}
__device__ __forceinline__ void norm_row(float4 (&v)[4], const float* gain, int lane) {
    const float rs = rsqrtf(row_sumsq(v) * (1.f / DM) + 1e-6f);
#pragma unroll
    for (int j = 0; j < 4; ++j) { const float4 g = *(const float4*)(gain + lane * 4 + 256 * j);
        v[j].x *= rs * g.x; v[j].y *= rs * g.y; v[j].z *= rs * g.z; v[j].w *= rs * g.w; }
}
__device__ __forceinline__ void store_row_bf16(bf16_t* row, int lane, const float4 (&v)[4]) {
#pragma unroll
    for (int j = 0; j < 4; ++j) { uint2 o; o.x = f2bf(v[j].x) | ((unsigned)f2bf(v[j].y) << 16); o.y = f2bf(v[j].z) | ((unsigned)f2bf(v[j].w) << 16);
        *(uint2*)(row + lane * 4 + 256 * j) = o; }
}
__device__ __forceinline__ void add_row_bf16(const bf16_t* row, int lane, float4 (&v)[4]) {
#pragma unroll
    for (int j = 0; j < 4; ++j) { const uint2 o = *(const uint2*)(row + lane * 4 + 256 * j);
        v[j].x += __uint_as_float(o.x << 16); v[j].y += __uint_as_float(o.x & 0xffff0000u); v[j].z += __uint_as_float(o.y << 16); v[j].w += __uint_as_float(o.y & 0xffff0000u); }
}

__device__ __forceinline__ void ph_norm0(const float* x, const float* gain, unsigned char* HN8, float* rowscale) {
    const int lane = threadIdx.x & 63, gw = blockIdx.x * 8 + (threadIdx.x >> 6), NGW = gridDim.x * 8;
    for (int n = gw; n < NTOK; n += NGW) { float4 v[4]; load_row16(x + (size_t)n * DM, lane, v); norm_row(v, gain, lane);
        float mx = 0.f;
#pragma unroll
        for (int j = 0; j < 4; ++j) mx = fmaxf(fmaxf(mx, fmaxf(fabsf(v[j].x), fabsf(v[j].y))), fmaxf(fabsf(v[j].z), fabsf(v[j].w)));
        mx = fmaxf(wave_max(mx), 1e-30f); const float qs = 127.f / mx;
        if (lane == 0) rowscale[n] = mx;
#pragma unroll
        for (int j = 0; j < 4; ++j) *(unsigned*)(HN8 + (size_t)n * DM + lane * 4 + 256 * j) = q8x4(v[j].x, v[j].y, v[j].z, v[j].w, qs); }
}
__device__ __forceinline__ void ld8bf(const bf16_t* p, float (&v)[8]) { const u32x4_t o = *(const u32x4_t*)p;
    v[0] = __uint_as_float(o.x << 16); v[1] = __uint_as_float(o.x & 0xffff0000u); v[2] = __uint_as_float(o.y << 16); v[3] = __uint_as_float(o.y & 0xffff0000u);
    v[4] = __uint_as_float(o.z << 16); v[5] = __uint_as_float(o.z & 0xffff0000u); v[6] = __uint_as_float(o.w << 16); v[7] = __uint_as_float(o.w & 0xffff0000u); }
__device__ __forceinline__ void st8bf(bf16_t* p, const float (&v)[8]) { *(u32x4_t*)p = (u32x4_t){pk2(v[0], v[1]), pk2(v[2], v[3]), pk2(v[4], v[5]), pk2(v[6], v[7])}; }
__device__ __forceinline__ void ph_combine_norm(bf16_t* XR, const bf16_t* Y, const float* gain, unsigned char* HN8, float* rowscale) {
    const int lane = threadIdx.x & 63, gw = blockIdx.x * 8 + (threadIdx.x >> 6), NGW = gridDim.x * 8;
    for (int n = gw; n < NTOK; n += NGW) { float x[2][8], y0[2][8], y1[2][8]; float ss = 0.f;
#pragma unroll
        for (int j = 0; j < 2; ++j) { const int o = lane * 8 + 512 * j; ld8bf(XR + (size_t)n * DM + o, x[j]); ld8bf(Y + (size_t)(2 * n) * DM + o, y0[j]); ld8bf(Y + (size_t)(2 * n + 1) * DM + o, y1[j]); }
#pragma unroll
        for (int j = 0; j < 2; ++j) {
#pragma unroll
            for (int i = 0; i < 8; ++i) x[j][i] = bf2f(f2bf(x[j][i] + y0[j][i] + y1[j][i]));
            st8bf(XR + (size_t)n * DM + lane * 8 + 512 * j, x[j]);
#pragma unroll
            for (int i = 0; i < 8; ++i) ss += x[j][i] * x[j][i]; }
        const float rs = rsqrtf(wave_sum(ss) * (1.f / DM) + 1e-6f);
#pragma unroll
        for (int j = 0; j < 2; ++j) { const int o = lane * 8 + 512 * j; const float4 g0 = *(const float4*)(gain + o), g1 = *(const float4*)(gain + o + 4);
            const float gg[8] = {g0.x, g0.y, g0.z, g0.w, g1.x, g1.y, g1.z, g1.w};
#pragma unroll
            for (int i = 0; i < 8; ++i) x[j][i] *= rs * gg[i]; }
        float mx = 0.f;
#pragma unroll
        for (int j = 0; j < 2; ++j)
#pragma unroll
            for (int i = 0; i < 8; ++i) mx = fmaxf(mx, fabsf(x[j][i]));
        mx = fmaxf(wave_max(mx), 1e-30f); const float qs = 127.f / mx;
        if (lane == 0) rowscale[n] = mx;
#pragma unroll
        for (int j = 0; j < 2; ++j) { const int o = lane * 8 + 512 * j;
            *(u32x2_t*)(HN8 + (size_t)n * DM + o) = (u32x2_t){q8x4(x[j][0], x[j][1], x[j][2], x[j][3], qs), q8x4(x[j][4], x[j][5], x[j][6], x[j][7], qs)}; } }
}
__device__ __forceinline__ void ph_final(const bf16_t* XR, const bf16_t* Y, const float* gain, float* out) {
    const int lane = threadIdx.x & 63, gw = blockIdx.x * 8 + (threadIdx.x >> 6), NGW = gridDim.x * 8;
    for (int n = gw; n < NTOK; n += NGW) { float x[2][8], y0[2][8], y1[2][8]; float ss = 0.f;
#pragma unroll
        for (int j = 0; j < 2; ++j) { const int o = lane * 8 + 512 * j; ld8bf(XR + (size_t)n * DM + o, x[j]); ld8bf(Y + (size_t)(2 * n) * DM + o, y0[j]); ld8bf(Y + (size_t)(2 * n + 1) * DM + o, y1[j]); }
#pragma unroll
        for (int j = 0; j < 2; ++j)
#pragma unroll
            for (int i = 0; i < 8; ++i) { x[j][i] = x[j][i] + y0[j][i] + y1[j][i]; ss += x[j][i] * x[j][i]; }
        const float rs = rsqrtf(wave_sum(ss) * (1.f / DM) + 1e-6f);
#pragma unroll
        for (int j = 0; j < 2; ++j) { const int o = lane * 8 + 512 * j; const float4 g0 = *(const float4*)(gain + o), g1 = *(const float4*)(gain + o + 4);
            *(float4*)(out + (size_t)n * DM + o) = make_float4(x[j][0] * rs * g0.x, x[j][1] * rs * g0.y, x[j][2] * rs * g0.z, x[j][3] * rs * g0.w);
            *(float4*)(out + (size_t)n * DM + o + 4) = make_float4(x[j][4] * rs * g1.x, x[j][5] * rs * g1.y, x[j][6] * rs * g1.z, x[j][7] * rs * g1.w); } }
}
__device__ __forceinline__ void ph_route(const Args& a, int Lyr, const bf16_t* XR, bf16_t* HN, float* RS, unsigned* cnt, int* asg_e, int* asg_rank, float* asg_gate, LAS float* lds) {
    const float* gain = a.in[2] + Lyr * DM; const float* bg = a.in[29] + Lyr * 4; const float* be = a.in[31] + Lyr * 32;
    const bf16_t* FRh = (const bf16_t*)(a.ws + FG_RT) + (size_t)Lyr * 2 * 49152; const bf16_t* FRl = FRh + 49152;
    const int lane = threadIdx.x & 63, wave = threadIdx.x >> 6, q4 = lane >> 4, c16 = lane & 15, r4 = lane >> 4, cidx = lane & 15;
    LAS unsigned char* Lb = (LAS unsigned char*)lds;
    LAS unsigned char* W = Lb + wave * 12288;
    LAS float* SS = (LAS float*)(W + 8704); LAS float* LG = (LAS float*)(W + 8768);
    LAS unsigned* lcnt = (LAS unsigned*)(Lb + 8 * 12288); LAS unsigned* lbase = lcnt + 32;
    const int NGW = gridDim.x * 8, gw = blockIdx.x * 8 + wave;
    for (int rnd = 0; rnd * NGW < NTOK / 16; ++rnd) {
        const int tile = rnd * NGW + gw; const bool act = tile < NTOK / 16; const int n0 = tile * 16;
        if (threadIdx.x < 32) lcnt[threadIdx.x] = 0u;
        __syncthreads();
        int e0 = 0, e1 = 0, lr0 = 0, lr1 = 0; float g0 = 0.f, g1 = 0.f;
        if (act) {
            f32x4 acc[3], accs = (f32x4){0.f, 0.f, 0.f, 0.f};
#pragma unroll
            for (int ct = 0; ct < 3; ++ct) acc[ct] = accs;
#pragma unroll 1
            for (int kc = 0; kc < 8; ++kc) {
                bf16x8_t bh[4][3], bl[4][3];
#pragma unroll
                for (int ks = 0; ks < 4; ++ks)
#pragma unroll
                    for (int ct = 0; ct < 3; ++ct) { const size_t o = ((size_t)((kc * 4 + ks) * 3 + ct) * 64 + lane) * 8; bh[ks][ct] = *(const bf16x8_t*)(FRh + o); bl[ks][ct] = *(const bf16x8_t*)(FRl + o); }
                u32x4_t xv[4];
#pragma unroll
                for (int j = 0; j < 4; ++j) xv[j] = *(const u32x4_t*)(XR + (size_t)(n0 + 4 * j + r4) * DM + kc * 128 + 8 * cidx);
                __builtin_amdgcn_sched_barrier(0);
#pragma unroll
                for (int j = 0; j < 4; ++j) *(LAS u32x4_t*)(W + (4 * j + r4) * 272 + cidx * 16) = xv[j];
#pragma unroll
                for (int ks = 0; ks < 4; ++ks) { const bf16x8_t ahi = *(const LAS bf16x8_t*)(W + c16 * 272 + ks * 64 + q4 * 16);
                    accs = __builtin_amdgcn_mfma_f32_16x16x32_bf16(ahi, ahi, accs, 0, 0, 0);
#pragma unroll
                    for (int ct = 0; ct < 3; ++ct) { acc[ct] = __builtin_amdgcn_mfma_f32_16x16x32_bf16(ahi, bh[ks][ct], acc[ct], 0, 0, 0); acc[ct] = __builtin_amdgcn_mfma_f32_16x16x32_bf16(ahi, bl[ks][ct], acc[ct], 0, 0, 0); } }
            }
#pragma unroll
            for (int r = 0; r < 4; ++r) if (c16 == 4 * q4 + r) { const float rsv = rsqrtf(accs[r] * (1.f / DM) + 1e-6f); SS[c16] = rsv; RS[n0 + c16] = rsv; }
            const f32x4 s4 = *(const LAS f32x4*)(SS + 4 * q4);
#pragma unroll
            for (int ct = 0; ct < 3; ++ct) { const int col = 16 * ct + c16; const float bias = col < 4 ? bg[col] : (col < 36 ? be[col - 4] : 0.f);
#pragma unroll
                for (int r = 0; r < 4; ++r) LG[(4 * q4 + r) * 48 + col] = acc[ct][r] * s4[r] + bias; }
            if (lane < 16) {
                const LAS float* lg = LG + lane * 48;
                int gs = 0; float gm = lg[0];
#pragma unroll
                for (int i = 1; i < 4; ++i) { const float v = lg[i]; if (v > gm) { gm = v; gs = i; } }
                float gden = 0.f;
#pragma unroll
                for (int i = 0; i < 4; ++i) gden += __expf(lg[i] - gm);
                const float ggate = 1.f / gden;
                const LAS float* l8 = lg + 4 + gs * 8;
                int i0 = 0; float m0 = l8[0];
#pragma unroll
                for (int i = 1; i < 8; ++i) { const float v = l8[i]; if (v > m0) { m0 = v; i0 = i; } }
                int i1 = (i0 == 0) ? 1 : 0; float m1 = l8[i1];
#pragma unroll
                for (int i = 0; i < 8; ++i) { const float v = l8[i]; if (i != i0 && v > m1) { m1 = v; i1 = i; } }
                const float ex = __expf(m1 - m0);
                g0 = ggate / (1.f + ex); g1 = ggate * ex / (1.f + ex);
                e0 = gs * 8 + i0; e1 = gs * 8 + i1;
                lr0 = (int)__hip_atomic_fetch_add(lcnt + e0, 1u, __ATOMIC_RELAXED, __HIP_MEMORY_SCOPE_WORKGROUP); lr1 = (int)__hip_atomic_fetch_add(lcnt + e1, 1u, __ATOMIC_RELAXED, __HIP_MEMORY_SCOPE_WORKGROUP);
            }
        }
        __syncthreads();
        if (threadIdx.x < 32) { const unsigned c = lcnt[threadIdx.x]; lbase[threadIdx.x] = c ? atomicAdd(&cnt[threadIdx.x], c) : 0u; }
        __syncthreads();
        if (act) {
            if (lane < 16) { const int n = n0 + lane;
                asg_e[2 * n] = e0; asg_e[2 * n + 1] = e1; asg_rank[2 * n] = (int)lbase[e0] + lr0; asg_rank[2 * n + 1] = (int)lbase[e1] + lr1; asg_gate[2 * n] = g0; asg_gate[2 * n + 1] = g1; }
            unsigned char* H8 = (unsigned char*)HN;
            float rsr[4];
#pragma unroll
            for (int j = 0; j < 4; ++j) rsr[j] = SS[4 * j + r4] * ACT_Q;
#pragma unroll 2
            for (int kc = 0; kc < 8; ++kc) { const float4 gn0 = *(const float4*)(gain + kc * 128 + 8 * cidx), gn1 = *(const float4*)(gain + kc * 128 + 8 * cidx + 4);
                u32x4_t xv[4];
#pragma unroll
                for (int j = 0; j < 4; ++j) xv[j] = *(const u32x4_t*)(XR + (size_t)(n0 + 4 * j + r4) * DM + kc * 128 + 8 * cidx);
#pragma unroll
                for (int j = 0; j < 4; ++j) { const u32x4_t o = xv[j]; const float q = rsr[j];
                    *(u32x2_t*)(H8 + (size_t)(n0 + 4 * j + r4) * DM + kc * 128 + 8 * cidx) = (u32x2_t){
                        q8x4(__uint_as_float(o.x << 16) * gn0.x, __uint_as_float(o.x & 0xffff0000u) * gn0.y, __uint_as_float(o.y << 16) * gn0.z, __uint_as_float(o.y & 0xffff0000u) * gn0.w, q),
                        q8x4(__uint_as_float(o.z << 16) * gn1.x, __uint_as_float(o.z & 0xffff0000u) * gn1.y, __uint_as_float(o.w << 16) * gn1.z, __uint_as_float(o.w & 0xffff0000u) * gn1.w, q)}; } }
        }
        __syncthreads();
    }
}
__device__ __forceinline__ void moe_prefix(const unsigned* cnt, LAS int* pst) {
    if (threadIdx.x == 0) { int acc = 0; for (int e = 0; e < NEXP; ++e) { pst[e] = acc; const int c = (int)cnt[e]; acc += (c + MOE_TM - 1) / MOE_TM * MOE_TM; } pst[NEXP] = acc; }
    __syncthreads();
}
__device__ __forceinline__ void ph_dispatch(const unsigned* cnt, const int* asg_e, const int* asg_rank, const float* asg_gate, const float* RS, int* row_tok, int* row_slot, float* row_gate, float* row_rs, LAS int* pst, const unsigned* wmax, float* tscale) {
    moe_prefix(cnt, pst);
    for (int t = blockIdx.x * NTHREADS + threadIdx.x; t < pst[NEXP] / 256; t += gridDim.x * NTHREADS) { int e = 0;
        for (int k = 1; k < NEXP; ++k) if (t * 256 >= pst[k]) e = k;
        tscale[2 * t] = __uint_as_float(wmax[2 * e]) * (1.f / (127.f * ACT_Q)); tscale[2 * t + 1] = __uint_as_float(wmax[2 * e + 1]) * (1.f / (127.f * ACT_Q)); }
    for (int i = blockIdx.x * NTHREADS + threadIdx.x; i < NASG; i += gridDim.x * NTHREADS) {
        const int e = asg_e[i], d = pst[e] + asg_rank[i];
        row_tok[d] = i >> 1; row_slot[d] = i; row_gate[d] = asg_gate[i]; row_rs[d] = RS[i >> 1];
    }
    for (int e = blockIdx.x; e < NEXP; e += gridDim.x) {
        const int c = (int)cnt[e], lo = pst[e] + c, hi = pst[e + 1];
        for (int r = lo + threadIdx.x; r < hi; r += NTHREADS) { row_tok[r] = -1; row_slot[r] = 0; row_gate[r] = 0.f; row_rs[r] = 0.f; }
    }
    __syncthreads();
}
__device__ __forceinline__ int moe_tile_expert(const LAS int* pst, int row0) { int e = 0;
    for (int i = 1; i < NEXP; ++i) if (row0 >= pst[i]) e = i;
    return e; }

__device__ __forceinline__ float shiftcol(const bf16_t* P, int n, int t, int col, const float* mu) {
    const float cur = bf2f(P[(size_t)n * ABC + col]); const float prev = t > 0 ? bf2f(P[(size_t)(n - 1) * ABC + col]) : 0.f;
    return cur + (prev - cur) * mu[col];
}
constexpr int RW_WMF = 0, RW_RF = 2048, RW_BKF = 4096, RW_ARF = 8192, RW_U = 9216, RW_V = 11264, RW_G = 13312, RW_REC = 13568;
__device__ __forceinline__ float fast_sigmoid(float x) { return __builtin_amdgcn_rcpf(1.f + __expf(-x)); }
__device__ __forceinline__ float fast_softplus(float x) { return fmaxf(x, 0.f) + __logf(1.f + __expf(-fabsf(x))); }
__device__ __forceinline__ void tr_acc(LAS float* TBf, const f32x4 (&acc)[4], int lane, float (&out)[16]) {
    const int q4 = lane >> 4, c16 = lane & 15;
#pragma unroll
    for (int ct = 0; ct < 4; ++ct)
#pragma unroll
        for (int r = 0; r < 4; ++r) TBf[(16 * ct + 4 * q4 + r) * 20 + c16] = acc[ct][r];
#pragma unroll
    for (int j = 0; j < 4; ++j) { const f32x4 v = *(const LAS f32x4*)(TBf + lane * 20 + 4 * j); out[4 * j] = v[0]; out[4 * j + 1] = v[1]; out[4 * j + 2] = v[2]; out[4 * j + 3] = v[3]; }
}
__device__ __forceinline__ void ph_l0_prep(const Args& a, LAS float* lds) {
    const bf16_t* P = (const bf16_t*)(a.ws + WS_B);
    unsigned char* FR = a.ws + WS_C;
    bf16_t* Vb = (bf16_t*)a.out; float* Bon = (float*)((unsigned char*)a.out + 32 * MiB);
    bf16_t* LA = (bf16_t*)(a.ws + WS_A); bf16_t* U = LA + (size_t)NTOK * 512;
    const float* mu = a.in[5]; const float* w0 = a.in[6]; const float* a0 = a.in[8];
    const float* k_k = a.in[11]; const float* k_a = a.in[12]; const float* r_k = a.in[13];
    const float* conv_w = a.in[16]; const float* conv_b = a.in[17]; const float* b_a = a.in[19]; const float* b_x = a.in[21]; const float* lam = a.in[22];
    const int lane = threadIdx.x & 63, wave = threadIdx.x >> 6, q4 = lane >> 4, c16 = lane & 15;
    LAS unsigned char* W = (LAS unsigned char*)lds + wave * 15360;
    constexpr int KAP = 0, BT = 2304, KT = 4608, RT = 6912, BTT = 9216, KTT = 11264, AKB = 13312, AKK = 14336, RS = 144;
    constexpr int XS = 0, XS2 = 2304, TB = 4608;
    LAS float* TBf = (LAS float*)(W + TB);
    for (int u = blockIdx.x * 8 + wave; u < (NTOK / 16) * 8; u += gridDim.x * 8) {
        const int tile = u >> 3, h = u & 7, n0 = tile * 16, c = h * 64 + lane;
        const bool first = (n0 & (SEQ - 1)) == 0;
        const bf16_t* Pn = P + (size_t)n0 * ABC;
        float xb[19]; unsigned pwp[9], pap[9], qrp[9], qkp[9], qvp[9];
#pragma unroll
        for (int i = 0; i < 19; ++i) xb[i] = (first && i < 3) ? 0.f : bf2f(Pn[(long)(i - 3) * ABC + 2304 + c]);
#pragma unroll
        for (int i = 0; i < 18; ++i) { const bool z = (first && i == 0) || i == 17; const long ro = (long)(i - 1) * ABC;
            const unsigned vw = z ? 0u : (unsigned)Pn[ro + 1536 + lane], va = z ? 0u : (unsigned)Pn[ro + 1600 + lane];
            if (i & 1) { pwp[i >> 1] |= vw << 16; pap[i >> 1] |= va << 16; } else { pwp[i >> 1] = vw; pap[i >> 1] = va; } }
        asm volatile("" ::: "memory");
#define UNPK(arr, i) __uint_as_float(((i) & 1) ? ((arr)[(i) >> 1] & 0xffff0000u) : ((arr)[(i) >> 1] << 16))
        {
            bf16_t* SG = (bf16_t*)((unsigned char*)a.out + DO_SG);
#pragma unroll
            for (int i = 0; i < 4; ++i) { const int idx = lane * 4 + i, tk = idx >> 4, col = 1664 + 16 * h + (idx & 15);
                const float cur = bf2f(Pn[(long)tk * ABC + col]); const float prev = (first && tk == 0) ? 0.f : bf2f(Pn[(long)(tk - 1) * ABC + col]);
                SG[(size_t)(n0 + tk) * 128 + 16 * h + (idx & 15)] = f2bf(fast_sigmoid(cur + (prev - cur) * mu[col])); }
        }
        {
            const float cw0 = conv_w[c], cw1 = conv_w[512 + c], cw2 = conv_w[1024 + c], cw3 = conv_w[1536 + c], cb = conv_b[c];
            float xcv[16];
#pragma unroll
            for (int tk = 0; tk < 16; ++tk) { xcv[tk] = cb + cw0 * xb[tk] + cw1 * xb[tk + 1] + cw2 * xb[tk + 2] + cw3 * xb[tk + 3]; *(LAS bf16_t*)(W + XS + tk * RS + lane * 2) = f2bf(xcv[tk]); }
            f32x4 accr[4], acci[4];
            const bf16_t* FA = (const bf16_t*)(a.ws + FG_WA) + h * 4096; const bf16_t* FX = (const bf16_t*)(a.ws + FG_WX) + h * 4096;
            bf16x8_t xf[2];
#pragma unroll
            for (int ks = 0; ks < 2; ++ks) xf[ks] = *(const LAS bf16x8_t*)(W + XS + c16 * RS + ks * 64 + q4 * 16);
#pragma unroll
            for (int ct = 0; ct < 4; ++ct) { asm volatile("" ::: "memory"); accr[ct] = (f32x4){0.f, 0.f, 0.f, 0.f}; acci[ct] = accr[ct];
#pragma unroll
                for (int ks = 0; ks < 2; ++ks) { accr[ct] = __builtin_amdgcn_mfma_f32_16x16x32_bf16(*(const bf16x8_t*)(FA + ((ct * 2 + ks) * 64 + lane) * 8), xf[ks], accr[ct], 0, 0, 0);
                    acci[ct] = __builtin_amdgcn_mfma_f32_16x16x32_bf16(*(const bf16x8_t*)(FX + ((ct * 2 + ks) * 64 + lane) * 8), xf[ks], acci[ct], 0, 0, 0); } }
            float rp[16], ip[16];
            tr_acc(TBf, accr, lane, rp); tr_acc(TBf, acci, lane, ip);
            const float bac = b_a[c], bxc = b_x[c], sp = fast_softplus(-lam[c]);
            float hloc = 0.f, sla = 0.f;
#pragma unroll
            for (int tk = 0; tk < 16; ++tk) { const float r = fast_sigmoid(rp[tk] + bac), i = fast_sigmoid(ip[tk] + bxc);
                const float la = -8.f * r * sp; const float uu = __builtin_amdgcn_sqrtf(fmaxf(1.f - __expf(2.f * la), 0.f)) * i * xcv[tk];
                const bf16_t lab = f2bf(la), uub = f2bf(uu); const float lar = bf2f(lab);
                LA[(size_t)(n0 + tk) * 512 + c] = lab; U[(size_t)(n0 + tk) * 512 + c] = uub; hloc = __expf(lar) * hloc + bf2f(uub); sla += lar; }
            ((float*)((unsigned char*)a.out + DO_LRU))[(size_t)tile * 512 + c] = hloc; ((float*)((unsigned char*)a.out + DO_LRU))[(size_t)(2048 + tile) * 512 + c] = sla;
        }
        asm volatile("" ::: "memory");
#pragma unroll
        for (int i = 0; i < 18; ++i) { const bool z = (first && i == 0) || i == 17; const long ro = (long)(i - 1) * ABC;
            const unsigned vr = z ? 0u : (unsigned)Pn[ro + c], vk = z ? 0u : (unsigned)Pn[ro + 512 + c], vv = z ? 0u : (unsigned)Pn[ro + 1024 + c];
            if (i & 1) { qrp[i >> 1] |= vr << 16; qkp[i >> 1] |= vk << 16; qvp[i >> 1] |= vv << 16; } else { qrp[i >> 1] = vr; qkp[i >> 1] = vk; qvp[i >> 1] = vv; } }
        asm volatile("" ::: "memory");
        float wpre[16], apre[16];
        {
            const float muw = mu[1536 + lane], mua = mu[1600 + lane];
#pragma unroll
            for (int tk = 0; tk < 16; ++tk) { const float pw1 = UNPK(pwp, tk + 1), pw0 = UNPK(pwp, tk), pa1 = UNPK(pap, tk + 1), pa0 = UNPK(pap, tk);
                const float wl = pw1 + (pw0 - pw1) * muw, al = pa1 + (pa0 - pa1) * mua;
                const float th = 1.f - 2.f * __builtin_amdgcn_rcpf(1.f + __expf(2.f * wl));
                *(LAS bf16_t*)(W + XS + tk * RS + lane * 2) = f2bf(th); *(LAS bf16_t*)(W + XS2 + tk * RS + lane * 2) = f2bf(al); }
            f32x4 accw[4], acca[4];
            const bf16_t* F2 = (const bf16_t*)(a.ws + FG_W2) + h * 4096; const bf16_t* FA2 = (const bf16_t*)(a.ws + FG_A2) + h * 4096;
            bf16x8_t wf[2], af[2];
#pragma unroll
            for (int ks = 0; ks < 2; ++ks) { wf[ks] = *(const LAS bf16x8_t*)(W + XS + c16 * RS + ks * 64 + q4 * 16); af[ks] = *(const LAS bf16x8_t*)(W + XS2 + c16 * RS + ks * 64 + q4 * 16); }
#pragma unroll
            for (int ct = 0; ct < 4; ++ct) { asm volatile("" ::: "memory"); accw[ct] = (f32x4){0.f, 0.f, 0.f, 0.f}; acca[ct] = accw[ct];
#pragma unroll
                for (int ks = 0; ks < 2; ++ks) { accw[ct] = __builtin_amdgcn_mfma_f32_16x16x32_bf16(*(const bf16x8_t*)(F2 + ((ct * 2 + ks) * 64 + lane) * 8), wf[ks], accw[ct], 0, 0, 0);
                    acca[ct] = __builtin_amdgcn_mfma_f32_16x16x32_bf16(*(const bf16x8_t*)(FA2 + ((ct * 2 + ks) * 64 + lane) * 8), af[ks], acca[ct], 0, 0, 0); } }
            tr_acc(TBf, accw, lane, wpre); tr_acc(TBf, acca, lane, apre);
        }
        const float w0c = w0[c], a0c = a0[c], kkc = k_k[c], kac = k_a[c], rkc = r_k[c];
        const float mur = mu[c], muk = mu[512 + c], muv = mu[1024 + c];
        unsigned char* rec = FR + ((size_t)tile * 8 + h) * RW_REC;
        float vsv[16];
        unsigned btp[8], ktp[8];
        float cum = 0.f, gC = 1.f;
#pragma unroll
        for (int tk = 0; tk < 16; ++tk) { const int n = n0 + tk;
            const float cr = UNPK(qrp, tk + 1), ck = UNPK(qkp, tk + 1), cv = UNPK(qvp, tk + 1), pr = UNPK(qrp, tk), pk = UNPK(qkp, tk), pv = UNPK(qvp, tk);
            const float rs = cr + (pr - cr) * mur, ks = ck + (pk - ck) * muk, vs = cv + (pv - cv) * muv;
            const float wv = -fast_softplus(-(w0c + wpre[tk])) - 0.5f; const float logdec = -__expf(wv);
            const float av = fast_sigmoid(a0c + apre[tk]);
            const float kkr = ks * kkc; const float ss = wave_sum(kkr * kkr); const float kkn = kkr * rsqrtf(fmaxf(ss, 1e-24f));
            const float kp = ks * (1.f + (av - 1.f) * kac);
            const float bsum = wave_sum(rs * kp * rkc);
            if (lane == 0) Bon[(size_t)n * 8 + h] = bsum;
            Vb[(size_t)n * 512 + c] = f2bf(vs); vsv[tk] = vs;
            const float gprev = __expf(cum); cum += logdec; const float g = __expf(cum), gi = __builtin_amdgcn_rcpf(g); gC = g;
            const float kapv = kkn * gprev, btv = av * kkn * gi, ktv = kp * gi, rtv = rs * g;
            const bf16_t kb = f2bf(kapv), bb = f2bf(btv), kb2 = f2bf(ktv), rb = f2bf(rtv);
            *(LAS bf16_t*)(W + KAP + tk * RS + lane * 2) = kb; *(LAS bf16_t*)(W + BT + tk * RS + lane * 2) = bb;
            *(LAS bf16_t*)(W + KT + tk * RS + lane * 2) = kb2; *(LAS bf16_t*)(W + RT + tk * RS + lane * 2) = rb;
            if (tk & 1) { btp[tk >> 1] |= (unsigned)bb << 16; ktp[tk >> 1] |= (unsigned)kb2 << 16; } else { btp[tk >> 1] = bb; ktp[tk >> 1] = kb2; } }
        *(LAS u32x4_t*)(W + BTT + lane * 32) = (u32x4_t){btp[0], btp[1], btp[2], btp[3]}; *(LAS u32x4_t*)(W + BTT + lane * 32 + 16) = (u32x4_t){btp[4], btp[5], btp[6], btp[7]};
        *(LAS u32x4_t*)(W + KTT + lane * 32) = (u32x4_t){ktp[0], ktp[1], ktp[2], ktp[3]}; *(LAS u32x4_t*)(W + KTT + lane * 32 + 16) = (u32x4_t){ktp[4], ktp[5], ktp[6], ktp[7]};
        *(float*)(rec + RW_G + lane * 4) = gC;
        f32x4 akb = (f32x4){0.f, 0.f, 0.f, 0.f}, akk = akb, arbT = akb, arkT = akb;
#pragma unroll
        for (int ks = 0; ks < 2; ++ks) { const int fo = c16 * RS + ks * 64 + q4 * 16;
            const bf16x8_t fkap = *(const LAS bf16x8_t*)(W + KAP + fo), fbt = *(const LAS bf16x8_t*)(W + BT + fo), fkt = *(const LAS bf16x8_t*)(W + KT + fo), frt = *(const LAS bf16x8_t*)(W + RT + fo);
            akb = __builtin_amdgcn_mfma_f32_16x16x32_bf16(fkap, fbt, akb, 0, 0, 0); akk = __builtin_amdgcn_mfma_f32_16x16x32_bf16(fkap, fkt, akk, 0, 0, 0);
            arbT = __builtin_amdgcn_mfma_f32_16x16x32_bf16(fbt, frt, arbT, 0, 0, 0); arkT = __builtin_amdgcn_mfma_f32_16x16x32_bf16(fkt, frt, arkT, 0, 0, 0); }
#pragma unroll
        for (int r = 0; r < 4; ++r) { const int t = 4 * q4 + r; ((LAS float*)(W + AKB))[t * 16 + c16] = (c16 < t) ? akb[r] : 0.f; ((LAS float*)(W + AKK))[t * 16 + c16] = (c16 < t) ? akk[r] : 0.f;
            const int sidx = 4 * q4 + r; if (sidx > c16) { arbT[r] = 0.f; arkT[r] = 0.f; } }
        *(u32x4_t*)(rec + RW_ARF + lane * 16) = (u32x4_t){pk2(arbT[0], arbT[1]), pk2(arbT[2], arbT[3]), pk2(arkT[0], arkT[1]), pk2(arkT[2], arkT[3])};
#pragma unroll
        for (int i = 0; i < 4; ++i) { const u32x2_t b2 = *(const LAS u32x2_t*)(W + BTT + (16 * i + c16) * 32 + q4 * 8), k2 = *(const LAS u32x2_t*)(W + KTT + (16 * i + c16) * 32 + q4 * 8);
            *(u32x4_t*)(rec + RW_BKF + i * 1024 + lane * 16) = (u32x4_t){b2.x, b2.y, k2.x, k2.y}; }
#pragma unroll
        for (int sx = 0; sx < 2; ++sx) { const u32x2_t lo = *(const LAS u32x2_t*)(W + RT + c16 * RS + (32 * sx + 4 * q4) * 2), hi = *(const LAS u32x2_t*)(W + RT + c16 * RS + (32 * sx + 16 + 4 * q4) * 2);
            *(u32x4_t*)(rec + RW_RF + sx * 1024 + lane * 16) = (u32x4_t){lo.x, lo.y, hi.x, hi.y}; }
        float Wm[16], Uu[16];
#pragma unroll
        for (int t = 0; t < 16; ++t) { float wacc = bf2f(*(const LAS bf16_t*)(W + KAP + t * RS + lane * 2)), uacc = 0.f;
#pragma unroll
            for (int s4 = 0; s4 < 4; ++s4) if (4 * s4 < t) { const f32x4 b4 = *(const LAS f32x4*)(W + AKB + (t * 16 + 4 * s4) * 4), k4 = *(const LAS f32x4*)(W + AKK + (t * 16 + 4 * s4) * 4);
#pragma unroll
                for (int e = 0; e < 4; ++e) { const int sidx = 4 * s4 + e; if (sidx < t) { wacc -= b4[e] * Wm[sidx]; uacc += k4[e] * vsv[sidx] - b4[e] * Uu[sidx]; } } }
            Wm[t] = wacc; Uu[t] = uacc;
            *(LAS bf16_t*)(W + KAP + t * RS + lane * 2) = f2bf(wacc);
        }
        {
            const int ub = ((lane >> 4) * 64 + (lane & 15)) * 8;
#pragma unroll
            for (int q = 0; q < 4; ++q) { *(u32x2_t*)(rec + RW_U + ub + q * 128) = (u32x2_t){pk2(Uu[4 * q], Uu[4 * q + 1]), pk2(Uu[4 * q + 2], Uu[4 * q + 3])};
                *(u32x2_t*)(rec + RW_V + ub + q * 128) = (u32x2_t){pk2(vsv[4 * q], vsv[4 * q + 1]), pk2(vsv[4 * q + 2], vsv[4 * q + 3])}; }
        }
#pragma unroll
        for (int sx = 0; sx < 2; ++sx) { const u32x2_t lo = *(const LAS u32x2_t*)(W + KAP + c16 * RS + (32 * sx + 4 * q4) * 2), hi = *(const LAS u32x2_t*)(W + KAP + c16 * RS + (32 * sx + 16 + 4 * q4) * 2);
            *(u32x4_t*)(rec + RW_WMF + sx * 1024 + lane * 16) = (u32x4_t){lo.x, lo.y, hi.x, hi.y}; }
    }
}
__device__ __forceinline__ void sub_barrier(unsigned* ctr, unsigned target) {
    asm volatile("s_waitcnt vmcnt(0)" ::: "memory");
    __syncthreads();
    if (threadIdx.x == 0) {
        (void)xb_add(ctr, 1u);
        unsigned sp = 0;
        while (xb_ld(ctr) < target) { __builtin_amdgcn_s_sleep(2); if (++sp > (1u << 22)) break; }
        __builtin_amdgcn_fence(__ATOMIC_ACQUIRE, "agent");
        asm volatile("s_waitcnt vmcnt(0)" ::: "memory");
    }
    __syncthreads();
}
__device__ __forceinline__ void st_wt(float* p, float v) { __hip_atomic_store((unsigned*)p, __float_as_uint(v), __ATOMIC_RELAXED, __HIP_MEMORY_SCOPE_AGENT); }
__device__ __forceinline__ void ph_lru_b(const Args& a, int bid, LAS float* lds) {
    if (bid >= 64) return;
    const float* CH = (const float*)((unsigned char*)a.out + DO_LRU); const float* CA = CH + (size_t)2048 * 512; float* CIN = (float*)((unsigned char*)a.out + DO_LRU) + (size_t)4096 * 512;
    const int b = bid >> 4, cg = bid & 15, cl = threadIdx.x & 31, seg = threadIdx.x >> 5, c = cg * 32 + cl;
    float ca[32], chv[32];
#pragma unroll
    for (int i = 0; i < 32; ++i) { const size_t o = (size_t)(b * 512 + seg * 32 + i) * 512 + c; ca[i] = CA[o]; chv[i] = CH[o]; }
    float h = 0.f, sa = 0.f;
#pragma unroll
    for (int i = 0; i < 32; ++i) { h = __expf(ca[i]) * h + chv[i]; sa += ca[i]; }
    lds[seg * 32 + cl] = sa; lds[512 + seg * 32 + cl] = h;
    __syncthreads();
    float hin = 0.f;
    for (int sg = 0; sg < seg; ++sg) hin = __expf(lds[sg * 32 + cl]) * hin + lds[512 + sg * 32 + cl];
    h = hin;
#pragma unroll
    for (int i = 0; i < 32; ++i) { st_wt(CIN + (size_t)(b * 512 + seg * 32 + i) * 512 + c, h); h = __expf(ca[i]) * h + chv[i]; }
}
__device__ __forceinline__ void ph_lru_c(const Args& a, int bid, int nblk) {
    const bf16_t* LA = (const bf16_t*)(a.ws + WS_A); const bf16_t* U = LA + (size_t)NTOK * 512; const bf16_t* P = (const bf16_t*)(a.ws + WS_B);
    const float* CIN = (const float*)((unsigned char*)a.out + DO_LRU) + (size_t)4096 * 512; bf16_t* MIX = (bf16_t*)(a.ws + WS_D);
    const int c = threadIdx.x;
    for (int u = bid; u < NTOK / 16; u += nblk) { float la[16], uv[16], gt[16];
        float h = CIN[(size_t)u * 512 + c];
#pragma unroll
        for (int s = 0; s < 16; ++s) { const int n = u * 16 + s; const size_t o = (size_t)n * 512 + c; la[s] = bf2f(LA[o]); uv[s] = bf2f(U[o]); gt[s] = bf2f(P[(size_t)n * ABC + 1792 + c]); }
#pragma unroll
        for (int s = 0; s < 16; ++s) { const int n = u * 16 + s; h = __expf(la[s]) * h + uv[s];
            const float x = gt[s], t2 = 0.7978845608028654f * (x + 0.044715f * x * x * x); const float th = 1.f - 2.f * __builtin_amdgcn_rcpf(1.f + __expf(2.f * t2));
            MIX[(size_t)n * DM + 512 + c] = f2bf(h * 0.5f * x * (1.f + th)); } }
}
#ifndef SP_MODE
#define SP_MODE 0
#endif
__device__ __forceinline__ void ph_rwkv_scan(const Args& a, LAS unsigned char* L) {
    if (blockIdx.x >= 32) return;
    constexpr int SLOT = 9472, GOFF = 9216, NS = 14, NCH = SEQ / 16; constexpr size_t CSTR = (size_t)8 * RW_REC;
    const unsigned char* FR = a.ws + WS_C; float* Yr = (float*)((unsigned char*)a.out + DO_YR);
    const int b = blockIdx.x >> 3, h = blockIdx.x & 7, lane = threadIdx.x & 63, wave = __builtin_amdgcn_readfirstlane(threadIdx.x >> 6), q4 = lane >> 4, c16 = lane & 15;
    const unsigned char* FRb = FR + ((size_t)(b * NCH) * 8 + h) * RW_REC;
#define RW_BARRIER() do { asm volatile("" ::: "memory"); __builtin_amdgcn_s_barrier(); asm volatile("" ::: "memory"); } while (0)
    if (wave >= 4) {
        const int lw = wave - 4;
        const unsigned char* rp = FRb + lane * 16; int so = 0;
#define RW_ISSUE1() do { LAS unsigned char* _slot = L + so; \
            if (lw < 2) { _Pragma("unroll") for (int _j = 0; _j < 3; ++_j) __builtin_amdgcn_global_load_lds((const unsigned*)(rp + (lw * 3 + _j) * 1024), (LAS unsigned*)(_slot + (lw * 3 + _j) * 1024), 16, 0, 0); } \
            else if (lw == 2) { _Pragma("unroll") for (int _j = 0; _j < 2; ++_j) __builtin_amdgcn_global_load_lds((const unsigned*)(rp + (6 + _j) * 1024), (LAS unsigned*)(_slot + (6 + _j) * 1024), 16, 0, 0); } \
            else { __builtin_amdgcn_global_load_lds((const unsigned*)(rp + 8 * 1024), (LAS unsigned*)(_slot + 8 * 1024), 16, 0, 0); \
                   __builtin_amdgcn_global_load_lds((const unsigned*)(rp - lane * 12 + RW_G), (LAS unsigned*)(_slot + GOFF), 4, 0, 0); } \
            rp += CSTR; so += SLOT; if (so == NS * SLOT) so = 0; } while (0)
#if SP_MODE & 4
#define RW_ISSUE() do { RW_ISSUE1(); rp -= CSTR; so -= SLOT; if (so < 0) so += NS * SLOT; RW_ISSUE1(); } while (0)
#else
#define RW_ISSUE() RW_ISSUE1()
#endif
#if SP_MODE & 4
#define RW_LWAIT() do { if (lw < 2) asm volatile("s_waitcnt vmcnt(54)" ::: "memory"); else asm volatile("s_waitcnt vmcnt(36)" ::: "memory"); } while (0)
#else
#define RW_LWAIT() do { if (lw < 2) asm volatile("s_waitcnt vmcnt(27)" ::: "memory"); else asm volatile("s_waitcnt vmcnt(18)" ::: "memory"); } while (0)
#endif
        for (int p = 0; p < NS - 2; ++p) RW_ISSUE();
        RW_LWAIT();
        RW_BARRIER();
#pragma unroll 1
        for (int it = 0; it < NCH / 2; ++it) { RW_ISSUE(); RW_ISSUE(); RW_LWAIT(); RW_BARRIER(); }
        asm volatile("s_waitcnt vmcnt(0)" ::: "memory");
#undef RW_ISSUE
#undef RW_ISSUE1
#undef RW_LWAIT
    } else {
        const int vs = wave;
#if SP_MODE & 2
        __builtin_amdgcn_s_setprio(3);
#endif
        f32x4 T[4];
#pragma unroll
        for (int i = 0; i < 4; ++i) T[i] = (f32x4){0.f, 0.f, 0.f, 0.f};
        struct Ops { bf16x8_t wmf[2], rf[2], bkf[4], arf; f32x4 g4[4]; };
        const LAS unsigned char* lp = L + lane * 16; const LAS unsigned char* lg = L + GOFF + q4 * 16; int so = 0;
        const unsigned char* up = FRb + RW_U + (vs * 64 + lane) * 8;
        float* yp = Yr + ((size_t)(b * NCH) * 8 + h) * 1024 + vs * 256 + lane * 4;
#if SP_MODE & 8
#define RW_LOAD(O) do { { const LAS unsigned char* _r = lp + so; const LAS unsigned char* _g = lg + so; \
            _Pragma("unroll") for (int _s = 0; _s < 2; ++_s) { bf16x8_t _t0 = *(const LAS bf16x8_t*)(_r + RW_WMF + _s * 1024); bf16x8_t _t1 = *(const LAS bf16x8_t*)(_r + RW_RF + _s * 1024); asm volatile("" :: "v"(_t0), "v"(_t1)); } \
            _Pragma("unroll") for (int _i = 0; _i < 4; ++_i) { bf16x8_t _t0 = *(const LAS bf16x8_t*)(_r + RW_BKF + _i * 1024); f32x4 _t1 = *(const LAS f32x4*)(_g + _i * 64); asm volatile("" :: "v"(_t0), "v"(_t1)); } \
            { bf16x8_t _t0 = *(const LAS bf16x8_t*)(_r + RW_ARF); asm volatile("" :: "v"(_t0)); } asm volatile("" ::: "memory"); } RW_LOAD1(O); } while (0)
#else
#define RW_LOAD(O) RW_LOAD1(O)
#endif
#define RW_LOAD1(O) do { const LAS unsigned char* _r = lp + so; const LAS unsigned char* _g = lg + so; \
            _Pragma("unroll") for (int _s = 0; _s < 2; ++_s) { O.wmf[_s] = *(const LAS bf16x8_t*)(_r + RW_WMF + _s * 1024); O.rf[_s] = *(const LAS bf16x8_t*)(_r + RW_RF + _s * 1024); } \
            _Pragma("unroll") for (int _i = 0; _i < 4; ++_i) O.bkf[_i] = *(const LAS bf16x8_t*)(_r + RW_BKF + _i * 1024); \
            O.arf = *(const LAS bf16x8_t*)(_r + RW_ARF); \
            _Pragma("unroll") for (int _i = 0; _i < 4; ++_i) O.g4[_i] = *(const LAS f32x4*)(_g + _i * 64); \
            so += SLOT; if (so == NS * SLOT) so = 0; \
            __builtin_amdgcn_sched_barrier(0); } while (0)
#define RW_UV(dst) do { dst[0] = *(const u32x2_t*)up; dst[1] = *(const u32x2_t*)(up + 2048); up += CSTR; } while (0)
#define RW_STEP(O, uv) do { \
            bf16x8_t _bS[2]; \
            _Pragma("unroll") for (int _s = 0; _s < 2; ++_s) { const u32x4_t _pk = (u32x4_t){pk2(T[2 * _s][0], T[2 * _s][1]), pk2(T[2 * _s][2], T[2 * _s][3]), pk2(T[2 * _s + 1][0], T[2 * _s + 1][1]), pk2(T[2 * _s + 1][2], T[2 * _s + 1][3])}; \
                _bS[_s] = __builtin_bit_cast(bf16x8_t, _pk); } \
            f32x4 _z = (f32x4){__uint_as_float(uv[0].x << 16), __uint_as_float(uv[0].x & 0xffff0000u), __uint_as_float(uv[0].y << 16), __uint_as_float(uv[0].y & 0xffff0000u)}; \
            _z = __builtin_amdgcn_mfma_f32_16x16x32_bf16(O.wmf[0], _bS[0], _z, 0, 0, 0); _z = __builtin_amdgcn_mfma_f32_16x16x32_bf16(O.wmf[1], _bS[1], _z, 0, 0, 0); \
            f32x4 _y = (f32x4){0.f, 0.f, 0.f, 0.f}; \
            _y = __builtin_amdgcn_mfma_f32_16x16x32_bf16(_bS[0], O.rf[0], _y, 0, 0, 0); _y = __builtin_amdgcn_mfma_f32_16x16x32_bf16(_bS[1], O.rf[1], _y, 0, 0, 0); \
            const u32x4_t _zvp = (u32x4_t){pk2(-_z[0], -_z[1]), pk2(-_z[2], -_z[3]), uv[1].x, uv[1].y}; \
            const bf16x8_t _bZV = __builtin_bit_cast(bf16x8_t, _zvp); \
            _Pragma("unroll") for (int _i = 0; _i < 4; ++_i) { T[_i] = __builtin_amdgcn_mfma_f32_16x16x32_bf16(O.bkf[_i], _bZV, T[_i], 0, 0, 0); T[_i] = T[_i] * O.g4[_i]; } \
            _y = __builtin_amdgcn_mfma_f32_16x16x32_bf16(_bZV, O.arf, _y, 0, 0, 0); \
            *(f32x4*)yp = _y; RW_ST2(); yp += 8 * 1024; } while (0)
#if SP_MODE & 16
#define RW_ST2() do { asm volatile("" ::: "memory"); *(f32x4*)yp = _y; } while (0)
#else
#define RW_ST2() do { } while (0)
#endif
#define RW_SYNC() do { asm volatile("s_waitcnt lgkmcnt(0)" ::: "memory"); RW_BARRIER(); } while (0)
        Ops A, B;
        u32x2_t uv0[2], uv1[2], uv2[2], uv3[2];
        RW_UV(uv0); RW_UV(uv1); RW_UV(uv2); RW_UV(uv3);
        RW_BARRIER();
        RW_LOAD(A);
#pragma unroll 1
        for (int ch = 0; ch < NCH; ch += 4) {
            RW_LOAD(B); RW_STEP(A, uv0); RW_UV(uv0);
            RW_LOAD(A); RW_STEP(B, uv1); RW_UV(uv1); RW_SYNC();
            RW_LOAD(B); RW_STEP(A, uv2); RW_UV(uv2);
            RW_LOAD(A); RW_STEP(B, uv3); RW_UV(uv3); RW_SYNC(); }
#undef RW_SYNC
#undef RW_LOAD
#undef RW_LOAD1
#undef RW_STEP
#undef RW_UV
    }
#undef RW_BARRIER
}
__device__ __forceinline__ void ph_rwkv_post(const Args& a, LAS float* lds) {
    const bf16_t* V = (const bf16_t*)a.out; const float* Bon = (const float*)((const unsigned char*)a.out + DO_BON); const bf16_t* SG = (const bf16_t*)((const unsigned char*)a.out + DO_SG);
    const float* Yr = (const float*)((const unsigned char*)a.out + DO_YR); bf16_t* MIX = (bf16_t*)(a.ws + WS_D);
    const float* ln_w = a.in[14]; const float* ln_b = a.in[15];
    LAS unsigned char* L = (LAS unsigned char*)lds;
    const int c = threadIdx.x, lane = c & 63, h = c >> 6, q4 = lane >> 4, c16 = lane & 15;
    const bf16_t* FG = (const bf16_t*)(a.ws + FG_G2) + h * 8192;
    for (int tile = blockIdx.x; tile < NTOK / 16; tile += gridDim.x) {
        const int n0 = tile * 16;
        __syncthreads();
        { const int tk = c >> 5, j4 = (c & 31) * 4; *(LAS u32x2_t*)(L + tk * 272 + j4 * 2) = *(const u32x2_t*)(SG + (size_t)(n0 + tk) * 128 + j4); }
        __syncthreads();
        const int n = n0 + c16;
        f32x4 g[4], y[4];
#pragma unroll
        for (int ct = 0; ct < 4; ++ct) { g[ct] = (f32x4){0.f, 0.f, 0.f, 0.f};
#pragma unroll
            for (int ks = 0; ks < 4; ++ks) { const bf16x8_t af = *(const bf16x8_t*)(FG + ((size_t)(ct * 4 + ks) * 64 + lane) * 8); const bf16x8_t bfr = *(const LAS bf16x8_t*)(L + c16 * 272 + ks * 64 + q4 * 16);
                g[ct] = __builtin_amdgcn_mfma_f32_16x16x32_bf16(af, bfr, g[ct], 0, 0, 0); }
            y[ct] = *(const f32x4*)(Yr + (size_t)tile * 8192 + h * 1024 + ct * 256 + lane * 4); }
        float sm = 0.f;
#pragma unroll
        for (int ct = 0; ct < 4; ++ct) sm += (y[ct][0] + y[ct][1]) + (y[ct][2] + y[ct][3]);
        sm = xrow16_sum(sm);
        const float mean = sm * (1.f / 64.f);
        float sv = 0.f;
#pragma unroll
        for (int ct = 0; ct < 4; ++ct) { y[ct] = y[ct] - mean; sv += (y[ct][0] * y[ct][0] + y[ct][1] * y[ct][1]) + (y[ct][2] * y[ct][2] + y[ct][3] * y[ct][3]); }
        sv = xrow16_sum(sv);
        const float rstd = rsqrtf(sv * (1.f / 64.f) + 64e-5f), bsc = Bon[(size_t)n * 8 + h];
#pragma unroll
        for (int ct = 0; ct < 4; ++ct) { const int ch = 64 * h + 16 * ct + 4 * q4;
            const f32x4 lw = *(const f32x4*)(ln_w + ch), lb = *(const f32x4*)(ln_b + ch);
            const u32x2_t vv = *(const u32x2_t*)(V + (size_t)n * 512 + ch);
            const float v0 = __uint_as_float(vv.x << 16), v1 = __uint_as_float(vv.x & 0xffff0000u), v2 = __uint_as_float(vv.y << 16), v3 = __uint_as_float(vv.y & 0xffff0000u);
            const float o0 = (y[ct][0] * rstd * lw[0] + lb[0] + bsc * v0) * g[ct][0], o1 = (y[ct][1] * rstd * lw[1] + lb[1] + bsc * v1) * g[ct][1];
            const float o2 = (y[ct][2] * rstd * lw[2] + lb[2] + bsc * v2) * g[ct][2], o3 = (y[ct][3] * rstd * lw[3] + lb[3] + bsc * v3) * g[ct][3];
            *(u32x2_t*)(MIX + (size_t)n * DM + ch) = (u32x2_t){pk2(o0, o1), pk2(o2, o3)}; }
    }
}

namespace gla {
typedef short bf16x8 __attribute__((ext_vector_type(8)));
typedef float f32x16 __attribute__((ext_vector_type(16)));
typedef unsigned u32x4 __attribute__((ext_vector_type(4)));
typedef unsigned u32x2 __attribute__((ext_vector_type(2)));
constexpr int QH_OFF = 0, KH_OFF = 17408, KT_OFF = 34816, VT_OFF = 53248, ST_OFF = 71680, AM_OFF = 106496, EB_OFF = 115712, ER_OFF = 116224, PS_OFF = 116736, SSQ_OFF = 118784;
constexpr int QS = 272, TS = 144;
#define GLA_BAR() do { asm volatile("s_waitcnt lgkmcnt(0)" ::: "memory"); __builtin_amdgcn_s_barrier(); asm volatile("" ::: "memory"); } while (0)
template <bool OUT>
__device__ __forceinline__ void unit(const Args& a, LAS unsigned char* L, int u) {
    const int tid = threadIdx.x, lane = tid & 63, w = tid >> 6;
    const int b = u >> 6, h = (u >> 3) & 7, j = u & 7;
    const bf16_t* Q = (const bf16_t*)(a.ws + WS_QFIG) + ((size_t)b * SEQ + (size_t)j * 1024) * 4096 + h * 128;
    float* Lb = (float*)(a.ws + WS_O); float* Db = Lb + (size_t)256 * 16384;
    const int dk = tid & 127, tg = tid >> 7;
    const float c0 = a.in[25][h * 128 + dk], c1 = a.in[25][1024 + h * 128 + dk];
    const float lbv = __builtin_amdgcn_rcpf(1.f + __expf(c0 - c1)), omlb = 1.f - lbv;
    LAS float* PS = (LAS float*)(L + PS_OFF); LAS float* EB = (LAS float*)(L + EB_OFF); LAS float* ER = (LAS float*)(L + ER_OFF); LAS float* SSQ = (LAS float*)(L + SSQ_OFF);
    const int si = w >> 1, sj0 = (w & 1) * 2, l31 = lane & 31, l5 = lane >> 5;
    const int ri = w >> 2, cj = w & 3, odv = 32 * cj + l31;
    f32x16 S[2];
#pragma unroll
    for (int jj = 0; jj < 2; ++jj)
#pragma unroll
        for (int r = 0; r < 16; ++r) S[jj][r] = 0.f;
    if (OUT) {
#pragma unroll 1
        for (int i = 0; i < j; ++i) { const int ui = u - j + i;
#pragma unroll
            for (int jj = 0; jj < 2; ++jj)
#pragma unroll
                for (int rg = 0; rg < 4; ++rg) { const int sdk0 = 32 * si + 8 * rg + 4 * l5, sdv = 32 * (sj0 + jj) + l31; const f32x4 dd = *(const f32x4*)(Db + ui * 128 + sdk0);
#pragma unroll
                    for (int e = 0; e < 4; ++e) S[jj][4 * rg + e] = dd[e] * S[jj][4 * rg + e] + Lb[(size_t)ui * 16384 + (sdk0 + e) * 128 + sdv]; } } }
    float dsum = 1.f;
    const int prow = tid >> 4, ppc = tid & 15;
    u32x4 pf[2], pv[2], pq[2];
#define GLA_PREFETCH(cx) do { const bf16_t* _q = Q + (size_t)((cx) * 64 + prow) * 4096 + ppc * 8; \
        _Pragma("unroll") for (int _r = 0; _r < 2; ++_r) { pf[_r] = *(const u32x4*)(_q + (size_t)_r * 32 * 4096 + 1024); pv[_r] = *(const u32x4*)(_q + (size_t)_r * 32 * 4096 + 2048); if (OUT) pq[_r] = *(const u32x4*)(_q + (size_t)_r * 32 * 4096); } } while (0)
    GLA_PREFETCH(0);
#pragma unroll 1
    for (int c = 0; c < 16; ++c) {
        int cc = c; asm volatile("" : "+s"(cc));
#pragma unroll
        for (int r = 0; r < 2; ++r) { *(LAS u32x4*)(L + KH_OFF + (prow + 32 * r) * QS + ppc * 16) = pf[r]; *(LAS u32x4*)(L + ST_OFF + (prow + 32 * r) * QS + ppc * 16) = pv[r];
            if (OUT) *(LAS u32x4*)(L + QH_OFF + (prow + 32 * r) * QS + ppc * 16) = pq[r]; }
        if (c + 1 < 16) GLA_PREFETCH(cc + 1);
        unsigned gp[8];
        if (OUT) { const bf16_t* G = Q + (size_t)(cc * 64) * 4096 + 3072;
            unsigned go = (unsigned)((32 * ri + 4 * l5) * 4096 + odv); asm volatile("" : "+v"(go));
#pragma unroll
            for (int r = 0; r < 16; r += 2) { const unsigned t0 = (unsigned)(((r & 3) + 8 * (r >> 2)) * 4096); gp[r >> 1] = (unsigned)G[go + t0] | ((unsigned)G[go + t0 + 4096u] << 16); } }
        GLA_BAR();
        float lf[16], kk[16];
#pragma unroll
        for (int i = 0; i < 16; ++i) { const float fv = bf2f(*(const LAS bf16_t*)(L + KH_OFF + (tg * 16 + i) * QS + dk * 2)); const float sg = __builtin_amdgcn_rcpf(1.f + __expf(-fv));
            lf[i] = lbv + omlb * sg; kk[i] = omlb * (1.f - sg); }
#pragma unroll
        for (int i = 1; i < 16; ++i) lf[i] *= lf[i - 1];
        PS[tg * 128 + dk] = lf[15];
        GLA_BAR();
        const float p0 = PS[dk], p1 = PS[128 + dk], p2 = PS[256 + dk], p3 = PS[384 + dk];
        const float off = (tg > 0 ? p0 : 1.f) * (tg > 1 ? p1 : 1.f) * (tg > 2 ? p2 : 1.f);
        const float pref = p0 * p1, pbl = pref * (p2 * p3), ebr = p2 * p3;
        const float ioff = off * __builtin_amdgcn_rcpf(pref);
        unsigned ktp[8], vtp[8];
#pragma unroll
        for (int i = 0; i < 16; i += 2) {
            float kb[2]; unsigned vv[2];
#pragma unroll
            for (int q = 0; q < 2; ++q) { const float e1 = ioff * lf[i + q]; const float e2 = __builtin_amdgcn_rcpf(e1);
                const float khat = kk[i + q] * e2; kb[q] = khat * ebr; vv[q] = *(const LAS bf16_t*)(L + ST_OFF + (tg * 16 + i + q) * QS + dk * 2);
                if (OUT) { LAS bf16_t* qp = (LAS bf16_t*)(L + QH_OFF + (tg * 16 + i + q) * QS + dk * 2); const float qr = bf2f(*qp); const float qv = qr * __builtin_amdgcn_rcpf(1.f + __expf(-qr));
                    *qp = f2bf(qv * e1); *(LAS bf16_t*)(L + KH_OFF + (tg * 16 + i + q) * QS + dk * 2) = f2bf(khat); } }
            ktp[i >> 1] = pk2(kb[0], kb[1]); vtp[i >> 1] = vv[0] | (vv[1] << 16);
        }
        *(LAS u32x4*)(L + KT_OFF + dk * TS + tg * 32) = (u32x4){ktp[0], ktp[1], ktp[2], ktp[3]}; *(LAS u32x4*)(L + KT_OFF + dk * TS + tg * 32 + 16) = (u32x4){ktp[4], ktp[5], ktp[6], ktp[7]};
        *(LAS u32x4*)(L + VT_OFF + dk * TS + tg * 32) = (u32x4){vtp[0], vtp[1], vtp[2], vtp[3]}; *(LAS u32x4*)(L + VT_OFF + dk * TS + tg * 32 + 16) = (u32x4){vtp[4], vtp[5], vtp[6], vtp[7]};
        if (tg == 0) { EB[dk] = pbl; ER[dk] = pref; dsum *= pbl; }
        GLA_BAR();
        f32x16 o;
        if (OUT) {
#pragma unroll
            for (int jj = 0; jj < 2; ++jj)
#pragma unroll
                for (int rg = 0; rg < 4; ++rg) { const int dk0 = 32 * si + 8 * rg + 4 * l5; const f32x4 er = *(const LAS f32x4*)(ER + dk0);
                    u32x2 pk; pk.x = pk2(S[jj][4 * rg] * er[0], S[jj][4 * rg + 1] * er[1]); pk.y = pk2(S[jj][4 * rg + 2] * er[2], S[jj][4 * rg + 3] * er[3]);
                    *(LAS u32x2*)(L + ST_OFF + (32 * (sj0 + jj) + l31) * QS + dk0 * 2) = pk; }
#pragma unroll
            for (int q = 0; q < 2; ++q) { const int ti = w >> 1, tj = (w & 1) * 2 + q;
                f32x4 sc = (f32x4){0.f, 0.f, 0.f, 0.f};
                if (tj <= ti) {
#pragma unroll
                    for (int ks = 0; ks < 4; ++ks) { const bf16x8 af = *(const LAS bf16x8*)(L + QH_OFF + (16 * ti + (lane & 15)) * QS + ks * 64 + (lane >> 4) * 16);
                        const bf16x8 bfr = *(const LAS bf16x8*)(L + KH_OFF + (16 * tj + (lane & 15)) * QS + ks * 64 + (lane >> 4) * 16);
                        sc = __builtin_amdgcn_mfma_f32_16x16x32_bf16(af, bfr, sc, 0, 0, 0); } }
                const int scol = 16 * tj + (lane & 15);
#pragma unroll
                for (int r = 0; r < 4; ++r) { const int trow = 16 * ti + 4 * (lane >> 4) + r; const float v = (scol <= trow) ? sc[r] : 0.f;
                    *(LAS bf16_t*)(L + AM_OFF + trow * TS + scol * 2) = f2bf(v); } }
            GLA_BAR();
#pragma unroll
            for (int r = 0; r < 16; ++r) o[r] = 0.f;
#pragma unroll
            for (int ks = 0; ks < 4; ++ks) if (ks < 2 * (ri + 1)) {
                const bf16x8 af = *(const LAS bf16x8*)(L + AM_OFF + (32 * ri + l31) * TS + ks * 32 + l5 * 16);
                const bf16x8 bfr = *(const LAS bf16x8*)(L + VT_OFF + (32 * cj + l31) * TS + ks * 32 + l5 * 16);
                o = __builtin_amdgcn_mfma_f32_32x32x16_bf16(af, bfr, o, 0, 0, 0); }
#pragma unroll
            for (int ks = 0; ks < 8; ++ks) { if ((ks & 3) == 0) asm volatile("" ::: "memory");
                const bf16x8 af = *(const LAS bf16x8*)(L + QH_OFF + (32 * ri + l31) * QS + ks * 32 + l5 * 16);
                const bf16x8 bfr = *(const LAS bf16x8*)(L + ST_OFF + (32 * cj + l31) * QS + ks * 32 + l5 * 16);
                o = __builtin_amdgcn_mfma_f32_32x32x16_bf16(af, bfr, o, 0, 0, 0); }
#pragma unroll
            for (int r = 0; r < 16; ++r) { const float q2 = xrow32_sum(row16_sum(o[r] * o[r]));
                if (l31 == 0) SSQ[(32 * ri + (r & 3) + 8 * (r >> 2) + 4 * l5) * 4 + cj] = q2; }
        }
        {
            bf16x8 af[4];
#pragma unroll
            for (int ks = 0; ks < 4; ++ks) af[ks] = *(const LAS bf16x8*)(L + KT_OFF + (32 * si + l31) * TS + ks * 32 + l5 * 16);
#pragma unroll
            for (int jj = 0; jj < 2; ++jj) {
#pragma unroll
                for (int rg = 0; rg < 4; ++rg) { const f32x4 eb = *(const LAS f32x4*)(EB + 32 * si + 8 * rg + 4 * l5);
                    S[jj][4 * rg] *= eb[0]; S[jj][4 * rg + 1] *= eb[1]; S[jj][4 * rg + 2] *= eb[2]; S[jj][4 * rg + 3] *= eb[3]; }
#pragma unroll
                for (int ks = 0; ks < 4; ++ks) { const bf16x8 bfr = *(const LAS bf16x8*)(L + VT_OFF + (32 * (sj0 + jj) + l31) * TS + ks * 32 + l5 * 16);
                    S[jj] = __builtin_amdgcn_mfma_f32_32x32x16_bf16(af[ks], bfr, S[jj], 0, 0, 0); } }
        }
        GLA_BAR();
        if (OUT) {
            const float nwv = a.in[26][h * 128 + odv];
            bf16_t* MIX = (bf16_t*)(a.ws + WS_MIX1) + ((size_t)b * SEQ + (size_t)j * 1024 + cc * 64) * DM + h * 128;
            unsigned mo = (unsigned)((32 * ri + 4 * l5) * DM + odv); asm volatile("" : "+v"(mo));
#pragma unroll
            for (int r = 0; r < 16; ++r) { const int t = 32 * ri + (r & 3) + 8 * (r >> 2) + 4 * l5; const f32x4 q4 = *(const LAS f32x4*)(SSQ + t * 4);
                const float rs = rsqrtf(((q4[0] + q4[1]) + (q4[2] + q4[3])) * (1.f / 128.f) + 1e-6f);
                const float gv = __uint_as_float((r & 1) ? (gp[r >> 1] & 0xffff0000u) : (gp[r >> 1] << 16)); const float y = o[r] * rs * nwv * gv * __builtin_amdgcn_rcpf(1.f + __expf(-gv));
                MIX[mo + (unsigned)(((r & 3) + 8 * (r >> 2)) * DM)] = f2bf(y); }
        }
    }
    if (!OUT) {
#pragma unroll
        for (int jj = 0; jj < 2; ++jj)
#pragma unroll
            for (int r = 0; r < 16; ++r) { const int sdk = 32 * si + (r & 3) + 8 * (r >> 2) + 4 * l5, sdv = 32 * (sj0 + jj) + l31; Lb[(size_t)u * 16384 + sdk * 128 + sdv] = S[jj][r]; }
        if (tg == 0) Db[u * 128 + dk] = dsum;
    }
    GLA_BAR();
#undef GLA_PREFETCH
}
__device__ __forceinline__ void pass2(const Args& a) {
    float* Lb = (float*)(a.ws + WS_O); const float* Db = Lb + (size_t)256 * 16384;
    for (int idx = blockIdx.x * NTHREADS + threadIdx.x; idx < 32 * 16384; idx += gridDim.x * NTHREADS) { const int bh = idx >> 14, el = idx & 16383, dkk = el >> 7; float sacc = 0.f;
        for (int j = 0; j < 8; ++j) { const int u = bh * 8 + j; const size_t o = (size_t)u * 16384 + el;
            if (j < 7) { const float tmp = Lb[o]; Lb[o] = sacc; sacc = Db[u * 128 + dkk] * sacc + tmp; } else Lb[o] = sacc; } }
}
}

constexpr int NPHASE = 24;
__global__ void __launch_bounds__(NTHREADS, 2) fwd(Args a) {
    extern __shared__ __attribute__((aligned(16))) unsigned char lds_raw[];
    LAS unsigned char* ldsb = (LAS unsigned char*)lds_raw;
    LAS float* lds = (LAS float*)ldsb;
    LAS int* pst = (LAS int*)(ldsb + LDS_MISC);
    volatile LAS unsigned* xbw = (volatile LAS unsigned*)(ldsb + LDS_MISC + 256);
    if (threadIdx.x == 0) { xbw[0] = 0u; xbw[1] = 0u; }
    __syncthreads();
    unsigned* ctl = (unsigned*)(a.ws + WS_CTL);
    const bool multi = (a.ph_hi - a.ph_lo) > 1;
    XcdBarrier bar; bar.bar = ctl; bar.x = 0; bar.st = xbw;
    if (multi) bar = xcd_barrier_post(ctl, xbw);
    unsigned char* ws = a.ws;
    bf16_t* HN = (bf16_t*)(ws + WS_A);
    bf16_t* XR = (bf16_t*)(ws + WS_XR); float* RSv = (float*)(ws + WS_ROUTE + RT_LRU_CH);
    int* asg_e = (int*)(ws + WS_ROUTE + RT_ASG_E); int* asg_rank = (int*)(ws + WS_ROUTE + RT_ASG_RANK); float* asg_gate = (float*)(ws + WS_ROUTE + RT_ASG_GATE);
    int* row_tok = (int*)(ws + WS_ROUTE + RT_ROW_TOK); int* row_slot = (int*)(ws + WS_ROUTE + RT_ROW_SLOT); float* row_gate = (float*)(ws + WS_ROUTE + RT_ROW_GATE); float* row_rs = (float*)(ws + WS_ROUTE + RT_LRU_CA); float* tscale = (float*)(ws + WS_ROUTE + RT_LRU_CIN);
#ifndef PHSEL
#define PHSEL(k) true
#endif
#ifndef REPMASK
#define REPMASK 0u
#endif
#define NREP(k) (((REPMASK >> (k)) & 1u) ? 2 : 1)
#define IN(k) (PHSEL(k) && a.ph_lo <= (k) && (k) < a.ph_hi)
#define SEAM(k) do { if (IN((k) + 1) && multi) xcd_barrier(bar); } while (0)
    if (IN(0)) { ph_cvt_frags(a); ph_cvt_dense_a(a, lds, ctl + CW_COLMAX); ph_norm0(a.in[0], a.in[1], (unsigned char*)HN, (float*)(ws + WS_ROUTE + RT_LRU_CH + 262144)); xcd_barrier(bar); ph_cvt_dense_b(a, lds, ctl + CW_COLMAX, 0); }
#if (REPMASK >> 0) & 1
    if (IN(0)) { xcd_barrier(bar);  ph_cvt_frags(a); ph_cvt_dense_a(a, lds, ctl + CW_COLMAX); ph_norm0(a.in[0], a.in[1], (unsigned char*)HN, (float*)(ws + WS_ROUTE + RT_LRU_CH + 262144)); xcd_barrier(bar); ph_cvt_dense_b(a, lds, ctl + CW_COLMAX, 0); }
#endif
    if (IN(0)) { SEAM(0); }
    if (IN(1)) { pg8::DenseOrder S; S.init(NTOK, ABC, DM / 2, gridDim.x, blockIdx.x, ws + WD_ABIN); pg8::EpiBf16I E{(bf16_t*)(ws + WS_B), ABC, (float*)(ws + WS_ROUTE + RT_LRU_CH + 262144), ctl + CW_COLMAX};
        pg8::gemm_phase<pg8::EpiBf16I, pg8::DenseOrder, true>(ldsb, (const char*)HN, DM, DM / 2, S, E); }
#if (REPMASK >> 1) & 1
    if (IN(1)) { xcd_barrier(bar);  pg8::DenseOrder S; S.init(NTOK, ABC, DM / 2, gridDim.x, blockIdx.x, ws + WD_ABIN); pg8::EpiBf16I E{(bf16_t*)(ws + WS_B), ABC, (float*)(ws + WS_ROUTE + RT_LRU_CH + 262144), ctl + CW_COLMAX};
        pg8::gemm_phase<pg8::EpiBf16I, pg8::DenseOrder, true>(ldsb, (const char*)HN, DM, DM / 2, S, E);  }
#endif
    if (IN(1)) { SEAM(1); }
    if (IN(2)) { ph_l0_prep(a, lds); }
#if (REPMASK >> 2) & 1
    if (IN(2)) { xcd_barrier(bar);  ph_l0_prep(a, lds);  }
#endif
    if (IN(2)) { SEAM(2); }
    if (IN(6)) {
        if (blockIdx.x < 32) ph_rwkv_scan(a, ldsb);
        else { const int gb = (int)blockIdx.x - 32, gn = (int)gridDim.x - 32; unsigned* sctr = ctl + CW_CNT + 256;
            ph_lru_b(a, gb, lds); sub_barrier(sctr, (unsigned)gn);
#if SP_MODE & 1
            ph_lru_c(a, gb, gn); }
        xcd_barrier(bar); ph_wmax(a.in[32], a.in[33], ctl + CW_WMAX, blockIdx.x, gridDim.x); xcd_barrier(bar);
        ph_cvt_moe(a, 0, lds, blockIdx.x, gridDim.x, 3); ph_cvt_moe(a, 1, lds, blockIdx.x, gridDim.x, 1);
#else
            ph_lru_c(a, gb, gn); ph_wmax(a.in[32], a.in[33], ctl + CW_WMAX, gb, gn); sub_barrier(sctr, 2u * (unsigned)gn);
            ph_cvt_moe(a, 0, lds, gb, gn, 3); ph_cvt_moe(a, 1, lds, gb, gn, 1); }
#endif
        SEAM(6); }
    if (IN(7)) { ph_rwkv_post(a, lds); }
#if (REPMASK >> 7) & 1
    if (IN(7)) { xcd_barrier(bar);  ph_rwkv_post(a, lds);  }
#endif
    if (IN(7)) { SEAM(7); }
    if (IN(8)) { pg8::DenseOrder S; S.init(NTOK, DM, DM, gridDim.x, blockIdx.x, ws + WD_ABOUT); pg8::EpiResid<true> E{a.in[0], XR};
        pg8::gemm_phase(ldsb, (const char*)(ws + WS_D), DM * 2, DM, S, E); }
#if (REPMASK >> 8) & 1
    if (IN(8)) { xcd_barrier(bar);  pg8::DenseOrder S; S.init(NTOK, DM, DM, gridDim.x, blockIdx.x, ws + WD_ABOUT); pg8::EpiResid<true> E{a.in[0], XR};
        pg8::gemm_phase(ldsb, (const char*)(ws + WS_D), DM * 2, DM, S, E);  }
#endif
    if (IN(8)) { SEAM(8); }
    if (IN(9)) { ph_route(a, 0, XR, HN, RSv, ctl + CW_CNT, asg_e, asg_rank, asg_gate, lds); SEAM(9); }
    if (IN(10)) { ph_dispatch(ctl + CW_CNT, asg_e, asg_rank, asg_gate, RSv, row_tok, row_slot, row_gate, row_rs, pst, ctl + CW_WMAX, tscale); ph_cvt_dense_b(a, lds, ctl + CW_COLMAX, 1); }
#if (REPMASK >> 10) & 1
    if (IN(10)) { xcd_barrier(bar);  ph_dispatch(ctl + CW_CNT, asg_e, asg_rank, asg_gate, RSv, row_tok, row_slot, row_gate, row_rs, pst, ctl + CW_WMAX, tscale);  }
#endif
    if (IN(10)) { SEAM(10); }
    if (IN(11)) { moe_prefix(ctl + CW_CNT, pst);
        pg8::MoeOrder S{(int)gridDim.x, (int)blockIdx.x, 4, pst[NEXP] / 256, pst, row_tok, (const char*)(ws + WM_GU), (size_t)DM * DM, (size_t)256 * DM}; pg8::EpiSwiGLU E{(bf16_t*)(ws + WS_H), tscale};
        pg8::gemm_phase<pg8::EpiSwiGLU, pg8::MoeOrder, true>(ldsb, (const char*)HN, DM, DM / 2, S, E); }
#if (REPMASK >> 11) & 1
    if (IN(11)) { xcd_barrier(bar);  moe_prefix(ctl + CW_CNT, pst);
        pg8::MoeOrder S{(int)gridDim.x, (int)blockIdx.x, 4, pst[NEXP] / 256, pst, row_tok, (const char*)(ws + WM_GU), (size_t)DM * DM, (size_t)256 * DM}; pg8::EpiSwiGLU E{(bf16_t*)(ws + WS_H), tscale};
        pg8::gemm_phase<pg8::EpiSwiGLU, pg8::MoeOrder, true>(ldsb, (const char*)HN, DM, DM / 2, S, E);  }
#endif
    if (IN(11)) { SEAM(11); }
    if (IN(12)) { moe_prefix(ctl + CW_CNT, pst);
        pg8::MoeOrder S{(int)gridDim.x, (int)blockIdx.x, 4, pst[NEXP] / 256, pst, nullptr, (const char*)(ws + WM_DN), (size_t)DM * FF * 2, (size_t)256 * FF * 2}; pg8::EpiDown E{(bf16_t*)(ws + WS_Y), row_tok, row_slot, row_gate};
        pg8::gemm_phase(ldsb, (const char*)(ws + WS_H), FF * 2, FF, S, E); }
#if (REPMASK >> 12) & 1
    if (IN(12)) { xcd_barrier(bar);  moe_prefix(ctl + CW_CNT, pst);
        pg8::MoeOrder S{(int)gridDim.x, (int)blockIdx.x, 4, pst[NEXP] / 256, pst, nullptr, (const char*)(ws + WM_DN), (size_t)DM * FF * 2, (size_t)256 * FF * 2}; pg8::EpiDown E{(bf16_t*)(ws + WS_Y), row_tok, row_slot, row_gate};
        pg8::gemm_phase(ldsb, (const char*)(ws + WS_H), FF * 2, FF, S, E);  }
#endif
    if (IN(12)) { SEAM(12); }
    if (IN(13)) { ph_combine_norm(XR, (const bf16_t*)(ws + WS_Y), a.in[1] + DM, (unsigned char*)HN, (float*)(ws + WS_ROUTE + RT_LRU_CH + 262144)); SEAM(13); }
    if (IN(14)) { pg8::DenseOrder S; S.init(NTOK, 4096, DM / 2, gridDim.x, blockIdx.x, ws + WD_CIN); pg8::EpiBf16I E{(bf16_t*)(ws + WS_QFIG), 4096, (float*)(ws + WS_ROUTE + RT_LRU_CH + 262144), ctl + CW_COLMAX + ABC};
        pg8::gemm_phase<pg8::EpiBf16I, pg8::DenseOrder, true>(ldsb, (const char*)HN, DM, DM / 2, S, E); }
#if (REPMASK >> 14) & 1
    if (IN(14)) { xcd_barrier(bar);  pg8::DenseOrder S; S.init(NTOK, 4096, DM / 2, gridDim.x, blockIdx.x, ws + WD_CIN); pg8::EpiBf16I E{(bf16_t*)(ws + WS_QFIG), 4096, (float*)(ws + WS_ROUTE + RT_LRU_CH + 262144), ctl + CW_COLMAX + ABC};
        pg8::gemm_phase<pg8::EpiBf16I, pg8::DenseOrder, true>(ldsb, (const char*)HN, DM, DM / 2, S, E);  }
#endif
    if (IN(14)) { SEAM(14); }
    if (IN(15)) { for (int u = blockIdx.x; u < 256; u += gridDim.x) if ((u & 7) != 7) gla::unit<false>(a, ldsb, u); }
#if (REPMASK >> 15) & 1
    if (IN(15)) { xcd_barrier(bar);  for (int u = blockIdx.x; u < 256; u += gridDim.x) if ((u & 7) != 7) gla::unit<false>(a, ldsb, u);  }
#endif
    if (IN(15)) { SEAM(15); }
    if (IN(17)) { for (int u = blockIdx.x; u < 256; u += gridDim.x) gla::unit<true>(a, ldsb, u); }
#if (REPMASK >> 17) & 1
    if (IN(17)) { xcd_barrier(bar);  for (int u = blockIdx.x; u < 256; u += gridDim.x) gla::unit<true>(a, ldsb, u);  }
#endif
    if (IN(17)) { SEAM(17); }
    if (IN(18)) { pg8::DenseOrder S; S.init(NTOK, DM, DM, gridDim.x, blockIdx.x, ws + WD_COUT); pg8::EpiResid<false> E{XR, XR};
        pg8::gemm_phase(ldsb, (const char*)(ws + WS_MIX1), DM * 2, DM, S, E); SEAM(18); }
    if (IN(19)) { ph_route(a, 1, XR, HN, RSv, ctl + CW_CNT + 64, asg_e, asg_rank, asg_gate, lds); SEAM(19); }
    if (IN(20)) { ph_dispatch(ctl + CW_CNT + 64, asg_e, asg_rank, asg_gate, RSv, row_tok, row_slot, row_gate, row_rs, pst, ctl + CW_WMAX + 64, tscale); ph_cvt_moe(a, 1, lds, blockIdx.x, gridDim.x, 2); }
#if (REPMASK >> 20) & 1
    if (IN(20)) { xcd_barrier(bar);  ph_dispatch(ctl + CW_CNT + 64, asg_e, asg_rank, asg_gate, RSv, row_tok, row_slot, row_gate, row_rs, pst, ctl + CW_WMAX + 64, tscale); ph_cvt_moe(a, 1, lds, blockIdx.x, gridDim.x, 2);  }
#endif
    if (IN(20)) { SEAM(20); }
    if (IN(21)) { moe_prefix(ctl + CW_CNT + 64, pst);
        pg8::MoeOrder S{(int)gridDim.x, (int)blockIdx.x, 4, pst[NEXP] / 256, pst, row_tok, (const char*)(ws + WM_GU1), (size_t)DM * DM, (size_t)256 * DM}; pg8::EpiSwiGLU E{(bf16_t*)(ws + WS_H), tscale};
        pg8::gemm_phase<pg8::EpiSwiGLU, pg8::MoeOrder, true>(ldsb, (const char*)HN, DM, DM / 2, S, E); }
#if (REPMASK >> 21) & 1
    if (IN(21)) { xcd_barrier(bar);  moe_prefix(ctl + CW_CNT + 64, pst);
        pg8::MoeOrder S{(int)gridDim.x, (int)blockIdx.x, 4, pst[NEXP] / 256, pst, row_tok, (const char*)(ws + WM_GU1), (size_t)DM * DM, (size_t)256 * DM}; pg8::EpiSwiGLU E{(bf16_t*)(ws + WS_H), tscale};
        pg8::gemm_phase<pg8::EpiSwiGLU, pg8::MoeOrder, true>(ldsb, (const char*)HN, DM, DM / 2, S, E);  }
#endif
    if (IN(21)) { SEAM(21); }
    if (IN(22)) { moe_prefix(ctl + CW_CNT + 64, pst);
        pg8::MoeOrder S{(int)gridDim.x, (int)blockIdx.x, 4, pst[NEXP] / 256, pst, nullptr, (const char*)(ws + WM_DN), (size_t)DM * FF * 2, (size_t)256 * FF * 2}; pg8::EpiDown E{(bf16_t*)(ws + WS_Y), row_tok, row_slot, row_gate};
        pg8::gemm_phase(ldsb, (const char*)(ws + WS_H), FF * 2, FF, S, E); }
#if (REPMASK >> 22) & 1
    if (IN(22)) { xcd_barrier(bar);  moe_prefix(ctl + CW_CNT + 64, pst);
        pg8::MoeOrder S{(int)gridDim.x, (int)blockIdx.x, 4, pst[NEXP] / 256, pst, nullptr, (const char*)(ws + WM_DN), (size_t)DM * FF * 2, (size_t)256 * FF * 2}; pg8::EpiDown E{(bf16_t*)(ws + WS_Y), row_tok, row_slot, row_gate};
        pg8::gemm_phase(ldsb, (const char*)(ws + WS_H), FF * 2, FF, S, E);  }
#endif
    if (IN(22)) { SEAM(22); }
    if (IN(23)) { ph_final(XR, (const bf16_t*)(ws + WS_Y), a.in[3], a.out); }
#undef IN
#undef SEAM
}

extern "C" void kernel_launch(void* const* d_in, const int* in_sizes, int n_in, void* d_out, int out_size, void* d_ws, size_t ws_size, hipStream_t stream) {
    static int grid = 0;
    if (grid == 0) {
        if (n_in != 35 || out_size != NTOK * DM || ws_size < WS_END) { fprintf(stderr, "kernel_launch: unexpected shapes (n_in %d out %d ws %zu)\n", n_in, out_size, ws_size); grid = -1; return; }
        int dev = 0, cus = 0;
        if (hipGetDevice(&dev) != hipSuccess || hipDeviceGetAttribute(&cus, hipDeviceAttributeMultiprocessorCount, dev) != hipSuccess) { grid = -1; return; }
        if (hipFuncSetAttribute((const void*)fwd, hipFuncAttributeMaxDynamicSharedMemorySize, LDS_BYTES) != hipSuccess) { fprintf(stderr, "kernel_launch: hipFuncSetAttribute failed\n"); grid = -1; return; }
        int per_cu = 0;
        (void)hipOccupancyMaxActiveBlocksPerMultiprocessor(&per_cu, (const void*)fwd, NTHREADS, LDS_BYTES);
        (void)hipGetLastError();
        grid = cus;
        if (grid < 64) { fprintf(stderr, "kernel_launch: needs >= 64 CUs\n"); grid = -1; return; }
    }
    if (grid < 0) return;
    (void)hipMemsetAsync((char*)d_ws + WS_CTL, 0, CTL_ZERO_BYTES, stream);
    Args a{};
    for (int i = 0; i < 35; ++i) a.in[i] = (const float*)d_in[i];
    a.out = (float*)d_out; a.ws = (unsigned char*)d_ws;
#if 0
    for (int p = 0; p < NPHASE; ++p) { a.ph_lo = p; a.ph_hi = p + 1; hipLaunchKernelGGL(fwd, dim3(grid), dim3(NTHREADS), LDS_BYTES, stream, a); }
#else
    a.ph_lo = 0; a.ph_hi = NPHASE; hipLaunchKernelGGL(fwd, dim3(grid), dim3(NTHREADS), LDS_BYTES, stream, a);
#endif
}
```

```cpp
#include <hip/hip_runtime.h>
#include <cstdio>
#include <cstdint>

typedef unsigned short bf16_t;
#define LAS __attribute__((address_space(3)))
typedef float f32x4 __attribute__((ext_vector_type(4)));
typedef short bf16x8_t __attribute__((ext_vector_type(8)));
typedef unsigned u32x4_t __attribute__((ext_vector_type(4)));
typedef unsigned u32x2_t __attribute__((ext_vector_type(2)));

constexpr int NTOK = 32768, SEQ = 8192, NBATCH = 4, DM = 1024;
constexpr int ABC = 2816, RWC = 1792;
constexpr int NEXP = 32, FF = 512;
constexpr int NASG = NTOK * 2;
constexpr int MOE_TM = 256;
constexpr int MAXROWS = NASG + NEXP * MOE_TM;
constexpr int NTHREADS = 512;
constexpr int LDS_BYTES = 156 * 1024;
constexpr int LDS_MISC = 155 * 1024;

constexpr size_t MiB = 1024ull * 1024ull;
constexpr size_t WS_CTL = 0;
constexpr size_t CTL_ZERO_BYTES = 64 * 1024;
constexpr size_t WS_ROUTE = 64 * 1024;
constexpr size_t WS_WD = 8 * MiB;
constexpr size_t WD_ABIN = WS_WD, WD_ABOUT = WD_ABIN + (size_t)ABC * DM * 2, WD_CIN = WD_ABOUT + (size_t)DM * DM * 2, WD_COUT = WD_CIN + (size_t)4096 * DM * 2;
constexpr size_t WS_AR = 26 * MiB;
constexpr size_t WS_A = WS_AR;
constexpr size_t WS_B = WS_AR + 64 * MiB;
constexpr size_t WS_C = WS_B + 176 * MiB;
constexpr size_t WS_D = WS_C + 212 * MiB;
constexpr size_t DO_LRU = 112 * MiB;
constexpr size_t WS_XR = WS_AR + 360 * MiB;
constexpr size_t WS_WM = WS_AR + 64 * MiB;
constexpr size_t WM_GU1 = WS_A + 32 * MiB;
constexpr size_t WM_GU = WS_WM, WM_DN = WS_WM + (size_t)NEXP * DM * DM;
constexpr size_t WS_H = WS_WM + 96 * MiB;
constexpr size_t WS_Y = WS_H + 72 * MiB;
constexpr size_t WS_QFIG = WS_AR + 64 * MiB;
constexpr size_t WS_O = WS_QFIG + 256 * MiB;
constexpr size_t WS_MIX1 = WS_O + 128 * MiB;
constexpr size_t WS_END = WS_AR + 516 * MiB;
static_assert(WS_D + 64 * MiB <= WS_END && WS_Y + 128 * MiB <= WS_END && WS_MIX1 + 64 * MiB <= WS_END, "arena");

constexpr size_t DO_VB = 0, DO_BON = 32 * MiB, DO_SG = 34 * MiB, DO_YR = 48 * MiB;

constexpr int CW_CNT = 8192;
constexpr int CW_WMAX = CW_CNT + 512;
constexpr int CW_COLMAX = CW_WMAX + 192;
constexpr float ACT_Q = 127.f / 6.f;
constexpr size_t RT_ASG_E = 0;
constexpr size_t RT_ASG_RANK = RT_ASG_E + NASG * 4;
constexpr size_t RT_ASG_GATE = RT_ASG_RANK + NASG * 4;
constexpr size_t RT_ROW_TOK = RT_ASG_GATE + NASG * 4;
constexpr size_t RT_ROW_SLOT = RT_ROW_TOK + MAXROWS * 4;
constexpr size_t RT_ROW_GATE = RT_ROW_SLOT + MAXROWS * 4;
constexpr size_t RT_LRU_CH = RT_ROW_GATE + MAXROWS * 4;
constexpr size_t RT_LRU_CA = RT_LRU_CH + 512 * 512 * 4;
constexpr size_t RT_LRU_CIN = RT_LRU_CA + 512 * 512 * 4;
constexpr size_t RT_END = RT_LRU_CIN + 512 * 512 * 4;
constexpr size_t WS_FRAG = 6 * MiB;
constexpr size_t FG_RT = WS_FRAG + 393216;
constexpr size_t FG_W2 = WS_FRAG, FG_A2 = FG_W2 + 65536, FG_WA = FG_A2 + 65536, FG_WX = FG_WA + 65536, FG_G2 = FG_WX + 65536;
static_assert(WS_ROUTE + RT_END <= 6 * MiB, "routing arrays overflow");

__device__ __forceinline__ float bf2f(bf16_t v) { return __uint_as_float(((unsigned)v) << 16); }
typedef __bf16 bf16x2_hw __attribute__((ext_vector_type(2)));
typedef float f32x2_hw __attribute__((ext_vector_type(2)));
__device__ __forceinline__ unsigned pk2(float lo, float hi) { const f32x2_hw v = {lo, hi}; const bf16x2_hw b = __builtin_convertvector(v, bf16x2_hw); return __builtin_bit_cast(unsigned, b); }
__device__ __forceinline__ bf16_t f2bf(float f) { const __bf16 b = (__bf16)f; return __builtin_bit_cast(bf16_t, b); }
template <int CTRL> __device__ __forceinline__ float dpp_(float x) { return __builtin_bit_cast(float, __builtin_amdgcn_mov_dpp(__builtin_bit_cast(int, x), CTRL, 0xf, 0xf, true)); }
__device__ __forceinline__ float row16_sum(float v) {
    v += dpp_<0xB1>(v); v += dpp_<0x4E>(v); v += dpp_<0x124>(v); v += dpp_<0x128>(v); return v; }
__device__ __forceinline__ float xrow16_sum(float x) {
    auto s = __builtin_amdgcn_permlane16_swap(__float_as_uint(x), __float_as_uint(x), false, false);
    x = __uint_as_float(s[0]) + __uint_as_float(s[1]);
    auto t = __builtin_amdgcn_permlane32_swap(__float_as_uint(x), __float_as_uint(x), false, false);
    return __uint_as_float(t[0]) + __uint_as_float(t[1]); }
__device__ __forceinline__ float xrow32_sum(float x) {
    auto s = __builtin_amdgcn_permlane16_swap(__float_as_uint(x), __float_as_uint(x), false, false);
    return __uint_as_float(s[0]) + __uint_as_float(s[1]); }
__device__ __forceinline__ float wave_sum(float v) { return xrow16_sum(row16_sum(v)); }
__device__ __forceinline__ float sigmoidf_(float x) { return 1.f / (1.f + __expf(-x)); }
__device__ __forceinline__ float softplusf_(float x) { return fmaxf(x, 0.f) + log1pf(__expf(-fabsf(x))); }
__device__ __forceinline__ float siluf_(float x) { return x * sigmoidf_(x); }
__device__ __forceinline__ float gelu_tanhf_(float x) { const float c = 0.7978845608028654f; return 0.5f * x * (1.f + tanhf(c * (x + 0.044715f * x * x * x))); }

struct Args {
    const float* in[35];
    float* out;
    unsigned char* ws;
    int ph_lo, ph_hi;
};

#define XB_TMO      128
#define XB_XCNT(j)  (256  + 64 * (j))
#define XB_XSUB(j)  (1280 + 64 * (j))
#define XB_XGEN(j)  (2304 + 64 * (j))
#define XB_TOP      3328
#define XB_TOPGEN   3392
#define XCD_BAR_WORDS 3456
#define XB_SPIN_CAP (1u << 18)
__device__ __forceinline__ unsigned xb_ld(unsigned* p)              { return __hip_atomic_load(p, __ATOMIC_RELAXED, __HIP_MEMORY_SCOPE_AGENT); }
__device__ __forceinline__ unsigned xb_add(unsigned* p, unsigned v) { return __hip_atomic_fetch_add(p, v, __ATOMIC_RELAXED, __HIP_MEMORY_SCOPE_AGENT); }
__device__ __forceinline__ unsigned xb_xcc_id() { return (unsigned)__builtin_amdgcn_s_getreg((3 << 11) | 20) & 0xFu; }
#define XB_SPIN(cond, bar) do { unsigned _sp = 0; while (cond) { __builtin_amdgcn_s_sleep(1); \
    if ((++_sp & 255u) == 0u) { if (xb_ld(&(bar)[XB_TMO])) break; if (_sp > XB_SPIN_CAP) { atomicAdd(&(bar)[XB_TMO], 1u); break; } } } } while (0)
struct XcdBarrier { unsigned* bar; unsigned x; volatile LAS unsigned* st; };
__device__ __forceinline__ XcdBarrier xcd_barrier_post(unsigned* bar, volatile LAS unsigned* st) {
    XcdBarrier b; b.bar = bar; b.x = xb_xcc_id(); b.st = st;
    if (threadIdx.x == 0) (void)xb_add(&bar[XB_XCNT(b.x)], 1u);
    return b;
}
__device__ __forceinline__ void xcd_barrier_complete(unsigned* bar, unsigned x, unsigned& nloc, unsigned& nx) {
    const unsigned G = gridDim.x * gridDim.y * gridDim.z;
    unsigned sum, cnt, mine, sp = 0u;
    for (;;) {
        sum = 0u; cnt = 0u; mine = 0u;
#pragma unroll
        for (unsigned j = 0; j < 16; ++j) { const unsigned c = xb_ld(&bar[XB_XCNT(j)]); sum += c; cnt += (c > 0u) ? 1u : 0u; mine = (j == x) ? c : mine; }
        if (sum == G) break;
        __builtin_amdgcn_s_sleep(1);
        if ((++sp & 255u) == 0u) { if (xb_ld(&bar[XB_TMO])) break; if (sp > XB_SPIN_CAP) { atomicAdd(&bar[XB_TMO], 1u); break; } }
    }
    nloc = mine > 0u ? mine : 1u; nx = cnt > 0u ? cnt : 1u;
}
__device__ __forceinline__ void xcd_barrier(const XcdBarrier& b) {
    asm volatile("s_waitcnt vmcnt(0)" ::: "memory");
    __syncthreads();
    if (threadIdx.x == 0) {
        unsigned* bar = b.bar;
        __builtin_amdgcn_s_waitcnt(0);
        unsigned nloc = b.st[0], nx = b.st[1];
        if (nloc == 0u) { xcd_barrier_complete(bar, b.x, nloc, nx); b.st[0] = nloc; b.st[1] = nx; }
        const unsigned old = xb_add(&bar[XB_XSUB(b.x)], 1u);
        const unsigned gen = old / nloc;
        if (old + 1u == (gen + 1u) * nloc) {
            __builtin_amdgcn_fence(__ATOMIC_RELEASE, "agent");
            asm volatile("s_waitcnt vmcnt(0)" ::: "memory");
            const unsigned og = xb_add(&bar[XB_TOP], 1u);
            const unsigned tg = og / nx;
            if (og + 1u == (tg + 1u) * nx) xb_add(&bar[XB_TOPGEN], 1u);
            else XB_SPIN(xb_ld(&bar[XB_TOPGEN]) == tg, bar);
            __builtin_amdgcn_fence(__ATOMIC_ACQUIRE, "agent");
            xb_add(&bar[XB_XGEN(b.x)], 1u);
            asm volatile("s_waitcnt vmcnt(0)" ::: "memory");
        } else {
            XB_SPIN(xb_ld(&bar[XB_XGEN(b.x)]) == gen, bar);
            __builtin_amdgcn_fence(__ATOMIC_ACQUIRE, "agent");
            asm volatile("s_waitcnt vmcnt(0)" ::: "memory");
        }
    }
    __syncthreads();
}

namespace pg8 {
typedef short bf16x8 __attribute__((ext_vector_type(8)));
typedef unsigned u32x4 __attribute__((ext_vector_type(4)));
typedef int v4i_t __attribute__((ext_vector_type(4)));
constexpr int BM = 256, BK = 64, HALF = 128, HTB = HALF * BK * 2, STAGE_BYTES = 8 * HTB, NXCD = 8, WGM = 8;
__device__ __forceinline__ int lds_byte(int r, int c) { const int st = (r >> 4) * 2 + (c >> 5), rr = r & 15, cc = c & 31, ob = rr * 64 + cc * 2; return st * 1024 + (ob ^ (((ob >> 9) & 1) << 5)); }
__device__ __forceinline__ void stage_rc(int b, int& R, int& C) { const int st = b / 1024, sb = b % 1024, swz = sb ^ (((sb >> 9) & 1) << 5); R = (st >> 1) * 16 + swz / 64; C = (st & 1) * 32 + (swz % 64) / 2; }
__device__ __forceinline__ int perm32(int rho) { const int n = rho >> 4, i = rho & 15; return 8 * (i >> 2) + 4 * n + (i & 3); }
__device__ __forceinline__ unsigned cvt_pk_bf16(float lo, float hi) { unsigned r; asm volatile("v_cvt_pk_bf16_f32 %0, %1, %2" : "=v"(r) : "v"(lo), "v"(hi)); return r; }

struct Unit { int pm, pn; const char* B; };

struct DenseOrder {
    int nM, nN, nwg, G, c; const char* Bt; size_t bstep;
    __device__ void init(int M, int N, int K, int G_, int c_, const void* Bt_) { nM = M / BM; nN = N / BM; nwg = nM * nN; G = G_; c = c_; Bt = (const char*)Bt_; bstep = (size_t)BM * K * 2; }
    __device__ bool next(int i, Unit& u) const {
        const long L = (long)i * G + c; if (L >= nwg) return false;
        int wgid = (int)L; { const int q = nwg / NXCD, r = nwg % NXCD, xcd = wgid % NXCD, off = wgid / NXCD; wgid = (xcd < r ? xcd * (q + 1) : r * (q + 1) + (xcd - r) * q) + off; }
        const int nig = WGM * nN, gid = wgid / nig, fm = gid * WGM, gsz = (nM - fm) < WGM ? (nM - fm) : WGM;
        u.pm = fm + ((wgid % nig) % gsz); u.pn = (wgid % nig) / gsz; u.B = Bt + (size_t)u.pn * bstep; return true;
    }
    __device__ __forceinline__ int arow(const Unit& u, int r) const { return u.pm * BM + r; }
};
struct MoeOrder {
    int G, c, nN, ntiles; const LAS int* pst; const int* rowidx; const char* Bt; size_t estep, bstep;
    __device__ bool next(int i, Unit& u) const {
        const int cc = (G % NXCD == 0) ? (c % NXCD) * (G / NXCD) + c / NXCD : c;
        const int L = i * G + cc; if (L >= ntiles * nN) return false;
        u.pm = L / nN; u.pn = L % nN; const int row0 = u.pm * BM; int e = 0;
#pragma unroll
        for (int st = NEXP / 2; st > 0; st >>= 1) if (row0 >= pst[e + st]) e += st;
        u.B = Bt + (size_t)e * estep + (size_t)u.pn * bstep; return true;
    }
    __device__ __forceinline__ int arow(const Unit& u, int r) const { if (!rowidx) return u.pm * BM + r; const int t = rowidx[u.pm * BM + r]; return t < 0 ? 0 : t; }
};

struct EpiBf16I { static constexpr bool PERM = true; bf16_t* O; int ldc; const float* rowscale; const unsigned* colmax;
    __device__ __forceinline__ void operator()(const f32x4 (&acc)[2][2][4][2], const Unit& u, int wr, int wc, int fr, int fq) const {
        const int row0 = u.pm * BM + wr * 64 + fr, col0 = u.pn * BM + wc * 32 + 8 * fq;
        float rsc[8]; f32x4 cs[2][2];
#pragma unroll
        for (int q = 0; q < 8; ++q) rsc[q] = rowscale[row0 + (q >> 2) * HALF + (q & 3) * 16] * (1.f / 127.f);
#pragma unroll
        for (int bj = 0; bj < 2; ++bj)
#pragma unroll
            for (int n = 0; n < 2; ++n) { const u32x4 c4 = *(const u32x4*)(colmax + col0 + bj * HALF + 4 * n); cs[bj][n] = (f32x4){__uint_as_float(c4.x), __uint_as_float(c4.y), __uint_as_float(c4.z), __uint_as_float(c4.w)} * (1.f / 127.f); }
#pragma unroll
        for (int ai = 0; ai < 2; ++ai)
#pragma unroll
            for (int m = 0; m < 4; ++m) { bf16_t* rowp = O + (size_t)(row0 + ai * HALF + m * 16) * ldc + col0; const float rs = rsc[ai * 4 + m];
#pragma unroll
                for (int bj = 0; bj < 2; ++bj) { const v4i_t i0 = __builtin_bit_cast(v4i_t, acc[ai][bj][m][0]), i1 = __builtin_bit_cast(v4i_t, acc[ai][bj][m][1]);
                    const f32x4 s0 = cs[bj][0] * rs, s1 = cs[bj][1] * rs;
                    u32x4 w; w.x = cvt_pk_bf16((float)i0[0] * s0[0], (float)i0[1] * s0[1]); w.y = cvt_pk_bf16((float)i0[2] * s0[2], (float)i0[3] * s0[3]);
                    w.z = cvt_pk_bf16((float)i1[0] * s1[0], (float)i1[1] * s1[1]); w.w = cvt_pk_bf16((float)i1[2] * s1[2], (float)i1[3] * s1[3]);
                    *(u32x4*)(rowp + bj * HALF) = w; } }
    } };
struct EpiBf16 { static constexpr bool PERM = true; bf16_t* O; int ldc;
    __device__ __forceinline__ void operator()(const f32x4 (&acc)[2][2][4][2], const Unit& u, int wr, int wc, int fr, int fq) const {
        const int row0 = u.pm * BM + wr * 64 + fr, col0 = u.pn * BM + wc * 32 + 8 * fq;
#pragma unroll
        for (int ai = 0; ai < 2; ++ai)
#pragma unroll
            for (int m = 0; m < 4; ++m) { bf16_t* rowp = O + (size_t)(row0 + ai * HALF + m * 16) * ldc + col0;
#pragma unroll
                for (int bj = 0; bj < 2; ++bj) { const f32x4 v0 = acc[ai][bj][m][0], v1 = acc[ai][bj][m][1];
                    u32x4 w; w.x = cvt_pk_bf16(v0[0], v0[1]); w.y = cvt_pk_bf16(v0[2], v0[3]); w.z = cvt_pk_bf16(v1[0], v1[1]); w.w = cvt_pk_bf16(v1[2], v1[3]);
                    *(u32x4*)(rowp + bj * HALF) = w; } }
    } };
template <bool XF32> struct EpiResid { static constexpr bool PERM = true; const void* __restrict__ X; bf16_t* __restrict__ O;
    __device__ __forceinline__ void operator()(const f32x4 (&acc)[2][2][4][2], const Unit& u, int wr, int wc, int fr, int fq) const {
        const int row0 = u.pm * BM + wr * 64 + fr, col0 = u.pn * BM + wc * 32 + 8 * fq;
        if constexpr (XF32) {
#pragma unroll
            for (int ai = 0; ai < 2; ++ai)
#pragma unroll
                for (int mp = 0; mp < 2; ++mp) { f32x4 x[2][2][2];
#pragma unroll
                    for (int mm = 0; mm < 2; ++mm)
#pragma unroll
                        for (int bj = 0; bj < 2; ++bj) { const float* xp = (const float*)X + (size_t)(row0 + ai * HALF + (mp * 2 + mm) * 16) * DM + col0 + bj * HALF; x[mm][bj][0] = *(const f32x4*)xp; x[mm][bj][1] = *(const f32x4*)(xp + 4); }
#pragma unroll
                    for (int mm = 0; mm < 2; ++mm)
#pragma unroll
                        for (int bj = 0; bj < 2; ++bj) { const f32x4 v0 = x[mm][bj][0] + acc[ai][bj][mp * 2 + mm][0], v1 = x[mm][bj][1] + acc[ai][bj][mp * 2 + mm][1];
                            u32x4 w; w.x = cvt_pk_bf16(v0[0], v0[1]); w.y = cvt_pk_bf16(v0[2], v0[3]); w.z = cvt_pk_bf16(v1[0], v1[1]); w.w = cvt_pk_bf16(v1[2], v1[3]);
                            *(u32x4*)(O + (size_t)(row0 + ai * HALF + (mp * 2 + mm) * 16) * DM + col0 + bj * HALF) = w; } }
        } else {
#pragma unroll
            for (int ai = 0; ai < 2; ++ai) { u32x4 x[4][2];
#pragma unroll
                for (int m = 0; m < 4; ++m)
#pragma unroll
                    for (int bj = 0; bj < 2; ++bj) x[m][bj] = *(const u32x4*)((const bf16_t*)X + (size_t)(row0 + ai * HALF + m * 16) * DM + col0 + bj * HALF);
#pragma unroll
                for (int m = 0; m < 4; ++m)
#pragma unroll
                    for (int bj = 0; bj < 2; ++bj) { const u32x4 o = x[m][bj];
                        const f32x4 v0 = (f32x4){__uint_as_float(o.x << 16), __uint_as_float(o.x & 0xffff0000u), __uint_as_float(o.y << 16), __uint_as_float(o.y & 0xffff0000u)} + acc[ai][bj][m][0];
                        const f32x4 v1 = (f32x4){__uint_as_float(o.z << 16), __uint_as_float(o.z & 0xffff0000u), __uint_as_float(o.w << 16), __uint_as_float(o.w & 0xffff0000u)} + acc[ai][bj][m][1];
                        u32x4 w; w.x = cvt_pk_bf16(v0[0], v0[1]); w.y = cvt_pk_bf16(v0[2], v0[3]); w.z = cvt_pk_bf16(v1[0], v1[1]); w.w = cvt_pk_bf16(v1[2], v1[3]);
                        *(u32x4*)(O + (size_t)(row0 + ai * HALF + m * 16) * DM + col0 + bj * HALF) = w; } }
        }
    } };
struct EpiSwiGLU { static constexpr bool PERM = true; bf16_t* H; const float* tscale;
    __device__ __forceinline__ void operator()(const f32x4 (&acc)[2][2][4][2], const Unit& u, int wr, int wc, int fr, int fq) const {
        const int row0 = u.pm * BM + wr * 64 + fr, col0 = u.pn * HALF + wc * 32 + 8 * fq;
        const float s0 = tscale[2 * u.pm], s1 = tscale[2 * u.pm + 1];
#pragma unroll
        for (int ai = 0; ai < 2; ++ai)
#pragma unroll
            for (int m = 0; m < 4; ++m) { float h[8];
#pragma unroll
                for (int n = 0; n < 2; ++n) { const v4i_t gi = __builtin_bit_cast(v4i_t, acc[ai][0][m][n]), ui = __builtin_bit_cast(v4i_t, acc[ai][1][m][n]);
#pragma unroll
                    for (int j = 0; j < 4; ++j) { const float g = (float)gi[j] * s0; h[n * 4 + j] = g * __builtin_amdgcn_rcpf(1.f + __expf(-g)) * ((float)ui[j] * s1); } }
                u32x4 w; w.x = cvt_pk_bf16(h[0], h[1]); w.y = cvt_pk_bf16(h[2], h[3]); w.z = cvt_pk_bf16(h[4], h[5]); w.w = cvt_pk_bf16(h[6], h[7]);
                *(u32x4*)(H + (size_t)(row0 + ai * HALF + m * 16) * FF + col0) = w; }
    } };
struct EpiDown { static constexpr bool PERM = true; bf16_t* Y; const int* row_tok; const int* row_slot; const float* row_gate;
    __device__ __forceinline__ void operator()(const f32x4 (&acc)[2][2][4][2], const Unit& u, int wr, int wc, int fr, int fq) const {
        const int row0 = u.pm * BM + wr * 64 + fr, col0 = u.pn * BM + wc * 32 + 8 * fq;
        int tk[8], sl[8]; float gt[8];
#pragma unroll
        for (int q = 0; q < 8; ++q) { const int r = row0 + (q >> 2) * HALF + (q & 3) * 16; tk[q] = row_tok[r]; sl[q] = row_slot[r]; gt[q] = row_gate[r]; }
#pragma unroll
        for (int ai = 0; ai < 2; ++ai)
#pragma unroll
            for (int m = 0; m < 4; ++m) { const int q = ai * 4 + m;
                if (tk[q] < 0) continue;
                bf16_t* rowp = Y + (size_t)sl[q] * DM + col0;
#pragma unroll
                for (int bj = 0; bj < 2; ++bj) { const f32x4 v0 = acc[ai][bj][m][0] * gt[q], v1 = acc[ai][bj][m][1] * gt[q];
                    u32x4 w; w.x = cvt_pk_bf16(v0[0], v0[1]); w.y = cvt_pk_bf16(v0[2], v0[3]); w.z = cvt_pk_bf16(v1[0], v1[1]); w.w = cvt_pk_bf16(v1[2], v1[3]);
                    *(u32x4*)(rowp + bj * HALF) = w; } }
    } };

template <class Epi, class Sched, bool I8 = false>
__device__ __forceinline__ void gemm_phase(LAS unsigned char* lds, const char* A, const unsigned lda_b, const int K, const Sched& S, const Epi& E) {
    const int tid = threadIdx.x, wid = __builtin_amdgcn_readfirstlane(tid >> 6), lane = tid & 63, wr = wid >> 2, wc = wid & 3, fr = lane & 15, fq = lane >> 4;
    const int nt = K / BK;
    unsigned voffB[2];
#pragma unroll
    for (int i = 0; i < 2; ++i) { int R, C; stage_rc(tid * 16 + i * 8192, R, C); const int Rb = Epi::PERM ? ((R & ~31) + perm32(R & 31)) : R; voffB[i] = (unsigned)(Rb * K + C) * 2u; }
    const size_t kstep = (size_t)(BK * 2);
    const size_t hstepB = (size_t)HALF * K * 2;
    const unsigned ldsw = (unsigned)wid * 1024u;
    const int aoff = lds_byte(wr * 64 + fr, fq * 8), boff = lds_byte(wc * 32 + fr, fq * 8);
#define PG8_SA(b, h) (((b) * 2 + (h)) * HTB)
#define PG8_SB(b, h) ((4 + (b) * 2 + (h)) * HTB)
#define PG8_STAGE(bufoff, gbase, voff) do { _Pragma("unroll") for (int _i = 0; _i < 2; ++_i) \
        __builtin_amdgcn_global_load_lds((const unsigned*)((const char*)(gbase) + (voff)[_i]), (LAS unsigned*)(lds + (bufoff) + ldsw + _i * 8192), 16, 0, 0); } while (0)
#define PG8_LDA(dst, b, h) do { _Pragma("unroll") for (int m = 0; m < 4; ++m) _Pragma("unroll") for (int k = 0; k < 2; ++k) dst[m][k] = *(const LAS bf16x8*)(lds + PG8_SA(b, h) + aoff + m * 2048 + k * 1024); } while (0)
#define PG8_LDB(dst, b, h) do { _Pragma("unroll") for (int n = 0; n < 2; ++n) _Pragma("unroll") for (int k = 0; k < 2; ++k) dst[n][k] = *(const LAS bf16x8*)(lds + PG8_SB(b, h) + boff + n * 2048 + k * 1024); } while (0)
#define PG8_MMA(ai, bj, At, Bt) do { __builtin_amdgcn_s_setprio(1); _Pragma("unroll") for (int m = 0; m < 4; ++m) _Pragma("unroll") for (int n = 0; n < 2; ++n) _Pragma("unroll") for (int k = 0; k < 2; ++k) { \
        if constexpr (I8) acc[ai][bj][m][n] = __builtin_bit_cast(f32x4, __builtin_amdgcn_mfma_i32_16x16x64_i8(__builtin_bit_cast(v4i_t, Bt[n][k]), __builtin_bit_cast(v4i_t, At[m][k]), __builtin_bit_cast(v4i_t, acc[ai][bj][m][n]), 0, 0, 0)); \
        else acc[ai][bj][m][n] = __builtin_amdgcn_mfma_f32_16x16x32_bf16(Bt[n][k], At[m][k], acc[ai][bj][m][n], 0, 0, 0); } __builtin_amdgcn_s_setprio(0); } while (0)
#define PG8_WAIT_V(n) asm volatile("s_waitcnt vmcnt(" #n ")" ::: "memory")
#define PG8_WAIT_L(n) asm volatile("s_waitcnt lgkmcnt(" #n ")" ::: "memory")
#define PG8_BAR __builtin_amdgcn_s_barrier()
#define PG8_SCHED __builtin_amdgcn_sched_barrier(0)
#define PG8_AOFF(dst, u) do { int _tz = threadIdx.x; asm volatile("" : "+v"(_tz)); _Pragma("unroll") for (int _i = 0; _i < 2; ++_i) { int _R, _C; stage_rc(_tz * 16 + _i * 8192, _R, _C); \
        _Pragma("unroll") for (int _h = 0; _h < 2; ++_h) dst[_h][_i] = (unsigned)S.arow(u, _h * HALF + _R) * lda_b + (unsigned)_C * 2u; } } while (0)
    Unit cur, nxt; int ui = 0;
    if (!S.next(0, cur)) return;
    f32x4 acc[2][2][4][2];
#pragma unroll
    for (int a = 0; a < 2; ++a)
#pragma unroll
        for (int b = 0; b < 2; ++b)
#pragma unroll
            for (int m = 0; m < 4; ++m)
#pragma unroll
                for (int n = 0; n < 2; ++n) acc[a][b][m][n] = (f32x4){0.f, 0.f, 0.f, 0.f};
    bf16x8 At[4][2], B0[2][2], B1[2][2];
    unsigned vA[2][2], vAn[2][2];
    PG8_AOFF(vA, cur);
    const char* cB = cur.B;
    PG8_STAGE(PG8_SB(0, 0), cB, voffB); PG8_STAGE(PG8_SA(0, 0), A, vA[0]); PG8_STAGE(PG8_SB(0, 1), cB + hstepB, voffB); PG8_STAGE(PG8_SA(0, 1), A, vA[1]);
    if (wr == 1) PG8_BAR;
    PG8_WAIT_V(4); PG8_BAR;
    PG8_STAGE(PG8_SB(1, 0), cB + kstep, voffB); PG8_STAGE(PG8_SA(1, 0), A + kstep, vA[0]); PG8_STAGE(PG8_SB(1, 1), cB + hstepB + kstep, voffB);
    PG8_WAIT_V(6); PG8_BAR;
    for (;;) {
        const bool has_next = S.next(ui + 1, nxt);
        if (has_next) { PG8_AOFF(vAn, nxt); } else {
#pragma unroll
            for (int h = 0; h < 2; ++h)
#pragma unroll
                for (int i = 0; i < 2; ++i) vAn[h][i] = vA[h][i]; }
        const char* nB = has_next ? nxt.B : cB;
        for (int t = 0; t < nt; t += 2) {
            const bool last = (t == nt - 2);
            const char* a1 = A + (size_t)(t + 1) * kstep;
            const char* a2 = last ? A : A + (size_t)(t + 2) * kstep; const char* b2 = last ? nB : cB + (size_t)(t + 2) * kstep;
            const char* a3 = a2 + kstep; const char* b3 = b2 + kstep;
            unsigned o2[2][2];
#pragma unroll
            for (int h = 0; h < 2; ++h)
#pragma unroll
                for (int i = 0; i < 2; ++i) o2[h][i] = last ? vAn[h][i] : vA[h][i];
            PG8_LDB(B0, 0, 0); PG8_SCHED; PG8_LDA(At, 0, 0); PG8_STAGE(PG8_SA(1, 1), a1, vA[1]);
            PG8_WAIT_L(8); PG8_BAR; PG8_WAIT_L(0); PG8_MMA(0, 0, At, B0); PG8_BAR; PG8_SCHED;
            PG8_LDB(B1, 0, 1); PG8_STAGE(PG8_SB(0, 0), b2, voffB);
            PG8_BAR; PG8_WAIT_L(0); PG8_MMA(0, 1, At, B1); PG8_BAR;
            PG8_LDA(At, 0, 1); PG8_STAGE(PG8_SA(0, 0), a2, o2[0]);
            PG8_BAR; PG8_WAIT_L(0); PG8_MMA(1, 0, At, B0); PG8_BAR; PG8_SCHED;
            PG8_STAGE(PG8_SB(0, 1), b2 + hstepB, voffB);
            PG8_WAIT_V(6); PG8_BAR; PG8_MMA(1, 1, At, B1); PG8_BAR;
            PG8_LDB(B0, 1, 0); PG8_SCHED; PG8_LDA(At, 1, 0); PG8_STAGE(PG8_SA(0, 1), a2, o2[1]);
            PG8_WAIT_L(8); PG8_BAR; PG8_WAIT_L(0); PG8_MMA(0, 0, At, B0); PG8_BAR; PG8_SCHED;
            PG8_LDB(B1, 1, 1); PG8_STAGE(PG8_SB(1, 0), b3, voffB);
            PG8_BAR; PG8_WAIT_L(0); PG8_MMA(0, 1, At, B1); PG8_BAR;
            PG8_LDA(At, 1, 1); PG8_STAGE(PG8_SA(1, 0), a3, o2[0]);
            PG8_BAR; PG8_WAIT_L(0); PG8_MMA(1, 0, At, B0); PG8_BAR; PG8_SCHED;
            PG8_STAGE(PG8_SB(1, 1), b3 + hstepB, voffB);
            PG8_WAIT_V(6); PG8_BAR; PG8_MMA(1, 1, At, B1); PG8_BAR;
        }
        E(acc, cur, wr, wc, fr, fq);
        if (!has_next) break;
#pragma unroll
        for (int a = 0; a < 2; ++a)
#pragma unroll
            for (int b = 0; b < 2; ++b)
#pragma unroll
                for (int m = 0; m < 4; ++m)
#pragma unroll
                    for (int n = 0; n < 2; ++n) acc[a][b][m][n] = (f32x4){0.f, 0.f, 0.f, 0.f};
        cur = nxt; cB = nB; ++ui;
#pragma unroll
        for (int h = 0; h < 2; ++h)
#pragma unroll
            for (int i = 0; i < 2; ++i) vA[h][i] = vAn[h][i];
    }
    PG8_WAIT_V(0);
    if (wr == 0) PG8_BAR;
    PG8_BAR;
#undef PG8_SA
#undef PG8_SB
#undef PG8_STAGE
#undef PG8_LDA
#undef PG8_LDB
#undef PG8_MMA
#undef PG8_WAIT_V
#undef PG8_WAIT_L
#undef PG8_BAR
#undef PG8_SCHED
#undef PG8_AOFF
}
}

template <int MODE>
__device__ __forceinline__ void transpose_item(const float* W, int K, int N, bf16_t* WT, LAS float* scr, int item, int lane) {
    const int nblk = N / 64, kb = item / nblk, nb = item % nblk, k0 = 64 * kb, n0 = 64 * nb;
    const int lr = lane >> 4, lc = (lane & 15) * 4;
    float4 v[16];
#pragma unroll
    for (int i = 0; i < 16; ++i) v[i] = *(const float4*)(W + (size_t)(k0 + 4 * i + lr) * N + n0 + lc);
#pragma unroll
    for (int i = 0; i < 16; ++i) { LAS float* d = scr + (4 * i + lr) * 66 + lc; *(LAS f32x2_hw*)d = (f32x2_hw){v[i].x, v[i].y}; *(LAS f32x2_hw*)(d + 2) = (f32x2_hw){v[i].z, v[i].w}; }
    asm volatile("s_waitcnt lgkmcnt(0)" ::: "memory");
    const int c = lane & 7;
#pragma unroll
    for (int j = 0; j < 8; ++j) { const int n = (lane >> 3) + 8 * j; const LAS float* sp = scr + (8 * c) * 66 + n;
        pg8::u32x4 o; o.x = pk2(sp[0 * 66], sp[1 * 66]); o.y = pk2(sp[2 * 66], sp[3 * 66]); o.z = pk2(sp[4 * 66], sp[5 * 66]); o.w = pk2(sp[6 * 66], sp[7 * 66]);
        const int nn = n0 + n; const int dr = MODE == 0 ? nn : (256 * (nn >> 7) + (nn & 127) + (MODE == 2 ? 128 : 0));
        *(pg8::u32x4*)(WT + (size_t)dr * K + k0 + 8 * c) = o; }
    asm volatile("s_waitcnt lgkmcnt(0)" ::: "memory");
}
__device__ __forceinline__ float wave_max(float v) {
    v = fmaxf(v, dpp_<0xB1>(v)); v = fmaxf(v, dpp_<0x4E>(v)); v = fmaxf(v, dpp_<0x124>(v)); v = fmaxf(v, dpp_<0x128>(v));
    auto s = __builtin_amdgcn_permlane16_swap(__float_as_uint(v), __float_as_uint(v), false, false); v = fmaxf(__uint_as_float(s[0]), __uint_as_float(s[1]));
    auto t = __builtin_amdgcn_permlane32_swap(__float_as_uint(v), __float_as_uint(v), false, false); return fmaxf(__uint_as_float(t[0]), __uint_as_float(t[1])); }
__device__ __forceinline__ unsigned q8x4(float a, float b, float c, float d, float qs) {
    const int ia = (int)rintf(fminf(fmaxf(a * qs, -127.f), 127.f)), ib = (int)rintf(fminf(fmaxf(b * qs, -127.f), 127.f)), ic = (int)rintf(fminf(fmaxf(c * qs, -127.f), 127.f)), id = (int)rintf(fminf(fmaxf(d * qs, -127.f), 127.f));
    return (unsigned)(ia & 255) | ((unsigned)(ib & 255) << 8) | ((unsigned)(ic & 255) << 16) | ((unsigned)(id & 255) << 24); }
__device__ __noinline__ void ph_wmax(const float* wg, const float* wu, unsigned* wmax, int bid, int nblk) {
    const int wave = threadIdx.x >> 6, lane = threadIdx.x & 63, gw = bid * 8 + wave, NGW = nblk * 8;
    constexpr int IT = (DM / 64) * (FF / 64);
    for (int it = gw; it < 2 * NEXP * 2 * IT; it += NGW) { const int mat = it / IT, tl = it % IT; const int le = mat >> 1, gu = mat & 1;
        const float* W = (gu ? wu : wg) + (size_t)le * DM * FF; const int k0 = 64 * (tl / (FF / 64)), n0 = 64 * (tl % (FF / 64));
        float m = 0.f;
#pragma unroll 4
        for (int i = 0; i < 16; ++i) { const float4 v = *(const float4*)(W + (size_t)(k0 + 4 * i + (lane >> 4)) * FF + n0 + (lane & 15) * 4); m = fmaxf(fmaxf(m, fmaxf(fabsf(v.x), fabsf(v.y))), fmaxf(fabsf(v.z), fabsf(v.w))); }
        m = wave_max(m);
        if (lane == 0) atomicMax(wmax + le * 2 + gu, __float_as_uint(m)); }
}
template <int MODE>
__device__ __forceinline__ void transpose_item_i8(const float* W, int K, int N, unsigned char* WT, LAS float* scr, int item, int lane, float qs) {
    const int nblk = N / 64, kb = item / nblk, nb = item % nblk, k0 = 64 * kb, n0 = 64 * nb;
    const int lr = lane >> 4, lc = (lane & 15) * 4;
    float4 v[16];
#pragma unroll
    for (int i = 0; i < 16; ++i) v[i] = *(const float4*)(W + (size_t)(k0 + 4 * i + lr) * N + n0 + lc);
#pragma unroll
    for (int i = 0; i < 16; ++i) { LAS float* d = scr + (4 * i + lr) * 66 + lc; *(LAS f32x2_hw*)d = (f32x2_hw){v[i].x, v[i].y}; *(LAS f32x2_hw*)(d + 2) = (f32x2_hw){v[i].z, v[i].w}; }
    asm volatile("s_waitcnt lgkmcnt(0)" ::: "memory");
    const int c = lane & 3;
#pragma unroll
    for (int j = 0; j < 4; ++j) { const int n = (lane >> 2) + 16 * j; const LAS float* sp = scr + (16 * c) * 66 + n;
        pg8::u32x4 o;
        o.x = q8x4(sp[0 * 66], sp[1 * 66], sp[2 * 66], sp[3 * 66], qs); o.y = q8x4(sp[4 * 66], sp[5 * 66], sp[6 * 66], sp[7 * 66], qs);
        o.z = q8x4(sp[8 * 66], sp[9 * 66], sp[10 * 66], sp[11 * 66], qs); o.w = q8x4(sp[12 * 66], sp[13 * 66], sp[14 * 66], sp[15 * 66], qs);
        const int nn = n0 + n; const int dr = MODE == 0 ? nn : (256 * (nn >> 7) + (nn & 127) + (MODE == 2 ? 128 : 0));
        *(pg8::u32x4*)(WT + (size_t)dr * K + k0 + 16 * c) = o; }
    asm volatile("s_waitcnt lgkmcnt(0)" ::: "memory");
}
__device__ __forceinline__ void transpose_item_i8c(const float* W, int K, int N, unsigned char* WT, LAS float* scr, int item, int lane, const unsigned* colmax) {
    const int nblk = N / 64, kb = item / nblk, nb = item % nblk, k0 = 64 * kb, n0 = 64 * nb;
    const int lr = lane >> 4, lc = (lane & 15) * 4;
    float4 v[16];
#pragma unroll
    for (int i = 0; i < 16; ++i) v[i] = *(const float4*)(W + (size_t)(k0 + 4 * i + lr) * N + n0 + lc);
#pragma unroll
    for (int i = 0; i < 16; ++i) { LAS float* d = scr + (4 * i + lr) * 66 + lc; *(LAS f32x2_hw*)d = (f32x2_hw){v[i].x, v[i].y}; *(LAS f32x2_hw*)(d + 2) = (f32x2_hw){v[i].z, v[i].w}; }
    asm volatile("s_waitcnt lgkmcnt(0)" ::: "memory");
    const int c = lane & 3;
#pragma unroll
    for (int j = 0; j < 4; ++j) { const int n = (lane >> 2) + 16 * j; const LAS float* sp = scr + (16 * c) * 66 + n;
        const float qs = 127.f / fmaxf(__uint_as_float(colmax[n0 + n]), 1e-30f);
        pg8::u32x4 o;
        o.x = q8x4(sp[0 * 66], sp[1 * 66], sp[2 * 66], sp[3 * 66], qs); o.y = q8x4(sp[4 * 66], sp[5 * 66], sp[6 * 66], sp[7 * 66], qs);
        o.z = q8x4(sp[8 * 66], sp[9 * 66], sp[10 * 66], sp[11 * 66], qs); o.w = q8x4(sp[12 * 66], sp[13 * 66], sp[14 * 66], sp[15 * 66], qs);
        *(pg8::u32x4*)(WT + (size_t)(n0 + n) * K + k0 + 16 * c) = o; }
    asm volatile("s_waitcnt lgkmcnt(0)" ::: "memory");
}
__device__ __forceinline__ void frag_build(const float* W, int ldw, int col0, int nks, bf16_t* dst, int lane) {
    const int q4 = lane >> 4, c16 = lane & 15;
    for (int ct = 0; ct < 4; ++ct) for (int ks = 0; ks < nks; ++ks) { float v[8];
#pragma unroll
        for (int jj = 0; jj < 8; ++jj) v[jj] = W[(size_t)(32 * ks + 8 * q4 + jj) * ldw + col0 + 16 * ct + c16];
        *(pg8::u32x4*)(dst + ((size_t)(ct * nks + ks) * 64 + lane) * 8) = (pg8::u32x4){pk2(v[0], v[1]), pk2(v[2], v[3]), pk2(v[4], v[5]), pk2(v[6], v[7])}; }
}
__device__ __forceinline__ void ph_cvt_frags(const Args& a) {
    const int wave = threadIdx.x >> 6, lane = threadIdx.x & 63, gw = blockIdx.x * 8 + wave;
    if (gw >= 40) {
        const int it = gw - 40; if (it >= 64) return;
        const int L = it >> 5, ks = it & 31, q4 = lane >> 4, c16 = lane & 15;
        const float* gain = a.in[2] + L * DM; const float* wg = a.in[28] + (size_t)L * DM * 4; const float* we = a.in[30] + (size_t)L * DM * 32;
        bf16_t* dh = (bf16_t*)(a.ws + FG_RT) + (size_t)L * 2 * 49152; bf16_t* dl = dh + 49152;
        for (int ct = 0; ct < 3; ++ct) { const int col = 16 * ct + c16; float hi[8], lo[8];
#pragma unroll
            for (int jj = 0; jj < 8; ++jj) { const int k = 32 * ks + 8 * q4 + jj; const float w = col < 4 ? wg[k * 4 + col] : (col < 36 ? we[k * 32 + col - 4] : 0.f); const float v = gain[k] * w;
                hi[jj] = bf2f(f2bf(v)); lo[jj] = v - hi[jj]; }
            const size_t o = ((size_t)(ks * 3 + ct) * 64 + lane) * 8;
            *(pg8::u32x4*)(dh + o) = (pg8::u32x4){pk2(hi[0], hi[1]), pk2(hi[2], hi[3]), pk2(hi[4], hi[5]), pk2(hi[6], hi[7])};
            *(pg8::u32x4*)(dl + o) = (pg8::u32x4){pk2(lo[0], lo[1]), pk2(lo[2], lo[3]), pk2(lo[4], lo[5]), pk2(lo[6], lo[7])}; }
        return; }
    const int arr = gw >> 3, h = gw & 7;
    if (arr == 0) frag_build(a.in[7], 512, 64 * h, 2, (bf16_t*)(a.ws + FG_W2) + h * 4096, lane);
    else if (arr == 1) frag_build(a.in[9], 512, 64 * h, 2, (bf16_t*)(a.ws + FG_A2) + h * 4096, lane);
    else if (arr == 2) frag_build(a.in[18] + h * 4096, 64, 0, 2, (bf16_t*)(a.ws + FG_WA) + h * 4096, lane);
    else if (arr == 3) frag_build(a.in[20] + h * 4096, 64, 0, 2, (bf16_t*)(a.ws + FG_WX) + h * 4096, lane);
    else frag_build(a.in[10], 512, 64 * h, 4, (bf16_t*)(a.ws + FG_G2) + h * 8192, lane);
}
__device__ __forceinline__ void ph_cvt_dense_a(const Args& a, LAS float* lds, unsigned* colmax) {
    const int wave = threadIdx.x >> 6, lane = threadIdx.x & 63, gw = blockIdx.x * 8 + wave, NGW = gridDim.x * 8;
    LAS float* scr = lds + wave * (64 * 66);
    constexpr int I0 = (DM / 64) * (ABC / 64), I1 = (DM / 64) * (DM / 64), I2 = (DM / 64) * (4096 / 64), I3 = I1;
    for (int it = gw; it < I0 + I1 + I2 + I3; it += NGW) { int r = it;
        if (r < I1) { transpose_item<0>(a.in[23], DM, DM, (bf16_t*)(a.ws + WD_ABOUT), scr, r, lane); continue; } r -= I1;
        if (r < I3) { transpose_item<0>(a.in[27], DM, DM, (bf16_t*)(a.ws + WD_COUT), scr, r, lane); continue; } r -= I3;
        const int m = r < I0 ? 0 : 1; if (m) r -= I0; const int N = m ? 4096 : ABC; const float* W = m ? a.in[24] : a.in[4];
        const int k0 = 64 * (r / (N / 64)), n0 = 64 * (r % (N / 64)); float mx[4] = {0.f, 0.f, 0.f, 0.f};
#pragma unroll 4
        for (int i = 0; i < 16; ++i) { const float4 v = *(const float4*)(W + (size_t)(k0 + 4 * i + (lane >> 4)) * N + n0 + (lane & 15) * 4);
            mx[0] = fmaxf(mx[0], fabsf(v.x)); mx[1] = fmaxf(mx[1], fabsf(v.y)); mx[2] = fmaxf(mx[2], fabsf(v.z)); mx[3] = fmaxf(mx[3], fabsf(v.w)); }
#pragma unroll
        for (int q = 0; q < 4; ++q) { float t = mx[q];
            auto s1 = __builtin_amdgcn_permlane16_swap(__float_as_uint(t), __float_as_uint(t), false, false); t = fmaxf(__uint_as_float(s1[0]), __uint_as_float(s1[1]));
            auto s2 = __builtin_amdgcn_permlane32_swap(__float_as_uint(t), __float_as_uint(t), false, false); t = fmaxf(__uint_as_float(s2[0]), __uint_as_float(s2[1]));
            if (lane < 16) atomicMax(colmax + (m ? ABC : 0) + n0 + lane * 4 + q, __float_as_uint(t)); } }
}
__device__ __forceinline__ void ph_cvt_dense_b(const Args& a, LAS float* lds, const unsigned* colmax, int m) {
    const int wave = threadIdx.x >> 6, lane = threadIdx.x & 63, gw = blockIdx.x * 8 + wave, NGW = gridDim.x * 8;
    LAS float* scr = lds + wave * (64 * 66);
    const int N = m ? 4096 : ABC; const int NI = (DM / 64) * (N / 64);
    for (int it = gw; it < NI; it += NGW) transpose_item_i8c(m ? a.in[24] : a.in[4], DM, N, a.ws + (m ? WD_CIN : WD_ABIN), scr, it, lane, colmax + (m ? ABC : 0));
}
__device__ __forceinline__ void ph_cvt_moe(const Args& a, int L, LAS float* lds, int bid, int nblk, int which) {
    const int wave = threadIdx.x >> 6, lane = threadIdx.x & 63, gw = bid * 8 + wave, NGW = nblk * 8;
    LAS float* scr = lds + wave * (64 * 66);
    constexpr int IG = (DM / 64) * (FF / 64), ID = (FF / 64) * (DM / 64);
    const int i0 = (which & 1) ? 0 : 2 * IG, IE = ((which & 1) ? 2 * IG : 0) + ((which & 2) ? ID : 0);
    unsigned char* gub = a.ws + (L ? WM_GU1 : WM_GU);
    for (int it = gw; it < NEXP * IE; it += NGW) { const int e = it / IE; int r = i0 + it % IE;
        unsigned char* gu = gub + (size_t)e * DM * DM; bf16_t* dn = (bf16_t*)(a.ws + WM_DN) + (size_t)e * DM * FF;
        const unsigned* wm = (const unsigned*)(a.ws + WS_CTL) + CW_WMAX + (L * NEXP + e) * 2;
        const size_t wo = ((size_t)L * NEXP + e) * DM * FF;
        if (r < IG) { transpose_item_i8<1>(a.in[32] + wo, DM, FF, gu, scr, r, lane, 127.f / fmaxf(__uint_as_float(wm[0]), 1e-30f)); continue; } r -= IG;
        if (r < IG) { transpose_item_i8<2>(a.in[33] + wo, DM, FF, gu, scr, r, lane, 127.f / fmaxf(__uint_as_float(wm[1]), 1e-30f)); continue; } r -= IG;
        transpose_item<0>(a.in[34] + wo, FF, DM, dn, scr, r, lane); }
}

__device__ __forceinline__ void load_row16(const float* row, int lane, float4 (&v)[4]) {
#pragma unroll
    for (int j = 0; j < 4; ++j) v[j] = *(const float4*)(row + lane * 4 + 256 * j);
}
__device__ __forceinline__ float row_sumsq(const float4 (&v)[4]) {
    float s = 0.f;
#pragma unroll
    for (int j = 0; j < 4; ++j) s += v[j].x * v[j].x + v[j].y * v[j].y + v[j].z * v[j].z + v[j].w * v[j].w;
    return wave_sum(s);
}
__device__ __forceinline__ void norm_row(float4 (&v)[4], const float* gain, int lane) {
    const float rs = rsqrtf(row_sumsq(v) * (1.f / DM) + 1e-6f);
#pragma unroll
    for (int j = 0; j < 4; ++j) { const float4 g = *(const float4*)(gain + lane * 4 + 256 * j);
        v[j].x *= rs * g.x; v[j].y *= rs * g.y; v[j].z *= rs * g.z; v[j].w *= rs * g.w; }
}
__device__ __forceinline__ void store_row_bf16(bf16_t* row, int lane, const float4 (&v)[4]) {
#pragma unroll
    for (int j = 0; j < 4; ++j) { uint2 o; o.x = f2bf(v[j].x) | ((unsigned)f2bf(v[j].y) << 16); o.y = f2bf(v[j].z) | ((unsigned)f2bf(v[j].w) << 16);
        *(uint2*)(row + lane * 4 + 256 * j) = o; }
}
__device__ __forceinline__ void add_row_bf16(const bf16_t* row, int lane, float4 (&v)[4]) {
#pragma unroll
    for (int j = 0; j < 4; ++j) { const uint2 o = *(const uint2*)(row + lane * 4 + 256 * j);
        v[j].x += __uint_as_float(o.x << 16); v[j].y += __uint_as_float(o.x & 0xffff0000u); v[j].z += __uint_as_float(o.y << 16); v[j].w += __uint_as_float(o.y & 0xffff0000u); }
}

__device__ __forceinline__ void ph_norm0(const float* x, const float* gain, unsigned char* HN8, float* rowscale) {
    const int lane = threadIdx.x & 63, gw = blockIdx.x * 8 + (threadIdx.x >> 6), NGW = gridDim.x * 8;
    for (int n = gw; n < NTOK; n += NGW) { float4 v[4]; load_row16(x + (size_t)n * DM, lane, v); norm_row(v, gain, lane);
        float mx = 0.f;
#pragma unroll
        for (int j = 0; j < 4; ++j) mx = fmaxf(fmaxf(mx, fmaxf(fabsf(v[j].x), fabsf(v[j].y))), fmaxf(fabsf(v[j].z), fabsf(v[j].w)));
        mx = fmaxf(wave_max(mx), 1e-30f); const float qs = 127.f / mx;
        if (lane == 0) rowscale[n] = mx;
#pragma unroll
        for (int j = 0; j < 4; ++j) *(unsigned*)(HN8 + (size_t)n * DM + lane * 4 + 256 * j) = q8x4(v[j].x, v[j].y, v[j].z, v[j].w, qs); }
}
__device__ __forceinline__ void ld8bf(const bf16_t* p, float (&v)[8]) { const u32x4_t o = *(const u32x4_t*)p;
    v[0] = __uint_as_float(o.x << 16); v[1] = __uint_as_float(o.x & 0xffff0000u); v[2] = __uint_as_float(o.y << 16); v[3] = __uint_as_float(o.y & 0xffff0000u);
    v[4] = __uint_as_float(o.z << 16); v[5] = __uint_as_float(o.z & 0xffff0000u); v[6] = __uint_as_float(o.w << 16); v[7] = __uint_as_float(o.w & 0xffff0000u); }
__device__ __forceinline__ void st8bf(bf16_t* p, const float (&v)[8]) { *(u32x4_t*)p = (u32x4_t){pk2(v[0], v[1]), pk2(v[2], v[3]), pk2(v[4], v[5]), pk2(v[6], v[7])}; }
__device__ __forceinline__ void ph_combine_norm(bf16_t* XR, const bf16_t* Y, const float* gain, unsigned char* HN8, float* rowscale) {
    const int lane = threadIdx.x & 63, gw = blockIdx.x * 8 + (threadIdx.x >> 6), NGW = gridDim.x * 8;
    for (int n = gw; n < NTOK; n += NGW) { float x[2][8], y0[2][8], y1[2][8]; float ss = 0.f;
#pragma unroll
        for (int j = 0; j < 2; ++j) { const int o = lane * 8 + 512 * j; ld8bf(XR + (size_t)n * DM + o, x[j]); ld8bf(Y + (size_t)(2 * n) * DM + o, y0[j]); ld8bf(Y + (size_t)(2 * n + 1) * DM + o, y1[j]); }
#pragma unroll
        for (int j = 0; j < 2; ++j) {
#pragma unroll
            for (int i = 0; i < 8; ++i) x[j][i] = bf2f(f2bf(x[j][i] + y0[j][i] + y1[j][i]));
            st8bf(XR + (size_t)n * DM + lane * 8 + 512 * j, x[j]);
#pragma unroll
            for (int i = 0; i < 8; ++i) ss += x[j][i] * x[j][i]; }
        const float rs = rsqrtf(wave_sum(ss) * (1.f / DM) + 1e-6f);
#pragma unroll
        for (int j = 0; j < 2; ++j) { const int o = lane * 8 + 512 * j; const float4 g0 = *(const float4*)(gain + o), g1 = *(const float4*)(gain + o + 4);
            const float gg[8] = {g0.x, g0.y, g0.z, g0.w, g1.x, g1.y, g1.z, g1.w};
#pragma unroll
            for (int i = 0; i < 8; ++i) x[j][i] *= rs * gg[i]; }
        float mx = 0.f;
#pragma unroll
        for (int j = 0; j < 2; ++j)
#pragma unroll
            for (int i = 0; i < 8; ++i) mx = fmaxf(mx, fabsf(x[j][i]));
        mx = fmaxf(wave_max(mx), 1e-30f); const float qs = 127.f / mx;
        if (lane == 0) rowscale[n] = mx;
#pragma unroll
        for (int j = 0; j < 2; ++j) { const int o = lane * 8 + 512 * j;
            *(u32x2_t*)(HN8 + (size_t)n * DM + o) = (u32x2_t){q8x4(x[j][0], x[j][1], x[j][2], x[j][3], qs), q8x4(x[j][4], x[j][5], x[j][6], x[j][7], qs)}; } }
}
__device__ __forceinline__ void ph_final(const bf16_t* XR, const bf16_t* Y, const float* gain, float* out) {
    const int lane = threadIdx.x & 63, gw = blockIdx.x * 8 + (threadIdx.x >> 6), NGW = gridDim.x * 8;
    for (int n = gw; n < NTOK; n += NGW) { float x[2][8], y0[2][8], y1[2][8]; float ss = 0.f;
#pragma unroll
        for (int j = 0; j < 2; ++j) { const int o = lane * 8 + 512 * j; ld8bf(XR + (size_t)n * DM + o, x[j]); ld8bf(Y + (size_t)(2 * n) * DM + o, y0[j]); ld8bf(Y + (size_t)(2 * n + 1) * DM + o, y1[j]); }
#pragma unroll
        for (int j = 0; j < 2; ++j)
#pragma unroll
            for (int i = 0; i < 8; ++i) { x[j][i] = x[j][i] + y0[j][i] + y1[j][i]; ss += x[j][i] * x[j][i]; }
        const float rs = rsqrtf(wave_sum(ss) * (1.f / DM) + 1e-6f);
#pragma unroll
        for (int j = 0; j < 2; ++j) { const int o = lane * 8 + 512 * j; const float4 g0 = *(const float4*)(gain + o), g1 = *(const float4*)(gain + o + 4);
            *(float4*)(out + (size_t)n * DM + o) = make_float4(x[j][0] * rs * g0.x, x[j][1] * rs * g0.y, x[j][2] * rs * g0.z, x[j][3] * rs * g0.w);
            *(float4*)(out + (size_t)n * DM + o + 4) = make_float4(x[j][4] * rs * g1.x, x[j][5] * rs * g1.y, x[j][6] * rs * g1.z, x[j][7] * rs * g1.w); } }
}
__device__ __forceinline__ void ph_route(const Args& a, int Lyr, const bf16_t* XR, bf16_t* HN, float* RS, unsigned* cnt, int* asg_e, int* asg_rank, float* asg_gate, LAS float* lds) {
    const float* gain = a.in[2] + Lyr * DM; const float* bg = a.in[29] + Lyr * 4; const float* be = a.in[31] + Lyr * 32;
    const bf16_t* FRh = (const bf16_t*)(a.ws + FG_RT) + (size_t)Lyr * 2 * 49152; const bf16_t* FRl = FRh + 49152;
    const int lane = threadIdx.x & 63, wave = threadIdx.x >> 6, q4 = lane >> 4, c16 = lane & 15, r4 = lane >> 4, cidx = lane & 15;
    LAS unsigned char* Lb = (LAS unsigned char*)lds;
    LAS unsigned char* W = Lb + wave * 12288;
    LAS float* SS = (LAS float*)(W + 8704); LAS float* LG = (LAS float*)(W + 8768);
    LAS unsigned* lcnt = (LAS unsigned*)(Lb + 8 * 12288); LAS unsigned* lbase = lcnt + 32;
    const int NGW = gridDim.x * 8, gw = blockIdx.x * 8 + wave;
    for (int rnd = 0; rnd * NGW < NTOK / 16; ++rnd) {
        const int tile = rnd * NGW + gw; const bool act = tile < NTOK / 16; const int n0 = tile * 16;
        if (threadIdx.x < 32) lcnt[threadIdx.x] = 0u;
        __syncthreads();
        int e0 = 0, e1 = 0, lr0 = 0, lr1 = 0; float g0 = 0.f, g1 = 0.f;
        if (act) {
            f32x4 acc[3], accs = (f32x4){0.f, 0.f, 0.f, 0.f};
#pragma unroll
            for (int ct = 0; ct < 3; ++ct) acc[ct] = accs;
#pragma unroll 1
            for (int kc = 0; kc < 8; ++kc) {
                bf16x8_t bh[4][3], bl[4][3];
#pragma unroll
                for (int ks = 0; ks < 4; ++ks)
#pragma unroll
                    for (int ct = 0; ct < 3; ++ct) { const size_t o = ((size_t)((kc * 4 + ks) * 3 + ct) * 64 + lane) * 8; bh[ks][ct] = *(const bf16x8_t*)(FRh + o); bl[ks][ct] = *(const bf16x8_t*)(FRl + o); }
                u32x4_t xv[4];
#pragma unroll
                for (int j = 0; j < 4; ++j) xv[j] = *(const u32x4_t*)(XR + (size_t)(n0 + 4 * j + r4) * DM + kc * 128 + 8 * cidx);
                __builtin_amdgcn_sched_barrier(0);
#pragma unroll
                for (int j = 0; j < 4; ++j) *(LAS u32x4_t*)(W + (4 * j + r4) * 272 + cidx * 16) = xv[j];
#pragma unroll
                for (int ks = 0; ks < 4; ++ks) { const bf16x8_t ahi = *(const LAS bf16x8_t*)(W + c16 * 272 + ks * 64 + q4 * 16);
                    accs = __builtin_amdgcn_mfma_f32_16x16x32_bf16(ahi, ahi, accs, 0, 0, 0);
#pragma unroll
                    for (int ct = 0; ct < 3; ++ct) { acc[ct] = __builtin_amdgcn_mfma_f32_16x16x32_bf16(ahi, bh[ks][ct], acc[ct], 0, 0, 0); acc[ct] = __builtin_amdgcn_mfma_f32_16x16x32_bf16(ahi, bl[ks][ct], acc[ct], 0, 0, 0); } }
            }
#pragma unroll
            for (int r = 0; r < 4; ++r) if (c16 == 4 * q4 + r) { const float rsv = rsqrtf(accs[r] * (1.f / DM) + 1e-6f); SS[c16] = rsv; RS[n0 + c16] = rsv; }
            const f32x4 s4 = *(const LAS f32x4*)(SS + 4 * q4);
#pragma unroll
            for (int ct = 0; ct < 3; ++ct) { const int col = 16 * ct + c16; const float bias = col < 4 ? bg[col] : (col < 36 ? be[col - 4] : 0.f);
#pragma unroll
                for (int r = 0; r < 4; ++r) LG[(4 * q4 + r) * 48 + col] = acc[ct][r] * s4[r] + bias; }
            if (lane < 16) {
                const LAS float* lg = LG + lane * 48;
                int gs = 0; float gm = lg[0];
#pragma unroll
                for (int i = 1; i < 4; ++i) { const float v = lg[i]; if (v > gm) { gm = v; gs = i; } }
                float gden = 0.f;
#pragma unroll
                for (int i = 0; i < 4; ++i) gden += __expf(lg[i] - gm);
                const float ggate = 1.f / gden;
                const LAS float* l8 = lg + 4 + gs * 8;
                int i0 = 0; float m0 = l8[0];
#pragma unroll
                for (int i = 1; i < 8; ++i) { const float v = l8[i]; if (v > m0) { m0 = v; i0 = i; } }
                int i1 = (i0 == 0) ? 1 : 0; float m1 = l8[i1];
#pragma unroll
                for (int i = 0; i < 8; ++i) { const float v = l8[i]; if (i != i0 && v > m1) { m1 = v; i1 = i; } }
                const float ex = __expf(m1 - m0);
                g0 = ggate / (1.f + ex); g1 = ggate * ex / (1.f + ex);
                e0 = gs * 8 + i0; e1 = gs * 8 + i1;
                lr0 = (int)__hip_atomic_fetch_add(lcnt + e0, 1u, __ATOMIC_RELAXED, __HIP_MEMORY_SCOPE_WORKGROUP); lr1 = (int)__hip_atomic_fetch_add(lcnt + e1, 1u, __ATOMIC_RELAXED, __HIP_MEMORY_SCOPE_WORKGROUP);
            }
        }
        __syncthreads();
        if (threadIdx.x < 32) { const unsigned c = lcnt[threadIdx.x]; lbase[threadIdx.x] = c ? atomicAdd(&cnt[threadIdx.x], c) : 0u; }
        __syncthreads();
        if (act) {
            if (lane < 16) { const int n = n0 + lane;
                asg_e[2 * n] = e0; asg_e[2 * n + 1] = e1; asg_rank[2 * n] = (int)lbase[e0] + lr0; asg_rank[2 * n + 1] = (int)lbase[e1] + lr1; asg_gate[2 * n] = g0; asg_gate[2 * n + 1] = g1; }
            unsigned char* H8 = (unsigned char*)HN;
            float rsr[4];
#pragma unroll
            for (int j = 0; j < 4; ++j) rsr[j] = SS[4 * j + r4] * ACT_Q;
#pragma unroll 2
            for (int kc = 0; kc < 8; ++kc) { const float4 gn0 = *(const float4*)(gain + kc * 128 + 8 * cidx), gn1 = *(const float4*)(gain + kc * 128 + 8 * cidx + 4);
                u32x4_t xv[4];
#pragma unroll
                for (int j = 0; j < 4; ++j) xv[j] = *(const u32x4_t*)(XR + (size_t)(n0 + 4 * j + r4) * DM + kc * 128 + 8 * cidx);
#pragma unroll
                for (int j = 0; j < 4; ++j) { const u32x4_t o = xv[j]; const float q = rsr[j];
                    *(u32x2_t*)(H8 + (size_t)(n0 + 4 * j + r4) * DM + kc * 128 + 8 * cidx) = (u32x2_t){
                        q8x4(__uint_as_float(o.x << 16) * gn0.x, __uint_as_float(o.x & 0xffff0000u) * gn0.y, __uint_as_float(o.y << 16) * gn0.z, __uint_as_float(o.y & 0xffff0000u) * gn0.w, q),
                        q8x4(__uint_as_float(o.z << 16) * gn1.x, __uint_as_float(o.z & 0xffff0000u) * gn1.y, __uint_as_float(o.w << 16) * gn1.z, __uint_as_float(o.w & 0xffff0000u) * gn1.w, q)}; } }
        }
        __syncthreads();
    }
}
__device__ __forceinline__ void moe_prefix(const unsigned* cnt, LAS int* pst) {
    if (threadIdx.x == 0) { int acc = 0; for (int e = 0; e < NEXP; ++e) { pst[e] = acc; const int c = (int)cnt[e]; acc += (c + MOE_TM - 1) / MOE_TM * MOE_TM; } pst[NEXP] = acc; }
    __syncthreads();
}
__device__ __forceinline__ void ph_dispatch(const unsigned* cnt, const int* asg_e, const int* asg_rank, const float* asg_gate, const float* RS, int* row_tok, int* row_slot, float* row_gate, float* row_rs, LAS int* pst, const unsigned* wmax, float* tscale) {
    moe_prefix(cnt, pst);
    for (int t = blockIdx.x * NTHREADS + threadIdx.x; t < pst[NEXP] / 256; t += gridDim.x * NTHREADS) { int e = 0;
        for (int k = 1; k < NEXP; ++k) if (t * 256 >= pst[k]) e = k;
        tscale[2 * t] = __uint_as_float(wmax[2 * e]) * (1.f / (127.f * ACT_Q)); tscale[2 * t + 1] = __uint_as_float(wmax[2 * e + 1]) * (1.f / (127.f * ACT_Q)); }
    for (int i = blockIdx.x * NTHREADS + threadIdx.x; i < NASG; i += gridDim.x * NTHREADS) {
        const int e = asg_e[i], d = pst[e] + asg_rank[i];
        row_tok[d] = i >> 1; row_slot[d] = i; row_gate[d] = asg_gate[i]; row_rs[d] = RS[i >> 1];
    }
    for (int e = blockIdx.x; e < NEXP; e += gridDim.x) {
        const int c = (int)cnt[e], lo = pst[e] + c, hi = pst[e + 1];
        for (int r = lo + threadIdx.x; r < hi; r += NTHREADS) { row_tok[r] = -1; row_slot[r] = 0; row_gate[r] = 0.f; row_rs[r] = 0.f; }
    }
    __syncthreads();
}
__device__ __forceinline__ int moe_tile_expert(const LAS int* pst, int row0) { int e = 0;
    for (int i = 1; i < NEXP; ++i) if (row0 >= pst[i]) e = i;
    return e; }

__device__ __forceinline__ float shiftcol(const bf16_t* P, int n, int t, int col, const float* mu) {
    const float cur = bf2f(P[(size_t)n * ABC + col]); const float prev = t > 0 ? bf2f(P[(size_t)(n - 1) * ABC + col]) : 0.f;
    return cur + (prev - cur) * mu[col];
}
constexpr int RW_WMF = 0, RW_RF = 2048, RW_BKF = 4096, RW_ARF = 8192, RW_U = 9216, RW_V = 11264, RW_G = 13312, RW_REC = 13568;
__device__ __forceinline__ float fast_sigmoid(float x) { return __builtin_amdgcn_rcpf(1.f + __expf(-x)); }
__device__ __forceinline__ float fast_softplus(float x) { return fmaxf(x, 0.f) + __logf(1.f + __expf(-fabsf(x))); }
__device__ __forceinline__ void tr_acc(LAS float* TBf, const f32x4 (&acc)[4], int lane, float (&out)[16]) {
    const int q4 = lane >> 4, c16 = lane & 15;
#pragma unroll
    for (int ct = 0; ct < 4; ++ct)
#pragma unroll
        for (int r = 0; r < 4; ++r) TBf[(16 * ct + 4 * q4 + r) * 20 + c16] = acc[ct][r];
#pragma unroll
    for (int j = 0; j < 4; ++j) { const f32x4 v = *(const LAS f32x4*)(TBf + lane * 20 + 4 * j); out[4 * j] = v[0]; out[4 * j + 1] = v[1]; out[4 * j + 2] = v[2]; out[4 * j + 3] = v[3]; }
}
__device__ __forceinline__ void ph_l0_prep(const Args& a, LAS float* lds) {
    const bf16_t* P = (const bf16_t*)(a.ws + WS_B);
    unsigned char* FR = a.ws + WS_C;
    bf16_t* Vb = (bf16_t*)a.out; float* Bon = (float*)((unsigned char*)a.out + 32 * MiB);
    bf16_t* LA = (bf16_t*)(a.ws + WS_A); bf16_t* U = LA + (size_t)NTOK * 512;
    const float* mu = a.in[5]; const float* w0 = a.in[6]; const float* a0 = a.in[8];
    const float* k_k = a.in[11]; const float* k_a = a.in[12]; const float* r_k = a.in[13];
    const float* conv_w = a.in[16]; const float* conv_b = a.in[17]; const float* b_a = a.in[19]; const float* b_x = a.in[21]; const float* lam = a.in[22];
    const int lane = threadIdx.x & 63, wave = threadIdx.x >> 6, q4 = lane >> 4, c16 = lane & 15;
    LAS unsigned char* W = (LAS unsigned char*)lds + wave * 15360;
    constexpr int KAP = 0, BT = 2304, KT = 4608, RT = 6912, BTT = 9216, KTT = 11264, AKB = 13312, AKK = 14336, RS = 144;
    constexpr int XS = 0, XS2 = 2304, TB = 4608;
    LAS float* TBf = (LAS float*)(W + TB);
    for (int u = blockIdx.x * 8 + wave; u < (NTOK / 16) * 8; u += gridDim.x * 8) {
        const int tile = u >> 3, h = u & 7, n0 = tile * 16, c = h * 64 + lane;
        const bool first = (n0 & (SEQ - 1)) == 0;
        const bf16_t* Pn = P + (size_t)n0 * ABC;
        float xb[19]; unsigned pwp[9], pap[9], qrp[9], qkp[9], qvp[9];
#pragma unroll
        for (int i = 0; i < 19; ++i) xb[i] = (first && i < 3) ? 0.f : bf2f(Pn[(long)(i - 3) * ABC + 2304 + c]);
#pragma unroll
        for (int i = 0; i < 18; ++i) { const bool z = (first && i == 0) || i == 17; const long ro = (long)(i - 1) * ABC;
            const unsigned vw = z ? 0u : (unsigned)Pn[ro + 1536 + lane], va = z ? 0u : (unsigned)Pn[ro + 1600 + lane];
            if (i & 1) { pwp[i >> 1] |= vw << 16; pap[i >> 1] |= va << 16; } else { pwp[i >> 1] = vw; pap[i >> 1] = va; } }
        asm volatile("" ::: "memory");
#define UNPK(arr, i) __uint_as_float(((i) & 1) ? ((arr)[(i) >> 1] & 0xffff0000u) : ((arr)[(i) >> 1] << 16))
        {
            bf16_t* SG = (bf16_t*)((unsigned char*)a.out + DO_SG);
            const int tk = lane >> 2, col = 1664 + 16 * h + (lane & 3) * 4;
            const u32x2_t cu = *(const u32x2_t*)(Pn + (long)tk * ABC + col); u32x2_t pu = (u32x2_t){0u, 0u};
            if (!(first && tk == 0)) pu = *(const u32x2_t*)(Pn + (long)(tk - 1) * ABC + col);
            const f32x4 m4 = *(const f32x4*)(mu + col);
            const float c0 = __uint_as_float(cu.x << 16), c1 = __uint_as_float(cu.x & 0xffff0000u), c2 = __uint_as_float(cu.y << 16), c3 = __uint_as_float(cu.y & 0xffff0000u);
            const float p0 = __uint_as_float(pu.x << 16), p1 = __uint_as_float(pu.x & 0xffff0000u), p2 = __uint_as_float(pu.y << 16), p3 = __uint_as_float(pu.y & 0xffff0000u);
            *(u32x2_t*)(SG + (size_t)(tile * 8 + h) * 256 + lane * 4) = (u32x2_t){pk2(fast_sigmoid(c0 + (p0 - c0) * m4[0]), fast_sigmoid(c1 + (p1 - c1) * m4[1])), pk2(fast_sigmoid(c2 + (p2 - c2) * m4[2]), fast_sigmoid(c3 + (p3 - c3) * m4[3]))};
        }
        {
            const float cw0 = conv_w[c], cw1 = conv_w[512 + c], cw2 = conv_w[1024 + c], cw3 = conv_w[1536 + c], cb = conv_b[c];
            float xcv[16];
#pragma unroll
            for (int tk = 0; tk < 16; ++tk) { xcv[tk] = cb + cw0 * xb[tk] + cw1 * xb[tk + 1] + cw2 * xb[tk + 2] + cw3 * xb[tk + 3]; *(LAS bf16_t*)(W + XS + tk * RS + lane * 2) = f2bf(xcv[tk]); }
            f32x4 accr[4], acci[4];
            const bf16_t* FA = (const bf16_t*)(a.ws + FG_WA) + h * 4096; const bf16_t* FX = (const bf16_t*)(a.ws + FG_WX) + h * 4096;
            bf16x8_t xf[2];
#pragma unroll
            for (int ks = 0; ks < 2; ++ks) xf[ks] = *(const LAS bf16x8_t*)(W + XS + c16 * RS + ks * 64 + q4 * 16);
#pragma unroll
            for (int ct = 0; ct < 4; ++ct) { asm volatile("" ::: "memory"); accr[ct] = (f32x4){0.f, 0.f, 0.f, 0.f}; acci[ct] = accr[ct];
#pragma unroll
                for (int ks = 0; ks < 2; ++ks) { accr[ct] = __builtin_amdgcn_mfma_f32_16x16x32_bf16(*(const bf16x8_t*)(FA + ((ct * 2 + ks) * 64 + lane) * 8), xf[ks], accr[ct], 0, 0, 0);
                    acci[ct] = __builtin_amdgcn_mfma_f32_16x16x32_bf16(*(const bf16x8_t*)(FX + ((ct * 2 + ks) * 64 + lane) * 8), xf[ks], acci[ct], 0, 0, 0); } }
            float rp[16], ip[16];
            tr_acc(TBf, accr, lane, rp); tr_acc(TBf, acci, lane, ip);
            const float bac = b_a[c], bxc = b_x[c], sp = fast_softplus(-lam[c]);
            float hloc = 0.f, sla = 0.f;
            unsigned lap[4], uup[4];
#pragma unroll
            for (int tk = 0; tk < 16; ++tk) { const float r = fast_sigmoid(rp[tk] + bac), i = fast_sigmoid(ip[tk] + bxc);
                const float la = -8.f * r * sp; const float uu = __builtin_amdgcn_sqrtf(fmaxf(1.f - __expf(2.f * la), 0.f)) * i * xcv[tk];
                const bf16_t lab = f2bf(la), uub = f2bf(uu); const float lar = bf2f(lab);
                if (tk & 1) { lap[(tk >> 1) & 3] |= (unsigned)lab << 16; uup[(tk >> 1) & 3] |= (unsigned)uub << 16; } else { lap[(tk >> 1) & 3] = lab; uup[(tk >> 1) & 3] = uub; }
                if ((tk & 7) == 7) { *(u32x4_t*)(LA + ((size_t)tile * 512 + c) * 16 + (tk >> 3) * 8) = (u32x4_t){lap[0], lap[1], lap[2], lap[3]}; *(u32x4_t*)(U + ((size_t)tile * 512 + c) * 16 + (tk >> 3) * 8) = (u32x4_t){uup[0], uup[1], uup[2], uup[3]}; }
                hloc = __expf(lar) * hloc + bf2f(uub); sla += lar; }
            ((float*)((unsigned char*)a.out + DO_LRU))[(size_t)tile * 512 + c] = hloc; ((float*)((unsigned char*)a.out + DO_LRU))[(size_t)(2048 + tile) * 512 + c] = sla;
        }
        asm volatile("" ::: "memory");
#pragma unroll
        for (int i = 0; i < 18; ++i) { const bool z = (first && i == 0) || i == 17; const long ro = (long)(i - 1) * ABC;
            const unsigned vr = z ? 0u : (unsigned)Pn[ro + c], vk = z ? 0u : (unsigned)Pn[ro + 512 + c], vv = z ? 0u : (unsigned)Pn[ro + 1024 + c];
            if (i & 1) { qrp[i >> 1] |= vr << 16; qkp[i >> 1] |= vk << 16; qvp[i >> 1] |= vv << 16; } else { qrp[i >> 1] = vr; qkp[i >> 1] = vk; qvp[i >> 1] = vv; } }
        asm volatile("" ::: "memory");
        float wpre[16], apre[16];
        {
            const float muw = mu[1536 + lane], mua = mu[1600 + lane];
#pragma unroll
            for (int tk = 0; tk < 16; ++tk) { const float pw1 = UNPK(pwp, tk + 1), pw0 = UNPK(pwp, tk), pa1 = UNPK(pap, tk + 1), pa0 = UNPK(pap, tk);
                const float wl = pw1 + (pw0 - pw1) * muw, al = pa1 + (pa0 - pa1) * mua;
                const float th = 1.f - 2.f * __builtin_amdgcn_rcpf(1.f + __expf(2.f * wl));
                *(LAS bf16_t*)(W + XS + tk * RS + lane * 2) = f2bf(th); *(LAS bf16_t*)(W + XS2 + tk * RS + lane * 2) = f2bf(al); }
            f32x4 accw[4], acca[4];
            const bf16_t* F2 = (const bf16_t*)(a.ws + FG_W2) + h * 4096; const bf16_t* FA2 = (const bf16_t*)(a.ws + FG_A2) + h * 4096;
            bf16x8_t wf[2], af[2];
#pragma unroll
            for (int ks = 0; ks < 2; ++ks) { wf[ks] = *(const LAS bf16x8_t*)(W + XS + c16 * RS + ks * 64 + q4 * 16); af[ks] = *(const LAS bf16x8_t*)(W + XS2 + c16 * RS + ks * 64 + q4 * 16); }
#pragma unroll
            for (int ct = 0; ct < 4; ++ct) { asm volatile("" ::: "memory"); accw[ct] = (f32x4){0.f, 0.f, 0.f, 0.f}; acca[ct] = accw[ct];
#pragma unroll
                for (int ks = 0; ks < 2; ++ks) { accw[ct] = __builtin_amdgcn_mfma_f32_16x16x32_bf16(*(const bf16x8_t*)(F2 + ((ct * 2 + ks) * 64 + lane) * 8), wf[ks], accw[ct], 0, 0, 0);
                    acca[ct] = __builtin_amdgcn_mfma_f32_16x16x32_bf16(*(const bf16x8_t*)(FA2 + ((ct * 2 + ks) * 64 + lane) * 8), af[ks], acca[ct], 0, 0, 0); } }
            tr_acc(TBf, accw, lane, wpre); tr_acc(TBf, acca, lane, apre);
        }
        const float w0c = w0[c], a0c = a0[c], kkc = k_k[c], kac = k_a[c], rkc = r_k[c];
        const float mur = mu[c], muk = mu[512 + c], muv = mu[1024 + c];
        unsigned char* rec = FR + ((size_t)tile * 8 + h) * RW_REC;
        float vsv[16];
        unsigned btp[8], ktp[8];
        float cum = 0.f, gC = 1.f;
#pragma unroll
        for (int tk = 0; tk < 16; ++tk) { const int n = n0 + tk;
            const float cr = UNPK(qrp, tk + 1), ck = UNPK(qkp, tk + 1), cv = UNPK(qvp, tk + 1), pr = UNPK(qrp, tk), pk = UNPK(qkp, tk), pv = UNPK(qvp, tk);
            const float rs = cr + (pr - cr) * mur, ks = ck + (pk - ck) * muk, vs = cv + (pv - cv) * muv;
            const float wv = -fast_softplus(-(w0c + wpre[tk])) - 0.5f; const float logdec = -__expf(wv);
            const float av = fast_sigmoid(a0c + apre[tk]);
            const float kkr = ks * kkc; const float ss = wave_sum(kkr * kkr); const float kkn = kkr * rsqrtf(fmaxf(ss, 1e-24f));
            const float kp = ks * (1.f + (av - 1.f) * kac);
            const float bsum = wave_sum(rs * kp * rkc);
            if (lane == 0) Bon[(size_t)n * 8 + h] = bsum;
            Vb[(size_t)n * 512 + c] = f2bf(vs); vsv[tk] = vs;
            const float gprev = __expf(cum); cum += logdec; const float g = __expf(cum), gi = __builtin_amdgcn_rcpf(g); gC = g;
            const float kapv = kkn * gprev, btv = av * kkn * gi, ktv = kp * gi, rtv = rs * g;
            const bf16_t kb = f2bf(kapv), bb = f2bf(btv), kb2 = f2bf(ktv), rb = f2bf(rtv);
            *(LAS bf16_t*)(W + KAP + tk * RS + lane * 2) = kb; *(LAS bf16_t*)(W + BT + tk * RS + lane * 2) = bb;
            *(LAS bf16_t*)(W + KT + tk * RS + lane * 2) = kb2; *(LAS bf16_t*)(W + RT + tk * RS + lane * 2) = rb;
            if (tk & 1) { btp[tk >> 1] |= (unsigned)bb << 16; ktp[tk >> 1] |= (unsigned)kb2 << 16; } else { btp[tk >> 1] = bb; ktp[tk >> 1] = kb2; } }
        *(LAS u32x4_t*)(W + BTT + lane * 32) = (u32x4_t){btp[0], btp[1], btp[2], btp[3]}; *(LAS u32x4_t*)(W + BTT + lane * 32 + 16) = (u32x4_t){btp[4], btp[5], btp[6], btp[7]};
        *(LAS u32x4_t*)(W + KTT + lane * 32) = (u32x4_t){ktp[0], ktp[1], ktp[2], ktp[3]}; *(LAS u32x4_t*)(W + KTT + lane * 32 + 16) = (u32x4_t){ktp[4], ktp[5], ktp[6], ktp[7]};
        *(float*)(rec + RW_G + lane * 4) = gC;
        f32x4 akb = (f32x4){0.f, 0.f, 0.f, 0.f}, akk = akb, arbT = akb, arkT = akb;
#pragma unroll
        for (int ks = 0; ks < 2; ++ks) { const int fo = c16 * RS + ks * 64 + q4 * 16;
            const bf16x8_t fkap = *(const LAS bf16x8_t*)(W + KAP + fo), fbt = *(const LAS bf16x8_t*)(W + BT + fo), fkt = *(const LAS bf16x8_t*)(W + KT + fo), frt = *(const LAS bf16x8_t*)(W + RT + fo);
            akb = __builtin_amdgcn_mfma_f32_16x16x32_bf16(fkap, fbt, akb, 0, 0, 0); akk = __builtin_amdgcn_mfma_f32_16x16x32_bf16(fkap, fkt, akk, 0, 0, 0);
            arbT = __builtin_amdgcn_mfma_f32_16x16x32_bf16(fbt, frt, arbT, 0, 0, 0); arkT = __builtin_amdgcn_mfma_f32_16x16x32_bf16(fkt, frt, arkT, 0, 0, 0); }
#pragma unroll
        for (int r = 0; r < 4; ++r) { const int t = 4 * q4 + r; ((LAS float*)(W + AKB))[t * 16 + c16] = (c16 < t) ? akb[r] : 0.f; ((LAS float*)(W + AKK))[t * 16 + c16] = (c16 < t) ? akk[r] : 0.f;
            const int sidx = 4 * q4 + r; if (sidx > c16) { arbT[r] = 0.f; arkT[r] = 0.f; } }
        *(u32x4_t*)(rec + RW_ARF + lane * 16) = (u32x4_t){pk2(arbT[0], arbT[1]), pk2(arbT[2], arbT[3]), pk2(arkT[0], arkT[1]), pk2(arkT[2], arkT[3])};
#pragma unroll
        for (int i = 0; i < 4; ++i) { const u32x2_t b2 = *(const LAS u32x2_t*)(W + BTT + (16 * i + c16) * 32 + q4 * 8), k2 = *(const LAS u32x2_t*)(W + KTT + (16 * i + c16) * 32 + q4 * 8);
            *(u32x4_t*)(rec + RW_BKF + i * 1024 + lane * 16) = (u32x4_t){b2.x, b2.y, k2.x, k2.y}; }
#pragma unroll
        for (int sx = 0; sx < 2; ++sx) { const u32x2_t lo = *(const LAS u32x2_t*)(W + RT + c16 * RS + (32 * sx + 4 * q4) * 2), hi = *(const LAS u32x2_t*)(W + RT + c16 * RS + (32 * sx + 16 + 4 * q4) * 2);
            *(u32x4_t*)(rec + RW_RF + sx * 1024 + lane * 16) = (u32x4_t){lo.x, lo.y, hi.x, hi.y}; }
        float Wm[16], Uu[16];
#pragma unroll
        for (int t = 0; t < 16; ++t) { float wacc = bf2f(*(const LAS bf16_t*)(W + KAP + t * RS + lane * 2)), uacc = 0.f;
#pragma unroll
            for (int s4 = 0; s4 < 4; ++s4) if (4 * s4 < t) { const f32x4 b4 = *(const LAS f32x4*)(W + AKB + (t * 16 + 4 * s4) * 4), k4 = *(const LAS f32x4*)(W + AKK + (t * 16 + 4 * s4) * 4);
#pragma unroll
                for (int e = 0; e < 4; ++e) { const int sidx = 4 * s4 + e; if (sidx < t) { wacc -= b4[e] * Wm[sidx]; uacc += k4[e] * vsv[sidx] - b4[e] * Uu[sidx]; } } }
            Wm[t] = wacc; Uu[t] = uacc;
            *(LAS bf16_t*)(W + KAP + t * RS + lane * 2) = f2bf(wacc);
        }
        {
            const int ub = ((lane >> 4) * 64 + (lane & 15)) * 8;
#pragma unroll
            for (int q = 0; q < 4; ++q) { *(u32x2_t*)(rec + RW_U + ub + q * 128) = (u32x2_t){pk2(Uu[4 * q], Uu[4 * q + 1]), pk2(Uu[4 * q + 2], Uu[4 * q + 3])};
                *(u32x2_t*)(rec + RW_V + ub + q * 128) = (u32x2_t){pk2(vsv[4 * q], vsv[4 * q + 1]), pk2(vsv[4 * q + 2], vsv[4 * q + 3])}; }
        }
#pragma unroll
        for (int sx = 0; sx < 2; ++sx) { const u32x2_t lo = *(const LAS u32x2_t*)(W + KAP + c16 * RS + (32 * sx + 4 * q4) * 2), hi = *(const LAS u32x2_t*)(W + KAP + c16 * RS + (32 * sx + 16 + 4 * q4) * 2);
            *(u32x4_t*)(rec + RW_WMF + sx * 1024 + lane * 16) = (u32x4_t){lo.x, lo.y, hi.x, hi.y}; }
    }
}
__device__ __forceinline__ void sub_barrier(unsigned* ctr, unsigned target) {
    asm volatile("s_waitcnt vmcnt(0)" ::: "memory");
    __syncthreads();
    if (threadIdx.x == 0) {
        (void)xb_add(ctr, 1u);
        unsigned sp = 0;
        while (xb_ld(ctr) < target) { __builtin_amdgcn_s_sleep(2); if (++sp > (1u << 22)) break; }
        __builtin_amdgcn_fence(__ATOMIC_ACQUIRE, "agent");
        asm volatile("s_waitcnt vmcnt(0)" ::: "memory");
    }
    __syncthreads();
}
__device__ __forceinline__ void st_wt(float* p, float v) { __hip_atomic_store((unsigned*)p, __float_as_uint(v), __ATOMIC_RELAXED, __HIP_MEMORY_SCOPE_AGENT); }
__device__ __forceinline__ void ph_lru_b(const Args& a, int bid, LAS float* lds) {
    if (bid >= 64) return;
    const float* CH = (const float*)((unsigned char*)a.out + DO_LRU); const float* CA = CH + (size_t)2048 * 512; float* CIN = (float*)((unsigned char*)a.out + DO_LRU) + (size_t)4096 * 512;
    const int b = bid >> 4, cg = bid & 15, cl = threadIdx.x & 31, seg = threadIdx.x >> 5, c = cg * 32 + cl;
    float ca[32], chv[32];
#pragma unroll
    for (int i = 0; i < 32; ++i) { const size_t o = (size_t)(b * 512 + seg * 32 + i) * 512 + c; ca[i] = CA[o]; chv[i] = CH[o]; }
    float h = 0.f, sa = 0.f;
#pragma unroll
    for (int i = 0; i < 32; ++i) { h = __expf(ca[i]) * h + chv[i]; sa += ca[i]; }
    lds[seg * 32 + cl] = sa; lds[512 + seg * 32 + cl] = h;
    __syncthreads();
    float hin = 0.f;
    for (int sg = 0; sg < seg; ++sg) hin = __expf(lds[sg * 32 + cl]) * hin + lds[512 + sg * 32 + cl];
    h = hin;
#pragma unroll
    for (int i = 0; i < 32; ++i) { st_wt(CIN + (size_t)(b * 512 + seg * 32 + i) * 512 + c, h); h = __expf(ca[i]) * h + chv[i]; }
}
__device__ __forceinline__ void ph_lru_c(const Args& a, int bid, int nblk) {
    const bf16_t* LA = (const bf16_t*)(a.ws + WS_A); const bf16_t* U = LA + (size_t)NTOK * 512; const bf16_t* P = (const bf16_t*)(a.ws + WS_B);
    const float* CIN = (const float*)((unsigned char*)a.out + DO_LRU) + (size_t)4096 * 512; bf16_t* MIX = (bf16_t*)(a.ws + WS_D);
    const int c = threadIdx.x;
    for (int u = bid; u < NTOK / 16; u += nblk) { float la[16], uv[16], gt[16];
        float h = CIN[(size_t)u * 512 + c];
#pragma unroll
        for (int s = 0; s < 16; ++s) { const int n = u * 16 + s; gt[s] = bf2f(P[(size_t)n * ABC + 1792 + c]); }
#pragma unroll
        for (int hf = 0; hf < 2; ++hf) { const u32x4_t l4 = *(const u32x4_t*)(LA + ((size_t)u * 512 + c) * 16 + hf * 8), u4 = *(const u32x4_t*)(U + ((size_t)u * 512 + c) * 16 + hf * 8);
#pragma unroll
            for (int e = 0; e < 4; ++e) { la[hf * 8 + 2 * e] = __uint_as_float(l4[e] << 16); la[hf * 8 + 2 * e + 1] = __uint_as_float(l4[e] & 0xffff0000u); uv[hf * 8 + 2 * e] = __uint_as_float(u4[e] << 16); uv[hf * 8 + 2 * e + 1] = __uint_as_float(u4[e] & 0xffff0000u); } }
#pragma unroll
        for (int s = 0; s < 16; ++s) { const int n = u * 16 + s; h = __expf(la[s]) * h + uv[s];
            const float x = gt[s], t2 = 0.7978845608028654f * (x + 0.044715f * x * x * x); const float th = 1.f - 2.f * __builtin_amdgcn_rcpf(1.f + __expf(2.f * t2));
            MIX[(size_t)n * DM + 512 + c] = f2bf(h * 0.5f * x * (1.f + th)); } }
}
#ifndef SP_MODE
#define SP_MODE 0
#endif
__device__ __forceinline__ void ph_rwkv_scan(const Args& a, LAS unsigned char* L) {
    if (blockIdx.x >= 32) return;
    constexpr int SLOT = 9472, GOFF = 9216, NS = 14, NCH = SEQ / 16; constexpr size_t CSTR = (size_t)8 * RW_REC;
    const unsigned char* FR = a.ws + WS_C; float* Yr = (float*)((unsigned char*)a.out + DO_YR);
    const int b = blockIdx.x >> 3, h = blockIdx.x & 7, lane = threadIdx.x & 63, wave = __builtin_amdgcn_readfirstlane(threadIdx.x >> 6), q4 = lane >> 4, c16 = lane & 15;
    const unsigned char* FRb = FR + ((size_t)(b * NCH) * 8 + h) * RW_REC;
#define RW_BARRIER() do { asm volatile("" ::: "memory"); __builtin_amdgcn_s_barrier(); asm volatile("" ::: "memory"); } while (0)
    if (wave >= 4) {
        const int lw = wave - 4;
        const unsigned char* rp = FRb + lane * 16; int so = 0;
#define RW_ISSUE1() do { LAS unsigned char* _slot = L + so; \
            if (lw < 2) { _Pragma("unroll") for (int _j = 0; _j < 3; ++_j) __builtin_amdgcn_global_load_lds((const unsigned*)(rp + (lw * 3 + _j) * 1024), (LAS unsigned*)(_slot + (lw * 3 + _j) * 1024), 16, 0, 0); } \
            else if (lw == 2) { _Pragma("unroll") for (int _j = 0; _j < 2; ++_j) __builtin_amdgcn_global_load_lds((const unsigned*)(rp + (6 + _j) * 1024), (LAS unsigned*)(_slot + (6 + _j) * 1024), 16, 0, 0); } \
            else { __builtin_amdgcn_global_load_lds((const unsigned*)(rp + 8 * 1024), (LAS unsigned*)(_slot + 8 * 1024), 16, 0, 0); \
                   __builtin_amdgcn_global_load_lds((const unsigned*)(rp - lane * 12 + RW_G), (LAS unsigned*)(_slot + GOFF), 4, 0, 0); } \
            rp += CSTR; so += SLOT; if (so == NS * SLOT) so = 0; } while (0)
#if SP_MODE & 4
#define RW_ISSUE() do { RW_ISSUE1(); rp -= CSTR; so -= SLOT; if (so < 0) so += NS * SLOT; RW_ISSUE1(); } while (0)
#else
#define RW_ISSUE() RW_ISSUE1()
#endif
#if SP_MODE & 4
#define RW_LWAIT() do { if (lw < 2) asm volatile("s_waitcnt vmcnt(54)" ::: "memory"); else asm volatile("s_waitcnt vmcnt(36)" ::: "memory"); } while (0)
#else
#define RW_LWAIT() do { if (lw < 2) asm volatile("s_waitcnt vmcnt(27)" ::: "memory"); else asm volatile("s_waitcnt vmcnt(18)" ::: "memory"); } while (0)
#endif
        for (int p = 0; p < NS - 2; ++p) RW_ISSUE();
        RW_LWAIT();
        RW_BARRIER();
#pragma unroll 1
        for (int it = 0; it < NCH / 2; ++it) { RW_ISSUE(); RW_ISSUE(); RW_LWAIT(); RW_BARRIER(); }
        asm volatile("s_waitcnt vmcnt(0)" ::: "memory");
#undef RW_ISSUE
#undef RW_ISSUE1
#undef RW_LWAIT
    } else {
        const int vs = wave;
#if SP_MODE & 2
        __builtin_amdgcn_s_setprio(3);
#endif
        f32x4 T[4];
#pragma unroll
        for (int i = 0; i < 4; ++i) T[i] = (f32x4){0.f, 0.f, 0.f, 0.f};
        struct Ops { bf16x8_t wmf[2], rf[2], bkf[4], arf; f32x4 g4[4]; };
        const LAS unsigned char* lp = L + lane * 16; const LAS unsigned char* lg = L + GOFF + q4 * 16; int so = 0;
        const unsigned char* up = FRb + RW_U + (vs * 64 + lane) * 8;
        float* yp = Yr + ((size_t)(b * NCH) * 8 + h) * 1024 + vs * 256 + lane * 4;
#if SP_MODE & 8
#define RW_LOAD(O) do { { const LAS unsigned char* _r = lp + so; const LAS unsigned char* _g = lg + so; \
            _Pragma("unroll") for (int _s = 0; _s < 2; ++_s) { bf16x8_t _t0 = *(const LAS bf16x8_t*)(_r + RW_WMF + _s * 1024); bf16x8_t _t1 = *(const LAS bf16x8_t*)(_r + RW_RF + _s * 1024); asm volatile("" :: "v"(_t0), "v"(_t1)); } \
            _Pragma("unroll") for (int _i = 0; _i < 4; ++_i) { bf16x8_t _t0 = *(const LAS bf16x8_t*)(_r + RW_BKF + _i * 1024); f32x4 _t1 = *(const LAS f32x4*)(_g + _i * 64); asm volatile("" :: "v"(_t0), "v"(_t1)); } \
            { bf16x8_t _t0 = *(const LAS bf16x8_t*)(_r + RW_ARF); asm volatile("" :: "v"(_t0)); } asm volatile("" ::: "memory"); } RW_LOAD1(O); } while (0)
#else
#define RW_LOAD(O) RW_LOAD1(O)
#endif
#define RW_LOAD1(O) do { const LAS unsigned char* _r = lp + so; const LAS unsigned char* _g = lg + so; \
            _Pragma("unroll") for (int _s = 0; _s < 2; ++_s) { O.wmf[_s] = *(const LAS bf16x8_t*)(_r + RW_WMF + _s * 1024); O.rf[_s] = *(const LAS bf16x8_t*)(_r + RW_RF + _s * 1024); } \
            _Pragma("unroll") for (int _i = 0; _i < 4; ++_i) O.bkf[_i] = *(const LAS bf16x8_t*)(_r + RW_BKF + _i * 1024); \
            O.arf = *(const LAS bf16x8_t*)(_r + RW_ARF); \
            _Pragma("unroll") for (int _i = 0; _i < 4; ++_i) O.g4[_i] = *(const LAS f32x4*)(_g + _i * 64); \
            so += SLOT; if (so == NS * SLOT) so = 0; \
            __builtin_amdgcn_sched_barrier(0); } while (0)
#define RW_UV(dst) do { dst[0] = *(const u32x2_t*)up; dst[1] = *(const u32x2_t*)(up + 2048); up += CSTR; } while (0)
#define RW_STEP(O, uv) do { \
            bf16x8_t _bS[2]; \
            _Pragma("unroll") for (int _s = 0; _s < 2; ++_s) { const u32x4_t _pk = (u32x4_t){pk2(T[2 * _s][0], T[2 * _s][1]), pk2(T[2 * _s][2], T[2 * _s][3]), pk2(T[2 * _s + 1][0], T[2 * _s + 1][1]), pk2(T[2 * _s + 1][2], T[2 * _s + 1][3])}; \
                _bS[_s] = __builtin_bit_cast(bf16x8_t, _pk); } \
            f32x4 _z = (f32x4){__uint_as_float(uv[0].x << 16), __uint_as_float(uv[0].x & 0xffff0000u), __uint_as_float(uv[0].y << 16), __uint_as_float(uv[0].y & 0xffff0000u)}; \
            _z = __builtin_amdgcn_mfma_f32_16x16x32_bf16(O.wmf[0], _bS[0], _z, 0, 0, 0); _z = __builtin_amdgcn_mfma_f32_16x16x32_bf16(O.wmf[1], _bS[1], _z, 0, 0, 0); \
            f32x4 _y = (f32x4){0.f, 0.f, 0.f, 0.f}; \
            _y = __builtin_amdgcn_mfma_f32_16x16x32_bf16(_bS[0], O.rf[0], _y, 0, 0, 0); _y = __builtin_amdgcn_mfma_f32_16x16x32_bf16(_bS[1], O.rf[1], _y, 0, 0, 0); \
            const u32x4_t _zvp = (u32x4_t){pk2(-_z[0], -_z[1]), pk2(-_z[2], -_z[3]), uv[1].x, uv[1].y}; \
            const bf16x8_t _bZV = __builtin_bit_cast(bf16x8_t, _zvp); \
            _Pragma("unroll") for (int _i = 0; _i < 4; ++_i) { T[_i] = __builtin_amdgcn_mfma_f32_16x16x32_bf16(O.bkf[_i], _bZV, T[_i], 0, 0, 0); T[_i] = T[_i] * O.g4[_i]; } \
            _y = __builtin_amdgcn_mfma_f32_16x16x32_bf16(_bZV, O.arf, _y, 0, 0, 0); \
            *(f32x4*)yp = _y; RW_ST2(); yp += 8 * 1024; } while (0)
#if SP_MODE & 16
#define RW_ST2() do { asm volatile("" ::: "memory"); *(f32x4*)yp = _y; } while (0)
#else
#define RW_ST2() do { } while (0)
#endif
#define RW_SYNC() do { asm volatile("s_waitcnt lgkmcnt(0)" ::: "memory"); RW_BARRIER(); } while (0)
        Ops A, B;
        u32x2_t uv0[2], uv1[2], uv2[2], uv3[2];
        RW_UV(uv0); RW_UV(uv1); RW_UV(uv2); RW_UV(uv3);
        RW_BARRIER();
        RW_LOAD(A);
#pragma unroll 1
        for (int ch = 0; ch < NCH; ch += 4) {
            RW_LOAD(B); RW_STEP(A, uv0); RW_UV(uv0);
            RW_LOAD(A); RW_STEP(B, uv1); RW_UV(uv1); RW_SYNC();
            RW_LOAD(B); RW_STEP(A, uv2); RW_UV(uv2);
            RW_LOAD(A); RW_STEP(B, uv3); RW_UV(uv3); RW_SYNC(); }
#undef RW_SYNC
#undef RW_LOAD
#undef RW_LOAD1
#undef RW_STEP
#undef RW_UV
    }
#undef RW_BARRIER
}
__device__ __forceinline__ void ph_rwkv_post(const Args& a, LAS float* lds) {
    const bf16_t* V = (const bf16_t*)a.out; const float* Bon = (const float*)((const unsigned char*)a.out + DO_BON); const bf16_t* SG = (const bf16_t*)((const unsigned char*)a.out + DO_SG);
    const float* Yr = (const float*)((const unsigned char*)a.out + DO_YR); bf16_t* MIX = (bf16_t*)(a.ws + WS_D);
    const float* ln_w = a.in[14]; const float* ln_b = a.in[15];
    LAS unsigned char* L = (LAS unsigned char*)lds;
    const int c = threadIdx.x, lane = c & 63, h = c >> 6, q4 = lane >> 4, c16 = lane & 15;
    const bf16_t* FG = (const bf16_t*)(a.ws + FG_G2) + h * 8192;
    for (int tile = blockIdx.x; tile < NTOK / 16; tile += gridDim.x) {
        const int n0 = tile * 16;
        __syncthreads();
        { const int tk = c >> 5, j4 = (c & 31) * 4; *(LAS u32x2_t*)(L + tk * 272 + j4 * 2) = *(const u32x2_t*)(SG + (size_t)tile * 2048 + (j4 >> 4) * 256 + tk * 16 + (j4 & 15)); }
        __syncthreads();
        const int n = n0 + c16;
        f32x4 g[4], y[4];
#pragma unroll
        for (int ct = 0; ct < 4; ++ct) { g[ct] = (f32x4){0.f, 0.f, 0.f, 0.f};
#pragma unroll
            for (int ks = 0; ks < 4; ++ks) { const bf16x8_t af = *(const bf16x8_t*)(FG + ((size_t)(ct * 4 + ks) * 64 + lane) * 8); const bf16x8_t bfr = *(const LAS bf16x8_t*)(L + c16 * 272 + ks * 64 + q4 * 16);
                g[ct] = __builtin_amdgcn_mfma_f32_16x16x32_bf16(af, bfr, g[ct], 0, 0, 0); }
            y[ct] = *(const f32x4*)(Yr + (size_t)tile * 8192 + h * 1024 + ct * 256 + lane * 4); }
        float sm = 0.f;
#pragma unroll
        for (int ct = 0; ct < 4; ++ct) sm += (y[ct][0] + y[ct][1]) + (y[ct][2] + y[ct][3]);
        sm = xrow16_sum(sm);
        const float mean = sm * (1.f / 64.f);
        float sv = 0.f;
#pragma unroll
        for (int ct = 0; ct < 4; ++ct) { y[ct] = y[ct] - mean; sv += (y[ct][0] * y[ct][0] + y[ct][1] * y[ct][1]) + (y[ct][2] * y[ct][2] + y[ct][3] * y[ct][3]); }
        sv = xrow16_sum(sv);
        const float rstd = rsqrtf(sv * (1.f / 64.f) + 64e-5f), bsc = Bon[(size_t)n * 8 + h];
#pragma unroll
        for (int ct = 0; ct < 4; ++ct) { const int ch = 64 * h + 16 * ct + 4 * q4;
            const f32x4 lw = *(const f32x4*)(ln_w + ch), lb = *(const f32x4*)(ln_b + ch);
            const u32x2_t vv = *(const u32x2_t*)(V + (size_t)n * 512 + ch);
            const float v0 = __uint_as_float(vv.x << 16), v1 = __uint_as_float(vv.x & 0xffff0000u), v2 = __uint_as_float(vv.y << 16), v3 = __uint_as_float(vv.y & 0xffff0000u);
            const float o0 = (y[ct][0] * rstd * lw[0] + lb[0] + bsc * v0) * g[ct][0], o1 = (y[ct][1] * rstd * lw[1] + lb[1] + bsc * v1) * g[ct][1];
            const float o2 = (y[ct][2] * rstd * lw[2] + lb[2] + bsc * v2) * g[ct][2], o3 = (y[ct][3] * rstd * lw[3] + lb[3] + bsc * v3) * g[ct][3];
            *(u32x2_t*)(MIX + (size_t)n * DM + ch) = (u32x2_t){pk2(o0, o1), pk2(o2, o3)}; }
    }
}

namespace gla {
typedef short bf16x8 __attribute__((ext_vector_type(8)));
typedef float f32x16 __attribute__((ext_vector_type(16)));
typedef unsigned u32x4 __attribute__((ext_vector_type(4)));
typedef unsigned u32x2 __attribute__((ext_vector_type(2)));
constexpr int QH_OFF = 0, KH_OFF = 17408, KT_OFF = 34816, VT_OFF = 53248, ST_OFF = 71680, AM_OFF = 106496, EB_OFF = 115712, ER_OFF = 116224, PS_OFF = 116736, SSQ_OFF = 118784;
constexpr int QS = 272, TS = 144;
#define GLA_BAR() do { asm volatile("s_waitcnt lgkmcnt(0)" ::: "memory"); __builtin_amdgcn_s_barrier(); asm volatile("" ::: "memory"); } while (0)
template <bool OUT>
__device__ __forceinline__ void unit(const Args& a, LAS unsigned char* L, int u) {
    const int tid = threadIdx.x, lane = tid & 63, w = tid >> 6;
    const int b = u >> 6, h = (u >> 3) & 7, j = u & 7;
    const bf16_t* Q = (const bf16_t*)(a.ws + WS_QFIG) + ((size_t)b * SEQ + (size_t)j * 1024) * 4096 + h * 128;
    float* Lb = (float*)(a.ws + WS_O); float* Db = Lb + (size_t)256 * 16384;
    const int dk = tid & 127, tg = tid >> 7;
    const float c0 = a.in[25][h * 128 + dk], c1 = a.in[25][1024 + h * 128 + dk];
    const float lbv = __builtin_amdgcn_rcpf(1.f + __expf(c0 - c1)), omlb = 1.f - lbv;
    LAS float* PS = (LAS float*)(L + PS_OFF); LAS float* EB = (LAS float*)(L + EB_OFF); LAS float* ER = (LAS float*)(L + ER_OFF); LAS float* SSQ = (LAS float*)(L + SSQ_OFF);
    const int si = w >> 1, sj0 = (w & 1) * 2, l31 = lane & 31, l5 = lane >> 5;
    const int ri = w >> 2, cj = w & 3, odv = 32 * cj + l31;
    f32x16 S[2];
#pragma unroll
    for (int jj = 0; jj < 2; ++jj)
#pragma unroll
        for (int r = 0; r < 16; ++r) S[jj][r] = 0.f;
    if (OUT) {
#pragma unroll 1
        for (int i = 0; i < j; ++i) { const int ui = u - j + i;
#pragma unroll
            for (int jj = 0; jj < 2; ++jj)
#pragma unroll
                for (int rg = 0; rg < 4; ++rg) { const int sdk0 = 32 * si + 8 * rg + 4 * l5, sdv = 32 * (sj0 + jj) + l31; const f32x4 dd = *(const f32x4*)(Db + ui * 128 + sdk0);
#pragma unroll
                    for (int e = 0; e < 4; ++e) S[jj][4 * rg + e] = dd[e] * S[jj][4 * rg + e] + Lb[(size_t)ui * 16384 + (sdk0 + e) * 128 + sdv]; } } }
    float dsum = 1.f;
    const int prow = tid >> 4, ppc = tid & 15;
    u32x4 pf[2], pv[2], pq[2];
#define GLA_PREFETCH(cx) do { const bf16_t* _q = Q + (size_t)((cx) * 64 + prow) * 4096 + ppc * 8; \
        _Pragma("unroll") for (int _r = 0; _r < 2; ++_r) { pf[_r] = *(const u32x4*)(_q + (size_t)_r * 32 * 4096 + 1024); pv[_r] = *(const u32x4*)(_q + (size_t)_r * 32 * 4096 + 2048); if (OUT) pq[_r] = *(const u32x4*)(_q + (size_t)_r * 32 * 4096); } } while (0)
    GLA_PREFETCH(0);
#pragma unroll 1
    for (int c = 0; c < 16; ++c) {
        int cc = c; asm volatile("" : "+s"(cc));
#pragma unroll
        for (int r = 0; r < 2; ++r) { *(LAS u32x4*)(L + KH_OFF + (prow + 32 * r) * QS + ppc * 16) = pf[r]; *(LAS u32x4*)(L + ST_OFF + (prow + 32 * r) * QS + ppc * 16) = pv[r];
            if (OUT) *(LAS u32x4*)(L + QH_OFF + (prow + 32 * r) * QS + ppc * 16) = pq[r]; }
        if (c + 1 < 16) GLA_PREFETCH(cc + 1);
        unsigned gp[8];
        if (OUT) { const bf16_t* G = Q + (size_t)(cc * 64) * 4096 + 3072;
            unsigned go = (unsigned)((32 * ri + 4 * l5) * 4096 + odv); asm volatile("" : "+v"(go));
#pragma unroll
            for (int r = 0; r < 16; r += 2) { const unsigned t0 = (unsigned)(((r & 3) + 8 * (r >> 2)) * 4096); gp[r >> 1] = (unsigned)G[go + t0] | ((unsigned)G[go + t0 + 4096u] << 16); } }
        GLA_BAR();
        float lf[16], kk[16];
#pragma unroll
        for (int i = 0; i < 16; ++i) { const float fv = bf2f(*(const LAS bf16_t*)(L + KH_OFF + (tg * 16 + i) * QS + dk * 2)); const float sg = __builtin_amdgcn_rcpf(1.f + __expf(-fv));
            lf[i] = lbv + omlb * sg; kk[i] = omlb * (1.f - sg); }
#pragma unroll
        for (int i = 1; i < 16; ++i) lf[i] *= lf[i - 1];
        PS[tg * 128 + dk] = lf[15];
        GLA_BAR();
        const float p0 = PS[dk], p1 = PS[128 + dk], p2 = PS[256 + dk], p3 = PS[384 + dk];
        const float off = (tg > 0 ? p0 : 1.f) * (tg > 1 ? p1 : 1.f) * (tg > 2 ? p2 : 1.f);
        const float pref = p0 * p1, pbl = pref * (p2 * p3), ebr = p2 * p3;
        const float ioff = off * __builtin_amdgcn_rcpf(pref);
        unsigned ktp[8], vtp[8];
#pragma unroll
        for (int i = 0; i < 16; i += 2) {
            float kb[2]; unsigned vv[2];
#pragma unroll
            for (int q = 0; q < 2; ++q) { const float e1 = ioff * lf[i + q]; const float e2 = __builtin_amdgcn_rcpf(e1);
                const float khat = kk[i + q] * e2; kb[q] = khat * ebr; vv[q] = *(const LAS bf16_t*)(L + ST_OFF + (tg * 16 + i + q) * QS + dk * 2);
                if (OUT) { LAS bf16_t* qp = (LAS bf16_t*)(L + QH_OFF + (tg * 16 + i + q) * QS + dk * 2); const float qr = bf2f(*qp); const float qv = qr * __builtin_amdgcn_rcpf(1.f + __expf(-qr));
                    *qp = f2bf(qv * e1); *(LAS bf16_t*)(L + KH_OFF + (tg * 16 + i + q) * QS + dk * 2) = f2bf(khat); } }
            ktp[i >> 1] = pk2(kb[0], kb[1]); vtp[i >> 1] = vv[0] | (vv[1] << 16);
        }
        *(LAS u32x4*)(L + KT_OFF + dk * TS + tg * 32) = (u32x4){ktp[0], ktp[1], ktp[2], ktp[3]}; *(LAS u32x4*)(L + KT_OFF + dk * TS + tg * 32 + 16) = (u32x4){ktp[4], ktp[5], ktp[6], ktp[7]};
        *(LAS u32x4*)(L + VT_OFF + dk * TS + tg * 32) = (u32x4){vtp[0], vtp[1], vtp[2], vtp[3]}; *(LAS u32x4*)(L + VT_OFF + dk * TS + tg * 32 + 16) = (u32x4){vtp[4], vtp[5], vtp[6], vtp[7]};
        if (tg == 0) { EB[dk] = pbl; ER[dk] = pref; dsum *= pbl; }
        GLA_BAR();
        f32x16 o;
        if (OUT) {
#pragma unroll
            for (int jj = 0; jj < 2; ++jj)
#pragma unroll
                for (int rg = 0; rg < 4; ++rg) { const int dk0 = 32 * si + 8 * rg + 4 * l5; const f32x4 er = *(const LAS f32x4*)(ER + dk0);
                    u32x2 pk; pk.x = pk2(S[jj][4 * rg] * er[0], S[jj][4 * rg + 1] * er[1]); pk.y = pk2(S[jj][4 * rg + 2] * er[2], S[jj][4 * rg + 3] * er[3]);
                    *(LAS u32x2*)(L + ST_OFF + (32 * (sj0 + jj) + l31) * QS + dk0 * 2) = pk; }
#pragma unroll
            for (int q = 0; q < 2; ++q) { const int ti = w >> 1, tj = (w & 1) * 2 + q;
                f32x4 sc = (f32x4){0.f, 0.f, 0.f, 0.f};
                if (tj <= ti) {
#pragma unroll
                    for (int ks = 0; ks < 4; ++ks) { const bf16x8 af = *(const LAS bf16x8*)(L + QH_OFF + (16 * ti + (lane & 15)) * QS + ks * 64 + (lane >> 4) * 16);
                        const bf16x8 bfr = *(const LAS bf16x8*)(L + KH_OFF + (16 * tj + (lane & 15)) * QS + ks * 64 + (lane >> 4) * 16);
                        sc = __builtin_amdgcn_mfma_f32_16x16x32_bf16(af, bfr, sc, 0, 0, 0); } }
                const int scol = 16 * tj + (lane & 15);
#pragma unroll
                for (int r = 0; r < 4; ++r) { const int trow = 16 * ti + 4 * (lane >> 4) + r; const float v = (scol <= trow) ? sc[r] : 0.f;
                    *(LAS bf16_t*)(L + AM_OFF + trow * TS + scol * 2) = f2bf(v); } }
            GLA_BAR();
#pragma unroll
            for (int r = 0; r < 16; ++r) o[r] = 0.f;
#pragma unroll
            for (int ks = 0; ks < 4; ++ks) if (ks < 2 * (ri + 1)) {
                const bf16x8 af = *(const LAS bf16x8*)(L + AM_OFF + (32 * ri + l31) * TS + ks * 32 + l5 * 16);
                const bf16x8 bfr = *(const LAS bf16x8*)(L + VT_OFF + (32 * cj + l31) * TS + ks * 32 + l5 * 16);
                o = __builtin_amdgcn_mfma_f32_32x32x16_bf16(af, bfr, o, 0, 0, 0); }
#pragma unroll
            for (int ks = 0; ks < 8; ++ks) { if ((ks & 3) == 0) asm volatile("" ::: "memory");
                const bf16x8 af = *(const LAS bf16x8*)(L + QH_OFF + (32 * ri + l31) * QS + ks * 32 + l5 * 16);
                const bf16x8 bfr = *(const LAS bf16x8*)(L + ST_OFF + (32 * cj + l31) * QS + ks * 32 + l5 * 16);
                o = __builtin_amdgcn_mfma_f32_32x32x16_bf16(af, bfr, o, 0, 0, 0); }
#pragma unroll
            for (int r = 0; r < 16; ++r) { const float q2 = xrow32_sum(row16_sum(o[r] * o[r]));
                if (l31 == 0) SSQ[(32 * ri + (r & 3) + 8 * (r >> 2) + 4 * l5) * 4 + cj] = q2; }
        }
        {
            bf16x8 af[4];
#pragma unroll
            for (int ks = 0; ks < 4; ++ks) af[ks] = *(const LAS bf16x8*)(L + KT_OFF + (32 * si + l31) * TS + ks * 32 + l5 * 16);
#pragma unroll
            for (int jj = 0; jj < 2; ++jj) {
#pragma unroll
                for (int rg = 0; rg < 4; ++rg) { const f32x4 eb = *(const LAS f32x4*)(EB + 32 * si + 8 * rg + 4 * l5);
                    S[jj][4 * rg] *= eb[0]; S[jj][4 * rg + 1] *= eb[1]; S[jj][4 * rg + 2] *= eb[2]; S[jj][4 * rg + 3] *= eb[3]; }
#pragma unroll
                for (int ks = 0; ks < 4; ++ks) { const bf16x8 bfr = *(const LAS bf16x8*)(L + VT_OFF + (32 * (sj0 + jj) + l31) * TS + ks * 32 + l5 * 16);
                    S[jj] = __builtin_amdgcn_mfma_f32_32x32x16_bf16(af[ks], bfr, S[jj], 0, 0, 0); } }
        }
        GLA_BAR();
        if (OUT) {
            const float nwv = a.in[26][h * 128 + odv];
            bf16_t* MIX = (bf16_t*)(a.ws + WS_MIX1) + ((size_t)b * SEQ + (size_t)j * 1024 + cc * 64) * DM + h * 128;
            unsigned mo = (unsigned)((32 * ri + 4 * l5) * DM + odv); asm volatile("" : "+v"(mo));
#pragma unroll
            for (int r = 0; r < 16; ++r) { const int t = 32 * ri + (r & 3) + 8 * (r >> 2) + 4 * l5; const f32x4 q4 = *(const LAS f32x4*)(SSQ + t * 4);
                const float rs = rsqrtf(((q4[0] + q4[1]) + (q4[2] + q4[3])) * (1.f / 128.f) + 1e-6f);
                const float gv = __uint_as_float((r & 1) ? (gp[r >> 1] & 0xffff0000u) : (gp[r >> 1] << 16)); const float y = o[r] * rs * nwv * gv * __builtin_amdgcn_rcpf(1.f + __expf(-gv));
                MIX[mo + (unsigned)(((r & 3) + 8 * (r >> 2)) * DM)] = f2bf(y); }
        }
    }
    if (!OUT) {
#pragma unroll
        for (int jj = 0; jj < 2; ++jj)
#pragma unroll
            for (int r = 0; r < 16; ++r) { const int sdk = 32 * si + (r & 3) + 8 * (r >> 2) + 4 * l5, sdv = 32 * (sj0 + jj) + l31; Lb[(size_t)u * 16384 + sdk * 128 + sdv] = S[jj][r]; }
        if (tg == 0) Db[u * 128 + dk] = dsum;
    }
    GLA_BAR();
#undef GLA_PREFETCH
}
__device__ __forceinline__ void pass2(const Args& a) {
    float* Lb = (float*)(a.ws + WS_O); const float* Db = Lb + (size_t)256 * 16384;
    for (int idx = blockIdx.x * NTHREADS + threadIdx.x; idx < 32 * 16384; idx += gridDim.x * NTHREADS) { const int bh = idx >> 14, el = idx & 16383, dkk = el >> 7; float sacc = 0.f;
        for (int j = 0; j < 8; ++j) { const int u = bh * 8 + j; const size_t o = (size_t)u * 16384 + el;
            if (j < 7) { const float tmp = Lb[o]; Lb[o] = sacc; sacc = Db[u * 128 + dkk] * sacc + tmp; } else Lb[o] = sacc; } }
}
}

constexpr int NPHASE = 24;
__global__ void __launch_bounds__(NTHREADS, 2) fwd(Args a) {
    extern __shared__ __attribute__((aligned(16))) unsigned char lds_raw[];
    LAS unsigned char* ldsb = (LAS unsigned char*)lds_raw;
    LAS float* lds = (LAS float*)ldsb;
    LAS int* pst = (LAS int*)(ldsb + LDS_MISC);
    volatile LAS unsigned* xbw = (volatile LAS unsigned*)(ldsb + LDS_MISC + 256);
    if (threadIdx.x == 0) { xbw[0] = 0u; xbw[1] = 0u; }
    __syncthreads();
    unsigned* ctl = (unsigned*)(a.ws + WS_CTL);
    const bool multi = (a.ph_hi - a.ph_lo) > 1;
    XcdBarrier bar; bar.bar = ctl; bar.x = 0; bar.st = xbw;
    if (multi) bar = xcd_barrier_post(ctl, xbw);
    unsigned char* ws = a.ws;
    bf16_t* HN = (bf16_t*)(ws + WS_A);
    bf16_t* XR = (bf16_t*)(ws + WS_XR); float* RSv = (float*)(ws + WS_ROUTE + RT_LRU_CH);
    int* asg_e = (int*)(ws + WS_ROUTE + RT_ASG_E); int* asg_rank = (int*)(ws + WS_ROUTE + RT_ASG_RANK); float* asg_gate = (float*)(ws + WS_ROUTE + RT_ASG_GATE);
    int* row_tok = (int*)(ws + WS_ROUTE + RT_ROW_TOK); int* row_slot = (int*)(ws + WS_ROUTE + RT_ROW_SLOT); float* row_gate = (float*)(ws + WS_ROUTE + RT_ROW_GATE); float* row_rs = (float*)(ws + WS_ROUTE + RT_LRU_CA); float* tscale = (float*)(ws + WS_ROUTE + RT_LRU_CIN);
#ifndef PHSEL
#define PHSEL(k) true
#endif
#ifndef REPMASK
#define REPMASK 0u
#endif
#define NREP(k) (((REPMASK >> (k)) & 1u) ? 2 : 1)
#define IN(k) (PHSEL(k) && a.ph_lo <= (k) && (k) < a.ph_hi)
#define SEAM(k) do { if (IN((k) + 1) && multi) xcd_barrier(bar); } while (0)
    if (IN(0)) { ph_cvt_frags(a); ph_cvt_dense_a(a, lds, ctl + CW_COLMAX); ph_norm0(a.in[0], a.in[1], (unsigned char*)HN, (float*)(ws + WS_ROUTE + RT_LRU_CH + 262144)); xcd_barrier(bar); ph_cvt_dense_b(a, lds, ctl + CW_COLMAX, 0); }
#if (REPMASK >> 0) & 1
    if (IN(0)) { xcd_barrier(bar);  ph_cvt_frags(a); ph_cvt_dense_a(a, lds, ctl + CW_COLMAX); ph_norm0(a.in[0], a.in[1], (unsigned char*)HN, (float*)(ws + WS_ROUTE + RT_LRU_CH + 262144)); xcd_barrier(bar); ph_cvt_dense_b(a, lds, ctl + CW_COLMAX, 0); }
#endif
    if (IN(0)) { SEAM(0); }
    if (IN(1)) { pg8::DenseOrder S; S.init(NTOK, ABC, DM / 2, gridDim.x, blockIdx.x, ws + WD_ABIN); pg8::EpiBf16I E{(bf16_t*)(ws + WS_B), ABC, (float*)(ws + WS_ROUTE + RT_LRU_CH + 262144), ctl + CW_COLMAX};
        pg8::gemm_phase<pg8::EpiBf16I, pg8::DenseOrder, true>(ldsb, (const char*)HN, DM, DM / 2, S, E); }
#if (REPMASK >> 1) & 1
    if (IN(1)) { xcd_barrier(bar);  pg8::DenseOrder S; S.init(NTOK, ABC, DM / 2, gridDim.x, blockIdx.x, ws + WD_ABIN); pg8::EpiBf16I E{(bf16_t*)(ws + WS_B), ABC, (float*)(ws + WS_ROUTE + RT_LRU_CH + 262144), ctl + CW_COLMAX};
        pg8::gemm_phase<pg8::EpiBf16I, pg8::DenseOrder, true>(ldsb, (const char*)HN, DM, DM / 2, S, E);  }
#endif
    if (IN(1)) { SEAM(1); }
    if (IN(2)) { ph_l0_prep(a, lds); }
#if (REPMASK >> 2) & 1
    if (IN(2)) { xcd_barrier(bar);  ph_l0_prep(a, lds);  }
#endif
    if (IN(2)) { SEAM(2); }
    if (IN(6)) {
        if (blockIdx.x < 32) ph_rwkv_scan(a, ldsb);
        else { const int gb = (int)blockIdx.x - 32, gn = (int)gridDim.x - 32; unsigned* sctr = ctl + CW_CNT + 256;
            ph_lru_b(a, gb, lds); sub_barrier(sctr, (unsigned)gn);
#if SP_MODE & 1
            ph_lru_c(a, gb, gn); }
        xcd_barrier(bar); ph_wmax(a.in[32], a.in[33], ctl + CW_WMAX, blockIdx.x, gridDim.x); xcd_barrier(bar);
        ph_cvt_moe(a, 0, lds, blockIdx.x, gridDim.x, 3); ph_cvt_moe(a, 1, lds, blockIdx.x, gridDim.x, 1);
#else
            ph_lru_c(a, gb, gn); ph_wmax(a.in[32], a.in[33], ctl + CW_WMAX, gb, gn); sub_barrier(sctr, 2u * (unsigned)gn);
            ph_cvt_moe(a, 0, lds, gb, gn, 3); ph_cvt_moe(a, 1, lds, gb, gn, 1); }
#endif
        SEAM(6); }
    if (IN(7)) { ph_rwkv_post(a, lds); }
#if (REPMASK >> 7) & 1
    if (IN(7)) { xcd_barrier(bar);  ph_rwkv_post(a, lds);  }
#endif
    if (IN(7)) { SEAM(7); }
    if (IN(8)) { pg8::DenseOrder S; S.init(NTOK, DM, DM, gridDim.x, blockIdx.x, ws + WD_ABOUT); pg8::EpiResid<true> E{a.in[0], XR};
        pg8::gemm_phase(ldsb, (const char*)(ws + WS_D), DM * 2, DM, S, E); }
#if (REPMASK >> 8) & 1
    if (IN(8)) { xcd_barrier(bar);  pg8::DenseOrder S; S.init(NTOK, DM, DM, gridDim.x, blockIdx.x, ws + WD_ABOUT); pg8::EpiResid<true> E{a.in[0], XR};
        pg8::gemm_phase(ldsb, (const char*)(ws + WS_D), DM * 2, DM, S, E);  }
#endif
    if (IN(8)) { SEAM(8); }
    if (IN(9)) { ph_route(a, 0, XR, HN, RSv, ctl + CW_CNT, asg_e, asg_rank, asg_gate, lds); SEAM(9); }
    if (IN(10)) { ph_dispatch(ctl + CW_CNT, asg_e, asg_rank, asg_gate, RSv, row_tok, row_slot, row_gate, row_rs, pst, ctl + CW_WMAX, tscale); ph_cvt_dense_b(a, lds, ctl + CW_COLMAX, 1); }
#if (REPMASK >> 10) & 1
    if (IN(10)) { xcd_barrier(bar);  ph_dispatch(ctl + CW_CNT, asg_e, asg_rank, asg_gate, RSv, row_tok, row_slot, row_gate, row_rs, pst, ctl + CW_WMAX, tscale);  }
#endif
    if (IN(10)) { SEAM(10); }
    if (IN(11)) { moe_prefix(ctl + CW_CNT, pst);
        pg8::MoeOrder S{(int)gridDim.x, (int)blockIdx.x, 4, pst[NEXP] / 256, pst, row_tok, (const char*)(ws + WM_GU), (size_t)DM * DM, (size_t)256 * DM}; pg8::EpiSwiGLU E{(bf16_t*)(ws + WS_H), tscale};
        pg8::gemm_phase<pg8::EpiSwiGLU, pg8::MoeOrder, true>(ldsb, (const char*)HN, DM, DM / 2, S, E); }
#if (REPMASK >> 11) & 1
    if (IN(11)) { xcd_barrier(bar);  moe_prefix(ctl + CW_CNT, pst);
        pg8::MoeOrder S{(int)gridDim.x, (int)blockIdx.x, 4, pst[NEXP] / 256, pst, row_tok, (const char*)(ws + WM_GU), (size_t)DM * DM, (size_t)256 * DM}; pg8::EpiSwiGLU E{(bf16_t*)(ws + WS_H), tscale};
        pg8::gemm_phase<pg8::EpiSwiGLU, pg8::MoeOrder, true>(ldsb, (const char*)HN, DM, DM / 2, S, E);  }
#endif
    if (IN(11)) { SEAM(11); }
    if (IN(12)) { moe_prefix(ctl + CW_CNT, pst);
        pg8::MoeOrder S{(int)gridDim.x, (int)blockIdx.x, 4, pst[NEXP] / 256, pst, nullptr, (const char*)(ws + WM_DN), (size_t)DM * FF * 2, (size_t)256 * FF * 2}; pg8::EpiDown E{(bf16_t*)(ws + WS_Y), row_tok, row_slot, row_gate};
        pg8::gemm_phase(ldsb, (const char*)(ws + WS_H), FF * 2, FF, S, E); }
#if (REPMASK >> 12) & 1
    if (IN(12)) { xcd_barrier(bar);  moe_prefix(ctl + CW_CNT, pst);
        pg8::MoeOrder S{(int)gridDim.x, (int)blockIdx.x, 4, pst[NEXP] / 256, pst, nullptr, (const char*)(ws + WM_DN), (size_t)DM * FF * 2, (size_t)256 * FF * 2}; pg8::EpiDown E{(bf16_t*)(ws + WS_Y), row_tok, row_slot, row_gate};
        pg8::gemm_phase(ldsb, (const char*)(ws + WS_H), FF * 2, FF, S, E);  }
#endif
    if (IN(12)) { SEAM(12); }
    if (IN(13)) { ph_combine_norm(XR, (const bf16_t*)(ws + WS_Y), a.in[1] + DM, (unsigned char*)HN, (float*)(ws + WS_ROUTE + RT_LRU_CH + 262144)); SEAM(13); }
    if (IN(14)) { pg8::DenseOrder S; S.init(NTOK, 4096, DM / 2, gridDim.x, blockIdx.x, ws + WD_CIN); pg8::EpiBf16I E{(bf16_t*)(ws + WS_QFIG), 4096, (float*)(ws + WS_ROUTE + RT_LRU_CH + 262144), ctl + CW_COLMAX + ABC};
        pg8::gemm_phase<pg8::EpiBf16I, pg8::DenseOrder, true>(ldsb, (const char*)HN, DM, DM / 2, S, E); }
#if (REPMASK >> 14) & 1
    if (IN(14)) { xcd_barrier(bar);  pg8::DenseOrder S; S.init(NTOK, 4096, DM / 2, gridDim.x, blockIdx.x, ws + WD_CIN); pg8::EpiBf16I E{(bf16_t*)(ws + WS_QFIG), 4096, (float*)(ws + WS_ROUTE + RT_LRU_CH + 262144), ctl + CW_COLMAX + ABC};
        pg8::gemm_phase<pg8::EpiBf16I, pg8::DenseOrder, true>(ldsb, (const char*)HN, DM, DM / 2, S, E);  }
#endif
    if (IN(14)) { SEAM(14); }
    if (IN(15)) { for (int u = blockIdx.x; u < 256; u += gridDim.x) if ((u & 7) != 7) gla::unit<false>(a, ldsb, u); }
#if (REPMASK >> 15) & 1
    if (IN(15)) { xcd_barrier(bar);  for (int u = blockIdx.x; u < 256; u += gridDim.x) if ((u & 7) != 7) gla::unit<false>(a, ldsb, u);  }
#endif
    if (IN(15)) { SEAM(15); }
    if (IN(17)) { for (int u = blockIdx.x; u < 256; u += gridDim.x) gla::unit<true>(a, ldsb, u); }
#if (REPMASK >> 17) & 1
    if (IN(17)) { xcd_barrier(bar);  for (int u = blockIdx.x; u < 256; u += gridDim.x) gla::unit<true>(a, ldsb, u);  }
#endif
    if (IN(17)) { SEAM(17); }
    if (IN(18)) { pg8::DenseOrder S; S.init(NTOK, DM, DM, gridDim.x, blockIdx.x, ws + WD_COUT); pg8::EpiResid<false> E{XR, XR};
        pg8::gemm_phase(ldsb, (const char*)(ws + WS_MIX1), DM * 2, DM, S, E); SEAM(18); }
    if (IN(19)) { ph_route(a, 1, XR, HN, RSv, ctl + CW_CNT + 64, asg_e, asg_rank, asg_gate, lds); SEAM(19); }
    if (IN(20)) { ph_dispatch(ctl + CW_CNT + 64, asg_e, asg_rank, asg_gate, RSv, row_tok, row_slot, row_gate, row_rs, pst, ctl + CW_WMAX + 64, tscale); ph_cvt_moe(a, 1, lds, blockIdx.x, gridDim.x, 2); }
#if (REPMASK >> 20) & 1
    if (IN(20)) { xcd_barrier(bar);  ph_dispatch(ctl + CW_CNT + 64, asg_e, asg_rank, asg_gate, RSv, row_tok, row_slot, row_gate, row_rs, pst, ctl + CW_WMAX + 64, tscale); ph_cvt_moe(a, 1, lds, blockIdx.x, gridDim.x, 2);  }
#endif
    if (IN(20)) { SEAM(20); }
    if (IN(21)) { moe_prefix(ctl + CW_CNT + 64, pst);
        pg8::MoeOrder S{(int)gridDim.x, (int)blockIdx.x, 4, pst[NEXP] / 256, pst, row_tok, (const char*)(ws + WM_GU1), (size_t)DM * DM, (size_t)256 * DM}; pg8::EpiSwiGLU E{(bf16_t*)(ws + WS_H), tscale};
        pg8::gemm_phase<pg8::EpiSwiGLU, pg8::MoeOrder, true>(ldsb, (const char*)HN, DM, DM / 2, S, E); }
#if (REPMASK >> 21) & 1
    if (IN(21)) { xcd_barrier(bar);  moe_prefix(ctl + CW_CNT + 64, pst);
        pg8::MoeOrder S{(int)gridDim.x, (int)blockIdx.x, 4, pst[NEXP] / 256, pst, row_tok, (const char*)(ws + WM_GU1), (size_t)DM * DM, (size_t)256 * DM}; pg8::EpiSwiGLU E{(bf16_t*)(ws + WS_H), tscale};
        pg8::gemm_phase<pg8::EpiSwiGLU, pg8::MoeOrder, true>(ldsb, (const char*)HN, DM, DM / 2, S, E);  }
#endif
    if (IN(21)) { SEAM(21); }
    if (IN(22)) { moe_prefix(ctl + CW_CNT + 64, pst);
        pg8::MoeOrder S{(int)gridDim.x, (int)blockIdx.x, 4, pst[NEXP] / 256, pst, nullptr, (const char*)(ws + WM_DN), (size_t)DM * FF * 2, (size_t)256 * FF * 2}; pg8::EpiDown E{(bf16_t*)(ws + WS_Y), row_tok, row_slot, row_gate};
        pg8::gemm_phase(ldsb, (const char*)(ws + WS_H), FF * 2, FF, S, E); }
#if (REPMASK >> 22) & 1
    if (IN(22)) { xcd_barrier(bar);  moe_prefix(ctl + CW_CNT + 64, pst);
        pg8::MoeOrder S{(int)gridDim.x, (int)blockIdx.x, 4, pst[NEXP] / 256, pst, nullptr, (const char*)(ws + WM_DN), (size_t)DM * FF * 2, (size_t)256 * FF * 2}; pg8::EpiDown E{(bf16_t*)(ws + WS_Y), row_tok, row_slot, row_gate};
        pg8::gemm_phase(ldsb, (const char*)(ws + WS_H), FF * 2, FF, S, E);  }
#endif
    if (IN(22)) { SEAM(22); }
    if (IN(23)) { ph_final(XR, (const bf16_t*)(ws + WS_Y), a.in[3], a.out); }
#undef IN
#undef SEAM
}

extern "C" void kernel_launch(void* const* d_in, const int* in_sizes, int n_in, void* d_out, int out_size, void* d_ws, size_t ws_size, hipStream_t stream) {
    static int grid = 0;
    if (grid == 0) {
        if (n_in != 35 || out_size != NTOK * DM || ws_size < WS_END) { fprintf(stderr, "kernel_launch: unexpected shapes (n_in %d out %d ws %zu)\n", n_in, out_size, ws_size); grid = -1; return; }
        int dev = 0, cus = 0;
        if (hipGetDevice(&dev) != hipSuccess || hipDeviceGetAttribute(&cus, hipDeviceAttributeMultiprocessorCount, dev) != hipSuccess) { grid = -1; return; }
        if (hipFuncSetAttribute((const void*)fwd, hipFuncAttributeMaxDynamicSharedMemorySize, LDS_BYTES) != hipSuccess) { fprintf(stderr, "kernel_launch: hipFuncSetAttribute failed\n"); grid = -1; return; }
        int per_cu = 0;
        (void)hipOccupancyMaxActiveBlocksPerMultiprocessor(&per_cu, (const void*)fwd, NTHREADS, LDS_BYTES);
        (void)hipGetLastError();
        grid = cus;
        if (grid < 64) { fprintf(stderr, "kernel_launch: needs >= 64 CUs\n"); grid = -1; return; }
    }
    if (grid < 0) return;
    (void)hipMemsetAsync((char*)d_ws + WS_CTL, 0, CTL_ZERO_BYTES, stream);
    Args a{};
    for (int i = 0; i < 35; ++i) a.in[i] = (const float*)d_in[i];
    a.out = (float*)d_out; a.ws = (unsigned char*)d_ws;
#if 0
    for (int p = 0; p < NPHASE; ++p) { a.ph_lo = p; a.ph_hi = p + 1; hipLaunchKernelGGL(fwd, dim3(grid), dim3(NTHREADS), LDS_BYTES, stream, a); }
#else
    a.ph_lo = 0; a.ph_hi = NPHASE; hipLaunchKernelGGL(fwd, dim3(grid), dim3(NTHREADS), LDS_BYTES, stream, a);
#endif
}
```

```cpp
#include <hip/hip_runtime.h>
#include <cstdio>
#include <cstdint>

typedef unsigned short bf16_t;
#define LAS __attribute__((address_space(3)))
typedef float f32x4 __attribute__((ext_vector_type(4)));
typedef short bf16x8_t __attribute__((ext_vector_type(8)));
typedef unsigned u32x4_t __attribute__((ext_vector_type(4)));
typedef unsigned u32x2_t __attribute__((ext_vector_type(2)));

constexpr int NTOK = 32768, SEQ = 8192, NBATCH = 4, DM = 1024;
constexpr int ABC = 2816, RWC = 1792;
constexpr int NEXP = 32, FF = 512;
constexpr int NASG = NTOK * 2;
constexpr int MOE_TM = 256;
constexpr int MAXROWS = NASG + NEXP * MOE_TM;
constexpr int NTHREADS = 512;
constexpr int LDS_BYTES = 156 * 1024;
constexpr int LDS_MISC = 155 * 1024;

constexpr size_t MiB = 1024ull * 1024ull;
constexpr size_t WS_CTL = 0;
constexpr size_t CTL_ZERO_BYTES = 64 * 1024;
constexpr size_t WS_ROUTE = 64 * 1024;
constexpr size_t WS_WD = 8 * MiB;
constexpr size_t WD_ABIN = WS_WD, WD_ABOUT = WD_ABIN + (size_t)ABC * DM * 2, WD_CIN = WD_ABOUT + (size_t)DM * DM * 2, WD_COUT = WD_CIN + (size_t)4096 * DM * 2;
constexpr size_t WS_AR = 26 * MiB;
constexpr size_t WS_A = WS_AR;
constexpr size_t WS_B = WS_AR + 64 * MiB;
constexpr size_t WS_C = WS_B + 176 * MiB;
constexpr size_t WS_D = WS_C + 212 * MiB;
constexpr size_t DO_LRU = 112 * MiB;
constexpr size_t WS_XR = WS_AR + 360 * MiB;
constexpr size_t WS_WM = WS_AR + 64 * MiB;
constexpr size_t WM_GU1 = WS_A + 32 * MiB;
constexpr size_t WM_GU = WS_WM, WM_DN = WS_WM + (size_t)NEXP * DM * DM;
constexpr size_t WS_H = WS_WM + 96 * MiB;
constexpr size_t WS_Y = WS_H + 72 * MiB;
constexpr size_t WS_QFIG = WS_AR + 64 * MiB;
constexpr size_t WS_O = WS_QFIG + 256 * MiB;
constexpr size_t WS_MIX1 = WS_O + 128 * MiB;
constexpr size_t WS_END = WS_AR + 516 * MiB;
static_assert(WS_D + 64 * MiB <= WS_END && WS_Y + 128 * MiB <= WS_END && WS_MIX1 + 64 * MiB <= WS_END, "arena");

constexpr size_t DO_VB = 0, DO_BON = 32 * MiB, DO_SG = 34 * MiB, DO_YR = 48 * MiB;

constexpr int CW_CNT = 8192;
constexpr int CW_WMAX = CW_CNT + 512;
constexpr int CW_COLMAX = CW_WMAX + 192;
constexpr float ACT_Q = 127.f / 6.f;
constexpr size_t RT_ASG_E = 0;
constexpr size_t RT_ASG_RANK = RT_ASG_E + NASG * 4;
constexpr size_t RT_ASG_GATE = RT_ASG_RANK + NASG * 4;
constexpr size_t RT_ROW_TOK = RT_ASG_GATE + NASG * 4;
constexpr size_t RT_ROW_SLOT = RT_ROW_TOK + MAXROWS * 4;
constexpr size_t RT_ROW_GATE = RT_ROW_SLOT + MAXROWS * 4;
constexpr size_t RT_LRU_CH = RT_ROW_GATE + MAXROWS * 4;
constexpr size_t RT_LRU_CA = RT_LRU_CH + 512 * 512 * 4;
constexpr size_t RT_LRU_CIN = RT_LRU_CA + 512 * 512 * 4;
constexpr size_t RT_END = RT_LRU_CIN + 512 * 512 * 4;
constexpr size_t WS_FRAG = 6 * MiB;
constexpr size_t FG_RT = WS_FRAG + 393216;
constexpr size_t FG_W2 = WS_FRAG, FG_A2 = FG_W2 + 65536, FG_WA = FG_A2 + 65536, FG_WX = FG_WA + 65536, FG_G2 = FG_WX + 65536;
static_assert(WS_ROUTE + RT_END <= 6 * MiB, "routing arrays overflow");

__device__ __forceinline__ float bf2f(bf16_t v) { return __uint_as_float(((unsigned)v) << 16); }
typedef __bf16 bf16x2_hw __attribute__((ext_vector_type(2)));
typedef float f32x2_hw __attribute__((ext_vector_type(2)));
__device__ __forceinline__ unsigned pk2(float lo, float hi) { const f32x2_hw v = {lo, hi}; const bf16x2_hw b = __builtin_convertvector(v, bf16x2_hw); return __builtin_bit_cast(unsigned, b); }
__device__ __forceinline__ bf16_t f2bf(float f) { const __bf16 b = (__bf16)f; return __builtin_bit_cast(bf16_t, b); }
template <int CTRL> __device__ __forceinline__ float dpp_(float x) { return __builtin_bit_cast(float, __builtin_amdgcn_mov_dpp(__builtin_bit_cast(int, x), CTRL, 0xf, 0xf, true)); }
__device__ __forceinline__ float row16_sum(float v) {
    v += dpp_<0xB1>(v); v += dpp_<0x4E>(v); v += dpp_<0x124>(v); v += dpp_<0x128>(v); return v; }
__device__ __forceinline__ float xrow16_sum(float x) {
    auto s = __builtin_amdgcn_permlane16_swap(__float_as_uint(x), __float_as_uint(x), false, false);
    x = __uint_as_float(s[0]) + __uint_as_float(s[1]);
    auto t = __builtin_amdgcn_permlane32_swap(__float_as_uint(x), __float_as_uint(x), false, false);
    return __uint_as_float(t[0]) + __uint_as_float(t[1]); }
__device__ __forceinline__ float xrow32_sum(float x) {
    auto s = __builtin_amdgcn_permlane16_swap(__float_as_uint(x), __float_as_uint(x), false, false);
    return __uint_as_float(s[0]) + __uint_as_float(s[1]); }
__device__ __forceinline__ float wave_sum(float v) { return xrow16_sum(row16_sum(v)); }
__device__ __forceinline__ float sigmoidf_(float x) { return 1.f / (1.f + __expf(-x)); }
__device__ __forceinline__ float softplusf_(float x) { return fmaxf(x, 0.f) + log1pf(__expf(-fabsf(x))); }
__device__ __forceinline__ float siluf_(float x) { return x * sigmoidf_(x); }
__device__ __forceinline__ float gelu_tanhf_(float x) { const float c = 0.7978845608028654f; return 0.5f * x * (1.f + tanhf(c * (x + 0.044715f * x * x * x))); }

struct Args {
    const float* in[35];
    float* out;
    unsigned char* ws;
    int ph_lo, ph_hi;
};

#define XB_TMO      128
#define XB_XCNT(j)  (256  + 64 * (j))
#define XB_XSUB(j)  (1280 + 64 * (j))
#define XB_XGEN(j)  (2304 + 64 * (j))
#define XB_TOP      3328
#define XB_TOPGEN   3392
#define XCD_BAR_WORDS 3456
#define XB_SPIN_CAP (1u << 18)
__device__ __forceinline__ unsigned xb_ld(unsigned* p)              { return __hip_atomic_load(p, __ATOMIC_RELAXED, __HIP_MEMORY_SCOPE_AGENT); }
__device__ __forceinline__ unsigned xb_add(unsigned* p, unsigned v) { return __hip_atomic_fetch_add(p, v, __ATOMIC_RELAXED, __HIP_MEMORY_SCOPE_AGENT); }
__device__ __forceinline__ unsigned xb_xcc_id() { return (unsigned)__builtin_amdgcn_s_getreg((3 << 11) | 20) & 0xFu; }
#define XB_SPIN(cond, bar) do { unsigned _sp = 0; while (cond) { __builtin_amdgcn_s_sleep(1); \
    if ((++_sp & 255u) == 0u) { if (xb_ld(&(bar)[XB_TMO])) break; if (_sp > XB_SPIN_CAP) { atomicAdd(&(bar)[XB_TMO], 1u); break; } } } } while (0)
struct XcdBarrier { unsigned* bar; unsigned x; volatile LAS unsigned* st; };
__device__ __forceinline__ XcdBarrier xcd_barrier_post(unsigned* bar, volatile LAS unsigned* st) {
    XcdBarrier b; b.bar = bar; b.x = xb_xcc_id(); b.st = st;
    if (threadIdx.x == 0) (void)xb_add(&bar[XB_XCNT(b.x)], 1u);
    return b;
}
__device__ __forceinline__ void xcd_barrier_complete(unsigned* bar, unsigned x, unsigned& nloc, unsigned& nx) {
    const unsigned G = gridDim.x * gridDim.y * gridDim.z;
    unsigned sum, cnt, mine, sp = 0u;
    for (;;) {
        sum = 0u; cnt = 0u; mine = 0u;
#pragma unroll
        for (unsigned j = 0; j < 16; ++j) { const unsigned c = xb_ld(&bar[XB_XCNT(j)]); sum += c; cnt += (c > 0u) ? 1u : 0u; mine = (j == x) ? c : mine; }
        if (sum == G) break;
        __builtin_amdgcn_s_sleep(1);
        if ((++sp & 255u) == 0u) { if (xb_ld(&bar[XB_TMO])) break; if (sp > XB_SPIN_CAP) { atomicAdd(&bar[XB_TMO], 1u); break; } }
    }
    nloc = mine > 0u ? mine : 1u; nx = cnt > 0u ? cnt : 1u;
}
__device__ __forceinline__ void xcd_barrier(const XcdBarrier& b) {
    asm volatile("s_waitcnt vmcnt(0)" ::: "memory");
    __syncthreads();
    if (threadIdx.x == 0) {
        unsigned* bar = b.bar;
        __builtin_amdgcn_s_waitcnt(0);
        unsigned nloc = b.st[0], nx = b.st[1];
        if (nloc == 0u) { xcd_barrier_complete(bar, b.x, nloc, nx); b.st[0] = nloc; b.st[1] = nx; }
        const unsigned old = xb_add(&bar[XB_XSUB(b.x)], 1u);
        const unsigned gen = old / nloc;
        if (old + 1u == (gen + 1u) * nloc) {
            __builtin_amdgcn_fence(__ATOMIC_RELEASE, "agent");
            asm volatile("s_waitcnt vmcnt(0)" ::: "memory");
            const unsigned og = xb_add(&bar[XB_TOP], 1u);
            const unsigned tg = og / nx;
            if (og + 1u == (tg + 1u) * nx) xb_add(&bar[XB_TOPGEN], 1u);
            else XB_SPIN(xb_ld(&bar[XB_TOPGEN]) == tg, bar);
            __builtin_amdgcn_fence(__ATOMIC_ACQUIRE, "agent");
            xb_add(&bar[XB_XGEN(b.x)], 1u);
            asm volatile("s_waitcnt vmcnt(0)" ::: "memory");
        } else {
            XB_SPIN(xb_ld(&bar[XB_XGEN(b.x)]) == gen, bar);
            __builtin_amdgcn_fence(__ATOMIC_ACQUIRE, "agent");
            asm volatile("s_waitcnt vmcnt(0)" ::: "memory");
        }
    }
    __syncthreads();
}

namespace pg8 {
typedef short bf16x8 __attribute__((ext_vector_type(8)));
typedef unsigned u32x4 __attribute__((ext_vector_type(4)));
typedef int v4i_t __attribute__((ext_vector_type(4)));
constexpr int BM = 256, BK = 64, HALF = 128, HTB = HALF * BK * 2, STAGE_BYTES = 8 * HTB, NXCD = 8, WGM = 8;
__device__ __forceinline__ int lds_byte(int r, int c) { const int st = (r >> 4) * 2 + (c >> 5), rr = r & 15, cc = c & 31, ob = rr * 64 + cc * 2; return st * 1024 + (ob ^ (((ob >> 9) & 1) << 5)); }
__device__ __forceinline__ void stage_rc(int b, int& R, int& C) { const int st = b / 1024, sb = b % 1024, swz = sb ^ (((sb >> 9) & 1) << 5); R = (st >> 1) * 16 + swz / 64; C = (st & 1) * 32 + (swz % 64) / 2; }
__device__ __forceinline__ int perm32(int rho) { const int n = rho >> 4, i = rho & 15; return 8 * (i >> 2) + 4 * n + (i & 3); }
__device__ __forceinline__ unsigned cvt_pk_bf16(float lo, float hi) { unsigned r; asm volatile("v_cvt_pk_bf16_f32 %0, %1, %2" : "=v"(r) : "v"(lo), "v"(hi)); return r; }

struct Unit { int pm, pn; const char* B; };

struct DenseOrder {
    int nM, nN, nwg, G, c; const char* Bt; size_t bstep;
    __device__ void init(int M, int N, int K, int G_, int c_, const void* Bt_) { nM = M / BM; nN = N / BM; nwg = nM * nN; G = G_; c = c_; Bt = (const char*)Bt_; bstep = (size_t)BM * K * 2; }
    __device__ bool next(int i, Unit& u) const {
        const long L = (long)i * G + c; if (L >= nwg) return false;
        int wgid = (int)L; { const int q = nwg / NXCD, r = nwg % NXCD, xcd = wgid % NXCD, off = wgid / NXCD; wgid = (xcd < r ? xcd * (q + 1) : r * (q + 1) + (xcd - r) * q) + off; }
        const int nig = WGM * nN, gid = wgid / nig, fm = gid * WGM, gsz = (nM - fm) < WGM ? (nM - fm) : WGM;
        u.pm = fm + ((wgid % nig) % gsz); u.pn = (wgid % nig) / gsz; u.B = Bt + (size_t)u.pn * bstep; return true;
    }
    __device__ __forceinline__ int arow(const Unit& u, int r) const { return u.pm * BM + r; }
};
struct MoeOrder {
    int G, c, nN, ntiles; const LAS int* pst; const int* rowidx; const char* Bt; size_t estep, bstep;
    __device__ bool next(int i, Unit& u) const {
        const int cc = (G % NXCD == 0) ? (c % NXCD) * (G / NXCD) + c / NXCD : c;
        const int L = i * G + cc; if (L >= ntiles * nN) return false;
        u.pm = L / nN; u.pn = L % nN; const int row0 = u.pm * BM; int e = 0;
#pragma unroll
        for (int st = NEXP / 2; st > 0; st >>= 1) if (row0 >= pst[e + st]) e += st;
        u.B = Bt + (size_t)e * estep + (size_t)u.pn * bstep; return true;
    }
    __device__ __forceinline__ int arow(const Unit& u, int r) const { if (!rowidx) return u.pm * BM + r; const int t = rowidx[u.pm * BM + r]; return t < 0 ? 0 : t; }
};

struct EpiBf16I { static constexpr bool PERM = true; bf16_t* O; int ldc; const float* rowscale; const unsigned* colmax;
    __device__ __forceinline__ void operator()(const f32x4 (&acc)[2][2][4][2], const Unit& u, int wr, int wc, int fr, int fq) const {
        const int row0 = u.pm * BM + wr * 64 + fr, col0 = u.pn * BM + wc * 32 + 8 * fq;
        float rsc[8]; f32x4 cs[2][2];
#pragma unroll
        for (int q = 0; q < 8; ++q) rsc[q] = rowscale[row0 + (q >> 2) * HALF + (q & 3) * 16] * (1.f / 127.f);
#pragma unroll
        for (int bj = 0; bj < 2; ++bj)
#pragma unroll
            for (int n = 0; n < 2; ++n) { const u32x4 c4 = *(const u32x4*)(colmax + col0 + bj * HALF + 4 * n); cs[bj][n] = (f32x4){__uint_as_float(c4.x), __uint_as_float(c4.y), __uint_as_float(c4.z), __uint_as_float(c4.w)} * (1.f / 127.f); }
#pragma unroll
        for (int ai = 0; ai < 2; ++ai)
#pragma unroll
            for (int m = 0; m < 4; ++m) { bf16_t* rowp = O + (size_t)(row0 + ai * HALF + m * 16) * ldc + col0; const float rs = rsc[ai * 4 + m];
#pragma unroll
                for (int bj = 0; bj < 2; ++bj) { const v4i_t i0 = __builtin_bit_cast(v4i_t, acc[ai][bj][m][0]), i1 = __builtin_bit_cast(v4i_t, acc[ai][bj][m][1]);
                    const f32x4 s0 = cs[bj][0] * rs, s1 = cs[bj][1] * rs;
                    u32x4 w; w.x = cvt_pk_bf16((float)i0[0] * s0[0], (float)i0[1] * s0[1]); w.y = cvt_pk_bf16((float)i0[2] * s0[2], (float)i0[3] * s0[3]);
                    w.z = cvt_pk_bf16((float)i1[0] * s1[0], (float)i1[1] * s1[1]); w.w = cvt_pk_bf16((float)i1[2] * s1[2], (float)i1[3] * s1[3]);
                    *(u32x4*)(rowp + bj * HALF) = w; } }
    } };
struct EpiBf16 { static constexpr bool PERM = true; bf16_t* O; int ldc;
    __device__ __forceinline__ void operator()(const f32x4 (&acc)[2][2][4][2], const Unit& u, int wr, int wc, int fr, int fq) const {
        const int row0 = u.pm * BM + wr * 64 + fr, col0 = u.pn * BM + wc * 32 + 8 * fq;
#pragma unroll
        for (int ai = 0; ai < 2; ++ai)
#pragma unroll
            for (int m = 0; m < 4; ++m) { bf16_t* rowp = O + (size_t)(row0 + ai * HALF + m * 16) * ldc + col0;
#pragma unroll
                for (int bj = 0; bj < 2; ++bj) { const f32x4 v0 = acc[ai][bj][m][0], v1 = acc[ai][bj][m][1];
                    u32x4 w; w.x = cvt_pk_bf16(v0[0], v0[1]); w.y = cvt_pk_bf16(v0[2], v0[3]); w.z = cvt_pk_bf16(v1[0], v1[1]); w.w = cvt_pk_bf16(v1[2], v1[3]);
                    *(u32x4*)(rowp + bj * HALF) = w; } }
    } };
template <bool XF32> struct EpiResid { static constexpr bool PERM = true; const void* __restrict__ X; bf16_t* __restrict__ O;
    __device__ __forceinline__ void operator()(const f32x4 (&acc)[2][2][4][2], const Unit& u, int wr, int wc, int fr, int fq) const {
        const int row0 = u.pm * BM + wr * 64 + fr, col0 = u.pn * BM + wc * 32 + 8 * fq;
        if constexpr (XF32) {
#pragma unroll
            for (int ai = 0; ai < 2; ++ai)
#pragma unroll
                for (int mp = 0; mp < 2; ++mp) { f32x4 x[2][2][2];
#pragma unroll
                    for (int mm = 0; mm < 2; ++mm)
#pragma unroll
                        for (int bj = 0; bj < 2; ++bj) { const float* xp = (const float*)X + (size_t)(row0 + ai * HALF + (mp * 2 + mm) * 16) * DM + col0 + bj * HALF; x[mm][bj][0] = *(const f32x4*)xp; x[mm][bj][1] = *(const f32x4*)(xp + 4); }
#pragma unroll
                    for (int mm = 0; mm < 2; ++mm)
#pragma unroll
                        for (int bj = 0; bj < 2; ++bj) { const f32x4 v0 = x[mm][bj][0] + acc[ai][bj][mp * 2 + mm][0], v1 = x[mm][bj][1] + acc[ai][bj][mp * 2 + mm][1];
                            u32x4 w; w.x = cvt_pk_bf16(v0[0], v0[1]); w.y = cvt_pk_bf16(v0[2], v0[3]); w.z = cvt_pk_bf16(v1[0], v1[1]); w.w = cvt_pk_bf16(v1[2], v1[3]);
                            *(u32x4*)(O + (size_t)(row0 + ai * HALF + (mp * 2 + mm) * 16) * DM + col0 + bj * HALF) = w; } }
        } else {
#pragma unroll
            for (int ai = 0; ai < 2; ++ai) { u32x4 x[4][2];
#pragma unroll
                for (int m = 0; m < 4; ++m)
#pragma unroll
                    for (int bj = 0; bj < 2; ++bj) x[m][bj] = *(const u32x4*)((const bf16_t*)X + (size_t)(row0 + ai * HALF + m * 16) * DM + col0 + bj * HALF);
#pragma unroll
                for (int m = 0; m < 4; ++m)
#pragma unroll
                    for (int bj = 0; bj < 2; ++bj) { const u32x4 o = x[m][bj];
                        const f32x4 v0 = (f32x4){__uint_as_float(o.x << 16), __uint_as_float(o.x & 0xffff0000u), __uint_as_float(o.y << 16), __uint_as_float(o.y & 0xffff0000u)} + acc[ai][bj][m][0];
                        const f32x4 v1 = (f32x4){__uint_as_float(o.z << 16), __uint_as_float(o.z & 0xffff0000u), __uint_as_float(o.w << 16), __uint_as_float(o.w & 0xffff0000u)} + acc[ai][bj][m][1];
                        u32x4 w; w.x = cvt_pk_bf16(v0[0], v0[1]); w.y = cvt_pk_bf16(v0[2], v0[3]); w.z = cvt_pk_bf16(v1[0], v1[1]); w.w = cvt_pk_bf16(v1[2], v1[3]);
                        *(u32x4*)(O + (size_t)(row0 + ai * HALF + m * 16) * DM + col0 + bj * HALF) = w; } }
        }
    } };
struct EpiSwiGLU { static constexpr bool PERM = true; bf16_t* H; const float* tscale;
    __device__ __forceinline__ void operator()(const f32x4 (&acc)[2][2][4][2], const Unit& u, int wr, int wc, int fr, int fq) const {
        const int row0 = u.pm * BM + wr * 64 + fr, col0 = u.pn * HALF + wc * 32 + 8 * fq;
        const float s0 = tscale[2 * u.pm], s1 = tscale[2 * u.pm + 1];
#pragma unroll
        for (int ai = 0; ai < 2; ++ai)
#pragma unroll
            for (int m = 0; m < 4; ++m) { float h[8];
#pragma unroll
                for (int n = 0; n < 2; ++n) { const v4i_t gi = __builtin_bit_cast(v4i_t, acc[ai][0][m][n]), ui = __builtin_bit_cast(v4i_t, acc[ai][1][m][n]);
#pragma unroll
                    for (int j = 0; j < 4; ++j) { const float g = (float)gi[j] * s0; h[n * 4 + j] = g * __builtin_amdgcn_rcpf(1.f + __expf(-g)) * ((float)ui[j] * s1); } }
                u32x4 w; w.x = cvt_pk_bf16(h[0], h[1]); w.y = cvt_pk_bf16(h[2], h[3]); w.z = cvt_pk_bf16(h[4], h[5]); w.w = cvt_pk_bf16(h[6], h[7]);
                *(u32x4*)(H + (size_t)(row0 + ai * HALF + m * 16) * FF + col0) = w; }
    } };
struct EpiDown { static constexpr bool PERM = true; bf16_t* Y; const int* row_tok; const int* row_slot; const float* row_gate;
    __device__ __forceinline__ void operator()(const f32x4 (&acc)[2][2][4][2], const Unit& u, int wr, int wc, int fr, int fq) const {
        const int row0 = u.pm * BM + wr * 64 + fr, col0 = u.pn * BM + wc * 32 + 8 * fq;
        int tk[8], sl[8]; float gt[8];
#pragma unroll
        for (int q = 0; q < 8; ++q) { const int r = row0 + (q >> 2) * HALF + (q & 3) * 16; tk[q] = row_tok[r]; sl[q] = row_slot[r]; gt[q] = row_gate[r]; }
#pragma unroll
        for (int ai = 0; ai < 2; ++ai)
#pragma unroll
            for (int m = 0; m < 4; ++m) { const int q = ai * 4 + m;
                if (tk[q] < 0) continue;
                bf16_t* rowp = Y + (size_t)sl[q] * DM + col0;
#pragma unroll
                for (int bj = 0; bj < 2; ++bj) { const f32x4 v0 = acc[ai][bj][m][0] * gt[q], v1 = acc[ai][bj][m][1] * gt[q];
                    u32x4 w; w.x = cvt_pk_bf16(v0[0], v0[1]); w.y = cvt_pk_bf16(v0[2], v0[3]); w.z = cvt_pk_bf16(v1[0], v1[1]); w.w = cvt_pk_bf16(v1[2], v1[3]);
                    *(u32x4*)(rowp + bj * HALF) = w; } }
    } };

template <class Epi, class Sched, bool I8 = false>
__device__ __forceinline__ void gemm_phase(LAS unsigned char* lds, const char* A, const unsigned lda_b, const int K, const Sched& S, const Epi& E) {
    const int tid = threadIdx.x, wid = __builtin_amdgcn_readfirstlane(tid >> 6), lane = tid & 63, wr = wid >> 2, wc = wid & 3, fr = lane & 15, fq = lane >> 4;
    const int nt = K / BK;
    unsigned voffB[2];
#pragma unroll
    for (int i = 0; i < 2; ++i) { int R, C; stage_rc(tid * 16 + i * 8192, R, C); const int Rb = Epi::PERM ? ((R & ~31) + perm32(R & 31)) : R; voffB[i] = (unsigned)(Rb * K + C) * 2u; }
    const size_t kstep = (size_t)(BK * 2);
    const size_t hstepB = (size_t)HALF * K * 2;
    const unsigned ldsw = (unsigned)wid * 1024u;
    const int aoff = lds_byte(wr * 64 + fr, fq * 8), boff = lds_byte(wc * 32 + fr, fq * 8);
#define PG8_SA(b, h) (((b) * 2 + (h)) * HTB)
#define PG8_SB(b, h) ((4 + (b) * 2 + (h)) * HTB)
#define PG8_STAGE(bufoff, gbase, voff) do { _Pragma("unroll") for (int _i = 0; _i < 2; ++_i) \
        __builtin_amdgcn_global_load_lds((const unsigned*)((const char*)(gbase) + (voff)[_i]), (LAS unsigned*)(lds + (bufoff) + ldsw + _i * 8192), 16, 0, 0); } while (0)
#define PG8_LDA(dst, b, h) do { _Pragma("unroll") for (int m = 0; m < 4; ++m) _Pragma("unroll") for (int k = 0; k < 2; ++k) dst[m][k] = *(const LAS bf16x8*)(lds + PG8_SA(b, h) + aoff + m * 2048 + k * 1024); } while (0)
#define PG8_LDB(dst, b, h) do { _Pragma("unroll") for (int n = 0; n < 2; ++n) _Pragma("unroll") for (int k = 0; k < 2; ++k) dst[n][k] = *(const LAS bf16x8*)(lds + PG8_SB(b, h) + boff + n * 2048 + k * 1024); } while (0)
#define PG8_MMA(ai, bj, At, Bt) do { __builtin_amdgcn_s_setprio(1); _Pragma("unroll") for (int m = 0; m < 4; ++m) _Pragma("unroll") for (int n = 0; n < 2; ++n) _Pragma("unroll") for (int k = 0; k < 2; ++k) { \
        if constexpr (I8) acc[ai][bj][m][n] = __builtin_bit_cast(f32x4, __builtin_amdgcn_mfma_i32_16x16x64_i8(__builtin_bit_cast(v4i_t, Bt[n][k]), __builtin_bit_cast(v4i_t, At[m][k]), __builtin_bit_cast(v4i_t, acc[ai][bj][m][n]), 0, 0, 0)); \
        else acc[ai][bj][m][n] = __builtin_amdgcn_mfma_f32_16x16x32_bf16(Bt[n][k], At[m][k], acc[ai][bj][m][n], 0, 0, 0); } __builtin_amdgcn_s_setprio(0); } while (0)
#define PG8_WAIT_V(n) asm volatile("s_waitcnt vmcnt(" #n ")" ::: "memory")
#define PG8_WAIT_L(n) asm volatile("s_waitcnt lgkmcnt(" #n ")" ::: "memory")
#define PG8_BAR __builtin_amdgcn_s_barrier()
#define PG8_SCHED __builtin_amdgcn_sched_barrier(0)
#define PG8_AOFF(dst, u) do { int _tz = threadIdx.x; asm volatile("" : "+v"(_tz)); _Pragma("unroll") for (int _i = 0; _i < 2; ++_i) { int _R, _C; stage_rc(_tz * 16 + _i * 8192, _R, _C); \
        _Pragma("unroll") for (int _h = 0; _h < 2; ++_h) dst[_h][_i] = (unsigned)S.arow(u, _h * HALF + _R) * lda_b + (unsigned)_C * 2u; } } while (0)
    Unit cur, nxt; int ui = 0;
    if (!S.next(0, cur)) return;
    f32x4 acc[2][2][4][2];
#pragma unroll
    for (int a = 0; a < 2; ++a)
#pragma unroll
        for (int b = 0; b < 2; ++b)
#pragma unroll
            for (int m = 0; m < 4; ++m)
#pragma unroll
                for (int n = 0; n < 2; ++n) acc[a][b][m][n] = (f32x4){0.f, 0.f, 0.f, 0.f};
    bf16x8 At[4][2], B0[2][2], B1[2][2];
    unsigned vA[2][2], vAn[2][2];
    PG8_AOFF(vA, cur);
    const char* cB = cur.B;
    PG8_STAGE(PG8_SB(0, 0), cB, voffB); PG8_STAGE(PG8_SA(0, 0), A, vA[0]); PG8_STAGE(PG8_SB(0, 1), cB + hstepB, voffB); PG8_STAGE(PG8_SA(0, 1), A, vA[1]);
    if (wr == 1) PG8_BAR;
    PG8_WAIT_V(4); PG8_BAR;
    PG8_STAGE(PG8_SB(1, 0), cB + kstep, voffB); PG8_STAGE(PG8_SA(1, 0), A + kstep, vA[0]); PG8_STAGE(PG8_SB(1, 1), cB + hstepB + kstep, voffB);
    PG8_WAIT_V(6); PG8_BAR;
    for (;;) {
        const bool has_next = S.next(ui + 1, nxt);
        if (has_next) { PG8_AOFF(vAn, nxt); } else {
#pragma unroll
            for (int h = 0; h < 2; ++h)
#pragma unroll
                for (int i = 0; i < 2; ++i) vAn[h][i] = vA[h][i]; }
        const char* nB = has_next ? nxt.B : cB;
        for (int t = 0; t < nt; t += 2) {
            const bool last = (t == nt - 2);
            const char* a1 = A + (size_t)(t + 1) * kstep;
            const char* a2 = last ? A : A + (size_t)(t + 2) * kstep; const char* b2 = last ? nB : cB + (size_t)(t + 2) * kstep;
            const char* a3 = a2 + kstep; const char* b3 = b2 + kstep;
            unsigned o2[2][2];
#pragma unroll
            for (int h = 0; h < 2; ++h)
#pragma unroll
                for (int i = 0; i < 2; ++i) o2[h][i] = last ? vAn[h][i] : vA[h][i];
            PG8_LDB(B0, 0, 0); PG8_SCHED; PG8_LDA(At, 0, 0); PG8_STAGE(PG8_SA(1, 1), a1, vA[1]);
            PG8_WAIT_L(8); PG8_BAR; PG8_WAIT_L(0); PG8_MMA(0, 0, At, B0); PG8_BAR; PG8_SCHED;
            PG8_LDB(B1, 0, 1); PG8_STAGE(PG8_SB(0, 0), b2, voffB);
            PG8_BAR; PG8_WAIT_L(0); PG8_MMA(0, 1, At, B1); PG8_BAR;
            PG8_LDA(At, 0, 1); PG8_STAGE(PG8_SA(0, 0), a2, o2[0]);
            PG8_BAR; PG8_WAIT_L(0); PG8_MMA(1, 0, At, B0); PG8_BAR; PG8_SCHED;
            PG8_STAGE(PG8_SB(0, 1), b2 + hstepB, voffB);
            PG8_WAIT_V(6); PG8_BAR; PG8_MMA(1, 1, At, B1); PG8_BAR;
            PG8_LDB(B0, 1, 0); PG8_SCHED; PG8_LDA(At, 1, 0); PG8_STAGE(PG8_SA(0, 1), a2, o2[1]);
            PG8_WAIT_L(8); PG8_BAR; PG8_WAIT_L(0); PG8_MMA(0, 0, At, B0); PG8_BAR; PG8_SCHED;
            PG8_LDB(B1, 1, 1); PG8_STAGE(PG8_SB(1, 0), b3, voffB);
            PG8_BAR; PG8_WAIT_L(0); PG8_MMA(0, 1, At, B1); PG8_BAR;
            PG8_LDA(At, 1, 1); PG8_STAGE(PG8_SA(1, 0), a3, o2[0]);
            PG8_BAR; PG8_WAIT_L(0); PG8_MMA(1, 0, At, B0); PG8_BAR; PG8_SCHED;
            PG8_STAGE(PG8_SB(1, 1), b3 + hstepB, voffB);
            PG8_WAIT_V(6); PG8_BAR; PG8_MMA(1, 1, At, B1); PG8_BAR;
        }
        E(acc, cur, wr, wc, fr, fq);
        if (!has_next) break;
#pragma unroll
        for (int a = 0; a < 2; ++a)
#pragma unroll
            for (int b = 0; b < 2; ++b)
#pragma unroll
                for (int m = 0; m < 4; ++m)
#pragma unroll
                    for (int n = 0; n < 2; ++n) acc[a][b][m][n] = (f32x4){0.f, 0.f, 0.f, 0.f};
        cur = nxt; cB = nB; ++ui;
#pragma unroll
        for (int h = 0; h < 2; ++h)
#pragma unroll
            for (int i = 0; i < 2; ++i) vA[h][i] = vAn[h][i];
    }
    PG8_WAIT_V(0);
    if (wr == 0) PG8_BAR;
    PG8_BAR;
#undef PG8_SA
#undef PG8_SB
#undef PG8_STAGE
#undef PG8_LDA
#undef PG8_LDB
#undef PG8_MMA
#undef PG8_WAIT_V
#undef PG8_WAIT_L
#undef PG8_BAR
#undef PG8_SCHED
#undef PG8_AOFF
}
}

template <int MODE>
__device__ __forceinline__ void transpose_item(const float* W, int K, int N, bf16_t* WT, LAS float* scr, int item, int lane) {
    const int nblk = N / 64, kb = item / nblk, nb = item % nblk, k0 = 64 * kb, n0 = 64 * nb;
    const int lr = lane >> 4, lc = (lane & 15) * 4;
    float4 v[16];
#pragma unroll
    for (int i = 0; i < 16; ++i) v[i] = *(const float4*)(W + (size_t)(k0 + 4 * i + lr) * N + n0 + lc);
#pragma unroll
    for (int i = 0; i < 16; ++i) { LAS float* d = scr + (4 * i + lr) * 66 + lc; *(LAS f32x2_hw*)d = (f32x2_hw){v[i].x, v[i].y}; *(LAS f32x2_hw*)(d + 2) = (f32x2_hw){v[i].z, v[i].w}; }
    asm volatile("s_waitcnt lgkmcnt(0)" ::: "memory");
    const int c = lane & 7;
#pragma unroll
    for (int j = 0; j < 8; ++j) { const int n = (lane >> 3) + 8 * j; const LAS float* sp = scr + (8 * c) * 66 + n;
        pg8::u32x4 o; o.x = pk2(sp[0 * 66], sp[1 * 66]); o.y = pk2(sp[2 * 66], sp[3 * 66]); o.z = pk2(sp[4 * 66], sp[5 * 66]); o.w = pk2(sp[6 * 66], sp[7 * 66]);
        const int nn = n0 + n; const int dr = MODE == 0 ? nn : (256 * (nn >> 7) + (nn & 127) + (MODE == 2 ? 128 : 0));
        *(pg8::u32x4*)(WT + (size_t)dr * K + k0 + 8 * c) = o; }
    asm volatile("s_waitcnt lgkmcnt(0)" ::: "memory");
}
__device__ __forceinline__ float wave_max(float v) {
    v = fmaxf(v, dpp_<0xB1>(v)); v = fmaxf(v, dpp_<0x4E>(v)); v = fmaxf(v, dpp_<0x124>(v)); v = fmaxf(v, dpp_<0x128>(v));
    auto s = __builtin_amdgcn_permlane16_swap(__float_as_uint(v), __float_as_uint(v), false, false); v = fmaxf(__uint_as_float(s[0]), __uint_as_float(s[1]));
    auto t = __builtin_amdgcn_permlane32_swap(__float_as_uint(v), __float_as_uint(v), false, false); return fmaxf(__uint_as_float(t[0]), __uint_as_float(t[1])); }
__device__ __forceinline__ unsigned q8x4(float a, float b, float c, float d, float qs) {
    const int ia = (int)rintf(fminf(fmaxf(a * qs, -127.f), 127.f)), ib = (int)rintf(fminf(fmaxf(b * qs, -127.f), 127.f)), ic = (int)rintf(fminf(fmaxf(c * qs, -127.f), 127.f)), id = (int)rintf(fminf(fmaxf(d * qs, -127.f), 127.f));
    return (unsigned)(ia & 255) | ((unsigned)(ib & 255) << 8) | ((unsigned)(ic & 255) << 16) | ((unsigned)(id & 255) << 24); }
__device__ __noinline__ void ph_wmax(const float* wg, const float* wu, unsigned* wmax, int bid, int nblk) {
    const int wave = threadIdx.x >> 6, lane = threadIdx.x & 63, gw = bid * 8 + wave, NGW = nblk * 8;
    constexpr int IT = (DM / 64) * (FF / 64);
    for (int it = gw; it < 2 * NEXP * 2 * IT; it += NGW) { const int mat = it / IT, tl = it % IT; const int le = mat >> 1, gu = mat & 1;
        const float* W = (gu ? wu : wg) + (size_t)le * DM * FF; const int k0 = 64 * (tl / (FF / 64)), n0 = 64 * (tl % (FF / 64));
        float m = 0.f;
#pragma unroll 4
        for (int i = 0; i < 16; ++i) { const float4 v = *(const float4*)(W + (size_t)(k0 + 4 * i + (lane >> 4)) * FF + n0 + (lane & 15) * 4); m = fmaxf(fmaxf(m, fmaxf(fabsf(v.x), fabsf(v.y))), fmaxf(fabsf(v.z), fabsf(v.w))); }
        m = wave_max(m);
        if (lane == 0) atomicMax(wmax + le * 2 + gu, __float_as_uint(m)); }
}
template <int MODE>
__device__ __forceinline__ void transpose_item_i8(const float* W, int K, int N, unsigned char* WT, LAS float* scr, int item, int lane, float qs) {
    const int nblk = N / 64, kb = item / nblk, nb = item % nblk, k0 = 64 * kb, n0 = 64 * nb;
    const int lr = lane >> 4, lc = (lane & 15) * 4;
    float4 v[16];
#pragma unroll
    for (int i = 0; i < 16; ++i) v[i] = *(const float4*)(W + (size_t)(k0 + 4 * i + lr) * N + n0 + lc);
#pragma unroll
    for (int i = 0; i < 16; ++i) { LAS float* d = scr + (4 * i + lr) * 66 + lc; *(LAS f32x2_hw*)d = (f32x2_hw){v[i].x, v[i].y}; *(LAS f32x2_hw*)(d + 2) = (f32x2_hw){v[i].z, v[i].w}; }
    asm volatile("s_waitcnt lgkmcnt(0)" ::: "memory");
    const int c = lane & 3;
#pragma unroll
    for (int j = 0; j < 4; ++j) { const int n = (lane >> 2) + 16 * j; const LAS float* sp = scr + (16 * c) * 66 + n;
        pg8::u32x4 o;
        o.x = q8x4(sp[0 * 66], sp[1 * 66], sp[2 * 66], sp[3 * 66], qs); o.y = q8x4(sp[4 * 66], sp[5 * 66], sp[6 * 66], sp[7 * 66], qs);
        o.z = q8x4(sp[8 * 66], sp[9 * 66], sp[10 * 66], sp[11 * 66], qs); o.w = q8x4(sp[12 * 66], sp[13 * 66], sp[14 * 66], sp[15 * 66], qs);
        const int nn = n0 + n; const int dr = MODE == 0 ? nn : (256 * (nn >> 7) + (nn & 127) + (MODE == 2 ? 128 : 0));
        *(pg8::u32x4*)(WT + (size_t)dr * K + k0 + 16 * c) = o; }
    asm volatile("s_waitcnt lgkmcnt(0)" ::: "memory");
}
__device__ __forceinline__ void transpose_item_i8c(const float* W, int K, int N, unsigned char* WT, LAS float* scr, int item, int lane, const unsigned* colmax) {
    const int nblk = N / 64, kb = item / nblk, nb = item % nblk, k0 = 64 * kb, n0 = 64 * nb;
    const int lr = lane >> 4, lc = (lane & 15) * 4;
    float4 v[16];
#pragma unroll
    for (int i = 0; i < 16; ++i) v[i] = *(const float4*)(W + (size_t)(k0 + 4 * i + lr) * N + n0 + lc);
#pragma unroll
    for (int i = 0; i < 16; ++i) { LAS float* d = scr + (4 * i + lr) * 66 + lc; *(LAS f32x2_hw*)d = (f32x2_hw){v[i].x, v[i].y}; *(LAS f32x2_hw*)(d + 2) = (f32x2_hw){v[i].z, v[i].w}; }
    asm volatile("s_waitcnt lgkmcnt(0)" ::: "memory");
    const int c = lane & 3;
#pragma unroll
    for (int j = 0; j < 4; ++j) { const int n = (lane >> 2) + 16 * j; const LAS float* sp = scr + (16 * c) * 66 + n;
        const float qs = 127.f / fmaxf(__uint_as_float(colmax[n0 + n]), 1e-30f);
        pg8::u32x4 o;
        o.x = q8x4(sp[0 * 66], sp[1 * 66], sp[2 * 66], sp[3 * 66], qs); o.y = q8x4(sp[4 * 66], sp[5 * 66], sp[6 * 66], sp[7 * 66], qs);
        o.z = q8x4(sp[8 * 66], sp[9 * 66], sp[10 * 66], sp[11 * 66], qs); o.w = q8x4(sp[12 * 66], sp[13 * 66], sp[14 * 66], sp[15 * 66], qs);
        *(pg8::u32x4*)(WT + (size_t)(n0 + n) * K + k0 + 16 * c) = o; }
    asm volatile("s_waitcnt lgkmcnt(0)" ::: "memory");
}
__device__ __forceinline__ void frag_build(const float* W, int ldw, int col0, int nks, bf16_t* dst, int lane) {
    const int q4 = lane >> 4, c16 = lane & 15;
    for (int ct = 0; ct < 4; ++ct) for (int ks = 0; ks < nks; ++ks) { float v[8];
#pragma unroll
        for (int jj = 0; jj < 8; ++jj) v[jj] = W[(size_t)(32 * ks + 8 * q4 + jj) * ldw + col0 + 16 * ct + c16];
        *(pg8::u32x4*)(dst + ((size_t)(ct * nks + ks) * 64 + lane) * 8) = (pg8::u32x4){pk2(v[0], v[1]), pk2(v[2], v[3]), pk2(v[4], v[5]), pk2(v[6], v[7])}; }
}
__device__ __forceinline__ void ph_cvt_frags(const Args& a) {
    const int wave = threadIdx.x >> 6, lane = threadIdx.x & 63, gw = blockIdx.x * 8 + wave;
    if (gw >= 40) {
        const int it = gw - 40; if (it >= 64) return;
        const int L = it >> 5, ks = it & 31, q4 = lane >> 4, c16 = lane & 15;
        const float* gain = a.in[2] + L * DM; const float* wg = a.in[28] + (size_t)L * DM * 4; const float* we = a.in[30] + (size_t)L * DM * 32;
        bf16_t* dh = (bf16_t*)(a.ws + FG_RT) + (size_t)L * 2 * 49152; bf16_t* dl = dh + 49152;
        for (int ct = 0; ct < 3; ++ct) { const int col = 16 * ct + c16; float hi[8], lo[8];
#pragma unroll
            for (int jj = 0; jj < 8; ++jj) { const int k = 32 * ks + 8 * q4 + jj; const float w = col < 4 ? wg[k * 4 + col] : (col < 36 ? we[k * 32 + col - 4] : 0.f); const float v = gain[k] * w;
                hi[jj] = bf2f(f2bf(v)); lo[jj] = v - hi[jj]; }
            const size_t o = ((size_t)(ks * 3 + ct) * 64 + lane) * 8;
            *(pg8::u32x4*)(dh + o) = (pg8::u32x4){pk2(hi[0], hi[1]), pk2(hi[2], hi[3]), pk2(hi[4], hi[5]), pk2(hi[6], hi[7])};
            *(pg8::u32x4*)(dl + o) = (pg8::u32x4){pk2(lo[0], lo[1]), pk2(lo[2], lo[3]), pk2(lo[4], lo[5]), pk2(lo[6], lo[7])}; }
        return; }
    const int arr = gw >> 3, h = gw & 7;
    if (arr == 0) frag_build(a.in[7], 512, 64 * h, 2, (bf16_t*)(a.ws + FG_W2) + h * 4096, lane);
    else if (arr == 1) frag_build(a.in[9], 512, 64 * h, 2, (bf16_t*)(a.ws + FG_A2) + h * 4096, lane);
    else if (arr == 2) frag_build(a.in[18] + h * 4096, 64, 0, 2, (bf16_t*)(a.ws + FG_WA) + h * 4096, lane);
    else if (arr == 3) frag_build(a.in[20] + h * 4096, 64, 0, 2, (bf16_t*)(a.ws + FG_WX) + h * 4096, lane);
    else frag_build(a.in[10], 512, 64 * h, 4, (bf16_t*)(a.ws + FG_G2) + h * 8192, lane);
}
__device__ __forceinline__ void ph_cvt_dense_a(const Args& a, LAS float* lds, unsigned* colmax) {
    const int wave = threadIdx.x >> 6, lane = threadIdx.x & 63, gw = blockIdx.x * 8 + wave, NGW = gridDim.x * 8;
    LAS float* scr = lds + wave * (64 * 66);
    constexpr int I0 = (DM / 64) * (ABC / 64), I1 = (DM / 64) * (DM / 64), I2 = (DM / 64) * (4096 / 64), I3 = I1;
    for (int it = gw; it < I0 + I1 + I2 + I3; it += NGW) { int r = it;
        if (r < I1) { transpose_item<0>(a.in[23], DM, DM, (bf16_t*)(a.ws + WD_ABOUT), scr, r, lane); continue; } r -= I1;
        if (r < I3) { transpose_item<0>(a.in[27], DM, DM, (bf16_t*)(a.ws + WD_COUT), scr, r, lane); continue; } r -= I3;
        const int m = r < I0 ? 0 : 1; if (m) r -= I0; const int N = m ? 4096 : ABC; const float* W = m ? a.in[24] : a.in[4];
        const int k0 = 64 * (r / (N / 64)), n0 = 64 * (r % (N / 64)); float mx[4] = {0.f, 0.f, 0.f, 0.f};
#pragma unroll 4
        for (int i = 0; i < 16; ++i) { const float4 v = *(const float4*)(W + (size_t)(k0 + 4 * i + (lane >> 4)) * N + n0 + (lane & 15) * 4);
            mx[0] = fmaxf(mx[0], fabsf(v.x)); mx[1] = fmaxf(mx[1], fabsf(v.y)); mx[2] = fmaxf(mx[2], fabsf(v.z)); mx[3] = fmaxf(mx[3], fabsf(v.w)); }
#pragma unroll
        for (int q = 0; q < 4; ++q) { float t = mx[q];
            auto s1 = __builtin_amdgcn_permlane16_swap(__float_as_uint(t), __float_as_uint(t), false, false); t = fmaxf(__uint_as_float(s1[0]), __uint_as_float(s1[1]));
            auto s2 = __builtin_amdgcn_permlane32_swap(__float_as_uint(t), __float_as_uint(t), false, false); t = fmaxf(__uint_as_float(s2[0]), __uint_as_float(s2[1]));
            if (lane < 16) atomicMax(colmax + (m ? ABC : 0) + n0 + lane * 4 + q, __float_as_uint(t)); } }
}
__device__ __forceinline__ void ph_cvt_dense_b(const Args& a, LAS float* lds, const unsigned* colmax, int m) {
    const int wave = threadIdx.x >> 6, lane = threadIdx.x & 63, gw = blockIdx.x * 8 + wave, NGW = gridDim.x * 8;
    LAS float* scr = lds + wave * (64 * 66);
    const int N = m ? 4096 : ABC; const int NI = (DM / 64) * (N / 64);
    for (int it = gw; it < NI; it += NGW) transpose_item_i8c(m ? a.in[24] : a.in[4], DM, N, a.ws + (m ? WD_CIN : WD_ABIN), scr, it, lane, colmax + (m ? ABC : 0));
}
__device__ __forceinline__ void ph_cvt_moe(const Args& a, int L, LAS float* lds, int bid, int nblk, int which) {
    const int wave = threadIdx.x >> 6, lane = threadIdx.x & 63, gw = bid * 8 + wave, NGW = nblk * 8;
    LAS float* scr = lds + wave * (64 * 66);
    constexpr int IG = (DM / 64) * (FF / 64), ID = (FF / 64) * (DM / 64);
    const int i0 = (which & 1) ? 0 : 2 * IG, IE = ((which & 1) ? 2 * IG : 0) + ((which & 2) ? ID : 0);
    unsigned char* gub = a.ws + (L ? WM_GU1 : WM_GU);
    for (int it = gw; it < NEXP * IE; it += NGW) { const int e = it / IE; int r = i0 + it % IE;
        unsigned char* gu = gub + (size_t)e * DM * DM; bf16_t* dn = (bf16_t*)(a.ws + WM_DN) + (size_t)e * DM * FF;
        const unsigned* wm = (const unsigned*)(a.ws + WS_CTL) + CW_WMAX + (L * NEXP + e) * 2;
        const size_t wo = ((size_t)L * NEXP + e) * DM * FF;
        if (r < IG) { transpose_item_i8<1>(a.in[32] + wo, DM, FF, gu, scr, r, lane, 127.f / fmaxf(__uint_as_float(wm[0]), 1e-30f)); continue; } r -= IG;
        if (r < IG) { transpose_item_i8<2>(a.in[33] + wo, DM, FF, gu, scr, r, lane, 127.f / fmaxf(__uint_as_float(wm[1]), 1e-30f)); continue; } r -= IG;
        transpose_item<0>(a.in[34] + wo, FF, DM, dn, scr, r, lane); }
}

__device__ __forceinline__ void load_row16(const float* row, int lane, float4 (&v)[4]) {
#pragma unroll
    for (int j = 0; j < 4; ++j) v[j] = *(const float4*)(row + lane * 4 + 256 * j);
}
__device__ __forceinline__ float row_sumsq(const float4 (&v)[4]) {
    float s = 0.f;
#pragma unroll
    for (int j = 0; j < 4; ++j) s += v[j].x * v[j].x + v[j].y * v[j].y + v[j].z * v[j].z + v[j].w * v[j].w;
    return wave_sum(s);
}
__device__ __forceinline__ void norm_row(float4 (&v)[4], const float* gain, int lane) {
    const float rs = rsqrtf(row_sumsq(v) * (1.f / DM) + 1e-6f);
#pragma unroll
    for (int j = 0; j < 4; ++j) { const float4 g = *(const float4*)(gain + lane * 4 + 256 * j);
        v[j].x *= rs * g.x; v[j].y *= rs * g.y; v[j].z *= rs * g.z; v[j].w *= rs * g.w; }
}
__device__ __forceinline__ void store_row_bf16(bf16_t* row, int lane, const float4 (&v)[4]) {
#pragma unroll
    for (int j = 0; j < 4; ++j) { uint2 o; o.x = f2bf(v[j].x) | ((unsigned)f2bf(v[j].y) << 16); o.y = f2bf(v[j].z) | ((unsigned)f2bf(v[j].w) << 16);
        *(uint2*)(row + lane * 4 + 256 * j) = o; }
}
__device__ __forceinline__ void add_row_bf16(const bf16_t* row, int lane, float4 (&v)[4]) {
#pragma unroll
    for (int j = 0; j < 4; ++j) { const uint2 o = *(const uint2*)(row + lane * 4 + 256 * j);
        v[j].x += __uint_as_float(o.x << 16); v[j].y += __uint_as_float(o.x & 0xffff0000u); v[j].z += __uint_as_float(o.y << 16); v[j].w += __uint_as_float(o.y & 0xffff0000u); }
}

__device__ __forceinline__ void ph_norm0(const float* x, const float* gain, unsigned char* HN8, float* rowscale) {
    const int lane = threadIdx.x & 63, gw = blockIdx.x * 8 + (threadIdx.x >> 6), NGW = gridDim.x * 8;
    for (int n = gw; n < NTOK; n += NGW) { float4 v[4]; load_row16(x + (size_t)n * DM, lane, v); norm_row(v, gain, lane);
        float mx = 0.f;
#pragma unroll
        for (int j = 0; j < 4; ++j) mx = fmaxf(fmaxf(mx, fmaxf(fabsf(v[j].x), fabsf(v[j].y))), fmaxf(fabsf(v[j].z), fabsf(v[j].w)));
        mx = fmaxf(wave_max(mx), 1e-30f); const float qs = 127.f / mx;
        if (lane == 0) rowscale[n] = mx;
#pragma unroll
        for (int j = 0; j < 4; ++j) *(unsigned*)(HN8 + (size_t)n * DM + lane * 4 + 256 * j) = q8x4(v[j].x, v[j].y, v[j].z, v[j].w, qs); }
}
__device__ __forceinline__ void ld8bf(const bf16_t* p, float (&v)[8]) { const u32x4_t o = *(const u32x4_t*)p;
    v[0] = __uint_as_float(o.x << 16); v[1] = __uint_as_float(o.x & 0xffff0000u); v[2] = __uint_as_float(o.y << 16); v[3] = __uint_as_float(o.y & 0xffff0000u);
    v[4] = __uint_as_float(o.z << 16); v[5] = __uint_as_float(o.z & 0xffff0000u); v[6] = __uint_as_float(o.w << 16); v[7] = __uint_as_float(o.w & 0xffff0000u); }
__device__ __forceinline__ void st8bf(bf16_t* p, const float (&v)[8]) { *(u32x4_t*)p = (u32x4_t){pk2(v[0], v[1]), pk2(v[2], v[3]), pk2(v[4], v[5]), pk2(v[6], v[7])}; }
__device__ __forceinline__ void ph_combine_norm(bf16_t* XR, const bf16_t* Y, const float* gain, unsigned char* HN8, float* rowscale) {
    const int lane = threadIdx.x & 63, gw = blockIdx.x * 8 + (threadIdx.x >> 6), NGW = gridDim.x * 8;
    for (int n = gw; n < NTOK; n += NGW) { float x[2][8], y0[2][8], y1[2][8]; float ss = 0.f;
#pragma unroll
        for (int j = 0; j < 2; ++j) { const int o = lane * 8 + 512 * j; ld8bf(XR + (size_t)n * DM + o, x[j]); ld8bf(Y + (size_t)(2 * n) * DM + o, y0[j]); ld8bf(Y + (size_t)(2 * n + 1) * DM + o, y1[j]); }
#pragma unroll
        for (int j = 0; j < 2; ++j) {
#pragma unroll
            for (int i = 0; i < 8; ++i) x[j][i] = bf2f(f2bf(x[j][i] + y0[j][i] + y1[j][i]));
            st8bf(XR + (size_t)n * DM + lane * 8 + 512 * j, x[j]);
#pragma unroll
            for (int i = 0; i < 8; ++i) ss += x[j][i] * x[j][i]; }
        const float rs = rsqrtf(wave_sum(ss) * (1.f / DM) + 1e-6f);
#pragma unroll
        for (int j = 0; j < 2; ++j) { const int o = lane * 8 + 512 * j; const float4 g0 = *(const float4*)(gain + o), g1 = *(const float4*)(gain + o + 4);
            const float gg[8] = {g0.x, g0.y, g0.z, g0.w, g1.x, g1.y, g1.z, g1.w};
#pragma unroll
            for (int i = 0; i < 8; ++i) x[j][i] *= rs * gg[i]; }
        float mx = 0.f;
#pragma unroll
        for (int j = 0; j < 2; ++j)
#pragma unroll
            for (int i = 0; i < 8; ++i) mx = fmaxf(mx, fabsf(x[j][i]));
        mx = fmaxf(wave_max(mx), 1e-30f); const float qs = 127.f / mx;
        if (lane == 0) rowscale[n] = mx;
#pragma unroll
        for (int j = 0; j < 2; ++j) { const int o = lane * 8 + 512 * j;
            *(u32x2_t*)(HN8 + (size_t)n * DM + o) = (u32x2_t){q8x4(x[j][0], x[j][1], x[j][2], x[j][3], qs), q8x4(x[j][4], x[j][5], x[j][6], x[j][7], qs)}; } }
}
__device__ __forceinline__ void ph_final(const bf16_t* XR, const bf16_t* Y, const float* gain, float* out) {
    const int lane = threadIdx.x & 63, gw = blockIdx.x * 8 + (threadIdx.x >> 6), NGW = gridDim.x * 8;
    for (int n = gw; n < NTOK; n += NGW) { float x[2][8], y0[2][8], y1[2][8]; float ss = 0.f;
#pragma unroll
        for (int j = 0; j < 2; ++j) { const int o = lane * 8 + 512 * j; ld8bf(XR + (size_t)n * DM + o, x[j]); ld8bf(Y + (size_t)(2 * n) * DM + o, y0[j]); ld8bf(Y + (size_t)(2 * n + 1) * DM + o, y1[j]); }
#pragma unroll
        for (int j = 0; j < 2; ++j)
#pragma unroll
            for (int i = 0; i < 8; ++i) { x[j][i] = x[j][i] + y0[j][i] + y1[j][i]; ss += x[j][i] * x[j][i]; }
        const float rs = rsqrtf(wave_sum(ss) * (1.f / DM) + 1e-6f);
#pragma unroll
        for (int j = 0; j < 2; ++j) { const int o = lane * 8 + 512 * j; const float4 g0 = *(const float4*)(gain + o), g1 = *(const float4*)(gain + o + 4);
            *(float4*)(out + (size_t)n * DM + o) = make_float4(x[j][0] * rs * g0.x, x[j][1] * rs * g0.y, x[j][2] * rs * g0.z, x[j][3] * rs * g0.w);
            *(float4*)(out + (size_t)n * DM + o + 4) = make_float4(x[j][4] * rs * g1.x, x[j][5] * rs * g1.y, x[j][6] * rs * g1.z, x[j][7] * rs * g1.w); } }
}
__device__ __forceinline__ void ph_route(const Args& a, int Lyr, const bf16_t* XR, bf16_t* HN, float* RS, unsigned* cnt, int* asg_e, int* asg_rank, float* asg_gate, LAS float* lds) {
    const float* gain = a.in[2] + Lyr * DM; const float* bg = a.in[29] + Lyr * 4; const float* be = a.in[31] + Lyr * 32;
    const bf16_t* FRh = (const bf16_t*)(a.ws + FG_RT) + (size_t)Lyr * 2 * 49152; const bf16_t* FRl = FRh + 49152;
    const int lane = threadIdx.x & 63, wave = threadIdx.x >> 6, q4 = lane >> 4, c16 = lane & 15, r4 = lane >> 4, cidx = lane & 15;
    LAS unsigned char* Lb = (LAS unsigned char*)lds;
    LAS unsigned char* W = Lb + wave * 12288;
    LAS float* SS = (LAS float*)(W + 8704); LAS float* LG = (LAS float*)(W + 8768);
    LAS unsigned* lcnt = (LAS unsigned*)(Lb + 8 * 12288); LAS unsigned* lbase = lcnt + 32;
    const int NGW = gridDim.x * 8, gw = blockIdx.x * 8 + wave;
    for (int rnd = 0; rnd * NGW < NTOK / 16; ++rnd) {
        const int tile = rnd * NGW + gw; const bool act = tile < NTOK / 16; const int n0 = tile * 16;
        if (threadIdx.x < 32) lcnt[threadIdx.x] = 0u;
        __syncthreads();
        int e0 = 0, e1 = 0, lr0 = 0, lr1 = 0; float g0 = 0.f, g1 = 0.f;
        if (act) {
            f32x4 acc[3], accs = (f32x4){0.f, 0.f, 0.f, 0.f};
#pragma unroll
            for (int ct = 0; ct < 3; ++ct) acc[ct] = accs;
#pragma unroll 1
            for (int kc = 0; kc < 8; ++kc) {
                bf16x8_t bh[4][3], bl[4][3];
#pragma unroll
                for (int ks = 0; ks < 4; ++ks)
#pragma unroll
                    for (int ct = 0; ct < 3; ++ct) { const size_t o = ((size_t)((kc * 4 + ks) * 3 + ct) * 64 + lane) * 8; bh[ks][ct] = *(const bf16x8_t*)(FRh + o); bl[ks][ct] = *(const bf16x8_t*)(FRl + o); }
                u32x4_t xv[4];
#pragma unroll
                for (int j = 0; j < 4; ++j) xv[j] = *(const u32x4_t*)(XR + (size_t)(n0 + 4 * j + r4) * DM + kc * 128 + 8 * cidx);
                __builtin_amdgcn_sched_barrier(0);
#pragma unroll
                for (int j = 0; j < 4; ++j) *(LAS u32x4_t*)(W + (4 * j + r4) * 272 + cidx * 16) = xv[j];
#pragma unroll
                for (int ks = 0; ks < 4; ++ks) { const bf16x8_t ahi = *(const LAS bf16x8_t*)(W + c16 * 272 + ks * 64 + q4 * 16);
                    accs = __builtin_amdgcn_mfma_f32_16x16x32_bf16(ahi, ahi, accs, 0, 0, 0);
#pragma unroll
                    for (int ct = 0; ct < 3; ++ct) { acc[ct] = __builtin_amdgcn_mfma_f32_16x16x32_bf16(ahi, bh[ks][ct], acc[ct], 0, 0, 0); acc[ct] = __builtin_amdgcn_mfma_f32_16x16x32_bf16(ahi, bl[ks][ct], acc[ct], 0, 0, 0); } }
            }
#pragma unroll
            for (int r = 0; r < 4; ++r) if (c16 == 4 * q4 + r) { const float rsv = rsqrtf(accs[r] * (1.f / DM) + 1e-6f); SS[c16] = rsv; RS[n0 + c16] = rsv; }
            const f32x4 s4 = *(const LAS f32x4*)(SS + 4 * q4);
#pragma unroll
            for (int ct = 0; ct < 3; ++ct) { const int col = 16 * ct + c16; const float bias = col < 4 ? bg[col] : (col < 36 ? be[col - 4] : 0.f);
#pragma unroll
                for (int r = 0; r < 4; ++r) LG[(4 * q4 + r) * 48 + col] = acc[ct][r] * s4[r] + bias; }
            if (lane < 16) {
                const LAS float* lg = LG + lane * 48;
                int gs = 0; float gm = lg[0];
#pragma unroll
                for (int i = 1; i < 4; ++i) { const float v = lg[i]; if (v > gm) { gm = v; gs = i; } }
                float gden = 0.f;
#pragma unroll
                for (int i = 0; i < 4; ++i) gden += __expf(lg[i] - gm);
                const float ggate = 1.f / gden;
                const LAS float* l8 = lg + 4 + gs * 8;
                int i0 = 0; float m0 = l8[0];
#pragma unroll
                for (int i = 1; i < 8; ++i) { const float v = l8[i]; if (v > m0) { m0 = v; i0 = i; } }
                int i1 = (i0 == 0) ? 1 : 0; float m1 = l8[i1];
#pragma unroll
                for (int i = 0; i < 8; ++i) { const float v = l8[i]; if (i != i0 && v > m1) { m1 = v; i1 = i; } }
                const float ex = __expf(m1 - m0);
                g0 = ggate / (1.f + ex); g1 = ggate * ex / (1.f + ex);
                e0 = gs * 8 + i0; e1 = gs * 8 + i1;
                lr0 = (int)__hip_atomic_fetch_add(lcnt + e0, 1u, __ATOMIC_RELAXED, __HIP_MEMORY_SCOPE_WORKGROUP); lr1 = (int)__hip_atomic_fetch_add(lcnt + e1, 1u, __ATOMIC_RELAXED, __HIP_MEMORY_SCOPE_WORKGROUP);
            }
        }
        __syncthreads();
        if (threadIdx.x < 32) { const unsigned c = lcnt[threadIdx.x]; lbase[threadIdx.x] = c ? atomicAdd(&cnt[threadIdx.x], c) : 0u; }
        __syncthreads();
        if (act) {
            if (lane < 16) { const int n = n0 + lane;
                asg_e[2 * n] = e0; asg_e[2 * n + 1] = e1; asg_rank[2 * n] = (int)lbase[e0] + lr0; asg_rank[2 * n + 1] = (int)lbase[e1] + lr1; asg_gate[2 * n] = g0; asg_gate[2 * n + 1] = g1; }
            unsigned char* H8 = (unsigned char*)HN;
            float rsr[4];
#pragma unroll
            for (int j = 0; j < 4; ++j) rsr[j] = SS[4 * j + r4] * ACT_Q;
#pragma unroll 2
            for (int kc = 0; kc < 8; ++kc) { const float4 gn0 = *(const float4*)(gain + kc * 128 + 8 * cidx), gn1 = *(const float4*)(gain + kc * 128 + 8 * cidx + 4);
                u32x4_t xv[4];
#pragma unroll
                for (int j = 0; j < 4; ++j) xv[j] = *(const u32x4_t*)(XR + (size_t)(n0 + 4 * j + r4) * DM + kc * 128 + 8 * cidx);
#pragma unroll
                for (int j = 0; j < 4; ++j) { const u32x4_t o = xv[j]; const float q = rsr[j];
                    *(u32x2_t*)(H8 + (size_t)(n0 + 4 * j + r4) * DM + kc * 128 + 8 * cidx) = (u32x2_t){
                        q8x4(__uint_as_float(o.x << 16) * gn0.x, __uint_as_float(o.x & 0xffff0000u) * gn0.y, __uint_as_float(o.y << 16) * gn0.z, __uint_as_float(o.y & 0xffff0000u) * gn0.w, q),
                        q8x4(__uint_as_float(o.z << 16) * gn1.x, __uint_as_float(o.z & 0xffff0000u) * gn1.y, __uint_as_float(o.w << 16) * gn1.z, __uint_as_float(o.w & 0xffff0000u) * gn1.w, q)}; } }
        }
        __syncthreads();
    }
}
__device__ __forceinline__ void moe_prefix(const unsigned* cnt, LAS int* pst) {
    if (threadIdx.x == 0) { int acc = 0; for (int e = 0; e < NEXP; ++e) { pst[e] = acc; const int c = (int)cnt[e]; acc += (c + MOE_TM - 1) / MOE_TM * MOE_TM; } pst[NEXP] = acc; }
    __syncthreads();
}
__device__ __forceinline__ void ph_dispatch(const unsigned* cnt, const int* asg_e, const int* asg_rank, const float* asg_gate, const float* RS, int* row_tok, int* row_slot, float* row_gate, float* row_rs, LAS int* pst, const unsigned* wmax, float* tscale) {
    moe_prefix(cnt, pst);
    for (int t = blockIdx.x * NTHREADS + threadIdx.x; t < pst[NEXP] / 256; t += gridDim.x * NTHREADS) { int e = 0;
        for (int k = 1; k < NEXP; ++k) if (t * 256 >= pst[k]) e = k;
        tscale[2 * t] = __uint_as_float(wmax[2 * e]) * (1.f / (127.f * ACT_Q)); tscale[2 * t + 1] = __uint_as_float(wmax[2 * e + 1]) * (1.f / (127.f * ACT_Q)); }
    for (int i = blockIdx.x * NTHREADS + threadIdx.x; i < NASG; i += gridDim.x * NTHREADS) {
        const int e = asg_e[i], d = pst[e] + asg_rank[i];
        row_tok[d] = i >> 1; row_slot[d] = i; row_gate[d] = asg_gate[i]; row_rs[d] = RS[i >> 1];
    }
    for (int e = blockIdx.x; e < NEXP; e += gridDim.x) {
        const int c = (int)cnt[e], lo = pst[e] + c, hi = pst[e + 1];
        for (int r = lo + threadIdx.x; r < hi; r += NTHREADS) { row_tok[r] = -1; row_slot[r] = 0; row_gate[r] = 0.f; row_rs[r] = 0.f; }
    }
    __syncthreads();
}
__device__ __forceinline__ int moe_tile_expert(const LAS int* pst, int row0) { int e = 0;
    for (int i = 1; i < NEXP; ++i) if (row0 >= pst[i]) e = i;
    return e; }

__device__ __forceinline__ float shiftcol(const bf16_t* P, int n, int t, int col, const float* mu) {
    const float cur = bf2f(P[(size_t)n * ABC + col]); const float prev = t > 0 ? bf2f(P[(size_t)(n - 1) * ABC + col]) : 0.f;
    return cur + (prev - cur) * mu[col];
}
constexpr int RW_WMF = 0, RW_RF = 2048, RW_BKF = 4096, RW_ARF = 8192, RW_U = 9216, RW_V = 11264, RW_G = 13312, RW_REC = 13568;
__device__ __forceinline__ float fast_sigmoid(float x) { return __builtin_amdgcn_rcpf(1.f + __expf(-x)); }
__device__ __forceinline__ float fast_softplus(float x) { return fmaxf(x, 0.f) + __logf(1.f + __expf(-fabsf(x))); }
__device__ __forceinline__ void tr_acc(LAS float* TBf, const f32x4 (&acc)[4], int lane, float (&out)[16]) {
    const int q4 = lane >> 4, c16 = lane & 15;
#pragma unroll
    for (int ct = 0; ct < 4; ++ct)
#pragma unroll
        for (int r = 0; r < 4; ++r) TBf[(16 * ct + 4 * q4 + r) * 20 + c16] = acc[ct][r];
#pragma unroll
    for (int j = 0; j < 4; ++j) { const f32x4 v = *(const LAS f32x4*)(TBf + lane * 20 + 4 * j); out[4 * j] = v[0]; out[4 * j + 1] = v[1]; out[4 * j + 2] = v[2]; out[4 * j + 3] = v[3]; }
}
__device__ __forceinline__ void ph_l0_prep(const Args& a, LAS float* lds) {
    const bf16_t* P = (const bf16_t*)(a.ws + WS_B);
    unsigned char* FR = a.ws + WS_C;
    bf16_t* Vb = (bf16_t*)a.out; float* Bon = (float*)((unsigned char*)a.out + 32 * MiB);
    bf16_t* LA = (bf16_t*)(a.ws + WS_A); bf16_t* U = LA + (size_t)NTOK * 512;
    const float* mu = a.in[5]; const float* w0 = a.in[6]; const float* a0 = a.in[8];
    const float* k_k = a.in[11]; const float* k_a = a.in[12]; const float* r_k = a.in[13];
    const float* conv_w = a.in[16]; const float* conv_b = a.in[17]; const float* b_a = a.in[19]; const float* b_x = a.in[21]; const float* lam = a.in[22];
    const int lane = threadIdx.x & 63, wave = threadIdx.x >> 6, q4 = lane >> 4, c16 = lane & 15;
    LAS unsigned char* W = (LAS unsigned char*)lds + wave * 15360;
    constexpr int KAP = 0, BT = 2304, KT = 4608, RT = 6912, BTT = 9216, KTT = 11264, AKB = 13312, AKK = 14336, RS = 144;
    constexpr int XS = 0, XS2 = 2304, TB = 4608;
    LAS float* TBf = (LAS float*)(W + TB);
    for (int u = blockIdx.x * 8 + wave; u < (NTOK / 16) * 8; u += gridDim.x * 8) {
        const int tile = u >> 3, h = u & 7, n0 = tile * 16, c = h * 64 + lane;
        const bool first = (n0 & (SEQ - 1)) == 0;
        const bf16_t* Pn = P + (size_t)n0 * ABC;
        float xb[19]; unsigned pwp[9], pap[9], qrp[9], qkp[9], qvp[9];
#pragma unroll
        for (int i = 0; i < 19; ++i) xb[i] = (first && i < 3) ? 0.f : bf2f(Pn[(long)(i - 3) * ABC + 2304 + c]);
#pragma unroll
        for (int i = 0; i < 18; ++i) { const bool z = (first && i == 0) || i == 17; const long ro = (long)(i - 1) * ABC;
            const unsigned vw = z ? 0u : (unsigned)Pn[ro + 1536 + lane], va = z ? 0u : (unsigned)Pn[ro + 1600 + lane];
            if (i & 1) { pwp[i >> 1] |= vw << 16; pap[i >> 1] |= va << 16; } else { pwp[i >> 1] = vw; pap[i >> 1] = va; } }
        asm volatile("" ::: "memory");
#define UNPK(arr, i) __uint_as_float(((i) & 1) ? ((arr)[(i) >> 1] & 0xffff0000u) : ((arr)[(i) >> 1] << 16))
        {
            bf16_t* SG = (bf16_t*)((unsigned char*)a.out + DO_SG);
            const int tk = lane >> 2, col = 1664 + 16 * h + (lane & 3) * 4;
            const u32x2_t cu = *(const u32x2_t*)(Pn + (long)tk * ABC + col); u32x2_t pu = (u32x2_t){0u, 0u};
            if (!(first && tk == 0)) pu = *(const u32x2_t*)(Pn + (long)(tk - 1) * ABC + col);
            const f32x4 m4 = *(const f32x4*)(mu + col);
            const float c0 = __uint_as_float(cu.x << 16), c1 = __uint_as_float(cu.x & 0xffff0000u), c2 = __uint_as_float(cu.y << 16), c3 = __uint_as_float(cu.y & 0xffff0000u);
            const float p0 = __uint_as_float(pu.x << 16), p1 = __uint_as_float(pu.x & 0xffff0000u), p2 = __uint_as_float(pu.y << 16), p3 = __uint_as_float(pu.y & 0xffff0000u);
            *(u32x2_t*)(SG + (size_t)(tile * 8 + h) * 256 + lane * 4) = (u32x2_t){pk2(fast_sigmoid(c0 + (p0 - c0) * m4[0]), fast_sigmoid(c1 + (p1 - c1) * m4[1])), pk2(fast_sigmoid(c2 + (p2 - c2) * m4[2]), fast_sigmoid(c3 + (p3 - c3) * m4[3]))};
        }
        {
            const float cw0 = conv_w[c], cw1 = conv_w[512 + c], cw2 = conv_w[1024 + c], cw3 = conv_w[1536 + c], cb = conv_b[c];
            float xcv[16];
#pragma unroll
            for (int tk = 0; tk < 16; ++tk) { xcv[tk] = cb + cw0 * xb[tk] + cw1 * xb[tk + 1] + cw2 * xb[tk + 2] + cw3 * xb[tk + 3]; *(LAS bf16_t*)(W + XS + tk * RS + lane * 2) = f2bf(xcv[tk]); }
            f32x4 accr[4], acci[4];
            const bf16_t* FA = (const bf16_t*)(a.ws + FG_WA) + h * 4096; const bf16_t* FX = (const bf16_t*)(a.ws + FG_WX) + h * 4096;
            bf16x8_t xf[2];
#pragma unroll
            for (int ks = 0; ks < 2; ++ks) xf[ks] = *(const LAS bf16x8_t*)(W + XS + c16 * RS + ks * 64 + q4 * 16);
#pragma unroll
            for (int ct = 0; ct < 4; ++ct) { asm volatile("" ::: "memory"); accr[ct] = (f32x4){0.f, 0.f, 0.f, 0.f}; acci[ct] = accr[ct];
#pragma unroll
                for (int ks = 0; ks < 2; ++ks) { accr[ct] = __builtin_amdgcn_mfma_f32_16x16x32_bf16(*(const bf16x8_t*)(FA + ((ct * 2 + ks) * 64 + lane) * 8), xf[ks], accr[ct], 0, 0, 0);
                    acci[ct] = __builtin_amdgcn_mfma_f32_16x16x32_bf16(*(const bf16x8_t*)(FX + ((ct * 2 + ks) * 64 + lane) * 8), xf[ks], acci[ct], 0, 0, 0); } }
            float rp[16], ip[16];
            tr_acc(TBf, accr, lane, rp); tr_acc(TBf, acci, lane, ip);
            const float bac = b_a[c], bxc = b_x[c], sp = fast_softplus(-lam[c]);
            float hloc = 0.f, sla = 0.f;
            unsigned lap[4], uup[4];
#pragma unroll
            for (int tk = 0; tk < 16; ++tk) { const float r = fast_sigmoid(rp[tk] + bac), i = fast_sigmoid(ip[tk] + bxc);
                const float la = -8.f * r * sp; const float uu = __builtin_amdgcn_sqrtf(fmaxf(1.f - __expf(2.f * la), 0.f)) * i * xcv[tk];
                const bf16_t lab = f2bf(la), uub = f2bf(uu); const float lar = bf2f(lab);
                if (tk & 1) { lap[(tk >> 1) & 3] |= (unsigned)lab << 16; uup[(tk >> 1) & 3] |= (unsigned)uub << 16; } else { lap[(tk >> 1) & 3] = lab; uup[(tk >> 1) & 3] = uub; }
                if ((tk & 7) == 7) { *(u32x4_t*)(LA + ((size_t)tile * 512 + c) * 16 + (tk >> 3) * 8) = (u32x4_t){lap[0], lap[1], lap[2], lap[3]}; *(u32x4_t*)(U + ((size_t)tile * 512 + c) * 16 + (tk >> 3) * 8) = (u32x4_t){uup[0], uup[1], uup[2], uup[3]}; }
                hloc = __expf(lar) * hloc + bf2f(uub); sla += lar; }
            ((float*)((unsigned char*)a.out + DO_LRU))[(size_t)tile * 512 + c] = hloc; ((float*)((unsigned char*)a.out + DO_LRU))[(size_t)(2048 + tile) * 512 + c] = sla;
        }
        asm volatile("" ::: "memory");
#pragma unroll
        for (int i = 0; i < 18; ++i) { const bool z = (first && i == 0) || i == 17; const long ro = (long)(i - 1) * ABC;
            const unsigned vr = z ? 0u : (unsigned)Pn[ro + c], vk = z ? 0u : (unsigned)Pn[ro + 512 + c], vv = z ? 0u : (unsigned)Pn[ro + 1024 + c];
            if (i & 1) { qrp[i >> 1] |= vr << 16; qkp[i >> 1] |= vk << 16; qvp[i >> 1] |= vv << 16; } else { qrp[i >> 1] = vr; qkp[i >> 1] = vk; qvp[i >> 1] = vv; } }
        asm volatile("" ::: "memory");
        float wpre[16], apre[16];
        {
            const float muw = mu[1536 + lane], mua = mu[1600 + lane];
#pragma unroll
            for (int tk = 0; tk < 16; ++tk) { const float pw1 = UNPK(pwp, tk + 1), pw0 = UNPK(pwp, tk), pa1 = UNPK(pap, tk + 1), pa0 = UNPK(pap, tk);
                const float wl = pw1 + (pw0 - pw1) * muw, al = pa1 + (pa0 - pa1) * mua;
                const float th = 1.f - 2.f * __builtin_amdgcn_rcpf(1.f + __expf(2.f * wl));
                *(LAS bf16_t*)(W + XS + tk * RS + lane * 2) = f2bf(th); *(LAS bf16_t*)(W + XS2 + tk * RS + lane * 2) = f2bf(al); }
            f32x4 accw[4], acca[4];
            const bf16_t* F2 = (const bf16_t*)(a.ws + FG_W2) + h * 4096; const bf16_t* FA2 = (const bf16_t*)(a.ws + FG_A2) + h * 4096;
            bf16x8_t wf[2], af[2];
#pragma unroll
            for (int ks = 0; ks < 2; ++ks) { wf[ks] = *(const LAS bf16x8_t*)(W + XS + c16 * RS + ks * 64 + q4 * 16); af[ks] = *(const LAS bf16x8_t*)(W + XS2 + c16 * RS + ks * 64 + q4 * 16); }
#pragma unroll
            for (int ct = 0; ct < 4; ++ct) { asm volatile("" ::: "memory"); accw[ct] = (f32x4){0.f, 0.f, 0.f, 0.f}; acca[ct] = accw[ct];
#pragma unroll
                for (int ks = 0; ks < 2; ++ks) { accw[ct] = __builtin_amdgcn_mfma_f32_16x16x32_bf16(*(const bf16x8_t*)(F2 + ((ct * 2 + ks) * 64 + lane) * 8), wf[ks], accw[ct], 0, 0, 0);
                    acca[ct] = __builtin_amdgcn_mfma_f32_16x16x32_bf16(*(const bf16x8_t*)(FA2 + ((ct * 2 + ks) * 64 + lane) * 8), af[ks], acca[ct], 0, 0, 0); } }
            tr_acc(TBf, accw, lane, wpre); tr_acc(TBf, acca, lane, apre);
        }
        const float w0c = w0[c], a0c = a0[c], kkc = k_k[c], kac = k_a[c], rkc = r_k[c];
        const float mur = mu[c], muk = mu[512 + c], muv = mu[1024 + c];
        unsigned char* rec = FR + ((size_t)tile * 8 + h) * RW_REC;
        float vsv[16];
        unsigned btp[8], ktp[8];
        float cum = 0.f, gC = 1.f;
#pragma unroll
        for (int tk = 0; tk < 16; ++tk) { const int n = n0 + tk;
            const float cr = UNPK(qrp, tk + 1), ck = UNPK(qkp, tk + 1), cv = UNPK(qvp, tk + 1), pr = UNPK(qrp, tk), pk = UNPK(qkp, tk), pv = UNPK(qvp, tk);
            const float rs = cr + (pr - cr) * mur, ks = ck + (pk - ck) * muk, vs = cv + (pv - cv) * muv;
            const float wv = -fast_softplus(-(w0c + wpre[tk])) - 0.5f; const float logdec = -__expf(wv);
            const float av = fast_sigmoid(a0c + apre[tk]);
            const float kkr = ks * kkc; const float ss = wave_sum(kkr * kkr); const float kkn = kkr * rsqrtf(fmaxf(ss, 1e-24f));
            const float kp = ks * (1.f + (av - 1.f) * kac);
            const float bsum = wave_sum(rs * kp * rkc);
            if (lane == 0) Bon[(size_t)n * 8 + h] = bsum;
            Vb[(size_t)n * 512 + c] = f2bf(vs); vsv[tk] = vs;
            const float gprev = __expf(cum); cum += logdec; const float g = __expf(cum), gi = __builtin_amdgcn_rcpf(g); gC = g;
            const float kapv = kkn * gprev, btv = av * kkn * gi, ktv = kp * gi, rtv = rs * g;
            const bf16_t kb = f2bf(kapv), bb = f2bf(btv), kb2 = f2bf(ktv), rb = f2bf(rtv);
            *(LAS bf16_t*)(W + KAP + tk * RS + lane * 2) = kb; *(LAS bf16_t*)(W + BT + tk * RS + lane * 2) = bb;
            *(LAS bf16_t*)(W + KT + tk * RS + lane * 2) = kb2; *(LAS bf16_t*)(W + RT + tk * RS + lane * 2) = rb;
            if (tk & 1) { btp[tk >> 1] |= (unsigned)bb << 16; ktp[tk >> 1] |= (unsigned)kb2 << 16; } else { btp[tk >> 1] = bb; ktp[tk >> 1] = kb2; } }
        *(LAS u32x4_t*)(W + BTT + lane * 32) = (u32x4_t){btp[0], btp[1], btp[2], btp[3]}; *(LAS u32x4_t*)(W + BTT + lane * 32 + 16) = (u32x4_t){btp[4], btp[5], btp[6], btp[7]};
        *(LAS u32x4_t*)(W + KTT + lane * 32) = (u32x4_t){ktp[0], ktp[1], ktp[2], ktp[3]}; *(LAS u32x4_t*)(W + KTT + lane * 32 + 16) = (u32x4_t){ktp[4], ktp[5], ktp[6], ktp[7]};
        *(float*)(rec + RW_G + lane * 4) = gC;
        f32x4 akb = (f32x4){0.f, 0.f, 0.f, 0.f}, akk = akb, arbT = akb, arkT = akb;
#pragma unroll
        for (int ks = 0; ks < 2; ++ks) { const int fo = c16 * RS + ks * 64 + q4 * 16;
            const bf16x8_t fkap = *(const LAS bf16x8_t*)(W + KAP + fo), fbt = *(const LAS bf16x8_t*)(W + BT + fo), fkt = *(const LAS bf16x8_t*)(W + KT + fo), frt = *(const LAS bf16x8_t*)(W + RT + fo);
            akb = __builtin_amdgcn_mfma_f32_16x16x32_bf16(fkap, fbt, akb, 0, 0, 0); akk = __builtin_amdgcn_mfma_f32_16x16x32_bf16(fkap, fkt, akk, 0, 0, 0);
            arbT = __builtin_amdgcn_mfma_f32_16x16x32_bf16(fbt, frt, arbT, 0, 0, 0); arkT = __builtin_amdgcn_mfma_f32_16x16x32_bf16(fkt, frt, arkT, 0, 0, 0); }
#pragma unroll
        for (int r = 0; r < 4; ++r) { const int t = 4 * q4 + r; ((LAS float*)(W + AKB))[t * 16 + c16] = (c16 < t) ? akb[r] : 0.f; ((LAS float*)(W + AKK))[t * 16 + c16] = (c16 < t) ? akk[r] : 0.f;
            const int sidx = 4 * q4 + r; if (sidx > c16) { arbT[r] = 0.f; arkT[r] = 0.f; } }
        *(u32x4_t*)(rec + RW_ARF + lane * 16) = (u32x4_t){pk2(arbT[0], arbT[1]), pk2(arbT[2], arbT[3]), pk2(arkT[0], arkT[1]), pk2(arkT[2], arkT[3])};
#pragma unroll
        for (int i = 0; i < 4; ++i) { const u32x2_t b2 = *(const LAS u32x2_t*)(W + BTT + (16 * i + c16) * 32 + q4 * 8), k2 = *(const LAS u32x2_t*)(W + KTT + (16 * i + c16) * 32 + q4 * 8);
            *(u32x4_t*)(rec + RW_BKF + i * 1024 + lane * 16) = (u32x4_t){b2.x, b2.y, k2.x, k2.y}; }
#pragma unroll
        for (int sx = 0; sx < 2; ++sx) { const u32x2_t lo = *(const LAS u32x2_t*)(W + RT + c16 * RS + (32 * sx + 4 * q4) * 2), hi = *(const LAS u32x2_t*)(W + RT + c16 * RS + (32 * sx + 16 + 4 * q4) * 2);
            *(u32x4_t*)(rec + RW_RF + sx * 1024 + lane * 16) = (u32x4_t){lo.x, lo.y, hi.x, hi.y}; }
        float Wm[16], Uu[16];
#pragma unroll
        for (int t = 0; t < 16; ++t) { float wacc = bf2f(*(const LAS bf16_t*)(W + KAP + t * RS + lane * 2)), uacc = 0.f;
#pragma unroll
            for (int s4 = 0; s4 < 4; ++s4) if (4 * s4 < t) { const f32x4 b4 = *(const LAS f32x4*)(W + AKB + (t * 16 + 4 * s4) * 4), k4 = *(const LAS f32x4*)(W + AKK + (t * 16 + 4 * s4) * 4);
#pragma unroll
                for (int e = 0; e < 4; ++e) { const int sidx = 4 * s4 + e; if (sidx < t) { wacc -= b4[e] * Wm[sidx]; uacc += k4[e] * vsv[sidx] - b4[e] * Uu[sidx]; } } }
            Wm[t] = wacc; Uu[t] = uacc;
            *(LAS bf16_t*)(W + KAP + t * RS + lane * 2) = f2bf(wacc);
        }
        {
            const int ub = ((lane >> 4) * 64 + (lane & 15)) * 8;
#pragma unroll
            for (int q = 0; q < 4; ++q) { *(u32x2_t*)(rec + RW_U + ub + q * 128) = (u32x2_t){pk2(Uu[4 * q], Uu[4 * q + 1]), pk2(Uu[4 * q + 2], Uu[4 * q + 3])};
                *(u32x2_t*)(rec + RW_V + ub + q * 128) = (u32x2_t){pk2(vsv[4 * q], vsv[4 * q + 1]), pk2(vsv[4 * q + 2], vsv[4 * q + 3])}; }
        }
#pragma unroll
        for (int sx = 0; sx < 2; ++sx) { const u32x2_t lo = *(const LAS u32x2_t*)(W + KAP + c16 * RS + (32 * sx + 4 * q4) * 2), hi = *(const LAS u32x2_t*)(W + KAP + c16 * RS + (32 * sx + 16 + 4 * q4) * 2);
            *(u32x4_t*)(rec + RW_WMF + sx * 1024 + lane * 16) = (u32x4_t){lo.x, lo.y, hi.x, hi.y}; }
    }
}
__device__ __forceinline__ void sub_barrier(unsigned* ctr, unsigned target) {
    asm volatile("s_waitcnt vmcnt(0)" ::: "memory");
    __syncthreads();
    if (threadIdx.x == 0) {
        (void)xb_add(ctr, 1u);
        unsigned sp = 0;
        while (xb_ld(ctr) < target) { __builtin_amdgcn_s_sleep(2); if (++sp > (1u << 22)) break; }
        __builtin_amdgcn_fence(__ATOMIC_ACQUIRE, "agent");
        asm volatile("s_waitcnt vmcnt(0)" ::: "memory");
    }
    __syncthreads();
}
__device__ __forceinline__ void st_wt(float* p, float v) { __hip_atomic_store((unsigned*)p, __float_as_uint(v), __ATOMIC_RELAXED, __HIP_MEMORY_SCOPE_AGENT); }
__device__ __forceinline__ void ph_lru_b(const Args& a, int bid, LAS float* lds) {
    if (bid >= 64) return;
    const float* CH = (const float*)((unsigned char*)a.out + DO_LRU); const float* CA = CH + (size_t)2048 * 512; float* CIN = (float*)((unsigned char*)a.out + DO_LRU) + (size_t)4096 * 512;
    const int b = bid >> 4, cg = bid & 15, cl = threadIdx.x & 31, seg = threadIdx.x >> 5, c = cg * 32 + cl;
    float ca[32], chv[32];
#pragma unroll
    for (int i = 0; i < 32; ++i) { const size_t o = (size_t)(b * 512 + seg * 32 + i) * 512 + c; ca[i] = CA[o]; chv[i] = CH[o]; }
    float h = 0.f, sa = 0.f;
#pragma unroll
    for (int i = 0; i < 32; ++i) { h = __expf(ca[i]) * h + chv[i]; sa += ca[i]; }
    lds[seg * 32 + cl] = sa; lds[512 + seg * 32 + cl] = h;
    __syncthreads();
    float hin = 0.f;
    for (int sg = 0; sg < seg; ++sg) hin = __expf(lds[sg * 32 + cl]) * hin + lds[512 + sg * 32 + cl];
    h = hin;
#pragma unroll
    for (int i = 0; i < 32; ++i) { st_wt(CIN + (size_t)(b * 512 + seg * 32 + i) * 512 + c, h); h = __expf(ca[i]) * h + chv[i]; }
}
__device__ __forceinline__ void ph_lru_c(const Args& a, int bid, int nblk) {
    const bf16_t* LA = (const bf16_t*)(a.ws + WS_A); const bf16_t* U = LA + (size_t)NTOK * 512; const bf16_t* P = (const bf16_t*)(a.ws + WS_B);
    const float* CIN = (const float*)((unsigned char*)a.out + DO_LRU) + (size_t)4096 * 512; bf16_t* MIX = (bf16_t*)(a.ws + WS_D);
    const int c = threadIdx.x;
    for (int u = bid; u < NTOK / 16; u += nblk) { float la[16], uv[16], gt[16];
        float h = CIN[(size_t)u * 512 + c];
#pragma unroll
        for (int s = 0; s < 16; ++s) { const int n = u * 16 + s; gt[s] = bf2f(P[(size_t)n * ABC + 1792 + c]); }
#pragma unroll
        for (int hf = 0; hf < 2; ++hf) { const u32x4_t l4 = *(const u32x4_t*)(LA + ((size_t)u * 512 + c) * 16 + hf * 8), u4 = *(const u32x4_t*)(U + ((size_t)u * 512 + c) * 16 + hf * 8);
#pragma unroll
            for (int e = 0; e < 4; ++e) { la[hf * 8 + 2 * e] = __uint_as_float(l4[e] << 16); la[hf * 8 + 2 * e + 1] = __uint_as_float(l4[e] & 0xffff0000u); uv[hf * 8 + 2 * e] = __uint_as_float(u4[e] << 16); uv[hf * 8 + 2 * e + 1] = __uint_as_float(u4[e] & 0xffff0000u); } }
#pragma unroll
        for (int s = 0; s < 16; ++s) { const int n = u * 16 + s; h = __expf(la[s]) * h + uv[s];
            const float x = gt[s], t2 = 0.7978845608028654f * (x + 0.044715f * x * x * x); const float th = 1.f - 2.f * __builtin_amdgcn_rcpf(1.f + __expf(2.f * t2));
            MIX[(size_t)n * DM + 512 + c] = f2bf(h * 0.5f * x * (1.f + th)); } }
}
#ifndef SP_MODE
#define SP_MODE 0
#endif
__device__ __forceinline__ void ph_rwkv_scan(const Args& a, LAS unsigned char* L) {
    if (blockIdx.x >= 32) return;
    constexpr int SLOT = 9472, GOFF = 9216, NS = 14, NCH = SEQ / 16; constexpr size_t CSTR = (size_t)8 * RW_REC;
    const unsigned char* FR = a.ws + WS_C; float* Yr = (float*)((unsigned char*)a.out + DO_YR);
    const int b = blockIdx.x >> 3, h = blockIdx.x & 7, lane = threadIdx.x & 63, wave = __builtin_amdgcn_readfirstlane(threadIdx.x >> 6), q4 = lane >> 4, c16 = lane & 15;
    const unsigned char* FRb = FR + ((size_t)(b * NCH) * 8 + h) * RW_REC;
#define RW_BARRIER() do { asm volatile("" ::: "memory"); __builtin_amdgcn_s_barrier(); asm volatile("" ::: "memory"); } while (0)
    if (wave >= 4) {
        const int lw = wave - 4;
        const unsigned char* rp = FRb + lane * 16; int so = 0;
#define RW_ISSUE1() do { LAS unsigned char* _slot = L + so; \
            if (lw < 2) { _Pragma("unroll") for (int _j = 0; _j < 3; ++_j) __builtin_amdgcn_global_load_lds((const unsigned*)(rp + (lw * 3 + _j) * 1024), (LAS unsigned*)(_slot + (lw * 3 + _j) * 1024), 16, 0, 0); } \
            else if (lw == 2) { _Pragma("unroll") for (int _j = 0; _j < 2; ++_j) __builtin_amdgcn_global_load_lds((const unsigned*)(rp + (6 + _j) * 1024), (LAS unsigned*)(_slot + (6 + _j) * 1024), 16, 0, 0); } \
            else { __builtin_amdgcn_global_load_lds((const unsigned*)(rp + 8 * 1024), (LAS unsigned*)(_slot + 8 * 1024), 16, 0, 0); \
                   __builtin_amdgcn_global_load_lds((const unsigned*)(rp - lane * 12 + RW_G), (LAS unsigned*)(_slot + GOFF), 4, 0, 0); } \
            rp += CSTR; so += SLOT; if (so == NS * SLOT) so = 0; } while (0)
#if SP_MODE & 4
#define RW_ISSUE() do { RW_ISSUE1(); rp -= CSTR; so -= SLOT; if (so < 0) so += NS * SLOT; RW_ISSUE1(); } while (0)
#else
#define RW_ISSUE() RW_ISSUE1()
#endif
#if SP_MODE & 4
#define RW_LWAIT() do { if (lw < 2) asm volatile("s_waitcnt vmcnt(54)" ::: "memory"); else asm volatile("s_waitcnt vmcnt(36)" ::: "memory"); } while (0)
#else
#define RW_LWAIT() do { if (lw < 2) asm volatile("s_waitcnt vmcnt(27)" ::: "memory"); else asm volatile("s_waitcnt vmcnt(18)" ::: "memory"); } while (0)
#endif
        for (int p = 0; p < NS - 2; ++p) RW_ISSUE();
        RW_LWAIT();
        RW_BARRIER();
#pragma unroll 1
        for (int it = 0; it < NCH / 2; ++it) { RW_ISSUE(); RW_ISSUE(); RW_LWAIT(); RW_BARRIER(); }
        asm volatile("s_waitcnt vmcnt(0)" ::: "memory");
#undef RW_ISSUE
#undef RW_ISSUE1
#undef RW_LWAIT
    } else {
        const int vs = wave;
#if SP_MODE & 2
        __builtin_amdgcn_s_setprio(3);
#endif
        f32x4 T[4];
#pragma unroll
        for (int i = 0; i < 4; ++i) T[i] = (f32x4){0.f, 0.f, 0.f, 0.f};
        struct Ops { bf16x8_t wmf[2], rf[2], bkf[4], arf; f32x4 g4[4]; };
        const LAS unsigned char* lp = L + lane * 16; const LAS unsigned char* lg = L + GOFF + q4 * 16; int so = 0;
        const unsigned char* up = FRb + RW_U + (vs * 64 + lane) * 8;
        float* yp = Yr + ((size_t)(b * NCH) * 8 + h) * 1024 + vs * 256 + lane * 4;
#if SP_MODE & 8
#define RW_LOAD(O) do { { const LAS unsigned char* _r = lp + so; const LAS unsigned char* _g = lg + so; \
            _Pragma("unroll") for (int _s = 0; _s < 2; ++_s) { bf16x8_t _t0 = *(const LAS bf16x8_t*)(_r + RW_WMF + _s * 1024); bf16x8_t _t1 = *(const LAS bf16x8_t*)(_r + RW_RF + _s * 1024); asm volatile("" :: "v"(_t0), "v"(_t1)); } \
            _Pragma("unroll") for (int _i = 0; _i < 4; ++_i) { bf16x8_t _t0 = *(const LAS bf16x8_t*)(_r + RW_BKF + _i * 1024); f32x4 _t1 = *(const LAS f32x4*)(_g + _i * 64); asm volatile("" :: "v"(_t0), "v"(_t1)); } \
            { bf16x8_t _t0 = *(const LAS bf16x8_t*)(_r + RW_ARF); asm volatile("" :: "v"(_t0)); } asm volatile("" ::: "memory"); } RW_LOAD1(O); } while (0)
#else
#define RW_LOAD(O) RW_LOAD1(O)
#endif
#define RW_LOAD1(O) do { const LAS unsigned char* _r = lp + so; const LAS unsigned char* _g = lg + so; \
            _Pragma("unroll") for (int _s = 0; _s < 2; ++_s) { O.wmf[_s] = *(const LAS bf16x8_t*)(_r + RW_WMF + _s * 1024); O.rf[_s] = *(const LAS bf16x8_t*)(_r + RW_RF + _s * 1024); } \
            _Pragma("unroll") for (int _i = 0; _i < 4; ++_i) O.bkf[_i] = *(const LAS bf16x8_t*)(_r + RW_BKF + _i * 1024); \
            O.arf = *(const LAS bf16x8_t*)(_r + RW_ARF); \
            _Pragma("unroll") for (int _i = 0; _i < 4; ++_i) O.g4[_i] = *(const LAS f32x4*)(_g + _i * 64); \
            so += SLOT; if (so == NS * SLOT) so = 0; \
            __builtin_amdgcn_sched_barrier(0); } while (0)
#define RW_UV(dst) do { dst[0] = *(const u32x2_t*)up; dst[1] = *(const u32x2_t*)(up + 2048); up += CSTR; } while (0)
#define RW_STEP(O, uv) do { \
            bf16x8_t _bS[2]; \
            _Pragma("unroll") for (int _s = 0; _s < 2; ++_s) { const u32x4_t _pk = (u32x4_t){pk2(T[2 * _s][0], T[2 * _s][1]), pk2(T[2 * _s][2], T[2 * _s][3]), pk2(T[2 * _s + 1][0], T[2 * _s + 1][1]), pk2(T[2 * _s + 1][2], T[2 * _s + 1][3])}; \
                _bS[_s] = __builtin_bit_cast(bf16x8_t, _pk); } \
            f32x4 _z = (f32x4){__uint_as_float(uv[0].x << 16), __uint_as_float(uv[0].x & 0xffff0000u), __uint_as_float(uv[0].y << 16), __uint_as_float(uv[0].y & 0xffff0000u)}; \
            _z = __builtin_amdgcn_mfma_f32_16x16x32_bf16(O.wmf[0], _bS[0], _z, 0, 0, 0); _z = __builtin_amdgcn_mfma_f32_16x16x32_bf16(O.wmf[1], _bS[1], _z, 0, 0, 0); \
            f32x4 _y = (f32x4){0.f, 0.f, 0.f, 0.f}; \
            _y = __builtin_amdgcn_mfma_f32_16x16x32_bf16(_bS[0], O.rf[0], _y, 0, 0, 0); _y = __builtin_amdgcn_mfma_f32_16x16x32_bf16(_bS[1], O.rf[1], _y, 0, 0, 0); \
            const u32x4_t _zvp = (u32x4_t){pk2(-_z[0], -_z[1]), pk2(-_z[2], -_z[3]), uv[1].x, uv[1].y}; \
            const bf16x8_t _bZV = __builtin_bit_cast(bf16x8_t, _zvp); \
            _Pragma("unroll") for (int _i = 0; _i < 4; ++_i) { T[_i] = __builtin_amdgcn_mfma_f32_16x16x32_bf16(O.bkf[_i], _bZV, T[_i], 0, 0, 0); T[_i] = T[_i] * O.g4[_i]; } \
            _y = __builtin_amdgcn_mfma_f32_16x16x32_bf16(_bZV, O.arf, _y, 0, 0, 0); \
            *(f32x4*)yp = _y; RW_ST2(); yp += 8 * 1024; } while (0)
#if SP_MODE & 16
#define RW_ST2() do { asm volatile("" ::: "memory"); *(f32x4*)yp = _y; } while (0)
#else
#define RW_ST2() do { } while (0)
#endif
#define RW_SYNC() do { asm volatile("s_waitcnt lgkmcnt(0)" ::: "memory"); RW_BARRIER(); } while (0)
        Ops A, B;
        u32x2_t uv0[2], uv1[2], uv2[2], uv3[2];
        RW_UV(uv0); RW_UV(uv1); RW_UV(uv2); RW_UV(uv3);
        RW_BARRIER();
        RW_LOAD(A);
#pragma unroll 1
        for (int ch = 0; ch < NCH; ch += 4) {
            RW_LOAD(B); RW_STEP(A, uv0); RW_UV(uv0);
            RW_LOAD(A); RW_STEP(B, uv1); RW_UV(uv1); RW_SYNC();
            RW_LOAD(B); RW_STEP(A, uv2); RW_UV(uv2);
            RW_LOAD(A); RW_STEP(B, uv3); RW_UV(uv3); RW_SYNC(); }
#undef RW_SYNC
#undef RW_LOAD
#undef RW_LOAD1
#undef RW_STEP
#undef RW_UV
    }
#undef RW_BARRIER
}
__device__ __forceinline__ void ph_rwkv_post(const Args& a, LAS float* lds) {
    const bf16_t* V = (const bf16_t*)a.out; const float* Bon = (const float*)((const unsigned char*)a.out + DO_BON); const bf16_t* SG = (const bf16_t*)((const unsigned char*)a.out + DO_SG);
    const float* Yr = (const float*)((const unsigned char*)a.out + DO_YR); bf16_t* MIX = (bf16_t*)(a.ws + WS_D);
    const float* ln_w = a.in[14]; const float* ln_b = a.in[15];
    LAS unsigned char* L = (LAS unsigned char*)lds;
    const int c = threadIdx.x, lane = c & 63, h = c >> 6, q4 = lane >> 4, c16 = lane & 15;
    const bf16_t* FG = (const bf16_t*)(a.ws + FG_G2) + h * 8192;
    LAS unsigned char* TW = L + 8192 + h * 2304;
    for (int tile = blockIdx.x; tile < NTOK / 16; tile += gridDim.x) {
        const int n0 = tile * 16;
        __syncthreads();
        { const int tk = c >> 5, j4 = (c & 31) * 4; *(LAS u32x2_t*)(L + tk * 272 + j4 * 2) = *(const u32x2_t*)(SG + (size_t)tile * 2048 + (j4 >> 4) * 256 + tk * 16 + (j4 & 15)); }
        __syncthreads();
        const int n = n0 + c16;
        f32x4 g[4], y[4];
#pragma unroll
        for (int ct = 0; ct < 4; ++ct) { g[ct] = (f32x4){0.f, 0.f, 0.f, 0.f};
#pragma unroll
            for (int ks = 0; ks < 4; ++ks) { const bf16x8_t af = *(const bf16x8_t*)(FG + ((size_t)(ct * 4 + ks) * 64 + lane) * 8); const bf16x8_t bfr = *(const LAS bf16x8_t*)(L + c16 * 272 + ks * 64 + q4 * 16);
                g[ct] = __builtin_amdgcn_mfma_f32_16x16x32_bf16(af, bfr, g[ct], 0, 0, 0); }
            y[ct] = *(const f32x4*)(Yr + (size_t)tile * 8192 + h * 1024 + ct * 256 + lane * 4); }
        float sm = 0.f;
#pragma unroll
        for (int ct = 0; ct < 4; ++ct) sm += (y[ct][0] + y[ct][1]) + (y[ct][2] + y[ct][3]);
        sm = xrow16_sum(sm);
        const float mean = sm * (1.f / 64.f);
        float sv = 0.f;
#pragma unroll
        for (int ct = 0; ct < 4; ++ct) { y[ct] = y[ct] - mean; sv += (y[ct][0] * y[ct][0] + y[ct][1] * y[ct][1]) + (y[ct][2] * y[ct][2] + y[ct][3] * y[ct][3]); }
        sv = xrow16_sum(sv);
        const float rstd = rsqrtf(sv * (1.f / 64.f) + 64e-5f), bsc = Bon[(size_t)n * 8 + h];
#pragma unroll
        for (int ct = 0; ct < 4; ++ct) { const int ch = 64 * h + 16 * ct + 4 * q4;
            const f32x4 lw = *(const f32x4*)(ln_w + ch), lb = *(const f32x4*)(ln_b + ch);
            const u32x2_t vv = *(const u32x2_t*)(V + (size_t)n * 512 + ch);
            const float v0 = __uint_as_float(vv.x << 16), v1 = __uint_as_float(vv.x & 0xffff0000u), v2 = __uint_as_float(vv.y << 16), v3 = __uint_as_float(vv.y & 0xffff0000u);
            const float o0 = (y[ct][0] * rstd * lw[0] + lb[0] + bsc * v0) * g[ct][0], o1 = (y[ct][1] * rstd * lw[1] + lb[1] + bsc * v1) * g[ct][1];
            const float o2 = (y[ct][2] * rstd * lw[2] + lb[2] + bsc * v2) * g[ct][2], o3 = (y[ct][3] * rstd * lw[3] + lb[3] + bsc * v3) * g[ct][3];
            *(LAS u32x2_t*)(TW + c16 * 136 + ct * 32 + q4 * 8) = (u32x2_t){pk2(o0, o1), pk2(o2, o3)}; }
#pragma unroll
        for (int j = 0; j < 2; ++j) { const int tk = 8 * j + (lane >> 3), pc = lane & 7;
            *(u32x4_t*)(MIX + (size_t)(n0 + tk) * DM + 64 * h + pc * 8) = *(const LAS u32x4_t*)(TW + tk * 136 + pc * 16); }
    }
}

namespace gla {
typedef short bf16x8 __attribute__((ext_vector_type(8)));
typedef float f32x16 __attribute__((ext_vector_type(16)));
typedef unsigned u32x4 __attribute__((ext_vector_type(4)));
typedef unsigned u32x2 __attribute__((ext_vector_type(2)));
constexpr int QH_OFF = 0, KH_OFF = 17408, KT_OFF = 34816, VT_OFF = 53248, ST_OFF = 71680, AM_OFF = 106496, EB_OFF = 115712, ER_OFF = 116224, PS_OFF = 116736, SSQ_OFF = 118784, OT_OFF = 119808;
constexpr int QS = 272, TS = 144;
#define GLA_BAR() do { asm volatile("s_waitcnt lgkmcnt(0)" ::: "memory"); __builtin_amdgcn_s_barrier(); asm volatile("" ::: "memory"); } while (0)
template <bool OUT>
__device__ __forceinline__ void unit(const Args& a, LAS unsigned char* L, int u) {
    const int tid = threadIdx.x, lane = tid & 63, w = tid >> 6;
    const int b = u >> 6, h = (u >> 3) & 7, j = u & 7;
    const bf16_t* Q = (const bf16_t*)(a.ws + WS_QFIG) + ((size_t)b * SEQ + (size_t)j * 1024) * 4096 + h * 128;
    float* Lb = (float*)(a.ws + WS_O); float* Db = Lb + (size_t)256 * 16384;
    const int dk = tid & 127, tg = tid >> 7;
    const float c0 = a.in[25][h * 128 + dk], c1 = a.in[25][1024 + h * 128 + dk];
    const float lbv = __builtin_amdgcn_rcpf(1.f + __expf(c0 - c1)), omlb = 1.f - lbv;
    LAS float* PS = (LAS float*)(L + PS_OFF); LAS float* EB = (LAS float*)(L + EB_OFF); LAS float* ER = (LAS float*)(L + ER_OFF); LAS float* SSQ = (LAS float*)(L + SSQ_OFF);
    const int si = w >> 1, sj0 = (w & 1) * 2, l31 = lane & 31, l5 = lane >> 5;
    const int ri = w >> 2, cj = w & 3, odv = 32 * cj + l31;
    f32x16 S[2];
#pragma unroll
    for (int jj = 0; jj < 2; ++jj)
#pragma unroll
        for (int r = 0; r < 16; ++r) S[jj][r] = 0.f;
    if (OUT) {
#pragma unroll 1
        for (int i = 0; i < j; ++i) { const int ui = u - j + i;
#pragma unroll
            for (int jj = 0; jj < 2; ++jj)
#pragma unroll
                for (int rg = 0; rg < 4; ++rg) { const int sdk0 = 32 * si + 8 * rg + 4 * l5, sdv = 32 * (sj0 + jj) + l31; const f32x4 dd = *(const f32x4*)(Db + ui * 128 + sdk0);
#pragma unroll
                    for (int e = 0; e < 4; ++e) S[jj][4 * rg + e] = dd[e] * S[jj][4 * rg + e] + Lb[(size_t)ui * 16384 + (sdk0 + e) * 128 + sdv]; } } }
    const float nwv = OUT ? a.in[26][h * 128 + odv] : 0.f;
    float dsum = 1.f;
    const int prow = tid >> 4, ppc = tid & 15;
    u32x4 pf[2], pv[2], pq[2];
#define GLA_PREFETCH(cx) do { const bf16_t* _q = Q + (size_t)((cx) * 64 + prow) * 4096 + ppc * 8; \
        _Pragma("unroll") for (int _r = 0; _r < 2; ++_r) { pf[_r] = *(const u32x4*)(_q + (size_t)_r * 32 * 4096 + 1024); pv[_r] = *(const u32x4*)(_q + (size_t)_r * 32 * 4096 + 2048); if (OUT) pq[_r] = *(const u32x4*)(_q + (size_t)_r * 32 * 4096); } } while (0)
    GLA_PREFETCH(0);
#pragma unroll 1
    for (int c = 0; c < 16; ++c) {
        int cc = c; asm volatile("" : "+s"(cc));
#pragma unroll
        for (int r = 0; r < 2; ++r) { *(LAS u32x4*)(L + KH_OFF + (prow + 32 * r) * QS + ppc * 16) = pf[r]; *(LAS u32x4*)(L + ST_OFF + (prow + 32 * r) * QS + ppc * 16) = pv[r];
            if (OUT) *(LAS u32x4*)(L + QH_OFF + (prow + 32 * r) * QS + ppc * 16) = pq[r]; }
        if (c + 1 < 16) GLA_PREFETCH(cc + 1);
        u32x4 gq[2];
        if (OUT) { const bf16_t* G = Q + (size_t)(cc * 64) * 4096 + 3072;
            unsigned go = (unsigned)((tid >> 3) * 4096 + (tid & 7) * 16); asm volatile("" : "+v"(go));
            gq[0] = *(const u32x4*)(G + go); gq[1] = *(const u32x4*)(G + go + 8u); }
        GLA_BAR();
        float lf[16], kk[16];
#pragma unroll
        for (int i = 0; i < 16; ++i) { const float fv = bf2f(*(const LAS bf16_t*)(L + KH_OFF + (tg * 16 + i) * QS + dk * 2)); const float sg = __builtin_amdgcn_rcpf(1.f + __expf(-fv));
            lf[i] = lbv + omlb * sg; kk[i] = omlb * (1.f - sg); }
#pragma unroll
        for (int i = 1; i < 16; ++i) lf[i] *= lf[i - 1];
        PS[tg * 128 + dk] = lf[15];
        GLA_BAR();
        const float p0 = PS[dk], p1 = PS[128 + dk], p2 = PS[256 + dk], p3 = PS[384 + dk];
        const float off = (tg > 0 ? p0 : 1.f) * (tg > 1 ? p1 : 1.f) * (tg > 2 ? p2 : 1.f);
        const float pref = p0 * p1, pbl = pref * (p2 * p3), ebr = p2 * p3;
        const float ioff = off * __builtin_amdgcn_rcpf(pref);
        unsigned ktp[8], vtp[8];
#pragma unroll
        for (int i = 0; i < 16; i += 2) {
            float kb[2]; unsigned vv[2];
#pragma unroll
            for (int q = 0; q < 2; ++q) { const float e1 = ioff * lf[i + q]; const float e2 = __builtin_amdgcn_rcpf(e1);
                const float khat = kk[i + q] * e2; kb[q] = khat * ebr; vv[q] = *(const LAS bf16_t*)(L + ST_OFF + (tg * 16 + i + q) * QS + dk * 2);
                if (OUT) { LAS bf16_t* qp = (LAS bf16_t*)(L + QH_OFF + (tg * 16 + i + q) * QS + dk * 2); const float qr = bf2f(*qp); const float qv = qr * __builtin_amdgcn_rcpf(1.f + __expf(-qr));
                    *qp = f2bf(qv * e1); *(LAS bf16_t*)(L + KH_OFF + (tg * 16 + i + q) * QS + dk * 2) = f2bf(khat); } }
            ktp[i >> 1] = pk2(kb[0], kb[1]); vtp[i >> 1] = vv[0] | (vv[1] << 16);
        }
        *(LAS u32x4*)(L + KT_OFF + dk * TS + tg * 32) = (u32x4){ktp[0], ktp[1], ktp[2], ktp[3]}; *(LAS u32x4*)(L + KT_OFF + dk * TS + tg * 32 + 16) = (u32x4){ktp[4], ktp[5], ktp[6], ktp[7]};
        *(LAS u32x4*)(L + VT_OFF + dk * TS + tg * 32) = (u32x4){vtp[0], vtp[1], vtp[2], vtp[3]}; *(LAS u32x4*)(L + VT_OFF + dk * TS + tg * 32 + 16) = (u32x4){vtp[4], vtp[5], vtp[6], vtp[7]};
        if (tg == 0) { EB[dk] = pbl; ER[dk] = pref; dsum *= pbl; }
        GLA_BAR();
        f32x16 o;
        if (OUT) {
#pragma unroll
            for (int jj = 0; jj < 2; ++jj)
#pragma unroll
                for (int rg = 0; rg < 4; ++rg) { const int dk0 = 32 * si + 8 * rg + 4 * l5; const f32x4 er = *(const LAS f32x4*)(ER + dk0);
                    u32x2 pk; pk.x = pk2(S[jj][4 * rg] * er[0], S[jj][4 * rg + 1] * er[1]); pk.y = pk2(S[jj][4 * rg + 2] * er[2], S[jj][4 * rg + 3] * er[3]);
                    *(LAS u32x2*)(L + ST_OFF + (32 * (sj0 + jj) + l31) * QS + dk0 * 2) = pk; }
#pragma unroll
            for (int q = 0; q < 2; ++q) { const int ti = w >> 1, tj = (w & 1) * 2 + q;
                f32x4 sc = (f32x4){0.f, 0.f, 0.f, 0.f};
                if (tj <= ti) {
#pragma unroll
                    for (int ks = 0; ks < 4; ++ks) { const bf16x8 af = *(const LAS bf16x8*)(L + QH_OFF + (16 * ti + (lane & 15)) * QS + ks * 64 + (lane >> 4) * 16);
                        const bf16x8 bfr = *(const LAS bf16x8*)(L + KH_OFF + (16 * tj + (lane & 15)) * QS + ks * 64 + (lane >> 4) * 16);
                        sc = __builtin_amdgcn_mfma_f32_16x16x32_bf16(af, bfr, sc, 0, 0, 0); } }
                const int scol = 16 * tj + (lane & 15);
#pragma unroll
                for (int r = 0; r < 4; ++r) { const int trow = 16 * ti + 4 * (lane >> 4) + r; const float v = (scol <= trow) ? sc[r] : 0.f;
                    *(LAS bf16_t*)(L + AM_OFF + trow * TS + scol * 2) = f2bf(v); } }
            GLA_BAR();
#pragma unroll
            for (int r = 0; r < 16; ++r) o[r] = 0.f;
#pragma unroll
            for (int ks = 0; ks < 4; ++ks) if (ks < 2 * (ri + 1)) {
                const bf16x8 af = *(const LAS bf16x8*)(L + AM_OFF + (32 * ri + l31) * TS + ks * 32 + l5 * 16);
                const bf16x8 bfr = *(const LAS bf16x8*)(L + VT_OFF + (32 * cj + l31) * TS + ks * 32 + l5 * 16);
                o = __builtin_amdgcn_mfma_f32_32x32x16_bf16(af, bfr, o, 0, 0, 0); }
#pragma unroll
            for (int ks = 0; ks < 8; ++ks) { if ((ks & 3) == 0) asm volatile("" ::: "memory");
                const bf16x8 af = *(const LAS bf16x8*)(L + QH_OFF + (32 * ri + l31) * QS + ks * 32 + l5 * 16);
                const bf16x8 bfr = *(const LAS bf16x8*)(L + ST_OFF + (32 * cj + l31) * QS + ks * 32 + l5 * 16);
                o = __builtin_amdgcn_mfma_f32_32x32x16_bf16(af, bfr, o, 0, 0, 0); }
#pragma unroll
            for (int r = 0; r < 16; ++r) { const float q2 = xrow32_sum(row16_sum(o[r] * o[r]));
                if (l31 == 0) SSQ[(32 * ri + (r & 3) + 8 * (r >> 2) + 4 * l5) * 4 + cj] = q2; }
#pragma unroll
            for (int r = 0; r < 16; ++r) *(LAS float*)(L + OT_OFF + (32 * ri + (r & 3) + 8 * (r >> 2) + 4 * l5) * 528 + odv * 4) = o[r] * nwv;
        }
        {
            bf16x8 af[4];
#pragma unroll
            for (int ks = 0; ks < 4; ++ks) af[ks] = *(const LAS bf16x8*)(L + KT_OFF + (32 * si + l31) * TS + ks * 32 + l5 * 16);
#pragma unroll
            for (int jj = 0; jj < 2; ++jj) {
#pragma unroll
                for (int rg = 0; rg < 4; ++rg) { const f32x4 eb = *(const LAS f32x4*)(EB + 32 * si + 8 * rg + 4 * l5);
                    S[jj][4 * rg] *= eb[0]; S[jj][4 * rg + 1] *= eb[1]; S[jj][4 * rg + 2] *= eb[2]; S[jj][4 * rg + 3] *= eb[3]; }
#pragma unroll
                for (int ks = 0; ks < 4; ++ks) { const bf16x8 bfr = *(const LAS bf16x8*)(L + VT_OFF + (32 * (sj0 + jj) + l31) * TS + ks * 32 + l5 * 16);
                    S[jj] = __builtin_amdgcn_mfma_f32_32x32x16_bf16(af[ks], bfr, S[jj], 0, 0, 0); } }
        }
        GLA_BAR();
        if (OUT) {
            const int et = tid >> 3, ep = tid & 7;
            const f32x4 q4 = *(const LAS f32x4*)(SSQ + et * 4);
            const float rs = rsqrtf(((q4[0] + q4[1]) + (q4[2] + q4[3])) * (1.f / 128.f) + 1e-6f);
            bf16_t* MIX = (bf16_t*)(a.ws + WS_MIX1) + ((size_t)b * SEQ + (size_t)j * 1024 + cc * 64) * DM + h * 128;
            unsigned mo = (unsigned)(et * DM + ep * 16); asm volatile("" : "+v"(mo));
#pragma unroll
            for (int hf = 0; hf < 2; ++hf) { unsigned ov[4];
#pragma unroll
                for (int e2 = 0; e2 < 2; ++e2) { const f32x4 o4 = *(const LAS f32x4*)(L + OT_OFF + et * 528 + ep * 64 + hf * 32 + e2 * 16);
#pragma unroll
                    for (int e = 0; e < 2; ++e) { const unsigned gw = gq[hf][e2 * 2 + e]; const float g0 = __uint_as_float(gw << 16), g1 = __uint_as_float(gw & 0xffff0000u);
                        ov[e2 * 2 + e] = pk2(o4[2 * e] * rs * g0 * __builtin_amdgcn_rcpf(1.f + __expf(-g0)), o4[2 * e + 1] * rs * g1 * __builtin_amdgcn_rcpf(1.f + __expf(-g1))); } }
                *(u32x4*)(MIX + mo + hf * 8) = (u32x4){ov[0], ov[1], ov[2], ov[3]}; }
        }
    }
    if (!OUT) {
#pragma unroll
        for (int jj = 0; jj < 2; ++jj)
#pragma unroll
            for (int r = 0; r < 16; ++r) { const int sdk = 32 * si + (r & 3) + 8 * (r >> 2) + 4 * l5, sdv = 32 * (sj0 + jj) + l31; Lb[(size_t)u * 16384 + sdk * 128 + sdv] = S[jj][r]; }
        if (tg == 0) Db[u * 128 + dk] = dsum;
    }
    GLA_BAR();
#undef GLA_PREFETCH
}
__device__ __forceinline__ void pass2(const Args& a) {
    float* Lb = (float*)(a.ws + WS_O); const float* Db = Lb + (size_t)256 * 16384;
    for (int idx = blockIdx.x * NTHREADS + threadIdx.x; idx < 32 * 16384; idx += gridDim.x * NTHREADS) { const int bh = idx >> 14, el = idx & 16383, dkk = el >> 7; float sacc = 0.f;
        for (int j = 0; j < 8; ++j) { const int u = bh * 8 + j; const size_t o = (size_t)u * 16384 + el;
            if (j < 7) { const float tmp = Lb[o]; Lb[o] = sacc; sacc = Db[u * 128 + dkk] * sacc + tmp; } else Lb[o] = sacc; } }
}
}

constexpr int NPHASE = 24;
__global__ void __launch_bounds__(NTHREADS, 2) fwd(Args a) {
    extern __shared__ __attribute__((aligned(16))) unsigned char lds_raw[];
    LAS unsigned char* ldsb = (LAS unsigned char*)lds_raw;
    LAS float* lds = (LAS float*)ldsb;
    LAS int* pst = (LAS int*)(ldsb + LDS_MISC);
    volatile LAS unsigned* xbw = (volatile LAS unsigned*)(ldsb + LDS_MISC + 256);
    if (threadIdx.x == 0) { xbw[0] = 0u; xbw[1] = 0u; }
    __syncthreads();
    unsigned* ctl = (unsigned*)(a.ws + WS_CTL);
    const bool multi = (a.ph_hi - a.ph_lo) > 1;
    XcdBarrier bar; bar.bar = ctl; bar.x = 0; bar.st = xbw;
    if (multi) bar = xcd_barrier_post(ctl, xbw);
    unsigned char* ws = a.ws;
    bf16_t* HN = (bf16_t*)(ws + WS_A);
    bf16_t* XR = (bf16_t*)(ws + WS_XR); float* RSv = (float*)(ws + WS_ROUTE + RT_LRU_CH);
    int* asg_e = (int*)(ws + WS_ROUTE + RT_ASG_E); int* asg_rank = (int*)(ws + WS_ROUTE + RT_ASG_RANK); float* asg_gate = (float*)(ws + WS_ROUTE + RT_ASG_GATE);
    int* row_tok = (int*)(ws + WS_ROUTE + RT_ROW_TOK); int* row_slot = (int*)(ws + WS_ROUTE + RT_ROW_SLOT); float* row_gate = (float*)(ws + WS_ROUTE + RT_ROW_GATE); float* row_rs = (float*)(ws + WS_ROUTE + RT_LRU_CA); float* tscale = (float*)(ws + WS_ROUTE + RT_LRU_CIN);
#ifndef PHSEL
#define PHSEL(k) true
#endif
#ifndef REPMASK
#define REPMASK 0u
#endif
#define NREP(k) (((REPMASK >> (k)) & 1u) ? 2 : 1)
#define IN(k) (PHSEL(k) && a.ph_lo <= (k) && (k) < a.ph_hi)
#define SEAM(k) do { if (IN((k) + 1) && multi) xcd_barrier(bar); } while (0)
    if (IN(0)) { ph_cvt_frags(a); ph_cvt_dense_a(a, lds, ctl + CW_COLMAX); ph_norm0(a.in[0], a.in[1], (unsigned char*)HN, (float*)(ws + WS_ROUTE + RT_LRU_CH + 262144)); xcd_barrier(bar); ph_cvt_dense_b(a, lds, ctl + CW_COLMAX, 0); }
#if (REPMASK >> 0) & 1
    if (IN(0)) { xcd_barrier(bar);  ph_cvt_frags(a); ph_cvt_dense_a(a, lds, ctl + CW_COLMAX); ph_norm0(a.in[0], a.in[1], (unsigned char*)HN, (float*)(ws + WS_ROUTE + RT_LRU_CH + 262144)); xcd_barrier(bar); ph_cvt_dense_b(a, lds, ctl + CW_COLMAX, 0); }
#endif
    if (IN(0)) { SEAM(0); }
    if (IN(1)) { pg8::DenseOrder S; S.init(NTOK, ABC, DM / 2, gridDim.x, blockIdx.x, ws + WD_ABIN); pg8::EpiBf16I E{(bf16_t*)(ws + WS_B), ABC, (float*)(ws + WS_ROUTE + RT_LRU_CH + 262144), ctl + CW_COLMAX};
        pg8::gemm_phase<pg8::EpiBf16I, pg8::DenseOrder, true>(ldsb, (const char*)HN, DM, DM / 2, S, E); }
#if (REPMASK >> 1) & 1
    if (IN(1)) { xcd_barrier(bar);  pg8::DenseOrder S; S.init(NTOK, ABC, DM / 2, gridDim.x, blockIdx.x, ws + WD_ABIN); pg8::EpiBf16I E{(bf16_t*)(ws + WS_B), ABC, (float*)(ws + WS_ROUTE + RT_LRU_CH + 262144), ctl + CW_COLMAX};
        pg8::gemm_phase<pg8::EpiBf16I, pg8::DenseOrder, true>(ldsb, (const char*)HN, DM, DM / 2, S, E);  }
#endif
    if (IN(1)) { SEAM(1); }
    if (IN(2)) { ph_l0_prep(a, lds); }
#if (REPMASK >> 2) & 1
    if (IN(2)) { xcd_barrier(bar);  ph_l0_prep(a, lds);  }
#endif
    if (IN(2)) { SEAM(2); }
    if (IN(6)) {
        if (blockIdx.x < 32) ph_rwkv_scan(a, ldsb);
        else { const int gb = (int)blockIdx.x - 32, gn = (int)gridDim.x - 32; unsigned* sctr = ctl + CW_CNT + 256;
            ph_lru_b(a, gb, lds); sub_barrier(sctr, (unsigned)gn);
#if SP_MODE & 1
            ph_lru_c(a, gb, gn); }
        xcd_barrier(bar); ph_wmax(a.in[32], a.in[33], ctl + CW_WMAX, blockIdx.x, gridDim.x); xcd_barrier(bar);
        ph_cvt_moe(a, 0, lds, blockIdx.x, gridDim.x, 3); ph_cvt_moe(a, 1, lds, blockIdx.x, gridDim.x, 1);
#else
            ph_lru_c(a, gb, gn); ph_wmax(a.in[32], a.in[33], ctl + CW_WMAX, gb, gn); sub_barrier(sctr, 2u * (unsigned)gn);
            ph_cvt_moe(a, 0, lds, gb, gn, 3); ph_cvt_moe(a, 1, lds, gb, gn, 1); }
#endif
        SEAM(6); }
    if (IN(7)) { ph_rwkv_post(a, lds); }
#if (REPMASK >> 7) & 1
    if (IN(7)) { xcd_barrier(bar);  ph_rwkv_post(a, lds);  }
#endif
    if (IN(7)) { SEAM(7); }
    if (IN(8)) { pg8::DenseOrder S; S.init(NTOK, DM, DM, gridDim.x, blockIdx.x, ws + WD_ABOUT); pg8::EpiResid<true> E{a.in[0], XR};
        pg8::gemm_phase(ldsb, (const char*)(ws + WS_D), DM * 2, DM, S, E); }
#if (REPMASK >> 8) & 1
    if (IN(8)) { xcd_barrier(bar);  pg8::DenseOrder S; S.init(NTOK, DM, DM, gridDim.x, blockIdx.x, ws + WD_ABOUT); pg8::EpiResid<true> E{a.in[0], XR};
        pg8::gemm_phase(ldsb, (const char*)(ws + WS_D), DM * 2, DM, S, E);  }
#endif
    if (IN(8)) { SEAM(8); }
    if (IN(9)) { ph_route(a, 0, XR, HN, RSv, ctl + CW_CNT, asg_e, asg_rank, asg_gate, lds); SEAM(9); }
    if (IN(10)) { ph_dispatch(ctl + CW_CNT, asg_e, asg_rank, asg_gate, RSv, row_tok, row_slot, row_gate, row_rs, pst, ctl + CW_WMAX, tscale); ph_cvt_dense_b(a, lds, ctl + CW_COLMAX, 1); }
#if (REPMASK >> 10) & 1
    if (IN(10)) { xcd_barrier(bar);  ph_dispatch(ctl + CW_CNT, asg_e, asg_rank, asg_gate, RSv, row_tok, row_slot, row_gate, row_rs, pst, ctl + CW_WMAX, tscale);  }
#endif
    if (IN(10)) { SEAM(10); }
    if (IN(11)) { moe_prefix(ctl + CW_CNT, pst);
        pg8::MoeOrder S{(int)gridDim.x, (int)blockIdx.x, 4, pst[NEXP] / 256, pst, row_tok, (const char*)(ws + WM_GU), (size_t)DM * DM, (size_t)256 * DM}; pg8::EpiSwiGLU E{(bf16_t*)(ws + WS_H), tscale};
        pg8::gemm_phase<pg8::EpiSwiGLU, pg8::MoeOrder, true>(ldsb, (const char*)HN, DM, DM / 2, S, E); }
#if (REPMASK >> 11) & 1
    if (IN(11)) { xcd_barrier(bar);  moe_prefix(ctl + CW_CNT, pst);
        pg8::MoeOrder S{(int)gridDim.x, (int)blockIdx.x, 4, pst[NEXP] / 256, pst, row_tok, (const char*)(ws + WM_GU), (size_t)DM * DM, (size_t)256 * DM}; pg8::EpiSwiGLU E{(bf16_t*)(ws + WS_H), tscale};
        pg8::gemm_phase<pg8::EpiSwiGLU, pg8::MoeOrder, true>(ldsb, (const char*)HN, DM, DM / 2, S, E);  }
#endif
    if (IN(11)) { SEAM(11); }
    if (IN(12)) { moe_prefix(ctl + CW_CNT, pst);
        pg8::MoeOrder S{(int)gridDim.x, (int)blockIdx.x, 4, pst[NEXP] / 256, pst, nullptr, (const char*)(ws + WM_DN), (size_t)DM * FF * 2, (size_t)256 * FF * 2}; pg8::EpiDown E{(bf16_t*)(ws + WS_Y), row_tok, row_slot, row_gate};
        pg8::gemm_phase(ldsb, (const char*)(ws + WS_H), FF * 2, FF, S, E); }
#if (REPMASK >> 12) & 1
    if (IN(12)) { xcd_barrier(bar);  moe_prefix(ctl + CW_CNT, pst);
        pg8::MoeOrder S{(int)gridDim.x, (int)blockIdx.x, 4, pst[NEXP] / 256, pst, nullptr, (const char*)(ws + WM_DN), (size_t)DM * FF * 2, (size_t)256 * FF * 2}; pg8::EpiDown E{(bf16_t*)(ws + WS_Y), row_tok, row_slot, row_gate};
        pg8::gemm_phase(ldsb, (const char*)(ws + WS_H), FF * 2, FF, S, E);  }
#endif
    if (IN(12)) { SEAM(12); }
    if (IN(13)) { ph_combine_norm(XR, (const bf16_t*)(ws + WS_Y), a.in[1] + DM, (unsigned char*)HN, (float*)(ws + WS_ROUTE + RT_LRU_CH + 262144)); SEAM(13); }
    if (IN(14)) { pg8::DenseOrder S; S.init(NTOK, 4096, DM / 2, gridDim.x, blockIdx.x, ws + WD_CIN); pg8::EpiBf16I E{(bf16_t*)(ws + WS_QFIG), 4096, (float*)(ws + WS_ROUTE + RT_LRU_CH + 262144), ctl + CW_COLMAX + ABC};
        pg8::gemm_phase<pg8::EpiBf16I, pg8::DenseOrder, true>(ldsb, (const char*)HN, DM, DM / 2, S, E); }
#if (REPMASK >> 14) & 1
    if (IN(14)) { xcd_barrier(bar);  pg8::DenseOrder S; S.init(NTOK, 4096, DM / 2, gridDim.x, blockIdx.x, ws + WD_CIN); pg8::EpiBf16I E{(bf16_t*)(ws + WS_QFIG), 4096, (float*)(ws + WS_ROUTE + RT_LRU_CH + 262144), ctl + CW_COLMAX + ABC};
        pg8::gemm_phase<pg8::EpiBf16I, pg8::DenseOrder, true>(ldsb, (const char*)HN, DM, DM / 2, S, E);  }
#endif
    if (IN(14)) { SEAM(14); }
    if (IN(15)) { for (int u = blockIdx.x; u < 256; u += gridDim.x) if ((u & 7) != 7) gla::unit<false>(a, ldsb, u); }
#if (REPMASK >> 15) & 1
    if (IN(15)) { xcd_barrier(bar);  for (int u = blockIdx.x; u < 256; u += gridDim.x) if ((u & 7) != 7) gla::unit<false>(a, ldsb, u);  }
#endif
    if (IN(15)) { SEAM(15); }
    if (IN(17)) { for (int u = blockIdx.x; u < 256; u += gridDim.x) gla::unit<true>(a, ldsb, u); }
#if (REPMASK >> 17) & 1
    if (IN(17)) { xcd_barrier(bar);  for (int u = blockIdx.x; u < 256; u += gridDim.x) gla::unit<true>(a, ldsb, u);  }
#endif
    if (IN(17)) { SEAM(17); }
    if (IN(18)) { pg8::DenseOrder S; S.init(NTOK, DM, DM, gridDim.x, blockIdx.x, ws + WD_COUT); pg8::EpiResid<false> E{XR, XR};
        pg8::gemm_phase(ldsb, (const char*)(ws + WS_MIX1), DM * 2, DM, S, E); SEAM(18); }
    if (IN(19)) { ph_route(a, 1, XR, HN, RSv, ctl + CW_CNT + 64, asg_e, asg_rank, asg_gate, lds); SEAM(19); }
    if (IN(20)) { ph_dispatch(ctl + CW_CNT + 64, asg_e, asg_rank, asg_gate, RSv, row_tok, row_slot, row_gate, row_rs, pst, ctl + CW_WMAX + 64, tscale); ph_cvt_moe(a, 1, lds, blockIdx.x, gridDim.x, 2); }
#if (REPMASK >> 20) & 1
    if (IN(20)) { xcd_barrier(bar);  ph_dispatch(ctl + CW_CNT + 64, asg_e, asg_rank, asg_gate, RSv, row_tok, row_slot, row_gate, row_rs, pst, ctl + CW_WMAX + 64, tscale); ph_cvt_moe(a, 1, lds, blockIdx.x, gridDim.x, 2);  }
#endif
    if (IN(20)) { SEAM(20); }
    if (IN(21)) { moe_prefix(ctl + CW_CNT + 64, pst);
        pg8::MoeOrder S{(int)gridDim.x, (int)blockIdx.x, 4, pst[NEXP] / 256, pst, row_tok, (const char*)(ws + WM_GU1), (size_t)DM * DM, (size_t)256 * DM}; pg8::EpiSwiGLU E{(bf16_t*)(ws + WS_H), tscale};
        pg8::gemm_phase<pg8::EpiSwiGLU, pg8::MoeOrder, true>(ldsb, (const char*)HN, DM, DM / 2, S, E); }
#if (REPMASK >> 21) & 1
    if (IN(21)) { xcd_barrier(bar);  moe_prefix(ctl + CW_CNT + 64, pst);
        pg8::MoeOrder S{(int)gridDim.x, (int)blockIdx.x, 4, pst[NEXP] / 256, pst, row_tok, (const char*)(ws + WM_GU1), (size_t)DM * DM, (size_t)256 * DM}; pg8::EpiSwiGLU E{(bf16_t*)(ws + WS_H), tscale};
        pg8::gemm_phase<pg8::EpiSwiGLU, pg8::MoeOrder, true>(ldsb, (const char*)HN, DM, DM / 2, S, E);  }
#endif
    if (IN(21)) { SEAM(21); }
    if (IN(22)) { moe_prefix(ctl + CW_CNT + 64, pst);
        pg8::MoeOrder S{(int)gridDim.x, (int)blockIdx.x, 4, pst[NEXP] / 256, pst, nullptr, (const char*)(ws + WM_DN), (size_t)DM * FF * 2, (size_t)256 * FF * 2}; pg8::EpiDown E{(bf16_t*)(ws + WS_Y), row_tok, row_slot, row_gate};
        pg8::gemm_phase(ldsb, (const char*)(ws + WS_H), FF * 2, FF, S, E); }
#if (REPMASK >> 22) & 1
    if (IN(22)) { xcd_barrier(bar);  moe_prefix(ctl + CW_CNT + 64, pst);
        pg8::MoeOrder S{(int)gridDim.x, (int)blockIdx.x, 4, pst[NEXP] / 256, pst, nullptr, (const char*)(ws + WM_DN), (size_t)DM * FF * 2, (size_t)256 * FF * 2}; pg8::EpiDown E{(bf16_t*)(ws + WS_Y), row_tok, row_slot, row_gate};
        pg8::gemm_phase(ldsb, (const char*)(ws + WS_H), FF * 2, FF, S, E);  }
#endif
    if (IN(22)) { SEAM(22); }
    if (IN(23)) { ph_final(XR, (const bf16_t*)(ws + WS_Y), a.in[3], a.out); }
#undef IN
#undef SEAM
}

extern "C" void kernel_launch(void* const* d_in, const int* in_sizes, int n_in, void* d_out, int out_size, void* d_ws, size_t ws_size, hipStream_t stream) {
    static int grid = 0;
    if (grid == 0) {
        if (n_in != 35 || out_size != NTOK * DM || ws_size < WS_END) { fprintf(stderr, "kernel_launch: unexpected shapes (n_in %d out %d ws %zu)\n", n_in, out_size, ws_size); grid = -1; return; }
        int dev = 0, cus = 0;
        if (hipGetDevice(&dev) != hipSuccess || hipDeviceGetAttribute(&cus, hipDeviceAttributeMultiprocessorCount, dev) != hipSuccess) { grid = -1; return; }
        if (hipFuncSetAttribute((const void*)fwd, hipFuncAttributeMaxDynamicSharedMemorySize, LDS_BYTES) != hipSuccess) { fprintf(stderr, "kernel_launch: hipFuncSetAttribute failed\n"); grid = -1; return; }
        int per_cu = 0;
        (void)hipOccupancyMaxActiveBlocksPerMultiprocessor(&per_cu, (const void*)fwd, NTHREADS, LDS_BYTES);
        (void)hipGetLastError();
        grid = cus;
        if (grid < 64) { fprintf(stderr, "kernel_launch: needs >= 64 CUs\n"); grid = -1; return; }
    }
    if (grid < 0) return;
    (void)hipMemsetAsync((char*)d_ws + WS_CTL, 0, CTL_ZERO_BYTES, stream);
    Args a{};
    for (int i = 0; i < 35; ++i) a.in[i] = (const float*)d_in[i];
    a.out = (float*)d_out; a.ws = (unsigned char*)d_ws;
#if 0
    for (int p = 0; p < NPHASE; ++p) { a.ph_lo = p; a.ph_hi = p + 1; hipLaunchKernelGGL(fwd, dim3(grid), dim3(NTHREADS), LDS_BYTES, stream, a); }
#else
    a.ph_lo = 0; a.ph_hi = NPHASE; hipLaunchKernelGGL(fwd, dim3(grid), dim3(NTHREADS), LDS_BYTES, stream, a);
#endif
}
```

```cpp
#include <hip/hip_runtime.h>
#include <cstdio>
#include <cstdint>

typedef unsigned short bf16_t;
#define LAS __attribute__((address_space(3)))
typedef float f32x4 __attribute__((ext_vector_type(4)));
typedef short bf16x8_t __attribute__((ext_vector_type(8)));
typedef unsigned u32x4_t __attribute__((ext_vector_type(4)));
typedef unsigned u32x2_t __attribute__((ext_vector_type(2)));

constexpr int NTOK = 32768, SEQ = 8192, NBATCH = 4, DM = 1024;
constexpr int ABC = 2816, RWC = 1792;
constexpr int NEXP = 32, FF = 512;
constexpr int NASG = NTOK * 2;
constexpr int MOE_TM = 256;
constexpr int MAXROWS = NASG + NEXP * MOE_TM;
constexpr int NTHREADS = 512;
constexpr int LDS_BYTES = 156 * 1024;
constexpr int LDS_MISC = 155 * 1024;

constexpr size_t MiB = 1024ull * 1024ull;
constexpr size_t WS_CTL = 0;
constexpr size_t CTL_ZERO_BYTES = 64 * 1024;
constexpr size_t WS_ROUTE = 64 * 1024;
constexpr size_t WS_WD = 8 * MiB;
constexpr size_t WD_ABIN = WS_WD, WD_ABOUT = WD_ABIN + (size_t)ABC * DM * 2, WD_CIN = WD_ABOUT + (size_t)DM * DM * 2, WD_COUT = WD_CIN + (size_t)4096 * DM * 2;
constexpr size_t WS_AR = 26 * MiB;
constexpr size_t WS_A = WS_AR;
constexpr size_t WS_B = WS_AR + 64 * MiB;
constexpr size_t WS_C = WS_B + 176 * MiB;
constexpr size_t WS_D = WS_C + 212 * MiB;
constexpr size_t DO_LRU = 112 * MiB;
constexpr size_t WS_XR = WS_AR + 360 * MiB;
constexpr size_t WS_WM = WS_AR + 64 * MiB;
constexpr size_t WM_GU1 = WS_A + 32 * MiB;
constexpr size_t WM_GU = WS_WM, WM_DN = WS_WM + (size_t)NEXP * DM * DM;
constexpr size_t WS_H = WS_WM + 96 * MiB;
constexpr size_t WS_Y = WS_H + 72 * MiB;
constexpr size_t WS_QFIG = WS_AR + 64 * MiB;
constexpr size_t WS_O = WS_QFIG + 256 * MiB;
constexpr size_t WS_MIX1 = WS_O + 128 * MiB;
constexpr size_t WS_END = WS_AR + 516 * MiB;
static_assert(WS_D + 64 * MiB <= WS_END && WS_Y + 128 * MiB <= WS_END && WS_MIX1 + 64 * MiB <= WS_END, "arena");

constexpr size_t DO_VB = 0, DO_BON = 32 * MiB, DO_SG = 34 * MiB, DO_YR = 48 * MiB;

constexpr int CW_CNT = 8192;
constexpr int CW_WMAX = CW_CNT + 512;
constexpr int CW_COLMAX = CW_WMAX + 192;
constexpr float ACT_Q = 127.f / 6.f;
constexpr size_t RT_ASG_E = 0;
constexpr size_t RT_ASG_RANK = RT_ASG_E + NASG * 4;
constexpr size_t RT_ASG_GATE = RT_ASG_RANK + NASG * 4;
constexpr size_t RT_ROW_TOK = RT_ASG_GATE + NASG * 4;
constexpr size_t RT_ROW_SLOT = RT_ROW_TOK + MAXROWS * 4;
constexpr size_t RT_ROW_GATE = RT_ROW_SLOT + MAXROWS * 4;
constexpr size_t RT_LRU_CH = RT_ROW_GATE + MAXROWS * 4;
constexpr size_t RT_LRU_CA = RT_LRU_CH + 512 * 512 * 4;
constexpr size_t RT_LRU_CIN = RT_LRU_CA + 512 * 512 * 4;
constexpr size_t RT_END = RT_LRU_CIN + 512 * 512 * 4;
constexpr size_t WS_FRAG = 6 * MiB;
constexpr size_t FG_RT = WS_FRAG + 393216;
constexpr size_t FG_W2 = WS_FRAG, FG_A2 = FG_W2 + 65536, FG_WA = FG_A2 + 65536, FG_WX = FG_WA + 65536, FG_G2 = FG_WX + 65536;
static_assert(WS_ROUTE + RT_END <= 6 * MiB, "routing arrays overflow");

__device__ __forceinline__ float bf2f(bf16_t v) { return __uint_as_float(((unsigned)v) << 16); }
typedef __bf16 bf16x2_hw __attribute__((ext_vector_type(2)));
typedef float f32x2_hw __attribute__((ext_vector_type(2)));
__device__ __forceinline__ unsigned pk2(float lo, float hi) { const f32x2_hw v = {lo, hi}; const bf16x2_hw b = __builtin_convertvector(v, bf16x2_hw); return __builtin_bit_cast(unsigned, b); }
__device__ __forceinline__ bf16_t f2bf(float f) { const __bf16 b = (__bf16)f; return __builtin_bit_cast(bf16_t, b); }
template <int CTRL> __device__ __forceinline__ float dpp_(float x) { return __builtin_bit_cast(float, __builtin_amdgcn_mov_dpp(__builtin_bit_cast(int, x), CTRL, 0xf, 0xf, true)); }
__device__ __forceinline__ float row16_sum(float v) {
    v += dpp_<0xB1>(v); v += dpp_<0x4E>(v); v += dpp_<0x124>(v); v += dpp_<0x128>(v); return v; }
__device__ __forceinline__ float xrow16_sum(float x) {
    auto s = __builtin_amdgcn_permlane16_swap(__float_as_uint(x), __float_as_uint(x), false, false);
    x = __uint_as_float(s[0]) + __uint_as_float(s[1]);
    auto t = __builtin_amdgcn_permlane32_swap(__float_as_uint(x), __float_as_uint(x), false, false);
    return __uint_as_float(t[0]) + __uint_as_float(t[1]); }
__device__ __forceinline__ float xrow32_sum(float x) {
    auto s = __builtin_amdgcn_permlane16_swap(__float_as_uint(x), __float_as_uint(x), false, false);
    return __uint_as_float(s[0]) + __uint_as_float(s[1]); }
__device__ __forceinline__ float wave_sum(float v) { return xrow16_sum(row16_sum(v)); }
__device__ __forceinline__ float sigmoidf_(float x) { return 1.f / (1.f + __expf(-x)); }
__device__ __forceinline__ float softplusf_(float x) { return fmaxf(x, 0.f) + log1pf(__expf(-fabsf(x))); }
__device__ __forceinline__ float siluf_(float x) { return x * sigmoidf_(x); }
__device__ __forceinline__ float gelu_tanhf_(float x) { const float c = 0.7978845608028654f; return 0.5f * x * (1.f + tanhf(c * (x + 0.044715f * x * x * x))); }

struct Args {
    const float* in[35];
    float* out;
    unsigned char* ws;
    int ph_lo, ph_hi;
};

#define XB_TMO      128
#define XB_XCNT(j)  (256  + 64 * (j))
#define XB_XSUB(j)  (1280 + 64 * (j))
#define XB_XGEN(j)  (2304 + 64 * (j))
#define XB_TOP      3328
#define XB_TOPGEN   3392
#define XCD_BAR_WORDS 3456
#define XB_SPIN_CAP (1u << 18)
__device__ __forceinline__ unsigned xb_ld(unsigned* p)              { return __hip_atomic_load(p, __ATOMIC_RELAXED, __HIP_MEMORY_SCOPE_AGENT); }
__device__ __forceinline__ unsigned xb_add(unsigned* p, unsigned v) { return __hip_atomic_fetch_add(p, v, __ATOMIC_RELAXED, __HIP_MEMORY_SCOPE_AGENT); }
__device__ __forceinline__ unsigned xb_xcc_id() { return (unsigned)__builtin_amdgcn_s_getreg((3 << 11) | 20) & 0xFu; }
#define XB_SPIN(cond, bar) do { unsigned _sp = 0; while (cond) { __builtin_amdgcn_s_sleep(1); \
    if ((++_sp & 255u) == 0u) { if (xb_ld(&(bar)[XB_TMO])) break; if (_sp > XB_SPIN_CAP) { atomicAdd(&(bar)[XB_TMO], 1u); break; } } } } while (0)
struct XcdBarrier { unsigned* bar; unsigned x; volatile LAS unsigned* st; };
__device__ __forceinline__ XcdBarrier xcd_barrier_post(unsigned* bar, volatile LAS unsigned* st) {
    XcdBarrier b; b.bar = bar; b.x = xb_xcc_id(); b.st = st;
    if (threadIdx.x == 0) (void)xb_add(&bar[XB_XCNT(b.x)], 1u);
    return b;
}
__device__ __forceinline__ void xcd_barrier_complete(unsigned* bar, unsigned x, unsigned& nloc, unsigned& nx) {
    const unsigned G = gridDim.x * gridDim.y * gridDim.z;
    unsigned sum, cnt, mine, sp = 0u;
    for (;;) {
        sum = 0u; cnt = 0u; mine = 0u;
#pragma unroll
        for (unsigned j = 0; j < 16; ++j) { const unsigned c = xb_ld(&bar[XB_XCNT(j)]); sum += c; cnt += (c > 0u) ? 1u : 0u; mine = (j == x) ? c : mine; }
        if (sum == G) break;
        __builtin_amdgcn_s_sleep(1);
        if ((++sp & 255u) == 0u) { if (xb_ld(&bar[XB_TMO])) break; if (sp > XB_SPIN_CAP) { atomicAdd(&bar[XB_TMO], 1u); break; } }
    }
    nloc = mine > 0u ? mine : 1u; nx = cnt > 0u ? cnt : 1u;
}
__device__ __forceinline__ void xcd_barrier(const XcdBarrier& b) {
    asm volatile("s_waitcnt vmcnt(0)" ::: "memory");
    __syncthreads();
    if (threadIdx.x == 0) {
        unsigned* bar = b.bar;
        __builtin_amdgcn_s_waitcnt(0);
        unsigned nloc = b.st[0], nx = b.st[1];
        if (nloc == 0u) { xcd_barrier_complete(bar, b.x, nloc, nx); b.st[0] = nloc; b.st[1] = nx; }
        const unsigned old = xb_add(&bar[XB_XSUB(b.x)], 1u);
        const unsigned gen = old / nloc;
        if (old + 1u == (gen + 1u) * nloc) {
            __builtin_amdgcn_fence(__ATOMIC_RELEASE, "agent");
            asm volatile("s_waitcnt vmcnt(0)" ::: "memory");
            const unsigned og = xb_add(&bar[XB_TOP], 1u);
            const unsigned tg = og / nx;
            if (og + 1u == (tg + 1u) * nx) xb_add(&bar[XB_TOPGEN], 1u);
            else XB_SPIN(xb_ld(&bar[XB_TOPGEN]) == tg, bar);
            __builtin_amdgcn_fence(__ATOMIC_ACQUIRE, "agent");
            xb_add(&bar[XB_XGEN(b.x)], 1u);
            asm volatile("s_waitcnt vmcnt(0)" ::: "memory");
        } else {
            XB_SPIN(xb_ld(&bar[XB_XGEN(b.x)]) == gen, bar);
            __builtin_amdgcn_fence(__ATOMIC_ACQUIRE, "agent");
            asm volatile("s_waitcnt vmcnt(0)" ::: "memory");
        }
    }
    __syncthreads();
}

namespace pg8 {
typedef short bf16x8 __attribute__((ext_vector_type(8)));
typedef unsigned u32x4 __attribute__((ext_vector_type(4)));
typedef int v4i_t __attribute__((ext_vector_type(4)));
constexpr int BM = 256, BK = 64, HALF = 128, HTB = HALF * BK * 2, STAGE_BYTES = 8 * HTB, NXCD = 8, WGM = 8;
__device__ __forceinline__ int lds_byte(int r, int c) { const int st = (r >> 4) * 2 + (c >> 5), rr = r & 15, cc = c & 31, ob = rr * 64 + cc * 2; return st * 1024 + (ob ^ (((ob >> 9) & 1) << 5)); }
__device__ __forceinline__ void stage_rc(int b, int& R, int& C) { const int st = b / 1024, sb = b % 1024, swz = sb ^ (((sb >> 9) & 1) << 5); R = (st >> 1) * 16 + swz / 64; C = (st & 1) * 32 + (swz % 64) / 2; }
__device__ __forceinline__ int perm32(int rho) { const int n = rho >> 4, i = rho & 15; return 8 * (i >> 2) + 4 * n + (i & 3); }
__device__ __forceinline__ unsigned cvt_pk_bf16(float lo, float hi) { unsigned r; asm volatile("v_cvt_pk_bf16_f32 %0, %1, %2" : "=v"(r) : "v"(lo), "v"(hi)); return r; }

struct Unit { int pm, pn; const char* B; };

struct DenseOrder {
    int nM, nN, nwg, G, c; const char* Bt; size_t bstep;
    __device__ void init(int M, int N, int K, int G_, int c_, const void* Bt_) { nM = M / BM; nN = N / BM; nwg = nM * nN; G = G_; c = c_; Bt = (const char*)Bt_; bstep = (size_t)BM * K * 2; }
    __device__ bool next(int i, Unit& u) const {
        const long L = (long)i * G + c; if (L >= nwg) return false;
        int wgid = (int)L; { const int q = nwg / NXCD, r = nwg % NXCD, xcd = wgid % NXCD, off = wgid / NXCD; wgid = (xcd < r ? xcd * (q + 1) : r * (q + 1) + (xcd - r) * q) + off; }
        const int nig = WGM * nN, gid = wgid / nig, fm = gid * WGM, gsz = (nM - fm) < WGM ? (nM - fm) : WGM;
        u.pm = fm + ((wgid % nig) % gsz); u.pn = (wgid % nig) / gsz; u.B = Bt + (size_t)u.pn * bstep; return true;
    }
    __device__ __forceinline__ int arow(const Unit& u, int r) const { return u.pm * BM + r; }
};
struct MoeOrder {
    int G, c, nN, ntiles; const LAS int* pst; const int* rowidx; const char* Bt; size_t estep, bstep;
    __device__ bool next(int i, Unit& u) const {
        const int cc = (G % NXCD == 0) ? (c % NXCD) * (G / NXCD) + c / NXCD : c;
        const int L = i * G + cc; if (L >= ntiles * nN) return false;
        u.pm = L / nN; u.pn = L % nN; const int row0 = u.pm * BM; int e = 0;
#pragma unroll
        for (int st = NEXP / 2; st > 0; st >>= 1) if (row0 >= pst[e + st]) e += st;
        u.B = Bt + (size_t)e * estep + (size_t)u.pn * bstep; return true;
    }
    __device__ __forceinline__ int arow(const Unit& u, int r) const { if (!rowidx) return u.pm * BM + r; const int t = rowidx[u.pm * BM + r]; return t < 0 ? 0 : t; }
};

struct EpiBf16I { static constexpr bool PERM = true; bf16_t* O; int ldc; const float* rowscale; const unsigned* colmax;
    __device__ __forceinline__ void operator()(const f32x4 (&acc)[2][2][4][2], const Unit& u, int wr, int wc, int fr, int fq) const {
        const int row0 = u.pm * BM + wr * 64 + fr, col0 = u.pn * BM + wc * 32 + 8 * fq;
        float rsc[8]; f32x4 cs[2][2];
#pragma unroll
        for (int q = 0; q < 8; ++q) rsc[q] = rowscale[row0 + (q >> 2) * HALF + (q & 3) * 16] * (1.f / 127.f);
#pragma unroll
        for (int bj = 0; bj < 2; ++bj)
#pragma unroll
            for (int n = 0; n < 2; ++n) { const u32x4 c4 = *(const u32x4*)(colmax + col0 + bj * HALF + 4 * n); cs[bj][n] = (f32x4){__uint_as_float(c4.x), __uint_as_float(c4.y), __uint_as_float(c4.z), __uint_as_float(c4.w)} * (1.f / 127.f); }
#pragma unroll
        for (int ai = 0; ai < 2; ++ai)
#pragma unroll
            for (int m = 0; m < 4; ++m) { bf16_t* rowp = O + (size_t)(row0 + ai * HALF + m * 16) * ldc + col0; const float rs = rsc[ai * 4 + m];
#pragma unroll
                for (int bj = 0; bj < 2; ++bj) { const v4i_t i0 = __builtin_bit_cast(v4i_t, acc[ai][bj][m][0]), i1 = __builtin_bit_cast(v4i_t, acc[ai][bj][m][1]);
                    const f32x4 s0 = cs[bj][0] * rs, s1 = cs[bj][1] * rs;
                    u32x4 w; w.x = cvt_pk_bf16((float)i0[0] * s0[0], (float)i0[1] * s0[1]); w.y = cvt_pk_bf16((float)i0[2] * s0[2], (float)i0[3] * s0[3]);
                    w.z = cvt_pk_bf16((float)i1[0] * s1[0], (float)i1[1] * s1[1]); w.w = cvt_pk_bf16((float)i1[2] * s1[2], (float)i1[3] * s1[3]);
                    *(u32x4*)(rowp + bj * HALF) = w; } }
    } };
struct EpiBf16IT { static constexpr bool PERM = true; bf16_t* O; int nf; const float* tokscale; const unsigned* chmax;
    __device__ __forceinline__ void operator()(const f32x4 (&acc)[2][2][4][2], const Unit& u, int wr, int wc, int fr, int fq) const {
        const int row0 = u.pm * BM + wr * 64 + fr, col0 = u.pn * BM + wc * 32 + 8 * fq;
        float rsc[8]; f32x4 cs[2][2];
#pragma unroll
        for (int q = 0; q < 8; ++q) rsc[q] = __uint_as_float(chmax[row0 + (q >> 2) * HALF + (q & 3) * 16]) * (1.f / 127.f);
#pragma unroll
        for (int bj = 0; bj < 2; ++bj)
#pragma unroll
            for (int n = 0; n < 2; ++n) cs[bj][n] = *(const f32x4*)(tokscale + col0 + bj * HALF + 4 * n) * (1.f / 127.f);
#pragma unroll
        for (int ai = 0; ai < 2; ++ai)
#pragma unroll
            for (int m = 0; m < 4; ++m) { const int nidx = row0 + ai * HALF + m * 16; const float rs = rsc[ai * 4 + m];
#pragma unroll
                for (int bj = 0; bj < 2; ++bj) { const v4i_t i0 = __builtin_bit_cast(v4i_t, acc[ai][bj][m][0]), i1 = __builtin_bit_cast(v4i_t, acc[ai][bj][m][1]);
                    const f32x4 s0 = cs[bj][0] * rs, s1 = cs[bj][1] * rs; const int tok0 = col0 + bj * HALF;
                    u32x4 w; w.x = cvt_pk_bf16((float)i0[0] * s0[0], (float)i0[1] * s0[1]); w.y = cvt_pk_bf16((float)i0[2] * s0[2], (float)i0[3] * s0[3]);
                    w.z = cvt_pk_bf16((float)i1[0] * s1[0], (float)i1[1] * s1[1]); w.w = cvt_pk_bf16((float)i1[2] * s1[2], (float)i1[3] * s1[3]);
                    *(u32x4*)(O + ((size_t)(tok0 >> 4) * nf + nidx) * 16 + (tok0 & 8)) = w; } }
    } };
struct EpiBf16 { static constexpr bool PERM = true; bf16_t* O; int ldc;
    __device__ __forceinline__ void operator()(const f32x4 (&acc)[2][2][4][2], const Unit& u, int wr, int wc, int fr, int fq) const {
        const int row0 = u.pm * BM + wr * 64 + fr, col0 = u.pn * BM + wc * 32 + 8 * fq;
#pragma unroll
        for (int ai = 0; ai < 2; ++ai)
#pragma unroll
            for (int m = 0; m < 4; ++m) { bf16_t* rowp = O + (size_t)(row0 + ai * HALF + m * 16) * ldc + col0;
#pragma unroll
                for (int bj = 0; bj < 2; ++bj) { const f32x4 v0 = acc[ai][bj][m][0], v1 = acc[ai][bj][m][1];
                    u32x4 w; w.x = cvt_pk_bf16(v0[0], v0[1]); w.y = cvt_pk_bf16(v0[2], v0[3]); w.z = cvt_pk_bf16(v1[0], v1[1]); w.w = cvt_pk_bf16(v1[2], v1[3]);
                    *(u32x4*)(rowp + bj * HALF) = w; } }
    } };
template <bool XF32> struct EpiResid { static constexpr bool PERM = true; const void* __restrict__ X; bf16_t* __restrict__ O;
    __device__ __forceinline__ void operator()(const f32x4 (&acc)[2][2][4][2], const Unit& u, int wr, int wc, int fr, int fq) const {
        const int row0 = u.pm * BM + wr * 64 + fr, col0 = u.pn * BM + wc * 32 + 8 * fq;
        if constexpr (XF32) {
#pragma unroll
            for (int ai = 0; ai < 2; ++ai)
#pragma unroll
                for (int mp = 0; mp < 2; ++mp) { f32x4 x[2][2][2];
#pragma unroll
                    for (int mm = 0; mm < 2; ++mm)
#pragma unroll
                        for (int bj = 0; bj < 2; ++bj) { const float* xp = (const float*)X + (size_t)(row0 + ai * HALF + (mp * 2 + mm) * 16) * DM + col0 + bj * HALF; x[mm][bj][0] = *(const f32x4*)xp; x[mm][bj][1] = *(const f32x4*)(xp + 4); }
#pragma unroll
                    for (int mm = 0; mm < 2; ++mm)
#pragma unroll
                        for (int bj = 0; bj < 2; ++bj) { const f32x4 v0 = x[mm][bj][0] + acc[ai][bj][mp * 2 + mm][0], v1 = x[mm][bj][1] + acc[ai][bj][mp * 2 + mm][1];
                            u32x4 w; w.x = cvt_pk_bf16(v0[0], v0[1]); w.y = cvt_pk_bf16(v0[2], v0[3]); w.z = cvt_pk_bf16(v1[0], v1[1]); w.w = cvt_pk_bf16(v1[2], v1[3]);
                            *(u32x4*)(O + (size_t)(row0 + ai * HALF + (mp * 2 + mm) * 16) * DM + col0 + bj * HALF) = w; } }
        } else {
#pragma unroll
            for (int ai = 0; ai < 2; ++ai) { u32x4 x[4][2];
#pragma unroll
                for (int m = 0; m < 4; ++m)
#pragma unroll
                    for (int bj = 0; bj < 2; ++bj) x[m][bj] = *(const u32x4*)((const bf16_t*)X + (size_t)(row0 + ai * HALF + m * 16) * DM + col0 + bj * HALF);
#pragma unroll
                for (int m = 0; m < 4; ++m)
#pragma unroll
                    for (int bj = 0; bj < 2; ++bj) { const u32x4 o = x[m][bj];
                        const f32x4 v0 = (f32x4){__uint_as_float(o.x << 16), __uint_as_float(o.x & 0xffff0000u), __uint_as_float(o.y << 16), __uint_as_float(o.y & 0xffff0000u)} + acc[ai][bj][m][0];
                        const f32x4 v1 = (f32x4){__uint_as_float(o.z << 16), __uint_as_float(o.z & 0xffff0000u), __uint_as_float(o.w << 16), __uint_as_float(o.w & 0xffff0000u)} + acc[ai][bj][m][1];
                        u32x4 w; w.x = cvt_pk_bf16(v0[0], v0[1]); w.y = cvt_pk_bf16(v0[2], v0[3]); w.z = cvt_pk_bf16(v1[0], v1[1]); w.w = cvt_pk_bf16(v1[2], v1[3]);
                        *(u32x4*)(O + (size_t)(row0 + ai * HALF + m * 16) * DM + col0 + bj * HALF) = w; } }
        }
    } };
struct EpiSwiGLU { static constexpr bool PERM = true; bf16_t* H; const float* tscale;
    __device__ __forceinline__ void operator()(const f32x4 (&acc)[2][2][4][2], const Unit& u, int wr, int wc, int fr, int fq) const {
        const int row0 = u.pm * BM + wr * 64 + fr, col0 = u.pn * HALF + wc * 32 + 8 * fq;
        const float s0 = tscale[2 * u.pm], s1 = tscale[2 * u.pm + 1];
#pragma unroll
        for (int ai = 0; ai < 2; ++ai)
#pragma unroll
            for (int m = 0; m < 4; ++m) { float h[8];
#pragma unroll
                for (int n = 0; n < 2; ++n) { const v4i_t gi = __builtin_bit_cast(v4i_t, acc[ai][0][m][n]), ui = __builtin_bit_cast(v4i_t, acc[ai][1][m][n]);
#pragma unroll
                    for (int j = 0; j < 4; ++j) { const float g = (float)gi[j] * s0; h[n * 4 + j] = g * __builtin_amdgcn_rcpf(1.f + __expf(-g)) * ((float)ui[j] * s1); } }
                u32x4 w; w.x = cvt_pk_bf16(h[0], h[1]); w.y = cvt_pk_bf16(h[2], h[3]); w.z = cvt_pk_bf16(h[4], h[5]); w.w = cvt_pk_bf16(h[6], h[7]);
                *(u32x4*)(H + (size_t)(row0 + ai * HALF + m * 16) * FF + col0) = w; }
    } };
struct EpiDown { static constexpr bool PERM = true; bf16_t* Y; const int* row_tok; const int* row_slot; const float* row_gate;
    __device__ __forceinline__ void operator()(const f32x4 (&acc)[2][2][4][2], const Unit& u, int wr, int wc, int fr, int fq) const {
        const int row0 = u.pm * BM + wr * 64 + fr, col0 = u.pn * BM + wc * 32 + 8 * fq;
        int tk[8], sl[8]; float gt[8];
#pragma unroll
        for (int q = 0; q < 8; ++q) { const int r = row0 + (q >> 2) * HALF + (q & 3) * 16; tk[q] = row_tok[r]; sl[q] = row_slot[r]; gt[q] = row_gate[r]; }
#pragma unroll
        for (int ai = 0; ai < 2; ++ai)
#pragma unroll
            for (int m = 0; m < 4; ++m) { const int q = ai * 4 + m;
                if (tk[q] < 0) continue;
                bf16_t* rowp = Y + (size_t)sl[q] * DM + col0;
#pragma unroll
                for (int bj = 0; bj < 2; ++bj) { const f32x4 v0 = acc[ai][bj][m][0] * gt[q], v1 = acc[ai][bj][m][1] * gt[q];
                    u32x4 w; w.x = cvt_pk_bf16(v0[0], v0[1]); w.y = cvt_pk_bf16(v0[2], v0[3]); w.z = cvt_pk_bf16(v1[0], v1[1]); w.w = cvt_pk_bf16(v1[2], v1[3]);
                    *(u32x4*)(rowp + bj * HALF) = w; } }
    } };

template <class Epi, class Sched, bool I8 = false>
__device__ __forceinline__ void gemm_phase(LAS unsigned char* lds, const char* A, const unsigned lda_b, const int K, const Sched& S, const Epi& E) {
    const int tid = threadIdx.x, wid = __builtin_amdgcn_readfirstlane(tid >> 6), lane = tid & 63, wr = wid >> 2, wc = wid & 3, fr = lane & 15, fq = lane >> 4;
    const int nt = K / BK;
    unsigned voffB[2];
#pragma unroll
    for (int i = 0; i < 2; ++i) { int R, C; stage_rc(tid * 16 + i * 8192, R, C); const int Rb = Epi::PERM ? ((R & ~31) + perm32(R & 31)) : R; voffB[i] = (unsigned)(Rb * K + C) * 2u; }
    const size_t kstep = (size_t)(BK * 2);
    const size_t hstepB = (size_t)HALF * K * 2;
    const unsigned ldsw = (unsigned)wid * 1024u;
    const int aoff = lds_byte(wr * 64 + fr, fq * 8), boff = lds_byte(wc * 32 + fr, fq * 8);
#define PG8_SA(b, h) (((b) * 2 + (h)) * HTB)
#define PG8_SB(b, h) ((4 + (b) * 2 + (h)) * HTB)
#define PG8_STAGE(bufoff, gbase, voff) do { _Pragma("unroll") for (int _i = 0; _i < 2; ++_i) \
        __builtin_amdgcn_global_load_lds((const unsigned*)((const char*)(gbase) + (voff)[_i]), (LAS unsigned*)(lds + (bufoff) + ldsw + _i * 8192), 16, 0, 0); } while (0)
#define PG8_LDA(dst, b, h) do { _Pragma("unroll") for (int m = 0; m < 4; ++m) _Pragma("unroll") for (int k = 0; k < 2; ++k) dst[m][k] = *(const LAS bf16x8*)(lds + PG8_SA(b, h) + aoff + m * 2048 + k * 1024); } while (0)
#define PG8_LDB(dst, b, h) do { _Pragma("unroll") for (int n = 0; n < 2; ++n) _Pragma("unroll") for (int k = 0; k < 2; ++k) dst[n][k] = *(const LAS bf16x8*)(lds + PG8_SB(b, h) + boff + n * 2048 + k * 1024); } while (0)
#define PG8_MMA(ai, bj, At, Bt) do { __builtin_amdgcn_s_setprio(1); _Pragma("unroll") for (int m = 0; m < 4; ++m) _Pragma("unroll") for (int n = 0; n < 2; ++n) _Pragma("unroll") for (int k = 0; k < 2; ++k) { \
        if constexpr (I8) acc[ai][bj][m][n] = __builtin_bit_cast(f32x4, __builtin_amdgcn_mfma_i32_16x16x64_i8(__builtin_bit_cast(v4i_t, Bt[n][k]), __builtin_bit_cast(v4i_t, At[m][k]), __builtin_bit_cast(v4i_t, acc[ai][bj][m][n]), 0, 0, 0)); \
        else acc[ai][bj][m][n] = __builtin_amdgcn_mfma_f32_16x16x32_bf16(Bt[n][k], At[m][k], acc[ai][bj][m][n], 0, 0, 0); } __builtin_amdgcn_s_setprio(0); } while (0)
#define PG8_WAIT_V(n) asm volatile("s_waitcnt vmcnt(" #n ")" ::: "memory")
#define PG8_WAIT_L(n) asm volatile("s_waitcnt lgkmcnt(" #n ")" ::: "memory")
#define PG8_BAR __builtin_amdgcn_s_barrier()
#define PG8_SCHED __builtin_amdgcn_sched_barrier(0)
#define PG8_AOFF(dst, u) do { int _tz = threadIdx.x; asm volatile("" : "+v"(_tz)); _Pragma("unroll") for (int _i = 0; _i < 2; ++_i) { int _R, _C; stage_rc(_tz * 16 + _i * 8192, _R, _C); \
        _Pragma("unroll") for (int _h = 0; _h < 2; ++_h) dst[_h][_i] = (unsigned)S.arow(u, _h * HALF + _R) * lda_b + (unsigned)_C * 2u; } } while (0)
    Unit cur, nxt; int ui = 0;
    if (!S.next(0, cur)) return;
    f32x4 acc[2][2][4][2];
#pragma unroll
    for (int a = 0; a < 2; ++a)
#pragma unroll
        for (int b = 0; b < 2; ++b)
#pragma unroll
            for (int m = 0; m < 4; ++m)
#pragma unroll
                for (int n = 0; n < 2; ++n) acc[a][b][m][n] = (f32x4){0.f, 0.f, 0.f, 0.f};
    bf16x8 At[4][2], B0[2][2], B1[2][2];
    unsigned vA[2][2], vAn[2][2];
    PG8_AOFF(vA, cur);
    const char* cB = cur.B;
    PG8_STAGE(PG8_SB(0, 0), cB, voffB); PG8_STAGE(PG8_SA(0, 0), A, vA[0]); PG8_STAGE(PG8_SB(0, 1), cB + hstepB, voffB); PG8_STAGE(PG8_SA(0, 1), A, vA[1]);
    if (wr == 1) PG8_BAR;
    PG8_WAIT_V(4); PG8_BAR;
    PG8_STAGE(PG8_SB(1, 0), cB + kstep, voffB); PG8_STAGE(PG8_SA(1, 0), A + kstep, vA[0]); PG8_STAGE(PG8_SB(1, 1), cB + hstepB + kstep, voffB);
    PG8_WAIT_V(6); PG8_BAR;
    for (;;) {
        const bool has_next = S.next(ui + 1, nxt);
        if (has_next) { PG8_AOFF(vAn, nxt); } else {
#pragma unroll
            for (int h = 0; h < 2; ++h)
#pragma unroll
                for (int i = 0; i < 2; ++i) vAn[h][i] = vA[h][i]; }
        const char* nB = has_next ? nxt.B : cB;
        for (int t = 0; t < nt; t += 2) {
            const bool last = (t == nt - 2);
            const char* a1 = A + (size_t)(t + 1) * kstep;
            const char* a2 = last ? A : A + (size_t)(t + 2) * kstep; const char* b2 = last ? nB : cB + (size_t)(t + 2) * kstep;
            const char* a3 = a2 + kstep; const char* b3 = b2 + kstep;
            unsigned o2[2][2];
#pragma unroll
            for (int h = 0; h < 2; ++h)
#pragma unroll
                for (int i = 0; i < 2; ++i) o2[h][i] = last ? vAn[h][i] : vA[h][i];
            PG8_LDB(B0, 0, 0); PG8_SCHED; PG8_LDA(At, 0, 0); PG8_STAGE(PG8_SA(1, 1), a1, vA[1]);
            PG8_WAIT_L(8); PG8_BAR; PG8_WAIT_L(0); PG8_MMA(0, 0, At, B0); PG8_BAR; PG8_SCHED;
            PG8_LDB(B1, 0, 1); PG8_STAGE(PG8_SB(0, 0), b2, voffB);
            PG8_BAR; PG8_WAIT_L(0); PG8_MMA(0, 1, At, B1); PG8_BAR;
            PG8_LDA(At, 0, 1); PG8_STAGE(PG8_SA(0, 0), a2, o2[0]);
            PG8_BAR; PG8_WAIT_L(0); PG8_MMA(1, 0, At, B0); PG8_BAR; PG8_SCHED;
            PG8_STAGE(PG8_SB(0, 1), b2 + hstepB, voffB);
            PG8_WAIT_V(6); PG8_BAR; PG8_MMA(1, 1, At, B1); PG8_BAR;
            PG8_LDB(B0, 1, 0); PG8_SCHED; PG8_LDA(At, 1, 0); PG8_STAGE(PG8_SA(0, 1), a2, o2[1]);
            PG8_WAIT_L(8); PG8_BAR; PG8_WAIT_L(0); PG8_MMA(0, 0, At, B0); PG8_BAR; PG8_SCHED;
            PG8_LDB(B1, 1, 1); PG8_STAGE(PG8_SB(1, 0), b3, voffB);
            PG8_BAR; PG8_WAIT_L(0); PG8_MMA(0, 1, At, B1); PG8_BAR;
            PG8_LDA(At, 1, 1); PG8_STAGE(PG8_SA(1, 0), a3, o2[0]);
            PG8_BAR; PG8_WAIT_L(0); PG8_MMA(1, 0, At, B0); PG8_BAR; PG8_SCHED;
            PG8_STAGE(PG8_SB(1, 1), b3 + hstepB, voffB);
            PG8_WAIT_V(6); PG8_BAR; PG8_MMA(1, 1, At, B1); PG8_BAR;
        }
        E(acc, cur, wr, wc, fr, fq);
        if (!has_next) break;
#pragma unroll
        for (int a = 0; a < 2; ++a)
#pragma unroll
            for (int b = 0; b < 2; ++b)
#pragma unroll
                for (int m = 0; m < 4; ++m)
#pragma unroll
                    for (int n = 0; n < 2; ++n) acc[a][b][m][n] = (f32x4){0.f, 0.f, 0.f, 0.f};
        cur = nxt; cB = nB; ++ui;
#pragma unroll
        for (int h = 0; h < 2; ++h)
#pragma unroll
            for (int i = 0; i < 2; ++i) vA[h][i] = vAn[h][i];
    }
    PG8_WAIT_V(0);
    if (wr == 0) PG8_BAR;
    PG8_BAR;
#undef PG8_SA
#undef PG8_SB
#undef PG8_STAGE
#undef PG8_LDA
#undef PG8_LDB
#undef PG8_MMA
#undef PG8_WAIT_V
#undef PG8_WAIT_L
#undef PG8_BAR
#undef PG8_SCHED
#undef PG8_AOFF
}
}

template <int MODE>
__device__ __forceinline__ void transpose_item(const float* W, int K, int N, bf16_t* WT, LAS float* scr, int item, int lane) {
    const int nblk = N / 64, kb = item / nblk, nb = item % nblk, k0 = 64 * kb, n0 = 64 * nb;
    const int lr = lane >> 4, lc = (lane & 15) * 4;
    float4 v[16];
#pragma unroll
    for (int i = 0; i < 16; ++i) v[i] = *(const float4*)(W + (size_t)(k0 + 4 * i + lr) * N + n0 + lc);
#pragma unroll
    for (int i = 0; i < 16; ++i) { LAS float* d = scr + (4 * i + lr) * 66 + lc; *(LAS f32x2_hw*)d = (f32x2_hw){v[i].x, v[i].y}; *(LAS f32x2_hw*)(d + 2) = (f32x2_hw){v[i].z, v[i].w}; }
    asm volatile("s_waitcnt lgkmcnt(0)" ::: "memory");
    const int c = lane & 7;
#pragma unroll
    for (int j = 0; j < 8; ++j) { const int n = (lane >> 3) + 8 * j; const LAS float* sp = scr + (8 * c) * 66 + n;
        pg8::u32x4 o; o.x = pk2(sp[0 * 66], sp[1 * 66]); o.y = pk2(sp[2 * 66], sp[3 * 66]); o.z = pk2(sp[4 * 66], sp[5 * 66]); o.w = pk2(sp[6 * 66], sp[7 * 66]);
        const int nn = n0 + n; const int dr = MODE == 0 ? nn : (256 * (nn >> 7) + (nn & 127) + (MODE == 2 ? 128 : 0));
        *(pg8::u32x4*)(WT + (size_t)dr * K + k0 + 8 * c) = o; }
    asm volatile("s_waitcnt lgkmcnt(0)" ::: "memory");
}
__device__ __forceinline__ float wave_max(float v) {
    v = fmaxf(v, dpp_<0xB1>(v)); v = fmaxf(v, dpp_<0x4E>(v)); v = fmaxf(v, dpp_<0x124>(v)); v = fmaxf(v, dpp_<0x128>(v));
    auto s = __builtin_amdgcn_permlane16_swap(__float_as_uint(v), __float_as_uint(v), false, false); v = fmaxf(__uint_as_float(s[0]), __uint_as_float(s[1]));
    auto t = __builtin_amdgcn_permlane32_swap(__float_as_uint(v), __float_as_uint(v), false, false); return fmaxf(__uint_as_float(t[0]), __uint_as_float(t[1])); }
__device__ __forceinline__ unsigned q8x4(float a, float b, float c, float d, float qs) {
    const int ia = (int)rintf(fminf(fmaxf(a * qs, -127.f), 127.f)), ib = (int)rintf(fminf(fmaxf(b * qs, -127.f), 127.f)), ic = (int)rintf(fminf(fmaxf(c * qs, -127.f), 127.f)), id = (int)rintf(fminf(fmaxf(d * qs, -127.f), 127.f));
    return (unsigned)(ia & 255) | ((unsigned)(ib & 255) << 8) | ((unsigned)(ic & 255) << 16) | ((unsigned)(id & 255) << 24); }
__device__ __noinline__ void ph_wmax(const float* wg, const float* wu, unsigned* wmax, int bid, int nblk) {
    const int wave = threadIdx.x >> 6, lane = threadIdx.x & 63, gw = bid * 8 + wave, NGW = nblk * 8;
    constexpr int IT = (DM / 64) * (FF / 64);
    for (int it = gw; it < 2 * NEXP * 2 * IT; it += NGW) { const int mat = it / IT, tl = it % IT; const int le = mat >> 1, gu = mat & 1;
        const float* W = (gu ? wu : wg) + (size_t)le * DM * FF; const int k0 = 64 * (tl / (FF / 64)), n0 = 64 * (tl % (FF / 64));
        float m = 0.f;
#pragma unroll 4
        for (int i = 0; i < 16; ++i) { const float4 v = *(const float4*)(W + (size_t)(k0 + 4 * i + (lane >> 4)) * FF + n0 + (lane & 15) * 4); m = fmaxf(fmaxf(m, fmaxf(fabsf(v.x), fabsf(v.y))), fmaxf(fabsf(v.z), fabsf(v.w))); }
        m = wave_max(m);
        if (lane == 0) atomicMax(wmax + le * 2 + gu, __float_as_uint(m)); }
}
template <int MODE>
__device__ __forceinline__ void transpose_item_i8(const float* W, int K, int N, unsigned char* WT, LAS float* scr, int item, int lane, float qs) {
    const int nblk = N / 64, kb = item / nblk, nb = item % nblk, k0 = 64 * kb, n0 = 64 * nb;
    const int lr = lane >> 4, lc = (lane & 15) * 4;
    float4 v[16];
#pragma unroll
    for (int i = 0; i < 16; ++i) v[i] = *(const float4*)(W + (size_t)(k0 + 4 * i + lr) * N + n0 + lc);
#pragma unroll
    for (int i = 0; i < 16; ++i) { LAS float* d = scr + (4 * i + lr) * 66 + lc; *(LAS f32x2_hw*)d = (f32x2_hw){v[i].x, v[i].y}; *(LAS f32x2_hw*)(d + 2) = (f32x2_hw){v[i].z, v[i].w}; }
    asm volatile("s_waitcnt lgkmcnt(0)" ::: "memory");
    const int c = lane & 3;
#pragma unroll
    for (int j = 0; j < 4; ++j) { const int n = (lane >> 2) + 16 * j; const LAS float* sp = scr + (16 * c) * 66 + n;
        pg8::u32x4 o;
        o.x = q8x4(sp[0 * 66], sp[1 * 66], sp[2 * 66], sp[3 * 66], qs); o.y = q8x4(sp[4 * 66], sp[5 * 66], sp[6 * 66], sp[7 * 66], qs);
        o.z = q8x4(sp[8 * 66], sp[9 * 66], sp[10 * 66], sp[11 * 66], qs); o.w = q8x4(sp[12 * 66], sp[13 * 66], sp[14 * 66], sp[15 * 66], qs);
        const int nn = n0 + n; const int dr = MODE == 0 ? nn : (256 * (nn >> 7) + (nn & 127) + (MODE == 2 ? 128 : 0));
        *(pg8::u32x4*)(WT + (size_t)dr * K + k0 + 16 * c) = o; }
    asm volatile("s_waitcnt lgkmcnt(0)" ::: "memory");
}
__device__ __forceinline__ void transpose_item_i8c(const float* W, int K, int N, unsigned char* WT, LAS float* scr, int item, int lane, const unsigned* colmax) {
    const int nblk = N / 64, kb = item / nblk, nb = item % nblk, k0 = 64 * kb, n0 = 64 * nb;
    const int lr = lane >> 4, lc = (lane & 15) * 4;
    float4 v[16];
#pragma unroll
    for (int i = 0; i < 16; ++i) v[i] = *(const float4*)(W + (size_t)(k0 + 4 * i + lr) * N + n0 + lc);
#pragma unroll
    for (int i = 0; i < 16; ++i) { LAS float* d = scr + (4 * i + lr) * 66 + lc; *(LAS f32x2_hw*)d = (f32x2_hw){v[i].x, v[i].y}; *(LAS f32x2_hw*)(d + 2) = (f32x2_hw){v[i].z, v[i].w}; }
    asm volatile("s_waitcnt lgkmcnt(0)" ::: "memory");
    const int c = lane & 3;
#pragma unroll
    for (int j = 0; j < 4; ++j) { const int n = (lane >> 2) + 16 * j; const LAS float* sp = scr + (16 * c) * 66 + n;
        const float qs = 127.f / fmaxf(__uint_as_float(colmax[n0 + n]), 1e-30f);
        pg8::u32x4 o;
        o.x = q8x4(sp[0 * 66], sp[1 * 66], sp[2 * 66], sp[3 * 66], qs); o.y = q8x4(sp[4 * 66], sp[5 * 66], sp[6 * 66], sp[7 * 66], qs);
        o.z = q8x4(sp[8 * 66], sp[9 * 66], sp[10 * 66], sp[11 * 66], qs); o.w = q8x4(sp[12 * 66], sp[13 * 66], sp[14 * 66], sp[15 * 66], qs);
        *(pg8::u32x4*)(WT + (size_t)(n0 + n) * K + k0 + 16 * c) = o; }
    asm volatile("s_waitcnt lgkmcnt(0)" ::: "memory");
}
__device__ __forceinline__ void frag_build(const float* W, int ldw, int col0, int nks, bf16_t* dst, int lane) {
    const int q4 = lane >> 4, c16 = lane & 15;
    for (int ct = 0; ct < 4; ++ct) for (int ks = 0; ks < nks; ++ks) { float v[8];
#pragma unroll
        for (int jj = 0; jj < 8; ++jj) v[jj] = W[(size_t)(32 * ks + 8 * q4 + jj) * ldw + col0 + 16 * ct + c16];
        *(pg8::u32x4*)(dst + ((size_t)(ct * nks + ks) * 64 + lane) * 8) = (pg8::u32x4){pk2(v[0], v[1]), pk2(v[2], v[3]), pk2(v[4], v[5]), pk2(v[6], v[7])}; }
}
__device__ __forceinline__ void ph_cvt_frags(const Args& a) {
    const int wave = threadIdx.x >> 6, lane = threadIdx.x & 63, gw = blockIdx.x * 8 + wave;
    if (gw >= 40) {
        const int it = gw - 40; if (it >= 64) return;
        const int L = it >> 5, ks = it & 31, q4 = lane >> 4, c16 = lane & 15;
        const float* gain = a.in[2] + L * DM; const float* wg = a.in[28] + (size_t)L * DM * 4; const float* we = a.in[30] + (size_t)L * DM * 32;
        bf16_t* dh = (bf16_t*)(a.ws + FG_RT) + (size_t)L * 2 * 49152; bf16_t* dl = dh + 49152;
        for (int ct = 0; ct < 3; ++ct) { const int col = 16 * ct + c16; float hi[8], lo[8];
#pragma unroll
            for (int jj = 0; jj < 8; ++jj) { const int k = 32 * ks + 8 * q4 + jj; const float w = col < 4 ? wg[k * 4 + col] : (col < 36 ? we[k * 32 + col - 4] : 0.f); const float v = gain[k] * w;
                hi[jj] = bf2f(f2bf(v)); lo[jj] = v - hi[jj]; }
            const size_t o = ((size_t)(ks * 3 + ct) * 64 + lane) * 8;
            *(pg8::u32x4*)(dh + o) = (pg8::u32x4){pk2(hi[0], hi[1]), pk2(hi[2], hi[3]), pk2(hi[4], hi[5]), pk2(hi[6], hi[7])};
            *(pg8::u32x4*)(dl + o) = (pg8::u32x4){pk2(lo[0], lo[1]), pk2(lo[2], lo[3]), pk2(lo[4], lo[5]), pk2(lo[6], lo[7])}; }
        return; }
    const int arr = gw >> 3, h = gw & 7;
    if (arr == 0) frag_build(a.in[7], 512, 64 * h, 2, (bf16_t*)(a.ws + FG_W2) + h * 4096, lane);
    else if (arr == 1) frag_build(a.in[9], 512, 64 * h, 2, (bf16_t*)(a.ws + FG_A2) + h * 4096, lane);
    else if (arr == 2) frag_build(a.in[18] + h * 4096, 64, 0, 2, (bf16_t*)(a.ws + FG_WA) + h * 4096, lane);
    else if (arr == 3) frag_build(a.in[20] + h * 4096, 64, 0, 2, (bf16_t*)(a.ws + FG_WX) + h * 4096, lane);
    else frag_build(a.in[10], 512, 64 * h, 4, (bf16_t*)(a.ws + FG_G2) + h * 8192, lane);
}
__device__ __forceinline__ void ph_cvt_dense_a(const Args& a, LAS float* lds, unsigned* colmax) {
    const int wave = threadIdx.x >> 6, lane = threadIdx.x & 63, gw = blockIdx.x * 8 + wave, NGW = gridDim.x * 8;
    LAS float* scr = lds + wave * (64 * 66);
    constexpr int I0 = (DM / 64) * (ABC / 64), I1 = (DM / 64) * (DM / 64), I2 = (DM / 64) * (4096 / 64), I3 = I1;
    for (int it = gw; it < I0 + I1 + I2 + I3; it += NGW) { int r = it;
        if (r < I1) { transpose_item<0>(a.in[23], DM, DM, (bf16_t*)(a.ws + WD_ABOUT), scr, r, lane); continue; } r -= I1;
        if (r < I3) { transpose_item<0>(a.in[27], DM, DM, (bf16_t*)(a.ws + WD_COUT), scr, r, lane); continue; } r -= I3;
        const int m = r < I0 ? 0 : 1; if (m) r -= I0; const int N = m ? 4096 : ABC; const float* W = m ? a.in[24] : a.in[4];
        const int k0 = 64 * (r / (N / 64)), n0 = 64 * (r % (N / 64)); float mx[4] = {0.f, 0.f, 0.f, 0.f};
#pragma unroll 4
        for (int i = 0; i < 16; ++i) { const float4 v = *(const float4*)(W + (size_t)(k0 + 4 * i + (lane >> 4)) * N + n0 + (lane & 15) * 4);
            mx[0] = fmaxf(mx[0], fabsf(v.x)); mx[1] = fmaxf(mx[1], fabsf(v.y)); mx[2] = fmaxf(mx[2], fabsf(v.z)); mx[3] = fmaxf(mx[3], fabsf(v.w)); }
#pragma unroll
        for (int q = 0; q < 4; ++q) { float t = mx[q];
            auto s1 = __builtin_amdgcn_permlane16_swap(__float_as_uint(t), __float_as_uint(t), false, false); t = fmaxf(__uint_as_float(s1[0]), __uint_as_float(s1[1]));
            auto s2 = __builtin_amdgcn_permlane32_swap(__float_as_uint(t), __float_as_uint(t), false, false); t = fmaxf(__uint_as_float(s2[0]), __uint_as_float(s2[1]));
            if (lane < 16) atomicMax(colmax + (m ? ABC : 0) + n0 + lane * 4 + q, __float_as_uint(t)); } }
}
__device__ __forceinline__ void ph_cvt_dense_b(const Args& a, LAS float* lds, const unsigned* colmax, int m) {
    const int wave = threadIdx.x >> 6, lane = threadIdx.x & 63, gw = blockIdx.x * 8 + wave, NGW = gridDim.x * 8;
    LAS float* scr = lds + wave * (64 * 66);
    const int N = m ? 4096 : ABC; const int NI = (DM / 64) * (N / 64);
    for (int it = gw; it < NI; it += NGW) transpose_item_i8c(m ? a.in[24] : a.in[4], DM, N, a.ws + (m ? WD_CIN : WD_ABIN), scr, it, lane, colmax + (m ? ABC : 0));
}
__device__ __forceinline__ void ph_cvt_moe(const Args& a, int L, LAS float* lds, int bid, int nblk, int which) {
    const int wave = threadIdx.x >> 6, lane = threadIdx.x & 63, gw = bid * 8 + wave, NGW = nblk * 8;
    LAS float* scr = lds + wave * (64 * 66);
    constexpr int IG = (DM / 64) * (FF / 64), ID = (FF / 64) * (DM / 64);
    const int i0 = (which & 1) ? 0 : 2 * IG, IE = ((which & 1) ? 2 * IG : 0) + ((which & 2) ? ID : 0);
    unsigned char* gub = a.ws + (L ? WM_GU1 : WM_GU);
    for (int it = gw; it < NEXP * IE; it += NGW) { const int e = it / IE; int r = i0 + it % IE;
        unsigned char* gu = gub + (size_t)e * DM * DM; bf16_t* dn = (bf16_t*)(a.ws + WM_DN) + (size_t)e * DM * FF;
        const unsigned* wm = (const unsigned*)(a.ws + WS_CTL) + CW_WMAX + (L * NEXP + e) * 2;
        const size_t wo = ((size_t)L * NEXP + e) * DM * FF;
        if (r < IG) { transpose_item_i8<1>(a.in[32] + wo, DM, FF, gu, scr, r, lane, 127.f / fmaxf(__uint_as_float(wm[0]), 1e-30f)); continue; } r -= IG;
        if (r < IG) { transpose_item_i8<2>(a.in[33] + wo, DM, FF, gu, scr, r, lane, 127.f / fmaxf(__uint_as_float(wm[1]), 1e-30f)); continue; } r -= IG;
        transpose_item<0>(a.in[34] + wo, FF, DM, dn, scr, r, lane); }
}

__device__ __forceinline__ void load_row16(const float* row, int lane, float4 (&v)[4]) {
#pragma unroll
    for (int j = 0; j < 4; ++j) v[j] = *(const float4*)(row + lane * 4 + 256 * j);
}
__device__ __forceinline__ float row_sumsq(const float4 (&v)[4]) {
    float s = 0.f;
#pragma unroll
    for (int j = 0; j < 4; ++j) s += v[j].x * v[j].x + v[j].y * v[j].y + v[j].z * v[j].z + v[j].w * v[j].w;
    return wave_sum(s);
}
__device__ __forceinline__ void norm_row(float4 (&v)[4], const float* gain, int lane) {
    const float rs = rsqrtf(row_sumsq(v) * (1.f / DM) + 1e-6f);
#pragma unroll
    for (int j = 0; j < 4; ++j) { const float4 g = *(const float4*)(gain + lane * 4 + 256 * j);
        v[j].x *= rs * g.x; v[j].y *= rs * g.y; v[j].z *= rs * g.z; v[j].w *= rs * g.w; }
}
__device__ __forceinline__ void store_row_bf16(bf16_t* row, int lane, const float4 (&v)[4]) {
#pragma unroll
    for (int j = 0; j < 4; ++j) { uint2 o; o.x = f2bf(v[j].x) | ((unsigned)f2bf(v[j].y) << 16); o.y = f2bf(v[j].z) | ((unsigned)f2bf(v[j].w) << 16);
        *(uint2*)(row + lane * 4 + 256 * j) = o; }
}
__device__ __forceinline__ void add_row_bf16(const bf16_t* row, int lane, float4 (&v)[4]) {
#pragma unroll
    for (int j = 0; j < 4; ++j) { const uint2 o = *(const uint2*)(row + lane * 4 + 256 * j);
        v[j].x += __uint_as_float(o.x << 16); v[j].y += __uint_as_float(o.x & 0xffff0000u); v[j].z += __uint_as_float(o.y << 16); v[j].w += __uint_as_float(o.y & 0xffff0000u); }
}

__device__ __forceinline__ void ph_norm0(const float* x, const float* gain, unsigned char* HN8, float* rowscale) {
    const int lane = threadIdx.x & 63, gw = blockIdx.x * 8 + (threadIdx.x >> 6), NGW = gridDim.x * 8;
    for (int n = gw; n < NTOK; n += NGW) { float4 v[4]; load_row16(x + (size_t)n * DM, lane, v); norm_row(v, gain, lane);
        float mx = 0.f;
#pragma unroll
        for (int j = 0; j < 4; ++j) mx = fmaxf(fmaxf(mx, fmaxf(fabsf(v[j].x), fabsf(v[j].y))), fmaxf(fabsf(v[j].z), fabsf(v[j].w)));
        mx = fmaxf(wave_max(mx), 1e-30f); const float qs = 127.f / mx;
        if (lane == 0) rowscale[n] = mx;
#pragma unroll
        for (int j = 0; j < 4; ++j) *(unsigned*)(HN8 + (size_t)n * DM + lane * 4 + 256 * j) = q8x4(v[j].x, v[j].y, v[j].z, v[j].w, qs); }
}
__device__ __forceinline__ void ld8bf(const bf16_t* p, float (&v)[8]) { const u32x4_t o = *(const u32x4_t*)p;
    v[0] = __uint_as_float(o.x << 16); v[1] = __uint_as_float(o.x & 0xffff0000u); v[2] = __uint_as_float(o.y << 16); v[3] = __uint_as_float(o.y & 0xffff0000u);
    v[4] = __uint_as_float(o.z << 16); v[5] = __uint_as_float(o.z & 0xffff0000u); v[6] = __uint_as_float(o.w << 16); v[7] = __uint_as_float(o.w & 0xffff0000u); }
__device__ __forceinline__ void st8bf(bf16_t* p, const float (&v)[8]) { *(u32x4_t*)p = (u32x4_t){pk2(v[0], v[1]), pk2(v[2], v[3]), pk2(v[4], v[5]), pk2(v[6], v[7])}; }
__device__ __forceinline__ void ph_combine_norm(bf16_t* XR, const bf16_t* Y, const float* gain, unsigned char* HN8, float* rowscale) {
    const int lane = threadIdx.x & 63, gw = blockIdx.x * 8 + (threadIdx.x >> 6), NGW = gridDim.x * 8;
    for (int n = gw; n < NTOK; n += NGW) { float x[2][8], y0[2][8], y1[2][8]; float ss = 0.f;
#pragma unroll
        for (int j = 0; j < 2; ++j) { const int o = lane * 8 + 512 * j; ld8bf(XR + (size_t)n * DM + o, x[j]); ld8bf(Y + (size_t)(2 * n) * DM + o, y0[j]); ld8bf(Y + (size_t)(2 * n + 1) * DM + o, y1[j]); }
#pragma unroll
        for (int j = 0; j < 2; ++j) {
#pragma unroll
            for (int i = 0; i < 8; ++i) x[j][i] = bf2f(f2bf(x[j][i] + y0[j][i] + y1[j][i]));
            st8bf(XR + (size_t)n * DM + lane * 8 + 512 * j, x[j]);
#pragma unroll
            for (int i = 0; i < 8; ++i) ss += x[j][i] * x[j][i]; }
        const float rs = rsqrtf(wave_sum(ss) * (1.f / DM) + 1e-6f);
#pragma unroll
        for (int j = 0; j < 2; ++j) { const int o = lane * 8 + 512 * j; const float4 g0 = *(const float4*)(gain + o), g1 = *(const float4*)(gain + o + 4);
            const float gg[8] = {g0.x, g0.y, g0.z, g0.w, g1.x, g1.y, g1.z, g1.w};
#pragma unroll
            for (int i = 0; i < 8; ++i) x[j][i] *= rs * gg[i]; }
        float mx = 0.f;
#pragma unroll
        for (int j = 0; j < 2; ++j)
#pragma unroll
            for (int i = 0; i < 8; ++i) mx = fmaxf(mx, fabsf(x[j][i]));
        mx = fmaxf(wave_max(mx), 1e-30f); const float qs = 127.f / mx;
        if (lane == 0) rowscale[n] = mx;
#pragma unroll
        for (int j = 0; j < 2; ++j) { const int o = lane * 8 + 512 * j;
            *(u32x2_t*)(HN8 + (size_t)n * DM + o) = (u32x2_t){q8x4(x[j][0], x[j][1], x[j][2], x[j][3], qs), q8x4(x[j][4], x[j][5], x[j][6], x[j][7], qs)}; } }
}
__device__ __forceinline__ void ph_final(const bf16_t* XR, const bf16_t* Y, const float* gain, float* out) {
    const int lane = threadIdx.x & 63, gw = blockIdx.x * 8 + (threadIdx.x >> 6), NGW = gridDim.x * 8;
    for (int n = gw; n < NTOK; n += NGW) { float x[2][8], y0[2][8], y1[2][8]; float ss = 0.f;
#pragma unroll
        for (int j = 0; j < 2; ++j) { const int o = lane * 8 + 512 * j; ld8bf(XR + (size_t)n * DM + o, x[j]); ld8bf(Y + (size_t)(2 * n) * DM + o, y0[j]); ld8bf(Y + (size_t)(2 * n + 1) * DM + o, y1[j]); }
#pragma unroll
        for (int j = 0; j < 2; ++j)
#pragma unroll
            for (int i = 0; i < 8; ++i) { x[j][i] = x[j][i] + y0[j][i] + y1[j][i]; ss += x[j][i] * x[j][i]; }
        const float rs = rsqrtf(wave_sum(ss) * (1.f / DM) + 1e-6f);
#pragma unroll
        for (int j = 0; j < 2; ++j) { const int o = lane * 8 + 512 * j; const float4 g0 = *(const float4*)(gain + o), g1 = *(const float4*)(gain + o + 4);
            *(float4*)(out + (size_t)n * DM + o) = make_float4(x[j][0] * rs * g0.x, x[j][1] * rs * g0.y, x[j][2] * rs * g0.z, x[j][3] * rs * g0.w);
            *(float4*)(out + (size_t)n * DM + o + 4) = make_float4(x[j][4] * rs * g1.x, x[j][5] * rs * g1.y, x[j][6] * rs * g1.z, x[j][7] * rs * g1.w); } }
}
__device__ __forceinline__ void ph_route(const Args& a, int Lyr, const bf16_t* XR, bf16_t* HN, float* RS, unsigned* cnt, int* asg_e, int* asg_rank, float* asg_gate, LAS float* lds) {
    const float* gain = a.in[2] + Lyr * DM; const float* bg = a.in[29] + Lyr * 4; const float* be = a.in[31] + Lyr * 32;
    const bf16_t* FRh = (const bf16_t*)(a.ws + FG_RT) + (size_t)Lyr * 2 * 49152; const bf16_t* FRl = FRh + 49152;
    const int lane = threadIdx.x & 63, wave = threadIdx.x >> 6, q4 = lane >> 4, c16 = lane & 15, r4 = lane >> 4, cidx = lane & 15;
    LAS unsigned char* Lb = (LAS unsigned char*)lds;
    LAS unsigned char* W = Lb + wave * 12288;
    LAS float* SS = (LAS float*)(W + 8704); LAS float* LG = (LAS float*)(W + 8768);
    LAS unsigned* lcnt = (LAS unsigned*)(Lb + 8 * 12288); LAS unsigned* lbase = lcnt + 32;
    const int NGW = gridDim.x * 8, gw = blockIdx.x * 8 + wave;
    for (int rnd = 0; rnd * NGW < NTOK / 16; ++rnd) {
        const int tile = rnd * NGW + gw; const bool act = tile < NTOK / 16; const int n0 = tile * 16;
        if (threadIdx.x < 32) lcnt[threadIdx.x] = 0u;
        __syncthreads();
        int e0 = 0, e1 = 0, lr0 = 0, lr1 = 0; float g0 = 0.f, g1 = 0.f;
        if (act) {
            f32x4 acc[3], accs = (f32x4){0.f, 0.f, 0.f, 0.f};
#pragma unroll
            for (int ct = 0; ct < 3; ++ct) acc[ct] = accs;
#pragma unroll 1
            for (int kc = 0; kc < 8; ++kc) {
                bf16x8_t bh[4][3], bl[4][3];
#pragma unroll
                for (int ks = 0; ks < 4; ++ks)
#pragma unroll
                    for (int ct = 0; ct < 3; ++ct) { const size_t o = ((size_t)((kc * 4 + ks) * 3 + ct) * 64 + lane) * 8; bh[ks][ct] = *(const bf16x8_t*)(FRh + o); bl[ks][ct] = *(const bf16x8_t*)(FRl + o); }
                u32x4_t xv[4];
#pragma unroll
                for (int j = 0; j < 4; ++j) xv[j] = *(const u32x4_t*)(XR + (size_t)(n0 + 4 * j + r4) * DM + kc * 128 + 8 * cidx);
                __builtin_amdgcn_sched_barrier(0);
#pragma unroll
                for (int j = 0; j < 4; ++j) *(LAS u32x4_t*)(W + (4 * j + r4) * 272 + cidx * 16) = xv[j];
#pragma unroll
                for (int ks = 0; ks < 4; ++ks) { const bf16x8_t ahi = *(const LAS bf16x8_t*)(W + c16 * 272 + ks * 64 + q4 * 16);
                    accs = __builtin_amdgcn_mfma_f32_16x16x32_bf16(ahi, ahi, accs, 0, 0, 0);
#pragma unroll
                    for (int ct = 0; ct < 3; ++ct) { acc[ct] = __builtin_amdgcn_mfma_f32_16x16x32_bf16(ahi, bh[ks][ct], acc[ct], 0, 0, 0); acc[ct] = __builtin_amdgcn_mfma_f32_16x16x32_bf16(ahi, bl[ks][ct], acc[ct], 0, 0, 0); } }
            }
#pragma unroll
            for (int r = 0; r < 4; ++r) if (c16 == 4 * q4 + r) { const float rsv = rsqrtf(accs[r] * (1.f / DM) + 1e-6f); SS[c16] = rsv; RS[n0 + c16] = rsv; }
            const f32x4 s4 = *(const LAS f32x4*)(SS + 4 * q4);
#pragma unroll
            for (int ct = 0; ct < 3; ++ct) { const int col = 16 * ct + c16; const float bias = col < 4 ? bg[col] : (col < 36 ? be[col - 4] : 0.f);
#pragma unroll
                for (int r = 0; r < 4; ++r) LG[(4 * q4 + r) * 48 + col] = acc[ct][r] * s4[r] + bias; }
            if (lane < 16) {
                const LAS float* lg = LG + lane * 48;
                int gs = 0; float gm = lg[0];
#pragma unroll
                for (int i = 1; i < 4; ++i) { const float v = lg[i]; if (v > gm) { gm = v; gs = i; } }
                float gden = 0.f;
#pragma unroll
                for (int i = 0; i < 4; ++i) gden += __expf(lg[i] - gm);
                const float ggate = 1.f / gden;
                const LAS float* l8 = lg + 4 + gs * 8;
                int i0 = 0; float m0 = l8[0];
#pragma unroll
                for (int i = 1; i < 8; ++i) { const float v = l8[i]; if (v > m0) { m0 = v; i0 = i; } }
                int i1 = (i0 == 0) ? 1 : 0; float m1 = l8[i1];
#pragma unroll
                for (int i = 0; i < 8; ++i) { const float v = l8[i]; if (i != i0 && v > m1) { m1 = v; i1 = i; } }
                const float ex = __expf(m1 - m0);
                g0 = ggate / (1.f + ex); g1 = ggate * ex / (1.f + ex);
                e0 = gs * 8 + i0; e1 = gs * 8 + i1;
                lr0 = (int)__hip_atomic_fetch_add(lcnt + e0, 1u, __ATOMIC_RELAXED, __HIP_MEMORY_SCOPE_WORKGROUP); lr1 = (int)__hip_atomic_fetch_add(lcnt + e1, 1u, __ATOMIC_RELAXED, __HIP_MEMORY_SCOPE_WORKGROUP);
            }
        }
        __syncthreads();
        if (threadIdx.x < 32) { const unsigned c = lcnt[threadIdx.x]; lbase[threadIdx.x] = c ? atomicAdd(&cnt[threadIdx.x], c) : 0u; }
        __syncthreads();
        if (act) {
            if (lane < 16) { const int n = n0 + lane;
                asg_e[2 * n] = e0; asg_e[2 * n + 1] = e1; asg_rank[2 * n] = (int)lbase[e0] + lr0; asg_rank[2 * n + 1] = (int)lbase[e1] + lr1; asg_gate[2 * n] = g0; asg_gate[2 * n + 1] = g1; }
            unsigned char* H8 = (unsigned char*)HN;
            float rsr[4];
#pragma unroll
            for (int j = 0; j < 4; ++j) rsr[j] = SS[4 * j + r4] * ACT_Q;
#pragma unroll 2
            for (int kc = 0; kc < 8; ++kc) { const float4 gn0 = *(const float4*)(gain + kc * 128 + 8 * cidx), gn1 = *(const float4*)(gain + kc * 128 + 8 * cidx + 4);
                u32x4_t xv[4];
#pragma unroll
                for (int j = 0; j < 4; ++j) xv[j] = *(const u32x4_t*)(XR + (size_t)(n0 + 4 * j + r4) * DM + kc * 128 + 8 * cidx);
#pragma unroll
                for (int j = 0; j < 4; ++j) { const u32x4_t o = xv[j]; const float q = rsr[j];
                    *(u32x2_t*)(H8 + (size_t)(n0 + 4 * j + r4) * DM + kc * 128 + 8 * cidx) = (u32x2_t){
                        q8x4(__uint_as_float(o.x << 16) * gn0.x, __uint_as_float(o.x & 0xffff0000u) * gn0.y, __uint_as_float(o.y << 16) * gn0.z, __uint_as_float(o.y & 0xffff0000u) * gn0.w, q),
                        q8x4(__uint_as_float(o.z << 16) * gn1.x, __uint_as_float(o.z & 0xffff0000u) * gn1.y, __uint_as_float(o.w << 16) * gn1.z, __uint_as_float(o.w & 0xffff0000u) * gn1.w, q)}; } }
        }
        __syncthreads();
    }
}
__device__ __forceinline__ void moe_prefix(const unsigned* cnt, LAS int* pst) {
    if (threadIdx.x == 0) { int acc = 0; for (int e = 0; e < NEXP; ++e) { pst[e] = acc; const int c = (int)cnt[e]; acc += (c + MOE_TM - 1) / MOE_TM * MOE_TM; } pst[NEXP] = acc; }
    __syncthreads();
}
__device__ __forceinline__ void ph_dispatch(const unsigned* cnt, const int* asg_e, const int* asg_rank, const float* asg_gate, const float* RS, int* row_tok, int* row_slot, float* row_gate, float* row_rs, LAS int* pst, const unsigned* wmax, float* tscale) {
    moe_prefix(cnt, pst);
    for (int t = blockIdx.x * NTHREADS + threadIdx.x; t < pst[NEXP] / 256; t += gridDim.x * NTHREADS) { int e = 0;
        for (int k = 1; k < NEXP; ++k) if (t * 256 >= pst[k]) e = k;
        tscale[2 * t] = __uint_as_float(wmax[2 * e]) * (1.f / (127.f * ACT_Q)); tscale[2 * t + 1] = __uint_as_float(wmax[2 * e + 1]) * (1.f / (127.f * ACT_Q)); }
    for (int i = blockIdx.x * NTHREADS + threadIdx.x; i < NASG; i += gridDim.x * NTHREADS) {
        const int e = asg_e[i], d = pst[e] + asg_rank[i];
        row_tok[d] = i >> 1; row_slot[d] = i; row_gate[d] = asg_gate[i]; row_rs[d] = RS[i >> 1];
    }
    for (int e = blockIdx.x; e < NEXP; e += gridDim.x) {
        const int c = (int)cnt[e], lo = pst[e] + c, hi = pst[e + 1];
        for (int r = lo + threadIdx.x; r < hi; r += NTHREADS) { row_tok[r] = -1; row_slot[r] = 0; row_gate[r] = 0.f; row_rs[r] = 0.f; }
    }
    __syncthreads();
}
__device__ __forceinline__ int moe_tile_expert(const LAS int* pst, int row0) { int e = 0;
    for (int i = 1; i < NEXP; ++i) if (row0 >= pst[i]) e = i;
    return e; }

__device__ __forceinline__ float shiftcol(const bf16_t* P, int n, int t, int col, const float* mu) {
    const float cur = bf2f(P[(size_t)n * ABC + col]); const float prev = t > 0 ? bf2f(P[(size_t)(n - 1) * ABC + col]) : 0.f;
    return cur + (prev - cur) * mu[col];
}
constexpr int RW_WMF = 0, RW_RF = 2048, RW_BKF = 4096, RW_ARF = 8192, RW_U = 9216, RW_V = 11264, RW_G = 13312, RW_REC = 13568;
__device__ __forceinline__ float fast_sigmoid(float x) { return __builtin_amdgcn_rcpf(1.f + __expf(-x)); }
__device__ __forceinline__ float fast_softplus(float x) { return fmaxf(x, 0.f) + __logf(1.f + __expf(-fabsf(x))); }
__device__ __forceinline__ void tr_acc(LAS float* TBf, const f32x4 (&acc)[4], int lane, float (&out)[16]) {
    const int q4 = lane >> 4, c16 = lane & 15;
#pragma unroll
    for (int ct = 0; ct < 4; ++ct)
#pragma unroll
        for (int r = 0; r < 4; ++r) TBf[(16 * ct + 4 * q4 + r) * 20 + c16] = acc[ct][r];
#pragma unroll
    for (int j = 0; j < 4; ++j) { const f32x4 v = *(const LAS f32x4*)(TBf + lane * 20 + 4 * j); out[4 * j] = v[0]; out[4 * j + 1] = v[1]; out[4 * j + 2] = v[2]; out[4 * j + 3] = v[3]; }
}
__device__ __forceinline__ void ph_l0_prep(const Args& a, LAS float* lds) {
    const bf16_t* P = (const bf16_t*)(a.ws + WS_B);
    unsigned char* FR = a.ws + WS_C;
    bf16_t* Vb = (bf16_t*)a.out; float* Bon = (float*)((unsigned char*)a.out + 32 * MiB);
    bf16_t* LA = (bf16_t*)(a.ws + WS_A); bf16_t* U = LA + (size_t)NTOK * 512;
    const float* mu = a.in[5]; const float* w0 = a.in[6]; const float* a0 = a.in[8];
    const float* k_k = a.in[11]; const float* k_a = a.in[12]; const float* r_k = a.in[13];
    const float* conv_w = a.in[16]; const float* conv_b = a.in[17]; const float* b_a = a.in[19]; const float* b_x = a.in[21]; const float* lam = a.in[22];
    const int lane = threadIdx.x & 63, wave = threadIdx.x >> 6, q4 = lane >> 4, c16 = lane & 15;
    LAS unsigned char* W = (LAS unsigned char*)lds + wave * 15360;
    constexpr int KAP = 0, BT = 2304, KT = 4608, RT = 6912, BTT = 9216, KTT = 11264, AKB = 13312, AKK = 14336, RS = 144;
    constexpr int XS = 0, XS2 = 2304, TB = 4608;
    LAS float* TBf = (LAS float*)(W + TB);
    for (int u = blockIdx.x * 8 + wave; u < (NTOK / 16) * 8; u += gridDim.x * 8) {
        const int tile = u >> 3, h = u & 7, n0 = tile * 16, c = h * 64 + lane;
        const bool first = (n0 & (SEQ - 1)) == 0;
        const unsigned char* PT = (const unsigned char*)(P + (size_t)tile * ABC * 16);
        const unsigned char* PTp = PT - (size_t)ABC * 32;
        unsigned lo32 = (unsigned)lane * 32u; asm volatile("" : "+v"(lo32));
#define LD16(dst, colbase, off) do { const u32x4_t _lo = *(const u32x4_t*)(PT + (colbase) * 32 + lo32), _hi = *(const u32x4_t*)(PT + (colbase) * 32 + 16 + lo32); \
            dst[(off)] = _lo.x; dst[(off) + 1] = _lo.y; dst[(off) + 2] = _lo.z; dst[(off) + 3] = _lo.w; dst[(off) + 4] = _hi.x; dst[(off) + 5] = _hi.y; dst[(off) + 6] = _hi.z; dst[(off) + 7] = _hi.w; } while (0)
        unsigned xbp[10], pwp[9], pap[9], qrp[9], qkp[9], qvp[9];
        { u32x2_t t2 = (u32x2_t){0u, 0u}; if (!first) t2 = *(const u32x2_t*)(PTp + (2304 + h * 64) * 32 + 24 + lo32); xbp[0] = t2.x; xbp[1] = t2.y; LD16(xbp, 2304 + h * 64, 2); }
        pwp[0] = first ? 0u : *(const unsigned*)(PTp + 1536 * 32 + 28 + lo32); LD16(pwp, 1536, 1);
        pap[0] = first ? 0u : *(const unsigned*)(PTp + 1600 * 32 + 28 + lo32); LD16(pap, 1600, 1);
        asm volatile("" ::: "memory");
#define UNPK(arr, i) __uint_as_float(((i) & 1) ? ((arr)[(i) >> 1] & 0xffff0000u) : ((arr)[(i) >> 1] << 16))
        {
            bf16_t* SG = (bf16_t*)((unsigned char*)a.out + DO_SG);
            const int tk = lane >> 2, col = 1664 + 16 * h + (lane & 3) * 4;
            unsigned so = (unsigned)((lane & 3) * 128 + tk * 2); asm volatile("" : "+v"(so));
            float cu[4], pu[4];
#pragma unroll
            for (int i = 0; i < 4; ++i) { cu[i] = bf2f(*(const bf16_t*)(PT + (1664 + 16 * h + i) * 32 + so));
                pu[i] = (tk > 0) ? bf2f(*(const bf16_t*)(PT + (1664 + 16 * h + i) * 32 - 2 + so)) : (first ? 0.f : bf2f(*(const bf16_t*)(PTp + (1664 + 16 * h + i) * 32 + 30 + so))); }
            const f32x4 m4 = *(const f32x4*)(mu + col);
            *(u32x2_t*)(SG + (size_t)(tile * 8 + h) * 256 + lane * 4) = (u32x2_t){pk2(fast_sigmoid(cu[0] + (pu[0] - cu[0]) * m4[0]), fast_sigmoid(cu[1] + (pu[1] - cu[1]) * m4[1])), pk2(fast_sigmoid(cu[2] + (pu[2] - cu[2]) * m4[2]), fast_sigmoid(cu[3] + (pu[3] - cu[3]) * m4[3]))};
        }
        {
            const float cw0 = conv_w[c], cw1 = conv_w[512 + c], cw2 = conv_w[1024 + c], cw3 = conv_w[1536 + c], cb = conv_b[c];
            float xcv[16], xb[19];
#pragma unroll
            for (int i = 0; i < 19; ++i) xb[i] = UNPK(xbp, i + 1);
#pragma unroll
            for (int tk = 0; tk < 16; ++tk) { xcv[tk] = cb + cw0 * xb[tk] + cw1 * xb[tk + 1] + cw2 * xb[tk + 2] + cw3 * xb[tk + 3]; *(LAS bf16_t*)(W + XS + tk * RS + lane * 2) = f2bf(xcv[tk]); }
            f32x4 accr[4], acci[4];
            const bf16_t* FA = (const bf16_t*)(a.ws + FG_WA) + h * 4096; const bf16_t* FX = (const bf16_t*)(a.ws + FG_WX) + h * 4096;
            bf16x8_t xf[2];
#pragma unroll
            for (int ks = 0; ks < 2; ++ks) xf[ks] = *(const LAS bf16x8_t*)(W + XS + c16 * RS + ks * 64 + q4 * 16);
#pragma unroll
            for (int ct = 0; ct < 4; ++ct) { asm volatile("" ::: "memory"); accr[ct] = (f32x4){0.f, 0.f, 0.f, 0.f}; acci[ct] = accr[ct];
#pragma unroll
                for (int ks = 0; ks < 2; ++ks) { accr[ct] = __builtin_amdgcn_mfma_f32_16x16x32_bf16(*(const bf16x8_t*)(FA + ((ct * 2 + ks) * 64 + lane) * 8), xf[ks], accr[ct], 0, 0, 0);
                    acci[ct] = __builtin_amdgcn_mfma_f32_16x16x32_bf16(*(const bf16x8_t*)(FX + ((ct * 2 + ks) * 64 + lane) * 8), xf[ks], acci[ct], 0, 0, 0); } }
            float rp[16], ip[16];
            tr_acc(TBf, accr, lane, rp); tr_acc(TBf, acci, lane, ip);
            const float bac = b_a[c], bxc = b_x[c], sp = fast_softplus(-lam[c]);
            float hloc = 0.f, sla = 0.f;
            unsigned lap[4], uup[4];
#pragma unroll
            for (int tk = 0; tk < 16; ++tk) { const float r = fast_sigmoid(rp[tk] + bac), i = fast_sigmoid(ip[tk] + bxc);
                const float la = -8.f * r * sp; const float uu = __builtin_amdgcn_sqrtf(fmaxf(1.f - __expf(2.f * la), 0.f)) * i * xcv[tk];
                const bf16_t lab = f2bf(la), uub = f2bf(uu); const float lar = bf2f(lab);
                if (tk & 1) { lap[(tk >> 1) & 3] |= (unsigned)lab << 16; uup[(tk >> 1) & 3] |= (unsigned)uub << 16; } else { lap[(tk >> 1) & 3] = lab; uup[(tk >> 1) & 3] = uub; }
                if ((tk & 7) == 7) { *(u32x4_t*)(LA + ((size_t)tile * 512 + c) * 16 + (tk >> 3) * 8) = (u32x4_t){lap[0], lap[1], lap[2], lap[3]}; *(u32x4_t*)(U + ((size_t)tile * 512 + c) * 16 + (tk >> 3) * 8) = (u32x4_t){uup[0], uup[1], uup[2], uup[3]}; }
                hloc = __expf(lar) * hloc + bf2f(uub); sla += lar; }
            ((float*)((unsigned char*)a.out + DO_LRU))[(size_t)tile * 512 + c] = hloc; ((float*)((unsigned char*)a.out + DO_LRU))[(size_t)(2048 + tile) * 512 + c] = sla;
        }
        asm volatile("" ::: "memory");
        asm volatile("" : "+v"(lo32));
        qrp[0] = first ? 0u : *(const unsigned*)(PTp + (h * 64) * 32 + 28 + lo32); LD16(qrp, h * 64, 1);
        qkp[0] = first ? 0u : *(const unsigned*)(PTp + (512 + h * 64) * 32 + 28 + lo32); LD16(qkp, 512 + h * 64, 1);
        qvp[0] = first ? 0u : *(const unsigned*)(PTp + (1024 + h * 64) * 32 + 28 + lo32); LD16(qvp, 1024 + h * 64, 1);
        asm volatile("" ::: "memory");
        float wpre[16], apre[16];
        {
            const float muw = mu[1536 + lane], mua = mu[1600 + lane];
#pragma unroll
            for (int tk = 0; tk < 16; ++tk) { const float pw1 = UNPK(pwp, tk + 2), pw0 = UNPK(pwp, tk + 1), pa1 = UNPK(pap, tk + 2), pa0 = UNPK(pap, tk + 1);
                const float wl = pw1 + (pw0 - pw1) * muw, al = pa1 + (pa0 - pa1) * mua;
                const float th = 1.f - 2.f * __builtin_amdgcn_rcpf(1.f + __expf(2.f * wl));
                *(LAS bf16_t*)(W + XS + tk * RS + lane * 2) = f2bf(th); *(LAS bf16_t*)(W + XS2 + tk * RS + lane * 2) = f2bf(al); }
            f32x4 accw[4], acca[4];
            const bf16_t* F2 = (const bf16_t*)(a.ws + FG_W2) + h * 4096; const bf16_t* FA2 = (const bf16_t*)(a.ws + FG_A2) + h * 4096;
            bf16x8_t wf[2], af[2];
#pragma unroll
            for (int ks = 0; ks < 2; ++ks) { wf[ks] = *(const LAS bf16x8_t*)(W + XS + c16 * RS + ks * 64 + q4 * 16); af[ks] = *(const LAS bf16x8_t*)(W + XS2 + c16 * RS + ks * 64 + q4 * 16); }
#pragma unroll
            for (int ct = 0; ct < 4; ++ct) { asm volatile("" ::: "memory"); accw[ct] = (f32x4){0.f, 0.f, 0.f, 0.f}; acca[ct] = accw[ct];
#pragma unroll
                for (int ks = 0; ks < 2; ++ks) { accw[ct] = __builtin_amdgcn_mfma_f32_16x16x32_bf16(*(const bf16x8_t*)(F2 + ((ct * 2 + ks) * 64 + lane) * 8), wf[ks], accw[ct], 0, 0, 0);
                    acca[ct] = __builtin_amdgcn_mfma_f32_16x16x32_bf16(*(const bf16x8_t*)(FA2 + ((ct * 2 + ks) * 64 + lane) * 8), af[ks], acca[ct], 0, 0, 0); } }
            tr_acc(TBf, accw, lane, wpre); tr_acc(TBf, acca, lane, apre);
        }
        const float w0c = w0[c], a0c = a0[c], kkc = k_k[c], kac = k_a[c], rkc = r_k[c];
        const float mur = mu[c], muk = mu[512 + c], muv = mu[1024 + c];
        unsigned char* rec = FR + ((size_t)tile * 8 + h) * RW_REC;
        float vsv[16];
        unsigned btp[8], ktp[8];
        float cum = 0.f, gC = 1.f;
#pragma unroll
        for (int tk = 0; tk < 16; ++tk) { const int n = n0 + tk;
            const float cr = UNPK(qrp, tk + 2), ck = UNPK(qkp, tk + 2), cv = UNPK(qvp, tk + 2), pr = UNPK(qrp, tk + 1), pk = UNPK(qkp, tk + 1), pv = UNPK(qvp, tk + 1);
            const float rs = cr + (pr - cr) * mur, ks = ck + (pk - ck) * muk, vs = cv + (pv - cv) * muv;
            const float wv = -fast_softplus(-(w0c + wpre[tk])) - 0.5f; const float logdec = -__expf(wv);
            const float av = fast_sigmoid(a0c + apre[tk]);
            const float kkr = ks * kkc; const float ss = wave_sum(kkr * kkr); const float kkn = kkr * rsqrtf(fmaxf(ss, 1e-24f));
            const float kp = ks * (1.f + (av - 1.f) * kac);
            const float bsum = wave_sum(rs * kp * rkc);
            if (lane == 0) Bon[(size_t)n * 8 + h] = bsum;
            Vb[(size_t)n * 512 + c] = f2bf(vs); vsv[tk] = vs;
            const float gprev = __expf(cum); cum += logdec; const float g = __expf(cum), gi = __builtin_amdgcn_rcpf(g); gC = g;
            const float kapv = kkn * gprev, btv = av * kkn * gi, ktv = kp * gi, rtv = rs * g;
            const bf16_t kb = f2bf(kapv), bb = f2bf(btv), kb2 = f2bf(ktv), rb = f2bf(rtv);
            *(LAS bf16_t*)(W + KAP + tk * RS + lane * 2) = kb; *(LAS bf16_t*)(W + BT + tk * RS + lane * 2) = bb;
            *(LAS bf16_t*)(W + KT + tk * RS + lane * 2) = kb2; *(LAS bf16_t*)(W + RT + tk * RS + lane * 2) = rb;
            if (tk & 1) { btp[tk >> 1] |= (unsigned)bb << 16; ktp[tk >> 1] |= (unsigned)kb2 << 16; } else { btp[tk >> 1] = bb; ktp[tk >> 1] = kb2; } }
        *(LAS u32x4_t*)(W + BTT + lane * 32) = (u32x4_t){btp[0], btp[1], btp[2], btp[3]}; *(LAS u32x4_t*)(W + BTT + lane * 32 + 16) = (u32x4_t){btp[4], btp[5], btp[6], btp[7]};
        *(LAS u32x4_t*)(W + KTT + lane * 32) = (u32x4_t){ktp[0], ktp[1], ktp[2], ktp[3]}; *(LAS u32x4_t*)(W + KTT + lane * 32 + 16) = (u32x4_t){ktp[4], ktp[5], ktp[6], ktp[7]};
        *(float*)(rec + RW_G + lane * 4) = gC;
        f32x4 akb = (f32x4){0.f, 0.f, 0.f, 0.f}, akk = akb, arbT = akb, arkT = akb;
#pragma unroll
        for (int ks = 0; ks < 2; ++ks) { const int fo = c16 * RS + ks * 64 + q4 * 16;
            const bf16x8_t fkap = *(const LAS bf16x8_t*)(W + KAP + fo), fbt = *(const LAS bf16x8_t*)(W + BT + fo), fkt = *(const LAS bf16x8_t*)(W + KT + fo), frt = *(const LAS bf16x8_t*)(W + RT + fo);
            akb = __builtin_amdgcn_mfma_f32_16x16x32_bf16(fkap, fbt, akb, 0, 0, 0); akk = __builtin_amdgcn_mfma_f32_16x16x32_bf16(fkap, fkt, akk, 0, 0, 0);
            arbT = __builtin_amdgcn_mfma_f32_16x16x32_bf16(fbt, frt, arbT, 0, 0, 0); arkT = __builtin_amdgcn_mfma_f32_16x16x32_bf16(fkt, frt, arkT, 0, 0, 0); }
#pragma unroll
        for (int r = 0; r < 4; ++r) { const int t = 4 * q4 + r; ((LAS float*)(W + AKB))[t * 16 + c16] = (c16 < t) ? akb[r] : 0.f; ((LAS float*)(W + AKK))[t * 16 + c16] = (c16 < t) ? akk[r] : 0.f;
            const int sidx = 4 * q4 + r; if (sidx > c16) { arbT[r] = 0.f; arkT[r] = 0.f; } }
        *(u32x4_t*)(rec + RW_ARF + lane * 16) = (u32x4_t){pk2(arbT[0], arbT[1]), pk2(arbT[2], arbT[3]), pk2(arkT[0], arkT[1]), pk2(arkT[2], arkT[3])};
#pragma unroll
        for (int i = 0; i < 4; ++i) { const u32x2_t b2 = *(const LAS u32x2_t*)(W + BTT + (16 * i + c16) * 32 + q4 * 8), k2 = *(const LAS u32x2_t*)(W + KTT + (16 * i + c16) * 32 + q4 * 8);
            *(u32x4_t*)(rec + RW_BKF + i * 1024 + lane * 16) = (u32x4_t){b2.x, b2.y, k2.x, k2.y}; }
#pragma unroll
        for (int sx = 0; sx < 2; ++sx) { const u32x2_t lo = *(const LAS u32x2_t*)(W + RT + c16 * RS + (32 * sx + 4 * q4) * 2), hi = *(const LAS u32x2_t*)(W + RT + c16 * RS + (32 * sx + 16 + 4 * q4) * 2);
            *(u32x4_t*)(rec + RW_RF + sx * 1024 + lane * 16) = (u32x4_t){lo.x, lo.y, hi.x, hi.y}; }
        float Wm[16], Uu[16];
#pragma unroll
        for (int t = 0; t < 16; ++t) { float wacc = bf2f(*(const LAS bf16_t*)(W + KAP + t * RS + lane * 2)), uacc = 0.f;
#pragma unroll
            for (int s4 = 0; s4 < 4; ++s4) if (4 * s4 < t) { const f32x4 b4 = *(const LAS f32x4*)(W + AKB + (t * 16 + 4 * s4) * 4), k4 = *(const LAS f32x4*)(W + AKK + (t * 16 + 4 * s4) * 4);
#pragma unroll
                for (int e = 0; e < 4; ++e) { const int sidx = 4 * s4 + e; if (sidx < t) { wacc -= b4[e] * Wm[sidx]; uacc += k4[e] * vsv[sidx] - b4[e] * Uu[sidx]; } } }
            Wm[t] = wacc; Uu[t] = uacc;
            *(LAS bf16_t*)(W + KAP + t * RS + lane * 2) = f2bf(wacc);
        }
        {
            const int ub = ((lane >> 4) * 64 + (lane & 15)) * 8;
#pragma unroll
            for (int q = 0; q < 4; ++q) { *(u32x2_t*)(rec + RW_U + ub + q * 128) = (u32x2_t){pk2(Uu[4 * q], Uu[4 * q + 1]), pk2(Uu[4 * q + 2], Uu[4 * q + 3])};
                *(u32x2_t*)(rec + RW_V + ub + q * 128) = (u32x2_t){pk2(vsv[4 * q], vsv[4 * q + 1]), pk2(vsv[4 * q + 2], vsv[4 * q + 3])}; }
        }
#pragma unroll
        for (int sx = 0; sx < 2; ++sx) { const u32x2_t lo = *(const LAS u32x2_t*)(W + KAP + c16 * RS + (32 * sx + 4 * q4) * 2), hi = *(const LAS u32x2_t*)(W + KAP + c16 * RS + (32 * sx + 16 + 4 * q4) * 2);
            *(u32x4_t*)(rec + RW_WMF + sx * 1024 + lane * 16) = (u32x4_t){lo.x, lo.y, hi.x, hi.y}; }
    }
}
__device__ __forceinline__ void sub_barrier(unsigned* ctr, unsigned target) {
    asm volatile("s_waitcnt vmcnt(0)" ::: "memory");
    __syncthreads();
    if (threadIdx.x == 0) {
        (void)xb_add(ctr, 1u);
        unsigned sp = 0;
        while (xb_ld(ctr) < target) { __builtin_amdgcn_s_sleep(2); if (++sp > (1u << 22)) break; }
        __builtin_amdgcn_fence(__ATOMIC_ACQUIRE, "agent");
        asm volatile("s_waitcnt vmcnt(0)" ::: "memory");
    }
    __syncthreads();
}
__device__ __forceinline__ void st_wt(float* p, float v) { __hip_atomic_store((unsigned*)p, __float_as_uint(v), __ATOMIC_RELAXED, __HIP_MEMORY_SCOPE_AGENT); }
__device__ __forceinline__ void ph_lru_b(const Args& a, int bid, LAS float* lds) {
    if (bid >= 64) return;
    const float* CH = (const float*)((unsigned char*)a.out + DO_LRU); const float* CA = CH + (size_t)2048 * 512; float* CIN = (float*)((unsigned char*)a.out + DO_LRU) + (size_t)4096 * 512;
    const int b = bid >> 4, cg = bid & 15, cl = threadIdx.x & 31, seg = threadIdx.x >> 5, c = cg * 32 + cl;
    float ca[32], chv[32];
#pragma unroll
    for (int i = 0; i < 32; ++i) { const size_t o = (size_t)(b * 512 + seg * 32 + i) * 512 + c; ca[i] = CA[o]; chv[i] = CH[o]; }
    float h = 0.f, sa = 0.f;
#pragma unroll
    for (int i = 0; i < 32; ++i) { h = __expf(ca[i]) * h + chv[i]; sa += ca[i]; }
    lds[seg * 32 + cl] = sa; lds[512 + seg * 32 + cl] = h;
    __syncthreads();
    float hin = 0.f;
    for (int sg = 0; sg < seg; ++sg) hin = __expf(lds[sg * 32 + cl]) * hin + lds[512 + sg * 32 + cl];
    h = hin;
#pragma unroll
    for (int i = 0; i < 32; ++i) { st_wt(CIN + (size_t)(b * 512 + seg * 32 + i) * 512 + c, h); h = __expf(ca[i]) * h + chv[i]; }
}
__device__ __forceinline__ void ph_lru_c(const Args& a, int bid, int nblk) {
    const bf16_t* LA = (const bf16_t*)(a.ws + WS_A); const bf16_t* U = LA + (size_t)NTOK * 512; const bf16_t* P = (const bf16_t*)(a.ws + WS_B);
    const float* CIN = (const float*)((unsigned char*)a.out + DO_LRU) + (size_t)4096 * 512; bf16_t* MIX = (bf16_t*)(a.ws + WS_D);
    const int c = threadIdx.x;
    for (int u = bid; u < NTOK / 16; u += nblk) { float la[16], uv[16], gt[16];
        float h = CIN[(size_t)u * 512 + c];
#pragma unroll
        for (int hf = 0; hf < 2; ++hf) { const u32x4_t l4 = *(const u32x4_t*)(LA + ((size_t)u * 512 + c) * 16 + hf * 8), u4 = *(const u32x4_t*)(U + ((size_t)u * 512 + c) * 16 + hf * 8), g4 = *(const u32x4_t*)(P + ((size_t)u * ABC + 1792 + c) * 16 + hf * 8);
#pragma unroll
            for (int e = 0; e < 4; ++e) { gt[hf * 8 + 2 * e] = __uint_as_float(g4[e] << 16); gt[hf * 8 + 2 * e + 1] = __uint_as_float(g4[e] & 0xffff0000u); la[hf * 8 + 2 * e] = __uint_as_float(l4[e] << 16); la[hf * 8 + 2 * e + 1] = __uint_as_float(l4[e] & 0xffff0000u); uv[hf * 8 + 2 * e] = __uint_as_float(u4[e] << 16); uv[hf * 8 + 2 * e + 1] = __uint_as_float(u4[e] & 0xffff0000u); } }
#pragma unroll
        for (int s = 0; s < 16; ++s) { const int n = u * 16 + s; h = __expf(la[s]) * h + uv[s];
            const float x = gt[s], t2 = 0.7978845608028654f * (x + 0.044715f * x * x * x); const float th = 1.f - 2.f * __builtin_amdgcn_rcpf(1.f + __expf(2.f * t2));
            MIX[(size_t)n * DM + 512 + c] = f2bf(h * 0.5f * x * (1.f + th)); } }
}
#ifndef SP_MODE
#define SP_MODE 0
#endif
__device__ __forceinline__ void ph_rwkv_scan(const Args& a, LAS unsigned char* L) {
    if (blockIdx.x >= 32) return;
    constexpr int SLOT = 9472, GOFF = 9216, NS = 14, NCH = SEQ / 16; constexpr size_t CSTR = (size_t)8 * RW_REC;
    const unsigned char* FR = a.ws + WS_C; float* Yr = (float*)((unsigned char*)a.out + DO_YR);
    const int b = blockIdx.x >> 3, h = blockIdx.x & 7, lane = threadIdx.x & 63, wave = __builtin_amdgcn_readfirstlane(threadIdx.x >> 6), q4 = lane >> 4, c16 = lane & 15;
    const unsigned char* FRb = FR + ((size_t)(b * NCH) * 8 + h) * RW_REC;
#define RW_BARRIER() do { asm volatile("" ::: "memory"); __builtin_amdgcn_s_barrier(); asm volatile("" ::: "memory"); } while (0)
    if (wave >= 4) {
        const int lw = wave - 4;
        const unsigned char* rp = FRb + lane * 16; int so = 0;
#define RW_ISSUE1() do { LAS unsigned char* _slot = L + so; \
            if (lw < 2) { _Pragma("unroll") for (int _j = 0; _j < 3; ++_j) __builtin_amdgcn_global_load_lds((const unsigned*)(rp + (lw * 3 + _j) * 1024), (LAS unsigned*)(_slot + (lw * 3 + _j) * 1024), 16, 0, 0); } \
            else if (lw == 2) { _Pragma("unroll") for (int _j = 0; _j < 2; ++_j) __builtin_amdgcn_global_load_lds((const unsigned*)(rp + (6 + _j) * 1024), (LAS unsigned*)(_slot + (6 + _j) * 1024), 16, 0, 0); } \
            else { __builtin_amdgcn_global_load_lds((const unsigned*)(rp + 8 * 1024), (LAS unsigned*)(_slot + 8 * 1024), 16, 0, 0); \
                   __builtin_amdgcn_global_load_lds((const unsigned*)(rp - lane * 12 + RW_G), (LAS unsigned*)(_slot + GOFF), 4, 0, 0); } \
            rp += CSTR; so += SLOT; if (so == NS * SLOT) so = 0; } while (0)
#if SP_MODE & 4
#define RW_ISSUE() do { RW_ISSUE1(); rp -= CSTR; so -= SLOT; if (so < 0) so += NS * SLOT; RW_ISSUE1(); } while (0)
#else
#define RW_ISSUE() RW_ISSUE1()
#endif
#if SP_MODE & 4
#define RW_LWAIT() do { if (lw < 2) asm volatile("s_waitcnt vmcnt(54)" ::: "memory"); else asm volatile("s_waitcnt vmcnt(36)" ::: "memory"); } while (0)
#else
#define RW_LWAIT() do { if (lw < 2) asm volatile("s_waitcnt vmcnt(27)" ::: "memory"); else asm volatile("s_waitcnt vmcnt(18)" ::: "memory"); } while (0)
#endif
        for (int p = 0; p < NS - 2; ++p) RW_ISSUE();
        RW_LWAIT();
        RW_BARRIER();
#pragma unroll 1
        for (int it = 0; it < NCH / 2; ++it) { RW_ISSUE(); RW_ISSUE(); RW_LWAIT(); RW_BARRIER(); }
        asm volatile("s_waitcnt vmcnt(0)" ::: "memory");
#undef RW_ISSUE
#undef RW_ISSUE1
#undef RW_LWAIT
    } else {
        const int vs = wave;
#if SP_MODE & 2
        __builtin_amdgcn_s_setprio(3);
#endif
        f32x4 T[4];
#pragma unroll
        for (int i = 0; i < 4; ++i) T[i] = (f32x4){0.f, 0.f, 0.f, 0.f};
        struct Ops { bf16x8_t wmf[2], rf[2], bkf[4], arf; f32x4 g4[4]; };
        const LAS unsigned char* lp = L + lane * 16; const LAS unsigned char* lg = L + GOFF + q4 * 16; int so = 0;
        const unsigned char* up = FRb + RW_U + (vs * 64 + lane) * 8;
        float* yp = Yr + ((size_t)(b * NCH) * 8 + h) * 1024 + vs * 256 + lane * 4;
#if SP_MODE & 8
#define RW_LOAD(O) do { { const LAS unsigned char* _r = lp + so; const LAS unsigned char* _g = lg + so; \
            _Pragma("unroll") for (int _s = 0; _s < 2; ++_s) { bf16x8_t _t0 = *(const LAS bf16x8_t*)(_r + RW_WMF + _s * 1024); bf16x8_t _t1 = *(const LAS bf16x8_t*)(_r + RW_RF + _s * 1024); asm volatile("" :: "v"(_t0), "v"(_t1)); } \
            _Pragma("unroll") for (int _i = 0; _i < 4; ++_i) { bf16x8_t _t0 = *(const LAS bf16x8_t*)(_r + RW_BKF + _i * 1024); f32x4 _t1 = *(const LAS f32x4*)(_g + _i * 64); asm volatile("" :: "v"(_t0), "v"(_t1)); } \
            { bf16x8_t _t0 = *(const LAS bf16x8_t*)(_r + RW_ARF); asm volatile("" :: "v"(_t0)); } asm volatile("" ::: "memory"); } RW_LOAD1(O); } while (0)
#else
#define RW_LOAD(O) RW_LOAD1(O)
#endif
#define RW_LOAD1(O) do { const LAS unsigned char* _r = lp + so; const LAS unsigned char* _g = lg + so; \
            _Pragma("unroll") for (int _s = 0; _s < 2; ++_s) { O.wmf[_s] = *(const LAS bf16x8_t*)(_r + RW_WMF + _s * 1024); O.rf[_s] = *(const LAS bf16x8_t*)(_r + RW_RF + _s * 1024); } \
            _Pragma("unroll") for (int _i = 0; _i < 4; ++_i) O.bkf[_i] = *(const LAS bf16x8_t*)(_r + RW_BKF + _i * 1024); \
            O.arf = *(const LAS bf16x8_t*)(_r + RW_ARF); \
            _Pragma("unroll") for (int _i = 0; _i < 4; ++_i) O.g4[_i] = *(const LAS f32x4*)(_g + _i * 64); \
            so += SLOT; if (so == NS * SLOT) so = 0; \
            __builtin_amdgcn_sched_barrier(0); } while (0)
#define RW_UV(dst) do { dst[0] = *(const u32x2_t*)up; dst[1] = *(const u32x2_t*)(up + 2048); up += CSTR; } while (0)
#define RW_STEP(O, uv) do { \
            bf16x8_t _bS[2]; \
            _Pragma("unroll") for (int _s = 0; _s < 2; ++_s) { const u32x4_t _pk = (u32x4_t){pk2(T[2 * _s][0], T[2 * _s][1]), pk2(T[2 * _s][2], T[2 * _s][3]), pk2(T[2 * _s + 1][0], T[2 * _s + 1][1]), pk2(T[2 * _s + 1][2], T[2 * _s + 1][3])}; \
                _bS[_s] = __builtin_bit_cast(bf16x8_t, _pk); } \
            f32x4 _z = (f32x4){__uint_as_float(uv[0].x << 16), __uint_as_float(uv[0].x & 0xffff0000u), __uint_as_float(uv[0].y << 16), __uint_as_float(uv[0].y & 0xffff0000u)}; \
            _z = __builtin_amdgcn_mfma_f32_16x16x32_bf16(O.wmf[0], _bS[0], _z, 0, 0, 0); _z = __builtin_amdgcn_mfma_f32_16x16x32_bf16(O.wmf[1], _bS[1], _z, 0, 0, 0); \
            f32x4 _y = (f32x4){0.f, 0.f, 0.f, 0.f}; \
            _y = __builtin_amdgcn_mfma_f32_16x16x32_bf16(_bS[0], O.rf[0], _y, 0, 0, 0); _y = __builtin_amdgcn_mfma_f32_16x16x32_bf16(_bS[1], O.rf[1], _y, 0, 0, 0); \
            const u32x4_t _zvp = (u32x4_t){pk2(-_z[0], -_z[1]), pk2(-_z[2], -_z[3]), uv[1].x, uv[1].y}; \
            const bf16x8_t _bZV = __builtin_bit_cast(bf16x8_t, _zvp); \
            _Pragma("unroll") for (int _i = 0; _i < 4; ++_i) { T[_i] = __builtin_amdgcn_mfma_f32_16x16x32_bf16(O.bkf[_i], _bZV, T[_i], 0, 0, 0); T[_i] = T[_i] * O.g4[_i]; } \
            _y = __builtin_amdgcn_mfma_f32_16x16x32_bf16(_bZV, O.arf, _y, 0, 0, 0); \
            *(f32x4*)yp = _y; RW_ST2(); yp += 8 * 1024; } while (0)
#if SP_MODE & 16
#define RW_ST2() do { asm volatile("" ::: "memory"); *(f32x4*)yp = _y; } while (0)
#else
#define RW_ST2() do { } while (0)
#endif
#define RW_SYNC() do { asm volatile("s_waitcnt lgkmcnt(0)" ::: "memory"); RW_BARRIER(); } while (0)
        Ops A, B;
        u32x2_t uv0[2], uv1[2], uv2[2], uv3[2];
        RW_UV(uv0); RW_UV(uv1); RW_UV(uv2); RW_UV(uv3);
        RW_BARRIER();
        RW_LOAD(A);
#pragma unroll 1
        for (int ch = 0; ch < NCH; ch += 4) {
            RW_LOAD(B); RW_STEP(A, uv0); RW_UV(uv0);
            RW_LOAD(A); RW_STEP(B, uv1); RW_UV(uv1); RW_SYNC();
            RW_LOAD(B); RW_STEP(A, uv2); RW_UV(uv2);
            RW_LOAD(A); RW_STEP(B, uv3); RW_UV(uv3); RW_SYNC(); }
#undef RW_SYNC
#undef RW_LOAD
#undef RW_LOAD1
#undef RW_STEP
#undef RW_UV
    }
#undef RW_BARRIER
}
__device__ __forceinline__ void ph_rwkv_post(const Args& a, LAS float* lds) {
    const bf16_t* V = (const bf16_t*)a.out; const float* Bon = (const float*)((const unsigned char*)a.out + DO_BON); const bf16_t* SG = (const bf16_t*)((const unsigned char*)a.out + DO_SG);
    const float* Yr = (const float*)((const unsigned char*)a.out + DO_YR); bf16_t* MIX = (bf16_t*)(a.ws + WS_D);
    const float* ln_w = a.in[14]; const float* ln_b = a.in[15];
    LAS unsigned char* L = (LAS unsigned char*)lds;
    const int c = threadIdx.x, lane = c & 63, h = c >> 6, q4 = lane >> 4, c16 = lane & 15;
    const bf16_t* FG = (const bf16_t*)(a.ws + FG_G2) + h * 8192;
    LAS unsigned char* TW = L + 8192 + h * 2304;
    for (int tile = blockIdx.x; tile < NTOK / 16; tile += gridDim.x) {
        const int n0 = tile * 16;
        __syncthreads();
        { const int tk = c >> 5, j4 = (c & 31) * 4; *(LAS u32x2_t*)(L + tk * 272 + j4 * 2) = *(const u32x2_t*)(SG + (size_t)tile * 2048 + (j4 >> 4) * 256 + tk * 16 + (j4 & 15)); }
        __syncthreads();
        const int n = n0 + c16;
        f32x4 g[4], y[4];
#pragma unroll
        for (int ct = 0; ct < 4; ++ct) { g[ct] = (f32x4){0.f, 0.f, 0.f, 0.f};
#pragma unroll
            for (int ks = 0; ks < 4; ++ks) { const bf16x8_t af = *(const bf16x8_t*)(FG + ((size_t)(ct * 4 + ks) * 64 + lane) * 8); const bf16x8_t bfr = *(const LAS bf16x8_t*)(L + c16 * 272 + ks * 64 + q4 * 16);
                g[ct] = __builtin_amdgcn_mfma_f32_16x16x32_bf16(af, bfr, g[ct], 0, 0, 0); }
            y[ct] = *(const f32x4*)(Yr + (size_t)tile * 8192 + h * 1024 + ct * 256 + lane * 4); }
        float sm = 0.f;
#pragma unroll
        for (int ct = 0; ct < 4; ++ct) sm += (y[ct][0] + y[ct][1]) + (y[ct][2] + y[ct][3]);
        sm = xrow16_sum(sm);
        const float mean = sm * (1.f / 64.f);
        float sv = 0.f;
#pragma unroll
        for (int ct = 0; ct < 4; ++ct) { y[ct] = y[ct] - mean; sv += (y[ct][0] * y[ct][0] + y[ct][1] * y[ct][1]) + (y[ct][2] * y[ct][2] + y[ct][3] * y[ct][3]); }
        sv = xrow16_sum(sv);
        const float rstd = rsqrtf(sv * (1.f / 64.f) + 64e-5f), bsc = Bon[(size_t)n * 8 + h];
#pragma unroll
        for (int ct = 0; ct < 4; ++ct) { const int ch = 64 * h + 16 * ct + 4 * q4;
            const f32x4 lw = *(const f32x4*)(ln_w + ch), lb = *(const f32x4*)(ln_b + ch);
            const u32x2_t vv = *(const u32x2_t*)(V + (size_t)n * 512 + ch);
            const float v0 = __uint_as_float(vv.x << 16), v1 = __uint_as_float(vv.x & 0xffff0000u), v2 = __uint_as_float(vv.y << 16), v3 = __uint_as_float(vv.y & 0xffff0000u);
            const float o0 = (y[ct][0] * rstd * lw[0] + lb[0] + bsc * v0) * g[ct][0], o1 = (y[ct][1] * rstd * lw[1] + lb[1] + bsc * v1) * g[ct][1];
            const float o2 = (y[ct][2] * rstd * lw[2] + lb[2] + bsc * v2) * g[ct][2], o3 = (y[ct][3] * rstd * lw[3] + lb[3] + bsc * v3) * g[ct][3];
            *(LAS u32x2_t*)(TW + c16 * 136 + ct * 32 + q4 * 8) = (u32x2_t){pk2(o0, o1), pk2(o2, o3)}; }
#pragma unroll
        for (int j = 0; j < 2; ++j) { const int tk = 8 * j + (lane >> 3), pc = lane & 7;
            *(u32x4_t*)(MIX + (size_t)(n0 + tk) * DM + 64 * h + pc * 8) = *(const LAS u32x4_t*)(TW + tk * 136 + pc * 16); }
    }
}

namespace gla {
typedef short bf16x8 __attribute__((ext_vector_type(8)));
typedef float f32x16 __attribute__((ext_vector_type(16)));
typedef unsigned u32x4 __attribute__((ext_vector_type(4)));
typedef unsigned u32x2 __attribute__((ext_vector_type(2)));
constexpr int QH_OFF = 0, KH_OFF = 17408, KT_OFF = 34816, VT_OFF = 53248, ST_OFF = 71680, AM_OFF = 106496, EB_OFF = 115712, ER_OFF = 116224, PS_OFF = 116736, SSQ_OFF = 118784, OT_OFF = 119808;
constexpr int QS = 272, TS = 144;
#define GLA_BAR() do { asm volatile("s_waitcnt lgkmcnt(0)" ::: "memory"); __builtin_amdgcn_s_barrier(); asm volatile("" ::: "memory"); } while (0)
template <bool OUT>
__device__ __forceinline__ void unit(const Args& a, LAS unsigned char* L, int u) {
    const int tid = threadIdx.x, lane = tid & 63, w = tid >> 6;
    const int b = u >> 6, h = (u >> 3) & 7, j = u & 7;
    const bf16_t* Q = (const bf16_t*)(a.ws + WS_QFIG) + ((size_t)b * SEQ + (size_t)j * 1024) * 4096 + h * 128;
    float* Lb = (float*)(a.ws + WS_O); float* Db = Lb + (size_t)256 * 16384;
    const int dk = tid & 127, tg = tid >> 7;
    const float c0 = a.in[25][h * 128 + dk], c1 = a.in[25][1024 + h * 128 + dk];
    const float lbv = __builtin_amdgcn_rcpf(1.f + __expf(c0 - c1)), omlb = 1.f - lbv;
    LAS float* PS = (LAS float*)(L + PS_OFF); LAS float* EB = (LAS float*)(L + EB_OFF); LAS float* ER = (LAS float*)(L + ER_OFF); LAS float* SSQ = (LAS float*)(L + SSQ_OFF);
    const int si = w >> 1, sj0 = (w & 1) * 2, l31 = lane & 31, l5 = lane >> 5;
    const int ri = w >> 2, cj = w & 3, odv = 32 * cj + l31;
    f32x16 S[2];
#pragma unroll
    for (int jj = 0; jj < 2; ++jj)
#pragma unroll
        for (int r = 0; r < 16; ++r) S[jj][r] = 0.f;
    if (OUT) {
#pragma unroll 1
        for (int i = 0; i < j; ++i) { const int ui = u - j + i;
#pragma unroll
            for (int jj = 0; jj < 2; ++jj)
#pragma unroll
                for (int rg = 0; rg < 4; ++rg) { const int sdk0 = 32 * si + 8 * rg + 4 * l5, sdv = 32 * (sj0 + jj) + l31; const f32x4 dd = *(const f32x4*)(Db + ui * 128 + sdk0);
#pragma unroll
                    for (int e = 0; e < 4; ++e) S[jj][4 * rg + e] = dd[e] * S[jj][4 * rg + e] + Lb[(size_t)ui * 16384 + (sdk0 + e) * 128 + sdv]; } } }
    const float nwv = OUT ? a.in[26][h * 128 + odv] : 0.f;
    float dsum = 1.f;
    const int prow = tid >> 4, ppc = tid & 15;
    u32x4 pf[2], pv[2], pq[2];
#define GLA_PREFETCH(cx) do { const bf16_t* _q = Q + (size_t)((cx) * 64 + prow) * 4096 + ppc * 8; \
        _Pragma("unroll") for (int _r = 0; _r < 2; ++_r) { pf[_r] = *(const u32x4*)(_q + (size_t)_r * 32 * 4096 + 1024); pv[_r] = *(const u32x4*)(_q + (size_t)_r * 32 * 4096 + 2048); if (OUT) pq[_r] = *(const u32x4*)(_q + (size_t)_r * 32 * 4096); } } while (0)
    GLA_PREFETCH(0);
#pragma unroll 1
    for (int c = 0; c < 16; ++c) {
        int cc = c; asm volatile("" : "+s"(cc));
#pragma unroll
        for (int r = 0; r < 2; ++r) { *(LAS u32x4*)(L + KH_OFF + (prow + 32 * r) * QS + ppc * 16) = pf[r]; *(LAS u32x4*)(L + ST_OFF + (prow + 32 * r) * QS + ppc * 16) = pv[r];
            if (OUT) *(LAS u32x4*)(L + QH_OFF + (prow + 32 * r) * QS + ppc * 16) = pq[r]; }
        if (c + 1 < 16) GLA_PREFETCH(cc + 1);
        u32x4 gq[2];
        if (OUT) { const bf16_t* G = Q + (size_t)(cc * 64) * 4096 + 3072;
            unsigned go = (unsigned)((tid >> 3) * 4096 + (tid & 7) * 16); asm volatile("" : "+v"(go));
            gq[0] = *(const u32x4*)(G + go); gq[1] = *(const u32x4*)(G + go + 8u); }
        GLA_BAR();
        float lf[16], kk[16];
#pragma unroll
        for (int i = 0; i < 16; ++i) { const float fv = bf2f(*(const LAS bf16_t*)(L + KH_OFF + (tg * 16 + i) * QS + dk * 2)); const float sg = __builtin_amdgcn_rcpf(1.f + __expf(-fv));
            lf[i] = lbv + omlb * sg; kk[i] = omlb * (1.f - sg); }
#pragma unroll
        for (int i = 1; i < 16; ++i) lf[i] *= lf[i - 1];
        PS[tg * 128 + dk] = lf[15];
        GLA_BAR();
        const float p0 = PS[dk], p1 = PS[128 + dk], p2 = PS[256 + dk], p3 = PS[384 + dk];
        const float off = (tg > 0 ? p0 : 1.f) * (tg > 1 ? p1 : 1.f) * (tg > 2 ? p2 : 1.f);
        const float pref = p0 * p1, pbl = pref * (p2 * p3), ebr = p2 * p3;
        const float ioff = off * __builtin_amdgcn_rcpf(pref);
        unsigned ktp[8], vtp[8];
#pragma unroll
        for (int i = 0; i < 16; i += 2) {
            float kb[2]; unsigned vv[2];
#pragma unroll
            for (int q = 0; q < 2; ++q) { const float e1 = ioff * lf[i + q]; const float e2 = __builtin_amdgcn_rcpf(e1);
                const float khat = kk[i + q] * e2; kb[q] = khat * ebr; vv[q] = *(const LAS bf16_t*)(L + ST_OFF + (tg * 16 + i + q) * QS + dk * 2);
                if (OUT) { LAS bf16_t* qp = (LAS bf16_t*)(L + QH_OFF + (tg * 16 + i + q) * QS + dk * 2); const float qr = bf2f(*qp); const float qv = qr * __builtin_amdgcn_rcpf(1.f + __expf(-qr));
                    *qp = f2bf(qv * e1); *(LAS bf16_t*)(L + KH_OFF + (tg * 16 + i + q) * QS + dk * 2) = f2bf(khat); } }
            ktp[i >> 1] = pk2(kb[0], kb[1]); vtp[i >> 1] = vv[0] | (vv[1] << 16);
        }
        *(LAS u32x4*)(L + KT_OFF + dk * TS + tg * 32) = (u32x4){ktp[0], ktp[1], ktp[2], ktp[3]}; *(LAS u32x4*)(L + KT_OFF + dk * TS + tg * 32 + 16) = (u32x4){ktp[4], ktp[5], ktp[6], ktp[7]};
        *(LAS u32x4*)(L + VT_OFF + dk * TS + tg * 32) = (u32x4){vtp[0], vtp[1], vtp[2], vtp[3]}; *(LAS u32x4*)(L + VT_OFF + dk * TS + tg * 32 + 16) = (u32x4){vtp[4], vtp[5], vtp[6], vtp[7]};
        if (tg == 0) { EB[dk] = pbl; ER[dk] = pref; dsum *= pbl; }
        GLA_BAR();
        f32x16 o;
        if (OUT) {
#pragma unroll
            for (int jj = 0; jj < 2; ++jj)
#pragma unroll
                for (int rg = 0; rg < 4; ++rg) { const int dk0 = 32 * si + 8 * rg + 4 * l5; const f32x4 er = *(const LAS f32x4*)(ER + dk0);
                    u32x2 pk; pk.x = pk2(S[jj][4 * rg] * er[0], S[jj][4 * rg + 1] * er[1]); pk.y = pk2(S[jj][4 * rg + 2] * er[2], S[jj][4 * rg + 3] * er[3]);
                    *(LAS u32x2*)(L + ST_OFF + (32 * (sj0 + jj) + l31) * QS + dk0 * 2) = pk; }
#pragma unroll
            for (int q = 0; q < 2; ++q) { const int ti = w >> 1, tj = (w & 1) * 2 + q;
                f32x4 sc = (f32x4){0.f, 0.f, 0.f, 0.f};
                if (tj <= ti) {
#pragma unroll
                    for (int ks = 0; ks < 4; ++ks) { const bf16x8 af = *(const LAS bf16x8*)(L + QH_OFF + (16 * ti + (lane & 15)) * QS + ks * 64 + (lane >> 4) * 16);
                        const bf16x8 bfr = *(const LAS bf16x8*)(L + KH_OFF + (16 * tj + (lane & 15)) * QS + ks * 64 + (lane >> 4) * 16);
                        sc = __builtin_amdgcn_mfma_f32_16x16x32_bf16(af, bfr, sc, 0, 0, 0); } }
                const int scol = 16 * tj + (lane & 15);
#pragma unroll
                for (int r = 0; r < 4; ++r) { const int trow = 16 * ti + 4 * (lane >> 4) + r; const float v = (scol <= trow) ? sc[r] : 0.f;
                    *(LAS bf16_t*)(L + AM_OFF + trow * TS + scol * 2) = f2bf(v); } }
            GLA_BAR();
#pragma unroll
            for (int r = 0; r < 16; ++r) o[r] = 0.f;
#pragma unroll
            for (int ks = 0; ks < 4; ++ks) if (ks < 2 * (ri + 1)) {
                const bf16x8 af = *(const LAS bf16x8*)(L + AM_OFF + (32 * ri + l31) * TS + ks * 32 + l5 * 16);
                const bf16x8 bfr = *(const LAS bf16x8*)(L + VT_OFF + (32 * cj + l31) * TS + ks * 32 + l5 * 16);
                o = __builtin_amdgcn_mfma_f32_32x32x16_bf16(af, bfr, o, 0, 0, 0); }
#pragma unroll
            for (int ks = 0; ks < 8; ++ks) { if ((ks & 3) == 0) asm volatile("" ::: "memory");
                const bf16x8 af = *(const LAS bf16x8*)(L + QH_OFF + (32 * ri + l31) * QS + ks * 32 + l5 * 16);
                const bf16x8 bfr = *(const LAS bf16x8*)(L + ST_OFF + (32 * cj + l31) * QS + ks * 32 + l5 * 16);
                o = __builtin_amdgcn_mfma_f32_32x32x16_bf16(af, bfr, o, 0, 0, 0); }
#pragma unroll
            for (int r = 0; r < 16; ++r) { const float q2 = xrow32_sum(row16_sum(o[r] * o[r]));
                if (l31 == 0) SSQ[(32 * ri + (r & 3) + 8 * (r >> 2) + 4 * l5) * 4 + cj] = q2; }
#pragma unroll
            for (int r = 0; r < 16; ++r) *(LAS float*)(L + OT_OFF + (32 * ri + (r & 3) + 8 * (r >> 2) + 4 * l5) * 528 + odv * 4) = o[r] * nwv;
        }
        {
            bf16x8 af[4];
#pragma unroll
            for (int ks = 0; ks < 4; ++ks) af[ks] = *(const LAS bf16x8*)(L + KT_OFF + (32 * si + l31) * TS + ks * 32 + l5 * 16);
#pragma unroll
            for (int jj = 0; jj < 2; ++jj) {
#pragma unroll
                for (int rg = 0; rg < 4; ++rg) { const f32x4 eb = *(const LAS f32x4*)(EB + 32 * si + 8 * rg + 4 * l5);
                    S[jj][4 * rg] *= eb[0]; S[jj][4 * rg + 1] *= eb[1]; S[jj][4 * rg + 2] *= eb[2]; S[jj][4 * rg + 3] *= eb[3]; }
#pragma unroll
                for (int ks = 0; ks < 4; ++ks) { const bf16x8 bfr = *(const LAS bf16x8*)(L + VT_OFF + (32 * (sj0 + jj) + l31) * TS + ks * 32 + l5 * 16);
                    S[jj] = __builtin_amdgcn_mfma_f32_32x32x16_bf16(af[ks], bfr, S[jj], 0, 0, 0); } }
        }
        GLA_BAR();
        if (OUT) {
            const int et = tid >> 3, ep = tid & 7;
            const f32x4 q4 = *(const LAS f32x4*)(SSQ + et * 4);
            const float rs = rsqrtf(((q4[0] + q4[1]) + (q4[2] + q4[3])) * (1.f / 128.f) + 1e-6f);
            bf16_t* MIX = (bf16_t*)(a.ws + WS_MIX1) + ((size_t)b * SEQ + (size_t)j * 1024 + cc * 64) * DM + h * 128;
            unsigned mo = (unsigned)(et * DM + ep * 16); asm volatile("" : "+v"(mo));
#pragma unroll
            for (int hf = 0; hf < 2; ++hf) { unsigned ov[4];
#pragma unroll
                for (int e2 = 0; e2 < 2; ++e2) { const f32x4 o4 = *(const LAS f32x4*)(L + OT_OFF + et * 528 + ep * 64 + hf * 32 + e2 * 16);
#pragma unroll
                    for (int e = 0; e < 2; ++e) { const unsigned gw = gq[hf][e2 * 2 + e]; const float g0 = __uint_as_float(gw << 16), g1 = __uint_as_float(gw & 0xffff0000u);
                        ov[e2 * 2 + e] = pk2(o4[2 * e] * rs * g0 * __builtin_amdgcn_rcpf(1.f + __expf(-g0)), o4[2 * e + 1] * rs * g1 * __builtin_amdgcn_rcpf(1.f + __expf(-g1))); } }
                *(u32x4*)(MIX + mo + hf * 8) = (u32x4){ov[0], ov[1], ov[2], ov[3]}; }
        }
    }
    if (!OUT) {
#pragma unroll
        for (int jj = 0; jj < 2; ++jj)
#pragma unroll
            for (int r = 0; r < 16; ++r) { const int sdk = 32 * si + (r & 3) + 8 * (r >> 2) + 4 * l5, sdv = 32 * (sj0 + jj) + l31; Lb[(size_t)u * 16384 + sdk * 128 + sdv] = S[jj][r]; }
        if (tg == 0) Db[u * 128 + dk] = dsum;
    }
    GLA_BAR();
#undef GLA_PREFETCH
}
__device__ __forceinline__ void pass2(const Args& a) {
    float* Lb = (float*)(a.ws + WS_O); const float* Db = Lb + (size_t)256 * 16384;
    for (int idx = blockIdx.x * NTHREADS + threadIdx.x; idx < 32 * 16384; idx += gridDim.x * NTHREADS) { const int bh = idx >> 14, el = idx & 16383, dkk = el >> 7; float sacc = 0.f;
        for (int j = 0; j < 8; ++j) { const int u = bh * 8 + j; const size_t o = (size_t)u * 16384 + el;
            if (j < 7) { const float tmp = Lb[o]; Lb[o] = sacc; sacc = Db[u * 128 + dkk] * sacc + tmp; } else Lb[o] = sacc; } }
}
}

constexpr int NPHASE = 24;
__global__ void __launch_bounds__(NTHREADS, 2) fwd(Args a) {
    extern __shared__ __attribute__((aligned(16))) unsigned char lds_raw[];
    LAS unsigned char* ldsb = (LAS unsigned char*)lds_raw;
    LAS float* lds = (LAS float*)ldsb;
    LAS int* pst = (LAS int*)(ldsb + LDS_MISC);
    volatile LAS unsigned* xbw = (volatile LAS unsigned*)(ldsb + LDS_MISC + 256);
    if (threadIdx.x == 0) { xbw[0] = 0u; xbw[1] = 0u; }
    __syncthreads();
    unsigned* ctl = (unsigned*)(a.ws + WS_CTL);
    const bool multi = (a.ph_hi - a.ph_lo) > 1;
    XcdBarrier bar; bar.bar = ctl; bar.x = 0; bar.st = xbw;
    if (multi) bar = xcd_barrier_post(ctl, xbw);
    unsigned char* ws = a.ws;
    bf16_t* HN = (bf16_t*)(ws + WS_A);
    bf16_t* XR = (bf16_t*)(ws + WS_XR); float* RSv = (float*)(ws + WS_ROUTE + RT_LRU_CH);
    int* asg_e = (int*)(ws + WS_ROUTE + RT_ASG_E); int* asg_rank = (int*)(ws + WS_ROUTE + RT_ASG_RANK); float* asg_gate = (float*)(ws + WS_ROUTE + RT_ASG_GATE);
    int* row_tok = (int*)(ws + WS_ROUTE + RT_ROW_TOK); int* row_slot = (int*)(ws + WS_ROUTE + RT_ROW_SLOT); float* row_gate = (float*)(ws + WS_ROUTE + RT_ROW_GATE); float* row_rs = (float*)(ws + WS_ROUTE + RT_LRU_CA); float* tscale = (float*)(ws + WS_ROUTE + RT_LRU_CIN);
#ifndef PHSEL
#define PHSEL(k) true
#endif
#ifndef REPMASK
#define REPMASK 0u
#endif
#define NREP(k) (((REPMASK >> (k)) & 1u) ? 2 : 1)
#define IN(k) (PHSEL(k) && a.ph_lo <= (k) && (k) < a.ph_hi)
#define SEAM(k) do { if (IN((k) + 1) && multi) xcd_barrier(bar); } while (0)
    if (IN(0)) { ph_cvt_frags(a); ph_cvt_dense_a(a, lds, ctl + CW_COLMAX); ph_norm0(a.in[0], a.in[1], (unsigned char*)HN, (float*)(ws + WS_ROUTE + RT_LRU_CH + 262144)); xcd_barrier(bar); ph_cvt_dense_b(a, lds, ctl + CW_COLMAX, 0); }
#if (REPMASK >> 0) & 1
    if (IN(0)) { xcd_barrier(bar);  ph_cvt_frags(a); ph_cvt_dense_a(a, lds, ctl + CW_COLMAX); ph_norm0(a.in[0], a.in[1], (unsigned char*)HN, (float*)(ws + WS_ROUTE + RT_LRU_CH + 262144)); xcd_barrier(bar); ph_cvt_dense_b(a, lds, ctl + CW_COLMAX, 0); }
#endif
    if (IN(0)) { SEAM(0); }
    if (IN(1)) { pg8::DenseOrder S; S.init(ABC, NTOK, DM / 2, gridDim.x, blockIdx.x, HN); pg8::EpiBf16IT E{(bf16_t*)(ws + WS_B), ABC, (float*)(ws + WS_ROUTE + RT_LRU_CH + 262144), ctl + CW_COLMAX};
        pg8::gemm_phase<pg8::EpiBf16IT, pg8::DenseOrder, true>(ldsb, (const char*)(ws + WD_ABIN), DM, DM / 2, S, E); }
#if (REPMASK >> 1) & 1
    if (IN(1)) { xcd_barrier(bar);  pg8::DenseOrder S; S.init(ABC, NTOK, DM / 2, gridDim.x, blockIdx.x, HN); pg8::EpiBf16IT E{(bf16_t*)(ws + WS_B), ABC, (float*)(ws + WS_ROUTE + RT_LRU_CH + 262144), ctl + CW_COLMAX};
        pg8::gemm_phase<pg8::EpiBf16IT, pg8::DenseOrder, true>(ldsb, (const char*)(ws + WD_ABIN), DM, DM / 2, S, E);  }
#endif
    if (IN(1)) { SEAM(1); }
    if (IN(2)) { ph_l0_prep(a, lds); }
#if (REPMASK >> 2) & 1
    if (IN(2)) { xcd_barrier(bar);  ph_l0_prep(a, lds);  }
#endif
    if (IN(2)) { SEAM(2); }
    if (IN(6)) {
        if (blockIdx.x < 32) ph_rwkv_scan(a, ldsb);
        else { const int gb = (int)blockIdx.x - 32, gn = (int)gridDim.x - 32; unsigned* sctr = ctl + CW_CNT + 256;
            ph_lru_b(a, gb, lds); sub_barrier(sctr, (unsigned)gn);
#if SP_MODE & 1
            ph_lru_c(a, gb, gn); }
        xcd_barrier(bar); ph_wmax(a.in[32], a.in[33], ctl + CW_WMAX, blockIdx.x, gridDim.x); xcd_barrier(bar);
        ph_cvt_moe(a, 0, lds, blockIdx.x, gridDim.x, 3); ph_cvt_moe(a, 1, lds, blockIdx.x, gridDim.x, 1);
#else
            ph_lru_c(a, gb, gn); ph_wmax(a.in[32], a.in[33], ctl + CW_WMAX, gb, gn); sub_barrier(sctr, 2u * (unsigned)gn);
            ph_cvt_moe(a, 0, lds, gb, gn, 3); ph_cvt_moe(a, 1, lds, gb, gn, 1); }
#endif
        SEAM(6); }
    if (IN(7)) { ph_rwkv_post(a, lds); }
#if (REPMASK >> 7) & 1
    if (IN(7)) { xcd_barrier(bar);  ph_rwkv_post(a, lds);  }
#endif
    if (IN(7)) { SEAM(7); }
    if (IN(8)) { pg8::DenseOrder S; S.init(NTOK, DM, DM, gridDim.x, blockIdx.x, ws + WD_ABOUT); pg8::EpiResid<true> E{a.in[0], XR};
        pg8::gemm_phase(ldsb, (const char*)(ws + WS_D), DM * 2, DM, S, E); }
#if (REPMASK >> 8) & 1
    if (IN(8)) { xcd_barrier(bar);  pg8::DenseOrder S; S.init(NTOK, DM, DM, gridDim.x, blockIdx.x, ws + WD_ABOUT); pg8::EpiResid<true> E{a.in[0], XR};
        pg8::gemm_phase(ldsb, (const char*)(ws + WS_D), DM * 2, DM, S, E);  }
#endif
    if (IN(8)) { SEAM(8); }
    if (IN(9)) { ph_route(a, 0, XR, HN, RSv, ctl + CW_CNT, asg_e, asg_rank, asg_gate, lds); SEAM(9); }
    if (IN(10)) { ph_dispatch(ctl + CW_CNT, asg_e, asg_rank, asg_gate, RSv, row_tok, row_slot, row_gate, row_rs, pst, ctl + CW_WMAX, tscale); ph_cvt_dense_b(a, lds, ctl + CW_COLMAX, 1); }
#if (REPMASK >> 10) & 1
    if (IN(10)) { xcd_barrier(bar);  ph_dispatch(ctl + CW_CNT, asg_e, asg_rank, asg_gate, RSv, row_tok, row_slot, row_gate, row_rs, pst, ctl + CW_WMAX, tscale);  }
#endif
    if (IN(10)) { SEAM(10); }
    if (IN(11)) { moe_prefix(ctl + CW_CNT, pst);
        pg8::MoeOrder S{(int)gridDim.x, (int)blockIdx.x, 4, pst[NEXP] / 256, pst, row_tok, (const char*)(ws + WM_GU), (size_t)DM * DM, (size_t)256 * DM}; pg8::EpiSwiGLU E{(bf16_t*)(ws + WS_H), tscale};
        pg8::gemm_phase<pg8::EpiSwiGLU, pg8::MoeOrder, true>(ldsb, (const char*)HN, DM, DM / 2, S, E); }
#if (REPMASK >> 11) & 1
    if (IN(11)) { xcd_barrier(bar);  moe_prefix(ctl + CW_CNT, pst);
        pg8::MoeOrder S{(int)gridDim.x, (int)blockIdx.x, 4, pst[NEXP] / 256, pst, row_tok, (const char*)(ws + WM_GU), (size_t)DM * DM, (size_t)256 * DM}; pg8::EpiSwiGLU E{(bf16_t*)(ws + WS_H), tscale};
        pg8::gemm_phase<pg8::EpiSwiGLU, pg8::MoeOrder, true>(ldsb, (const char*)HN, DM, DM / 2, S, E);  }
#endif
    if (IN(11)) { SEAM(11); }
    if (IN(12)) { moe_prefix(ctl + CW_CNT, pst);
        pg8::MoeOrder S{(int)gridDim.x, (int)blockIdx.x, 4, pst[NEXP] / 256, pst, nullptr, (const char*)(ws + WM_DN), (size_t)DM * FF * 2, (size_t)256 * FF * 2}; pg8::EpiDown E{(bf16_t*)(ws + WS_Y), row_tok, row_slot, row_gate};
        pg8::gemm_phase(ldsb, (const char*)(ws + WS_H), FF * 2, FF, S, E); }
#if (REPMASK >> 12) & 1
    if (IN(12)) { xcd_barrier(bar);  moe_prefix(ctl + CW_CNT, pst);
        pg8::MoeOrder S{(int)gridDim.x, (int)blockIdx.x, 4, pst[NEXP] / 256, pst, nullptr, (const char*)(ws + WM_DN), (size_t)DM * FF * 2, (size_t)256 * FF * 2}; pg8::EpiDown E{(bf16_t*)(ws + WS_Y), row_tok, row_slot, row_gate};
        pg8::gemm_phase(ldsb, (const char*)(ws + WS_H), FF * 2, FF, S, E);  }
#endif
    if (IN(12)) { SEAM(12); }
    if (IN(13)) { ph_combine_norm(XR, (const bf16_t*)(ws + WS_Y), a.in[1] + DM, (unsigned char*)HN, (float*)(ws + WS_ROUTE + RT_LRU_CH + 262144)); SEAM(13); }
    if (IN(14)) { pg8::DenseOrder S; S.init(NTOK, 4096, DM / 2, gridDim.x, blockIdx.x, ws + WD_CIN); pg8::EpiBf16I E{(bf16_t*)(ws + WS_QFIG), 4096, (float*)(ws + WS_ROUTE + RT_LRU_CH + 262144), ctl + CW_COLMAX + ABC};
        pg8::gemm_phase<pg8::EpiBf16I, pg8::DenseOrder, true>(ldsb, (const char*)HN, DM, DM / 2, S, E); }
#if (REPMASK >> 14) & 1
    if (IN(14)) { xcd_barrier(bar);  pg8::DenseOrder S; S.init(NTOK, 4096, DM / 2, gridDim.x, blockIdx.x, ws + WD_CIN); pg8::EpiBf16I E{(bf16_t*)(ws + WS_QFIG), 4096, (float*)(ws + WS_ROUTE + RT_LRU_CH + 262144), ctl + CW_COLMAX + ABC};
        pg8::gemm_phase<pg8::EpiBf16I, pg8::DenseOrder, true>(ldsb, (const char*)HN, DM, DM / 2, S, E);  }
#endif
    if (IN(14)) { SEAM(14); }
    if (IN(15)) { for (int u = blockIdx.x; u < 256; u += gridDim.x) if ((u & 7) != 7) gla::unit<false>(a, ldsb, u); }
#if (REPMASK >> 15) & 1
    if (IN(15)) { xcd_barrier(bar);  for (int u = blockIdx.x; u < 256; u += gridDim.x) if ((u & 7) != 7) gla::unit<false>(a, ldsb, u);  }
#endif
    if (IN(15)) { SEAM(15); }
    if (IN(17)) { for (int u = blockIdx.x; u < 256; u += gridDim.x) gla::unit<true>(a, ldsb, u); }
#if (REPMASK >> 17) & 1
    if (IN(17)) { xcd_barrier(bar);  for (int u = blockIdx.x; u < 256; u += gridDim.x) gla::unit<true>(a, ldsb, u);  }
#endif
    if (IN(17)) { SEAM(17); }
    if (IN(18)) { pg8::DenseOrder S; S.init(NTOK, DM, DM, gridDim.x, blockIdx.x, ws + WD_COUT); pg8::EpiResid<false> E{XR, XR};
        pg8::gemm_phase(ldsb, (const char*)(ws + WS_MIX1), DM * 2, DM, S, E); SEAM(18); }
    if (IN(19)) { ph_route(a, 1, XR, HN, RSv, ctl + CW_CNT + 64, asg_e, asg_rank, asg_gate, lds); SEAM(19); }
    if (IN(20)) { ph_dispatch(ctl + CW_CNT + 64, asg_e, asg_rank, asg_gate, RSv, row_tok, row_slot, row_gate, row_rs, pst, ctl + CW_WMAX + 64, tscale); ph_cvt_moe(a, 1, lds, blockIdx.x, gridDim.x, 2); }
#if (REPMASK >> 20) & 1
    if (IN(20)) { xcd_barrier(bar);  ph_dispatch(ctl + CW_CNT + 64, asg_e, asg_rank, asg_gate, RSv, row_tok, row_slot, row_gate, row_rs, pst, ctl + CW_WMAX + 64, tscale); ph_cvt_moe(a, 1, lds, blockIdx.x, gridDim.x, 2);  }
#endif
    if (IN(20)) { SEAM(20); }
    if (IN(21)) { moe_prefix(ctl + CW_CNT + 64, pst);
        pg8::MoeOrder S{(int)gridDim.x, (int)blockIdx.x, 4, pst[NEXP] / 256, pst, row_tok, (const char*)(ws + WM_GU1), (size_t)DM * DM, (size_t)256 * DM}; pg8::EpiSwiGLU E{(bf16_t*)(ws + WS_H), tscale};
        pg8::gemm_phase<pg8::EpiSwiGLU, pg8::MoeOrder, true>(ldsb, (const char*)HN, DM, DM / 2, S, E); }
#if (REPMASK >> 21) & 1
    if (IN(21)) { xcd_barrier(bar);  moe_prefix(ctl + CW_CNT + 64, pst);
        pg8::MoeOrder S{(int)gridDim.x, (int)blockIdx.x, 4, pst[NEXP] / 256, pst, row_tok, (const char*)(ws + WM_GU1), (size_t)DM * DM, (size_t)256 * DM}; pg8::EpiSwiGLU E{(bf16_t*)(ws + WS_H), tscale};
        pg8::gemm_phase<pg8::EpiSwiGLU, pg8::MoeOrder, true>(ldsb, (const char*)HN, DM, DM / 2, S, E);  }
#endif
    if (IN(21)) { SEAM(21); }
    if (IN(22)) { moe_prefix(ctl + CW_CNT + 64, pst);
        pg8::MoeOrder S{(int)gridDim.x, (int)blockIdx.x, 4, pst[NEXP] / 256, pst, nullptr, (const char*)(ws + WM_DN), (size_t)DM * FF * 2, (size_t)256 * FF * 2}; pg8::EpiDown E{(bf16_t*)(ws + WS_Y), row_tok, row_slot, row_gate};
        pg8::gemm_phase(ldsb, (const char*)(ws + WS_H), FF * 2, FF, S, E); }
#if (REPMASK >> 22) & 1
    if (IN(22)) { xcd_barrier(bar);  moe_prefix(ctl + CW_CNT + 64, pst);
        pg8::MoeOrder S{(int)gridDim.x, (int)blockIdx.x, 4, pst[NEXP] / 256, pst, nullptr, (const char*)(ws + WM_DN), (size_t)DM * FF * 2, (size_t)256 * FF * 2}; pg8::EpiDown E{(bf16_t*)(ws + WS_Y), row_tok, row_slot, row_gate};
        pg8::gemm_phase(ldsb, (const char*)(ws + WS_H), FF * 2, FF, S, E);  }
#endif
    if (IN(22)) { SEAM(22); }
    if (IN(23)) { ph_final(XR, (const bf16_t*)(ws + WS_Y), a.in[3], a.out); }
#undef IN
#undef SEAM
}

extern "C" void kernel_launch(void* const* d_in, const int* in_sizes, int n_in, void* d_out, int out_size, void* d_ws, size_t ws_size, hipStream_t stream) {
    static int grid = 0;
    if (grid == 0) {
        if (n_in != 35 || out_size != NTOK * DM || ws_size < WS_END) { fprintf(stderr, "kernel_launch: unexpected shapes (n_in %d out %d ws %zu)\n", n_in, out_size, ws_size); grid = -1; return; }
        int dev = 0, cus = 0;
        if (hipGetDevice(&dev) != hipSuccess || hipDeviceGetAttribute(&cus, hipDeviceAttributeMultiprocessorCount, dev) != hipSuccess) { grid = -1; return; }
        if (hipFuncSetAttribute((const void*)fwd, hipFuncAttributeMaxDynamicSharedMemorySize, LDS_BYTES) != hipSuccess) { fprintf(stderr, "kernel_launch: hipFuncSetAttribute failed\n"); grid = -1; return; }
        int per_cu = 0;
        (void)hipOccupancyMaxActiveBlocksPerMultiprocessor(&per_cu, (const void*)fwd, NTHREADS, LDS_BYTES);
        (void)hipGetLastError();
        grid = cus;
        if (grid < 64) { fprintf(stderr, "kernel_launch: needs >= 64 CUs\n"); grid = -1; return; }
    }
    if (grid < 0) return;
    (void)hipMemsetAsync((char*)d_ws + WS_CTL, 0, CTL_ZERO_BYTES, stream);
    Args a{};
    for (int i = 0; i < 35; ++i) a.in[i] = (const float*)d_in[i];
    a.out = (float*)d_out; a.ws = (unsigned char*)d_ws;
#if 0
    for (int p = 0; p < NPHASE; ++p) { a.ph_lo = p; a.ph_hi = p + 1; hipLaunchKernelGGL(fwd, dim3(grid), dim3(NTHREADS), LDS_BYTES, stream, a); }
#else
    a.ph_lo = 0; a.ph_hi = NPHASE; hipLaunchKernelGGL(fwd, dim3(grid), dim3(NTHREADS), LDS_BYTES, stream, a);
#endif
}
```

```cpp
#include <hip/hip_runtime.h>
#include <cstdio>
#include <cstdint>

typedef unsigned short bf16_t;
#define LAS __attribute__((address_space(3)))
typedef float f32x4 __attribute__((ext_vector_type(4)));
typedef short bf16x8_t __attribute__((ext_vector_type(8)));
typedef unsigned u32x4_t __attribute__((ext_vector_type(4)));
typedef unsigned u32x2_t __attribute__((ext_vector_type(2)));

constexpr int NTOK = 32768, SEQ = 8192, NBATCH = 4, DM = 1024;
constexpr int ABC = 2816, RWC = 1792;
constexpr int NEXP = 32, FF = 512;
constexpr int NASG = NTOK * 2;
constexpr int MOE_TM = 256;
constexpr int MAXROWS = NASG + NEXP * MOE_TM;
constexpr int NTHREADS = 512;
constexpr int LDS_BYTES = 156 * 1024;
constexpr int LDS_MISC = 155 * 1024;

constexpr size_t MiB = 1024ull * 1024ull;
constexpr size_t WS_CTL = 0;
constexpr size_t CTL_ZERO_BYTES = 64 * 1024;
constexpr size_t WS_ROUTE = 64 * 1024;
constexpr size_t WS_WD = 8 * MiB;
constexpr size_t WD_ABIN = WS_WD, WD_ABOUT = WD_ABIN + (size_t)ABC * DM * 2, WD_CIN = WD_ABOUT + (size_t)DM * DM * 2, WD_COUT = WD_CIN + (size_t)4096 * DM * 2;
constexpr size_t WS_AR = 26 * MiB;
constexpr size_t WS_A = WS_AR;
constexpr size_t WS_B = WS_AR + 64 * MiB;
constexpr size_t WS_C = WS_B + 176 * MiB;
constexpr size_t WS_D = WS_C + 212 * MiB;
constexpr size_t DO_LRU = 112 * MiB;
constexpr size_t WS_XR = WS_AR + 360 * MiB;
constexpr size_t WS_WM = WS_AR + 64 * MiB;
constexpr size_t WM_GU1 = WS_A + 32 * MiB;
constexpr size_t WM_GU = WS_WM, WM_DN = WS_WM + (size_t)NEXP * DM * DM;
constexpr size_t WS_H = WS_WM + 96 * MiB;
constexpr size_t WS_Y = WS_H + 72 * MiB;
constexpr size_t WS_QFIG = WS_AR + 64 * MiB;
constexpr size_t WS_O = WS_QFIG + 256 * MiB;
constexpr size_t WS_MIX1 = WS_O + 128 * MiB;
constexpr size_t WS_END = WS_AR + 516 * MiB;
static_assert(WS_D + 64 * MiB <= WS_END && WS_Y + 128 * MiB <= WS_END && WS_MIX1 + 64 * MiB <= WS_END, "arena");

constexpr size_t DO_VB = 0, DO_BON = 32 * MiB, DO_SG = 34 * MiB, DO_YR = 48 * MiB;

constexpr int CW_CNT = 8192;
constexpr int CW_WMAX = CW_CNT + 512;
constexpr int CW_COLMAX = CW_WMAX + 192;
constexpr float ACT_Q = 127.f / 6.f;
constexpr size_t RT_ASG_E = 0;
constexpr size_t RT_ASG_RANK = RT_ASG_E + NASG * 4;
constexpr size_t RT_ASG_GATE = RT_ASG_RANK + NASG * 4;
constexpr size_t RT_ROW_TOK = RT_ASG_GATE + NASG * 4;
constexpr size_t RT_ROW_SLOT = RT_ROW_TOK + MAXROWS * 4;
constexpr size_t RT_ROW_GATE = RT_ROW_SLOT + MAXROWS * 4;
constexpr size_t RT_LRU_CH = RT_ROW_GATE + MAXROWS * 4;
constexpr size_t RT_LRU_CA = RT_LRU_CH + 512 * 512 * 4;
constexpr size_t RT_LRU_CIN = RT_LRU_CA + 512 * 512 * 4;
constexpr size_t RT_END = RT_LRU_CIN + 512 * 512 * 4;
constexpr size_t WS_FRAG = 6 * MiB;
constexpr size_t FG_RT = WS_FRAG + 393216;
constexpr size_t FG_W2 = WS_FRAG, FG_A2 = FG_W2 + 65536, FG_WA = FG_A2 + 65536, FG_WX = FG_WA + 65536, FG_G2 = FG_WX + 65536;
static_assert(WS_ROUTE + RT_END <= 6 * MiB, "routing arrays overflow");

__device__ __forceinline__ float bf2f(bf16_t v) { return __uint_as_float(((unsigned)v) << 16); }
typedef __bf16 bf16x2_hw __attribute__((ext_vector_type(2)));
typedef float f32x2_hw __attribute__((ext_vector_type(2)));
__device__ __forceinline__ unsigned pk2(float lo, float hi) { const f32x2_hw v = {lo, hi}; const bf16x2_hw b = __builtin_convertvector(v, bf16x2_hw); return __builtin_bit_cast(unsigned, b); }
__device__ __forceinline__ bf16_t f2bf(float f) { const __bf16 b = (__bf16)f; return __builtin_bit_cast(bf16_t, b); }
template <int CTRL> __device__ __forceinline__ float dpp_(float x) { return __builtin_bit_cast(float, __builtin_amdgcn_mov_dpp(__builtin_bit_cast(int, x), CTRL, 0xf, 0xf, true)); }
__device__ __forceinline__ float row16_sum(float v) {
    v += dpp_<0xB1>(v); v += dpp_<0x4E>(v); v += dpp_<0x124>(v); v += dpp_<0x128>(v); return v; }
__device__ __forceinline__ float xrow16_sum(float x) {
    auto s = __builtin_amdgcn_permlane16_swap(__float_as_uint(x), __float_as_uint(x), false, false);
    x = __uint_as_float(s[0]) + __uint_as_float(s[1]);
    auto t = __builtin_amdgcn_permlane32_swap(__float_as_uint(x), __float_as_uint(x), false, false);
    return __uint_as_float(t[0]) + __uint_as_float(t[1]); }
__device__ __forceinline__ float xrow32_sum(float x) {
    auto s = __builtin_amdgcn_permlane16_swap(__float_as_uint(x), __float_as_uint(x), false, false);
    return __uint_as_float(s[0]) + __uint_as_float(s[1]); }
__device__ __forceinline__ float wave_sum(float v) { return xrow16_sum(row16_sum(v)); }
__device__ __forceinline__ float sigmoidf_(float x) { return 1.f / (1.f + __expf(-x)); }
__device__ __forceinline__ float softplusf_(float x) { return fmaxf(x, 0.f) + log1pf(__expf(-fabsf(x))); }
__device__ __forceinline__ float siluf_(float x) { return x * sigmoidf_(x); }
__device__ __forceinline__ float gelu_tanhf_(float x) { const float c = 0.7978845608028654f; return 0.5f * x * (1.f + tanhf(c * (x + 0.044715f * x * x * x))); }

struct Args {
    const float* in[35];
    float* out;
    unsigned char* ws;
    int ph_lo, ph_hi;
};

#define XB_TMO      128
#define XB_XCNT(j)  (256  + 64 * (j))
#define XB_XSUB(j)  (1280 + 64 * (j))
#define XB_XGEN(j)  (2304 + 64 * (j))
#define XB_TOP      3328
#define XB_TOPGEN   3392
#define XCD_BAR_WORDS 3456
#define XB_SPIN_CAP (1u << 18)
__device__ __forceinline__ unsigned xb_ld(unsigned* p)              { return __hip_atomic_load(p, __ATOMIC_RELAXED, __HIP_MEMORY_SCOPE_AGENT); }
__device__ __forceinline__ unsigned xb_add(unsigned* p, unsigned v) { return __hip_atomic_fetch_add(p, v, __ATOMIC_RELAXED, __HIP_MEMORY_SCOPE_AGENT); }
__device__ __forceinline__ unsigned xb_xcc_id() { return (unsigned)__builtin_amdgcn_s_getreg((3 << 11) | 20) & 0xFu; }
#define XB_SPIN(cond, bar) do { unsigned _sp = 0; while (cond) { __builtin_amdgcn_s_sleep(1); \
    if ((++_sp & 255u) == 0u) { if (xb_ld(&(bar)[XB_TMO])) break; if (_sp > XB_SPIN_CAP) { atomicAdd(&(bar)[XB_TMO], 1u); break; } } } } while (0)
struct XcdBarrier { unsigned* bar; unsigned x; volatile LAS unsigned* st; };
__device__ __forceinline__ XcdBarrier xcd_barrier_post(unsigned* bar, volatile LAS unsigned* st) {
    XcdBarrier b; b.bar = bar; b.x = xb_xcc_id(); b.st = st;
    if (threadIdx.x == 0) (void)xb_add(&bar[XB_XCNT(b.x)], 1u);
    return b;
}
__device__ __forceinline__ void xcd_barrier_complete(unsigned* bar, unsigned x, unsigned& nloc, unsigned& nx) {
    const unsigned G = gridDim.x * gridDim.y * gridDim.z;
    unsigned sum, cnt, mine, sp = 0u;
    for (;;) {
        sum = 0u; cnt = 0u; mine = 0u;
#pragma unroll
        for (unsigned j = 0; j < 16; ++j) { const unsigned c = xb_ld(&bar[XB_XCNT(j)]); sum += c; cnt += (c > 0u) ? 1u : 0u; mine = (j == x) ? c : mine; }
        if (sum == G) break;
        __builtin_amdgcn_s_sleep(1);
        if ((++sp & 255u) == 0u) { if (xb_ld(&bar[XB_TMO])) break; if (sp > XB_SPIN_CAP) { atomicAdd(&bar[XB_TMO], 1u); break; } }
    }
    nloc = mine > 0u ? mine : 1u; nx = cnt > 0u ? cnt : 1u;
}
__device__ __forceinline__ void xcd_barrier(const XcdBarrier& b) {
    asm volatile("s_waitcnt vmcnt(0)" ::: "memory");
    __syncthreads();
    if (threadIdx.x == 0) {
        unsigned* bar = b.bar;
        __builtin_amdgcn_s_waitcnt(0);
        unsigned nloc = b.st[0], nx = b.st[1];
        if (nloc == 0u) { xcd_barrier_complete(bar, b.x, nloc, nx); b.st[0] = nloc; b.st[1] = nx; }
        const unsigned old = xb_add(&bar[XB_XSUB(b.x)], 1u);
        const unsigned gen = old / nloc;
        if (old + 1u == (gen + 1u) * nloc) {
            __builtin_amdgcn_fence(__ATOMIC_RELEASE, "agent");
            asm volatile("s_waitcnt vmcnt(0)" ::: "memory");
            const unsigned og = xb_add(&bar[XB_TOP], 1u);
            const unsigned tg = og / nx;
            if (og + 1u == (tg + 1u) * nx) xb_add(&bar[XB_TOPGEN], 1u);
            else XB_SPIN(xb_ld(&bar[XB_TOPGEN]) == tg, bar);
            __builtin_amdgcn_fence(__ATOMIC_ACQUIRE, "agent");
            xb_add(&bar[XB_XGEN(b.x)], 1u);
            asm volatile("s_waitcnt vmcnt(0)" ::: "memory");
        } else {
            XB_SPIN(xb_ld(&bar[XB_XGEN(b.x)]) == gen, bar);
            __builtin_amdgcn_fence(__ATOMIC_ACQUIRE, "agent");
            asm volatile("s_waitcnt vmcnt(0)" ::: "memory");
        }
    }
    __syncthreads();
}

namespace pg8 {
typedef short bf16x8 __attribute__((ext_vector_type(8)));
typedef unsigned u32x4 __attribute__((ext_vector_type(4)));
typedef int v4i_t __attribute__((ext_vector_type(4)));
constexpr int BM = 256, BK = 64, HALF = 128, HTB = HALF * BK * 2, STAGE_BYTES = 8 * HTB, NXCD = 8, WGM = 8;
__device__ __forceinline__ int lds_byte(int r, int c) { const int st = (r >> 4) * 2 + (c >> 5), rr = r & 15, cc = c & 31, ob = rr * 64 + cc * 2; return st * 1024 + (ob ^ (((ob >> 9) & 1) << 5)); }
__device__ __forceinline__ void stage_rc(int b, int& R, int& C) { const int st = b / 1024, sb = b % 1024, swz = sb ^ (((sb >> 9) & 1) << 5); R = (st >> 1) * 16 + swz / 64; C = (st & 1) * 32 + (swz % 64) / 2; }
__device__ __forceinline__ int perm32(int rho) { const int n = rho >> 4, i = rho & 15; return 8 * (i >> 2) + 4 * n + (i & 3); }
__device__ __forceinline__ unsigned cvt_pk_bf16(float lo, float hi) { unsigned r; asm volatile("v_cvt_pk_bf16_f32 %0, %1, %2" : "=v"(r) : "v"(lo), "v"(hi)); return r; }

struct Unit { int pm, pn; const char* B; };

struct DenseOrder {
    int nM, nN, nwg, G, c; const char* Bt; size_t bstep;
    __device__ void init(int M, int N, int K, int G_, int c_, const void* Bt_) { nM = M / BM; nN = N / BM; nwg = nM * nN; G = G_; c = c_; Bt = (const char*)Bt_; bstep = (size_t)BM * K * 2; }
    __device__ bool next(int i, Unit& u) const {
        const long L = (long)i * G + c; if (L >= nwg) return false;
        int wgid = (int)L; { const int q = nwg / NXCD, r = nwg % NXCD, xcd = wgid % NXCD, off = wgid / NXCD; wgid = (xcd < r ? xcd * (q + 1) : r * (q + 1) + (xcd - r) * q) + off; }
        const int nig = WGM * nN, gid = wgid / nig, fm = gid * WGM, gsz = (nM - fm) < WGM ? (nM - fm) : WGM;
        u.pm = fm + ((wgid % nig) % gsz); u.pn = (wgid % nig) / gsz; u.B = Bt + (size_t)u.pn * bstep; return true;
    }
    __device__ __forceinline__ int arow(const Unit& u, int r) const { return u.pm * BM + r; }
};
struct MoeOrder {
    int G, c, nN, ntiles; const LAS int* pst; const int* rowidx; const char* Bt; size_t estep, bstep;
    __device__ bool next(int i, Unit& u) const {
        const int cc = (G % NXCD == 0) ? (c % NXCD) * (G / NXCD) + c / NXCD : c;
        const int L = i * G + cc; if (L >= ntiles * nN) return false;
        u.pm = L / nN; u.pn = L % nN; const int row0 = u.pm * BM; int e = 0;
#pragma unroll
        for (int st = NEXP / 2; st > 0; st >>= 1) if (row0 >= pst[e + st]) e += st;
        u.B = Bt + (size_t)e * estep + (size_t)u.pn * bstep; return true;
    }
    __device__ __forceinline__ int arow(const Unit& u, int r) const { if (!rowidx) return u.pm * BM + r; const int t = rowidx[u.pm * BM + r]; return t < 0 ? 0 : t; }
};

struct EpiBf16I { static constexpr bool PERM = true; bf16_t* O; int ldc; const float* rowscale; const unsigned* colmax;
    __device__ __forceinline__ void operator()(const f32x4 (&acc)[2][2][4][2], const Unit& u, int wr, int wc, int fr, int fq) const {
        const int row0 = u.pm * BM + wr * 64 + fr, col0 = u.pn * BM + wc * 32 + 8 * fq;
        float rsc[8]; f32x4 cs[2][2];
#pragma unroll
        for (int q = 0; q < 8; ++q) rsc[q] = rowscale[row0 + (q >> 2) * HALF + (q & 3) * 16] * (1.f / 127.f);
#pragma unroll
        for (int bj = 0; bj < 2; ++bj)
#pragma unroll
            for (int n = 0; n < 2; ++n) { const u32x4 c4 = *(const u32x4*)(colmax + col0 + bj * HALF + 4 * n); cs[bj][n] = (f32x4){__uint_as_float(c4.x), __uint_as_float(c4.y), __uint_as_float(c4.z), __uint_as_float(c4.w)} * (1.f / 127.f); }
#pragma unroll
        for (int ai = 0; ai < 2; ++ai)
#pragma unroll
            for (int m = 0; m < 4; ++m) { bf16_t* rowp = O + (size_t)(row0 + ai * HALF + m * 16) * ldc + col0; const float rs = rsc[ai * 4 + m];
#pragma unroll
                for (int bj = 0; bj < 2; ++bj) { const v4i_t i0 = __builtin_bit_cast(v4i_t, acc[ai][bj][m][0]), i1 = __builtin_bit_cast(v4i_t, acc[ai][bj][m][1]);
                    const f32x4 s0 = cs[bj][0] * rs, s1 = cs[bj][1] * rs;
                    u32x4 w; w.x = cvt_pk_bf16((float)i0[0] * s0[0], (float)i0[1] * s0[1]); w.y = cvt_pk_bf16((float)i0[2] * s0[2], (float)i0[3] * s0[3]);
                    w.z = cvt_pk_bf16((float)i1[0] * s1[0], (float)i1[1] * s1[1]); w.w = cvt_pk_bf16((float)i1[2] * s1[2], (float)i1[3] * s1[3]);
                    *(u32x4*)(rowp + bj * HALF) = w; } }
    } };
struct EpiBf16IT { static constexpr bool PERM = true; bf16_t* O; int nf; const float* tokscale; const unsigned* chmax;
    __device__ __forceinline__ void operator()(const f32x4 (&acc)[2][2][4][2], const Unit& u, int wr, int wc, int fr, int fq) const {
        const int row0 = u.pm * BM + wr * 64 + fr, col0 = u.pn * BM + wc * 32 + 8 * fq;
        float rsc[8]; f32x4 cs[2][2];
#pragma unroll
        for (int q = 0; q < 8; ++q) rsc[q] = __uint_as_float(chmax[row0 + (q >> 2) * HALF + (q & 3) * 16]) * (1.f / 127.f);
#pragma unroll
        for (int bj = 0; bj < 2; ++bj)
#pragma unroll
            for (int n = 0; n < 2; ++n) cs[bj][n] = *(const f32x4*)(tokscale + col0 + bj * HALF + 4 * n) * (1.f / 127.f);
#pragma unroll
        for (int ai = 0; ai < 2; ++ai)
#pragma unroll
            for (int m = 0; m < 4; ++m) { const int nidx = row0 + ai * HALF + m * 16; const float rs = rsc[ai * 4 + m];
#pragma unroll
                for (int bj = 0; bj < 2; ++bj) { const v4i_t i0 = __builtin_bit_cast(v4i_t, acc[ai][bj][m][0]), i1 = __builtin_bit_cast(v4i_t, acc[ai][bj][m][1]);
                    const f32x4 s0 = cs[bj][0] * rs, s1 = cs[bj][1] * rs; const int tok0 = col0 + bj * HALF;
                    u32x4 w; w.x = cvt_pk_bf16((float)i0[0] * s0[0], (float)i0[1] * s0[1]); w.y = cvt_pk_bf16((float)i0[2] * s0[2], (float)i0[3] * s0[3]);
                    w.z = cvt_pk_bf16((float)i1[0] * s1[0], (float)i1[1] * s1[1]); w.w = cvt_pk_bf16((float)i1[2] * s1[2], (float)i1[3] * s1[3]);
                    *(u32x4*)(O + ((size_t)(tok0 >> 4) * nf + nidx) * 16 + (tok0 & 8)) = w; } }
    } };
struct EpiBf16 { static constexpr bool PERM = true; bf16_t* O; int ldc;
    __device__ __forceinline__ void operator()(const f32x4 (&acc)[2][2][4][2], const Unit& u, int wr, int wc, int fr, int fq) const {
        const int row0 = u.pm * BM + wr * 64 + fr, col0 = u.pn * BM + wc * 32 + 8 * fq;
#pragma unroll
        for (int ai = 0; ai < 2; ++ai)
#pragma unroll
            for (int m = 0; m < 4; ++m) { bf16_t* rowp = O + (size_t)(row0 + ai * HALF + m * 16) * ldc + col0;
#pragma unroll
                for (int bj = 0; bj < 2; ++bj) { const f32x4 v0 = acc[ai][bj][m][0], v1 = acc[ai][bj][m][1];
                    u32x4 w; w.x = cvt_pk_bf16(v0[0], v0[1]); w.y = cvt_pk_bf16(v0[2], v0[3]); w.z = cvt_pk_bf16(v1[0], v1[1]); w.w = cvt_pk_bf16(v1[2], v1[3]);
                    *(u32x4*)(rowp + bj * HALF) = w; } }
    } };
template <bool XF32> struct EpiResid { static constexpr bool PERM = true; const void* __restrict__ X; bf16_t* __restrict__ O;
    __device__ __forceinline__ void operator()(const f32x4 (&acc)[2][2][4][2], const Unit& u, int wr, int wc, int fr, int fq) const {
        const int row0 = u.pm * BM + wr * 64 + fr, col0 = u.pn * BM + wc * 32 + 8 * fq;
        if constexpr (XF32) {
#pragma unroll
            for (int ai = 0; ai < 2; ++ai)
#pragma unroll
                for (int mp = 0; mp < 2; ++mp) { f32x4 x[2][2][2];
#pragma unroll
                    for (int mm = 0; mm < 2; ++mm)
#pragma unroll
                        for (int bj = 0; bj < 2; ++bj) { const float* xp = (const float*)X + (size_t)(row0 + ai * HALF + (mp * 2 + mm) * 16) * DM + col0 + bj * HALF; x[mm][bj][0] = *(const f32x4*)xp; x[mm][bj][1] = *(const f32x4*)(xp + 4); }
#pragma unroll
                    for (int mm = 0; mm < 2; ++mm)
#pragma unroll
                        for (int bj = 0; bj < 2; ++bj) { const f32x4 v0 = x[mm][bj][0] + acc[ai][bj][mp * 2 + mm][0], v1 = x[mm][bj][1] + acc[ai][bj][mp * 2 + mm][1];
                            u32x4 w; w.x = cvt_pk_bf16(v0[0], v0[1]); w.y = cvt_pk_bf16(v0[2], v0[3]); w.z = cvt_pk_bf16(v1[0], v1[1]); w.w = cvt_pk_bf16(v1[2], v1[3]);
                            *(u32x4*)(O + (size_t)(row0 + ai * HALF + (mp * 2 + mm) * 16) * DM + col0 + bj * HALF) = w; } }
        } else {
#pragma unroll
            for (int ai = 0; ai < 2; ++ai) { u32x4 x[4][2];
#pragma unroll
                for (int m = 0; m < 4; ++m)
#pragma unroll
                    for (int bj = 0; bj < 2; ++bj) x[m][bj] = *(const u32x4*)((const bf16_t*)X + (size_t)(row0 + ai * HALF + m * 16) * DM + col0 + bj * HALF);
#pragma unroll
                for (int m = 0; m < 4; ++m)
#pragma unroll
                    for (int bj = 0; bj < 2; ++bj) { const u32x4 o = x[m][bj];
                        const f32x4 v0 = (f32x4){__uint_as_float(o.x << 16), __uint_as_float(o.x & 0xffff0000u), __uint_as_float(o.y << 16), __uint_as_float(o.y & 0xffff0000u)} + acc[ai][bj][m][0];
                        const f32x4 v1 = (f32x4){__uint_as_float(o.z << 16), __uint_as_float(o.z & 0xffff0000u), __uint_as_float(o.w << 16), __uint_as_float(o.w & 0xffff0000u)} + acc[ai][bj][m][1];
                        u32x4 w; w.x = cvt_pk_bf16(v0[0], v0[1]); w.y = cvt_pk_bf16(v0[2], v0[3]); w.z = cvt_pk_bf16(v1[0], v1[1]); w.w = cvt_pk_bf16(v1[2], v1[3]);
                        *(u32x4*)(O + (size_t)(row0 + ai * HALF + m * 16) * DM + col0 + bj * HALF) = w; } }
        }
    } };
struct EpiSwiGLU { static constexpr bool PERM = true; bf16_t* H; const float* tscale;
    __device__ __forceinline__ void operator()(const f32x4 (&acc)[2][2][4][2], const Unit& u, int wr, int wc, int fr, int fq) const {
        const int row0 = u.pm * BM + wr * 64 + fr, col0 = u.pn * HALF + wc * 32 + 8 * fq;
        const float s0 = tscale[2 * u.pm], s1 = tscale[2 * u.pm + 1];
#pragma unroll
        for (int ai = 0; ai < 2; ++ai)
#pragma unroll
            for (int m = 0; m < 4; ++m) { float h[8];
#pragma unroll
                for (int n = 0; n < 2; ++n) { const v4i_t gi = __builtin_bit_cast(v4i_t, acc[ai][0][m][n]), ui = __builtin_bit_cast(v4i_t, acc[ai][1][m][n]);
#pragma unroll
                    for (int j = 0; j < 4; ++j) { const float g = (float)gi[j] * s0; h[n * 4 + j] = g * __builtin_amdgcn_rcpf(1.f + __expf(-g)) * ((float)ui[j] * s1); } }
                u32x4 w; w.x = cvt_pk_bf16(h[0], h[1]); w.y = cvt_pk_bf16(h[2], h[3]); w.z = cvt_pk_bf16(h[4], h[5]); w.w = cvt_pk_bf16(h[6], h[7]);
                *(u32x4*)(H + (size_t)(row0 + ai * HALF + m * 16) * FF + col0) = w; }
    } };
struct EpiDown { static constexpr bool PERM = true; bf16_t* Y; const int* row_tok; const int* row_slot; const float* row_gate;
    __device__ __forceinline__ void operator()(const f32x4 (&acc)[2][2][4][2], const Unit& u, int wr, int wc, int fr, int fq) const {
        const int row0 = u.pm * BM + wr * 64 + fr, col0 = u.pn * BM + wc * 32 + 8 * fq;
        int tk[8], sl[8]; float gt[8];
#pragma unroll
        for (int q = 0; q < 8; ++q) { const int r = row0 + (q >> 2) * HALF + (q & 3) * 16; tk[q] = row_tok[r]; sl[q] = row_slot[r]; gt[q] = row_gate[r]; }
#pragma unroll
        for (int ai = 0; ai < 2; ++ai)
#pragma unroll
            for (int m = 0; m < 4; ++m) { const int q = ai * 4 + m;
                if (tk[q] < 0) continue;
                bf16_t* rowp = Y + (size_t)sl[q] * DM + col0;
#pragma unroll
                for (int bj = 0; bj < 2; ++bj) { const f32x4 v0 = acc[ai][bj][m][0] * gt[q], v1 = acc[ai][bj][m][1] * gt[q];
                    u32x4 w; w.x = cvt_pk_bf16(v0[0], v0[1]); w.y = cvt_pk_bf16(v0[2], v0[3]); w.z = cvt_pk_bf16(v1[0], v1[1]); w.w = cvt_pk_bf16(v1[2], v1[3]);
                    *(u32x4*)(rowp + bj * HALF) = w; } }
    } };

template <class Epi, class Sched, bool I8 = false>
__device__ __forceinline__ void gemm_phase(LAS unsigned char* lds, const char* A, const unsigned lda_b, const int K, const Sched& S, const Epi& E) {
    const int tid = threadIdx.x, wid = __builtin_amdgcn_readfirstlane(tid >> 6), lane = tid & 63, wr = wid >> 2, wc = wid & 3, fr = lane & 15, fq = lane >> 4;
    const int nt = K / BK;
    unsigned voffB[2];
#pragma unroll
    for (int i = 0; i < 2; ++i) { int R, C; stage_rc(tid * 16 + i * 8192, R, C); const int Rb = Epi::PERM ? ((R & ~31) + perm32(R & 31)) : R; voffB[i] = (unsigned)(Rb * K + C) * 2u; }
    const size_t kstep = (size_t)(BK * 2);
    const size_t hstepB = (size_t)HALF * K * 2;
    const unsigned ldsw = (unsigned)wid * 1024u;
    const int aoff = lds_byte(wr * 64 + fr, fq * 8), boff = lds_byte(wc * 32 + fr, fq * 8);
#define PG8_SA(b, h) (((b) * 2 + (h)) * HTB)
#define PG8_SB(b, h) ((4 + (b) * 2 + (h)) * HTB)
#define PG8_STAGE(bufoff, gbase, voff) do { _Pragma("unroll") for (int _i = 0; _i < 2; ++_i) \
        __builtin_amdgcn_global_load_lds((const unsigned*)((const char*)(gbase) + (voff)[_i]), (LAS unsigned*)(lds + (bufoff) + ldsw + _i * 8192), 16, 0, 0); } while (0)
#define PG8_LDA(dst, b, h) do { _Pragma("unroll") for (int m = 0; m < 4; ++m) _Pragma("unroll") for (int k = 0; k < 2; ++k) dst[m][k] = *(const LAS bf16x8*)(lds + PG8_SA(b, h) + aoff + m * 2048 + k * 1024); } while (0)
#define PG8_LDB(dst, b, h) do { _Pragma("unroll") for (int n = 0; n < 2; ++n) _Pragma("unroll") for (int k = 0; k < 2; ++k) dst[n][k] = *(const LAS bf16x8*)(lds + PG8_SB(b, h) + boff + n * 2048 + k * 1024); } while (0)
#define PG8_MMA(ai, bj, At, Bt) do { __builtin_amdgcn_s_setprio(1); _Pragma("unroll") for (int m = 0; m < 4; ++m) _Pragma("unroll") for (int n = 0; n < 2; ++n) _Pragma("unroll") for (int k = 0; k < 2; ++k) { \
        if constexpr (I8) acc[ai][bj][m][n] = __builtin_bit_cast(f32x4, __builtin_amdgcn_mfma_i32_16x16x64_i8(__builtin_bit_cast(v4i_t, Bt[n][k]), __builtin_bit_cast(v4i_t, At[m][k]), __builtin_bit_cast(v4i_t, acc[ai][bj][m][n]), 0, 0, 0)); \
        else acc[ai][bj][m][n] = __builtin_amdgcn_mfma_f32_16x16x32_bf16(Bt[n][k], At[m][k], acc[ai][bj][m][n], 0, 0, 0); } __builtin_amdgcn_s_setprio(0); } while (0)
#define PG8_WAIT_V(n) asm volatile("s_waitcnt vmcnt(" #n ")" ::: "memory")
#define PG8_WAIT_L(n) asm volatile("s_waitcnt lgkmcnt(" #n ")" ::: "memory")
#define PG8_BAR __builtin_amdgcn_s_barrier()
#define PG8_SCHED __builtin_amdgcn_sched_barrier(0)
#define PG8_AOFF(dst, u) do { int _tz = threadIdx.x; asm volatile("" : "+v"(_tz)); _Pragma("unroll") for (int _i = 0; _i < 2; ++_i) { int _R, _C; stage_rc(_tz * 16 + _i * 8192, _R, _C); \
        _Pragma("unroll") for (int _h = 0; _h < 2; ++_h) dst[_h][_i] = (unsigned)S.arow(u, _h * HALF + _R) * lda_b + (unsigned)_C * 2u; } } while (0)
    Unit cur, nxt; int ui = 0;
    if (!S.next(0, cur)) return;
    f32x4 acc[2][2][4][2];
#pragma unroll
    for (int a = 0; a < 2; ++a)
#pragma unroll
        for (int b = 0; b < 2; ++b)
#pragma unroll
            for (int m = 0; m < 4; ++m)
#pragma unroll
                for (int n = 0; n < 2; ++n) acc[a][b][m][n] = (f32x4){0.f, 0.f, 0.f, 0.f};
    bf16x8 At[4][2], B0[2][2], B1[2][2];
    unsigned vA[2][2], vAn[2][2];
    PG8_AOFF(vA, cur);
    const char* cB = cur.B;
    PG8_STAGE(PG8_SB(0, 0), cB, voffB); PG8_STAGE(PG8_SA(0, 0), A, vA[0]); PG8_STAGE(PG8_SB(0, 1), cB + hstepB, voffB); PG8_STAGE(PG8_SA(0, 1), A, vA[1]);
    if (wr == 1) PG8_BAR;
    PG8_WAIT_V(4); PG8_BAR;
    PG8_STAGE(PG8_SB(1, 0), cB + kstep, voffB); PG8_STAGE(PG8_SA(1, 0), A + kstep, vA[0]); PG8_STAGE(PG8_SB(1, 1), cB + hstepB + kstep, voffB);
    PG8_WAIT_V(6); PG8_BAR;
    for (;;) {
        const bool has_next = S.next(ui + 1, nxt);
        if (has_next) { PG8_AOFF(vAn, nxt); } else {
#pragma unroll
            for (int h = 0; h < 2; ++h)
#pragma unroll
                for (int i = 0; i < 2; ++i) vAn[h][i] = vA[h][i]; }
        const char* nB = has_next ? nxt.B : cB;
        for (int t = 0; t < nt; t += 2) {
            const bool last = (t == nt - 2);
            const char* a1 = A + (size_t)(t + 1) * kstep;
            const char* a2 = last ? A : A + (size_t)(t + 2) * kstep; const char* b2 = last ? nB : cB + (size_t)(t + 2) * kstep;
            const char* a3 = a2 + kstep; const char* b3 = b2 + kstep;
            unsigned o2[2][2];
#pragma unroll
            for (int h = 0; h < 2; ++h)
#pragma unroll
                for (int i = 0; i < 2; ++i) o2[h][i] = last ? vAn[h][i] : vA[h][i];
            PG8_LDB(B0, 0, 0); PG8_SCHED; PG8_LDA(At, 0, 0); PG8_STAGE(PG8_SA(1, 1), a1, vA[1]);
            PG8_WAIT_L(8); PG8_BAR; PG8_WAIT_L(0); PG8_MMA(0, 0, At, B0); PG8_BAR; PG8_SCHED;
            PG8_LDB(B1, 0, 1); PG8_STAGE(PG8_SB(0, 0), b2, voffB);
            PG8_BAR; PG8_WAIT_L(0); PG8_MMA(0, 1, At, B1); PG8_BAR;
            PG8_LDA(At, 0, 1); PG8_STAGE(PG8_SA(0, 0), a2, o2[0]);
            PG8_BAR; PG8_WAIT_L(0); PG8_MMA(1, 0, At, B0); PG8_BAR; PG8_SCHED;
            PG8_STAGE(PG8_SB(0, 1), b2 + hstepB, voffB);
            PG8_WAIT_V(6); PG8_BAR; PG8_MMA(1, 1, At, B1); PG8_BAR;
            PG8_LDB(B0, 1, 0); PG8_SCHED; PG8_LDA(At, 1, 0); PG8_STAGE(PG8_SA(0, 1), a2, o2[1]);
            PG8_WAIT_L(8); PG8_BAR; PG8_WAIT_L(0); PG8_MMA(0, 0, At, B0); PG8_BAR; PG8_SCHED;
            PG8_LDB(B1, 1, 1); PG8_STAGE(PG8_SB(1, 0), b3, voffB);
            PG8_BAR; PG8_WAIT_L(0); PG8_MMA(0, 1, At, B1); PG8_BAR;
            PG8_LDA(At, 1, 1); PG8_STAGE(PG8_SA(1, 0), a3, o2[0]);
            PG8_BAR; PG8_WAIT_L(0); PG8_MMA(1, 0, At, B0); PG8_BAR; PG8_SCHED;
            PG8_STAGE(PG8_SB(1, 1), b3 + hstepB, voffB);
            PG8_WAIT_V(6); PG8_BAR; PG8_MMA(1, 1, At, B1); PG8_BAR;
        }
        E(acc, cur, wr, wc, fr, fq);
        if (!has_next) break;
#pragma unroll
        for (int a = 0; a < 2; ++a)
#pragma unroll
            for (int b = 0; b < 2; ++b)
#pragma unroll
                for (int m = 0; m < 4; ++m)
#pragma unroll
                    for (int n = 0; n < 2; ++n) acc[a][b][m][n] = (f32x4){0.f, 0.f, 0.f, 0.f};
        cur = nxt; cB = nB; ++ui;
#pragma unroll
        for (int h = 0; h < 2; ++h)
#pragma unroll
            for (int i = 0; i < 2; ++i) vA[h][i] = vAn[h][i];
    }
    PG8_WAIT_V(0);
    if (wr == 0) PG8_BAR;
    PG8_BAR;
#undef PG8_SA
#undef PG8_SB
#undef PG8_STAGE
#undef PG8_LDA
#undef PG8_LDB
#undef PG8_MMA
#undef PG8_WAIT_V
#undef PG8_WAIT_L
#undef PG8_BAR
#undef PG8_SCHED
#undef PG8_AOFF
}
}

template <int MODE>
__device__ __forceinline__ void transpose_item(const float* W, int K, int N, bf16_t* WT, LAS float* scr, int item, int lane) {
    const int nblk = N / 64, kb = item / nblk, nb = item % nblk, k0 = 64 * kb, n0 = 64 * nb;
    const int lr = lane >> 4, lc = (lane & 15) * 4;
    float4 v[16];
#pragma unroll
    for (int i = 0; i < 16; ++i) v[i] = *(const float4*)(W + (size_t)(k0 + 4 * i + lr) * N + n0 + lc);
#pragma unroll
    for (int i = 0; i < 16; ++i) { LAS float* d = scr + (4 * i + lr) * 66 + lc; *(LAS f32x2_hw*)d = (f32x2_hw){v[i].x, v[i].y}; *(LAS f32x2_hw*)(d + 2) = (f32x2_hw){v[i].z, v[i].w}; }
    asm volatile("s_waitcnt lgkmcnt(0)" ::: "memory");
    const int c = lane & 7;
#pragma unroll
    for (int j = 0; j < 8; ++j) { const int n = (lane >> 3) + 8 * j; const LAS float* sp = scr + (8 * c) * 66 + n;
        pg8::u32x4 o; o.x = pk2(sp[0 * 66], sp[1 * 66]); o.y = pk2(sp[2 * 66], sp[3 * 66]); o.z = pk2(sp[4 * 66], sp[5 * 66]); o.w = pk2(sp[6 * 66], sp[7 * 66]);
        const int nn = n0 + n; const int dr = MODE == 0 ? nn : (256 * (nn >> 7) + (nn & 127) + (MODE == 2 ? 128 : 0));
        *(pg8::u32x4*)(WT + (size_t)dr * K + k0 + 8 * c) = o; }
    asm volatile("s_waitcnt lgkmcnt(0)" ::: "memory");
}
__device__ __forceinline__ float wave_max(float v) {
    v = fmaxf(v, dpp_<0xB1>(v)); v = fmaxf(v, dpp_<0x4E>(v)); v = fmaxf(v, dpp_<0x124>(v)); v = fmaxf(v, dpp_<0x128>(v));
    auto s = __builtin_amdgcn_permlane16_swap(__float_as_uint(v), __float_as_uint(v), false, false); v = fmaxf(__uint_as_float(s[0]), __uint_as_float(s[1]));
    auto t = __builtin_amdgcn_permlane32_swap(__float_as_uint(v), __float_as_uint(v), false, false); return fmaxf(__uint_as_float(t[0]), __uint_as_float(t[1])); }
__device__ __forceinline__ unsigned q8x4(float a, float b, float c, float d, float qs) {
    const int ia = (int)rintf(fminf(fmaxf(a * qs, -127.f), 127.f)), ib = (int)rintf(fminf(fmaxf(b * qs, -127.f), 127.f)), ic = (int)rintf(fminf(fmaxf(c * qs, -127.f), 127.f)), id = (int)rintf(fminf(fmaxf(d * qs, -127.f), 127.f));
    return (unsigned)(ia & 255) | ((unsigned)(ib & 255) << 8) | ((unsigned)(ic & 255) << 16) | ((unsigned)(id & 255) << 24); }
__device__ __noinline__ void ph_wmax(const float* wg, const float* wu, unsigned* wmax, int bid, int nblk) {
    const int wave = threadIdx.x >> 6, lane = threadIdx.x & 63, gw = bid * 8 + wave, NGW = nblk * 8;
    constexpr int IT = (DM / 64) * (FF / 64);
    for (int it = gw; it < 2 * NEXP * 2 * IT; it += NGW) { const int mat = it / IT, tl = it % IT; const int le = mat >> 1, gu = mat & 1;
        const float* W = (gu ? wu : wg) + (size_t)le * DM * FF; const int k0 = 64 * (tl / (FF / 64)), n0 = 64 * (tl % (FF / 64));
        float m = 0.f;
#pragma unroll 4
        for (int i = 0; i < 16; ++i) { const float4 v = *(const float4*)(W + (size_t)(k0 + 4 * i + (lane >> 4)) * FF + n0 + (lane & 15) * 4); m = fmaxf(fmaxf(m, fmaxf(fabsf(v.x), fabsf(v.y))), fmaxf(fabsf(v.z), fabsf(v.w))); }
        m = wave_max(m);
        if (lane == 0) atomicMax(wmax + le * 2 + gu, __float_as_uint(m)); }
}
template <int MODE>
__device__ __forceinline__ void transpose_item_i8(const float* W, int K, int N, unsigned char* WT, LAS float* scr, int item, int lane, float qs) {
    const int nblk = N / 64, kb = item / nblk, nb = item % nblk, k0 = 64 * kb, n0 = 64 * nb;
    const int lr = lane >> 4, lc = (lane & 15) * 4;
    float4 v[16];
#pragma unroll
    for (int i = 0; i < 16; ++i) v[i] = *(const float4*)(W + (size_t)(k0 + 4 * i + lr) * N + n0 + lc);
#pragma unroll
    for (int i = 0; i < 16; ++i) { LAS float* d = scr + (4 * i + lr) * 66 + lc; *(LAS f32x2_hw*)d = (f32x2_hw){v[i].x, v[i].y}; *(LAS f32x2_hw*)(d + 2) = (f32x2_hw){v[i].z, v[i].w}; }
    asm volatile("s_waitcnt lgkmcnt(0)" ::: "memory");
    const int c = lane & 3;
#pragma unroll
    for (int j = 0; j < 4; ++j) { const int n = (lane >> 2) + 16 * j; const LAS float* sp = scr + (16 * c) * 66 + n;
        pg8::u32x4 o;
        o.x = q8x4(sp[0 * 66], sp[1 * 66], sp[2 * 66], sp[3 * 66], qs); o.y = q8x4(sp[4 * 66], sp[5 * 66], sp[6 * 66], sp[7 * 66], qs);
        o.z = q8x4(sp[8 * 66], sp[9 * 66], sp[10 * 66], sp[11 * 66], qs); o.w = q8x4(sp[12 * 66], sp[13 * 66], sp[14 * 66], sp[15 * 66], qs);
        const int nn = n0 + n; const int dr = MODE == 0 ? nn : (256 * (nn >> 7) + (nn & 127) + (MODE == 2 ? 128 : 0));
        *(pg8::u32x4*)(WT + (size_t)dr * K + k0 + 16 * c) = o; }
    asm volatile("s_waitcnt lgkmcnt(0)" ::: "memory");
}
__device__ __forceinline__ void transpose_item_i8c(const float* W, int K, int N, unsigned char* WT, LAS float* scr, int item, int lane, const unsigned* colmax) {
    const int nblk = N / 64, kb = item / nblk, nb = item % nblk, k0 = 64 * kb, n0 = 64 * nb;
    const int lr = lane >> 4, lc = (lane & 15) * 4;
    float4 v[16];
#pragma unroll
    for (int i = 0; i < 16; ++i) v[i] = *(const float4*)(W + (size_t)(k0 + 4 * i + lr) * N + n0 + lc);
#pragma unroll
    for (int i = 0; i < 16; ++i) { LAS float* d = scr + (4 * i + lr) * 66 + lc; *(LAS f32x2_hw*)d = (f32x2_hw){v[i].x, v[i].y}; *(LAS f32x2_hw*)(d + 2) = (f32x2_hw){v[i].z, v[i].w}; }
    asm volatile("s_waitcnt lgkmcnt(0)" ::: "memory");
    const int c = lane & 3;
#pragma unroll
    for (int j = 0; j < 4; ++j) { const int n = (lane >> 2) + 16 * j; const LAS float* sp = scr + (16 * c) * 66 + n;
        const float qs = 127.f / fmaxf(__uint_as_float(colmax[n0 + n]), 1e-30f);
        pg8::u32x4 o;
        o.x = q8x4(sp[0 * 66], sp[1 * 66], sp[2 * 66], sp[3 * 66], qs); o.y = q8x4(sp[4 * 66], sp[5 * 66], sp[6 * 66], sp[7 * 66], qs);
        o.z = q8x4(sp[8 * 66], sp[9 * 66], sp[10 * 66], sp[11 * 66], qs); o.w = q8x4(sp[12 * 66], sp[13 * 66], sp[14 * 66], sp[15 * 66], qs);
        *(pg8::u32x4*)(WT + (size_t)(n0 + n) * K + k0 + 16 * c) = o; }
    asm volatile("s_waitcnt lgkmcnt(0)" ::: "memory");
}
__device__ __forceinline__ void frag_build(const float* W, int ldw, int col0, int nks, bf16_t* dst, int lane) {
    const int q4 = lane >> 4, c16 = lane & 15;
    for (int ct = 0; ct < 4; ++ct) for (int ks = 0; ks < nks; ++ks) { float v[8];
#pragma unroll
        for (int jj = 0; jj < 8; ++jj) v[jj] = W[(size_t)(32 * ks + 8 * q4 + jj) * ldw + col0 + 16 * ct + c16];
        *(pg8::u32x4*)(dst + ((size_t)(ct * nks + ks) * 64 + lane) * 8) = (pg8::u32x4){pk2(v[0], v[1]), pk2(v[2], v[3]), pk2(v[4], v[5]), pk2(v[6], v[7])}; }
}
__device__ __forceinline__ void ph_cvt_frags(const Args& a) {
    const int wave = threadIdx.x >> 6, lane = threadIdx.x & 63, gw = blockIdx.x * 8 + wave;
    if (gw >= 40) {
        const int it = gw - 40; if (it >= 64) return;
        const int L = it >> 5, ks = it & 31, q4 = lane >> 4, c16 = lane & 15;
        const float* gain = a.in[2] + L * DM; const float* wg = a.in[28] + (size_t)L * DM * 4; const float* we = a.in[30] + (size_t)L * DM * 32;
        bf16_t* dh = (bf16_t*)(a.ws + FG_RT) + (size_t)L * 2 * 49152; bf16_t* dl = dh + 49152;
        for (int ct = 0; ct < 3; ++ct) { const int col = 16 * ct + c16; float hi[8], lo[8];
#pragma unroll
            for (int jj = 0; jj < 8; ++jj) { const int k = 32 * ks + 8 * q4 + jj; const float w = col < 4 ? wg[k * 4 + col] : (col < 36 ? we[k * 32 + col - 4] : 0.f); const float v = gain[k] * w;
                hi[jj] = bf2f(f2bf(v)); lo[jj] = v - hi[jj]; }
            const size_t o = ((size_t)(ks * 3 + ct) * 64 + lane) * 8;
            *(pg8::u32x4*)(dh + o) = (pg8::u32x4){pk2(hi[0], hi[1]), pk2(hi[2], hi[3]), pk2(hi[4], hi[5]), pk2(hi[6], hi[7])};
            *(pg8::u32x4*)(dl + o) = (pg8::u32x4){pk2(lo[0], lo[1]), pk2(lo[2], lo[3]), pk2(lo[4], lo[5]), pk2(lo[6], lo[7])}; }
        return; }
    const int arr = gw >> 3, h = gw & 7;
    if (arr == 0) frag_build(a.in[7], 512, 64 * h, 2, (bf16_t*)(a.ws + FG_W2) + h * 4096, lane);
    else if (arr == 1) frag_build(a.in[9], 512, 64 * h, 2, (bf16_t*)(a.ws + FG_A2) + h * 4096, lane);
    else if (arr == 2) frag_build(a.in[18] + h * 4096, 64, 0, 2, (bf16_t*)(a.ws + FG_WA) + h * 4096, lane);
    else if (arr == 3) frag_build(a.in[20] + h * 4096, 64, 0, 2, (bf16_t*)(a.ws + FG_WX) + h * 4096, lane);
    else frag_build(a.in[10], 512, 64 * h, 4, (bf16_t*)(a.ws + FG_G2) + h * 8192, lane);
}
__device__ __forceinline__ void ph_cvt_dense_a(const Args& a, LAS float* lds, unsigned* colmax) {
    const int wave = threadIdx.x >> 6, lane = threadIdx.x & 63, gw = blockIdx.x * 8 + wave, NGW = gridDim.x * 8;
    LAS float* scr = lds + wave * (64 * 66);
    constexpr int I0 = (DM / 64) * (ABC / 64), I1 = (DM / 64) * (DM / 64), I2 = (DM / 64) * (4096 / 64), I3 = I1;
    for (int it = gw; it < I0 + I1 + I2 + I3; it += NGW) { int r = it;
        if (r < I1) { transpose_item<0>(a.in[23], DM, DM, (bf16_t*)(a.ws + WD_ABOUT), scr, r, lane); continue; } r -= I1;
        if (r < I3) { transpose_item<0>(a.in[27], DM, DM, (bf16_t*)(a.ws + WD_COUT), scr, r, lane); continue; } r -= I3;
        const int m = r < I0 ? 0 : 1; if (m) r -= I0; const int N = m ? 4096 : ABC; const float* W = m ? a.in[24] : a.in[4];
        const int k0 = 64 * (r / (N / 64)), n0 = 64 * (r % (N / 64)); float mx[4] = {0.f, 0.f, 0.f, 0.f};
#pragma unroll 4
        for (int i = 0; i < 16; ++i) { const float4 v = *(const float4*)(W + (size_t)(k0 + 4 * i + (lane >> 4)) * N + n0 + (lane & 15) * 4);
            mx[0] = fmaxf(mx[0], fabsf(v.x)); mx[1] = fmaxf(mx[1], fabsf(v.y)); mx[2] = fmaxf(mx[2], fabsf(v.z)); mx[3] = fmaxf(mx[3], fabsf(v.w)); }
#pragma unroll
        for (int q = 0; q < 4; ++q) { float t = mx[q];
            auto s1 = __builtin_amdgcn_permlane16_swap(__float_as_uint(t), __float_as_uint(t), false, false); t = fmaxf(__uint_as_float(s1[0]), __uint_as_float(s1[1]));
            auto s2 = __builtin_amdgcn_permlane32_swap(__float_as_uint(t), __float_as_uint(t), false, false); t = fmaxf(__uint_as_float(s2[0]), __uint_as_float(s2[1]));
            if (lane < 16) atomicMax(colmax + (m ? ABC : 0) + n0 + lane * 4 + q, __float_as_uint(t)); } }
}
__device__ __forceinline__ void ph_cvt_dense_b(const Args& a, LAS float* lds, const unsigned* colmax, int m) {
    const int wave = threadIdx.x >> 6, lane = threadIdx.x & 63, gw = blockIdx.x * 8 + wave, NGW = gridDim.x * 8;
    LAS float* scr = lds + wave * (64 * 66);
    const int N = m ? 4096 : ABC; const int NI = (DM / 64) * (N / 64);
    for (int it = gw; it < NI; it += NGW) transpose_item_i8c(m ? a.in[24] : a.in[4], DM, N, a.ws + (m ? WD_CIN : WD_ABIN), scr, it, lane, colmax + (m ? ABC : 0));
}
__device__ __forceinline__ void ph_cvt_moe(const Args& a, int L, LAS float* lds, int bid, int nblk, int which) {
    const int wave = threadIdx.x >> 6, lane = threadIdx.x & 63, gw = bid * 8 + wave, NGW = nblk * 8;
    LAS float* scr = lds + wave * (64 * 66);
    constexpr int IG = (DM / 64) * (FF / 64), ID = (FF / 64) * (DM / 64);
    const int i0 = (which & 1) ? 0 : 2 * IG, IE = ((which & 1) ? 2 * IG : 0) + ((which & 2) ? ID : 0);
    unsigned char* gub = a.ws + (L ? WM_GU1 : WM_GU);
    for (int it = gw; it < NEXP * IE; it += NGW) { const int e = it / IE; int r = i0 + it % IE;
        unsigned char* gu = gub + (size_t)e * DM * DM; bf16_t* dn = (bf16_t*)(a.ws + WM_DN) + (size_t)e * DM * FF;
        const unsigned* wm = (const unsigned*)(a.ws + WS_CTL) + CW_WMAX + (L * NEXP + e) * 2;
        const size_t wo = ((size_t)L * NEXP + e) * DM * FF;
        if (r < IG) { transpose_item_i8<1>(a.in[32] + wo, DM, FF, gu, scr, r, lane, 127.f / fmaxf(__uint_as_float(wm[0]), 1e-30f)); continue; } r -= IG;
        if (r < IG) { transpose_item_i8<2>(a.in[33] + wo, DM, FF, gu, scr, r, lane, 127.f / fmaxf(__uint_as_float(wm[1]), 1e-30f)); continue; } r -= IG;
        transpose_item<0>(a.in[34] + wo, FF, DM, dn, scr, r, lane); }
}

__device__ __forceinline__ void load_row16(const float* row, int lane, float4 (&v)[4]) {
#pragma unroll
    for (int j = 0; j < 4; ++j) v[j] = *(const float4*)(row + lane * 4 + 256 * j);
}
__device__ __forceinline__ float row_sumsq(const float4 (&v)[4]) {
    float s = 0.f;
#pragma unroll
    for (int j = 0; j < 4; ++j) s += v[j].x * v[j].x + v[j].y * v[j].y + v[j].z * v[j].z + v[j].w * v[j].w;
    return wave_sum(s);
}
__device__ __forceinline__ void norm_row(float4 (&v)[4], const float* gain, int lane) {
    const float rs = rsqrtf(row_sumsq(v) * (1.f / DM) + 1e-6f);
#pragma unroll
    for (int j = 0; j < 4; ++j) { const float4 g = *(const float4*)(gain + lane * 4 + 256 * j);
        v[j].x *= rs * g.x; v[j].y *= rs * g.y; v[j].z *= rs * g.z; v[j].w *= rs * g.w; }
}
__device__ __forceinline__ void store_row_bf16(bf16_t* row, int lane, const float4 (&v)[4]) {
#pragma unroll
    for (int j = 0; j < 4; ++j) { uint2 o; o.x = f2bf(v[j].x) | ((unsigned)f2bf(v[j].y) << 16); o.y = f2bf(v[j].z) | ((unsigned)f2bf(v[j].w) << 16);
        *(uint2*)(row + lane * 4 + 256 * j) = o; }
}
__device__ __forceinline__ void add_row_bf16(const bf16_t* row, int lane, float4 (&v)[4]) {
#pragma unroll
    for (int j = 0; j < 4; ++j) { const uint2 o = *(const uint2*)(row + lane * 4 + 256 * j);
        v[j].x += __uint_as_float(o.x << 16); v[j].y += __uint_as_float(o.x & 0xffff0000u); v[j].z += __uint_as_float(o.y << 16); v[j].w += __uint_as_float(o.y & 0xffff0000u); }
}

__device__ __forceinline__ void ph_norm0(const float* x, const float* gain, unsigned char* HN8, float* rowscale) {
    const int lane = threadIdx.x & 63, gw = blockIdx.x * 8 + (threadIdx.x >> 6), NGW = gridDim.x * 8;
    for (int n = gw; n < NTOK; n += NGW) { float4 v[4]; load_row16(x + (size_t)n * DM, lane, v); norm_row(v, gain, lane);
        float mx = 0.f;
#pragma unroll
        for (int j = 0; j < 4; ++j) mx = fmaxf(fmaxf(mx, fmaxf(fabsf(v[j].x), fabsf(v[j].y))), fmaxf(fabsf(v[j].z), fabsf(v[j].w)));
        mx = fmaxf(wave_max(mx), 1e-30f); const float qs = 127.f / mx;
        if (lane == 0) rowscale[n] = mx;
#pragma unroll
        for (int j = 0; j < 4; ++j) *(unsigned*)(HN8 + (size_t)n * DM + lane * 4 + 256 * j) = q8x4(v[j].x, v[j].y, v[j].z, v[j].w, qs); }
}
__device__ __forceinline__ void ld8bf(const bf16_t* p, float (&v)[8]) { const u32x4_t o = *(const u32x4_t*)p;
    v[0] = __uint_as_float(o.x << 16); v[1] = __uint_as_float(o.x & 0xffff0000u); v[2] = __uint_as_float(o.y << 16); v[3] = __uint_as_float(o.y & 0xffff0000u);
    v[4] = __uint_as_float(o.z << 16); v[5] = __uint_as_float(o.z & 0xffff0000u); v[6] = __uint_as_float(o.w << 16); v[7] = __uint_as_float(o.w & 0xffff0000u); }
__device__ __forceinline__ void st8bf(bf16_t* p, const float (&v)[8]) { *(u32x4_t*)p = (u32x4_t){pk2(v[0], v[1]), pk2(v[2], v[3]), pk2(v[4], v[5]), pk2(v[6], v[7])}; }
__device__ __forceinline__ void ph_combine_norm(bf16_t* XR, const bf16_t* Y, const float* gain, unsigned char* HN8, float* rowscale) {
    const int lane = threadIdx.x & 63, gw = blockIdx.x * 8 + (threadIdx.x >> 6), NGW = gridDim.x * 8;
    for (int n = gw; n < NTOK; n += NGW) { float x[2][8], y0[2][8], y1[2][8]; float ss = 0.f;
#pragma unroll
        for (int j = 0; j < 2; ++j) { const int o = lane * 8 + 512 * j; ld8bf(XR + (size_t)n * DM + o, x[j]); ld8bf(Y + (size_t)(2 * n) * DM + o, y0[j]); ld8bf(Y + (size_t)(2 * n + 1) * DM + o, y1[j]); }
#pragma unroll
        for (int j = 0; j < 2; ++j) {
#pragma unroll
            for (int i = 0; i < 8; ++i) x[j][i] = bf2f(f2bf(x[j][i] + y0[j][i] + y1[j][i]));
            st8bf(XR + (size_t)n * DM + lane * 8 + 512 * j, x[j]);
#pragma unroll
            for (int i = 0; i < 8; ++i) ss += x[j][i] * x[j][i]; }
        const float rs = rsqrtf(wave_sum(ss) * (1.f / DM) + 1e-6f);
#pragma unroll
        for (int j = 0; j < 2; ++j) { const int o = lane * 8 + 512 * j; const float4 g0 = *(const float4*)(gain + o), g1 = *(const float4*)(gain + o + 4);
            const float gg[8] = {g0.x, g0.y, g0.z, g0.w, g1.x, g1.y, g1.z, g1.w};
#pragma unroll
            for (int i = 0; i < 8; ++i) x[j][i] *= rs * gg[i]; }
        float mx = 0.f;
#pragma unroll
        for (int j = 0; j < 2; ++j)
#pragma unroll
            for (int i = 0; i < 8; ++i) mx = fmaxf(mx, fabsf(x[j][i]));
        mx = fmaxf(wave_max(mx), 1e-30f); const float qs = 127.f / mx;
        if (lane == 0) rowscale[n] = mx;
#pragma unroll
        for (int j = 0; j < 2; ++j) { const int o = lane * 8 + 512 * j;
            *(u32x2_t*)(HN8 + (size_t)n * DM + o) = (u32x2_t){q8x4(x[j][0], x[j][1], x[j][2], x[j][3], qs), q8x4(x[j][4], x[j][5], x[j][6], x[j][7], qs)}; } }
}
__device__ __forceinline__ void ph_final(const bf16_t* XR, const bf16_t* Y, const float* gain, float* out) {
    const int lane = threadIdx.x & 63, gw = blockIdx.x * 8 + (threadIdx.x >> 6), NGW = gridDim.x * 8;
    for (int n = gw; n < NTOK; n += NGW) { float x[2][8], y0[2][8], y1[2][8]; float ss = 0.f;
#pragma unroll
        for (int j = 0; j < 2; ++j) { const int o = lane * 8 + 512 * j; ld8bf(XR + (size_t)n * DM + o, x[j]); ld8bf(Y + (size_t)(2 * n) * DM + o, y0[j]); ld8bf(Y + (size_t)(2 * n + 1) * DM + o, y1[j]); }
#pragma unroll
        for (int j = 0; j < 2; ++j)
#pragma unroll
            for (int i = 0; i < 8; ++i) { x[j][i] = x[j][i] + y0[j][i] + y1[j][i]; ss += x[j][i] * x[j][i]; }
        const float rs = rsqrtf(wave_sum(ss) * (1.f / DM) + 1e-6f);
#pragma unroll
        for (int j = 0; j < 2; ++j) { const int o = lane * 8 + 512 * j; const float4 g0 = *(const float4*)(gain + o), g1 = *(const float4*)(gain + o + 4);
            *(float4*)(out + (size_t)n * DM + o) = make_float4(x[j][0] * rs * g0.x, x[j][1] * rs * g0.y, x[j][2] * rs * g0.z, x[j][3] * rs * g0.w);
            *(float4*)(out + (size_t)n * DM + o + 4) = make_float4(x[j][4] * rs * g1.x, x[j][5] * rs * g1.y, x[j][6] * rs * g1.z, x[j][7] * rs * g1.w); } }
}
__device__ __forceinline__ void ph_route(const Args& a, int Lyr, const bf16_t* XR, bf16_t* HN, float* RS, unsigned* cnt, int* asg_e, int* asg_rank, float* asg_gate, LAS float* lds) {
    const float* gain = a.in[2] + Lyr * DM; const float* bg = a.in[29] + Lyr * 4; const float* be = a.in[31] + Lyr * 32;
    const bf16_t* FRh = (const bf16_t*)(a.ws + FG_RT) + (size_t)Lyr * 2 * 49152; const bf16_t* FRl = FRh + 49152;
    const int lane = threadIdx.x & 63, wave = threadIdx.x >> 6, q4 = lane >> 4, c16 = lane & 15, r4 = lane >> 4, cidx = lane & 15;
    LAS unsigned char* Lb = (LAS unsigned char*)lds;
    LAS unsigned char* W = Lb + wave * 12288;
    LAS float* SS = (LAS float*)(W + 8704); LAS float* LG = (LAS float*)(W + 8768);
    LAS unsigned* lcnt = (LAS unsigned*)(Lb + 8 * 12288); LAS unsigned* lbase = lcnt + 32;
    const int NGW = gridDim.x * 8, gw = blockIdx.x * 8 + wave;
    for (int rnd = 0; rnd * NGW < NTOK / 16; ++rnd) {
        const int tile = rnd * NGW + gw; const bool act = tile < NTOK / 16; const int n0 = tile * 16;
        if (threadIdx.x < 32) lcnt[threadIdx.x] = 0u;
        __syncthreads();
        int e0 = 0, e1 = 0, lr0 = 0, lr1 = 0; float g0 = 0.f, g1 = 0.f;
        if (act) {
            f32x4 acc[3], accs = (f32x4){0.f, 0.f, 0.f, 0.f};
#pragma unroll
            for (int ct = 0; ct < 3; ++ct) acc[ct] = accs;
#pragma unroll 1
            for (int kc = 0; kc < 8; ++kc) {
                bf16x8_t bh[4][3], bl[4][3];
#pragma unroll
                for (int ks = 0; ks < 4; ++ks)
#pragma unroll
                    for (int ct = 0; ct < 3; ++ct) { const size_t o = ((size_t)((kc * 4 + ks) * 3 + ct) * 64 + lane) * 8; bh[ks][ct] = *(const bf16x8_t*)(FRh + o); bl[ks][ct] = *(const bf16x8_t*)(FRl + o); }
                u32x4_t xv[4];
#pragma unroll
                for (int j = 0; j < 4; ++j) xv[j] = *(const u32x4_t*)(XR + (size_t)(n0 + 4 * j + r4) * DM + kc * 128 + 8 * cidx);
                __builtin_amdgcn_sched_barrier(0);
#pragma unroll
                for (int j = 0; j < 4; ++j) *(LAS u32x4_t*)(W + (4 * j + r4) * 272 + cidx * 16) = xv[j];
#pragma unroll
                for (int ks = 0; ks < 4; ++ks) { const bf16x8_t ahi = *(const LAS bf16x8_t*)(W + c16 * 272 + ks * 64 + q4 * 16);
                    accs = __builtin_amdgcn_mfma_f32_16x16x32_bf16(ahi, ahi, accs, 0, 0, 0);
#pragma unroll
                    for (int ct = 0; ct < 3; ++ct) { acc[ct] = __builtin_amdgcn_mfma_f32_16x16x32_bf16(ahi, bh[ks][ct], acc[ct], 0, 0, 0); acc[ct] = __builtin_amdgcn_mfma_f32_16x16x32_bf16(ahi, bl[ks][ct], acc[ct], 0, 0, 0); } }
            }
#pragma unroll
            for (int r = 0; r < 4; ++r) if (c16 == 4 * q4 + r) { const float rsv = rsqrtf(accs[r] * (1.f / DM) + 1e-6f); SS[c16] = rsv; RS[n0 + c16] = rsv; }
            const f32x4 s4 = *(const LAS f32x4*)(SS + 4 * q4);
#pragma unroll
            for (int ct = 0; ct < 3; ++ct) { const int col = 16 * ct + c16; const float bias = col < 4 ? bg[col] : (col < 36 ? be[col - 4] : 0.f);
#pragma unroll
                for (int r = 0; r < 4; ++r) LG[(4 * q4 + r) * 48 + col] = acc[ct][r] * s4[r] + bias; }
            if (lane < 16) {
                const LAS float* lg = LG + lane * 48;
                int gs = 0; float gm = lg[0];
#pragma unroll
                for (int i = 1; i < 4; ++i) { const float v = lg[i]; if (v > gm) { gm = v; gs = i; } }
                float gden = 0.f;
#pragma unroll
                for (int i = 0; i < 4; ++i) gden += __expf(lg[i] - gm);
                const float ggate = 1.f / gden;
                const LAS float* l8 = lg + 4 + gs * 8;
                int i0 = 0; float m0 = l8[0];
#pragma unroll
                for (int i = 1; i < 8; ++i) { const float v = l8[i]; if (v > m0) { m0 = v; i0 = i; } }
                int i1 = (i0 == 0) ? 1 : 0; float m1 = l8[i1];
#pragma unroll
                for (int i = 0; i < 8; ++i) { const float v = l8[i]; if (i != i0 && v > m1) { m1 = v; i1 = i; } }
                const float ex = __expf(m1 - m0);
                g0 = ggate / (1.f + ex); g1 = ggate * ex / (1.f + ex);
                e0 = gs * 8 + i0; e1 = gs * 8 + i1;
                lr0 = (int)__hip_atomic_fetch_add(lcnt + e0, 1u, __ATOMIC_RELAXED, __HIP_MEMORY_SCOPE_WORKGROUP); lr1 = (int)__hip_atomic_fetch_add(lcnt + e1, 1u, __ATOMIC_RELAXED, __HIP_MEMORY_SCOPE_WORKGROUP);
            }
        }
        __syncthreads();
        if (threadIdx.x < 32) { const unsigned c = lcnt[threadIdx.x]; lbase[threadIdx.x] = c ? atomicAdd(&cnt[threadIdx.x], c) : 0u; }
        __syncthreads();
        if (act) {
            if (lane < 16) { const int n = n0 + lane;
                asg_e[2 * n] = e0; asg_e[2 * n + 1] = e1; asg_rank[2 * n] = (int)lbase[e0] + lr0; asg_rank[2 * n + 1] = (int)lbase[e1] + lr1; asg_gate[2 * n] = g0; asg_gate[2 * n + 1] = g1; }
            unsigned char* H8 = (unsigned char*)HN;
            float rsr[4];
#pragma unroll
            for (int j = 0; j < 4; ++j) rsr[j] = SS[4 * j + r4] * ACT_Q;
#pragma unroll 2
            for (int kc = 0; kc < 8; ++kc) { const float4 gn0 = *(const float4*)(gain + kc * 128 + 8 * cidx), gn1 = *(const float4*)(gain + kc * 128 + 8 * cidx + 4);
                u32x4_t xv[4];
#pragma unroll
                for (int j = 0; j < 4; ++j) xv[j] = *(const u32x4_t*)(XR + (size_t)(n0 + 4 * j + r4) * DM + kc * 128 + 8 * cidx);
#pragma unroll
                for (int j = 0; j < 4; ++j) { const u32x4_t o = xv[j]; const float q = rsr[j];
                    *(u32x2_t*)(H8 + (size_t)(n0 + 4 * j + r4) * DM + kc * 128 + 8 * cidx) = (u32x2_t){
                        q8x4(__uint_as_float(o.x << 16) * gn0.x, __uint_as_float(o.x & 0xffff0000u) * gn0.y, __uint_as_float(o.y << 16) * gn0.z, __uint_as_float(o.y & 0xffff0000u) * gn0.w, q),
                        q8x4(__uint_as_float(o.z << 16) * gn1.x, __uint_as_float(o.z & 0xffff0000u) * gn1.y, __uint_as_float(o.w << 16) * gn1.z, __uint_as_float(o.w & 0xffff0000u) * gn1.w, q)}; } }
        }
        __syncthreads();
    }
}
__device__ __forceinline__ void moe_prefix(const unsigned* cnt, LAS int* pst) {
    if (threadIdx.x == 0) { int acc = 0; for (int e = 0; e < NEXP; ++e) { pst[e] = acc; const int c = (int)cnt[e]; acc += (c + MOE_TM - 1) / MOE_TM * MOE_TM; } pst[NEXP] = acc; }
    __syncthreads();
}
__device__ __forceinline__ void ph_dispatch(const unsigned* cnt, const int* asg_e, const int* asg_rank, const float* asg_gate, const float* RS, int* row_tok, int* row_slot, float* row_gate, float* row_rs, LAS int* pst, const unsigned* wmax, float* tscale) {
    moe_prefix(cnt, pst);
    for (int t = blockIdx.x * NTHREADS + threadIdx.x; t < pst[NEXP] / 256; t += gridDim.x * NTHREADS) { int e = 0;
        for (int k = 1; k < NEXP; ++k) if (t * 256 >= pst[k]) e = k;
        tscale[2 * t] = __uint_as_float(wmax[2 * e]) * (1.f / (127.f * ACT_Q)); tscale[2 * t + 1] = __uint_as_float(wmax[2 * e + 1]) * (1.f / (127.f * ACT_Q)); }
    for (int i = blockIdx.x * NTHREADS + threadIdx.x; i < NASG; i += gridDim.x * NTHREADS) {
        const int e = asg_e[i], d = pst[e] + asg_rank[i];
        row_tok[d] = i >> 1; row_slot[d] = i; row_gate[d] = asg_gate[i]; row_rs[d] = RS[i >> 1];
    }
    for (int e = blockIdx.x; e < NEXP; e += gridDim.x) {
        const int c = (int)cnt[e], lo = pst[e] + c, hi = pst[e + 1];
        for (int r = lo + threadIdx.x; r < hi; r += NTHREADS) { row_tok[r] = -1; row_slot[r] = 0; row_gate[r] = 0.f; row_rs[r] = 0.f; }
    }
    __syncthreads();
}
__device__ __forceinline__ int moe_tile_expert(const LAS int* pst, int row0) { int e = 0;
    for (int i = 1; i < NEXP; ++i) if (row0 >= pst[i]) e = i;
    return e; }

__device__ __forceinline__ float shiftcol(const bf16_t* P, int n, int t, int col, const float* mu) {
    const float cur = bf2f(P[(size_t)n * ABC + col]); const float prev = t > 0 ? bf2f(P[(size_t)(n - 1) * ABC + col]) : 0.f;
    return cur + (prev - cur) * mu[col];
}
constexpr int RW_WMF = 0, RW_RF = 2048, RW_BKF = 4096, RW_ARF = 8192, RW_U = 9216, RW_V = 11264, RW_G = 13312, RW_REC = 13568;
__device__ __forceinline__ float fast_sigmoid(float x) { return __builtin_amdgcn_rcpf(1.f + __expf(-x)); }
__device__ __forceinline__ float fast_softplus(float x) { return fmaxf(x, 0.f) + __logf(1.f + __expf(-fabsf(x))); }
__device__ __forceinline__ void tr_acc(LAS float* TBf, const f32x4 (&acc)[4], int lane, float (&out)[16]) {
    const int q4 = lane >> 4, c16 = lane & 15;
#pragma unroll
    for (int ct = 0; ct < 4; ++ct)
#pragma unroll
        for (int r = 0; r < 4; ++r) TBf[(16 * ct + 4 * q4 + r) * 20 + c16] = acc[ct][r];
#pragma unroll
    for (int j = 0; j < 4; ++j) { const f32x4 v = *(const LAS f32x4*)(TBf + lane * 20 + 4 * j); out[4 * j] = v[0]; out[4 * j + 1] = v[1]; out[4 * j + 2] = v[2]; out[4 * j + 3] = v[3]; }
}
__device__ __forceinline__ void ph_l0_prep(const Args& a, LAS float* lds) {
    const bf16_t* P = (const bf16_t*)(a.ws + WS_B);
    unsigned char* FR = a.ws + WS_C;
    bf16_t* Vb = (bf16_t*)a.out; float* Bon = (float*)((unsigned char*)a.out + 32 * MiB);
    bf16_t* LA = (bf16_t*)(a.ws + WS_A); bf16_t* U = LA + (size_t)NTOK * 512;
    const float* mu = a.in[5]; const float* w0 = a.in[6]; const float* a0 = a.in[8];
    const float* k_k = a.in[11]; const float* k_a = a.in[12]; const float* r_k = a.in[13];
    const float* conv_w = a.in[16]; const float* conv_b = a.in[17]; const float* b_a = a.in[19]; const float* b_x = a.in[21]; const float* lam = a.in[22];
    const int lane = threadIdx.x & 63, wave = threadIdx.x >> 6, q4 = lane >> 4, c16 = lane & 15;
    LAS unsigned char* W = (LAS unsigned char*)lds + wave * 15360;
    constexpr int KAP = 0, BT = 2304, KT = 4608, RT = 6912, BTT = 9216, KTT = 11264, AKB = 13312, AKK = 14336, RS = 144;
    constexpr int XS = 0, XS2 = 2304, TB = 4608;
    LAS float* TBf = (LAS float*)(W + TB);
    for (int u = blockIdx.x * 8 + wave; u < (NTOK / 16) * 8; u += gridDim.x * 8) {
        const int tile = u >> 3, h = u & 7, n0 = tile * 16, c = h * 64 + lane;
        const bool first = (n0 & (SEQ - 1)) == 0;
        const unsigned char* PT = (const unsigned char*)(P + (size_t)tile * ABC * 16);
        const unsigned char* PTp = PT - (size_t)ABC * 32;
        unsigned lo32 = (unsigned)lane * 32u; asm volatile("" : "+v"(lo32));
#define LD16(dst, colbase, off) do { const u32x4_t _lo = *(const u32x4_t*)(PT + (colbase) * 32 + lo32), _hi = *(const u32x4_t*)(PT + (colbase) * 32 + 16 + lo32); \
            dst[(off)] = _lo.x; dst[(off) + 1] = _lo.y; dst[(off) + 2] = _lo.z; dst[(off) + 3] = _lo.w; dst[(off) + 4] = _hi.x; dst[(off) + 5] = _hi.y; dst[(off) + 6] = _hi.z; dst[(off) + 7] = _hi.w; } while (0)
        unsigned xbp[10], pwp[9], pap[9], qrp[9], qkp[9], qvp[9];
        { u32x2_t t2 = (u32x2_t){0u, 0u}; if (!first) t2 = *(const u32x2_t*)(PTp + (2304 + h * 64) * 32 + 24 + lo32); xbp[0] = t2.x; xbp[1] = t2.y; LD16(xbp, 2304 + h * 64, 2); }
        pwp[0] = first ? 0u : *(const unsigned*)(PTp + 1536 * 32 + 28 + lo32); LD16(pwp, 1536, 1);
        pap[0] = first ? 0u : *(const unsigned*)(PTp + 1600 * 32 + 28 + lo32); LD16(pap, 1600, 1);
        asm volatile("" ::: "memory");
#define UNPK(arr, i) __uint_as_float(((i) & 1) ? ((arr)[(i) >> 1] & 0xffff0000u) : ((arr)[(i) >> 1] << 16))
        {
            bf16_t* SG = (bf16_t*)((unsigned char*)a.out + DO_SG);
            const int tk = lane >> 2, col = 1664 + 16 * h + (lane & 3) * 4;
            unsigned so = (unsigned)((lane & 3) * 128 + tk * 2); asm volatile("" : "+v"(so));
            float cu[4], pu[4];
#pragma unroll
            for (int i = 0; i < 4; ++i) { cu[i] = bf2f(*(const bf16_t*)(PT + (1664 + 16 * h + i) * 32 + so));
                pu[i] = (tk > 0) ? bf2f(*(const bf16_t*)(PT + (1664 + 16 * h + i) * 32 - 2 + so)) : (first ? 0.f : bf2f(*(const bf16_t*)(PTp + (1664 + 16 * h + i) * 32 + 30 + so))); }
            const f32x4 m4 = *(const f32x4*)(mu + col);
            *(u32x2_t*)(SG + (size_t)(tile * 8 + h) * 256 + lane * 4) = (u32x2_t){pk2(fast_sigmoid(cu[0] + (pu[0] - cu[0]) * m4[0]), fast_sigmoid(cu[1] + (pu[1] - cu[1]) * m4[1])), pk2(fast_sigmoid(cu[2] + (pu[2] - cu[2]) * m4[2]), fast_sigmoid(cu[3] + (pu[3] - cu[3]) * m4[3]))};
        }
        {
            const float cw0 = conv_w[c], cw1 = conv_w[512 + c], cw2 = conv_w[1024 + c], cw3 = conv_w[1536 + c], cb = conv_b[c];
            float xcv[16], xb[19];
#pragma unroll
            for (int i = 0; i < 19; ++i) xb[i] = UNPK(xbp, i + 1);
#pragma unroll
            for (int tk = 0; tk < 16; ++tk) { xcv[tk] = cb + cw0 * xb[tk] + cw1 * xb[tk + 1] + cw2 * xb[tk + 2] + cw3 * xb[tk + 3]; *(LAS bf16_t*)(W + XS + tk * RS + lane * 2) = f2bf(xcv[tk]); }
            f32x4 accr[4], acci[4];
            const bf16_t* FA = (const bf16_t*)(a.ws + FG_WA) + h * 4096; const bf16_t* FX = (const bf16_t*)(a.ws + FG_WX) + h * 4096;
            bf16x8_t xf[2];
#pragma unroll
            for (int ks = 0; ks < 2; ++ks) xf[ks] = *(const LAS bf16x8_t*)(W + XS + c16 * RS + ks * 64 + q4 * 16);
#pragma unroll
            for (int ct = 0; ct < 4; ++ct) { asm volatile("" ::: "memory"); accr[ct] = (f32x4){0.f, 0.f, 0.f, 0.f}; acci[ct] = accr[ct];
#pragma unroll
                for (int ks = 0; ks < 2; ++ks) { accr[ct] = __builtin_amdgcn_mfma_f32_16x16x32_bf16(*(const bf16x8_t*)(FA + ((ct * 2 + ks) * 64 + lane) * 8), xf[ks], accr[ct], 0, 0, 0);
                    acci[ct] = __builtin_amdgcn_mfma_f32_16x16x32_bf16(*(const bf16x8_t*)(FX + ((ct * 2 + ks) * 64 + lane) * 8), xf[ks], acci[ct], 0, 0, 0); } }
            float rp[16], ip[16];
            tr_acc(TBf, accr, lane, rp); tr_acc(TBf, acci, lane, ip);
            const float bac = b_a[c], bxc = b_x[c], sp = fast_softplus(-lam[c]);
            float hloc = 0.f, sla = 0.f;
            unsigned lap[4], uup[4];
#pragma unroll
            for (int tk = 0; tk < 16; ++tk) { const float r = fast_sigmoid(rp[tk] + bac), i = fast_sigmoid(ip[tk] + bxc);
                const float la = -8.f * r * sp; const float uu = __builtin_amdgcn_sqrtf(fmaxf(1.f - __expf(2.f * la), 0.f)) * i * xcv[tk];
                const bf16_t lab = f2bf(la), uub = f2bf(uu); const float lar = bf2f(lab);
                if (tk & 1) { lap[(tk >> 1) & 3] |= (unsigned)lab << 16; uup[(tk >> 1) & 3] |= (unsigned)uub << 16; } else { lap[(tk >> 1) & 3] = lab; uup[(tk >> 1) & 3] = uub; }
                if ((tk & 7) == 7) { *(u32x4_t*)(LA + ((size_t)tile * 512 + c) * 16 + (tk >> 3) * 8) = (u32x4_t){lap[0], lap[1], lap[2], lap[3]}; *(u32x4_t*)(U + ((size_t)tile * 512 + c) * 16 + (tk >> 3) * 8) = (u32x4_t){uup[0], uup[1], uup[2], uup[3]}; }
                hloc = __expf(lar) * hloc + bf2f(uub); sla += lar; }
            ((float*)((unsigned char*)a.out + DO_LRU))[(size_t)tile * 512 + c] = hloc; ((float*)((unsigned char*)a.out + DO_LRU))[(size_t)(2048 + tile) * 512 + c] = sla;
        }
        asm volatile("" ::: "memory");
        asm volatile("" : "+v"(lo32));
        qrp[0] = first ? 0u : *(const unsigned*)(PTp + (h * 64) * 32 + 28 + lo32); LD16(qrp, h * 64, 1);
        qkp[0] = first ? 0u : *(const unsigned*)(PTp + (512 + h * 64) * 32 + 28 + lo32); LD16(qkp, 512 + h * 64, 1);
        qvp[0] = first ? 0u : *(const unsigned*)(PTp + (1024 + h * 64) * 32 + 28 + lo32); LD16(qvp, 1024 + h * 64, 1);
        asm volatile("" ::: "memory");
        float wpre[16], apre[16];
        {
            const float muw = mu[1536 + lane], mua = mu[1600 + lane];
#pragma unroll
            for (int tk = 0; tk < 16; ++tk) { const float pw1 = UNPK(pwp, tk + 2), pw0 = UNPK(pwp, tk + 1), pa1 = UNPK(pap, tk + 2), pa0 = UNPK(pap, tk + 1);
                const float wl = pw1 + (pw0 - pw1) * muw, al = pa1 + (pa0 - pa1) * mua;
                const float th = 1.f - 2.f * __builtin_amdgcn_rcpf(1.f + __expf(2.f * wl));
                *(LAS bf16_t*)(W + XS + tk * RS + lane * 2) = f2bf(th); *(LAS bf16_t*)(W + XS2 + tk * RS + lane * 2) = f2bf(al); }
            f32x4 accw[4], acca[4];
            const bf16_t* F2 = (const bf16_t*)(a.ws + FG_W2) + h * 4096; const bf16_t* FA2 = (const bf16_t*)(a.ws + FG_A2) + h * 4096;
            bf16x8_t wf[2], af[2];
#pragma unroll
            for (int ks = 0; ks < 2; ++ks) { wf[ks] = *(const LAS bf16x8_t*)(W + XS + c16 * RS + ks * 64 + q4 * 16); af[ks] = *(const LAS bf16x8_t*)(W + XS2 + c16 * RS + ks * 64 + q4 * 16); }
#pragma unroll
            for (int ct = 0; ct < 4; ++ct) { asm volatile("" ::: "memory"); accw[ct] = (f32x4){0.f, 0.f, 0.f, 0.f}; acca[ct] = accw[ct];
#pragma unroll
                for (int ks = 0; ks < 2; ++ks) { accw[ct] = __builtin_amdgcn_mfma_f32_16x16x32_bf16(*(const bf16x8_t*)(F2 + ((ct * 2 + ks) * 64 + lane) * 8), wf[ks], accw[ct], 0, 0, 0);
                    acca[ct] = __builtin_amdgcn_mfma_f32_16x16x32_bf16(*(const bf16x8_t*)(FA2 + ((ct * 2 + ks) * 64 + lane) * 8), af[ks], acca[ct], 0, 0, 0); } }
            tr_acc(TBf, accw, lane, wpre); tr_acc(TBf, acca, lane, apre);
        }
        const float w0c = w0[c], a0c = a0[c], kkc = k_k[c], kac = k_a[c], rkc = r_k[c];
        const float mur = mu[c], muk = mu[512 + c], muv = mu[1024 + c];
        unsigned char* rec = FR + ((size_t)tile * 8 + h) * RW_REC;
        float vsv[16];
        unsigned btp[8], ktp[8];
        float cum = 0.f, gC = 1.f;
#pragma unroll
        for (int tk = 0; tk < 16; ++tk) { const int n = n0 + tk;
            const float cr = UNPK(qrp, tk + 2), ck = UNPK(qkp, tk + 2), cv = UNPK(qvp, tk + 2), pr = UNPK(qrp, tk + 1), pk = UNPK(qkp, tk + 1), pv = UNPK(qvp, tk + 1);
            const float rs = cr + (pr - cr) * mur, ks = ck + (pk - ck) * muk, vs = cv + (pv - cv) * muv;
            const float wv = -fast_softplus(-(w0c + wpre[tk])) - 0.5f; const float logdec = -__expf(wv);
            const float av = fast_sigmoid(a0c + apre[tk]);
            const float kkr = ks * kkc; const float ss = wave_sum(kkr * kkr); const float kkn = kkr * rsqrtf(fmaxf(ss, 1e-24f));
            const float kp = ks * (1.f + (av - 1.f) * kac);
            const float bsum = wave_sum(rs * kp * rkc);
            if (lane == 0) Bon[(size_t)n * 8 + h] = bsum;
            Vb[(size_t)n * 512 + c] = f2bf(vs); vsv[tk] = vs;
            const float gprev = __expf(cum); cum += logdec; const float g = __expf(cum), gi = __builtin_amdgcn_rcpf(g); gC = g;
            const float kapv = kkn * gprev, btv = av * kkn * gi, ktv = kp * gi, rtv = rs * g;
            const bf16_t kb = f2bf(kapv), bb = f2bf(btv), kb2 = f2bf(ktv), rb = f2bf(rtv);
            *(LAS bf16_t*)(W + KAP + tk * RS + lane * 2) = kb; *(LAS bf16_t*)(W + BT + tk * RS + lane * 2) = bb;
            *(LAS bf16_t*)(W + KT + tk * RS + lane * 2) = kb2; *(LAS bf16_t*)(W + RT + tk * RS + lane * 2) = rb;
            if (tk & 1) { btp[tk >> 1] |= (unsigned)bb << 16; ktp[tk >> 1] |= (unsigned)kb2 << 16; } else { btp[tk >> 1] = bb; ktp[tk >> 1] = kb2; } }
        *(LAS u32x4_t*)(W + BTT + lane * 32) = (u32x4_t){btp[0], btp[1], btp[2], btp[3]}; *(LAS u32x4_t*)(W + BTT + lane * 32 + 16) = (u32x4_t){btp[4], btp[5], btp[6], btp[7]};
        *(LAS u32x4_t*)(W + KTT + lane * 32) = (u32x4_t){ktp[0], ktp[1], ktp[2], ktp[3]}; *(LAS u32x4_t*)(W + KTT + lane * 32 + 16) = (u32x4_t){ktp[4], ktp[5], ktp[6], ktp[7]};
        *(float*)(rec + RW_G + lane * 4) = gC;
        f32x4 akb = (f32x4){0.f, 0.f, 0.f, 0.f}, akk = akb, arbT = akb, arkT = akb;
#pragma unroll
        for (int ks = 0; ks < 2; ++ks) { const int fo = c16 * RS + ks * 64 + q4 * 16;
            const bf16x8_t fkap = *(const LAS bf16x8_t*)(W + KAP + fo), fbt = *(const LAS bf16x8_t*)(W + BT + fo), fkt = *(const LAS bf16x8_t*)(W + KT + fo), frt = *(const LAS bf16x8_t*)(W + RT + fo);
            akb = __builtin_amdgcn_mfma_f32_16x16x32_bf16(fkap, fbt, akb, 0, 0, 0); akk = __builtin_amdgcn_mfma_f32_16x16x32_bf16(fkap, fkt, akk, 0, 0, 0);
            arbT = __builtin_amdgcn_mfma_f32_16x16x32_bf16(fbt, frt, arbT, 0, 0, 0); arkT = __builtin_amdgcn_mfma_f32_16x16x32_bf16(fkt, frt, arkT, 0, 0, 0); }
#pragma unroll
        for (int r = 0; r < 4; ++r) { const int t = 4 * q4 + r; ((LAS float*)(W + AKB))[t * 16 + c16] = (c16 < t) ? akb[r] : 0.f; ((LAS float*)(W + AKK))[t * 16 + c16] = (c16 < t) ? akk[r] : 0.f;
            const int sidx = 4 * q4 + r; if (sidx > c16) { arbT[r] = 0.f; arkT[r] = 0.f; } }
        *(u32x4_t*)(rec + RW_ARF + lane * 16) = (u32x4_t){pk2(arbT[0], arbT[1]), pk2(arbT[2], arbT[3]), pk2(arkT[0], arkT[1]), pk2(arkT[2], arkT[3])};
#pragma unroll
        for (int i = 0; i < 4; ++i) { const u32x2_t b2 = *(const LAS u32x2_t*)(W + BTT + (16 * i + c16) * 32 + q4 * 8), k2 = *(const LAS u32x2_t*)(W + KTT + (16 * i + c16) * 32 + q4 * 8);
            *(u32x4_t*)(rec + RW_BKF + i * 1024 + lane * 16) = (u32x4_t){b2.x, b2.y, k2.x, k2.y}; }
#pragma unroll
        for (int sx = 0; sx < 2; ++sx) { const u32x2_t lo = *(const LAS u32x2_t*)(W + RT + c16 * RS + (32 * sx + 4 * q4) * 2), hi = *(const LAS u32x2_t*)(W + RT + c16 * RS + (32 * sx + 16 + 4 * q4) * 2);
            *(u32x4_t*)(rec + RW_RF + sx * 1024 + lane * 16) = (u32x4_t){lo.x, lo.y, hi.x, hi.y}; }
        float Wm[16], Uu[16];
#pragma unroll
        for (int t = 0; t < 16; ++t) { float wacc = bf2f(*(const LAS bf16_t*)(W + KAP + t * RS + lane * 2)), uacc = 0.f;
#pragma unroll
            for (int s4 = 0; s4 < 4; ++s4) if (4 * s4 < t) { const f32x4 b4 = *(const LAS f32x4*)(W + AKB + (t * 16 + 4 * s4) * 4), k4 = *(const LAS f32x4*)(W + AKK + (t * 16 + 4 * s4) * 4);
#pragma unroll
                for (int e = 0; e < 4; ++e) { const int sidx = 4 * s4 + e; if (sidx < t) { wacc -= b4[e] * Wm[sidx]; uacc += k4[e] * vsv[sidx] - b4[e] * Uu[sidx]; } } }
            Wm[t] = wacc; Uu[t] = uacc;
            *(LAS bf16_t*)(W + KAP + t * RS + lane * 2) = f2bf(wacc);
        }
        {
            const int ub = ((lane >> 4) * 64 + (lane & 15)) * 8;
#pragma unroll
            for (int q = 0; q < 4; ++q) { *(u32x2_t*)(rec + RW_U + ub + q * 128) = (u32x2_t){pk2(Uu[4 * q], Uu[4 * q + 1]), pk2(Uu[4 * q + 2], Uu[4 * q + 3])};
                *(u32x2_t*)(rec + RW_V + ub + q * 128) = (u32x2_t){pk2(vsv[4 * q], vsv[4 * q + 1]), pk2(vsv[4 * q + 2], vsv[4 * q + 3])}; }
        }
#pragma unroll
        for (int sx = 0; sx < 2; ++sx) { const u32x2_t lo = *(const LAS u32x2_t*)(W + KAP + c16 * RS + (32 * sx + 4 * q4) * 2), hi = *(const LAS u32x2_t*)(W + KAP + c16 * RS + (32 * sx + 16 + 4 * q4) * 2);
            *(u32x4_t*)(rec + RW_WMF + sx * 1024 + lane * 16) = (u32x4_t){lo.x, lo.y, hi.x, hi.y}; }
    }
}
__device__ __forceinline__ void sub_barrier(unsigned* ctr, unsigned target) {
    asm volatile("s_waitcnt vmcnt(0)" ::: "memory");
    __syncthreads();
    if (threadIdx.x == 0) {
        (void)xb_add(ctr, 1u);
        unsigned sp = 0;
        while (xb_ld(ctr) < target) { __builtin_amdgcn_s_sleep(2); if (++sp > (1u << 22)) break; }
        __builtin_amdgcn_fence(__ATOMIC_ACQUIRE, "agent");
        asm volatile("s_waitcnt vmcnt(0)" ::: "memory");
    }
    __syncthreads();
}
__device__ __forceinline__ void st_wt(float* p, float v) { __hip_atomic_store((unsigned*)p, __float_as_uint(v), __ATOMIC_RELAXED, __HIP_MEMORY_SCOPE_AGENT); }
__device__ __forceinline__ void ph_lru_b(const Args& a, int bid, LAS float* lds) {
    if (bid >= 64) return;
    const float* CH = (const float*)((unsigned char*)a.out + DO_LRU); const float* CA = CH + (size_t)2048 * 512; float* CIN = (float*)((unsigned char*)a.out + DO_LRU) + (size_t)4096 * 512;
    const int b = bid >> 4, cg = bid & 15, cl = threadIdx.x & 31, seg = threadIdx.x >> 5, c = cg * 32 + cl;
    float ca[32], chv[32];
#pragma unroll
    for (int i = 0; i < 32; ++i) { const size_t o = (size_t)(b * 512 + seg * 32 + i) * 512 + c; ca[i] = CA[o]; chv[i] = CH[o]; }
    float h = 0.f, sa = 0.f;
#pragma unroll
    for (int i = 0; i < 32; ++i) { h = __expf(ca[i]) * h + chv[i]; sa += ca[i]; }
    lds[seg * 32 + cl] = sa; lds[512 + seg * 32 + cl] = h;
    __syncthreads();
    float hin = 0.f;
    for (int sg = 0; sg < seg; ++sg) hin = __expf(lds[sg * 32 + cl]) * hin + lds[512 + sg * 32 + cl];
    h = hin;
#pragma unroll
    for (int i = 0; i < 32; ++i) { st_wt(CIN + (size_t)(b * 512 + seg * 32 + i) * 512 + c, h); h = __expf(ca[i]) * h + chv[i]; }
}
__device__ __forceinline__ void ph_lru_c(const Args& a, int bid, int nblk) {
    const bf16_t* LA = (const bf16_t*)(a.ws + WS_A); const bf16_t* U = LA + (size_t)NTOK * 512; const bf16_t* P = (const bf16_t*)(a.ws + WS_B);
    const float* CIN = (const float*)((unsigned char*)a.out + DO_LRU) + (size_t)4096 * 512; bf16_t* MIX = (bf16_t*)(a.ws + WS_D);
    const int c = threadIdx.x;
    for (int u = bid; u < NTOK / 16; u += nblk) { float la[16], uv[16], gt[16];
        float h = CIN[(size_t)u * 512 + c];
#pragma unroll
        for (int hf = 0; hf < 2; ++hf) { const u32x4_t l4 = *(const u32x4_t*)(LA + ((size_t)u * 512 + c) * 16 + hf * 8), u4 = *(const u32x4_t*)(U + ((size_t)u * 512 + c) * 16 + hf * 8), g4 = *(const u32x4_t*)(P + ((size_t)u * ABC + 1792 + c) * 16 + hf * 8);
#pragma unroll
            for (int e = 0; e < 4; ++e) { gt[hf * 8 + 2 * e] = __uint_as_float(g4[e] << 16); gt[hf * 8 + 2 * e + 1] = __uint_as_float(g4[e] & 0xffff0000u); la[hf * 8 + 2 * e] = __uint_as_float(l4[e] << 16); la[hf * 8 + 2 * e + 1] = __uint_as_float(l4[e] & 0xffff0000u); uv[hf * 8 + 2 * e] = __uint_as_float(u4[e] << 16); uv[hf * 8 + 2 * e + 1] = __uint_as_float(u4[e] & 0xffff0000u); } }
#pragma unroll
        for (int s = 0; s < 16; ++s) { const int n = u * 16 + s; h = __expf(la[s]) * h + uv[s];
            const float x = gt[s], t2 = 0.7978845608028654f * (x + 0.044715f * x * x * x); const float th = 1.f - 2.f * __builtin_amdgcn_rcpf(1.f + __expf(2.f * t2));
            MIX[(size_t)n * DM + 512 + c] = f2bf(h * 0.5f * x * (1.f + th)); } }
}
#ifndef SP_MODE
#define SP_MODE 0
#endif
#ifndef SP_VAR
#define SP_VAR 0
#endif
constexpr bool SCAN_COOP = true; constexpr int NSCAN = SCAN_COOP ? 64 : 32;
template <int VAR = 0, bool COOP = false>
__device__ __forceinline__ void ph_rwkv_scan(const Args& a, LAS unsigned char* L) {
    if (blockIdx.x >= (COOP ? 64 : 32)) return;
    constexpr int SLOT = 9472, GOFF = 9216, NS = 14, NCH = SEQ / 16; constexpr size_t CSTR = (size_t)8 * RW_REC;
    const unsigned char* FR = a.ws + WS_C; float* Yr = (float*)((unsigned char*)a.out + DO_YR);
    const int chain = COOP ? ((int)blockIdx.x & 31) : (int)blockIdx.x, half = COOP ? ((int)blockIdx.x >> 5) : 0;
    const int b = chain >> 3, h = chain & 7, lane = threadIdx.x & 63, wave = __builtin_amdgcn_readfirstlane(threadIdx.x >> 6), q4 = lane >> 4, c16 = lane & 15;
    const unsigned char* FRb = FR + ((size_t)(b * NCH) * 8 + h) * RW_REC;
#define RW_BARRIER() do { asm volatile("" ::: "memory"); __builtin_amdgcn_s_barrier(); asm volatile("" ::: "memory"); } while (0)
    if (COOP && wave >= 4) {
        const int lw = wave - 4, sub = lw & 1; const bool far = lw < 2;
        const int set = far ? half : (half ^ 1);
        const int p0 = set * 5 + sub * 3, n1k = (sub == 0) ? 3 : (set == 0 ? 2 : 1); const bool hasG = (set == 1) && (sub == 1);
        const unsigned char* rp = FRb + lane * 16 + p0 * 1024; int so = p0 * 1024;
#define RW_CISSUE() do { LAS unsigned char* _slot = L + so; \
            _Pragma("unroll") for (int _j = 0; _j < 3; ++_j) if (_j < n1k) __builtin_amdgcn_global_load_lds((const unsigned*)(rp + _j * 1024), (LAS unsigned*)(_slot + _j * 1024), 16, 0, 0); \
            if (hasG) __builtin_amdgcn_global_load_lds((const unsigned*)(rp - lane * 12 - p0 * 1024 + RW_G), (LAS unsigned*)(_slot - p0 * 1024 + GOFF), 4, 0, 0); \
            rp += CSTR; so += SLOT; if (so >= NS * SLOT) so -= NS * SLOT; } while (0)
        if (far) {
#define RW_CWAIT() do { if (sub == 0) asm volatile("s_waitcnt vmcnt(27)" ::: "memory"); else asm volatile("s_waitcnt vmcnt(18)" ::: "memory"); } while (0)
            for (int p = 0; p < NS - 2; ++p) RW_CISSUE();
            RW_CWAIT(); RW_BARRIER();
#pragma unroll 1
            for (int it = 0; it < NCH / 2; ++it) { RW_CISSUE(); RW_CISSUE(); RW_CWAIT(); RW_BARRIER(); }
#undef RW_CWAIT
        } else {
#define RW_CWAIT() do { if (sub == 0) asm volatile("s_waitcnt vmcnt(6)" ::: "memory"); else asm volatile("s_waitcnt vmcnt(4)" ::: "memory"); } while (0)
            for (int p = 0; p < 5; ++p) RW_CISSUE();
            RW_CWAIT(); RW_BARRIER();
#pragma unroll 1
            for (int it = 0; it < NCH / 2; ++it) { RW_CISSUE(); RW_CISSUE(); RW_CWAIT(); RW_BARRIER(); }
#undef RW_CWAIT
        }
        asm volatile("s_waitcnt vmcnt(0)" ::: "memory");
#undef RW_CISSUE
    } else if (COOP && wave >= 2) {
        RW_BARRIER();
#pragma unroll 1
        for (int it = 0; it < NCH / 2; ++it) RW_BARRIER();
    } else if (wave >= 4) {
        const int lw = wave - 4;
        const unsigned char* rp = FRb + lane * 16; int so = 0;
#define RW_ISSUE1() do { LAS unsigned char* _slot = L + so; \
            if (VAR & 1) { } else if (lw < 2) { _Pragma("unroll") for (int _j = 0; _j < 3; ++_j) __builtin_amdgcn_global_load_lds((const unsigned*)(rp + (lw * 3 + _j) * 1024), (LAS unsigned*)(_slot + (lw * 3 + _j) * 1024), 16, 0, 0); } \
            else if (lw == 2) { _Pragma("unroll") for (int _j = 0; _j < 2; ++_j) __builtin_amdgcn_global_load_lds((const unsigned*)(rp + (6 + _j) * 1024), (LAS unsigned*)(_slot + (6 + _j) * 1024), 16, 0, 0); } \
            else { __builtin_amdgcn_global_load_lds((const unsigned*)(rp + 8 * 1024), (LAS unsigned*)(_slot + 8 * 1024), 16, 0, 0); \
                   __builtin_amdgcn_global_load_lds((const unsigned*)(rp - lane * 12 + RW_G), (LAS unsigned*)(_slot + GOFF), 4, 0, 0); } \
            if (!(VAR & 8)) rp += CSTR; so += SLOT; if (so == NS * SLOT) so = 0; } while (0)
#if SP_MODE & 4
#define RW_ISSUE() do { RW_ISSUE1(); rp -= CSTR; so -= SLOT; if (so < 0) so += NS * SLOT; RW_ISSUE1(); } while (0)
#else
#define RW_ISSUE() RW_ISSUE1()
#endif
#if SP_MODE & 4
#define RW_LWAIT() do { if (lw < 2) asm volatile("s_waitcnt vmcnt(54)" ::: "memory"); else asm volatile("s_waitcnt vmcnt(36)" ::: "memory"); } while (0)
#else
#define RW_LWAIT() do { if (lw < 2) asm volatile("s_waitcnt vmcnt(27)" ::: "memory"); else asm volatile("s_waitcnt vmcnt(18)" ::: "memory"); } while (0)
#endif
        for (int p = 0; p < NS - 2; ++p) RW_ISSUE();
        RW_LWAIT();
        RW_BARRIER();
#pragma unroll 1
        for (int it = 0; it < NCH / 2; ++it) { RW_ISSUE(); RW_ISSUE(); RW_LWAIT(); RW_BARRIER(); }
        asm volatile("s_waitcnt vmcnt(0)" ::: "memory");
#undef RW_ISSUE
#undef RW_ISSUE1
#undef RW_LWAIT
    } else {
        const int vs = COOP ? 2 * half + wave : wave;
#if SP_MODE & 2
        __builtin_amdgcn_s_setprio(3);
#endif
        f32x4 T[4];
#pragma unroll
        for (int i = 0; i < 4; ++i) T[i] = (f32x4){0.f, 0.f, 0.f, 0.f};
        struct Ops { bf16x8_t wmf[2], rf[2], bkf[4], arf; f32x4 g4[4]; };
        const LAS unsigned char* lp = L + lane * 16; const LAS unsigned char* lg = L + GOFF + q4 * 16; int so = 0;
        const unsigned char* up = FRb + RW_U + (vs * 64 + lane) * 8;
        float* yp = Yr + ((size_t)(b * NCH) * 8 + h) * 1024 + vs * 256 + lane * 4;
#if SP_MODE & 8
#define RW_LOAD(O) do { { const LAS unsigned char* _r = lp + so; const LAS unsigned char* _g = lg + so; \
            _Pragma("unroll") for (int _s = 0; _s < 2; ++_s) { bf16x8_t _t0 = *(const LAS bf16x8_t*)(_r + RW_WMF + _s * 1024); bf16x8_t _t1 = *(const LAS bf16x8_t*)(_r + RW_RF + _s * 1024); asm volatile("" :: "v"(_t0), "v"(_t1)); } \
            _Pragma("unroll") for (int _i = 0; _i < 4; ++_i) { bf16x8_t _t0 = *(const LAS bf16x8_t*)(_r + RW_BKF + _i * 1024); f32x4 _t1 = *(const LAS f32x4*)(_g + _i * 64); asm volatile("" :: "v"(_t0), "v"(_t1)); } \
            { bf16x8_t _t0 = *(const LAS bf16x8_t*)(_r + RW_ARF); asm volatile("" :: "v"(_t0)); } asm volatile("" ::: "memory"); } RW_LOAD1(O); } while (0)
#else
#define RW_LOAD(O) RW_LOAD1(O)
#endif
#define RW_LOAD1(O) do { const LAS unsigned char* _r = lp + so; const LAS unsigned char* _g = lg + so; \
            _Pragma("unroll") for (int _s = 0; _s < 2; ++_s) { O.wmf[_s] = *(const LAS bf16x8_t*)(_r + RW_WMF + _s * 1024); O.rf[_s] = *(const LAS bf16x8_t*)(_r + RW_RF + _s * 1024); } \
            _Pragma("unroll") for (int _i = 0; _i < 4; ++_i) O.bkf[_i] = *(const LAS bf16x8_t*)(_r + RW_BKF + _i * 1024); \
            O.arf = *(const LAS bf16x8_t*)(_r + RW_ARF); \
            _Pragma("unroll") for (int _i = 0; _i < 4; ++_i) O.g4[_i] = *(const LAS f32x4*)(_g + _i * 64); \
            so += SLOT; if (so == NS * SLOT) so = 0; \
            __builtin_amdgcn_sched_barrier(0); } while (0)
#define RW_UV(dst) do { if (!(VAR & 2)) { dst[0] = *(const u32x2_t*)up; dst[1] = *(const u32x2_t*)(up + 2048); } else { asm volatile("" : "+v"(dst[0]), "+v"(dst[1])); } if (!(VAR & 16)) up += CSTR; } while (0)
#define RW_STEP(O, uv) do { \
            bf16x8_t _bS[2]; \
            _Pragma("unroll") for (int _s = 0; _s < 2; ++_s) { const u32x4_t _pk = (u32x4_t){pk2(T[2 * _s][0], T[2 * _s][1]), pk2(T[2 * _s][2], T[2 * _s][3]), pk2(T[2 * _s + 1][0], T[2 * _s + 1][1]), pk2(T[2 * _s + 1][2], T[2 * _s + 1][3])}; \
                _bS[_s] = __builtin_bit_cast(bf16x8_t, _pk); } \
            f32x4 _z = (f32x4){__uint_as_float(uv[0].x << 16), __uint_as_float(uv[0].x & 0xffff0000u), __uint_as_float(uv[0].y << 16), __uint_as_float(uv[0].y & 0xffff0000u)}; \
            _z = __builtin_amdgcn_mfma_f32_16x16x32_bf16(O.wmf[0], _bS[0], _z, 0, 0, 0); _z = __builtin_amdgcn_mfma_f32_16x16x32_bf16(O.wmf[1], _bS[1], _z, 0, 0, 0); \
            f32x4 _y = (f32x4){0.f, 0.f, 0.f, 0.f}; \
            _y = __builtin_amdgcn_mfma_f32_16x16x32_bf16(_bS[0], O.rf[0], _y, 0, 0, 0); _y = __builtin_amdgcn_mfma_f32_16x16x32_bf16(_bS[1], O.rf[1], _y, 0, 0, 0); \
            const u32x4_t _zvp = (u32x4_t){pk2(-_z[0], -_z[1]), pk2(-_z[2], -_z[3]), uv[1].x, uv[1].y}; \
            const bf16x8_t _bZV = __builtin_bit_cast(bf16x8_t, _zvp); \
            _Pragma("unroll") for (int _i = 0; _i < 4; ++_i) { T[_i] = __builtin_amdgcn_mfma_f32_16x16x32_bf16(O.bkf[_i], _bZV, T[_i], 0, 0, 0); T[_i] = T[_i] * O.g4[_i]; } \
            _y = __builtin_amdgcn_mfma_f32_16x16x32_bf16(_bZV, O.arf, _y, 0, 0, 0); \
            if (!(VAR & 4)) *(f32x4*)yp = _y; else asm volatile("" :: "v"(_y)); RW_ST2(); yp += 8 * 1024; } while (0)
#if SP_MODE & 16
#define RW_ST2() do { asm volatile("" ::: "memory"); *(f32x4*)yp = _y; } while (0)
#else
#define RW_ST2() do { } while (0)
#endif
#define RW_SYNC() do { asm volatile("s_waitcnt lgkmcnt(0)" ::: "memory"); RW_BARRIER(); } while (0)
        Ops A, B;
        u32x2_t uv0[2], uv1[2], uv2[2], uv3[2], uv4[2], uv5[2], uv6[2], uv7[2];
        RW_UV(uv0); RW_UV(uv1); RW_UV(uv2); RW_UV(uv3); RW_UV(uv4); RW_UV(uv5); RW_UV(uv6); RW_UV(uv7);
        RW_BARRIER();
        RW_LOAD(A);
#pragma unroll 1
        for (int ch = 0; ch < NCH; ch += 8) {
            RW_LOAD(B); RW_STEP(A, uv0); RW_UV(uv0);
            RW_LOAD(A); RW_STEP(B, uv1); RW_UV(uv1); RW_SYNC();
            RW_LOAD(B); RW_STEP(A, uv2); RW_UV(uv2);
            RW_LOAD(A); RW_STEP(B, uv3); RW_UV(uv3); RW_SYNC();
            RW_LOAD(B); RW_STEP(A, uv4); RW_UV(uv4);
            RW_LOAD(A); RW_STEP(B, uv5); RW_UV(uv5); RW_SYNC();
            RW_LOAD(B); RW_STEP(A, uv6); RW_UV(uv6);
            RW_LOAD(A); RW_STEP(B, uv7); RW_UV(uv7); RW_SYNC(); }
#undef RW_SYNC
#undef RW_LOAD
#undef RW_LOAD1
#undef RW_STEP
#undef RW_UV
    }
#undef RW_BARRIER
}
__device__ __forceinline__ void ph_rwkv_post(const Args& a, LAS float* lds) {
    const bf16_t* V = (const bf16_t*)a.out; const float* Bon = (const float*)((const unsigned char*)a.out + DO_BON); const bf16_t* SG = (const bf16_t*)((const unsigned char*)a.out + DO_SG);
    const float* Yr = (const float*)((const unsigned char*)a.out + DO_YR); bf16_t* MIX = (bf16_t*)(a.ws + WS_D);
    const float* ln_w = a.in[14]; const float* ln_b = a.in[15];
    LAS unsigned char* L = (LAS unsigned char*)lds;
    const int c = threadIdx.x, lane = c & 63, h = c >> 6, q4 = lane >> 4, c16 = lane & 15;
    const bf16_t* FG = (const bf16_t*)(a.ws + FG_G2) + h * 8192;
    LAS unsigned char* TW = L + 8192 + h * 2304;
    for (int tile = blockIdx.x; tile < NTOK / 16; tile += gridDim.x) {
        const int n0 = tile * 16;
        __syncthreads();
        { const int tk = c >> 5, j4 = (c & 31) * 4; *(LAS u32x2_t*)(L + tk * 272 + j4 * 2) = *(const u32x2_t*)(SG + (size_t)tile * 2048 + (j4 >> 4) * 256 + tk * 16 + (j4 & 15)); }
        __syncthreads();
        const int n = n0 + c16;
        f32x4 g[4], y[4];
#pragma unroll
        for (int ct = 0; ct < 4; ++ct) { g[ct] = (f32x4){0.f, 0.f, 0.f, 0.f};
#pragma unroll
            for (int ks = 0; ks < 4; ++ks) { const bf16x8_t af = *(const bf16x8_t*)(FG + ((size_t)(ct * 4 + ks) * 64 + lane) * 8); const bf16x8_t bfr = *(const LAS bf16x8_t*)(L + c16 * 272 + ks * 64 + q4 * 16);
                g[ct] = __builtin_amdgcn_mfma_f32_16x16x32_bf16(af, bfr, g[ct], 0, 0, 0); }
            y[ct] = *(const f32x4*)(Yr + (size_t)tile * 8192 + h * 1024 + ct * 256 + lane * 4); }
        float sm = 0.f;
#pragma unroll
        for (int ct = 0; ct < 4; ++ct) sm += (y[ct][0] + y[ct][1]) + (y[ct][2] + y[ct][3]);
        sm = xrow16_sum(sm);
        const float mean = sm * (1.f / 64.f);
        float sv = 0.f;
#pragma unroll
        for (int ct = 0; ct < 4; ++ct) { y[ct] = y[ct] - mean; sv += (y[ct][0] * y[ct][0] + y[ct][1] * y[ct][1]) + (y[ct][2] * y[ct][2] + y[ct][3] * y[ct][3]); }
        sv = xrow16_sum(sv);
        const float rstd = rsqrtf(sv * (1.f / 64.f) + 64e-5f), bsc = Bon[(size_t)n * 8 + h];
#pragma unroll
        for (int ct = 0; ct < 4; ++ct) { const int ch = 64 * h + 16 * ct + 4 * q4;
            const f32x4 lw = *(const f32x4*)(ln_w + ch), lb = *(const f32x4*)(ln_b + ch);
            const u32x2_t vv = *(const u32x2_t*)(V + (size_t)n * 512 + ch);
            const float v0 = __uint_as_float(vv.x << 16), v1 = __uint_as_float(vv.x & 0xffff0000u), v2 = __uint_as_float(vv.y << 16), v3 = __uint_as_float(vv.y & 0xffff0000u);
            const float o0 = (y[ct][0] * rstd * lw[0] + lb[0] + bsc * v0) * g[ct][0], o1 = (y[ct][1] * rstd * lw[1] + lb[1] + bsc * v1) * g[ct][1];
            const float o2 = (y[ct][2] * rstd * lw[2] + lb[2] + bsc * v2) * g[ct][2], o3 = (y[ct][3] * rstd * lw[3] + lb[3] + bsc * v3) * g[ct][3];
            *(LAS u32x2_t*)(TW + c16 * 136 + ct * 32 + q4 * 8) = (u32x2_t){pk2(o0, o1), pk2(o2, o3)}; }
#pragma unroll
        for (int j = 0; j < 2; ++j) { const int tk = 8 * j + (lane >> 3), pc = lane & 7;
            *(u32x4_t*)(MIX + (size_t)(n0 + tk) * DM + 64 * h + pc * 8) = *(const LAS u32x4_t*)(TW + tk * 136 + pc * 16); }
    }
}

namespace gla {
typedef short bf16x8 __attribute__((ext_vector_type(8)));
typedef float f32x16 __attribute__((ext_vector_type(16)));
typedef unsigned u32x4 __attribute__((ext_vector_type(4)));
typedef unsigned u32x2 __attribute__((ext_vector_type(2)));
constexpr int QH_OFF = 0, KH_OFF = 17408, KT_OFF = 34816, VT_OFF = 53248, ST_OFF = 71680, AM_OFF = 106496, EB_OFF = 115712, ER_OFF = 116224, PS_OFF = 116736, SSQ_OFF = 118784, OT_OFF = 119808;
constexpr int QS = 272, TS = 144;
#define GLA_BAR() do { asm volatile("s_waitcnt lgkmcnt(0)" ::: "memory"); __builtin_amdgcn_s_barrier(); asm volatile("" ::: "memory"); } while (0)
template <bool OUT>
__device__ __forceinline__ void unit(const Args& a, LAS unsigned char* L, int u) {
    const int tid = threadIdx.x, lane = tid & 63, w = tid >> 6;
    const int b = u >> 6, h = (u >> 3) & 7, j = u & 7;
    const bf16_t* Q = (const bf16_t*)(a.ws + WS_QFIG) + ((size_t)b * SEQ + (size_t)j * 1024) * 4096 + h * 128;
    float* Lb = (float*)(a.ws + WS_O); float* Db = Lb + (size_t)256 * 16384;
    const int dk = tid & 127, tg = tid >> 7;
    const float c0 = a.in[25][h * 128 + dk], c1 = a.in[25][1024 + h * 128 + dk];
    const float lbv = __builtin_amdgcn_rcpf(1.f + __expf(c0 - c1)), omlb = 1.f - lbv;
    LAS float* PS = (LAS float*)(L + PS_OFF); LAS float* EB = (LAS float*)(L + EB_OFF); LAS float* ER = (LAS float*)(L + ER_OFF); LAS float* SSQ = (LAS float*)(L + SSQ_OFF);
    const int si = w >> 1, sj0 = (w & 1) * 2, l31 = lane & 31, l5 = lane >> 5;
    const int ri = w >> 2, cj = w & 3, odv = 32 * cj + l31;
    f32x16 S[2];
#pragma unroll
    for (int jj = 0; jj < 2; ++jj)
#pragma unroll
        for (int r = 0; r < 16; ++r) S[jj][r] = 0.f;
    if (OUT) {
#pragma unroll 1
        for (int i = 0; i < j; ++i) { const int ui = u - j + i;
#pragma unroll
            for (int jj = 0; jj < 2; ++jj)
#pragma unroll
                for (int rg = 0; rg < 4; ++rg) { const int sdk0 = 32 * si + 8 * rg + 4 * l5, sdv = 32 * (sj0 + jj) + l31; const f32x4 dd = *(const f32x4*)(Db + ui * 128 + sdk0);
#pragma unroll
                    for (int e = 0; e < 4; ++e) S[jj][4 * rg + e] = dd[e] * S[jj][4 * rg + e] + Lb[(size_t)ui * 16384 + (sdk0 + e) * 128 + sdv]; } } }
    const float nwv = OUT ? a.in[26][h * 128 + odv] : 0.f;
    float dsum = 1.f;
    const int prow = tid >> 4, ppc = tid & 15;
    u32x4 pf[2], pv[2], pq[2];
#define GLA_PREFETCH(cx) do { const bf16_t* _q = Q + (size_t)((cx) * 64 + prow) * 4096 + ppc * 8; \
        _Pragma("unroll") for (int _r = 0; _r < 2; ++_r) { pf[_r] = *(const u32x4*)(_q + (size_t)_r * 32 * 4096 + 1024); pv[_r] = *(const u32x4*)(_q + (size_t)_r * 32 * 4096 + 2048); if (OUT) pq[_r] = *(const u32x4*)(_q + (size_t)_r * 32 * 4096); } } while (0)
    GLA_PREFETCH(0);
#pragma unroll 1
    for (int c = 0; c < 16; ++c) {
        int cc = c; asm volatile("" : "+s"(cc));
#pragma unroll
        for (int r = 0; r < 2; ++r) { *(LAS u32x4*)(L + KH_OFF + (prow + 32 * r) * QS + ppc * 16) = pf[r]; *(LAS u32x4*)(L + ST_OFF + (prow + 32 * r) * QS + ppc * 16) = pv[r];
            if (OUT) *(LAS u32x4*)(L + QH_OFF + (prow + 32 * r) * QS + ppc * 16) = pq[r]; }
        if (c + 1 < 16) GLA_PREFETCH(cc + 1);
        u32x4 gq[2];
        if (OUT) { const bf16_t* G = Q + (size_t)(cc * 64) * 4096 + 3072;
            unsigned go = (unsigned)((tid >> 3) * 4096 + (tid & 7) * 16); asm volatile("" : "+v"(go));
            gq[0] = *(const u32x4*)(G + go); gq[1] = *(const u32x4*)(G + go + 8u); }
        GLA_BAR();
        float lf[16], kk[16];
#pragma unroll
        for (int i = 0; i < 16; ++i) { const float fv = bf2f(*(const LAS bf16_t*)(L + KH_OFF + (tg * 16 + i) * QS + dk * 2)); const float sg = __builtin_amdgcn_rcpf(1.f + __expf(-fv));
            lf[i] = lbv + omlb * sg; kk[i] = omlb * (1.f - sg); }
#pragma unroll
        for (int i = 1; i < 16; ++i) lf[i] *= lf[i - 1];
        PS[tg * 128 + dk] = lf[15];
        GLA_BAR();
        const float p0 = PS[dk], p1 = PS[128 + dk], p2 = PS[256 + dk], p3 = PS[384 + dk];
        const float off = (tg > 0 ? p0 : 1.f) * (tg > 1 ? p1 : 1.f) * (tg > 2 ? p2 : 1.f);
        const float pref = p0 * p1, pbl = pref * (p2 * p3), ebr = p2 * p3;
        const float ioff = off * __builtin_amdgcn_rcpf(pref);
        unsigned ktp[8], vtp[8];
#pragma unroll
        for (int i = 0; i < 16; i += 2) {
            float kb[2]; unsigned vv[2];
#pragma unroll
            for (int q = 0; q < 2; ++q) { const float e1 = ioff * lf[i + q]; const float e2 = __builtin_amdgcn_rcpf(e1);
                const float khat = kk[i + q] * e2; kb[q] = khat * ebr; vv[q] = *(const LAS bf16_t*)(L + ST_OFF + (tg * 16 + i + q) * QS + dk * 2);
                if (OUT) { LAS bf16_t* qp = (LAS bf16_t*)(L + QH_OFF + (tg * 16 + i + q) * QS + dk * 2); const float qr = bf2f(*qp); const float qv = qr * __builtin_amdgcn_rcpf(1.f + __expf(-qr));
                    *qp = f2bf(qv * e1); *(LAS bf16_t*)(L + KH_OFF + (tg * 16 + i + q) * QS + dk * 2) = f2bf(khat); } }
            ktp[i >> 1] = pk2(kb[0], kb[1]); vtp[i >> 1] = vv[0] | (vv[1] << 16);
        }
        *(LAS u32x4*)(L + KT_OFF + dk * TS + tg * 32) = (u32x4){ktp[0], ktp[1], ktp[2], ktp[3]}; *(LAS u32x4*)(L + KT_OFF + dk * TS + tg * 32 + 16) = (u32x4){ktp[4], ktp[5], ktp[6], ktp[7]};
        *(LAS u32x4*)(L + VT_OFF + dk * TS + tg * 32) = (u32x4){vtp[0], vtp[1], vtp[2], vtp[3]}; *(LAS u32x4*)(L + VT_OFF + dk * TS + tg * 32 + 16) = (u32x4){vtp[4], vtp[5], vtp[6], vtp[7]};
        if (tg == 0) { EB[dk] = pbl; ER[dk] = pref; dsum *= pbl; }
        GLA_BAR();
        f32x16 o;
        if (OUT) {
#pragma unroll
            for (int jj = 0; jj < 2; ++jj)
#pragma unroll
                for (int rg = 0; rg < 4; ++rg) { const int dk0 = 32 * si + 8 * rg + 4 * l5; const f32x4 er = *(const LAS f32x4*)(ER + dk0);
                    u32x2 pk; pk.x = pk2(S[jj][4 * rg] * er[0], S[jj][4 * rg + 1] * er[1]); pk.y = pk2(S[jj][4 * rg + 2] * er[2], S[jj][4 * rg + 3] * er[3]);
                    *(LAS u32x2*)(L + ST_OFF + (32 * (sj0 + jj) + l31) * QS + dk0 * 2) = pk; }
#pragma unroll
            for (int q = 0; q < 2; ++q) { const int ti = w >> 1, tj = (w & 1) * 2 + q;
                f32x4 sc = (f32x4){0.f, 0.f, 0.f, 0.f};
                if (tj <= ti) {
#pragma unroll
                    for (int ks = 0; ks < 4; ++ks) { const bf16x8 af = *(const LAS bf16x8*)(L + QH_OFF + (16 * ti + (lane & 15)) * QS + ks * 64 + (lane >> 4) * 16);
                        const bf16x8 bfr = *(const LAS bf16x8*)(L + KH_OFF + (16 * tj + (lane & 15)) * QS + ks * 64 + (lane >> 4) * 16);
                        sc = __builtin_amdgcn_mfma_f32_16x16x32_bf16(af, bfr, sc, 0, 0, 0); } }
                const int scol = 16 * tj + (lane & 15);
#pragma unroll
                for (int r = 0; r < 4; ++r) { const int trow = 16 * ti + 4 * (lane >> 4) + r; const float v = (scol <= trow) ? sc[r] : 0.f;
                    *(LAS bf16_t*)(L + AM_OFF + trow * TS + scol * 2) = f2bf(v); } }
            GLA_BAR();
#pragma unroll
            for (int r = 0; r < 16; ++r) o[r] = 0.f;
#pragma unroll
            for (int ks = 0; ks < 4; ++ks) if (ks < 2 * (ri + 1)) {
                const bf16x8 af = *(const LAS bf16x8*)(L + AM_OFF + (32 * ri + l31) * TS + ks * 32 + l5 * 16);
                const bf16x8 bfr = *(const LAS bf16x8*)(L + VT_OFF + (32 * cj + l31) * TS + ks * 32 + l5 * 16);
                o = __builtin_amdgcn_mfma_f32_32x32x16_bf16(af, bfr, o, 0, 0, 0); }
#pragma unroll
            for (int ks = 0; ks < 8; ++ks) { if ((ks & 3) == 0) asm volatile("" ::: "memory");
                const bf16x8 af = *(const LAS bf16x8*)(L + QH_OFF + (32 * ri + l31) * QS + ks * 32 + l5 * 16);
                const bf16x8 bfr = *(const LAS bf16x8*)(L + ST_OFF + (32 * cj + l31) * QS + ks * 32 + l5 * 16);
                o = __builtin_amdgcn_mfma_f32_32x32x16_bf16(af, bfr, o, 0, 0, 0); }
#pragma unroll
            for (int r = 0; r < 16; ++r) { const float q2 = xrow32_sum(row16_sum(o[r] * o[r]));
                if (l31 == 0) SSQ[(32 * ri + (r & 3) + 8 * (r >> 2) + 4 * l5) * 4 + cj] = q2; }
#pragma unroll
            for (int r = 0; r < 16; ++r) *(LAS float*)(L + OT_OFF + (32 * ri + (r & 3) + 8 * (r >> 2) + 4 * l5) * 528 + odv * 4) = o[r] * nwv;
        }
        {
            bf16x8 af[4];
#pragma unroll
            for (int ks = 0; ks < 4; ++ks) af[ks] = *(const LAS bf16x8*)(L + KT_OFF + (32 * si + l31) * TS + ks * 32 + l5 * 16);
#pragma unroll
            for (int jj = 0; jj < 2; ++jj) {
#pragma unroll
                for (int rg = 0; rg < 4; ++rg) { const f32x4 eb = *(const LAS f32x4*)(EB + 32 * si + 8 * rg + 4 * l5);
                    S[jj][4 * rg] *= eb[0]; S[jj][4 * rg + 1] *= eb[1]; S[jj][4 * rg + 2] *= eb[2]; S[jj][4 * rg + 3] *= eb[3]; }
#pragma unroll
                for (int ks = 0; ks < 4; ++ks) { const bf16x8 bfr = *(const LAS bf16x8*)(L + VT_OFF + (32 * (sj0 + jj) + l31) * TS + ks * 32 + l5 * 16);
                    S[jj] = __builtin_amdgcn_mfma_f32_32x32x16_bf16(af[ks], bfr, S[jj], 0, 0, 0); } }
        }
        GLA_BAR();
        if (OUT) {
            const int et = tid >> 3, ep = tid & 7;
            const f32x4 q4 = *(const LAS f32x4*)(SSQ + et * 4);
            const float rs = rsqrtf(((q4[0] + q4[1]) + (q4[2] + q4[3])) * (1.f / 128.f) + 1e-6f);
            bf16_t* MIX = (bf16_t*)(a.ws + WS_MIX1) + ((size_t)b * SEQ + (size_t)j * 1024 + cc * 64) * DM + h * 128;
            unsigned mo = (unsigned)(et * DM + ep * 16); asm volatile("" : "+v"(mo));
#pragma unroll
            for (int hf = 0; hf < 2; ++hf) { unsigned ov[4];
#pragma unroll
                for (int e2 = 0; e2 < 2; ++e2) { const f32x4 o4 = *(const LAS f32x4*)(L + OT_OFF + et * 528 + ep * 64 + hf * 32 + e2 * 16);
#pragma unroll
                    for (int e = 0; e < 2; ++e) { const unsigned gw = gq[hf][e2 * 2 + e]; const float g0 = __uint_as_float(gw << 16), g1 = __uint_as_float(gw & 0xffff0000u);
                        ov[e2 * 2 + e] = pk2(o4[2 * e] * rs * g0 * __builtin_amdgcn_rcpf(1.f + __expf(-g0)), o4[2 * e + 1] * rs * g1 * __builtin_amdgcn_rcpf(1.f + __expf(-g1))); } }
                *(u32x4*)(MIX + mo + hf * 8) = (u32x4){ov[0], ov[1], ov[2], ov[3]}; }
        }
    }
    if (!OUT) {
#pragma unroll
        for (int jj = 0; jj < 2; ++jj)
#pragma unroll
            for (int r = 0; r < 16; ++r) { const int sdk = 32 * si + (r & 3) + 8 * (r >> 2) + 4 * l5, sdv = 32 * (sj0 + jj) + l31; Lb[(size_t)u * 16384 + sdk * 128 + sdv] = S[jj][r]; }
        if (tg == 0) Db[u * 128 + dk] = dsum;
    }
    GLA_BAR();
#undef GLA_PREFETCH
}
__device__ __forceinline__ void pass2(const Args& a) {
    float* Lb = (float*)(a.ws + WS_O); const float* Db = Lb + (size_t)256 * 16384;
    for (int idx = blockIdx.x * NTHREADS + threadIdx.x; idx < 32 * 16384; idx += gridDim.x * NTHREADS) { const int bh = idx >> 14, el = idx & 16383, dkk = el >> 7; float sacc = 0.f;
        for (int j = 0; j < 8; ++j) { const int u = bh * 8 + j; const size_t o = (size_t)u * 16384 + el;
            if (j < 7) { const float tmp = Lb[o]; Lb[o] = sacc; sacc = Db[u * 128 + dkk] * sacc + tmp; } else Lb[o] = sacc; } }
}
}

constexpr int NPHASE = 24;
__global__ void __launch_bounds__(NTHREADS, 2) fwd(Args a) {
    extern __shared__ __attribute__((aligned(16))) unsigned char lds_raw[];
    LAS unsigned char* ldsb = (LAS unsigned char*)lds_raw;
    LAS float* lds = (LAS float*)ldsb;
    LAS int* pst = (LAS int*)(ldsb + LDS_MISC);
    volatile LAS unsigned* xbw = (volatile LAS unsigned*)(ldsb + LDS_MISC + 256);
    if (threadIdx.x == 0) { xbw[0] = 0u; xbw[1] = 0u; }
    __syncthreads();
    unsigned* ctl = (unsigned*)(a.ws + WS_CTL);
    const bool multi = (a.ph_hi - a.ph_lo) > 1;
    XcdBarrier bar; bar.bar = ctl; bar.x = 0; bar.st = xbw;
    if (multi) bar = xcd_barrier_post(ctl, xbw);
    unsigned char* ws = a.ws;
    bf16_t* HN = (bf16_t*)(ws + WS_A);
    bf16_t* XR = (bf16_t*)(ws + WS_XR); float* RSv = (float*)(ws + WS_ROUTE + RT_LRU_CH);
    int* asg_e = (int*)(ws + WS_ROUTE + RT_ASG_E); int* asg_rank = (int*)(ws + WS_ROUTE + RT_ASG_RANK); float* asg_gate = (float*)(ws + WS_ROUTE + RT_ASG_GATE);
    int* row_tok = (int*)(ws + WS_ROUTE + RT_ROW_TOK); int* row_slot = (int*)(ws + WS_ROUTE + RT_ROW_SLOT); float* row_gate = (float*)(ws + WS_ROUTE + RT_ROW_GATE); float* row_rs = (float*)(ws + WS_ROUTE + RT_LRU_CA); float* tscale = (float*)(ws + WS_ROUTE + RT_LRU_CIN);
#ifndef PHSEL
#define PHSEL(k) true
#endif
#ifndef REPMASK
#define REPMASK 0u
#endif
#define NREP(k) (((REPMASK >> (k)) & 1u) ? 2 : 1)
#define IN(k) (PHSEL(k) && a.ph_lo <= (k) && (k) < a.ph_hi)
#define SEAM(k) do { if (IN((k) + 1) && multi) xcd_barrier(bar); } while (0)
    if (IN(0)) { ph_cvt_frags(a); ph_cvt_dense_a(a, lds, ctl + CW_COLMAX); ph_norm0(a.in[0], a.in[1], (unsigned char*)HN, (float*)(ws + WS_ROUTE + RT_LRU_CH + 262144)); xcd_barrier(bar); ph_cvt_dense_b(a, lds, ctl + CW_COLMAX, 0); }
#if (REPMASK >> 0) & 1
    if (IN(0)) { xcd_barrier(bar);  ph_cvt_frags(a); ph_cvt_dense_a(a, lds, ctl + CW_COLMAX); ph_norm0(a.in[0], a.in[1], (unsigned char*)HN, (float*)(ws + WS_ROUTE + RT_LRU_CH + 262144)); xcd_barrier(bar); ph_cvt_dense_b(a, lds, ctl + CW_COLMAX, 0); }
#endif
    if (IN(0)) { SEAM(0); }
    if (IN(1)) { pg8::DenseOrder S; S.init(ABC, NTOK, DM / 2, gridDim.x, blockIdx.x, HN); pg8::EpiBf16IT E{(bf16_t*)(ws + WS_B), ABC, (float*)(ws + WS_ROUTE + RT_LRU_CH + 262144), ctl + CW_COLMAX};
        pg8::gemm_phase<pg8::EpiBf16IT, pg8::DenseOrder, true>(ldsb, (const char*)(ws + WD_ABIN), DM, DM / 2, S, E); }
#if (REPMASK >> 1) & 1
    if (IN(1)) { xcd_barrier(bar);  pg8::DenseOrder S; S.init(ABC, NTOK, DM / 2, gridDim.x, blockIdx.x, HN); pg8::EpiBf16IT E{(bf16_t*)(ws + WS_B), ABC, (float*)(ws + WS_ROUTE + RT_LRU_CH + 262144), ctl + CW_COLMAX};
        pg8::gemm_phase<pg8::EpiBf16IT, pg8::DenseOrder, true>(ldsb, (const char*)(ws + WD_ABIN), DM, DM / 2, S, E);  }
#endif
    if (IN(1)) { SEAM(1); }
    if (IN(2)) { ph_l0_prep(a, lds); }
#if (REPMASK >> 2) & 1
    if (IN(2)) { xcd_barrier(bar);  ph_l0_prep(a, lds);  }
#endif
    if (IN(2)) { SEAM(2); }
    if (IN(6)) {
        if (blockIdx.x < NSCAN) {
#if SP_MODE & 64
            ph_rwkv_scan<0, SCAN_COOP>(a, ldsb); __syncthreads();
#endif
#if SP_VAR
            ph_rwkv_scan<SP_VAR, SCAN_COOP>(a, ldsb); __syncthreads(); ph_rwkv_scan<0, SCAN_COOP>(a, ldsb);
#else
            ph_rwkv_scan<0, SCAN_COOP>(a, ldsb);
#endif
        } else { const int gb = (int)blockIdx.x - NSCAN, gn = (int)gridDim.x - NSCAN; unsigned* sctr = ctl + CW_CNT + 256;
            ph_lru_b(a, gb, lds); sub_barrier(sctr, (unsigned)gn);
#if SP_MODE & 1
            ph_lru_c(a, gb, gn); }
        xcd_barrier(bar); ph_wmax(a.in[32], a.in[33], ctl + CW_WMAX, blockIdx.x, gridDim.x); xcd_barrier(bar);
        ph_cvt_moe(a, 0, lds, blockIdx.x, gridDim.x, 3); ph_cvt_moe(a, 1, lds, blockIdx.x, gridDim.x, 1);
#else
            ph_lru_c(a, gb, gn); ph_wmax(a.in[32], a.in[33], ctl + CW_WMAX, gb, gn); sub_barrier(sctr, 2u * (unsigned)gn);
            ph_cvt_moe(a, 0, lds, gb, gn, 3); ph_cvt_moe(a, 1, lds, gb, gn, 1);
#if SP_MODE & 32
            ph_cvt_moe(a, 1, lds, gb, gn, 1);
#endif
            }
#endif
        SEAM(6); }
    if (IN(7)) { ph_rwkv_post(a, lds); }
#if (REPMASK >> 7) & 1
    if (IN(7)) { xcd_barrier(bar);  ph_rwkv_post(a, lds);  }
#endif
    if (IN(7)) { SEAM(7); }
    if (IN(8)) { pg8::DenseOrder S; S.init(NTOK, DM, DM, gridDim.x, blockIdx.x, ws + WD_ABOUT); pg8::EpiResid<true> E{a.in[0], XR};
        pg8::gemm_phase(ldsb, (const char*)(ws + WS_D), DM * 2, DM, S, E); }
#if (REPMASK >> 8) & 1
    if (IN(8)) { xcd_barrier(bar);  pg8::DenseOrder S; S.init(NTOK, DM, DM, gridDim.x, blockIdx.x, ws + WD_ABOUT); pg8::EpiResid<true> E{a.in[0], XR};
        pg8::gemm_phase(ldsb, (const char*)(ws + WS_D), DM * 2, DM, S, E);  }
#endif
    if (IN(8)) { SEAM(8); }
    if (IN(9)) { ph_route(a, 0, XR, HN, RSv, ctl + CW_CNT, asg_e, asg_rank, asg_gate, lds); SEAM(9); }
    if (IN(10)) { ph_dispatch(ctl + CW_CNT, asg_e, asg_rank, asg_gate, RSv, row_tok, row_slot, row_gate, row_rs, pst, ctl + CW_WMAX, tscale); ph_cvt_dense_b(a, lds, ctl + CW_COLMAX, 1); }
#if (REPMASK >> 10) & 1
    if (IN(10)) { xcd_barrier(bar);  ph_dispatch(ctl + CW_CNT, asg_e, asg_rank, asg_gate, RSv, row_tok, row_slot, row_gate, row_rs, pst, ctl + CW_WMAX, tscale);  }
#endif
    if (IN(10)) { SEAM(10); }
    if (IN(11)) { moe_prefix(ctl + CW_CNT, pst);
        pg8::MoeOrder S{(int)gridDim.x, (int)blockIdx.x, 4, pst[NEXP] / 256, pst, row_tok, (const char*)(ws + WM_GU), (size_t)DM * DM, (size_t)256 * DM}; pg8::EpiSwiGLU E{(bf16_t*)(ws + WS_H), tscale};
        pg8::gemm_phase<pg8::EpiSwiGLU, pg8::MoeOrder, true>(ldsb, (const char*)HN, DM, DM / 2, S, E); }
#if (REPMASK >> 11) & 1
    if (IN(11)) { xcd_barrier(bar);  moe_prefix(ctl + CW_CNT, pst);
        pg8::MoeOrder S{(int)gridDim.x, (int)blockIdx.x, 4, pst[NEXP] / 256, pst, row_tok, (const char*)(ws + WM_GU), (size_t)DM * DM, (size_t)256 * DM}; pg8::EpiSwiGLU E{(bf16_t*)(ws + WS_H), tscale};
        pg8::gemm_phase<pg8::EpiSwiGLU, pg8::MoeOrder, true>(ldsb, (const char*)HN, DM, DM / 2, S, E);  }
#endif
    if (IN(11)) { SEAM(11); }
    if (IN(12)) { moe_prefix(ctl + CW_CNT, pst);
        pg8::MoeOrder S{(int)gridDim.x, (int)blockIdx.x, 4, pst[NEXP] / 256, pst, nullptr, (const char*)(ws + WM_DN), (size_t)DM * FF * 2, (size_t)256 * FF * 2}; pg8::EpiDown E{(bf16_t*)(ws + WS_Y), row_tok, row_slot, row_gate};
        pg8::gemm_phase(ldsb, (const char*)(ws + WS_H), FF * 2, FF, S, E); }
#if (REPMASK >> 12) & 1
    if (IN(12)) { xcd_barrier(bar);  moe_prefix(ctl + CW_CNT, pst);
        pg8::MoeOrder S{(int)gridDim.x, (int)blockIdx.x, 4, pst[NEXP] / 256, pst, nullptr, (const char*)(ws + WM_DN), (size_t)DM * FF * 2, (size_t)256 * FF * 2}; pg8::EpiDown E{(bf16_t*)(ws + WS_Y), row_tok, row_slot, row_gate};
        pg8::gemm_phase(ldsb, (const char*)(ws + WS_H), FF * 2, FF, S, E);  }
#endif
    if (IN(12)) { SEAM(12); }
    if (IN(13)) { ph_combine_norm(XR, (const bf16_t*)(ws + WS_Y), a.in[1] + DM, (unsigned char*)HN, (float*)(ws + WS_ROUTE + RT_LRU_CH + 262144)); SEAM(13); }
    if (IN(14)) { pg8::DenseOrder S; S.init(NTOK, 4096, DM / 2, gridDim.x, blockIdx.x, ws + WD_CIN); pg8::EpiBf16I E{(bf16_t*)(ws + WS_QFIG), 4096, (float*)(ws + WS_ROUTE + RT_LRU_CH + 262144), ctl + CW_COLMAX + ABC};
        pg8::gemm_phase<pg8::EpiBf16I, pg8::DenseOrder, true>(ldsb, (const char*)HN, DM, DM / 2, S, E); }
#if (REPMASK >> 14) & 1
    if (IN(14)) { xcd_barrier(bar);  pg8::DenseOrder S; S.init(NTOK, 4096, DM / 2, gridDim.x, blockIdx.x, ws + WD_CIN); pg8::EpiBf16I E{(bf16_t*)(ws + WS_QFIG), 4096, (float*)(ws + WS_ROUTE + RT_LRU_CH + 262144), ctl + CW_COLMAX + ABC};
        pg8::gemm_phase<pg8::EpiBf16I, pg8::DenseOrder, true>(ldsb, (const char*)HN, DM, DM / 2, S, E);  }
#endif
    if (IN(14)) { SEAM(14); }
    if (IN(15)) { for (int u = blockIdx.x; u < 256; u += gridDim.x) if ((u & 7) != 7) gla::unit<false>(a, ldsb, u); }
#if (REPMASK >> 15) & 1
    if (IN(15)) { xcd_barrier(bar);  for (int u = blockIdx.x; u < 256; u += gridDim.x) if ((u & 7) != 7) gla::unit<false>(a, ldsb, u);  }
#endif
    if (IN(15)) { SEAM(15); }
    if (IN(17)) { for (int u = blockIdx.x; u < 256; u += gridDim.x) gla::unit<true>(a, ldsb, u); }
#if (REPMASK >> 17) & 1
    if (IN(17)) { xcd_barrier(bar);  for (int u = blockIdx.x; u < 256; u += gridDim.x) gla::unit<true>(a, ldsb, u);  }
#endif
    if (IN(17)) { SEAM(17); }
    if (IN(18)) { pg8::DenseOrder S; S.init(NTOK, DM, DM, gridDim.x, blockIdx.x, ws + WD_COUT); pg8::EpiResid<false> E{XR, XR};
        pg8::gemm_phase(ldsb, (const char*)(ws + WS_MIX1), DM * 2, DM, S, E); SEAM(18); }
    if (IN(19)) { ph_route(a, 1, XR, HN, RSv, ctl + CW_CNT + 64, asg_e, asg_rank, asg_gate, lds); SEAM(19); }
    if (IN(20)) { ph_dispatch(ctl + CW_CNT + 64, asg_e, asg_rank, asg_gate, RSv, row_tok, row_slot, row_gate, row_rs, pst, ctl + CW_WMAX + 64, tscale); ph_cvt_moe(a, 1, lds, blockIdx.x, gridDim.x, 2); }
#if (REPMASK >> 20) & 1
    if (IN(20)) { xcd_barrier(bar);  ph_dispatch(ctl + CW_CNT + 64, asg_e, asg_rank, asg_gate, RSv, row_tok, row_slot, row_gate, row_rs, pst, ctl + CW_WMAX + 64, tscale); ph_cvt_moe(a, 1, lds, blockIdx.x, gridDim.x, 2);  }
#endif
    if (IN(20)) { SEAM(20); }
    if (IN(21)) { moe_prefix(ctl + CW_CNT + 64, pst);
        pg8::MoeOrder S{(int)gridDim.x, (int)blockIdx.x, 4, pst[NEXP] / 256, pst, row_tok, (const char*)(ws + WM_GU1), (size_t)DM * DM, (size_t)256 * DM}; pg8::EpiSwiGLU E{(bf16_t*)(ws + WS_H), tscale};
        pg8::gemm_phase<pg8::EpiSwiGLU, pg8::MoeOrder, true>(ldsb, (const char*)HN, DM, DM / 2, S, E); }
#if (REPMASK >> 21) & 1
    if (IN(21)) { xcd_barrier(bar);  moe_prefix(ctl + CW_CNT + 64, pst);
        pg8::MoeOrder S{(int)gridDim.x, (int)blockIdx.x, 4, pst[NEXP] / 256, pst, row_tok, (const char*)(ws + WM_GU1), (size_t)DM * DM, (size_t)256 * DM}; pg8::EpiSwiGLU E{(bf16_t*)(ws + WS_H), tscale};
        pg8::gemm_phase<pg8::EpiSwiGLU, pg8::MoeOrder, true>(ldsb, (const char*)HN, DM, DM / 2, S, E);  }
#endif
    if (IN(21)) { SEAM(21); }
    if (IN(22)) { moe_prefix(ctl + CW_CNT + 64, pst);
        pg8::MoeOrder S{(int)gridDim.x, (int)blockIdx.x, 4, pst[NEXP] / 256, pst, nullptr, (const char*)(ws + WM_DN), (size_t)DM * FF * 2, (size_t)256 * FF * 2}; pg8::EpiDown E{(bf16_t*)(ws + WS_Y), row_tok, row_slot, row_gate};
        pg8::gemm_phase(ldsb, (const char*)(ws + WS_H), FF * 2, FF, S, E); }
#if (REPMASK >> 22) & 1
    if (IN(22)) { xcd_barrier(bar);  moe_prefix(ctl + CW_CNT + 64, pst);
        pg8::MoeOrder S{(int)gridDim.x, (int)blockIdx.x, 4, pst[NEXP] / 256, pst, nullptr, (const char*)(ws + WM_DN), (size_t)DM * FF * 2, (size_t)256 * FF * 2}; pg8::EpiDown E{(bf16_t*)(ws + WS_Y), row_tok, row_slot, row_gate};
        pg8::gemm_phase(ldsb, (const char*)(ws + WS_H), FF * 2, FF, S, E);  }
#endif
    if (IN(22)) { SEAM(22); }
    if (IN(23)) { ph_final(XR, (const bf16_t*)(ws + WS_Y), a.in[3], a.out); }
#undef IN
#undef SEAM
}

extern "C" void kernel_launch(void* const* d_in, const int* in_sizes, int n_in, void* d_out, int out_size, void* d_ws, size_t ws_size, hipStream_t stream) {
    static int grid = 0;
    if (grid == 0) {
        if (n_in != 35 || out_size != NTOK * DM || ws_size < WS_END) { fprintf(stderr, "kernel_launch: unexpected shapes (n_in %d out %d ws %zu)\n", n_in, out_size, ws_size); grid = -1; return; }
        int dev = 0, cus = 0;
        if (hipGetDevice(&dev) != hipSuccess || hipDeviceGetAttribute(&cus, hipDeviceAttributeMultiprocessorCount, dev) != hipSuccess) { grid = -1; return; }
        if (hipFuncSetAttribute((const void*)fwd, hipFuncAttributeMaxDynamicSharedMemorySize, LDS_BYTES) != hipSuccess) { fprintf(stderr, "kernel_launch: hipFuncSetAttribute failed\n"); grid = -1; return; }
        int per_cu = 0;
        (void)hipOccupancyMaxActiveBlocksPerMultiprocessor(&per_cu, (const void*)fwd, NTHREADS, LDS_BYTES);
        (void)hipGetLastError();
        grid = cus;
        if (grid < 64) { fprintf(stderr, "kernel_launch: needs >= 64 CUs\n"); grid = -1; return; }
    }
    if (grid < 0) return;
    (void)hipMemsetAsync((char*)d_ws + WS_CTL, 0, CTL_ZERO_BYTES, stream);
    Args a{};
    for (int i = 0; i < 35; ++i) a.in[i] = (const float*)d_in[i];
    a.out = (float*)d_out; a.ws = (unsigned char*)d_ws;
#if 0
    for (int p = 0; p < NPHASE; ++p) { a.ph_lo = p; a.ph_hi = p + 1; hipLaunchKernelGGL(fwd, dim3(grid), dim3(NTHREADS), LDS_BYTES, stream, a); }
#else
    a.ph_lo = 0; a.ph_hi = NPHASE; hipLaunchKernelGGL(fwd, dim3(grid), dim3(NTHREADS), LDS_BYTES, stream, a);
#endif
}
```

```cpp
#include <hip/hip_runtime.h>
#include <cstdio>
#include <cstdint>

typedef unsigned short bf16_t;
#define LAS __attribute__((address_space(3)))
typedef float f32x4 __attribute__((ext_vector_type(4)));
typedef short bf16x8_t __attribute__((ext_vector_type(8)));
typedef unsigned u32x4_t __attribute__((ext_vector_type(4)));
typedef unsigned u32x2_t __attribute__((ext_vector_type(2)));

constexpr int NTOK = 32768, SEQ = 8192, NBATCH = 4, DM = 1024;
constexpr int ABC = 2816, RWC = 1792;
constexpr int NEXP = 32, FF = 512;
constexpr int NASG = NTOK * 2;
constexpr int MOE_TM = 256;
constexpr int MAXROWS = NASG + NEXP * MOE_TM;
constexpr int NTHREADS = 512;
constexpr int LDS_BYTES = 156 * 1024;
constexpr int LDS_MISC = 155 * 1024;

constexpr size_t MiB = 1024ull * 1024ull;
constexpr size_t WS_CTL = 0;
constexpr size_t CTL_ZERO_BYTES = 64 * 1024;
constexpr size_t WS_ROUTE = 64 * 1024;
constexpr size_t WS_WD = 8 * MiB;
constexpr size_t WD_ABIN = WS_WD, WD_ABOUT = WD_ABIN + (size_t)ABC * DM * 2, WD_CIN = WD_ABOUT + (size_t)DM * DM * 2, WD_COUT = WD_CIN + (size_t)4096 * DM * 2;
constexpr size_t WS_AR = 26 * MiB;
constexpr size_t WS_A = WS_AR;
constexpr size_t WS_B = WS_AR + 64 * MiB;
constexpr size_t WS_C = WS_B + 176 * MiB;
constexpr size_t WS_D = WS_C + 212 * MiB;
constexpr size_t DO_LRU = 112 * MiB;
constexpr size_t WS_XR = WS_AR + 360 * MiB;
constexpr size_t WS_WM = WS_AR + 64 * MiB;
constexpr size_t WM_GU1 = WS_A + 32 * MiB;
constexpr size_t WM_GU = WS_WM, WM_DN = WS_WM + (size_t)NEXP * DM * DM;
constexpr size_t WS_H = WS_WM + 96 * MiB;
constexpr size_t WS_Y = WS_H + 72 * MiB;
constexpr size_t WS_QFIG = WS_AR + 64 * MiB;
constexpr size_t WS_O = WS_QFIG + 256 * MiB;
constexpr size_t WS_MIX1 = WS_O + 128 * MiB;
constexpr size_t WS_END = WS_AR + 516 * MiB;
static_assert(WS_D + 64 * MiB <= WS_END && WS_Y + 128 * MiB <= WS_END && WS_MIX1 + 64 * MiB <= WS_END, "arena");

constexpr size_t DO_VB = 0, DO_BON = 32 * MiB, DO_SG = 34 * MiB, DO_YR = 48 * MiB;

constexpr int CW_CNT = 8192;
constexpr int CW_WMAX = CW_CNT + 512;
constexpr int CW_COLMAX = CW_WMAX + 192;
constexpr float ACT_Q = 127.f / 6.f;
constexpr size_t RT_ASG_E = 0;
constexpr size_t RT_ASG_RANK = RT_ASG_E + NASG * 4;
constexpr size_t RT_ASG_GATE = RT_ASG_RANK + NASG * 4;
constexpr size_t RT_ROW_TOK = RT_ASG_GATE + NASG * 4;
constexpr size_t RT_ROW_SLOT = RT_ROW_TOK + MAXROWS * 4;
constexpr size_t RT_ROW_GATE = RT_ROW_SLOT + MAXROWS * 4;
constexpr size_t RT_LRU_CH = RT_ROW_GATE + MAXROWS * 4;
constexpr size_t RT_LRU_CA = RT_LRU_CH + 512 * 512 * 4;
constexpr size_t RT_LRU_CIN = RT_LRU_CA + 512 * 512 * 4;
constexpr size_t RT_END = RT_LRU_CIN + 512 * 512 * 4;
constexpr size_t WS_FRAG = 6 * MiB;
constexpr size_t FG_RT = WS_FRAG + 393216;
constexpr size_t FG_W2 = WS_FRAG, FG_A2 = FG_W2 + 65536, FG_WA = FG_A2 + 65536, FG_WX = FG_WA + 65536, FG_G2 = FG_WX + 65536;
static_assert(WS_ROUTE + RT_END <= 6 * MiB, "routing arrays overflow");

__device__ __forceinline__ float bf2f(bf16_t v) { return __uint_as_float(((unsigned)v) << 16); }
typedef __bf16 bf16x2_hw __attribute__((ext_vector_type(2)));
typedef float f32x2_hw __attribute__((ext_vector_type(2)));
__device__ __forceinline__ unsigned pk2(float lo, float hi) { const f32x2_hw v = {lo, hi}; const bf16x2_hw b = __builtin_convertvector(v, bf16x2_hw); return __builtin_bit_cast(unsigned, b); }
__device__ __forceinline__ bf16_t f2bf(float f) { const __bf16 b = (__bf16)f; return __builtin_bit_cast(bf16_t, b); }
template <int CTRL> __device__ __forceinline__ float dpp_(float x) { return __builtin_bit_cast(float, __builtin_amdgcn_mov_dpp(__builtin_bit_cast(int, x), CTRL, 0xf, 0xf, true)); }
__device__ __forceinline__ float row16_sum(float v) {
    v += dpp_<0xB1>(v); v += dpp_<0x4E>(v); v += dpp_<0x124>(v); v += dpp_<0x128>(v); return v; }
__device__ __forceinline__ float xrow16_sum(float x) {
    auto s = __builtin_amdgcn_permlane16_swap(__float_as_uint(x), __float_as_uint(x), false, false);
    x = __uint_as_float(s[0]) + __uint_as_float(s[1]);
    auto t = __builtin_amdgcn_permlane32_swap(__float_as_uint(x), __float_as_uint(x), false, false);
    return __uint_as_float(t[0]) + __uint_as_float(t[1]); }
__device__ __forceinline__ float xrow32_sum(float x) {
    auto s = __builtin_amdgcn_permlane16_swap(__float_as_uint(x), __float_as_uint(x), false, false);
    return __uint_as_float(s[0]) + __uint_as_float(s[1]); }
__device__ __forceinline__ float wave_sum(float v) { return xrow16_sum(row16_sum(v)); }
__device__ __forceinline__ float sigmoidf_(float x) { return 1.f / (1.f + __expf(-x)); }
__device__ __forceinline__ float softplusf_(float x) { return fmaxf(x, 0.f) + log1pf(__expf(-fabsf(x))); }
__device__ __forceinline__ float siluf_(float x) { return x * sigmoidf_(x); }
__device__ __forceinline__ float gelu_tanhf_(float x) { const float c = 0.7978845608028654f; return 0.5f * x * (1.f + tanhf(c * (x + 0.044715f * x * x * x))); }

struct Args {
    const float* in[35];
    float* out;
    unsigned char* ws;
    int ph_lo, ph_hi;
};

#define XB_TMO      128
#define XB_XCNT(j)  (256  + 64 * (j))
#define XB_XSUB(j)  (1280 + 64 * (j))
#define XB_XGEN(j)  (2304 + 64 * (j))
#define XB_TOP      3328
#define XB_TOPGEN   3392
#define XCD_BAR_WORDS 3456
#define XB_SPIN_CAP (1u << 18)
__device__ __forceinline__ unsigned xb_ld(unsigned* p)              { return __hip_atomic_load(p, __ATOMIC_RELAXED, __HIP_MEMORY_SCOPE_AGENT); }
__device__ __forceinline__ unsigned xb_add(unsigned* p, unsigned v) { return __hip_atomic_fetch_add(p, v, __ATOMIC_RELAXED, __HIP_MEMORY_SCOPE_AGENT); }
__device__ __forceinline__ unsigned xb_xcc_id() { return (unsigned)__builtin_amdgcn_s_getreg((3 << 11) | 20) & 0xFu; }
#define XB_SPIN(cond, bar) do { unsigned _sp = 0; while (cond) { __builtin_amdgcn_s_sleep(1); \
    if ((++_sp & 255u) == 0u) { if (xb_ld(&(bar)[XB_TMO])) break; if (_sp > XB_SPIN_CAP) { atomicAdd(&(bar)[XB_TMO], 1u); break; } } } } while (0)
struct XcdBarrier { unsigned* bar; unsigned x; volatile LAS unsigned* st; };
__device__ __forceinline__ XcdBarrier xcd_barrier_post(unsigned* bar, volatile LAS unsigned* st) {
    XcdBarrier b; b.bar = bar; b.x = xb_xcc_id(); b.st = st;
    if (threadIdx.x == 0) (void)xb_add(&bar[XB_XCNT(b.x)], 1u);
    return b;
}
__device__ __forceinline__ void xcd_barrier_complete(unsigned* bar, unsigned x, unsigned& nloc, unsigned& nx) {
    const unsigned G = gridDim.x * gridDim.y * gridDim.z;
    unsigned sum, cnt, mine, sp = 0u;
    for (;;) {
        sum = 0u; cnt = 0u; mine = 0u;
#pragma unroll
        for (unsigned j = 0; j < 16; ++j) { const unsigned c = xb_ld(&bar[XB_XCNT(j)]); sum += c; cnt += (c > 0u) ? 1u : 0u; mine = (j == x) ? c : mine; }
        if (sum == G) break;
        __builtin_amdgcn_s_sleep(1);
        if ((++sp & 255u) == 0u) { if (xb_ld(&bar[XB_TMO])) break; if (sp > XB_SPIN_CAP) { atomicAdd(&bar[XB_TMO], 1u); break; } }
    }
    nloc = mine > 0u ? mine : 1u; nx = cnt > 0u ? cnt : 1u;
}
__device__ __forceinline__ void xcd_barrier(const XcdBarrier& b) {
    asm volatile("s_waitcnt vmcnt(0)" ::: "memory");
    __syncthreads();
    if (threadIdx.x == 0) {
        unsigned* bar = b.bar;
        __builtin_amdgcn_s_waitcnt(0);
        unsigned nloc = b.st[0], nx = b.st[1];
        if (nloc == 0u) { xcd_barrier_complete(bar, b.x, nloc, nx); b.st[0] = nloc; b.st[1] = nx; }
        const unsigned old = xb_add(&bar[XB_XSUB(b.x)], 1u);
        const unsigned gen = old / nloc;
        if (old + 1u == (gen + 1u) * nloc) {
            __builtin_amdgcn_fence(__ATOMIC_RELEASE, "agent");
            asm volatile("s_waitcnt vmcnt(0)" ::: "memory");
            const unsigned og = xb_add(&bar[XB_TOP], 1u);
            const unsigned tg = og / nx;
            if (og + 1u == (tg + 1u) * nx) xb_add(&bar[XB_TOPGEN], 1u);
            else XB_SPIN(xb_ld(&bar[XB_TOPGEN]) == tg, bar);
            __builtin_amdgcn_fence(__ATOMIC_ACQUIRE, "agent");
            xb_add(&bar[XB_XGEN(b.x)], 1u);
            asm volatile("s_waitcnt vmcnt(0)" ::: "memory");
        } else {
            XB_SPIN(xb_ld(&bar[XB_XGEN(b.x)]) == gen, bar);
            __builtin_amdgcn_fence(__ATOMIC_ACQUIRE, "agent");
            asm volatile("s_waitcnt vmcnt(0)" ::: "memory");
        }
    }
    __syncthreads();
}

namespace pg8 {
typedef short bf16x8 __attribute__((ext_vector_type(8)));
typedef unsigned u32x4 __attribute__((ext_vector_type(4)));
typedef int v4i_t __attribute__((ext_vector_type(4)));
constexpr int BM = 256, BK = 64, HALF = 128, HTB = HALF * BK * 2, STAGE_BYTES = 8 * HTB, NXCD = 8, WGM = 8;
__device__ __forceinline__ int lds_byte(int r, int c) { const int st = (r >> 4) * 2 + (c >> 5), rr = r & 15, cc = c & 31, ob = rr * 64 + cc * 2; return st * 1024 + (ob ^ (((ob >> 9) & 1) << 5)); }
__device__ __forceinline__ void stage_rc(int b, int& R, int& C) { const int st = b / 1024, sb = b % 1024, swz = sb ^ (((sb >> 9) & 1) << 5); R = (st >> 1) * 16 + swz / 64; C = (st & 1) * 32 + (swz % 64) / 2; }
__device__ __forceinline__ int perm32(int rho) { const int n = rho >> 4, i = rho & 15; return 8 * (i >> 2) + 4 * n + (i & 3); }
__device__ __forceinline__ unsigned cvt_pk_bf16(float lo, float hi) { unsigned r; asm volatile("v_cvt_pk_bf16_f32 %0, %1, %2" : "=v"(r) : "v"(lo), "v"(hi)); return r; }

struct Unit { int pm, pn; const char* B; };

struct DenseOrder {
    int nM, nN, nwg, G, c; const char* Bt; size_t bstep;
    __device__ void init(int M, int N, int K, int G_, int c_, const void* Bt_) { nM = M / BM; nN = N / BM; nwg = nM * nN; G = G_; c = c_; Bt = (const char*)Bt_; bstep = (size_t)BM * K * 2; }
    __device__ bool next(int i, Unit& u) const {
        const long L = (long)i * G + c; if (L >= nwg) return false;
        int wgid = (int)L; { const int q = nwg / NXCD, r = nwg % NXCD, xcd = wgid % NXCD, off = wgid / NXCD; wgid = (xcd < r ? xcd * (q + 1) : r * (q + 1) + (xcd - r) * q) + off; }
        const int nig = WGM * nN, gid = wgid / nig, fm = gid * WGM, gsz = (nM - fm) < WGM ? (nM - fm) : WGM;
        u.pm = fm + ((wgid % nig) % gsz); u.pn = (wgid % nig) / gsz; u.B = Bt + (size_t)u.pn * bstep; return true;
    }
    __device__ __forceinline__ int arow(const Unit& u, int r) const { return u.pm * BM + r; }
};
struct MoeOrder {
    int G, c, nN, ntiles; const LAS int* pst; const int* rowidx; const char* Bt; size_t estep, bstep;
    __device__ bool next(int i, Unit& u) const {
        const int cc = (G % NXCD == 0) ? (c % NXCD) * (G / NXCD) + c / NXCD : c;
        const int L = i * G + cc; if (L >= ntiles * nN) return false;
        u.pm = L / nN; u.pn = L % nN; const int row0 = u.pm * BM; int e = 0;
#pragma unroll
        for (int st = NEXP / 2; st > 0; st >>= 1) if (row0 >= pst[e + st]) e += st;
        u.B = Bt + (size_t)e * estep + (size_t)u.pn * bstep; return true;
    }
    __device__ __forceinline__ int arow(const Unit& u, int r) const { if (!rowidx) return u.pm * BM + r; const int t = rowidx[u.pm * BM + r]; return t < 0 ? 0 : t; }
};

struct EpiBf16I { static constexpr bool PERM = true; bf16_t* O; int ldc; const float* rowscale; const unsigned* colmax;
    __device__ __forceinline__ void operator()(const f32x4 (&acc)[2][2][4][2], const Unit& u, int wr, int wc, int fr, int fq) const {
        const int row0 = u.pm * BM + wr * 64 + fr, col0 = u.pn * BM + wc * 32 + 8 * fq;
        float rsc[8]; f32x4 cs[2][2];
#pragma unroll
        for (int q = 0; q < 8; ++q) rsc[q] = rowscale[row0 + (q >> 2) * HALF + (q & 3) * 16] * (1.f / 127.f);
#pragma unroll
        for (int bj = 0; bj < 2; ++bj)
#pragma unroll
            for (int n = 0; n < 2; ++n) { const u32x4 c4 = *(const u32x4*)(colmax + col0 + bj * HALF + 4 * n); cs[bj][n] = (f32x4){__uint_as_float(c4.x), __uint_as_float(c4.y), __uint_as_float(c4.z), __uint_as_float(c4.w)} * (1.f / 127.f); }
#pragma unroll
        for (int ai = 0; ai < 2; ++ai)
#pragma unroll
            for (int m = 0; m < 4; ++m) { bf16_t* rowp = O + (size_t)(row0 + ai * HALF + m * 16) * ldc + col0; const float rs = rsc[ai * 4 + m];
#pragma unroll
                for (int bj = 0; bj < 2; ++bj) { const v4i_t i0 = __builtin_bit_cast(v4i_t, acc[ai][bj][m][0]), i1 = __builtin_bit_cast(v4i_t, acc[ai][bj][m][1]);
                    const f32x4 s0 = cs[bj][0] * rs, s1 = cs[bj][1] * rs;
                    u32x4 w; w.x = cvt_pk_bf16((float)i0[0] * s0[0], (float)i0[1] * s0[1]); w.y = cvt_pk_bf16((float)i0[2] * s0[2], (float)i0[3] * s0[3]);
                    w.z = cvt_pk_bf16((float)i1[0] * s1[0], (float)i1[1] * s1[1]); w.w = cvt_pk_bf16((float)i1[2] * s1[2], (float)i1[3] * s1[3]);
                    *(u32x4*)(rowp + bj * HALF) = w; } }
    } };
struct EpiBf16IT { static constexpr bool PERM = true; bf16_t* O; int nf; const float* tokscale; const unsigned* chmax;
    __device__ __forceinline__ void operator()(const f32x4 (&acc)[2][2][4][2], const Unit& u, int wr, int wc, int fr, int fq) const {
        const int row0 = u.pm * BM + wr * 64 + fr, col0 = u.pn * BM + wc * 32 + 8 * fq;
        float rsc[8]; f32x4 cs[2][2];
#pragma unroll
        for (int q = 0; q < 8; ++q) rsc[q] = __uint_as_float(chmax[row0 + (q >> 2) * HALF + (q & 3) * 16]) * (1.f / 127.f);
#pragma unroll
        for (int bj = 0; bj < 2; ++bj)
#pragma unroll
            for (int n = 0; n < 2; ++n) cs[bj][n] = *(const f32x4*)(tokscale + col0 + bj * HALF + 4 * n) * (1.f / 127.f);
#pragma unroll
        for (int ai = 0; ai < 2; ++ai)
#pragma unroll
            for (int m = 0; m < 4; ++m) { const int nidx = row0 + ai * HALF + m * 16; const float rs = rsc[ai * 4 + m];
#pragma unroll
                for (int bj = 0; bj < 2; ++bj) { const v4i_t i0 = __builtin_bit_cast(v4i_t, acc[ai][bj][m][0]), i1 = __builtin_bit_cast(v4i_t, acc[ai][bj][m][1]);
                    const f32x4 s0 = cs[bj][0] * rs, s1 = cs[bj][1] * rs; const int tok0 = col0 + bj * HALF;
                    u32x4 w; w.x = cvt_pk_bf16((float)i0[0] * s0[0], (float)i0[1] * s0[1]); w.y = cvt_pk_bf16((float)i0[2] * s0[2], (float)i0[3] * s0[3]);
                    w.z = cvt_pk_bf16((float)i1[0] * s1[0], (float)i1[1] * s1[1]); w.w = cvt_pk_bf16((float)i1[2] * s1[2], (float)i1[3] * s1[3]);
                    *(u32x4*)(O + ((size_t)(tok0 >> 4) * nf + nidx) * 16 + (tok0 & 8)) = w; } }
    } };
struct EpiBf16 { static constexpr bool PERM = true; bf16_t* O; int ldc;
    __device__ __forceinline__ void operator()(const f32x4 (&acc)[2][2][4][2], const Unit& u, int wr, int wc, int fr, int fq) const {
        const int row0 = u.pm * BM + wr * 64 + fr, col0 = u.pn * BM + wc * 32 + 8 * fq;
#pragma unroll
        for (int ai = 0; ai < 2; ++ai)
#pragma unroll
            for (int m = 0; m < 4; ++m) { bf16_t* rowp = O + (size_t)(row0 + ai * HALF + m * 16) * ldc + col0;
#pragma unroll
                for (int bj = 0; bj < 2; ++bj) { const f32x4 v0 = acc[ai][bj][m][0], v1 = acc[ai][bj][m][1];
                    u32x4 w; w.x = cvt_pk_bf16(v0[0], v0[1]); w.y = cvt_pk_bf16(v0[2], v0[3]); w.z = cvt_pk_bf16(v1[0], v1[1]); w.w = cvt_pk_bf16(v1[2], v1[3]);
                    *(u32x4*)(rowp + bj * HALF) = w; } }
    } };
template <bool XF32> struct EpiResid { static constexpr bool PERM = true; const void* __restrict__ X; bf16_t* __restrict__ O;
    __device__ __forceinline__ void operator()(const f32x4 (&acc)[2][2][4][2], const Unit& u, int wr, int wc, int fr, int fq) const {
        const int row0 = u.pm * BM + wr * 64 + fr, col0 = u.pn * BM + wc * 32 + 8 * fq;
        if constexpr (XF32) {
#pragma unroll
            for (int ai = 0; ai < 2; ++ai)
#pragma unroll
                for (int mp = 0; mp < 2; ++mp) { f32x4 x[2][2][2];
#pragma unroll
                    for (int mm = 0; mm < 2; ++mm)
#pragma unroll
                        for (int bj = 0; bj < 2; ++bj) { const float* xp = (const float*)X + (size_t)(row0 + ai * HALF + (mp * 2 + mm) * 16) * DM + col0 + bj * HALF; x[mm][bj][0] = *(const f32x4*)xp; x[mm][bj][1] = *(const f32x4*)(xp + 4); }
#pragma unroll
                    for (int mm = 0; mm < 2; ++mm)
#pragma unroll
                        for (int bj = 0; bj < 2; ++bj) { const f32x4 v0 = x[mm][bj][0] + acc[ai][bj][mp * 2 + mm][0], v1 = x[mm][bj][1] + acc[ai][bj][mp * 2 + mm][1];
                            u32x4 w; w.x = cvt_pk_bf16(v0[0], v0[1]); w.y = cvt_pk_bf16(v0[2], v0[3]); w.z = cvt_pk_bf16(v1[0], v1[1]); w.w = cvt_pk_bf16(v1[2], v1[3]);
                            *(u32x4*)(O + (size_t)(row0 + ai * HALF + (mp * 2 + mm) * 16) * DM + col0 + bj * HALF) = w; } }
        } else {
#pragma unroll
            for (int ai = 0; ai < 2; ++ai) { u32x4 x[4][2];
#pragma unroll
                for (int m = 0; m < 4; ++m)
#pragma unroll
                    for (int bj = 0; bj < 2; ++bj) x[m][bj] = *(const u32x4*)((const bf16_t*)X + (size_t)(row0 + ai * HALF + m * 16) * DM + col0 + bj * HALF);
#pragma unroll
                for (int m = 0; m < 4; ++m)
#pragma unroll
                    for (int bj = 0; bj < 2; ++bj) { const u32x4 o = x[m][bj];
                        const f32x4 v0 = (f32x4){__uint_as_float(o.x << 16), __uint_as_float(o.x & 0xffff0000u), __uint_as_float(o.y << 16), __uint_as_float(o.y & 0xffff0000u)} + acc[ai][bj][m][0];
                        const f32x4 v1 = (f32x4){__uint_as_float(o.z << 16), __uint_as_float(o.z & 0xffff0000u), __uint_as_float(o.w << 16), __uint_as_float(o.w & 0xffff0000u)} + acc[ai][bj][m][1];
                        u32x4 w; w.x = cvt_pk_bf16(v0[0], v0[1]); w.y = cvt_pk_bf16(v0[2], v0[3]); w.z = cvt_pk_bf16(v1[0], v1[1]); w.w = cvt_pk_bf16(v1[2], v1[3]);
                        *(u32x4*)(O + (size_t)(row0 + ai * HALF + m * 16) * DM + col0 + bj * HALF) = w; } }
        }
    } };
struct EpiSwiGLU { static constexpr bool PERM = true; bf16_t* H; const float* tscale;
    __device__ __forceinline__ void operator()(const f32x4 (&acc)[2][2][4][2], const Unit& u, int wr, int wc, int fr, int fq) const {
        const int row0 = u.pm * BM + wr * 64 + fr, col0 = u.pn * HALF + wc * 32 + 8 * fq;
        const float s0 = tscale[2 * u.pm], s1 = tscale[2 * u.pm + 1];
#pragma unroll
        for (int ai = 0; ai < 2; ++ai)
#pragma unroll
            for (int m = 0; m < 4; ++m) { float h[8];
#pragma unroll
                for (int n = 0; n < 2; ++n) { const v4i_t gi = __builtin_bit_cast(v4i_t, acc[ai][0][m][n]), ui = __builtin_bit_cast(v4i_t, acc[ai][1][m][n]);
#pragma unroll
                    for (int j = 0; j < 4; ++j) { const float g = (float)gi[j] * s0; h[n * 4 + j] = g * __builtin_amdgcn_rcpf(1.f + __expf(-g)) * ((float)ui[j] * s1); } }
                u32x4 w; w.x = cvt_pk_bf16(h[0], h[1]); w.y = cvt_pk_bf16(h[2], h[3]); w.z = cvt_pk_bf16(h[4], h[5]); w.w = cvt_pk_bf16(h[6], h[7]);
                *(u32x4*)(H + (size_t)(row0 + ai * HALF + m * 16) * FF + col0) = w; }
    } };
struct EpiDown { static constexpr bool PERM = true; bf16_t* Y; const int* row_tok; const int* row_slot; const float* row_gate;
    __device__ __forceinline__ void operator()(const f32x4 (&acc)[2][2][4][2], const Unit& u, int wr, int wc, int fr, int fq) const {
        const int row0 = u.pm * BM + wr * 64 + fr, col0 = u.pn * BM + wc * 32 + 8 * fq;
        int tk[8], sl[8]; float gt[8];
#pragma unroll
        for (int q = 0; q < 8; ++q) { const int r = row0 + (q >> 2) * HALF + (q & 3) * 16; tk[q] = row_tok[r]; sl[q] = row_slot[r]; gt[q] = row_gate[r]; }
#pragma unroll
        for (int ai = 0; ai < 2; ++ai)
#pragma unroll
            for (int m = 0; m < 4; ++m) { const int q = ai * 4 + m;
                if (tk[q] < 0) continue;
                bf16_t* rowp = Y + (size_t)sl[q] * DM + col0;
#pragma unroll
                for (int bj = 0; bj < 2; ++bj) { const f32x4 v0 = acc[ai][bj][m][0] * gt[q], v1 = acc[ai][bj][m][1] * gt[q];
                    u32x4 w; w.x = cvt_pk_bf16(v0[0], v0[1]); w.y = cvt_pk_bf16(v0[2], v0[3]); w.z = cvt_pk_bf16(v1[0], v1[1]); w.w = cvt_pk_bf16(v1[2], v1[3]);
                    *(u32x4*)(rowp + bj * HALF) = w; } }
    } };

template <class Epi, class Sched, bool I8 = false>
__device__ __forceinline__ void gemm_phase(LAS unsigned char* lds, const char* A, const unsigned lda_b, const int K, const Sched& S, const Epi& E) {
    const int tid = threadIdx.x, wid = __builtin_amdgcn_readfirstlane(tid >> 6), lane = tid & 63, wr = wid >> 2, wc = wid & 3, fr = lane & 15, fq = lane >> 4;
    const int nt = K / BK;
    unsigned voffB[2];
#pragma unroll
    for (int i = 0; i < 2; ++i) { int R, C; stage_rc(tid * 16 + i * 8192, R, C); const int Rb = Epi::PERM ? ((R & ~31) + perm32(R & 31)) : R; voffB[i] = (unsigned)(Rb * K + C) * 2u; }
    const size_t kstep = (size_t)(BK * 2);
    const size_t hstepB = (size_t)HALF * K * 2;
    const unsigned ldsw = (unsigned)wid * 1024u;
    const int aoff = lds_byte(wr * 64 + fr, fq * 8), boff = lds_byte(wc * 32 + fr, fq * 8);
#define PG8_SA(b, h) (((b) * 2 + (h)) * HTB)
#define PG8_SB(b, h) ((4 + (b) * 2 + (h)) * HTB)
#define PG8_STAGE(bufoff, gbase, voff) do { _Pragma("unroll") for (int _i = 0; _i < 2; ++_i) \
        __builtin_amdgcn_global_load_lds((const unsigned*)((const char*)(gbase) + (voff)[_i]), (LAS unsigned*)(lds + (bufoff) + ldsw + _i * 8192), 16, 0, 0); } while (0)
#define PG8_LDA(dst, b, h) do { _Pragma("unroll") for (int m = 0; m < 4; ++m) _Pragma("unroll") for (int k = 0; k < 2; ++k) dst[m][k] = *(const LAS bf16x8*)(lds + PG8_SA(b, h) + aoff + m * 2048 + k * 1024); } while (0)
#define PG8_LDB(dst, b, h) do { _Pragma("unroll") for (int n = 0; n < 2; ++n) _Pragma("unroll") for (int k = 0; k < 2; ++k) dst[n][k] = *(const LAS bf16x8*)(lds + PG8_SB(b, h) + boff + n * 2048 + k * 1024); } while (0)
#define PG8_MMA(ai, bj, At, Bt) do { __builtin_amdgcn_s_setprio(1); _Pragma("unroll") for (int m = 0; m < 4; ++m) _Pragma("unroll") for (int n = 0; n < 2; ++n) _Pragma("unroll") for (int k = 0; k < 2; ++k) { \
        if constexpr (I8) acc[ai][bj][m][n] = __builtin_bit_cast(f32x4, __builtin_amdgcn_mfma_i32_16x16x64_i8(__builtin_bit_cast(v4i_t, Bt[n][k]), __builtin_bit_cast(v4i_t, At[m][k]), __builtin_bit_cast(v4i_t, acc[ai][bj][m][n]), 0, 0, 0)); \
        else acc[ai][bj][m][n] = __builtin_amdgcn_mfma_f32_16x16x32_bf16(Bt[n][k], At[m][k], acc[ai][bj][m][n], 0, 0, 0); } __builtin_amdgcn_s_setprio(0); } while (0)
#define PG8_WAIT_V(n) asm volatile("s_waitcnt vmcnt(" #n ")" ::: "memory")
#define PG8_WAIT_L(n) asm volatile("s_waitcnt lgkmcnt(" #n ")" ::: "memory")
#define PG8_BAR __builtin_amdgcn_s_barrier()
#define PG8_SCHED __builtin_amdgcn_sched_barrier(0)
#define PG8_AOFF(dst, u) do { int _tz = threadIdx.x; asm volatile("" : "+v"(_tz)); _Pragma("unroll") for (int _i = 0; _i < 2; ++_i) { int _R, _C; stage_rc(_tz * 16 + _i * 8192, _R, _C); \
        _Pragma("unroll") for (int _h = 0; _h < 2; ++_h) dst[_h][_i] = (unsigned)S.arow(u, _h * HALF + _R) * lda_b + (unsigned)_C * 2u; } } while (0)
    Unit cur, nxt; int ui = 0;
    if (!S.next(0, cur)) return;
    f32x4 acc[2][2][4][2];
#pragma unroll
    for (int a = 0; a < 2; ++a)
#pragma unroll
        for (int b = 0; b < 2; ++b)
#pragma unroll
            for (int m = 0; m < 4; ++m)
#pragma unroll
                for (int n = 0; n < 2; ++n) acc[a][b][m][n] = (f32x4){0.f, 0.f, 0.f, 0.f};
    bf16x8 At[4][2], B0[2][2], B1[2][2];
    unsigned vA[2][2], vAn[2][2];
    PG8_AOFF(vA, cur);
    const char* cB = cur.B;
    PG8_STAGE(PG8_SB(0, 0), cB, voffB); PG8_STAGE(PG8_SA(0, 0), A, vA[0]); PG8_STAGE(PG8_SB(0, 1), cB + hstepB, voffB); PG8_STAGE(PG8_SA(0, 1), A, vA[1]);
    if (wr == 1) PG8_BAR;
    PG8_WAIT_V(4); PG8_BAR;
    PG8_STAGE(PG8_SB(1, 0), cB + kstep, voffB); PG8_STAGE(PG8_SA(1, 0), A + kstep, vA[0]); PG8_STAGE(PG8_SB(1, 1), cB + hstepB + kstep, voffB);
    PG8_WAIT_V(6); PG8_BAR;
    for (;;) {
        const bool has_next = S.next(ui + 1, nxt);
        if (has_next) { PG8_AOFF(vAn, nxt); } else {
#pragma unroll
            for (int h = 0; h < 2; ++h)
#pragma unroll
                for (int i = 0; i < 2; ++i) vAn[h][i] = vA[h][i]; }
        const char* nB = has_next ? nxt.B : cB;
        for (int t = 0; t < nt; t += 2) {
            const bool last = (t == nt - 2);
            const char* a1 = A + (size_t)(t + 1) * kstep;
            const char* a2 = last ? A : A + (size_t)(t + 2) * kstep; const char* b2 = last ? nB : cB + (size_t)(t + 2) * kstep;
            const char* a3 = a2 + kstep; const char* b3 = b2 + kstep;
            unsigned o2[2][2];
#pragma unroll
            for (int h = 0; h < 2; ++h)
#pragma unroll
                for (int i = 0; i < 2; ++i) o2[h][i] = last ? vAn[h][i] : vA[h][i];
            PG8_LDB(B0, 0, 0); PG8_SCHED; PG8_LDA(At, 0, 0); PG8_STAGE(PG8_SA(1, 1), a1, vA[1]);
            PG8_WAIT_L(8); PG8_BAR; PG8_WAIT_L(0); PG8_MMA(0, 0, At, B0); PG8_BAR; PG8_SCHED;
            PG8_LDB(B1, 0, 1); PG8_STAGE(PG8_SB(0, 0), b2, voffB);
            PG8_BAR; PG8_WAIT_L(0); PG8_MMA(0, 1, At, B1); PG8_BAR;
            PG8_LDA(At, 0, 1); PG8_STAGE(PG8_SA(0, 0), a2, o2[0]);
            PG8_BAR; PG8_WAIT_L(0); PG8_MMA(1, 0, At, B0); PG8_BAR; PG8_SCHED;
            PG8_STAGE(PG8_SB(0, 1), b2 + hstepB, voffB);
            PG8_WAIT_V(6); PG8_BAR; PG8_MMA(1, 1, At, B1); PG8_BAR;
            PG8_LDB(B0, 1, 0); PG8_SCHED; PG8_LDA(At, 1, 0); PG8_STAGE(PG8_SA(0, 1), a2, o2[1]);
            PG8_WAIT_L(8); PG8_BAR; PG8_WAIT_L(0); PG8_MMA(0, 0, At, B0); PG8_BAR; PG8_SCHED;
            PG8_LDB(B1, 1, 1); PG8_STAGE(PG8_SB(1, 0), b3, voffB);
            PG8_BAR; PG8_WAIT_L(0); PG8_MMA(0, 1, At, B1); PG8_BAR;
            PG8_LDA(At, 1, 1); PG8_STAGE(PG8_SA(1, 0), a3, o2[0]);
            PG8_BAR; PG8_WAIT_L(0); PG8_MMA(1, 0, At, B0); PG8_BAR; PG8_SCHED;
            PG8_STAGE(PG8_SB(1, 1), b3 + hstepB, voffB);
            PG8_WAIT_V(6); PG8_BAR; PG8_MMA(1, 1, At, B1); PG8_BAR;
        }
        E(acc, cur, wr, wc, fr, fq);
        if (!has_next) break;
#pragma unroll
        for (int a = 0; a < 2; ++a)
#pragma unroll
            for (int b = 0; b < 2; ++b)
#pragma unroll
                for (int m = 0; m < 4; ++m)
#pragma unroll
                    for (int n = 0; n < 2; ++n) acc[a][b][m][n] = (f32x4){0.f, 0.f, 0.f, 0.f};
        cur = nxt; cB = nB; ++ui;
#pragma unroll
        for (int h = 0; h < 2; ++h)
#pragma unroll
            for (int i = 0; i < 2; ++i) vA[h][i] = vAn[h][i];
    }
    PG8_WAIT_V(0);
    if (wr == 0) PG8_BAR;
    PG8_BAR;
#undef PG8_SA
#undef PG8_SB
#undef PG8_STAGE
#undef PG8_LDA
#undef PG8_LDB
#undef PG8_MMA
#undef PG8_WAIT_V
#undef PG8_WAIT_L
#undef PG8_BAR
#undef PG8_SCHED
#undef PG8_AOFF
}
}

template <int MODE>
__device__ __forceinline__ void transpose_item(const float* W, int K, int N, bf16_t* WT, LAS float* scr, int item, int lane) {
    const int nblk = N / 64, kb = item / nblk, nb = item % nblk, k0 = 64 * kb, n0 = 64 * nb;
    const int lr = lane >> 4, lc = (lane & 15) * 4;
    float4 v[16];
#pragma unroll
    for (int i = 0; i < 16; ++i) v[i] = *(const float4*)(W + (size_t)(k0 + 4 * i + lr) * N + n0 + lc);
#pragma unroll
    for (int i = 0; i < 16; ++i) { LAS float* d = scr + (4 * i + lr) * 66 + lc; *(LAS f32x2_hw*)d = (f32x2_hw){v[i].x, v[i].y}; *(LAS f32x2_hw*)(d + 2) = (f32x2_hw){v[i].z, v[i].w}; }
    asm volatile("s_waitcnt lgkmcnt(0)" ::: "memory");
    const int c = lane & 7;
#pragma unroll
    for (int j = 0; j < 8; ++j) { const int n = (lane >> 3) + 8 * j; const LAS float* sp = scr + (8 * c) * 66 + n;
        pg8::u32x4 o; o.x = pk2(sp[0 * 66], sp[1 * 66]); o.y = pk2(sp[2 * 66], sp[3 * 66]); o.z = pk2(sp[4 * 66], sp[5 * 66]); o.w = pk2(sp[6 * 66], sp[7 * 66]);
        const int nn = n0 + n; const int dr = MODE == 0 ? nn : (256 * (nn >> 7) + (nn & 127) + (MODE == 2 ? 128 : 0));
        *(pg8::u32x4*)(WT + (size_t)dr * K + k0 + 8 * c) = o; }
    asm volatile("s_waitcnt lgkmcnt(0)" ::: "memory");
}
__device__ __forceinline__ float wave_max(float v) {
    v = fmaxf(v, dpp_<0xB1>(v)); v = fmaxf(v, dpp_<0x4E>(v)); v = fmaxf(v, dpp_<0x124>(v)); v = fmaxf(v, dpp_<0x128>(v));
    auto s = __builtin_amdgcn_permlane16_swap(__float_as_uint(v), __float_as_uint(v), false, false); v = fmaxf(__uint_as_float(s[0]), __uint_as_float(s[1]));
    auto t = __builtin_amdgcn_permlane32_swap(__float_as_uint(v), __float_as_uint(v), false, false); return fmaxf(__uint_as_float(t[0]), __uint_as_float(t[1])); }
__device__ __forceinline__ unsigned q8x4(float a, float b, float c, float d, float qs) {
    const int ia = (int)rintf(fminf(fmaxf(a * qs, -127.f), 127.f)), ib = (int)rintf(fminf(fmaxf(b * qs, -127.f), 127.f)), ic = (int)rintf(fminf(fmaxf(c * qs, -127.f), 127.f)), id = (int)rintf(fminf(fmaxf(d * qs, -127.f), 127.f));
    return (unsigned)(ia & 255) | ((unsigned)(ib & 255) << 8) | ((unsigned)(ic & 255) << 16) | ((unsigned)(id & 255) << 24); }
__device__ __noinline__ void ph_wmax(const float* wg, const float* wu, unsigned* wmax, int bid, int nblk) {
    const int wave = threadIdx.x >> 6, lane = threadIdx.x & 63, gw = bid * 8 + wave, NGW = nblk * 8;
    constexpr int IT = (DM / 64) * (FF / 64);
    for (int it = gw; it < 2 * NEXP * 2 * IT; it += NGW) { const int mat = it / IT, tl = it % IT; const int le = mat >> 1, gu = mat & 1;
        const float* W = (gu ? wu : wg) + (size_t)le * DM * FF; const int k0 = 64 * (tl / (FF / 64)), n0 = 64 * (tl % (FF / 64));
        float m = 0.f;
#pragma unroll 4
        for (int i = 0; i < 16; ++i) { const float4 v = *(const float4*)(W + (size_t)(k0 + 4 * i + (lane >> 4)) * FF + n0 + (lane & 15) * 4); m = fmaxf(fmaxf(m, fmaxf(fabsf(v.x), fabsf(v.y))), fmaxf(fabsf(v.z), fabsf(v.w))); }
        m = wave_max(m);
        if (lane == 0) atomicMax(wmax + le * 2 + gu, __float_as_uint(m)); }
}
template <int MODE>
__device__ __forceinline__ void transpose_item_i8(const float* W, int K, int N, unsigned char* WT, LAS float* scr, int item, int lane, float qs) {
    const int nblk = N / 64, kb = item / nblk, nb = item % nblk, k0 = 64 * kb, n0 = 64 * nb;
    const int lr = lane >> 4, lc = (lane & 15) * 4;
    float4 v[16];
#pragma unroll
    for (int i = 0; i < 16; ++i) v[i] = *(const float4*)(W + (size_t)(k0 + 4 * i + lr) * N + n0 + lc);
#pragma unroll
    for (int i = 0; i < 16; ++i) { LAS float* d = scr + (4 * i + lr) * 66 + lc; *(LAS f32x2_hw*)d = (f32x2_hw){v[i].x, v[i].y}; *(LAS f32x2_hw*)(d + 2) = (f32x2_hw){v[i].z, v[i].w}; }
    asm volatile("s_waitcnt lgkmcnt(0)" ::: "memory");
    const int c = lane & 3;
#pragma unroll
    for (int j = 0; j < 4; ++j) { const int n = (lane >> 2) + 16 * j; const LAS float* sp = scr + (16 * c) * 66 + n;
        pg8::u32x4 o;
        o.x = q8x4(sp[0 * 66], sp[1 * 66], sp[2 * 66], sp[3 * 66], qs); o.y = q8x4(sp[4 * 66], sp[5 * 66], sp[6 * 66], sp[7 * 66], qs);
        o.z = q8x4(sp[8 * 66], sp[9 * 66], sp[10 * 66], sp[11 * 66], qs); o.w = q8x4(sp[12 * 66], sp[13 * 66], sp[14 * 66], sp[15 * 66], qs);
        const int nn = n0 + n; const int dr = MODE == 0 ? nn : (256 * (nn >> 7) + (nn & 127) + (MODE == 2 ? 128 : 0));
        *(pg8::u32x4*)(WT + (size_t)dr * K + k0 + 16 * c) = o; }
    asm volatile("s_waitcnt lgkmcnt(0)" ::: "memory");
}
__device__ __forceinline__ void transpose_item_i8c(const float* W, int K, int N, unsigned char* WT, LAS float* scr, int item, int lane, const unsigned* colmax) {
    const int nblk = N / 64, kb = item / nblk, nb = item % nblk, k0 = 64 * kb, n0 = 64 * nb;
    const int lr = lane >> 4, lc = (lane & 15) * 4;
    float4 v[16];
#pragma unroll
    for (int i = 0; i < 16; ++i) v[i] = *(const float4*)(W + (size_t)(k0 + 4 * i + lr) * N + n0 + lc);
#pragma unroll
    for (int i = 0; i < 16; ++i) { LAS float* d = scr + (4 * i + lr) * 66 + lc; *(LAS f32x2_hw*)d = (f32x2_hw){v[i].x, v[i].y}; *(LAS f32x2_hw*)(d + 2) = (f32x2_hw){v[i].z, v[i].w}; }
    asm volatile("s_waitcnt lgkmcnt(0)" ::: "memory");
    const int c = lane & 3;
#pragma unroll
    for (int j = 0; j < 4; ++j) { const int n = (lane >> 2) + 16 * j; const LAS float* sp = scr + (16 * c) * 66 + n;
        const float qs = 127.f / fmaxf(__uint_as_float(colmax[n0 + n]), 1e-30f);
        pg8::u32x4 o;
        o.x = q8x4(sp[0 * 66], sp[1 * 66], sp[2 * 66], sp[3 * 66], qs); o.y = q8x4(sp[4 * 66], sp[5 * 66], sp[6 * 66], sp[7 * 66], qs);
        o.z = q8x4(sp[8 * 66], sp[9 * 66], sp[10 * 66], sp[11 * 66], qs); o.w = q8x4(sp[12 * 66], sp[13 * 66], sp[14 * 66], sp[15 * 66], qs);
        *(pg8::u32x4*)(WT + (size_t)(n0 + n) * K + k0 + 16 * c) = o; }
    asm volatile("s_waitcnt lgkmcnt(0)" ::: "memory");
}
__device__ __forceinline__ void frag_build(const float* W, int ldw, int col0, int nks, bf16_t* dst, int lane) {
    const int q4 = lane >> 4, c16 = lane & 15;
    for (int ct = 0; ct < 4; ++ct) for (int ks = 0; ks < nks; ++ks) { float v[8];
#pragma unroll
        for (int jj = 0; jj < 8; ++jj) v[jj] = W[(size_t)(32 * ks + 8 * q4 + jj) * ldw + col0 + 16 * ct + c16];
        *(pg8::u32x4*)(dst + ((size_t)(ct * nks + ks) * 64 + lane) * 8) = (pg8::u32x4){pk2(v[0], v[1]), pk2(v[2], v[3]), pk2(v[4], v[5]), pk2(v[6], v[7])}; }
}
__device__ __forceinline__ void ph_cvt_frags(const Args& a) {
    const int wave = threadIdx.x >> 6, lane = threadIdx.x & 63, gw = blockIdx.x * 8 + wave;
    if (gw >= 40) {
        const int it = gw - 40; if (it >= 64) return;
        const int L = it >> 5, ks = it & 31, q4 = lane >> 4, c16 = lane & 15;
        const float* gain = a.in[2] + L * DM; const float* wg = a.in[28] + (size_t)L * DM * 4; const float* we = a.in[30] + (size_t)L * DM * 32;
        bf16_t* dh = (bf16_t*)(a.ws + FG_RT) + (size_t)L * 2 * 49152; bf16_t* dl = dh + 49152;
        for (int ct = 0; ct < 3; ++ct) { const int col = 16 * ct + c16; float hi[8], lo[8];
#pragma unroll
            for (int jj = 0; jj < 8; ++jj) { const int k = 32 * ks + 8 * q4 + jj; const float w = col < 4 ? wg[k * 4 + col] : (col < 36 ? we[k * 32 + col - 4] : 0.f); const float v = gain[k] * w;
                hi[jj] = bf2f(f2bf(v)); lo[jj] = v - hi[jj]; }
            const size_t o = ((size_t)(ks * 3 + ct) * 64 + lane) * 8;
            *(pg8::u32x4*)(dh + o) = (pg8::u32x4){pk2(hi[0], hi[1]), pk2(hi[2], hi[3]), pk2(hi[4], hi[5]), pk2(hi[6], hi[7])};
            *(pg8::u32x4*)(dl + o) = (pg8::u32x4){pk2(lo[0], lo[1]), pk2(lo[2], lo[3]), pk2(lo[4], lo[5]), pk2(lo[6], lo[7])}; }
        return; }
    const int arr = gw >> 3, h = gw & 7;
    if (arr == 0) frag_build(a.in[7], 512, 64 * h, 2, (bf16_t*)(a.ws + FG_W2) + h * 4096, lane);
    else if (arr == 1) frag_build(a.in[9], 512, 64 * h, 2, (bf16_t*)(a.ws + FG_A2) + h * 4096, lane);
    else if (arr == 2) frag_build(a.in[18] + h * 4096, 64, 0, 2, (bf16_t*)(a.ws + FG_WA) + h * 4096, lane);
    else if (arr == 3) frag_build(a.in[20] + h * 4096, 64, 0, 2, (bf16_t*)(a.ws + FG_WX) + h * 4096, lane);
    else frag_build(a.in[10], 512, 64 * h, 4, (bf16_t*)(a.ws + FG_G2) + h * 8192, lane);
}
__device__ __forceinline__ void ph_cvt_dense_a(const Args& a, LAS float* lds, unsigned* colmax, int bid, int nblk, int part) {
    const int wave = threadIdx.x >> 6, lane = threadIdx.x & 63, gw = bid * 8 + wave, NGW = nblk * 8;
    LAS float* scr = lds + wave * (64 * 66);
    constexpr int I0 = (DM / 64) * (ABC / 64), I1 = (DM / 64) * (DM / 64), I2 = (DM / 64) * (4096 / 64), I3 = I1;
    for (int it = gw; it < (part ? I1 + I3 + I2 : I0); it += NGW) { int r = part ? it : it + I1 + I3;
        if (r < I1) { transpose_item<0>(a.in[23], DM, DM, (bf16_t*)(a.ws + WD_ABOUT), scr, r, lane); continue; } r -= I1;
        if (r < I3) { transpose_item<0>(a.in[27], DM, DM, (bf16_t*)(a.ws + WD_COUT), scr, r, lane); continue; } r -= I3;
        if (part) r += I0;
        const int m = r < I0 ? 0 : 1; if (m) r -= I0; const int N = m ? 4096 : ABC; const float* W = m ? a.in[24] : a.in[4];
        const int k0 = 64 * (r / (N / 64)), n0 = 64 * (r % (N / 64)); float mx[4] = {0.f, 0.f, 0.f, 0.f};
#pragma unroll 4
        for (int i = 0; i < 16; ++i) { const float4 v = *(const float4*)(W + (size_t)(k0 + 4 * i + (lane >> 4)) * N + n0 + (lane & 15) * 4);
            mx[0] = fmaxf(mx[0], fabsf(v.x)); mx[1] = fmaxf(mx[1], fabsf(v.y)); mx[2] = fmaxf(mx[2], fabsf(v.z)); mx[3] = fmaxf(mx[3], fabsf(v.w)); }
#pragma unroll
        for (int q = 0; q < 4; ++q) { float t = mx[q];
            auto s1 = __builtin_amdgcn_permlane16_swap(__float_as_uint(t), __float_as_uint(t), false, false); t = fmaxf(__uint_as_float(s1[0]), __uint_as_float(s1[1]));
            auto s2 = __builtin_amdgcn_permlane32_swap(__float_as_uint(t), __float_as_uint(t), false, false); t = fmaxf(__uint_as_float(s2[0]), __uint_as_float(s2[1]));
            if (lane < 16) atomicMax(colmax + (m ? ABC : 0) + n0 + lane * 4 + q, __float_as_uint(t)); } }
}
__device__ __forceinline__ void ph_cvt_dense_b(const Args& a, LAS float* lds, const unsigned* colmax, int m, int bid, int nblk) {
    const int wave = threadIdx.x >> 6, lane = threadIdx.x & 63, gw = bid * 8 + wave, NGW = nblk * 8;
    LAS float* scr = lds + wave * (64 * 66);
    const int N = m ? 4096 : ABC; const int NI = (DM / 64) * (N / 64);
    for (int it = gw; it < NI; it += NGW) transpose_item_i8c(m ? a.in[24] : a.in[4], DM, N, a.ws + (m ? WD_CIN : WD_ABIN), scr, it, lane, colmax + (m ? ABC : 0));
}
__device__ __forceinline__ void ph_cvt_down1(const Args& a, LAS float* lds, int bid, int nblk, int e_lo, int e_hi) {
    const int wave = threadIdx.x >> 6, lane = threadIdx.x & 63, gw = bid * 8 + wave, NGW = nblk * 8;
    LAS float* scr = lds + wave * (64 * 66);
    constexpr int ID = (FF / 64) * (DM / 64);
    for (int it = gw; it < (e_hi - e_lo) * ID; it += NGW) { const int e = e_lo + it / ID, r = it % ID;
        transpose_item<0>(a.in[34] + ((size_t)NEXP + e) * DM * FF, FF, DM, (bf16_t*)a.out + (size_t)e * DM * FF, scr, r, lane); }
}
__device__ __forceinline__ void moe_tail_cvt(const Args& a, LAS float* lds, const LAS int* pst, int e_lo, int e_hi) {
    const int G = (int)gridDim.x, c = (int)blockIdx.x, cc = (G % pg8::NXCD == 0) ? (c % pg8::NXCD) * (G / pg8::NXCD) + c / pg8::NXCD : c;
    const int nun = (pst[NEXP] / 256) * 4, last = nun - ((nun - 1) / G) * G, nidle = G - last;
    __syncthreads();
    if (nidle >= 64) { if (cc >= last) ph_cvt_down1(a, lds, cc - last, nidle, e_lo, e_hi); }
    else ph_cvt_down1(a, lds, c, G, e_lo, e_hi);
}
__device__ __forceinline__ void ph_cvt_moe(const Args& a, int L, LAS float* lds, int bid, int nblk, int which) {
    const int wave = threadIdx.x >> 6, lane = threadIdx.x & 63, gw = bid * 8 + wave, NGW = nblk * 8;
    LAS float* scr = lds + wave * (64 * 66);
    constexpr int IG = (DM / 64) * (FF / 64), ID = (FF / 64) * (DM / 64);
    const int i0 = (which & 1) ? 0 : 2 * IG, IE = ((which & 1) ? 2 * IG : 0) + ((which & 2) ? ID : 0);
    unsigned char* gub = a.ws + (L ? WM_GU1 : WM_GU);
    for (int it = gw; it < NEXP * IE; it += NGW) { const int e = it / IE; int r = i0 + it % IE;
        unsigned char* gu = gub + (size_t)e * DM * DM; bf16_t* dn = (bf16_t*)(a.ws + WM_DN) + (size_t)e * DM * FF;
        const unsigned* wm = (const unsigned*)(a.ws + WS_CTL) + CW_WMAX + (L * NEXP + e) * 2;
        const size_t wo = ((size_t)L * NEXP + e) * DM * FF;
        if (r < IG) { transpose_item_i8<1>(a.in[32] + wo, DM, FF, gu, scr, r, lane, 127.f / fmaxf(__uint_as_float(wm[0]), 1e-30f)); continue; } r -= IG;
        if (r < IG) { transpose_item_i8<2>(a.in[33] + wo, DM, FF, gu, scr, r, lane, 127.f / fmaxf(__uint_as_float(wm[1]), 1e-30f)); continue; } r -= IG;
        transpose_item<0>(a.in[34] + wo, FF, DM, dn, scr, r, lane); }
}

__device__ __forceinline__ void load_row16(const float* row, int lane, float4 (&v)[4]) {
#pragma unroll
    for (int j = 0; j < 4; ++j) v[j] = *(const float4*)(row + lane * 4 + 256 * j);
}
__device__ __forceinline__ float row_sumsq(const float4 (&v)[4]) {
    float s = 0.f;
#pragma unroll
    for (int j = 0; j < 4; ++j) s += v[j].x * v[j].x + v[j].y * v[j].y + v[j].z * v[j].z + v[j].w * v[j].w;
    return wave_sum(s);
}
__device__ __forceinline__ void norm_row(float4 (&v)[4], const float* gain, int lane) {
    const float rs = rsqrtf(row_sumsq(v) * (1.f / DM) + 1e-6f);
#pragma unroll
    for (int j = 0; j < 4; ++j) { const float4 g = *(const float4*)(gain + lane * 4 + 256 * j);
        v[j].x *= rs * g.x; v[j].y *= rs * g.y; v[j].z *= rs * g.z; v[j].w *= rs * g.w; }
}
__device__ __forceinline__ void store_row_bf16(bf16_t* row, int lane, const float4 (&v)[4]) {
#pragma unroll
    for (int j = 0; j < 4; ++j) { uint2 o; o.x = f2bf(v[j].x) | ((unsigned)f2bf(v[j].y) << 16); o.y = f2bf(v[j].z) | ((unsigned)f2bf(v[j].w) << 16);
        *(uint2*)(row + lane * 4 + 256 * j) = o; }
}
__device__ __forceinline__ void add_row_bf16(const bf16_t* row, int lane, float4 (&v)[4]) {
#pragma unroll
    for (int j = 0; j < 4; ++j) { const uint2 o = *(const uint2*)(row + lane * 4 + 256 * j);
        v[j].x += __uint_as_float(o.x << 16); v[j].y += __uint_as_float(o.x & 0xffff0000u); v[j].z += __uint_as_float(o.y << 16); v[j].w += __uint_as_float(o.y & 0xffff0000u); }
}

__device__ __forceinline__ void ph_norm0(const float* x, const float* gain, unsigned char* HN8, float* rowscale) {
    const int lane = threadIdx.x & 63, gw = blockIdx.x * 8 + (threadIdx.x >> 6), NGW = gridDim.x * 8;
    for (int n = gw; n < NTOK; n += NGW) { float4 v[4]; load_row16(x + (size_t)n * DM, lane, v); norm_row(v, gain, lane);
        float mx = 0.f;
#pragma unroll
        for (int j = 0; j < 4; ++j) mx = fmaxf(fmaxf(mx, fmaxf(fabsf(v[j].x), fabsf(v[j].y))), fmaxf(fabsf(v[j].z), fabsf(v[j].w)));
        mx = fmaxf(wave_max(mx), 1e-30f); const float qs = 127.f / mx;
        if (lane == 0) rowscale[n] = mx;
#pragma unroll
        for (int j = 0; j < 4; ++j) *(unsigned*)(HN8 + (size_t)n * DM + lane * 4 + 256 * j) = q8x4(v[j].x, v[j].y, v[j].z, v[j].w, qs); }
}
__device__ __forceinline__ void ld8bf(const bf16_t* p, float (&v)[8]) { const u32x4_t o = *(const u32x4_t*)p;
    v[0] = __uint_as_float(o.x << 16); v[1] = __uint_as_float(o.x & 0xffff0000u); v[2] = __uint_as_float(o.y << 16); v[3] = __uint_as_float(o.y & 0xffff0000u);
    v[4] = __uint_as_float(o.z << 16); v[5] = __uint_as_float(o.z & 0xffff0000u); v[6] = __uint_as_float(o.w << 16); v[7] = __uint_as_float(o.w & 0xffff0000u); }
__device__ __forceinline__ void st8bf(bf16_t* p, const float (&v)[8]) { *(u32x4_t*)p = (u32x4_t){pk2(v[0], v[1]), pk2(v[2], v[3]), pk2(v[4], v[5]), pk2(v[6], v[7])}; }
__device__ __forceinline__ void ph_combine_norm(bf16_t* XR, const bf16_t* Y, const float* gain, unsigned char* HN8, float* rowscale) {
    const int lane = threadIdx.x & 63, gw = blockIdx.x * 8 + (threadIdx.x >> 6), NGW = gridDim.x * 8;
    for (int n = gw; n < NTOK; n += NGW) { float x[2][8], y0[2][8], y1[2][8]; float ss = 0.f;
#pragma unroll
        for (int j = 0; j < 2; ++j) { const int o = lane * 8 + 512 * j; ld8bf(XR + (size_t)n * DM + o, x[j]); ld8bf(Y + (size_t)(2 * n) * DM + o, y0[j]); ld8bf(Y + (size_t)(2 * n + 1) * DM + o, y1[j]); }
#pragma unroll
        for (int j = 0; j < 2; ++j) {
#pragma unroll
            for (int i = 0; i < 8; ++i) x[j][i] = bf2f(f2bf(x[j][i] + y0[j][i] + y1[j][i]));
            st8bf(XR + (size_t)n * DM + lane * 8 + 512 * j, x[j]);
#pragma unroll
            for (int i = 0; i < 8; ++i) ss += x[j][i] * x[j][i]; }
        const float rs = rsqrtf(wave_sum(ss) * (1.f / DM) + 1e-6f);
#pragma unroll
        for (int j = 0; j < 2; ++j) { const int o = lane * 8 + 512 * j; const float4 g0 = *(const float4*)(gain + o), g1 = *(const float4*)(gain + o + 4);
            const float gg[8] = {g0.x, g0.y, g0.z, g0.w, g1.x, g1.y, g1.z, g1.w};
#pragma unroll
            for (int i = 0; i < 8; ++i) x[j][i] *= rs * gg[i]; }
        float mx = 0.f;
#pragma unroll
        for (int j = 0; j < 2; ++j)
#pragma unroll
            for (int i = 0; i < 8; ++i) mx = fmaxf(mx, fabsf(x[j][i]));
        mx = fmaxf(wave_max(mx), 1e-30f); const float qs = 127.f / mx;
        if (lane == 0) rowscale[n] = mx;
#pragma unroll
        for (int j = 0; j < 2; ++j) { const int o = lane * 8 + 512 * j;
            *(u32x2_t*)(HN8 + (size_t)n * DM + o) = (u32x2_t){q8x4(x[j][0], x[j][1], x[j][2], x[j][3], qs), q8x4(x[j][4], x[j][5], x[j][6], x[j][7], qs)}; } }
}
__device__ __forceinline__ void ph_final(const bf16_t* XR, const bf16_t* Y, const float* gain, float* out) {
    const int lane = threadIdx.x & 63, gw = blockIdx.x * 8 + (threadIdx.x >> 6), NGW = gridDim.x * 8;
    for (int n = gw; n < NTOK; n += NGW) { float x[2][8], y0[2][8], y1[2][8]; float ss = 0.f;
#pragma unroll
        for (int j = 0; j < 2; ++j) { const int o = lane * 8 + 512 * j; ld8bf(XR + (size_t)n * DM + o, x[j]); ld8bf(Y + (size_t)(2 * n) * DM + o, y0[j]); ld8bf(Y + (size_t)(2 * n + 1) * DM + o, y1[j]); }
#pragma unroll
        for (int j = 0; j < 2; ++j)
#pragma unroll
            for (int i = 0; i < 8; ++i) { x[j][i] = x[j][i] + y0[j][i] + y1[j][i]; ss += x[j][i] * x[j][i]; }
        const float rs = rsqrtf(wave_sum(ss) * (1.f / DM) + 1e-6f);
#pragma unroll
        for (int j = 0; j < 2; ++j) { const int o = lane * 8 + 512 * j; const float4 g0 = *(const float4*)(gain + o), g1 = *(const float4*)(gain + o + 4);
            *(float4*)(out + (size_t)n * DM + o) = make_float4(x[j][0] * rs * g0.x, x[j][1] * rs * g0.y, x[j][2] * rs * g0.z, x[j][3] * rs * g0.w);
            *(float4*)(out + (size_t)n * DM + o + 4) = make_float4(x[j][4] * rs * g1.x, x[j][5] * rs * g1.y, x[j][6] * rs * g1.z, x[j][7] * rs * g1.w); } }
}
__device__ __forceinline__ void ph_route(const Args& a, int Lyr, const bf16_t* XR, bf16_t* HN, float* RS, unsigned* cnt, int* asg_e, int* asg_rank, float* asg_gate, LAS float* lds) {
    const float* gain = a.in[2] + Lyr * DM; const float* bg = a.in[29] + Lyr * 4; const float* be = a.in[31] + Lyr * 32;
    const bf16_t* FRh = (const bf16_t*)(a.ws + FG_RT) + (size_t)Lyr * 2 * 49152; const bf16_t* FRl = FRh + 49152;
    const int lane = threadIdx.x & 63, wave = threadIdx.x >> 6, q4 = lane >> 4, c16 = lane & 15, r4 = lane >> 4, cidx = lane & 15;
    LAS unsigned char* Lb = (LAS unsigned char*)lds;
    LAS unsigned char* W = Lb + wave * 12288;
    LAS float* SS = (LAS float*)(W + 8704); LAS float* LG = (LAS float*)(W + 8768);
    LAS unsigned* lcnt = (LAS unsigned*)(Lb + 8 * 12288); LAS unsigned* lbase = lcnt + 32;
    const int NGW = gridDim.x * 8, gw = blockIdx.x * 8 + wave;
    for (int rnd = 0; rnd * NGW < NTOK / 16; ++rnd) {
        const int tile = rnd * NGW + gw; const bool act = tile < NTOK / 16; const int n0 = tile * 16;
        if (threadIdx.x < 32) lcnt[threadIdx.x] = 0u;
        __syncthreads();
        int e0 = 0, e1 = 0, lr0 = 0, lr1 = 0; float g0 = 0.f, g1 = 0.f;
        if (act) {
            f32x4 acc[3], accs = (f32x4){0.f, 0.f, 0.f, 0.f};
#pragma unroll
            for (int ct = 0; ct < 3; ++ct) acc[ct] = accs;
#pragma unroll 1
            for (int kc = 0; kc < 8; ++kc) {
                bf16x8_t bh[4][3], bl[4][3];
#pragma unroll
                for (int ks = 0; ks < 4; ++ks)
#pragma unroll
                    for (int ct = 0; ct < 3; ++ct) { const size_t o = ((size_t)((kc * 4 + ks) * 3 + ct) * 64 + lane) * 8; bh[ks][ct] = *(const bf16x8_t*)(FRh + o); bl[ks][ct] = *(const bf16x8_t*)(FRl + o); }
                u32x4_t xv[4];
#pragma unroll
                for (int j = 0; j < 4; ++j) xv[j] = *(const u32x4_t*)(XR + (size_t)(n0 + 4 * j + r4) * DM + kc * 128 + 8 * cidx);
                __builtin_amdgcn_sched_barrier(0);
#pragma unroll
                for (int j = 0; j < 4; ++j) *(LAS u32x4_t*)(W + (4 * j + r4) * 272 + cidx * 16) = xv[j];
#pragma unroll
                for (int ks = 0; ks < 4; ++ks) { const bf16x8_t ahi = *(const LAS bf16x8_t*)(W + c16 * 272 + ks * 64 + q4 * 16);
                    accs = __builtin_amdgcn_mfma_f32_16x16x32_bf16(ahi, ahi, accs, 0, 0, 0);
#pragma unroll
                    for (int ct = 0; ct < 3; ++ct) { acc[ct] = __builtin_amdgcn_mfma_f32_16x16x32_bf16(ahi, bh[ks][ct], acc[ct], 0, 0, 0); acc[ct] = __builtin_amdgcn_mfma_f32_16x16x32_bf16(ahi, bl[ks][ct], acc[ct], 0, 0, 0); } }
            }
#pragma unroll
            for (int r = 0; r < 4; ++r) if (c16 == 4 * q4 + r) { const float rsv = rsqrtf(accs[r] * (1.f / DM) + 1e-6f); SS[c16] = rsv; RS[n0 + c16] = rsv; }
            const f32x4 s4 = *(const LAS f32x4*)(SS + 4 * q4);
#pragma unroll
            for (int ct = 0; ct < 3; ++ct) { const int col = 16 * ct + c16; const float bias = col < 4 ? bg[col] : (col < 36 ? be[col - 4] : 0.f);
#pragma unroll
                for (int r = 0; r < 4; ++r) LG[(4 * q4 + r) * 48 + col] = acc[ct][r] * s4[r] + bias; }
            if (lane < 16) {
                const LAS float* lg = LG + lane * 48;
                int gs = 0; float gm = lg[0];
#pragma unroll
                for (int i = 1; i < 4; ++i) { const float v = lg[i]; if (v > gm) { gm = v; gs = i; } }
                float gden = 0.f;
#pragma unroll
                for (int i = 0; i < 4; ++i) gden += __expf(lg[i] - gm);
                const float ggate = 1.f / gden;
                const LAS float* l8 = lg + 4 + gs * 8;
                int i0 = 0; float m0 = l8[0];
#pragma unroll
                for (int i = 1; i < 8; ++i) { const float v = l8[i]; if (v > m0) { m0 = v; i0 = i; } }
                int i1 = (i0 == 0) ? 1 : 0; float m1 = l8[i1];
#pragma unroll
                for (int i = 0; i < 8; ++i) { const float v = l8[i]; if (i != i0 && v > m1) { m1 = v; i1 = i; } }
                const float ex = __expf(m1 - m0);
                g0 = ggate / (1.f + ex); g1 = ggate * ex / (1.f + ex);
                e0 = gs * 8 + i0; e1 = gs * 8 + i1;
                lr0 = (int)__hip_atomic_fetch_add(lcnt + e0, 1u, __ATOMIC_RELAXED, __HIP_MEMORY_SCOPE_WORKGROUP); lr1 = (int)__hip_atomic_fetch_add(lcnt + e1, 1u, __ATOMIC_RELAXED, __HIP_MEMORY_SCOPE_WORKGROUP);
            }
        }
        __syncthreads();
        if (threadIdx.x < 32) { const unsigned c = lcnt[threadIdx.x]; lbase[threadIdx.x] = c ? atomicAdd(&cnt[threadIdx.x], c) : 0u; }
        __syncthreads();
        if (act) {
            if (lane < 16) { const int n = n0 + lane;
                asg_e[2 * n] = e0; asg_e[2 * n + 1] = e1; asg_rank[2 * n] = (int)lbase[e0] + lr0; asg_rank[2 * n + 1] = (int)lbase[e1] + lr1; asg_gate[2 * n] = g0; asg_gate[2 * n + 1] = g1; }
            unsigned char* H8 = (unsigned char*)HN;
            float rsr[4];
#pragma unroll
            for (int j = 0; j < 4; ++j) rsr[j] = SS[4 * j + r4] * ACT_Q;
#pragma unroll 2
            for (int kc = 0; kc < 8; ++kc) { const float4 gn0 = *(const float4*)(gain + kc * 128 + 8 * cidx), gn1 = *(const float4*)(gain + kc * 128 + 8 * cidx + 4);
                u32x4_t xv[4];
#pragma unroll
                for (int j = 0; j < 4; ++j) xv[j] = *(const u32x4_t*)(XR + (size_t)(n0 + 4 * j + r4) * DM + kc * 128 + 8 * cidx);
#pragma unroll
                for (int j = 0; j < 4; ++j) { const u32x4_t o = xv[j]; const float q = rsr[j];
                    *(u32x2_t*)(H8 + (size_t)(n0 + 4 * j + r4) * DM + kc * 128 + 8 * cidx) = (u32x2_t){
                        q8x4(__uint_as_float(o.x << 16) * gn0.x, __uint_as_float(o.x & 0xffff0000u) * gn0.y, __uint_as_float(o.y << 16) * gn0.z, __uint_as_float(o.y & 0xffff0000u) * gn0.w, q),
                        q8x4(__uint_as_float(o.z << 16) * gn1.x, __uint_as_float(o.z & 0xffff0000u) * gn1.y, __uint_as_float(o.w << 16) * gn1.z, __uint_as_float(o.w & 0xffff0000u) * gn1.w, q)}; } }
        }
        __syncthreads();
    }
}
__device__ __forceinline__ void moe_prefix(const unsigned* cnt, LAS int* pst) {
    if (threadIdx.x == 0) { int acc = 0; for (int e = 0; e < NEXP; ++e) { pst[e] = acc; const int c = (int)cnt[e]; acc += (c + MOE_TM - 1) / MOE_TM * MOE_TM; } pst[NEXP] = acc; }
    __syncthreads();
}
__device__ __forceinline__ void ph_dispatch(const unsigned* cnt, const int* asg_e, const int* asg_rank, const float* asg_gate, const float* RS, int* row_tok, int* row_slot, float* row_gate, float* row_rs, LAS int* pst, const unsigned* wmax, float* tscale) {
    moe_prefix(cnt, pst);
    for (int t = blockIdx.x * NTHREADS + threadIdx.x; t < pst[NEXP] / 256; t += gridDim.x * NTHREADS) { int e = 0;
        for (int k = 1; k < NEXP; ++k) if (t * 256 >= pst[k]) e = k;
        tscale[2 * t] = __uint_as_float(wmax[2 * e]) * (1.f / (127.f * ACT_Q)); tscale[2 * t + 1] = __uint_as_float(wmax[2 * e + 1]) * (1.f / (127.f * ACT_Q)); }
    for (int i = blockIdx.x * NTHREADS + threadIdx.x; i < NASG; i += gridDim.x * NTHREADS) {
        const int e = asg_e[i], d = pst[e] + asg_rank[i];
        row_tok[d] = i >> 1; row_slot[d] = i; row_gate[d] = asg_gate[i]; row_rs[d] = RS[i >> 1];
    }
    for (int e = blockIdx.x; e < NEXP; e += gridDim.x) {
        const int c = (int)cnt[e], lo = pst[e] + c, hi = pst[e + 1];
        for (int r = lo + threadIdx.x; r < hi; r += NTHREADS) { row_tok[r] = -1; row_slot[r] = 0; row_gate[r] = 0.f; row_rs[r] = 0.f; }
    }
    __syncthreads();
}
__device__ __forceinline__ int moe_tile_expert(const LAS int* pst, int row0) { int e = 0;
    for (int i = 1; i < NEXP; ++i) if (row0 >= pst[i]) e = i;
    return e; }

__device__ __forceinline__ float shiftcol(const bf16_t* P, int n, int t, int col, const float* mu) {
    const float cur = bf2f(P[(size_t)n * ABC + col]); const float prev = t > 0 ? bf2f(P[(size_t)(n - 1) * ABC + col]) : 0.f;
    return cur + (prev - cur) * mu[col];
}
constexpr int RW_WMF = 0, RW_RF = 2048, RW_BKF = 4096, RW_ARF = 8192, RW_U = 9216, RW_V = 11264, RW_G = 13312, RW_REC = 13568;
__device__ __forceinline__ float fast_sigmoid(float x) { return __builtin_amdgcn_rcpf(1.f + __expf(-x)); }
__device__ __forceinline__ float fast_softplus(float x) { return fmaxf(x, 0.f) + __logf(1.f + __expf(-fabsf(x))); }
__device__ __forceinline__ void tr_acc(LAS float* TBf, const f32x4 (&acc)[4], int lane, float (&out)[16]) {
    const int q4 = lane >> 4, c16 = lane & 15;
#pragma unroll
    for (int ct = 0; ct < 4; ++ct)
#pragma unroll
        for (int r = 0; r < 4; ++r) TBf[(16 * ct + 4 * q4 + r) * 20 + c16] = acc[ct][r];
#pragma unroll
    for (int j = 0; j < 4; ++j) { const f32x4 v = *(const LAS f32x4*)(TBf + lane * 20 + 4 * j); out[4 * j] = v[0]; out[4 * j + 1] = v[1]; out[4 * j + 2] = v[2]; out[4 * j + 3] = v[3]; }
}
__device__ __forceinline__ void ph_l0_prep(const Args& a, LAS float* lds) {
    const bf16_t* P = (const bf16_t*)(a.ws + WS_B);
    unsigned char* FR = a.ws + WS_C;
    bf16_t* Vb = (bf16_t*)a.out; float* Bon = (float*)((unsigned char*)a.out + 32 * MiB);
    bf16_t* LA = (bf16_t*)(a.ws + WS_A); bf16_t* U = LA + (size_t)NTOK * 512;
    const float* mu = a.in[5]; const float* w0 = a.in[6]; const float* a0 = a.in[8];
    const float* k_k = a.in[11]; const float* k_a = a.in[12]; const float* r_k = a.in[13];
    const float* conv_w = a.in[16]; const float* conv_b = a.in[17]; const float* b_a = a.in[19]; const float* b_x = a.in[21]; const float* lam = a.in[22];
    const int lane = threadIdx.x & 63, wave = threadIdx.x >> 6, q4 = lane >> 4, c16 = lane & 15;
    LAS unsigned char* W = (LAS unsigned char*)lds + wave * 15360;
    constexpr int KAP = 0, BT = 2304, KT = 4608, RT = 6912, BTT = 9216, KTT = 11264, AKB = 13312, AKK = 14336, RS = 144;
    constexpr int XS = 0, XS2 = 2304, TB = 4608;
    LAS float* TBf = (LAS float*)(W + TB);
    for (int u = blockIdx.x * 8 + wave; u < (NTOK / 16) * 8; u += gridDim.x * 8) {
        const int tile = u >> 3, h = u & 7, n0 = tile * 16, c = h * 64 + lane;
        const bool first = (n0 & (SEQ - 1)) == 0;
        const unsigned char* PT = (const unsigned char*)(P + (size_t)tile * ABC * 16);
        const unsigned char* PTp = PT - (size_t)ABC * 32;
        unsigned lo32 = (unsigned)lane * 32u; asm volatile("" : "+v"(lo32));
#define LD16(dst, colbase, off) do { const u32x4_t _lo = *(const u32x4_t*)(PT + (colbase) * 32 + lo32), _hi = *(const u32x4_t*)(PT + (colbase) * 32 + 16 + lo32); \
            dst[(off)] = _lo.x; dst[(off) + 1] = _lo.y; dst[(off) + 2] = _lo.z; dst[(off) + 3] = _lo.w; dst[(off) + 4] = _hi.x; dst[(off) + 5] = _hi.y; dst[(off) + 6] = _hi.z; dst[(off) + 7] = _hi.w; } while (0)
        unsigned xbp[10], pwp[9], pap[9], qrp[9], qkp[9], qvp[9];
        { u32x2_t t2 = (u32x2_t){0u, 0u}; if (!first) t2 = *(const u32x2_t*)(PTp + (2304 + h * 64) * 32 + 24 + lo32); xbp[0] = t2.x; xbp[1] = t2.y; LD16(xbp, 2304 + h * 64, 2); }
        pwp[0] = first ? 0u : *(const unsigned*)(PTp + 1536 * 32 + 28 + lo32); LD16(pwp, 1536, 1);
        pap[0] = first ? 0u : *(const unsigned*)(PTp + 1600 * 32 + 28 + lo32); LD16(pap, 1600, 1);
        asm volatile("" ::: "memory");
#define UNPK(arr, i) __uint_as_float(((i) & 1) ? ((arr)[(i) >> 1] & 0xffff0000u) : ((arr)[(i) >> 1] << 16))
        {
            bf16_t* SG = (bf16_t*)((unsigned char*)a.out + DO_SG);
            const int tk = lane >> 2, col = 1664 + 16 * h + (lane & 3) * 4;
            unsigned so = (unsigned)((lane & 3) * 128 + tk * 2); asm volatile("" : "+v"(so));
            float cu[4], pu[4];
#pragma unroll
            for (int i = 0; i < 4; ++i) { cu[i] = bf2f(*(const bf16_t*)(PT + (1664 + 16 * h + i) * 32 + so));
                pu[i] = (tk > 0) ? bf2f(*(const bf16_t*)(PT + (1664 + 16 * h + i) * 32 - 2 + so)) : (first ? 0.f : bf2f(*(const bf16_t*)(PTp + (1664 + 16 * h + i) * 32 + 30 + so))); }
            const f32x4 m4 = *(const f32x4*)(mu + col);
            *(u32x2_t*)(SG + (size_t)(tile * 8 + h) * 256 + lane * 4) = (u32x2_t){pk2(fast_sigmoid(cu[0] + (pu[0] - cu[0]) * m4[0]), fast_sigmoid(cu[1] + (pu[1] - cu[1]) * m4[1])), pk2(fast_sigmoid(cu[2] + (pu[2] - cu[2]) * m4[2]), fast_sigmoid(cu[3] + (pu[3] - cu[3]) * m4[3]))};
        }
        {
            const float cw0 = conv_w[c], cw1 = conv_w[512 + c], cw2 = conv_w[1024 + c], cw3 = conv_w[1536 + c], cb = conv_b[c];
            float xcv[16], xb[19];
#pragma unroll
            for (int i = 0; i < 19; ++i) xb[i] = UNPK(xbp, i + 1);
#pragma unroll
            for (int tk = 0; tk < 16; ++tk) { xcv[tk] = cb + cw0 * xb[tk] + cw1 * xb[tk + 1] + cw2 * xb[tk + 2] + cw3 * xb[tk + 3]; *(LAS bf16_t*)(W + XS + tk * RS + lane * 2) = f2bf(xcv[tk]); }
            f32x4 accr[4], acci[4];
            const bf16_t* FA = (const bf16_t*)(a.ws + FG_WA) + h * 4096; const bf16_t* FX = (const bf16_t*)(a.ws + FG_WX) + h * 4096;
            bf16x8_t xf[2];
#pragma unroll
            for (int ks = 0; ks < 2; ++ks) xf[ks] = *(const LAS bf16x8_t*)(W + XS + c16 * RS + ks * 64 + q4 * 16);
#pragma unroll
            for (int ct = 0; ct < 4; ++ct) { asm volatile("" ::: "memory"); accr[ct] = (f32x4){0.f, 0.f, 0.f, 0.f}; acci[ct] = accr[ct];
#pragma unroll
                for (int ks = 0; ks < 2; ++ks) { accr[ct] = __builtin_amdgcn_mfma_f32_16x16x32_bf16(*(const bf16x8_t*)(FA + ((ct * 2 + ks) * 64 + lane) * 8), xf[ks], accr[ct], 0, 0, 0);
                    acci[ct] = __builtin_amdgcn_mfma_f32_16x16x32_bf16(*(const bf16x8_t*)(FX + ((ct * 2 + ks) * 64 + lane) * 8), xf[ks], acci[ct], 0, 0, 0); } }
            float rp[16], ip[16];
            tr_acc(TBf, accr, lane, rp); tr_acc(TBf, acci, lane, ip);
            const float bac = b_a[c], bxc = b_x[c], sp = fast_softplus(-lam[c]);
            float hloc = 0.f, sla = 0.f;
            unsigned lap[4], uup[4];
#pragma unroll
            for (int tk = 0; tk < 16; ++tk) { const float r = fast_sigmoid(rp[tk] + bac), i = fast_sigmoid(ip[tk] + bxc);
                const float la = -8.f * r * sp; const float uu = __builtin_amdgcn_sqrtf(fmaxf(1.f - __expf(2.f * la), 0.f)) * i * xcv[tk];
                const bf16_t lab = f2bf(la), uub = f2bf(uu); const float lar = bf2f(lab);
                if (tk & 1) { lap[(tk >> 1) & 3] |= (unsigned)lab << 16; uup[(tk >> 1) & 3] |= (unsigned)uub << 16; } else { lap[(tk >> 1) & 3] = lab; uup[(tk >> 1) & 3] = uub; }
                if ((tk & 7) == 7) { *(u32x4_t*)(LA + ((size_t)tile * 512 + c) * 16 + (tk >> 3) * 8) = (u32x4_t){lap[0], lap[1], lap[2], lap[3]}; *(u32x4_t*)(U + ((size_t)tile * 512 + c) * 16 + (tk >> 3) * 8) = (u32x4_t){uup[0], uup[1], uup[2], uup[3]}; }
                hloc = __expf(lar) * hloc + bf2f(uub); sla += lar; }
            ((float*)((unsigned char*)a.out + DO_LRU))[(size_t)tile * 512 + c] = hloc; ((float*)((unsigned char*)a.out + DO_LRU))[(size_t)(2048 + tile) * 512 + c] = sla;
        }
        asm volatile("" ::: "memory");
        asm volatile("" : "+v"(lo32));
        qrp[0] = first ? 0u : *(const unsigned*)(PTp + (h * 64) * 32 + 28 + lo32); LD16(qrp, h * 64, 1);
        qkp[0] = first ? 0u : *(const unsigned*)(PTp + (512 + h * 64) * 32 + 28 + lo32); LD16(qkp, 512 + h * 64, 1);
        qvp[0] = first ? 0u : *(const unsigned*)(PTp + (1024 + h * 64) * 32 + 28 + lo32); LD16(qvp, 1024 + h * 64, 1);
        asm volatile("" ::: "memory");
        float wpre[16], apre[16];
        {
            const float muw = mu[1536 + lane], mua = mu[1600 + lane];
#pragma unroll
            for (int tk = 0; tk < 16; ++tk) { const float pw1 = UNPK(pwp, tk + 2), pw0 = UNPK(pwp, tk + 1), pa1 = UNPK(pap, tk + 2), pa0 = UNPK(pap, tk + 1);
                const float wl = pw1 + (pw0 - pw1) * muw, al = pa1 + (pa0 - pa1) * mua;
                const float th = 1.f - 2.f * __builtin_amdgcn_rcpf(1.f + __expf(2.f * wl));
                *(LAS bf16_t*)(W + XS + tk * RS + lane * 2) = f2bf(th); *(LAS bf16_t*)(W + XS2 + tk * RS + lane * 2) = f2bf(al); }
            f32x4 accw[4], acca[4];
            const bf16_t* F2 = (const bf16_t*)(a.ws + FG_W2) + h * 4096; const bf16_t* FA2 = (const bf16_t*)(a.ws + FG_A2) + h * 4096;
            bf16x8_t wf[2], af[2];
#pragma unroll
            for (int ks = 0; ks < 2; ++ks) { wf[ks] = *(const LAS bf16x8_t*)(W + XS + c16 * RS + ks * 64 + q4 * 16); af[ks] = *(const LAS bf16x8_t*)(W + XS2 + c16 * RS + ks * 64 + q4 * 16); }
#pragma unroll
            for (int ct = 0; ct < 4; ++ct) { asm volatile("" ::: "memory"); accw[ct] = (f32x4){0.f, 0.f, 0.f, 0.f}; acca[ct] = accw[ct];
#pragma unroll
                for (int ks = 0; ks < 2; ++ks) { accw[ct] = __builtin_amdgcn_mfma_f32_16x16x32_bf16(*(const bf16x8_t*)(F2 + ((ct * 2 + ks) * 64 + lane) * 8), wf[ks], accw[ct], 0, 0, 0);
                    acca[ct] = __builtin_amdgcn_mfma_f32_16x16x32_bf16(*(const bf16x8_t*)(FA2 + ((ct * 2 + ks) * 64 + lane) * 8), af[ks], acca[ct], 0, 0, 0); } }
            tr_acc(TBf, accw, lane, wpre); tr_acc(TBf, acca, lane, apre);
        }
        const float w0c = w0[c], a0c = a0[c], kkc = k_k[c], kac = k_a[c], rkc = r_k[c];
        const float mur = mu[c], muk = mu[512 + c], muv = mu[1024 + c];
        unsigned char* rec = FR + ((size_t)tile * 8 + h) * RW_REC;
        float vsv[16];
        unsigned btp[8], ktp[8];
        float cum = 0.f, gC = 1.f;
#pragma unroll
        for (int tk = 0; tk < 16; ++tk) { const int n = n0 + tk;
            const float cr = UNPK(qrp, tk + 2), ck = UNPK(qkp, tk + 2), cv = UNPK(qvp, tk + 2), pr = UNPK(qrp, tk + 1), pk = UNPK(qkp, tk + 1), pv = UNPK(qvp, tk + 1);
            const float rs = cr + (pr - cr) * mur, ks = ck + (pk - ck) * muk, vs = cv + (pv - cv) * muv;
            const float wv = -fast_softplus(-(w0c + wpre[tk])) - 0.5f; const float logdec = -__expf(wv);
            const float av = fast_sigmoid(a0c + apre[tk]);
            const float kkr = ks * kkc; const float ss = wave_sum(kkr * kkr); const float kkn = kkr * rsqrtf(fmaxf(ss, 1e-24f));
            const float kp = ks * (1.f + (av - 1.f) * kac);
            const float bsum = wave_sum(rs * kp * rkc);
            if (lane == 0) Bon[(size_t)n * 8 + h] = bsum;
            Vb[(size_t)n * 512 + c] = f2bf(vs); vsv[tk] = vs;
            const float gprev = __expf(cum); cum += logdec; const float g = __expf(cum), gi = __builtin_amdgcn_rcpf(g); gC = g;
            const float kapv = kkn * gprev, btv = av * kkn * gi, ktv = kp * gi, rtv = rs * g;
            const bf16_t kb = f2bf(kapv), bb = f2bf(btv), kb2 = f2bf(ktv), rb = f2bf(rtv);
            *(LAS bf16_t*)(W + KAP + tk * RS + lane * 2) = kb; *(LAS bf16_t*)(W + BT + tk * RS + lane * 2) = bb;
            *(LAS bf16_t*)(W + KT + tk * RS + lane * 2) = kb2; *(LAS bf16_t*)(W + RT + tk * RS + lane * 2) = rb;
            if (tk & 1) { btp[tk >> 1] |= (unsigned)bb << 16; ktp[tk >> 1] |= (unsigned)kb2 << 16; } else { btp[tk >> 1] = bb; ktp[tk >> 1] = kb2; } }
        *(LAS u32x4_t*)(W + BTT + lane * 32) = (u32x4_t){btp[0], btp[1], btp[2], btp[3]}; *(LAS u32x4_t*)(W + BTT + lane * 32 + 16) = (u32x4_t){btp[4], btp[5], btp[6], btp[7]};
        *(LAS u32x4_t*)(W + KTT + lane * 32) = (u32x4_t){ktp[0], ktp[1], ktp[2], ktp[3]}; *(LAS u32x4_t*)(W + KTT + lane * 32 + 16) = (u32x4_t){ktp[4], ktp[5], ktp[6], ktp[7]};
        *(float*)(rec + RW_G + lane * 4) = gC;
        f32x4 akb = (f32x4){0.f, 0.f, 0.f, 0.f}, akk = akb, arbT = akb, arkT = akb;
#pragma unroll
        for (int ks = 0; ks < 2; ++ks) { const int fo = c16 * RS + ks * 64 + q4 * 16;
            const bf16x8_t fkap = *(const LAS bf16x8_t*)(W + KAP + fo), fbt = *(const LAS bf16x8_t*)(W + BT + fo), fkt = *(const LAS bf16x8_t*)(W + KT + fo), frt = *(const LAS bf16x8_t*)(W + RT + fo);
            akb = __builtin_amdgcn_mfma_f32_16x16x32_bf16(fkap, fbt, akb, 0, 0, 0); akk = __builtin_amdgcn_mfma_f32_16x16x32_bf16(fkap, fkt, akk, 0, 0, 0);
            arbT = __builtin_amdgcn_mfma_f32_16x16x32_bf16(fbt, frt, arbT, 0, 0, 0); arkT = __builtin_amdgcn_mfma_f32_16x16x32_bf16(fkt, frt, arkT, 0, 0, 0); }
#pragma unroll
        for (int r = 0; r < 4; ++r) { const int t = 4 * q4 + r; ((LAS float*)(W + AKB))[t * 16 + c16] = (c16 < t) ? akb[r] : 0.f; ((LAS float*)(W + AKK))[t * 16 + c16] = (c16 < t) ? akk[r] : 0.f;
            const int sidx = 4 * q4 + r; if (sidx > c16) { arbT[r] = 0.f; arkT[r] = 0.f; } }
        *(u32x4_t*)(rec + RW_ARF + lane * 16) = (u32x4_t){pk2(arbT[0], arbT[1]), pk2(arbT[2], arbT[3]), pk2(arkT[0], arkT[1]), pk2(arkT[2], arkT[3])};
#pragma unroll
        for (int i = 0; i < 4; ++i) { const u32x2_t b2 = *(const LAS u32x2_t*)(W + BTT + (16 * i + c16) * 32 + q4 * 8), k2 = *(const LAS u32x2_t*)(W + KTT + (16 * i + c16) * 32 + q4 * 8);
            *(u32x4_t*)(rec + RW_BKF + i * 1024 + lane * 16) = (u32x4_t){b2.x, b2.y, k2.x, k2.y}; }
#pragma unroll
        for (int sx = 0; sx < 2; ++sx) { const u32x2_t lo = *(const LAS u32x2_t*)(W + RT + c16 * RS + (32 * sx + 4 * q4) * 2), hi = *(const LAS u32x2_t*)(W + RT + c16 * RS + (32 * sx + 16 + 4 * q4) * 2);
            *(u32x4_t*)(rec + RW_RF + sx * 1024 + lane * 16) = (u32x4_t){lo.x, lo.y, hi.x, hi.y}; }
        float Wm[16], Uu[16];
#pragma unroll
        for (int t = 0; t < 16; ++t) { float wacc = bf2f(*(const LAS bf16_t*)(W + KAP + t * RS + lane * 2)), uacc = 0.f;
#pragma unroll
            for (int s4 = 0; s4 < 4; ++s4) if (4 * s4 < t) { const f32x4 b4 = *(const LAS f32x4*)(W + AKB + (t * 16 + 4 * s4) * 4), k4 = *(const LAS f32x4*)(W + AKK + (t * 16 + 4 * s4) * 4);
#pragma unroll
                for (int e = 0; e < 4; ++e) { const int sidx = 4 * s4 + e; if (sidx < t) { wacc -= b4[e] * Wm[sidx]; uacc += k4[e] * vsv[sidx] - b4[e] * Uu[sidx]; } } }
            Wm[t] = wacc; Uu[t] = uacc;
            *(LAS bf16_t*)(W + KAP + t * RS + lane * 2) = f2bf(wacc);
        }
        {
            const int ub = ((lane >> 4) * 64 + (lane & 15)) * 8;
#pragma unroll
            for (int q = 0; q < 4; ++q) { *(u32x2_t*)(rec + RW_U + ub + q * 128) = (u32x2_t){pk2(Uu[4 * q], Uu[4 * q + 1]), pk2(Uu[4 * q + 2], Uu[4 * q + 3])};
                *(u32x2_t*)(rec + RW_V + ub + q * 128) = (u32x2_t){pk2(vsv[4 * q], vsv[4 * q + 1]), pk2(vsv[4 * q + 2], vsv[4 * q + 3])}; }
        }
#pragma unroll
        for (int sx = 0; sx < 2; ++sx) { const u32x2_t lo = *(const LAS u32x2_t*)(W + KAP + c16 * RS + (32 * sx + 4 * q4) * 2), hi = *(const LAS u32x2_t*)(W + KAP + c16 * RS + (32 * sx + 16 + 4 * q4) * 2);
            *(u32x4_t*)(rec + RW_WMF + sx * 1024 + lane * 16) = (u32x4_t){lo.x, lo.y, hi.x, hi.y}; }
    }
}
__device__ __forceinline__ void sub_barrier(unsigned* ctr, unsigned target) {
    asm volatile("s_waitcnt vmcnt(0)" ::: "memory");
    __syncthreads();
    if (threadIdx.x == 0) {
        (void)xb_add(ctr, 1u);
        unsigned sp = 0;
        while (xb_ld(ctr) < target) { __builtin_amdgcn_s_sleep(2); if (++sp > (1u << 22)) break; }
        __builtin_amdgcn_fence(__ATOMIC_ACQUIRE, "agent");
        asm volatile("s_waitcnt vmcnt(0)" ::: "memory");
    }
    __syncthreads();
}
__device__ __forceinline__ void st_wt(float* p, float v) { __hip_atomic_store((unsigned*)p, __float_as_uint(v), __ATOMIC_RELAXED, __HIP_MEMORY_SCOPE_AGENT); }
__device__ __forceinline__ void ph_lru_b(const Args& a, int bid, LAS float* lds) {
    if (bid >= 64) return;
    const float* CH = (const float*)((unsigned char*)a.out + DO_LRU); const float* CA = CH + (size_t)2048 * 512; float* CIN = (float*)((unsigned char*)a.out + DO_LRU) + (size_t)4096 * 512;
    const int b = bid >> 4, cg = bid & 15, cl = threadIdx.x & 31, seg = threadIdx.x >> 5, c = cg * 32 + cl;
    float ca[32], chv[32];
#pragma unroll
    for (int i = 0; i < 32; ++i) { const size_t o = (size_t)(b * 512 + seg * 32 + i) * 512 + c; ca[i] = CA[o]; chv[i] = CH[o]; }
    float h = 0.f, sa = 0.f;
#pragma unroll
    for (int i = 0; i < 32; ++i) { h = __expf(ca[i]) * h + chv[i]; sa += ca[i]; }
    lds[seg * 32 + cl] = sa; lds[512 + seg * 32 + cl] = h;
    __syncthreads();
    float hin = 0.f;
    for (int sg = 0; sg < seg; ++sg) hin = __expf(lds[sg * 32 + cl]) * hin + lds[512 + sg * 32 + cl];
    h = hin;
#pragma unroll
    for (int i = 0; i < 32; ++i) { st_wt(CIN + (size_t)(b * 512 + seg * 32 + i) * 512 + c, h); h = __expf(ca[i]) * h + chv[i]; }
}
__device__ __forceinline__ void ph_lru_c(const Args& a, int bid, int nblk) {
    const bf16_t* LA = (const bf16_t*)(a.ws + WS_A); const bf16_t* U = LA + (size_t)NTOK * 512; const bf16_t* P = (const bf16_t*)(a.ws + WS_B);
    const float* CIN = (const float*)((unsigned char*)a.out + DO_LRU) + (size_t)4096 * 512; bf16_t* MIX = (bf16_t*)(a.ws + WS_D);
    const int c = threadIdx.x;
    for (int u = bid; u < NTOK / 16; u += nblk) { float la[16], uv[16], gt[16];
        float h = CIN[(size_t)u * 512 + c];
#pragma unroll
        for (int hf = 0; hf < 2; ++hf) { const u32x4_t l4 = *(const u32x4_t*)(LA + ((size_t)u * 512 + c) * 16 + hf * 8), u4 = *(const u32x4_t*)(U + ((size_t)u * 512 + c) * 16 + hf * 8), g4 = *(const u32x4_t*)(P + ((size_t)u * ABC + 1792 + c) * 16 + hf * 8);
#pragma unroll
            for (int e = 0; e < 4; ++e) { gt[hf * 8 + 2 * e] = __uint_as_float(g4[e] << 16); gt[hf * 8 + 2 * e + 1] = __uint_as_float(g4[e] & 0xffff0000u); la[hf * 8 + 2 * e] = __uint_as_float(l4[e] << 16); la[hf * 8 + 2 * e + 1] = __uint_as_float(l4[e] & 0xffff0000u); uv[hf * 8 + 2 * e] = __uint_as_float(u4[e] << 16); uv[hf * 8 + 2 * e + 1] = __uint_as_float(u4[e] & 0xffff0000u); } }
#pragma unroll
        for (int s = 0; s < 16; ++s) { const int n = u * 16 + s; h = __expf(la[s]) * h + uv[s];
            const float x = gt[s], t2 = 0.7978845608028654f * (x + 0.044715f * x * x * x); const float th = 1.f - 2.f * __builtin_amdgcn_rcpf(1.f + __expf(2.f * t2));
            MIX[(size_t)n * DM + 512 + c] = f2bf(h * 0.5f * x * (1.f + th)); } }
}
#ifndef SP_MODE
#define SP_MODE 0
#endif
#ifndef SP_VAR
#define SP_VAR 0
#endif
constexpr bool SCAN_COOP = true; constexpr int NSCAN = SCAN_COOP ? 64 : 32;
template <int VAR = 0, bool COOP = false>
__device__ __forceinline__ void ph_rwkv_scan(const Args& a, LAS unsigned char* L) {
    if (blockIdx.x >= (COOP ? 64 : 32)) return;
    constexpr int SLOT = 9472, GOFF = 9216, NS = 14, NCH = SEQ / 16; constexpr size_t CSTR = (size_t)8 * RW_REC;
    const unsigned char* FR = a.ws + WS_C; float* Yr = (float*)((unsigned char*)a.out + DO_YR);
    const int chain = COOP ? ((int)blockIdx.x & 31) : (int)blockIdx.x, half = COOP ? ((int)blockIdx.x >> 5) : 0;
    const int b = chain >> 3, h = chain & 7, lane = threadIdx.x & 63, wave = __builtin_amdgcn_readfirstlane(threadIdx.x >> 6), q4 = lane >> 4, c16 = lane & 15;
    const unsigned char* FRb = FR + ((size_t)(b * NCH) * 8 + h) * RW_REC;
#define RW_BARRIER() do { asm volatile("" ::: "memory"); __builtin_amdgcn_s_barrier(); asm volatile("" ::: "memory"); } while (0)
    if (COOP && wave >= 4) {
        const int lw = wave - 4, sub = lw & 1; const bool far = lw < 2;
        const int set = far ? half : (half ^ 1);
        const int p0 = set * 5 + sub * 3, n1k = (sub == 0) ? 3 : (set == 0 ? 2 : 1); const bool hasG = (set == 1) && (sub == 1);
        const unsigned char* rp = FRb + lane * 16 + p0 * 1024; int so = p0 * 1024;
#define RW_CISSUE() do { LAS unsigned char* _slot = L + so; \
            _Pragma("unroll") for (int _j = 0; _j < 3; ++_j) if (_j < n1k) __builtin_amdgcn_global_load_lds((const unsigned*)(rp + _j * 1024), (LAS unsigned*)(_slot + _j * 1024), 16, 0, 0); \
            if (hasG) __builtin_amdgcn_global_load_lds((const unsigned*)(rp - lane * 12 - p0 * 1024 + RW_G), (LAS unsigned*)(_slot - p0 * 1024 + GOFF), 4, 0, 0); \
            rp += CSTR; so += SLOT; if (so >= NS * SLOT) so -= NS * SLOT; } while (0)
        if (far) {
#define RW_CWAIT() do { if (sub == 0) asm volatile("s_waitcnt vmcnt(27)" ::: "memory"); else asm volatile("s_waitcnt vmcnt(18)" ::: "memory"); } while (0)
            for (int p = 0; p < NS - 2; ++p) RW_CISSUE();
            RW_CWAIT(); RW_BARRIER();
#pragma unroll 1
            for (int it = 0; it < NCH / 2; ++it) { RW_CISSUE(); RW_CISSUE(); RW_CWAIT(); RW_BARRIER(); }
#undef RW_CWAIT
        } else {
#define RW_CWAIT() do { if (sub == 0) asm volatile("s_waitcnt vmcnt(6)" ::: "memory"); else asm volatile("s_waitcnt vmcnt(4)" ::: "memory"); } while (0)
            for (int p = 0; p < 5; ++p) RW_CISSUE();
            RW_CWAIT(); RW_BARRIER();
#pragma unroll 1
            for (int it = 0; it < NCH / 2; ++it) { RW_CISSUE(); RW_CISSUE(); RW_CWAIT(); RW_BARRIER(); }
#undef RW_CWAIT
        }
        asm volatile("s_waitcnt vmcnt(0)" ::: "memory");
#undef RW_CISSUE
    } else if (COOP && wave >= 2) {
        RW_BARRIER();
#pragma unroll 1
        for (int it = 0; it < NCH / 2; ++it) RW_BARRIER();
    } else if (wave >= 4) {
        const int lw = wave - 4;
        const unsigned char* rp = FRb + lane * 16; int so = 0;
#define RW_ISSUE1() do { LAS unsigned char* _slot = L + so; \
            if (VAR & 1) { } else if (lw < 2) { _Pragma("unroll") for (int _j = 0; _j < 3; ++_j) __builtin_amdgcn_global_load_lds((const unsigned*)(rp + (lw * 3 + _j) * 1024), (LAS unsigned*)(_slot + (lw * 3 + _j) * 1024), 16, 0, 0); } \
            else if (lw == 2) { _Pragma("unroll") for (int _j = 0; _j < 2; ++_j) __builtin_amdgcn_global_load_lds((const unsigned*)(rp + (6 + _j) * 1024), (LAS unsigned*)(_slot + (6 + _j) * 1024), 16, 0, 0); } \
            else { __builtin_amdgcn_global_load_lds((const unsigned*)(rp + 8 * 1024), (LAS unsigned*)(_slot + 8 * 1024), 16, 0, 0); \
                   __builtin_amdgcn_global_load_lds((const unsigned*)(rp - lane * 12 + RW_G), (LAS unsigned*)(_slot + GOFF), 4, 0, 0); } \
            if (!(VAR & 8)) rp += CSTR; so += SLOT; if (so == NS * SLOT) so = 0; } while (0)
#if SP_MODE & 4
#define RW_ISSUE() do { RW_ISSUE1(); rp -= CSTR; so -= SLOT; if (so < 0) so += NS * SLOT; RW_ISSUE1(); } while (0)
#else
#define RW_ISSUE() RW_ISSUE1()
#endif
#if SP_MODE & 4
#define RW_LWAIT() do { if (lw < 2) asm volatile("s_waitcnt vmcnt(54)" ::: "memory"); else asm volatile("s_waitcnt vmcnt(36)" ::: "memory"); } while (0)
#else
#define RW_LWAIT() do { if (lw < 2) asm volatile("s_waitcnt vmcnt(27)" ::: "memory"); else asm volatile("s_waitcnt vmcnt(18)" ::: "memory"); } while (0)
#endif
        for (int p = 0; p < NS - 2; ++p) RW_ISSUE();
        RW_LWAIT();
        RW_BARRIER();
#pragma unroll 1
        for (int it = 0; it < NCH / 2; ++it) { RW_ISSUE(); RW_ISSUE(); RW_LWAIT(); RW_BARRIER(); }
        asm volatile("s_waitcnt vmcnt(0)" ::: "memory");
#undef RW_ISSUE
#undef RW_ISSUE1
#undef RW_LWAIT
    } else {
        const int vs = COOP ? 2 * half + wave : wave;
#if SP_MODE & 2
        __builtin_amdgcn_s_setprio(3);
#endif
        f32x4 T[4];
#pragma unroll
        for (int i = 0; i < 4; ++i) T[i] = (f32x4){0.f, 0.f, 0.f, 0.f};
        struct Ops { bf16x8_t wmf[2], rf[2], bkf[4], arf; f32x4 g4[4]; };
        const LAS unsigned char* lp = L + lane * 16; const LAS unsigned char* lg = L + GOFF + q4 * 16; int so = 0;
        const unsigned char* up = FRb + RW_U + (vs * 64 + lane) * 8;
        float* yp = Yr + ((size_t)(b * NCH) * 8 + h) * 1024 + vs * 256 + lane * 4;
#if SP_MODE & 8
#define RW_LOAD(O) do { { const LAS unsigned char* _r = lp + so; const LAS unsigned char* _g = lg + so; \
            _Pragma("unroll") for (int _s = 0; _s < 2; ++_s) { bf16x8_t _t0 = *(const LAS bf16x8_t*)(_r + RW_WMF + _s * 1024); bf16x8_t _t1 = *(const LAS bf16x8_t*)(_r + RW_RF + _s * 1024); asm volatile("" :: "v"(_t0), "v"(_t1)); } \
            _Pragma("unroll") for (int _i = 0; _i < 4; ++_i) { bf16x8_t _t0 = *(const LAS bf16x8_t*)(_r + RW_BKF + _i * 1024); f32x4 _t1 = *(const LAS f32x4*)(_g + _i * 64); asm volatile("" :: "v"(_t0), "v"(_t1)); } \
            { bf16x8_t _t0 = *(const LAS bf16x8_t*)(_r + RW_ARF); asm volatile("" :: "v"(_t0)); } asm volatile("" ::: "memory"); } RW_LOAD1(O); } while (0)
#else
#define RW_LOAD(O) RW_LOAD1(O)
#endif
#define RW_LOAD1(O) do { const LAS unsigned char* _r = lp + so; const LAS unsigned char* _g = lg + so; \
            _Pragma("unroll") for (int _s = 0; _s < 2; ++_s) { O.wmf[_s] = *(const LAS bf16x8_t*)(_r + RW_WMF + _s * 1024); O.rf[_s] = *(const LAS bf16x8_t*)(_r + RW_RF + _s * 1024); } \
            _Pragma("unroll") for (int _i = 0; _i < 4; ++_i) O.bkf[_i] = *(const LAS bf16x8_t*)(_r + RW_BKF + _i * 1024); \
            O.arf = *(const LAS bf16x8_t*)(_r + RW_ARF); \
            _Pragma("unroll") for (int _i = 0; _i < 4; ++_i) O.g4[_i] = *(const LAS f32x4*)(_g + _i * 64); \
            so += SLOT; if (so == NS * SLOT) so = 0; \
            __builtin_amdgcn_sched_barrier(0); } while (0)
#define RW_UV(dst) do { if (!(VAR & 2)) { dst[0] = *(const u32x2_t*)up; dst[1] = *(const u32x2_t*)(up + 2048); } else { asm volatile("" : "+v"(dst[0]), "+v"(dst[1])); } if (!(VAR & 16)) up += CSTR; } while (0)
#define RW_STEP(O, uv) do { \
            bf16x8_t _bS[2]; \
            _Pragma("unroll") for (int _s = 0; _s < 2; ++_s) { const u32x4_t _pk = (u32x4_t){pk2(T[2 * _s][0], T[2 * _s][1]), pk2(T[2 * _s][2], T[2 * _s][3]), pk2(T[2 * _s + 1][0], T[2 * _s + 1][1]), pk2(T[2 * _s + 1][2], T[2 * _s + 1][3])}; \
                _bS[_s] = __builtin_bit_cast(bf16x8_t, _pk); } \
            f32x4 _z = (f32x4){__uint_as_float(uv[0].x << 16), __uint_as_float(uv[0].x & 0xffff0000u), __uint_as_float(uv[0].y << 16), __uint_as_float(uv[0].y & 0xffff0000u)}; \
            _z = __builtin_amdgcn_mfma_f32_16x16x32_bf16(O.wmf[0], _bS[0], _z, 0, 0, 0); _z = __builtin_amdgcn_mfma_f32_16x16x32_bf16(O.wmf[1], _bS[1], _z, 0, 0, 0); \
            f32x4 _y = (f32x4){0.f, 0.f, 0.f, 0.f}; \
            _y = __builtin_amdgcn_mfma_f32_16x16x32_bf16(_bS[0], O.rf[0], _y, 0, 0, 0); _y = __builtin_amdgcn_mfma_f32_16x16x32_bf16(_bS[1], O.rf[1], _y, 0, 0, 0); \
            const u32x4_t _zvp = (u32x4_t){pk2(-_z[0], -_z[1]), pk2(-_z[2], -_z[3]), uv[1].x, uv[1].y}; \
            const bf16x8_t _bZV = __builtin_bit_cast(bf16x8_t, _zvp); \
            _Pragma("unroll") for (int _i = 0; _i < 4; ++_i) { T[_i] = __builtin_amdgcn_mfma_f32_16x16x32_bf16(O.bkf[_i], _bZV, T[_i], 0, 0, 0); T[_i] = T[_i] * O.g4[_i]; } \
            _y = __builtin_amdgcn_mfma_f32_16x16x32_bf16(_bZV, O.arf, _y, 0, 0, 0); \
            if (!(VAR & 4)) *(f32x4*)yp = _y; else asm volatile("" :: "v"(_y)); RW_ST2(); yp += 8 * 1024; } while (0)
#if SP_MODE & 16
#define RW_ST2() do { asm volatile("" ::: "memory"); *(f32x4*)yp = _y; } while (0)
#else
#define RW_ST2() do { } while (0)
#endif
#define RW_SYNC() do { asm volatile("s_waitcnt lgkmcnt(0)" ::: "memory"); RW_BARRIER(); } while (0)
        Ops A, B;
        u32x2_t uv0[2], uv1[2], uv2[2], uv3[2], uv4[2], uv5[2], uv6[2], uv7[2];
        RW_UV(uv0); RW_UV(uv1); RW_UV(uv2); RW_UV(uv3); RW_UV(uv4); RW_UV(uv5); RW_UV(uv6); RW_UV(uv7);
        RW_BARRIER();
        RW_LOAD(A);
#pragma unroll 1
        for (int ch = 0; ch < NCH; ch += 8) {
            RW_LOAD(B); RW_STEP(A, uv0); RW_UV(uv0);
            RW_LOAD(A); RW_STEP(B, uv1); RW_UV(uv1); RW_SYNC();
            RW_LOAD(B); RW_STEP(A, uv2); RW_UV(uv2);
            RW_LOAD(A); RW_STEP(B, uv3); RW_UV(uv3); RW_SYNC();
            RW_LOAD(B); RW_STEP(A, uv4); RW_UV(uv4);
            RW_LOAD(A); RW_STEP(B, uv5); RW_UV(uv5); RW_SYNC();
            RW_LOAD(B); RW_STEP(A, uv6); RW_UV(uv6);
            RW_LOAD(A); RW_STEP(B, uv7); RW_UV(uv7); RW_SYNC(); }
#undef RW_SYNC
#undef RW_LOAD
#undef RW_LOAD1
#undef RW_STEP
#undef RW_UV
    }
#undef RW_BARRIER
}
__device__ __forceinline__ void ph_rwkv_post(const Args& a, LAS float* lds) {
    const bf16_t* V = (const bf16_t*)a.out; const float* Bon = (const float*)((const unsigned char*)a.out + DO_BON); const bf16_t* SG = (const bf16_t*)((const unsigned char*)a.out + DO_SG);
    const float* Yr = (const float*)((const unsigned char*)a.out + DO_YR); bf16_t* MIX = (bf16_t*)(a.ws + WS_D);
    const float* ln_w = a.in[14]; const float* ln_b = a.in[15];
    LAS unsigned char* L = (LAS unsigned char*)lds;
    const int c = threadIdx.x, lane = c & 63, h = c >> 6, q4 = lane >> 4, c16 = lane & 15;
    const bf16_t* FG = (const bf16_t*)(a.ws + FG_G2) + h * 8192;
    LAS unsigned char* TW = L + 8192 + h * 2304;
    for (int tile = blockIdx.x; tile < NTOK / 16; tile += gridDim.x) {
        const int n0 = tile * 16;
        __syncthreads();
        { const int tk = c >> 5, j4 = (c & 31) * 4; *(LAS u32x2_t*)(L + tk * 272 + j4 * 2) = *(const u32x2_t*)(SG + (size_t)tile * 2048 + (j4 >> 4) * 256 + tk * 16 + (j4 & 15)); }
        __syncthreads();
        const int n = n0 + c16;
        f32x4 g[4], y[4];
#pragma unroll
        for (int ct = 0; ct < 4; ++ct) { g[ct] = (f32x4){0.f, 0.f, 0.f, 0.f};
#pragma unroll
            for (int ks = 0; ks < 4; ++ks) { const bf16x8_t af = *(const bf16x8_t*)(FG + ((size_t)(ct * 4 + ks) * 64 + lane) * 8); const bf16x8_t bfr = *(const LAS bf16x8_t*)(L + c16 * 272 + ks * 64 + q4 * 16);
                g[ct] = __builtin_amdgcn_mfma_f32_16x16x32_bf16(af, bfr, g[ct], 0, 0, 0); }
            y[ct] = *(const f32x4*)(Yr + (size_t)tile * 8192 + h * 1024 + ct * 256 + lane * 4); }
        float sm = 0.f;
#pragma unroll
        for (int ct = 0; ct < 4; ++ct) sm += (y[ct][0] + y[ct][1]) + (y[ct][2] + y[ct][3]);
        sm = xrow16_sum(sm);
        const float mean = sm * (1.f / 64.f);
        float sv = 0.f;
#pragma unroll
        for (int ct = 0; ct < 4; ++ct) { y[ct] = y[ct] - mean; sv += (y[ct][0] * y[ct][0] + y[ct][1] * y[ct][1]) + (y[ct][2] * y[ct][2] + y[ct][3] * y[ct][3]); }
        sv = xrow16_sum(sv);
        const float rstd = rsqrtf(sv * (1.f / 64.f) + 64e-5f), bsc = Bon[(size_t)n * 8 + h];
#pragma unroll
        for (int ct = 0; ct < 4; ++ct) { const int ch = 64 * h + 16 * ct + 4 * q4;
            const f32x4 lw = *(const f32x4*)(ln_w + ch), lb = *(const f32x4*)(ln_b + ch);
            const u32x2_t vv = *(const u32x2_t*)(V + (size_t)n * 512 + ch);
            const float v0 = __uint_as_float(vv.x << 16), v1 = __uint_as_float(vv.x & 0xffff0000u), v2 = __uint_as_float(vv.y << 16), v3 = __uint_as_float(vv.y & 0xffff0000u);
            const float o0 = (y[ct][0] * rstd * lw[0] + lb[0] + bsc * v0) * g[ct][0], o1 = (y[ct][1] * rstd * lw[1] + lb[1] + bsc * v1) * g[ct][1];
            const float o2 = (y[ct][2] * rstd * lw[2] + lb[2] + bsc * v2) * g[ct][2], o3 = (y[ct][3] * rstd * lw[3] + lb[3] + bsc * v3) * g[ct][3];
            *(LAS u32x2_t*)(TW + c16 * 136 + ct * 32 + q4 * 8) = (u32x2_t){pk2(o0, o1), pk2(o2, o3)}; }
#pragma unroll
        for (int j = 0; j < 2; ++j) { const int tk = 8 * j + (lane >> 3), pc = lane & 7;
            *(u32x4_t*)(MIX + (size_t)(n0 + tk) * DM + 64 * h + pc * 8) = *(const LAS u32x4_t*)(TW + tk * 136 + pc * 16); }
    }
}

namespace gla {
typedef short bf16x8 __attribute__((ext_vector_type(8)));
typedef float f32x16 __attribute__((ext_vector_type(16)));
typedef unsigned u32x4 __attribute__((ext_vector_type(4)));
typedef unsigned u32x2 __attribute__((ext_vector_type(2)));
constexpr int QH_OFF = 0, KH_OFF = 17408, KT_OFF = 34816, VT_OFF = 53248, ST_OFF = 71680, AM_OFF = 106496, EB_OFF = 115712, ER_OFF = 116224, PS_OFF = 116736, SSQ_OFF = 118784, OT_OFF = 119808;
constexpr int QS = 272, TS = 144;
#define GLA_BAR() do { asm volatile("s_waitcnt lgkmcnt(0)" ::: "memory"); __builtin_amdgcn_s_barrier(); asm volatile("" ::: "memory"); } while (0)
template <bool OUT>
__device__ __forceinline__ void unit(const Args& a, LAS unsigned char* L, int u) {
    const int tid = threadIdx.x, lane = tid & 63, w = tid >> 6;
    const int b = u >> 6, h = (u >> 3) & 7, j = u & 7;
    const bf16_t* Q = (const bf16_t*)(a.ws + WS_QFIG) + ((size_t)b * SEQ + (size_t)j * 1024) * 4096 + h * 128;
    float* Lb = (float*)(a.ws + WS_O); float* Db = Lb + (size_t)256 * 16384;
    const int dk = tid & 127, tg = tid >> 7;
    const float c0 = a.in[25][h * 128 + dk], c1 = a.in[25][1024 + h * 128 + dk];
    const float lbv = __builtin_amdgcn_rcpf(1.f + __expf(c0 - c1)), omlb = 1.f - lbv;
    LAS float* PS = (LAS float*)(L + PS_OFF); LAS float* EB = (LAS float*)(L + EB_OFF); LAS float* ER = (LAS float*)(L + ER_OFF); LAS float* SSQ = (LAS float*)(L + SSQ_OFF);
    const int si = w >> 1, sj0 = (w & 1) * 2, l31 = lane & 31, l5 = lane >> 5;
    const int ri = w >> 2, cj = w & 3, odv = 32 * cj + l31;
    f32x16 S[2];
#pragma unroll
    for (int jj = 0; jj < 2; ++jj)
#pragma unroll
        for (int r = 0; r < 16; ++r) S[jj][r] = 0.f;
    if (OUT) {
#pragma unroll 1
        for (int i = 0; i < j; ++i) { const int ui = u - j + i;
#pragma unroll
            for (int jj = 0; jj < 2; ++jj)
#pragma unroll
                for (int rg = 0; rg < 4; ++rg) { const int sdk0 = 32 * si + 8 * rg + 4 * l5, sdv = 32 * (sj0 + jj) + l31; const f32x4 dd = *(const f32x4*)(Db + ui * 128 + sdk0);
#pragma unroll
                    for (int e = 0; e < 4; ++e) S[jj][4 * rg + e] = dd[e] * S[jj][4 * rg + e] + Lb[(size_t)ui * 16384 + (sdk0 + e) * 128 + sdv]; } } }
    const float nwv = OUT ? a.in[26][h * 128 + odv] : 0.f;
    float dsum = 1.f;
    const int prow = tid >> 4, ppc = tid & 15;
    u32x4 pf[2], pv[2], pq[2];
#define GLA_PREFETCH(cx) do { const bf16_t* _q = Q + (size_t)((cx) * 64 + prow) * 4096 + ppc * 8; \
        _Pragma("unroll") for (int _r = 0; _r < 2; ++_r) { pf[_r] = *(const u32x4*)(_q + (size_t)_r * 32 * 4096 + 1024); pv[_r] = *(const u32x4*)(_q + (size_t)_r * 32 * 4096 + 2048); if (OUT) pq[_r] = *(const u32x4*)(_q + (size_t)_r * 32 * 4096); } } while (0)
    GLA_PREFETCH(0);
#pragma unroll 1
    for (int c = 0; c < 16; ++c) {
        int cc = c; asm volatile("" : "+s"(cc));
#pragma unroll
        for (int r = 0; r < 2; ++r) { *(LAS u32x4*)(L + KH_OFF + (prow + 32 * r) * QS + ppc * 16) = pf[r]; *(LAS u32x4*)(L + ST_OFF + (prow + 32 * r) * QS + ppc * 16) = pv[r];
            if (OUT) *(LAS u32x4*)(L + QH_OFF + (prow + 32 * r) * QS + ppc * 16) = pq[r]; }
        if (c + 1 < 16) GLA_PREFETCH(cc + 1);
        u32x4 gq[2];
        if (OUT) { const bf16_t* G = Q + (size_t)(cc * 64) * 4096 + 3072;
            unsigned go = (unsigned)((tid >> 3) * 4096 + (tid & 7) * 16); asm volatile("" : "+v"(go));
            gq[0] = *(const u32x4*)(G + go); gq[1] = *(const u32x4*)(G + go + 8u); }
        GLA_BAR();
        float lf[16], kk[16];
#pragma unroll
        for (int i = 0; i < 16; ++i) { const float fv = bf2f(*(const LAS bf16_t*)(L + KH_OFF + (tg * 16 + i) * QS + dk * 2)); const float sg = __builtin_amdgcn_rcpf(1.f + __expf(-fv));
            lf[i] = lbv + omlb * sg; kk[i] = omlb * (1.f - sg); }
#pragma unroll
        for (int i = 1; i < 16; ++i) lf[i] *= lf[i - 1];
        PS[tg * 128 + dk] = lf[15];
        GLA_BAR();
        const float p0 = PS[dk], p1 = PS[128 + dk], p2 = PS[256 + dk], p3 = PS[384 + dk];
        const float off = (tg > 0 ? p0 : 1.f) * (tg > 1 ? p1 : 1.f) * (tg > 2 ? p2 : 1.f);
        const float pref = p0 * p1, pbl = pref * (p2 * p3), ebr = p2 * p3;
        const float ioff = off * __builtin_amdgcn_rcpf(pref);
        unsigned ktp[8], vtp[8];
#pragma unroll
        for (int i = 0; i < 16; i += 2) {
            float kb[2]; unsigned vv[2];
#pragma unroll
            for (int q = 0; q < 2; ++q) { const float e1 = ioff * lf[i + q]; const float e2 = __builtin_amdgcn_rcpf(e1);
                const float khat = kk[i + q] * e2; kb[q] = khat * ebr; vv[q] = *(const LAS bf16_t*)(L + ST_OFF + (tg * 16 + i + q) * QS + dk * 2);
                if (OUT) { LAS bf16_t* qp = (LAS bf16_t*)(L + QH_OFF + (tg * 16 + i + q) * QS + dk * 2); const float qr = bf2f(*qp); const float qv = qr * __builtin_amdgcn_rcpf(1.f + __expf(-qr));
                    *qp = f2bf(qv * e1); *(LAS bf16_t*)(L + KH_OFF + (tg * 16 + i + q) * QS + dk * 2) = f2bf(khat); } }
            ktp[i >> 1] = pk2(kb[0], kb[1]); vtp[i >> 1] = vv[0] | (vv[1] << 16);
        }
        *(LAS u32x4*)(L + KT_OFF + dk * TS + tg * 32) = (u32x4){ktp[0], ktp[1], ktp[2], ktp[3]}; *(LAS u32x4*)(L + KT_OFF + dk * TS + tg * 32 + 16) = (u32x4){ktp[4], ktp[5], ktp[6], ktp[7]};
        *(LAS u32x4*)(L + VT_OFF + dk * TS + tg * 32) = (u32x4){vtp[0], vtp[1], vtp[2], vtp[3]}; *(LAS u32x4*)(L + VT_OFF + dk * TS + tg * 32 + 16) = (u32x4){vtp[4], vtp[5], vtp[6], vtp[7]};
        if (tg == 0) { EB[dk] = pbl; ER[dk] = pref; dsum *= pbl; }
        GLA_BAR();
        f32x16 o;
        if (OUT) {
#pragma unroll
            for (int jj = 0; jj < 2; ++jj)
#pragma unroll
                for (int rg = 0; rg < 4; ++rg) { const int dk0 = 32 * si + 8 * rg + 4 * l5; const f32x4 er = *(const LAS f32x4*)(ER + dk0);
                    u32x2 pk; pk.x = pk2(S[jj][4 * rg] * er[0], S[jj][4 * rg + 1] * er[1]); pk.y = pk2(S[jj][4 * rg + 2] * er[2], S[jj][4 * rg + 3] * er[3]);
                    *(LAS u32x2*)(L + ST_OFF + (32 * (sj0 + jj) + l31) * QS + dk0 * 2) = pk; }
#pragma unroll
            for (int q = 0; q < 2; ++q) { const int ti = w >> 1, tj = (w & 1) * 2 + q;
                f32x4 sc = (f32x4){0.f, 0.f, 0.f, 0.f};
                if (tj <= ti) {
#pragma unroll
                    for (int ks = 0; ks < 4; ++ks) { const bf16x8 af = *(const LAS bf16x8*)(L + QH_OFF + (16 * ti + (lane & 15)) * QS + ks * 64 + (lane >> 4) * 16);
                        const bf16x8 bfr = *(const LAS bf16x8*)(L + KH_OFF + (16 * tj + (lane & 15)) * QS + ks * 64 + (lane >> 4) * 16);
                        sc = __builtin_amdgcn_mfma_f32_16x16x32_bf16(af, bfr, sc, 0, 0, 0); } }
                const int scol = 16 * tj + (lane & 15);
#pragma unroll
                for (int r = 0; r < 4; ++r) { const int trow = 16 * ti + 4 * (lane >> 4) + r; const float v = (scol <= trow) ? sc[r] : 0.f;
                    *(LAS bf16_t*)(L + AM_OFF + trow * TS + scol * 2) = f2bf(v); } }
            GLA_BAR();
#pragma unroll
            for (int r = 0; r < 16; ++r) o[r] = 0.f;
#pragma unroll
            for (int ks = 0; ks < 4; ++ks) if (ks < 2 * (ri + 1)) {
                const bf16x8 af = *(const LAS bf16x8*)(L + AM_OFF + (32 * ri + l31) * TS + ks * 32 + l5 * 16);
                const bf16x8 bfr = *(const LAS bf16x8*)(L + VT_OFF + (32 * cj + l31) * TS + ks * 32 + l5 * 16);
                o = __builtin_amdgcn_mfma_f32_32x32x16_bf16(af, bfr, o, 0, 0, 0); }
#pragma unroll
            for (int ks = 0; ks < 8; ++ks) { if ((ks & 3) == 0) asm volatile("" ::: "memory");
                const bf16x8 af = *(const LAS bf16x8*)(L + QH_OFF + (32 * ri + l31) * QS + ks * 32 + l5 * 16);
                const bf16x8 bfr = *(const LAS bf16x8*)(L + ST_OFF + (32 * cj + l31) * QS + ks * 32 + l5 * 16);
                o = __builtin_amdgcn_mfma_f32_32x32x16_bf16(af, bfr, o, 0, 0, 0); }
#pragma unroll
            for (int r = 0; r < 16; ++r) { const float q2 = xrow32_sum(row16_sum(o[r] * o[r]));
                if (l31 == 0) SSQ[(32 * ri + (r & 3) + 8 * (r >> 2) + 4 * l5) * 4 + cj] = q2; }
#pragma unroll
            for (int r = 0; r < 16; ++r) *(LAS float*)(L + OT_OFF + (32 * ri + (r & 3) + 8 * (r >> 2) + 4 * l5) * 528 + odv * 4) = o[r] * nwv;
        }
        {
            bf16x8 af[4];
#pragma unroll
            for (int ks = 0; ks < 4; ++ks) af[ks] = *(const LAS bf16x8*)(L + KT_OFF + (32 * si + l31) * TS + ks * 32 + l5 * 16);
#pragma unroll
            for (int jj = 0; jj < 2; ++jj) {
#pragma unroll
                for (int rg = 0; rg < 4; ++rg) { const f32x4 eb = *(const LAS f32x4*)(EB + 32 * si + 8 * rg + 4 * l5);
                    S[jj][4 * rg] *= eb[0]; S[jj][4 * rg + 1] *= eb[1]; S[jj][4 * rg + 2] *= eb[2]; S[jj][4 * rg + 3] *= eb[3]; }
#pragma unroll
                for (int ks = 0; ks < 4; ++ks) { const bf16x8 bfr = *(const LAS bf16x8*)(L + VT_OFF + (32 * (sj0 + jj) + l31) * TS + ks * 32 + l5 * 16);
                    S[jj] = __builtin_amdgcn_mfma_f32_32x32x16_bf16(af[ks], bfr, S[jj], 0, 0, 0); } }
        }
        GLA_BAR();
        if (OUT) {
            const int et = tid >> 3, ep = tid & 7;
            const f32x4 q4 = *(const LAS f32x4*)(SSQ + et * 4);
            const float rs = rsqrtf(((q4[0] + q4[1]) + (q4[2] + q4[3])) * (1.f / 128.f) + 1e-6f);
            bf16_t* MIX = (bf16_t*)(a.ws + WS_MIX1) + ((size_t)b * SEQ + (size_t)j * 1024 + cc * 64) * DM + h * 128;
            unsigned mo = (unsigned)(et * DM + ep * 16); asm volatile("" : "+v"(mo));
#pragma unroll
            for (int hf = 0; hf < 2; ++hf) { unsigned ov[4];
#pragma unroll
                for (int e2 = 0; e2 < 2; ++e2) { const f32x4 o4 = *(const LAS f32x4*)(L + OT_OFF + et * 528 + ep * 64 + hf * 32 + e2 * 16);
#pragma unroll
                    for (int e = 0; e < 2; ++e) { const unsigned gw = gq[hf][e2 * 2 + e]; const float g0 = __uint_as_float(gw << 16), g1 = __uint_as_float(gw & 0xffff0000u);
                        ov[e2 * 2 + e] = pk2(o4[2 * e] * rs * g0 * __builtin_amdgcn_rcpf(1.f + __expf(-g0)), o4[2 * e + 1] * rs * g1 * __builtin_amdgcn_rcpf(1.f + __expf(-g1))); } }
                *(u32x4*)(MIX + mo + hf * 8) = (u32x4){ov[0], ov[1], ov[2], ov[3]}; }
        }
    }
    if (!OUT) {
#pragma unroll
        for (int jj = 0; jj < 2; ++jj)
#pragma unroll
            for (int r = 0; r < 16; ++r) { const int sdk = 32 * si + (r & 3) + 8 * (r >> 2) + 4 * l5, sdv = 32 * (sj0 + jj) + l31; Lb[(size_t)u * 16384 + sdk * 128 + sdv] = S[jj][r]; }
        if (tg == 0) Db[u * 128 + dk] = dsum;
    }
    GLA_BAR();
#undef GLA_PREFETCH
}
__device__ __forceinline__ void pass2(const Args& a) {
    float* Lb = (float*)(a.ws + WS_O); const float* Db = Lb + (size_t)256 * 16384;
    for (int idx = blockIdx.x * NTHREADS + threadIdx.x; idx < 32 * 16384; idx += gridDim.x * NTHREADS) { const int bh = idx >> 14, el = idx & 16383, dkk = el >> 7; float sacc = 0.f;
        for (int j = 0; j < 8; ++j) { const int u = bh * 8 + j; const size_t o = (size_t)u * 16384 + el;
            if (j < 7) { const float tmp = Lb[o]; Lb[o] = sacc; sacc = Db[u * 128 + dkk] * sacc + tmp; } else Lb[o] = sacc; } }
}
}

constexpr int NPHASE = 24;
__global__ void __launch_bounds__(NTHREADS, 2) fwd(Args a) {
    extern __shared__ __attribute__((aligned(16))) unsigned char lds_raw[];
    LAS unsigned char* ldsb = (LAS unsigned char*)lds_raw;
    LAS float* lds = (LAS float*)ldsb;
    LAS int* pst = (LAS int*)(ldsb + LDS_MISC);
    volatile LAS unsigned* xbw = (volatile LAS unsigned*)(ldsb + LDS_MISC + 256);
    if (threadIdx.x == 0) { xbw[0] = 0u; xbw[1] = 0u; }
    __syncthreads();
    unsigned* ctl = (unsigned*)(a.ws + WS_CTL);
    const bool multi = (a.ph_hi - a.ph_lo) > 1;
    XcdBarrier bar; bar.bar = ctl; bar.x = 0; bar.st = xbw;
    if (multi) bar = xcd_barrier_post(ctl, xbw);
    unsigned char* ws = a.ws;
    bf16_t* HN = (bf16_t*)(ws + WS_A);
    bf16_t* XR = (bf16_t*)(ws + WS_XR); float* RSv = (float*)(ws + WS_ROUTE + RT_LRU_CH);
    int* asg_e = (int*)(ws + WS_ROUTE + RT_ASG_E); int* asg_rank = (int*)(ws + WS_ROUTE + RT_ASG_RANK); float* asg_gate = (float*)(ws + WS_ROUTE + RT_ASG_GATE);
    int* row_tok = (int*)(ws + WS_ROUTE + RT_ROW_TOK); int* row_slot = (int*)(ws + WS_ROUTE + RT_ROW_SLOT); float* row_gate = (float*)(ws + WS_ROUTE + RT_ROW_GATE); float* row_rs = (float*)(ws + WS_ROUTE + RT_LRU_CA); float* tscale = (float*)(ws + WS_ROUTE + RT_LRU_CIN);
#ifndef PHSEL
#define PHSEL(k) true
#endif
#ifndef REPMASK
#define REPMASK 0u
#endif
#define NREP(k) (((REPMASK >> (k)) & 1u) ? 2 : 1)
#define IN(k) (PHSEL(k) && a.ph_lo <= (k) && (k) < a.ph_hi)
#define SEAM(k) do { if (IN((k) + 1) && multi) xcd_barrier(bar); } while (0)
    if (IN(0)) { ph_cvt_frags(a); ph_cvt_dense_a(a, lds, ctl + CW_COLMAX, blockIdx.x, gridDim.x, 0); ph_norm0(a.in[0], a.in[1], (unsigned char*)HN, (float*)(ws + WS_ROUTE + RT_LRU_CH + 262144)); xcd_barrier(bar); ph_cvt_dense_b(a, lds, ctl + CW_COLMAX, 0, blockIdx.x, gridDim.x); }
#if (REPMASK >> 0) & 1
    if (IN(0)) { xcd_barrier(bar);  ph_cvt_frags(a); ph_cvt_dense_a(a, lds, ctl + CW_COLMAX, blockIdx.x, gridDim.x, 0); ph_norm0(a.in[0], a.in[1], (unsigned char*)HN, (float*)(ws + WS_ROUTE + RT_LRU_CH + 262144)); xcd_barrier(bar); ph_cvt_dense_b(a, lds, ctl + CW_COLMAX, 0, blockIdx.x, gridDim.x); }
#endif
    if (IN(0)) { SEAM(0); }
    if (IN(1)) { pg8::DenseOrder S; S.init(ABC, NTOK, DM / 2, gridDim.x, blockIdx.x, HN); pg8::EpiBf16IT E{(bf16_t*)(ws + WS_B), ABC, (float*)(ws + WS_ROUTE + RT_LRU_CH + 262144), ctl + CW_COLMAX};
        pg8::gemm_phase<pg8::EpiBf16IT, pg8::DenseOrder, true>(ldsb, (const char*)(ws + WD_ABIN), DM, DM / 2, S, E); }
#if (REPMASK >> 1) & 1
    if (IN(1)) { xcd_barrier(bar);  pg8::DenseOrder S; S.init(ABC, NTOK, DM / 2, gridDim.x, blockIdx.x, HN); pg8::EpiBf16IT E{(bf16_t*)(ws + WS_B), ABC, (float*)(ws + WS_ROUTE + RT_LRU_CH + 262144), ctl + CW_COLMAX};
        pg8::gemm_phase<pg8::EpiBf16IT, pg8::DenseOrder, true>(ldsb, (const char*)(ws + WD_ABIN), DM, DM / 2, S, E);  }
#endif
    if (IN(1)) { SEAM(1); }
    if (IN(2)) { ph_l0_prep(a, lds); }
#if (REPMASK >> 2) & 1
    if (IN(2)) { xcd_barrier(bar);  ph_l0_prep(a, lds);  }
#endif
    if (IN(2)) { SEAM(2); }
    if (IN(6)) {
        if (blockIdx.x < NSCAN) {
#if SP_MODE & 64
            ph_rwkv_scan<0, SCAN_COOP>(a, ldsb); __syncthreads();
#endif
#if SP_VAR
            ph_rwkv_scan<SP_VAR, SCAN_COOP>(a, ldsb); __syncthreads(); ph_rwkv_scan<0, SCAN_COOP>(a, ldsb);
#else
            ph_rwkv_scan<0, SCAN_COOP>(a, ldsb);
#endif
        } else { const int gb = (int)blockIdx.x - NSCAN, gn = (int)gridDim.x - NSCAN; unsigned* sctr = ctl + CW_CNT + 256;
            ph_lru_b(a, gb, lds); sub_barrier(sctr, (unsigned)gn);
#if SP_MODE & 1
            ph_lru_c(a, gb, gn); }
        xcd_barrier(bar); ph_wmax(a.in[32], a.in[33], ctl + CW_WMAX, blockIdx.x, gridDim.x); ph_cvt_dense_a(a, lds, ctl + CW_COLMAX, blockIdx.x, gridDim.x, 1); xcd_barrier(bar);
        ph_cvt_moe(a, 0, lds, blockIdx.x, gridDim.x, 3); ph_cvt_moe(a, 1, lds, blockIdx.x, gridDim.x, 1); ph_cvt_dense_b(a, lds, ctl + CW_COLMAX, 1, blockIdx.x, gridDim.x);
#else
            ph_lru_c(a, gb, gn); ph_wmax(a.in[32], a.in[33], ctl + CW_WMAX, gb, gn); ph_cvt_dense_a(a, lds, ctl + CW_COLMAX, gb, gn, 1); sub_barrier(sctr, 2u * (unsigned)gn);
            ph_cvt_moe(a, 0, lds, gb, gn, 3); ph_cvt_moe(a, 1, lds, gb, gn, 1); ph_cvt_dense_b(a, lds, ctl + CW_COLMAX, 1, gb, gn);
#if SP_MODE & 32
            ph_cvt_moe(a, 1, lds, gb, gn, 1);
#endif
            }
#endif
        SEAM(6); }
    if (IN(7)) { ph_rwkv_post(a, lds); }
#if (REPMASK >> 7) & 1
    if (IN(7)) { xcd_barrier(bar);  ph_rwkv_post(a, lds);  }
#endif
    if (IN(7)) { SEAM(7); }
    if (IN(8)) { pg8::DenseOrder S; S.init(NTOK, DM, DM, gridDim.x, blockIdx.x, ws + WD_ABOUT); pg8::EpiResid<true> E{a.in[0], XR};
        pg8::gemm_phase(ldsb, (const char*)(ws + WS_D), DM * 2, DM, S, E); }
#if (REPMASK >> 8) & 1
    if (IN(8)) { xcd_barrier(bar);  pg8::DenseOrder S; S.init(NTOK, DM, DM, gridDim.x, blockIdx.x, ws + WD_ABOUT); pg8::EpiResid<true> E{a.in[0], XR};
        pg8::gemm_phase(ldsb, (const char*)(ws + WS_D), DM * 2, DM, S, E);  }
#endif
    if (IN(8)) { SEAM(8); }
    if (IN(9)) { ph_route(a, 0, XR, HN, RSv, ctl + CW_CNT, asg_e, asg_rank, asg_gate, lds); SEAM(9); }
    if (IN(10)) { ph_dispatch(ctl + CW_CNT, asg_e, asg_rank, asg_gate, RSv, row_tok, row_slot, row_gate, row_rs, pst, ctl + CW_WMAX, tscale); }
#if (REPMASK >> 10) & 1
    if (IN(10)) { xcd_barrier(bar);  ph_dispatch(ctl + CW_CNT, asg_e, asg_rank, asg_gate, RSv, row_tok, row_slot, row_gate, row_rs, pst, ctl + CW_WMAX, tscale);  }
#endif
    if (IN(10)) { SEAM(10); }
    if (IN(11)) { moe_prefix(ctl + CW_CNT, pst);
        pg8::MoeOrder S{(int)gridDim.x, (int)blockIdx.x, 4, pst[NEXP] / 256, pst, row_tok, (const char*)(ws + WM_GU), (size_t)DM * DM, (size_t)256 * DM}; pg8::EpiSwiGLU E{(bf16_t*)(ws + WS_H), tscale};
        pg8::gemm_phase<pg8::EpiSwiGLU, pg8::MoeOrder, true>(ldsb, (const char*)HN, DM, DM / 2, S, E); moe_tail_cvt(a, lds, pst, 0, 13); }
#if (REPMASK >> 11) & 1
    if (IN(11)) { xcd_barrier(bar);  moe_prefix(ctl + CW_CNT, pst);
        pg8::MoeOrder S{(int)gridDim.x, (int)blockIdx.x, 4, pst[NEXP] / 256, pst, row_tok, (const char*)(ws + WM_GU), (size_t)DM * DM, (size_t)256 * DM}; pg8::EpiSwiGLU E{(bf16_t*)(ws + WS_H), tscale};
        pg8::gemm_phase<pg8::EpiSwiGLU, pg8::MoeOrder, true>(ldsb, (const char*)HN, DM, DM / 2, S, E);  }
#endif
    if (IN(11)) { SEAM(11); }
    if (IN(12)) { moe_prefix(ctl + CW_CNT, pst);
        pg8::MoeOrder S{(int)gridDim.x, (int)blockIdx.x, 4, pst[NEXP] / 256, pst, nullptr, (const char*)(ws + WM_DN), (size_t)DM * FF * 2, (size_t)256 * FF * 2}; pg8::EpiDown E{(bf16_t*)(ws + WS_Y), row_tok, row_slot, row_gate};
        pg8::gemm_phase(ldsb, (const char*)(ws + WS_H), FF * 2, FF, S, E); moe_tail_cvt(a, lds, pst, 13, NEXP); }
#if (REPMASK >> 12) & 1
    if (IN(12)) { xcd_barrier(bar);  moe_prefix(ctl + CW_CNT, pst);
        pg8::MoeOrder S{(int)gridDim.x, (int)blockIdx.x, 4, pst[NEXP] / 256, pst, nullptr, (const char*)(ws + WM_DN), (size_t)DM * FF * 2, (size_t)256 * FF * 2}; pg8::EpiDown E{(bf16_t*)(ws + WS_Y), row_tok, row_slot, row_gate};
        pg8::gemm_phase(ldsb, (const char*)(ws + WS_H), FF * 2, FF, S, E);  }
#endif
    if (IN(12)) { SEAM(12); }
    if (IN(13)) { ph_combine_norm(XR, (const bf16_t*)(ws + WS_Y), a.in[1] + DM, (unsigned char*)HN, (float*)(ws + WS_ROUTE + RT_LRU_CH + 262144)); SEAM(13); }
    if (IN(14)) { pg8::DenseOrder S; S.init(NTOK, 4096, DM / 2, gridDim.x, blockIdx.x, ws + WD_CIN); pg8::EpiBf16I E{(bf16_t*)(ws + WS_QFIG), 4096, (float*)(ws + WS_ROUTE + RT_LRU_CH + 262144), ctl + CW_COLMAX + ABC};
        pg8::gemm_phase<pg8::EpiBf16I, pg8::DenseOrder, true>(ldsb, (const char*)HN, DM, DM / 2, S, E); }
#if (REPMASK >> 14) & 1
    if (IN(14)) { xcd_barrier(bar);  pg8::DenseOrder S; S.init(NTOK, 4096, DM / 2, gridDim.x, blockIdx.x, ws + WD_CIN); pg8::EpiBf16I E{(bf16_t*)(ws + WS_QFIG), 4096, (float*)(ws + WS_ROUTE + RT_LRU_CH + 262144), ctl + CW_COLMAX + ABC};
        pg8::gemm_phase<pg8::EpiBf16I, pg8::DenseOrder, true>(ldsb, (const char*)HN, DM, DM / 2, S, E);  }
#endif
    if (IN(14)) { SEAM(14); }
    if (IN(15)) { for (int u = blockIdx.x; u < 256; u += gridDim.x) if ((u & 7) != 7) gla::unit<false>(a, ldsb, u); }
#if (REPMASK >> 15) & 1
    if (IN(15)) { xcd_barrier(bar);  for (int u = blockIdx.x; u < 256; u += gridDim.x) if ((u & 7) != 7) gla::unit<false>(a, ldsb, u);  }
#endif
    if (IN(15)) { SEAM(15); }
    if (IN(17)) { for (int u = blockIdx.x; u < 256; u += gridDim.x) gla::unit<true>(a, ldsb, u); }
#if (REPMASK >> 17) & 1
    if (IN(17)) { xcd_barrier(bar);  for (int u = blockIdx.x; u < 256; u += gridDim.x) gla::unit<true>(a, ldsb, u);  }
#endif
    if (IN(17)) { SEAM(17); }
    if (IN(18)) { pg8::DenseOrder S; S.init(NTOK, DM, DM, gridDim.x, blockIdx.x, ws + WD_COUT); pg8::EpiResid<false> E{XR, XR};
        pg8::gemm_phase(ldsb, (const char*)(ws + WS_MIX1), DM * 2, DM, S, E); SEAM(18); }
    if (IN(19)) { ph_route(a, 1, XR, HN, RSv, ctl + CW_CNT + 64, asg_e, asg_rank, asg_gate, lds); SEAM(19); }
    if (IN(20)) { ph_dispatch(ctl + CW_CNT + 64, asg_e, asg_rank, asg_gate, RSv, row_tok, row_slot, row_gate, row_rs, pst, ctl + CW_WMAX + 64, tscale); }
#if (REPMASK >> 20) & 1
    if (IN(20)) { xcd_barrier(bar);  ph_dispatch(ctl + CW_CNT + 64, asg_e, asg_rank, asg_gate, RSv, row_tok, row_slot, row_gate, row_rs, pst, ctl + CW_WMAX + 64, tscale);  }
#endif
    if (IN(20)) { SEAM(20); }
    if (IN(21)) { moe_prefix(ctl + CW_CNT + 64, pst);
        pg8::MoeOrder S{(int)gridDim.x, (int)blockIdx.x, 4, pst[NEXP] / 256, pst, row_tok, (const char*)(ws + WM_GU1), (size_t)DM * DM, (size_t)256 * DM}; pg8::EpiSwiGLU E{(bf16_t*)(ws + WS_H), tscale};
        pg8::gemm_phase<pg8::EpiSwiGLU, pg8::MoeOrder, true>(ldsb, (const char*)HN, DM, DM / 2, S, E); }
#if (REPMASK >> 21) & 1
    if (IN(21)) { xcd_barrier(bar);  moe_prefix(ctl + CW_CNT + 64, pst);
        pg8::MoeOrder S{(int)gridDim.x, (int)blockIdx.x, 4, pst[NEXP] / 256, pst, row_tok, (const char*)(ws + WM_GU1), (size_t)DM * DM, (size_t)256 * DM}; pg8::EpiSwiGLU E{(bf16_t*)(ws + WS_H), tscale};
        pg8::gemm_phase<pg8::EpiSwiGLU, pg8::MoeOrder, true>(ldsb, (const char*)HN, DM, DM / 2, S, E);  }
#endif
    if (IN(21)) { SEAM(21); }
    if (IN(22)) { moe_prefix(ctl + CW_CNT + 64, pst);
        pg8::MoeOrder S{(int)gridDim.x, (int)blockIdx.x, 4, pst[NEXP] / 256, pst, nullptr, (const char*)a.out, (size_t)DM * FF * 2, (size_t)256 * FF * 2}; pg8::EpiDown E{(bf16_t*)(ws + WS_Y), row_tok, row_slot, row_gate};
        pg8::gemm_phase(ldsb, (const char*)(ws + WS_H), FF * 2, FF, S, E); }
#if (REPMASK >> 22) & 1
    if (IN(22)) { xcd_barrier(bar);  moe_prefix(ctl + CW_CNT + 64, pst);
        pg8::MoeOrder S{(int)gridDim.x, (int)blockIdx.x, 4, pst[NEXP] / 256, pst, nullptr, (const char*)(ws + WM_DN), (size_t)DM * FF * 2, (size_t)256 * FF * 2}; pg8::EpiDown E{(bf16_t*)(ws + WS_Y), row_tok, row_slot, row_gate};
        pg8::gemm_phase(ldsb, (const char*)(ws + WS_H), FF * 2, FF, S, E);  }
#endif
    if (IN(22)) { SEAM(22); }
    if (IN(23)) { ph_final(XR, (const bf16_t*)(ws + WS_Y), a.in[3], a.out); }
#undef IN
#undef SEAM
}

extern "C" void kernel_launch(void* const* d_in, const int* in_sizes, int n_in, void* d_out, int out_size, void* d_ws, size_t ws_size, hipStream_t stream) {
    static int grid = 0;
    if (grid == 0) {
        if (n_in != 35 || out_size != NTOK * DM || ws_size < WS_END) { fprintf(stderr, "kernel_launch: unexpected shapes (n_in %d out %d ws %zu)\n", n_in, out_size, ws_size); grid = -1; return; }
        int dev = 0, cus = 0;
        if (hipGetDevice(&dev) != hipSuccess || hipDeviceGetAttribute(&cus, hipDeviceAttributeMultiprocessorCount, dev) != hipSuccess) { grid = -1; return; }
        if (hipFuncSetAttribute((const void*)fwd, hipFuncAttributeMaxDynamicSharedMemorySize, LDS_BYTES) != hipSuccess) { fprintf(stderr, "kernel_launch: hipFuncSetAttribute failed\n"); grid = -1; return; }
        int per_cu = 0;
        (void)hipOccupancyMaxActiveBlocksPerMultiprocessor(&per_cu, (const void*)fwd, NTHREADS, LDS_BYTES);
        (void)hipGetLastError();
        grid = cus;
        if (grid < 64) { fprintf(stderr, "kernel_launch: needs >= 64 CUs\n"); grid = -1; return; }
    }
    if (grid < 0) return;
    (void)hipMemsetAsync((char*)d_ws + WS_CTL, 0, CTL_ZERO_BYTES, stream);
    Args a{};
    for (int i = 0; i < 35; ++i) a.in[i] = (const float*)d_in[i];
    a.out = (float*)d_out; a.ws = (unsigned char*)d_ws;
#if 0
    for (int p = 0; p < NPHASE; ++p) { a.ph_lo = p; a.ph_hi = p + 1; hipLaunchKernelGGL(fwd, dim3(grid), dim3(NTHREADS), LDS_BYTES, stream, a); }
#else
    a.ph_lo = 0; a.ph_hi = NPHASE; hipLaunchKernelGGL(fwd, dim3(grid), dim3(NTHREADS), LDS_BYTES, stream, a);
#endif
}
```

```cpp
#include <hip/hip_runtime.h>
#include <cstdio>
#include <cstdint>

typedef unsigned short bf16_t;
#define LAS __attribute__((address_space(3)))
typedef float f32x4 __attribute__((ext_vector_type(4)));
typedef short bf16x8_t __attribute__((ext_vector_type(8)));
typedef unsigned u32x4_t __attribute__((ext_vector_type(4)));
typedef unsigned u32x2_t __attribute__((ext_vector_type(2)));

constexpr int NTOK = 32768, SEQ = 8192, NBATCH = 4, DM = 1024;
constexpr int ABC = 2816, RWC = 1792;
constexpr int NEXP = 32, FF = 512;
constexpr int NASG = NTOK * 2;
constexpr int MOE_TM = 256;
constexpr int MOE_CAP = NTOK;
constexpr int MAXROWS = NASG + NEXP * MOE_TM;
constexpr int NTHREADS = 512;
constexpr int LDS_BYTES = 156 * 1024;
constexpr int LDS_MISC = 155 * 1024;

constexpr size_t MiB = 1024ull * 1024ull;
constexpr size_t WS_CTL = 0;
constexpr size_t CTL_ZERO_BYTES = 64 * 1024;
constexpr size_t WS_ROUTE = 64 * 1024;
constexpr size_t WS_WD = 8 * MiB;
constexpr size_t WD_ABIN = WS_WD, WD_ABOUT = WD_ABIN + (size_t)ABC * DM * 2, WD_CIN = WD_ABOUT + (size_t)DM * DM * 2, WD_COUT = WD_CIN + (size_t)4096 * DM * 2;
constexpr size_t WS_AR = 26 * MiB;
constexpr size_t WS_A = WS_AR;
constexpr size_t WS_B = WS_AR + 64 * MiB;
constexpr size_t WS_C = WS_B + 176 * MiB;
constexpr size_t WS_D = WS_C + 212 * MiB;
constexpr size_t DO_LRU = 112 * MiB;
constexpr size_t WS_XR = WS_AR + 360 * MiB;
constexpr size_t WS_WM = WS_AR + 64 * MiB;
constexpr size_t WM_GU1 = WS_A + 32 * MiB;
constexpr size_t WM_GU = WS_WM, WM_DN = WS_WM + (size_t)NEXP * DM * DM;
constexpr size_t WS_H = WS_WM + 96 * MiB;
constexpr size_t WS_Y = WS_H + 72 * MiB;
constexpr size_t WS_QFIG = WS_AR + 64 * MiB;
constexpr size_t WS_O = WS_QFIG + 256 * MiB;
constexpr size_t WS_MIX1 = WS_O + 128 * MiB;
constexpr size_t WS_LIST = WS_AR + 424 * MiB;
constexpr size_t WS_END = WS_AR + 516 * MiB;
static_assert(WS_D + 64 * MiB <= WS_END && WS_Y + 128 * MiB <= WS_END && WS_MIX1 + 64 * MiB <= WS_END, "arena");

constexpr size_t DO_VB = 0, DO_BON = 32 * MiB, DO_SG = 34 * MiB, DO_YR = 48 * MiB;

constexpr int CW_CNT = 8192;
constexpr int CW_WMAX = CW_CNT + 512;
constexpr int CW_COLMAX = CW_WMAX + 192;
constexpr float ACT_Q = 127.f / 6.f;
constexpr size_t RT_ASG_E = 0;
constexpr size_t RT_ASG_RANK = RT_ASG_E + NASG * 4;
constexpr size_t RT_ASG_GATE = RT_ASG_RANK + NASG * 4;
constexpr size_t RT_ROW_TOK = RT_ASG_GATE + NASG * 4;
constexpr size_t RT_ROW_SLOT = RT_ROW_TOK + MAXROWS * 4;
constexpr size_t RT_ROW_GATE = RT_ROW_SLOT + MAXROWS * 4;
constexpr size_t RT_LRU_CH = RT_ROW_GATE + MAXROWS * 4;
constexpr size_t RT_LRU_CA = RT_LRU_CH + 512 * 512 * 4;
constexpr size_t RT_LRU_CIN = RT_LRU_CA + 512 * 512 * 4;
constexpr size_t RT_END = RT_LRU_CIN + 512 * 512 * 4;
constexpr size_t WS_FRAG = 6 * MiB;
constexpr size_t FG_RT = WS_FRAG + 393216;
constexpr size_t FG_W2 = WS_FRAG, FG_A2 = FG_W2 + 65536, FG_WA = FG_A2 + 65536, FG_WX = FG_WA + 65536, FG_G2 = FG_WX + 65536;
static_assert(WS_ROUTE + RT_END <= 6 * MiB, "routing arrays overflow");

__device__ __forceinline__ float bf2f(bf16_t v) { return __uint_as_float(((unsigned)v) << 16); }
typedef __bf16 bf16x2_hw __attribute__((ext_vector_type(2)));
typedef float f32x2_hw __attribute__((ext_vector_type(2)));
__device__ __forceinline__ unsigned pk2(float lo, float hi) { const f32x2_hw v = {lo, hi}; const bf16x2_hw b = __builtin_convertvector(v, bf16x2_hw); return __builtin_bit_cast(unsigned, b); }
__device__ __forceinline__ bf16_t f2bf(float f) { const __bf16 b = (__bf16)f; return __builtin_bit_cast(bf16_t, b); }
template <int CTRL> __device__ __forceinline__ float dpp_(float x) { return __builtin_bit_cast(float, __builtin_amdgcn_mov_dpp(__builtin_bit_cast(int, x), CTRL, 0xf, 0xf, true)); }
__device__ __forceinline__ float row16_sum(float v) {
    v += dpp_<0xB1>(v); v += dpp_<0x4E>(v); v += dpp_<0x124>(v); v += dpp_<0x128>(v); return v; }
__device__ __forceinline__ float xrow16_sum(float x) {
    auto s = __builtin_amdgcn_permlane16_swap(__float_as_uint(x), __float_as_uint(x), false, false);
    x = __uint_as_float(s[0]) + __uint_as_float(s[1]);
    auto t = __builtin_amdgcn_permlane32_swap(__float_as_uint(x), __float_as_uint(x), false, false);
    return __uint_as_float(t[0]) + __uint_as_float(t[1]); }
__device__ __forceinline__ float xrow32_sum(float x) {
    auto s = __builtin_amdgcn_permlane16_swap(__float_as_uint(x), __float_as_uint(x), false, false);
    return __uint_as_float(s[0]) + __uint_as_float(s[1]); }
__device__ __forceinline__ float wave_sum(float v) { return xrow16_sum(row16_sum(v)); }
__device__ __forceinline__ float sigmoidf_(float x) { return 1.f / (1.f + __expf(-x)); }
__device__ __forceinline__ float softplusf_(float x) { return fmaxf(x, 0.f) + log1pf(__expf(-fabsf(x))); }
__device__ __forceinline__ float siluf_(float x) { return x * sigmoidf_(x); }
__device__ __forceinline__ float gelu_tanhf_(float x) { const float c = 0.7978845608028654f; return 0.5f * x * (1.f + tanhf(c * (x + 0.044715f * x * x * x))); }

struct Args {
    const float* in[35];
    float* out;
    unsigned char* ws;
    int ph_lo, ph_hi;
};

#define XB_TMO      128
#define XB_XCNT(j)  (256  + 64 * (j))
#define XB_XSUB(j)  (1280 + 64 * (j))
#define XB_XGEN(j)  (2304 + 64 * (j))
#define XB_TOP      3328
#define XB_TOPGEN   3392
#define XCD_BAR_WORDS 3456
#define XB_SPIN_CAP (1u << 18)
__device__ __forceinline__ unsigned xb_ld(unsigned* p)              { return __hip_atomic_load(p, __ATOMIC_RELAXED, __HIP_MEMORY_SCOPE_AGENT); }
__device__ __forceinline__ unsigned xb_add(unsigned* p, unsigned v) { return __hip_atomic_fetch_add(p, v, __ATOMIC_RELAXED, __HIP_MEMORY_SCOPE_AGENT); }
__device__ __forceinline__ unsigned xb_xcc_id() { return (unsigned)__builtin_amdgcn_s_getreg((3 << 11) | 20) & 0xFu; }
#define XB_SPIN(cond, bar) do { unsigned _sp = 0; while (cond) { __builtin_amdgcn_s_sleep(1); \
    if ((++_sp & 255u) == 0u) { if (xb_ld(&(bar)[XB_TMO])) break; if (_sp > XB_SPIN_CAP) { atomicAdd(&(bar)[XB_TMO], 1u); break; } } } } while (0)
struct XcdBarrier { unsigned* bar; unsigned x; volatile LAS unsigned* st; };
__device__ __forceinline__ XcdBarrier xcd_barrier_post(unsigned* bar, volatile LAS unsigned* st) {
    XcdBarrier b; b.bar = bar; b.x = xb_xcc_id(); b.st = st;
    if (threadIdx.x == 0) (void)xb_add(&bar[XB_XCNT(b.x)], 1u);
    return b;
}
__device__ __forceinline__ void xcd_barrier_complete(unsigned* bar, unsigned x, unsigned& nloc, unsigned& nx) {
    const unsigned G = gridDim.x * gridDim.y * gridDim.z;
    unsigned sum, cnt, mine, sp = 0u;
    for (;;) {
        sum = 0u; cnt = 0u; mine = 0u;
#pragma unroll
        for (unsigned j = 0; j < 16; ++j) { const unsigned c = xb_ld(&bar[XB_XCNT(j)]); sum += c; cnt += (c > 0u) ? 1u : 0u; mine = (j == x) ? c : mine; }
        if (sum == G) break;
        __builtin_amdgcn_s_sleep(1);
        if ((++sp & 255u) == 0u) { if (xb_ld(&bar[XB_TMO])) break; if (sp > XB_SPIN_CAP) { atomicAdd(&bar[XB_TMO], 1u); break; } }
    }
    nloc = mine > 0u ? mine : 1u; nx = cnt > 0u ? cnt : 1u;
}
__device__ __forceinline__ void xcd_barrier(const XcdBarrier& b) {
    asm volatile("s_waitcnt vmcnt(0)" ::: "memory");
    __syncthreads();
    if (threadIdx.x == 0) {
        unsigned* bar = b.bar;
        __builtin_amdgcn_s_waitcnt(0);
        unsigned nloc = b.st[0], nx = b.st[1];
        if (nloc == 0u) { xcd_barrier_complete(bar, b.x, nloc, nx); b.st[0] = nloc; b.st[1] = nx; }
        const unsigned old = xb_add(&bar[XB_XSUB(b.x)], 1u);
        const unsigned gen = old / nloc;
        if (old + 1u == (gen + 1u) * nloc) {
            __builtin_amdgcn_fence(__ATOMIC_RELEASE, "agent");
            asm volatile("s_waitcnt vmcnt(0)" ::: "memory");
            const unsigned og = xb_add(&bar[XB_TOP], 1u);
            const unsigned tg = og / nx;
            if (og + 1u == (tg + 1u) * nx) xb_add(&bar[XB_TOPGEN], 1u);
            else XB_SPIN(xb_ld(&bar[XB_TOPGEN]) == tg, bar);
            __builtin_amdgcn_fence(__ATOMIC_ACQUIRE, "agent");
            xb_add(&bar[XB_XGEN(b.x)], 1u);
            asm volatile("s_waitcnt vmcnt(0)" ::: "memory");
        } else {
            XB_SPIN(xb_ld(&bar[XB_XGEN(b.x)]) == gen, bar);
            __builtin_amdgcn_fence(__ATOMIC_ACQUIRE, "agent");
            asm volatile("s_waitcnt vmcnt(0)" ::: "memory");
        }
    }
    __syncthreads();
}

namespace pg8 {
typedef short bf16x8 __attribute__((ext_vector_type(8)));
typedef unsigned u32x4 __attribute__((ext_vector_type(4)));
typedef int v4i_t __attribute__((ext_vector_type(4)));
constexpr int BM = 256, BK = 64, HALF = 128, HTB = HALF * BK * 2, STAGE_BYTES = 8 * HTB, NXCD = 8, WGM = 8;
__device__ __forceinline__ int lds_byte(int r, int c) { const int st = (r >> 4) * 2 + (c >> 5), rr = r & 15, cc = c & 31, ob = rr * 64 + cc * 2; return st * 1024 + (ob ^ (((ob >> 9) & 1) << 5)); }
__device__ __forceinline__ void stage_rc(int b, int& R, int& C) { const int st = b / 1024, sb = b % 1024, swz = sb ^ (((sb >> 9) & 1) << 5); R = (st >> 1) * 16 + swz / 64; C = (st & 1) * 32 + (swz % 64) / 2; }
__device__ __forceinline__ int perm32(int rho) { const int n = rho >> 4, i = rho & 15; return 8 * (i >> 2) + 4 * n + (i & 3); }
__device__ __forceinline__ unsigned cvt_pk_bf16(float lo, float hi) { unsigned r; asm volatile("v_cvt_pk_bf16_f32 %0, %1, %2" : "=v"(r) : "v"(lo), "v"(hi)); return r; }

struct Unit { int pm, pn; const char* B; int off, nval, e; };

struct DenseOrder {
    int nM, nN, nwg, G, c; const char* Bt; size_t bstep;
    __device__ void init(int M, int N, int K, int G_, int c_, const void* Bt_) { nM = M / BM; nN = N / BM; nwg = nM * nN; G = G_; c = c_; Bt = (const char*)Bt_; bstep = (size_t)BM * K * 2; }
    __device__ bool next(int i, Unit& u) const {
        const long L = (long)i * G + c; if (L >= nwg) return false;
        int wgid = (int)L; { const int q = nwg / NXCD, r = nwg % NXCD, xcd = wgid % NXCD, off = wgid / NXCD; wgid = (xcd < r ? xcd * (q + 1) : r * (q + 1) + (xcd - r) * q) + off; }
        const int nig = WGM * nN, gid = wgid / nig, fm = gid * WGM, gsz = (nM - fm) < WGM ? (nM - fm) : WGM;
        u.pm = fm + ((wgid % nig) % gsz); u.pn = (wgid % nig) / gsz; u.B = Bt + (size_t)u.pn * bstep; return true;
    }
    __device__ __forceinline__ int arow(const Unit& u, int r) const { return u.pm * BM + r; }
};
struct MoeOrder {
    int G, c, nN, ntiles; const LAS int* pst; const unsigned* cnt; const int* rowslot; const char* Bt; size_t estep, bstep;
    __device__ bool next(int i, Unit& u) const {
        const int cc = (G % NXCD == 0) ? (c % NXCD) * (G / NXCD) + c / NXCD : c;
        const int L = i * G + cc; if (L >= ntiles * nN) return false;
        u.pm = L / nN; u.pn = L % nN; const int row0 = u.pm * BM; int e = 0;
#pragma unroll
        for (int st = NEXP / 2; st > 0; st >>= 1) if (row0 >= pst[e + st]) e += st;
        const int t0 = row0 - pst[e];
        u.e = e; u.off = e * MOE_CAP + t0; u.nval = (int)cnt[e] - t0;
        u.B = Bt + (size_t)e * estep + (size_t)u.pn * bstep; return true;
    }
    __device__ __forceinline__ int arow(const Unit& u, int r) const { if (!rowslot) return u.pm * BM + r; return r < u.nval ? (rowslot[u.off + r] >> 1) : 0; }
};

struct EpiBf16I { static constexpr bool PERM = true; bf16_t* O; int ldc; const float* rowscale; const unsigned* colmax;
    __device__ __forceinline__ void operator()(const f32x4 (&acc)[2][2][4][2], const Unit& u, int wr, int wc, int fr, int fq) const {
        const int row0 = u.pm * BM + wr * 64 + fr, col0 = u.pn * BM + wc * 32 + 8 * fq;
        float rsc[8]; f32x4 cs[2][2];
#pragma unroll
        for (int q = 0; q < 8; ++q) rsc[q] = rowscale[row0 + (q >> 2) * HALF + (q & 3) * 16] * (1.f / 127.f);
#pragma unroll
        for (int bj = 0; bj < 2; ++bj)
#pragma unroll
            for (int n = 0; n < 2; ++n) { const u32x4 c4 = *(const u32x4*)(colmax + col0 + bj * HALF + 4 * n); cs[bj][n] = (f32x4){__uint_as_float(c4.x), __uint_as_float(c4.y), __uint_as_float(c4.z), __uint_as_float(c4.w)} * (1.f / 127.f); }
#pragma unroll
        for (int ai = 0; ai < 2; ++ai)
#pragma unroll
            for (int m = 0; m < 4; ++m) { bf16_t* rowp = O + (size_t)(row0 + ai * HALF + m * 16) * ldc + col0; const float rs = rsc[ai * 4 + m];
#pragma unroll
                for (int bj = 0; bj < 2; ++bj) { const v4i_t i0 = __builtin_bit_cast(v4i_t, acc[ai][bj][m][0]), i1 = __builtin_bit_cast(v4i_t, acc[ai][bj][m][1]);
                    const f32x4 s0 = cs[bj][0] * rs, s1 = cs[bj][1] * rs;
                    u32x4 w; w.x = cvt_pk_bf16((float)i0[0] * s0[0], (float)i0[1] * s0[1]); w.y = cvt_pk_bf16((float)i0[2] * s0[2], (float)i0[3] * s0[3]);
                    w.z = cvt_pk_bf16((float)i1[0] * s1[0], (float)i1[1] * s1[1]); w.w = cvt_pk_bf16((float)i1[2] * s1[2], (float)i1[3] * s1[3]);
                    *(u32x4*)(rowp + bj * HALF) = w; } }
    } };
struct EpiBf16IT { static constexpr bool PERM = true; bf16_t* O; int nf; const float* tokscale; const unsigned* chmax;
    __device__ __forceinline__ void operator()(const f32x4 (&acc)[2][2][4][2], const Unit& u, int wr, int wc, int fr, int fq) const {
        const int row0 = u.pm * BM + wr * 64 + fr, col0 = u.pn * BM + wc * 32 + 8 * fq;
        float rsc[8]; f32x4 cs[2][2];
#pragma unroll
        for (int q = 0; q < 8; ++q) rsc[q] = __uint_as_float(chmax[row0 + (q >> 2) * HALF + (q & 3) * 16]) * (1.f / 127.f);
#pragma unroll
        for (int bj = 0; bj < 2; ++bj)
#pragma unroll
            for (int n = 0; n < 2; ++n) cs[bj][n] = *(const f32x4*)(tokscale + col0 + bj * HALF + 4 * n) * (1.f / 127.f);
#pragma unroll
        for (int ai = 0; ai < 2; ++ai)
#pragma unroll
            for (int m = 0; m < 4; ++m) { const int nidx = row0 + ai * HALF + m * 16; const float rs = rsc[ai * 4 + m];
#pragma unroll
                for (int bj = 0; bj < 2; ++bj) { const v4i_t i0 = __builtin_bit_cast(v4i_t, acc[ai][bj][m][0]), i1 = __builtin_bit_cast(v4i_t, acc[ai][bj][m][1]);
                    const f32x4 s0 = cs[bj][0] * rs, s1 = cs[bj][1] * rs; const int tok0 = col0 + bj * HALF;
                    u32x4 w; w.x = cvt_pk_bf16((float)i0[0] * s0[0], (float)i0[1] * s0[1]); w.y = cvt_pk_bf16((float)i0[2] * s0[2], (float)i0[3] * s0[3]);
                    w.z = cvt_pk_bf16((float)i1[0] * s1[0], (float)i1[1] * s1[1]); w.w = cvt_pk_bf16((float)i1[2] * s1[2], (float)i1[3] * s1[3]);
                    *(u32x4*)(O + ((size_t)(tok0 >> 4) * nf + nidx) * 16 + (tok0 & 8)) = w; } }
    } };
struct EpiBf16 { static constexpr bool PERM = true; bf16_t* O; int ldc;
    __device__ __forceinline__ void operator()(const f32x4 (&acc)[2][2][4][2], const Unit& u, int wr, int wc, int fr, int fq) const {
        const int row0 = u.pm * BM + wr * 64 + fr, col0 = u.pn * BM + wc * 32 + 8 * fq;
#pragma unroll
        for (int ai = 0; ai < 2; ++ai)
#pragma unroll
            for (int m = 0; m < 4; ++m) { bf16_t* rowp = O + (size_t)(row0 + ai * HALF + m * 16) * ldc + col0;
#pragma unroll
                for (int bj = 0; bj < 2; ++bj) { const f32x4 v0 = acc[ai][bj][m][0], v1 = acc[ai][bj][m][1];
                    u32x4 w; w.x = cvt_pk_bf16(v0[0], v0[1]); w.y = cvt_pk_bf16(v0[2], v0[3]); w.z = cvt_pk_bf16(v1[0], v1[1]); w.w = cvt_pk_bf16(v1[2], v1[3]);
                    *(u32x4*)(rowp + bj * HALF) = w; } }
    } };
template <bool XF32> struct EpiResid { static constexpr bool PERM = true; const void* __restrict__ X; bf16_t* __restrict__ O;
    __device__ __forceinline__ void operator()(const f32x4 (&acc)[2][2][4][2], const Unit& u, int wr, int wc, int fr, int fq) const {
        const int row0 = u.pm * BM + wr * 64 + fr, col0 = u.pn * BM + wc * 32 + 8 * fq;
        if constexpr (XF32) {
#pragma unroll
            for (int ai = 0; ai < 2; ++ai)
#pragma unroll
                for (int mp = 0; mp < 2; ++mp) { f32x4 x[2][2][2];
#pragma unroll
                    for (int mm = 0; mm < 2; ++mm)
#pragma unroll
                        for (int bj = 0; bj < 2; ++bj) { const float* xp = (const float*)X + (size_t)(row0 + ai * HALF + (mp * 2 + mm) * 16) * DM + col0 + bj * HALF; x[mm][bj][0] = *(const f32x4*)xp; x[mm][bj][1] = *(const f32x4*)(xp + 4); }
#pragma unroll
                    for (int mm = 0; mm < 2; ++mm)
#pragma unroll
                        for (int bj = 0; bj < 2; ++bj) { const f32x4 v0 = x[mm][bj][0] + acc[ai][bj][mp * 2 + mm][0], v1 = x[mm][bj][1] + acc[ai][bj][mp * 2 + mm][1];
                            u32x4 w; w.x = cvt_pk_bf16(v0[0], v0[1]); w.y = cvt_pk_bf16(v0[2], v0[3]); w.z = cvt_pk_bf16(v1[0], v1[1]); w.w = cvt_pk_bf16(v1[2], v1[3]);
                            *(u32x4*)(O + (size_t)(row0 + ai * HALF + (mp * 2 + mm) * 16) * DM + col0 + bj * HALF) = w; } }
        } else {
#pragma unroll
            for (int ai = 0; ai < 2; ++ai) { u32x4 x[4][2];
#pragma unroll
                for (int m = 0; m < 4; ++m)
#pragma unroll
                    for (int bj = 0; bj < 2; ++bj) x[m][bj] = *(const u32x4*)((const bf16_t*)X + (size_t)(row0 + ai * HALF + m * 16) * DM + col0 + bj * HALF);
#pragma unroll
                for (int m = 0; m < 4; ++m)
#pragma unroll
                    for (int bj = 0; bj < 2; ++bj) { const u32x4 o = x[m][bj];
                        const f32x4 v0 = (f32x4){__uint_as_float(o.x << 16), __uint_as_float(o.x & 0xffff0000u), __uint_as_float(o.y << 16), __uint_as_float(o.y & 0xffff0000u)} + acc[ai][bj][m][0];
                        const f32x4 v1 = (f32x4){__uint_as_float(o.z << 16), __uint_as_float(o.z & 0xffff0000u), __uint_as_float(o.w << 16), __uint_as_float(o.w & 0xffff0000u)} + acc[ai][bj][m][1];
                        u32x4 w; w.x = cvt_pk_bf16(v0[0], v0[1]); w.y = cvt_pk_bf16(v0[2], v0[3]); w.z = cvt_pk_bf16(v1[0], v1[1]); w.w = cvt_pk_bf16(v1[2], v1[3]);
                        *(u32x4*)(O + (size_t)(row0 + ai * HALF + m * 16) * DM + col0 + bj * HALF) = w; } }
        }
    } };
struct EpiSwiGLU { static constexpr bool PERM = true; bf16_t* H; const unsigned* wmax;
    __device__ __forceinline__ void operator()(const f32x4 (&acc)[2][2][4][2], const Unit& u, int wr, int wc, int fr, int fq) const {
        const int row0 = u.pm * BM + wr * 64 + fr, col0 = u.pn * HALF + wc * 32 + 8 * fq;
        const float s0 = __uint_as_float(wmax[2 * u.e]) * (1.f / (127.f * ACT_Q)), s1 = __uint_as_float(wmax[2 * u.e + 1]) * (1.f / (127.f * ACT_Q));
#pragma unroll
        for (int ai = 0; ai < 2; ++ai)
#pragma unroll
            for (int m = 0; m < 4; ++m) { float h[8];
#pragma unroll
                for (int n = 0; n < 2; ++n) { const v4i_t gi = __builtin_bit_cast(v4i_t, acc[ai][0][m][n]), ui = __builtin_bit_cast(v4i_t, acc[ai][1][m][n]);
#pragma unroll
                    for (int j = 0; j < 4; ++j) { const float g = (float)gi[j] * s0; h[n * 4 + j] = g * __builtin_amdgcn_rcpf(1.f + __expf(-g)) * ((float)ui[j] * s1); } }
                u32x4 w; w.x = cvt_pk_bf16(h[0], h[1]); w.y = cvt_pk_bf16(h[2], h[3]); w.z = cvt_pk_bf16(h[4], h[5]); w.w = cvt_pk_bf16(h[6], h[7]);
                *(u32x4*)(H + (size_t)(row0 + ai * HALF + m * 16) * FF + col0) = w; }
    } };
struct EpiDown { static constexpr bool PERM = true; bf16_t* Y; const int* list_slot; const float* list_gate;
    __device__ __forceinline__ void operator()(const f32x4 (&acc)[2][2][4][2], const Unit& u, int wr, int wc, int fr, int fq) const {
        const int rl0 = wr * 64 + fr, col0 = u.pn * BM + wc * 32 + 8 * fq;
        int tk[8], sl[8]; float gt[8];
#pragma unroll
        for (int q = 0; q < 8; ++q) { const int r = rl0 + (q >> 2) * HALF + (q & 3) * 16; sl[q] = list_slot[u.off + r]; gt[q] = list_gate[u.off + r]; tk[q] = (r < u.nval) ? 0 : -1; }
#pragma unroll
        for (int ai = 0; ai < 2; ++ai)
#pragma unroll
            for (int m = 0; m < 4; ++m) { const int q = ai * 4 + m;
                if (tk[q] < 0) continue;
                bf16_t* rowp = Y + (size_t)sl[q] * DM + col0;
#pragma unroll
                for (int bj = 0; bj < 2; ++bj) { const f32x4 v0 = acc[ai][bj][m][0] * gt[q], v1 = acc[ai][bj][m][1] * gt[q];
                    u32x4 w; w.x = cvt_pk_bf16(v0[0], v0[1]); w.y = cvt_pk_bf16(v0[2], v0[3]); w.z = cvt_pk_bf16(v1[0], v1[1]); w.w = cvt_pk_bf16(v1[2], v1[3]);
                    *(u32x4*)(rowp + bj * HALF) = w; } }
    } };

template <class Epi, class Sched, bool I8 = false>
__device__ __forceinline__ void gemm_phase(LAS unsigned char* lds, const char* A, const unsigned lda_b, const int K, const Sched& S, const Epi& E) {
    const int tid = threadIdx.x, wid = __builtin_amdgcn_readfirstlane(tid >> 6), lane = tid & 63, wr = wid >> 2, wc = wid & 3, fr = lane & 15, fq = lane >> 4;
    const int nt = K / BK;
    unsigned voffB[2];
#pragma unroll
    for (int i = 0; i < 2; ++i) { int R, C; stage_rc(tid * 16 + i * 8192, R, C); const int Rb = Epi::PERM ? ((R & ~31) + perm32(R & 31)) : R; voffB[i] = (unsigned)(Rb * K + C) * 2u; }
    const size_t kstep = (size_t)(BK * 2);
    const size_t hstepB = (size_t)HALF * K * 2;
    const unsigned ldsw = (unsigned)wid * 1024u;
    const int aoff = lds_byte(wr * 64 + fr, fq * 8), boff = lds_byte(wc * 32 + fr, fq * 8);
#define PG8_SA(b, h) (((b) * 2 + (h)) * HTB)
#define PG8_SB(b, h) ((4 + (b) * 2 + (h)) * HTB)
#define PG8_STAGE(bufoff, gbase, voff) do { _Pragma("unroll") for (int _i = 0; _i < 2; ++_i) \
        __builtin_amdgcn_global_load_lds((const unsigned*)((const char*)(gbase) + (voff)[_i]), (LAS unsigned*)(lds + (bufoff) + ldsw + _i * 8192), 16, 0, 0); } while (0)
#define PG8_LDA(dst, b, h) do { _Pragma("unroll") for (int m = 0; m < 4; ++m) _Pragma("unroll") for (int k = 0; k < 2; ++k) dst[m][k] = *(const LAS bf16x8*)(lds + PG8_SA(b, h) + aoff + m * 2048 + k * 1024); } while (0)
#define PG8_LDB(dst, b, h) do { _Pragma("unroll") for (int n = 0; n < 2; ++n) _Pragma("unroll") for (int k = 0; k < 2; ++k) dst[n][k] = *(const LAS bf16x8*)(lds + PG8_SB(b, h) + boff + n * 2048 + k * 1024); } while (0)
#define PG8_MMA(ai, bj, At, Bt) do { __builtin_amdgcn_s_setprio(1); _Pragma("unroll") for (int m = 0; m < 4; ++m) _Pragma("unroll") for (int n = 0; n < 2; ++n) _Pragma("unroll") for (int k = 0; k < 2; ++k) { \
        if constexpr (I8) acc[ai][bj][m][n] = __builtin_bit_cast(f32x4, __builtin_amdgcn_mfma_i32_16x16x64_i8(__builtin_bit_cast(v4i_t, Bt[n][k]), __builtin_bit_cast(v4i_t, At[m][k]), __builtin_bit_cast(v4i_t, acc[ai][bj][m][n]), 0, 0, 0)); \
        else acc[ai][bj][m][n] = __builtin_amdgcn_mfma_f32_16x16x32_bf16(Bt[n][k], At[m][k], acc[ai][bj][m][n], 0, 0, 0); } __builtin_amdgcn_s_setprio(0); } while (0)
#define PG8_WAIT_V(n) asm volatile("s_waitcnt vmcnt(" #n ")" ::: "memory")
#define PG8_WAIT_L(n) asm volatile("s_waitcnt lgkmcnt(" #n ")" ::: "memory")
#define PG8_BAR __builtin_amdgcn_s_barrier()
#define PG8_SCHED __builtin_amdgcn_sched_barrier(0)
#define PG8_AOFF(dst, u) do { int _tz = threadIdx.x; asm volatile("" : "+v"(_tz)); _Pragma("unroll") for (int _i = 0; _i < 2; ++_i) { int _R, _C; stage_rc(_tz * 16 + _i * 8192, _R, _C); \
        _Pragma("unroll") for (int _h = 0; _h < 2; ++_h) dst[_h][_i] = (unsigned)S.arow(u, _h * HALF + _R) * lda_b + (unsigned)_C * 2u; } } while (0)
    Unit cur, nxt; int ui = 0;
    if (!S.next(0, cur)) return;
    f32x4 acc[2][2][4][2];
#pragma unroll
    for (int a = 0; a < 2; ++a)
#pragma unroll
        for (int b = 0; b < 2; ++b)
#pragma unroll
            for (int m = 0; m < 4; ++m)
#pragma unroll
                for (int n = 0; n < 2; ++n) acc[a][b][m][n] = (f32x4){0.f, 0.f, 0.f, 0.f};
    bf16x8 At[4][2], B0[2][2], B1[2][2];
    unsigned vA[2][2], vAn[2][2];
    PG8_AOFF(vA, cur);
    const char* cB = cur.B;
    PG8_STAGE(PG8_SB(0, 0), cB, voffB); PG8_STAGE(PG8_SA(0, 0), A, vA[0]); PG8_STAGE(PG8_SB(0, 1), cB + hstepB, voffB); PG8_STAGE(PG8_SA(0, 1), A, vA[1]);
    if (wr == 1) PG8_BAR;
    PG8_WAIT_V(4); PG8_BAR;
    PG8_STAGE(PG8_SB(1, 0), cB + kstep, voffB); PG8_STAGE(PG8_SA(1, 0), A + kstep, vA[0]); PG8_STAGE(PG8_SB(1, 1), cB + hstepB + kstep, voffB);
    PG8_WAIT_V(6); PG8_BAR;
    for (;;) {
        const bool has_next = S.next(ui + 1, nxt);
        if (has_next) { PG8_AOFF(vAn, nxt); } else {
#pragma unroll
            for (int h = 0; h < 2; ++h)
#pragma unroll
                for (int i = 0; i < 2; ++i) vAn[h][i] = vA[h][i]; }
        const char* nB = has_next ? nxt.B : cB;
        for (int t = 0; t < nt; t += 2) {
            const bool last = (t == nt - 2);
            const char* a1 = A + (size_t)(t + 1) * kstep;
            const char* a2 = last ? A : A + (size_t)(t + 2) * kstep; const char* b2 = last ? nB : cB + (size_t)(t + 2) * kstep;
            const char* a3 = a2 + kstep; const char* b3 = b2 + kstep;
            unsigned o2[2][2];
#pragma unroll
            for (int h = 0; h < 2; ++h)
#pragma unroll
                for (int i = 0; i < 2; ++i) o2[h][i] = last ? vAn[h][i] : vA[h][i];
            PG8_LDB(B0, 0, 0); PG8_SCHED; PG8_LDA(At, 0, 0); PG8_STAGE(PG8_SA(1, 1), a1, vA[1]);
            PG8_WAIT_L(8); PG8_BAR; PG8_WAIT_L(0); PG8_MMA(0, 0, At, B0); PG8_BAR; PG8_SCHED;
            PG8_LDB(B1, 0, 1); PG8_STAGE(PG8_SB(0, 0), b2, voffB);
            PG8_BAR; PG8_WAIT_L(0); PG8_MMA(0, 1, At, B1); PG8_BAR;
            PG8_LDA(At, 0, 1); PG8_STAGE(PG8_SA(0, 0), a2, o2[0]);
            PG8_BAR; PG8_WAIT_L(0); PG8_MMA(1, 0, At, B0); PG8_BAR; PG8_SCHED;
            PG8_STAGE(PG8_SB(0, 1), b2 + hstepB, voffB);
            PG8_WAIT_V(6); PG8_BAR; PG8_MMA(1, 1, At, B1); PG8_BAR;
            PG8_LDB(B0, 1, 0); PG8_SCHED; PG8_LDA(At, 1, 0); PG8_STAGE(PG8_SA(0, 1), a2, o2[1]);
            PG8_WAIT_L(8); PG8_BAR; PG8_WAIT_L(0); PG8_MMA(0, 0, At, B0); PG8_BAR; PG8_SCHED;
            PG8_LDB(B1, 1, 1); PG8_STAGE(PG8_SB(1, 0), b3, voffB);
            PG8_BAR; PG8_WAIT_L(0); PG8_MMA(0, 1, At, B1); PG8_BAR;
            PG8_LDA(At, 1, 1); PG8_STAGE(PG8_SA(1, 0), a3, o2[0]);
            PG8_BAR; PG8_WAIT_L(0); PG8_MMA(1, 0, At, B0); PG8_BAR; PG8_SCHED;
            PG8_STAGE(PG8_SB(1, 1), b3 + hstepB, voffB);
            PG8_WAIT_V(6); PG8_BAR; PG8_MMA(1, 1, At, B1); PG8_BAR;
        }
        E(acc, cur, wr, wc, fr, fq);
        if (!has_next) break;
#pragma unroll
        for (int a = 0; a < 2; ++a)
#pragma unroll
            for (int b = 0; b < 2; ++b)
#pragma unroll
                for (int m = 0; m < 4; ++m)
#pragma unroll
                    for (int n = 0; n < 2; ++n) acc[a][b][m][n] = (f32x4){0.f, 0.f, 0.f, 0.f};
        cur = nxt; cB = nB; ++ui;
#pragma unroll
        for (int h = 0; h < 2; ++h)
#pragma unroll
            for (int i = 0; i < 2; ++i) vA[h][i] = vAn[h][i];
    }
    PG8_WAIT_V(0);
    if (wr == 0) PG8_BAR;
    PG8_BAR;
#undef PG8_SA
#undef PG8_SB
#undef PG8_STAGE
#undef PG8_LDA
#undef PG8_LDB
#undef PG8_MMA
#undef PG8_WAIT_V
#undef PG8_WAIT_L
#undef PG8_BAR
#undef PG8_SCHED
#undef PG8_AOFF
}
}

template <int MODE>
__device__ __forceinline__ void transpose_item(const float* W, int K, int N, bf16_t* WT, LAS float* scr, int item, int lane) {
    const int nblk = N / 64, kb = item / nblk, nb = item % nblk, k0 = 64 * kb, n0 = 64 * nb;
    const int lr = lane >> 4, lc = (lane & 15) * 4;
    float4 v[16];
#pragma unroll
    for (int i = 0; i < 16; ++i) v[i] = *(const float4*)(W + (size_t)(k0 + 4 * i + lr) * N + n0 + lc);
#pragma unroll
    for (int i = 0; i < 16; ++i) { LAS float* d = scr + (4 * i + lr) * 66 + lc; *(LAS f32x2_hw*)d = (f32x2_hw){v[i].x, v[i].y}; *(LAS f32x2_hw*)(d + 2) = (f32x2_hw){v[i].z, v[i].w}; }
    asm volatile("s_waitcnt lgkmcnt(0)" ::: "memory");
    const int c = lane & 7;
#pragma unroll
    for (int j = 0; j < 8; ++j) { const int n = (lane >> 3) + 8 * j; const LAS float* sp = scr + (8 * c) * 66 + n;
        pg8::u32x4 o; o.x = pk2(sp[0 * 66], sp[1 * 66]); o.y = pk2(sp[2 * 66], sp[3 * 66]); o.z = pk2(sp[4 * 66], sp[5 * 66]); o.w = pk2(sp[6 * 66], sp[7 * 66]);
        const int nn = n0 + n; const int dr = MODE == 0 ? nn : (256 * (nn >> 7) + (nn & 127) + (MODE == 2 ? 128 : 0));
        *(pg8::u32x4*)(WT + (size_t)dr * K + k0 + 8 * c) = o; }
    asm volatile("s_waitcnt lgkmcnt(0)" ::: "memory");
}
__device__ __forceinline__ float wave_max(float v) {
    v = fmaxf(v, dpp_<0xB1>(v)); v = fmaxf(v, dpp_<0x4E>(v)); v = fmaxf(v, dpp_<0x124>(v)); v = fmaxf(v, dpp_<0x128>(v));
    auto s = __builtin_amdgcn_permlane16_swap(__float_as_uint(v), __float_as_uint(v), false, false); v = fmaxf(__uint_as_float(s[0]), __uint_as_float(s[1]));
    auto t = __builtin_amdgcn_permlane32_swap(__float_as_uint(v), __float_as_uint(v), false, false); return fmaxf(__uint_as_float(t[0]), __uint_as_float(t[1])); }
__device__ __forceinline__ unsigned q8x4(float a, float b, float c, float d, float qs) {
    const int ia = (int)rintf(fminf(fmaxf(a * qs, -127.f), 127.f)), ib = (int)rintf(fminf(fmaxf(b * qs, -127.f), 127.f)), ic = (int)rintf(fminf(fmaxf(c * qs, -127.f), 127.f)), id = (int)rintf(fminf(fmaxf(d * qs, -127.f), 127.f));
    return (unsigned)(ia & 255) | ((unsigned)(ib & 255) << 8) | ((unsigned)(ic & 255) << 16) | ((unsigned)(id & 255) << 24); }
__device__ __noinline__ void ph_wmax(const float* wg, const float* wu, unsigned* wmax, int bid, int nblk) {
    const int wave = threadIdx.x >> 6, lane = threadIdx.x & 63, gw = bid * 8 + wave, NGW = nblk * 8;
    constexpr int IT = (DM / 64) * (FF / 64);
    for (int it = gw; it < 2 * NEXP * 2 * IT; it += NGW) { const int mat = it / IT, tl = it % IT; const int le = mat >> 1, gu = mat & 1;
        const float* W = (gu ? wu : wg) + (size_t)le * DM * FF; const int k0 = 64 * (tl / (FF / 64)), n0 = 64 * (tl % (FF / 64));
        float m = 0.f;
#pragma unroll 4
        for (int i = 0; i < 16; ++i) { const float4 v = *(const float4*)(W + (size_t)(k0 + 4 * i + (lane >> 4)) * FF + n0 + (lane & 15) * 4); m = fmaxf(fmaxf(m, fmaxf(fabsf(v.x), fabsf(v.y))), fmaxf(fabsf(v.z), fabsf(v.w))); }
        m = wave_max(m);
        if (lane == 0) atomicMax(wmax + le * 2 + gu, __float_as_uint(m)); }
}
template <int MODE>
__device__ __forceinline__ void transpose_item_i8(const float* W, int K, int N, unsigned char* WT, LAS float* scr, int item, int lane, float qs) {
    const int nblk = N / 64, kb = item / nblk, nb = item % nblk, k0 = 64 * kb, n0 = 64 * nb;
    const int lr = lane >> 4, lc = (lane & 15) * 4;
    float4 v[16];
#pragma unroll
    for (int i = 0; i < 16; ++i) v[i] = *(const float4*)(W + (size_t)(k0 + 4 * i + lr) * N + n0 + lc);
#pragma unroll
    for (int i = 0; i < 16; ++i) { LAS float* d = scr + (4 * i + lr) * 66 + lc; *(LAS f32x2_hw*)d = (f32x2_hw){v[i].x, v[i].y}; *(LAS f32x2_hw*)(d + 2) = (f32x2_hw){v[i].z, v[i].w}; }
    asm volatile("s_waitcnt lgkmcnt(0)" ::: "memory");
    const int c = lane & 3;
#pragma unroll
    for (int j = 0; j < 4; ++j) { const int n = (lane >> 2) + 16 * j; const LAS float* sp = scr + (16 * c) * 66 + n;
        pg8::u32x4 o;
        o.x = q8x4(sp[0 * 66], sp[1 * 66], sp[2 * 66], sp[3 * 66], qs); o.y = q8x4(sp[4 * 66], sp[5 * 66], sp[6 * 66], sp[7 * 66], qs);
        o.z = q8x4(sp[8 * 66], sp[9 * 66], sp[10 * 66], sp[11 * 66], qs); o.w = q8x4(sp[12 * 66], sp[13 * 66], sp[14 * 66], sp[15 * 66], qs);
        const int nn = n0 + n; const int dr = MODE == 0 ? nn : (256 * (nn >> 7) + (nn & 127) + (MODE == 2 ? 128 : 0));
        *(pg8::u32x4*)(WT + (size_t)dr * K + k0 + 16 * c) = o; }
    asm volatile("s_waitcnt lgkmcnt(0)" ::: "memory");
}
__device__ __forceinline__ void transpose_item_i8c(const float* W, int K, int N, unsigned char* WT, LAS float* scr, int item, int lane, const unsigned* colmax) {
    const int nblk = N / 64, kb = item / nblk, nb = item % nblk, k0 = 64 * kb, n0 = 64 * nb;
    const int lr = lane >> 4, lc = (lane & 15) * 4;
    float4 v[16];
#pragma unroll
    for (int i = 0; i < 16; ++i) v[i] = *(const float4*)(W + (size_t)(k0 + 4 * i + lr) * N + n0 + lc);
#pragma unroll
    for (int i = 0; i < 16; ++i) { LAS float* d = scr + (4 * i + lr) * 66 + lc; *(LAS f32x2_hw*)d = (f32x2_hw){v[i].x, v[i].y}; *(LAS f32x2_hw*)(d + 2) = (f32x2_hw){v[i].z, v[i].w}; }
    asm volatile("s_waitcnt lgkmcnt(0)" ::: "memory");
    const int c = lane & 3;
#pragma unroll
    for (int j = 0; j < 4; ++j) { const int n = (lane >> 2) + 16 * j; const LAS float* sp = scr + (16 * c) * 66 + n;
        const float qs = 127.f / fmaxf(__uint_as_float(colmax[n0 + n]), 1e-30f);
        pg8::u32x4 o;
        o.x = q8x4(sp[0 * 66], sp[1 * 66], sp[2 * 66], sp[3 * 66], qs); o.y = q8x4(sp[4 * 66], sp[5 * 66], sp[6 * 66], sp[7 * 66], qs);
        o.z = q8x4(sp[8 * 66], sp[9 * 66], sp[10 * 66], sp[11 * 66], qs); o.w = q8x4(sp[12 * 66], sp[13 * 66], sp[14 * 66], sp[15 * 66], qs);
        *(pg8::u32x4*)(WT + (size_t)(n0 + n) * K + k0 + 16 * c) = o; }
    asm volatile("s_waitcnt lgkmcnt(0)" ::: "memory");
}
__device__ __forceinline__ void frag_build(const float* W, int ldw, int col0, int nks, bf16_t* dst, int lane) {
    const int q4 = lane >> 4, c16 = lane & 15;
    for (int ct = 0; ct < 4; ++ct) for (int ks = 0; ks < nks; ++ks) { float v[8];
#pragma unroll
        for (int jj = 0; jj < 8; ++jj) v[jj] = W[(size_t)(32 * ks + 8 * q4 + jj) * ldw + col0 + 16 * ct + c16];
        *(pg8::u32x4*)(dst + ((size_t)(ct * nks + ks) * 64 + lane) * 8) = (pg8::u32x4){pk2(v[0], v[1]), pk2(v[2], v[3]), pk2(v[4], v[5]), pk2(v[6], v[7])}; }
}
__device__ __forceinline__ void ph_cvt_frags(const Args& a) {
    const int wave = threadIdx.x >> 6, lane = threadIdx.x & 63, gw = blockIdx.x * 8 + wave;
    if (gw >= 40) {
        const int it = gw - 40; if (it >= 64) return;
        const int L = it >> 5, ks = it & 31, q4 = lane >> 4, c16 = lane & 15;
        const float* gain = a.in[2] + L * DM; const float* wg = a.in[28] + (size_t)L * DM * 4; const float* we = a.in[30] + (size_t)L * DM * 32;
        bf16_t* dh = (bf16_t*)(a.ws + FG_RT) + (size_t)L * 2 * 49152; bf16_t* dl = dh + 49152;
        for (int ct = 0; ct < 3; ++ct) { const int col = 16 * ct + c16; float hi[8], lo[8];
#pragma unroll
            for (int jj = 0; jj < 8; ++jj) { const int k = 32 * ks + 8 * q4 + jj; const float w = col < 4 ? wg[k * 4 + col] : (col < 36 ? we[k * 32 + col - 4] : 0.f); const float v = gain[k] * w;
                hi[jj] = bf2f(f2bf(v)); lo[jj] = v - hi[jj]; }
            const size_t o = ((size_t)(ks * 3 + ct) * 64 + lane) * 8;
            *(pg8::u32x4*)(dh + o) = (pg8::u32x4){pk2(hi[0], hi[1]), pk2(hi[2], hi[3]), pk2(hi[4], hi[5]), pk2(hi[6], hi[7])};
            *(pg8::u32x4*)(dl + o) = (pg8::u32x4){pk2(lo[0], lo[1]), pk2(lo[2], lo[3]), pk2(lo[4], lo[5]), pk2(lo[6], lo[7])}; }
        return; }
    const int arr = gw >> 3, h = gw & 7;
    if (arr == 0) frag_build(a.in[7], 512, 64 * h, 2, (bf16_t*)(a.ws + FG_W2) + h * 4096, lane);
    else if (arr == 1) frag_build(a.in[9], 512, 64 * h, 2, (bf16_t*)(a.ws + FG_A2) + h * 4096, lane);
    else if (arr == 2) frag_build(a.in[18] + h * 4096, 64, 0, 2, (bf16_t*)(a.ws + FG_WA) + h * 4096, lane);
    else if (arr == 3) frag_build(a.in[20] + h * 4096, 64, 0, 2, (bf16_t*)(a.ws + FG_WX) + h * 4096, lane);
    else frag_build(a.in[10], 512, 64 * h, 4, (bf16_t*)(a.ws + FG_G2) + h * 8192, lane);
}
__device__ __forceinline__ void ph_cvt_dense_a(const Args& a, LAS float* lds, unsigned* colmax, int bid, int nblk, int part) {
    const int wave = threadIdx.x >> 6, lane = threadIdx.x & 63, gw = bid * 8 + wave, NGW = nblk * 8;
    LAS float* scr = lds + wave * (64 * 66);
    constexpr int I0 = (DM / 64) * (ABC / 64), I1 = (DM / 64) * (DM / 64), I2 = (DM / 64) * (4096 / 64), I3 = I1;
    for (int it = gw; it < (part ? I1 + I3 + I2 : I0); it += NGW) { int r = part ? it : it + I1 + I3;
        if (r < I1) { transpose_item<0>(a.in[23], DM, DM, (bf16_t*)(a.ws + WD_ABOUT), scr, r, lane); continue; } r -= I1;
        if (r < I3) { transpose_item<0>(a.in[27], DM, DM, (bf16_t*)(a.ws + WD_COUT), scr, r, lane); continue; } r -= I3;
        if (part) r += I0;
        const int m = r < I0 ? 0 : 1; if (m) r -= I0; const int N = m ? 4096 : ABC; const float* W = m ? a.in[24] : a.in[4];
        const int k0 = 64 * (r / (N / 64)), n0 = 64 * (r % (N / 64)); float mx[4] = {0.f, 0.f, 0.f, 0.f};
#pragma unroll 4
        for (int i = 0; i < 16; ++i) { const float4 v = *(const float4*)(W + (size_t)(k0 + 4 * i + (lane >> 4)) * N + n0 + (lane & 15) * 4);
            mx[0] = fmaxf(mx[0], fabsf(v.x)); mx[1] = fmaxf(mx[1], fabsf(v.y)); mx[2] = fmaxf(mx[2], fabsf(v.z)); mx[3] = fmaxf(mx[3], fabsf(v.w)); }
#pragma unroll
        for (int q = 0; q < 4; ++q) { float t = mx[q];
            auto s1 = __builtin_amdgcn_permlane16_swap(__float_as_uint(t), __float_as_uint(t), false, false); t = fmaxf(__uint_as_float(s1[0]), __uint_as_float(s1[1]));
            auto s2 = __builtin_amdgcn_permlane32_swap(__float_as_uint(t), __float_as_uint(t), false, false); t = fmaxf(__uint_as_float(s2[0]), __uint_as_float(s2[1]));
            if (lane < 16) atomicMax(colmax + (m ? ABC : 0) + n0 + lane * 4 + q, __float_as_uint(t)); } }
}
__device__ __forceinline__ void ph_cvt_dense_b(const Args& a, LAS float* lds, const unsigned* colmax, int m, int bid, int nblk) {
    const int wave = threadIdx.x >> 6, lane = threadIdx.x & 63, gw = bid * 8 + wave, NGW = nblk * 8;
    LAS float* scr = lds + wave * (64 * 66);
    const int N = m ? 4096 : ABC; const int NI = (DM / 64) * (N / 64);
    for (int it = gw; it < NI; it += NGW) transpose_item_i8c(m ? a.in[24] : a.in[4], DM, N, a.ws + (m ? WD_CIN : WD_ABIN), scr, it, lane, colmax + (m ? ABC : 0));
}
__device__ __forceinline__ void ph_cvt_down1(const Args& a, LAS float* lds, int bid, int nblk, int e_lo, int e_hi) {
    const int wave = threadIdx.x >> 6, lane = threadIdx.x & 63, gw = bid * 8 + wave, NGW = nblk * 8;
    LAS float* scr = lds + wave * (64 * 66);
    constexpr int ID = (FF / 64) * (DM / 64);
    for (int it = gw; it < (e_hi - e_lo) * ID; it += NGW) { const int e = e_lo + it / ID, r = it % ID;
        transpose_item<0>(a.in[34] + ((size_t)NEXP + e) * DM * FF, FF, DM, (bf16_t*)a.out + (size_t)e * DM * FF, scr, r, lane); }
}
__device__ __forceinline__ void moe_tail_cvt(const Args& a, LAS float* lds, const LAS int* pst, int e_lo, int e_hi) {
    const int G = (int)gridDim.x, c = (int)blockIdx.x, cc = (G % pg8::NXCD == 0) ? (c % pg8::NXCD) * (G / pg8::NXCD) + c / pg8::NXCD : c;
    const int nun = (pst[NEXP] / 256) * 4, last = nun - ((nun - 1) / G) * G, nidle = G - last;
    __syncthreads();
    if (nidle >= 64) { if (cc >= last) ph_cvt_down1(a, lds, cc - last, nidle, e_lo, e_hi); }
    else ph_cvt_down1(a, lds, c, G, e_lo, e_hi);
}
__device__ __forceinline__ void ph_cvt_moe(const Args& a, int L, LAS float* lds, int bid, int nblk, int which) {
    const int wave = threadIdx.x >> 6, lane = threadIdx.x & 63, gw = bid * 8 + wave, NGW = nblk * 8;
    LAS float* scr = lds + wave * (64 * 66);
    constexpr int IG = (DM / 64) * (FF / 64), ID = (FF / 64) * (DM / 64);
    const int i0 = (which & 1) ? 0 : 2 * IG, IE = ((which & 1) ? 2 * IG : 0) + ((which & 2) ? ID : 0);
    unsigned char* gub = a.ws + (L ? WM_GU1 : WM_GU);
    for (int it = gw; it < NEXP * IE; it += NGW) { const int e = it / IE; int r = i0 + it % IE;
        unsigned char* gu = gub + (size_t)e * DM * DM; bf16_t* dn = (bf16_t*)(a.ws + WM_DN) + (size_t)e * DM * FF;
        const unsigned* wm = (const unsigned*)(a.ws + WS_CTL) + CW_WMAX + (L * NEXP + e) * 2;
        const size_t wo = ((size_t)L * NEXP + e) * DM * FF;
        if (r < IG) { transpose_item_i8<1>(a.in[32] + wo, DM, FF, gu, scr, r, lane, 127.f / fmaxf(__uint_as_float(wm[0]), 1e-30f)); continue; } r -= IG;
        if (r < IG) { transpose_item_i8<2>(a.in[33] + wo, DM, FF, gu, scr, r, lane, 127.f / fmaxf(__uint_as_float(wm[1]), 1e-30f)); continue; } r -= IG;
        transpose_item<0>(a.in[34] + wo, FF, DM, dn, scr, r, lane); }
}

__device__ __forceinline__ void load_row16(const float* row, int lane, float4 (&v)[4]) {
#pragma unroll
    for (int j = 0; j < 4; ++j) v[j] = *(const float4*)(row + lane * 4 + 256 * j);
}
__device__ __forceinline__ float row_sumsq(const float4 (&v)[4]) {
    float s = 0.f;
#pragma unroll
    for (int j = 0; j < 4; ++j) s += v[j].x * v[j].x + v[j].y * v[j].y + v[j].z * v[j].z + v[j].w * v[j].w;
    return wave_sum(s);
}
__device__ __forceinline__ void norm_row(float4 (&v)[4], const float* gain, int lane) {
    const float rs = rsqrtf(row_sumsq(v) * (1.f / DM) + 1e-6f);
#pragma unroll
    for (int j = 0; j < 4; ++j) { const float4 g = *(const float4*)(gain + lane * 4 + 256 * j);
        v[j].x *= rs * g.x; v[j].y *= rs * g.y; v[j].z *= rs * g.z; v[j].w *= rs * g.w; }
}
__device__ __forceinline__ void store_row_bf16(bf16_t* row, int lane, const float4 (&v)[4]) {
#pragma unroll
    for (int j = 0; j < 4; ++j) { uint2 o; o.x = f2bf(v[j].x) | ((unsigned)f2bf(v[j].y) << 16); o.y = f2bf(v[j].z) | ((unsigned)f2bf(v[j].w) << 16);
        *(uint2*)(row + lane * 4 + 256 * j) = o; }
}
__device__ __forceinline__ void add_row_bf16(const bf16_t* row, int lane, float4 (&v)[4]) {
#pragma unroll
    for (int j = 0; j < 4; ++j) { const uint2 o = *(const uint2*)(row + lane * 4 + 256 * j);
        v[j].x += __uint_as_float(o.x << 16); v[j].y += __uint_as_float(o.x & 0xffff0000u); v[j].z += __uint_as_float(o.y << 16); v[j].w += __uint_as_float(o.y & 0xffff0000u); }
}

__device__ __forceinline__ void ph_norm0(const float* x, const float* gain, unsigned char* HN8, float* rowscale) {
    const int lane = threadIdx.x & 63, gw = blockIdx.x * 8 + (threadIdx.x >> 6), NGW = gridDim.x * 8;
    for (int n = gw; n < NTOK; n += NGW) { float4 v[4]; load_row16(x + (size_t)n * DM, lane, v); norm_row(v, gain, lane);
        float mx = 0.f;
#pragma unroll
        for (int j = 0; j < 4; ++j) mx = fmaxf(fmaxf(mx, fmaxf(fabsf(v[j].x), fabsf(v[j].y))), fmaxf(fabsf(v[j].z), fabsf(v[j].w)));
        mx = fmaxf(wave_max(mx), 1e-30f); const float qs = 127.f / mx;
        if (lane == 0) rowscale[n] = mx;
#pragma unroll
        for (int j = 0; j < 4; ++j) *(unsigned*)(HN8 + (size_t)n * DM + lane * 4 + 256 * j) = q8x4(v[j].x, v[j].y, v[j].z, v[j].w, qs); }
}
__device__ __forceinline__ void ld8bf(const bf16_t* p, float (&v)[8]) { const u32x4_t o = *(const u32x4_t*)p;
    v[0] = __uint_as_float(o.x << 16); v[1] = __uint_as_float(o.x & 0xffff0000u); v[2] = __uint_as_float(o.y << 16); v[3] = __uint_as_float(o.y & 0xffff0000u);
    v[4] = __uint_as_float(o.z << 16); v[5] = __uint_as_float(o.z & 0xffff0000u); v[6] = __uint_as_float(o.w << 16); v[7] = __uint_as_float(o.w & 0xffff0000u); }
__device__ __forceinline__ void st8bf(bf16_t* p, const float (&v)[8]) { *(u32x4_t*)p = (u32x4_t){pk2(v[0], v[1]), pk2(v[2], v[3]), pk2(v[4], v[5]), pk2(v[6], v[7])}; }
__device__ __forceinline__ void ph_combine_norm(bf16_t* XR, const bf16_t* Y, const float* gain, unsigned char* HN8, float* rowscale) {
    const int lane = threadIdx.x & 63, gw = blockIdx.x * 8 + (threadIdx.x >> 6), NGW = gridDim.x * 8;
    for (int n = gw; n < NTOK; n += NGW) { float x[2][8], y0[2][8], y1[2][8]; float ss = 0.f;
#pragma unroll
        for (int j = 0; j < 2; ++j) { const int o = lane * 8 + 512 * j; ld8bf(XR + (size_t)n * DM + o, x[j]); ld8bf(Y + (size_t)(2 * n) * DM + o, y0[j]); ld8bf(Y + (size_t)(2 * n + 1) * DM + o, y1[j]); }
#pragma unroll
        for (int j = 0; j < 2; ++j) {
#pragma unroll
            for (int i = 0; i < 8; ++i) x[j][i] = bf2f(f2bf(x[j][i] + y0[j][i] + y1[j][i]));
            st8bf(XR + (size_t)n * DM + lane * 8 + 512 * j, x[j]);
#pragma unroll
            for (int i = 0; i < 8; ++i) ss += x[j][i] * x[j][i]; }
        const float rs = rsqrtf(wave_sum(ss) * (1.f / DM) + 1e-6f);
#pragma unroll
        for (int j = 0; j < 2; ++j) { const int o = lane * 8 + 512 * j; const float4 g0 = *(const float4*)(gain + o), g1 = *(const float4*)(gain + o + 4);
            const float gg[8] = {g0.x, g0.y, g0.z, g0.w, g1.x, g1.y, g1.z, g1.w};
#pragma unroll
            for (int i = 0; i < 8; ++i) x[j][i] *= rs * gg[i]; }
        float mx = 0.f;
#pragma unroll
        for (int j = 0; j < 2; ++j)
#pragma unroll
            for (int i = 0; i < 8; ++i) mx = fmaxf(mx, fabsf(x[j][i]));
        mx = fmaxf(wave_max(mx), 1e-30f); const float qs = 127.f / mx;
        if (lane == 0) rowscale[n] = mx;
#pragma unroll
        for (int j = 0; j < 2; ++j) { const int o = lane * 8 + 512 * j;
            *(u32x2_t*)(HN8 + (size_t)n * DM + o) = (u32x2_t){q8x4(x[j][0], x[j][1], x[j][2], x[j][3], qs), q8x4(x[j][4], x[j][5], x[j][6], x[j][7], qs)}; } }
}
__device__ __forceinline__ void ph_final(const bf16_t* XR, const bf16_t* Y, const float* gain, float* out) {
    const int lane = threadIdx.x & 63, gw = blockIdx.x * 8 + (threadIdx.x >> 6), NGW = gridDim.x * 8;
    for (int n = gw; n < NTOK; n += NGW) { float x[2][8], y0[2][8], y1[2][8]; float ss = 0.f;
#pragma unroll
        for (int j = 0; j < 2; ++j) { const int o = lane * 8 + 512 * j; ld8bf(XR + (size_t)n * DM + o, x[j]); ld8bf(Y + (size_t)(2 * n) * DM + o, y0[j]); ld8bf(Y + (size_t)(2 * n + 1) * DM + o, y1[j]); }
#pragma unroll
        for (int j = 0; j < 2; ++j)
#pragma unroll
            for (int i = 0; i < 8; ++i) { x[j][i] = x[j][i] + y0[j][i] + y1[j][i]; ss += x[j][i] * x[j][i]; }
        const float rs = rsqrtf(wave_sum(ss) * (1.f / DM) + 1e-6f);
#pragma unroll
        for (int j = 0; j < 2; ++j) { const int o = lane * 8 + 512 * j; const float4 g0 = *(const float4*)(gain + o), g1 = *(const float4*)(gain + o + 4);
            *(float4*)(out + (size_t)n * DM + o) = make_float4(x[j][0] * rs * g0.x, x[j][1] * rs * g0.y, x[j][2] * rs * g0.z, x[j][3] * rs * g0.w);
            *(float4*)(out + (size_t)n * DM + o + 4) = make_float4(x[j][4] * rs * g1.x, x[j][5] * rs * g1.y, x[j][6] * rs * g1.z, x[j][7] * rs * g1.w); } }
}
__device__ __forceinline__ void ph_route(const Args& a, int Lyr, const bf16_t* XR, bf16_t* HN, float* RS, unsigned* cnt, int* list_slot, float* list_gate, LAS float* lds) {
    const float* gain = a.in[2] + Lyr * DM; const float* bg = a.in[29] + Lyr * 4; const float* be = a.in[31] + Lyr * 32;
    const bf16_t* FRh = (const bf16_t*)(a.ws + FG_RT) + (size_t)Lyr * 2 * 49152; const bf16_t* FRl = FRh + 49152;
    const int lane = threadIdx.x & 63, wave = threadIdx.x >> 6, q4 = lane >> 4, c16 = lane & 15, r4 = lane >> 4, cidx = lane & 15;
    LAS unsigned char* Lb = (LAS unsigned char*)lds;
    LAS unsigned char* W = Lb + wave * 12288;
    LAS float* SS = (LAS float*)(W + 8704); LAS float* LG = (LAS float*)(W + 8768);
    LAS unsigned* lcnt = (LAS unsigned*)(Lb + 8 * 12288); LAS unsigned* lbase = lcnt + 32;
    const int NGW = gridDim.x * 8, gw = blockIdx.x * 8 + wave;
    for (int rnd = 0; rnd * NGW < NTOK / 16; ++rnd) {
        const int tile = rnd * NGW + gw; const bool act = tile < NTOK / 16; const int n0 = tile * 16;
        if (threadIdx.x < 32) lcnt[threadIdx.x] = 0u;
        __syncthreads();
        int e0 = 0, e1 = 0, lr0 = 0, lr1 = 0; float g0 = 0.f, g1 = 0.f;
        if (act) {
            f32x4 acc[3], accs = (f32x4){0.f, 0.f, 0.f, 0.f};
#pragma unroll
            for (int ct = 0; ct < 3; ++ct) acc[ct] = accs;
#pragma unroll 1
            for (int kc = 0; kc < 8; ++kc) {
                bf16x8_t bh[4][3], bl[4][3];
#pragma unroll
                for (int ks = 0; ks < 4; ++ks)
#pragma unroll
                    for (int ct = 0; ct < 3; ++ct) { const size_t o = ((size_t)((kc * 4 + ks) * 3 + ct) * 64 + lane) * 8; bh[ks][ct] = *(const bf16x8_t*)(FRh + o); bl[ks][ct] = *(const bf16x8_t*)(FRl + o); }
                u32x4_t xv[4];
#pragma unroll
                for (int j = 0; j < 4; ++j) xv[j] = *(const u32x4_t*)(XR + (size_t)(n0 + 4 * j + r4) * DM + kc * 128 + 8 * cidx);
                __builtin_amdgcn_sched_barrier(0);
#pragma unroll
                for (int j = 0; j < 4; ++j) *(LAS u32x4_t*)(W + (4 * j + r4) * 272 + cidx * 16) = xv[j];
#pragma unroll
                for (int ks = 0; ks < 4; ++ks) { const bf16x8_t ahi = *(const LAS bf16x8_t*)(W + c16 * 272 + ks * 64 + q4 * 16);
                    accs = __builtin_amdgcn_mfma_f32_16x16x32_bf16(ahi, ahi, accs, 0, 0, 0);
#pragma unroll
                    for (int ct = 0; ct < 3; ++ct) { acc[ct] = __builtin_amdgcn_mfma_f32_16x16x32_bf16(ahi, bh[ks][ct], acc[ct], 0, 0, 0); acc[ct] = __builtin_amdgcn_mfma_f32_16x16x32_bf16(ahi, bl[ks][ct], acc[ct], 0, 0, 0); } }
            }
#pragma unroll
            for (int r = 0; r < 4; ++r) if (c16 == 4 * q4 + r) { const float rsv = rsqrtf(accs[r] * (1.f / DM) + 1e-6f); SS[c16] = rsv; RS[n0 + c16] = rsv; }
            const f32x4 s4 = *(const LAS f32x4*)(SS + 4 * q4);
#pragma unroll
            for (int ct = 0; ct < 3; ++ct) { const int col = 16 * ct + c16; const float bias = col < 4 ? bg[col] : (col < 36 ? be[col - 4] : 0.f);
#pragma unroll
                for (int r = 0; r < 4; ++r) LG[(4 * q4 + r) * 48 + col] = acc[ct][r] * s4[r] + bias; }
            if (lane < 16) {
                const LAS float* lg = LG + lane * 48;
                int gs = 0; float gm = lg[0];
#pragma unroll
                for (int i = 1; i < 4; ++i) { const float v = lg[i]; if (v > gm) { gm = v; gs = i; } }
                float gden = 0.f;
#pragma unroll
                for (int i = 0; i < 4; ++i) gden += __expf(lg[i] - gm);
                const float ggate = 1.f / gden;
                const LAS float* l8 = lg + 4 + gs * 8;
                int i0 = 0; float m0 = l8[0];
#pragma unroll
                for (int i = 1; i < 8; ++i) { const float v = l8[i]; if (v > m0) { m0 = v; i0 = i; } }
                int i1 = (i0 == 0) ? 1 : 0; float m1 = l8[i1];
#pragma unroll
                for (int i = 0; i < 8; ++i) { const float v = l8[i]; if (i != i0 && v > m1) { m1 = v; i1 = i; } }
                const float ex = __expf(m1 - m0);
                g0 = ggate / (1.f + ex); g1 = ggate * ex / (1.f + ex);
                e0 = gs * 8 + i0; e1 = gs * 8 + i1;
                lr0 = (int)__hip_atomic_fetch_add(lcnt + e0, 1u, __ATOMIC_RELAXED, __HIP_MEMORY_SCOPE_WORKGROUP); lr1 = (int)__hip_atomic_fetch_add(lcnt + e1, 1u, __ATOMIC_RELAXED, __HIP_MEMORY_SCOPE_WORKGROUP);
            }
        }
        __syncthreads();
        if (threadIdx.x < 32) { const unsigned c = lcnt[threadIdx.x]; lbase[threadIdx.x] = c ? atomicAdd(&cnt[threadIdx.x], c) : 0u; }
        __syncthreads();
        if (act) {
            if (lane < 16) { const int n = n0 + lane;
                const int d0 = e0 * MOE_CAP + (int)lbase[e0] + lr0, d1 = e1 * MOE_CAP + (int)lbase[e1] + lr1;
                list_slot[d0] = 2 * n; list_slot[d1] = 2 * n + 1; list_gate[d0] = g0; list_gate[d1] = g1; }
            unsigned char* H8 = (unsigned char*)HN;
            float rsr[4];
#pragma unroll
            for (int j = 0; j < 4; ++j) rsr[j] = SS[4 * j + r4] * ACT_Q;
#pragma unroll 2
            for (int kc = 0; kc < 8; ++kc) { const float4 gn0 = *(const float4*)(gain + kc * 128 + 8 * cidx), gn1 = *(const float4*)(gain + kc * 128 + 8 * cidx + 4);
                u32x4_t xv[4];
#pragma unroll
                for (int j = 0; j < 4; ++j) xv[j] = *(const u32x4_t*)(XR + (size_t)(n0 + 4 * j + r4) * DM + kc * 128 + 8 * cidx);
#pragma unroll
                for (int j = 0; j < 4; ++j) { const u32x4_t o = xv[j]; const float q = rsr[j];
                    *(u32x2_t*)(H8 + (size_t)(n0 + 4 * j + r4) * DM + kc * 128 + 8 * cidx) = (u32x2_t){
                        q8x4(__uint_as_float(o.x << 16) * gn0.x, __uint_as_float(o.x & 0xffff0000u) * gn0.y, __uint_as_float(o.y << 16) * gn0.z, __uint_as_float(o.y & 0xffff0000u) * gn0.w, q),
                        q8x4(__uint_as_float(o.z << 16) * gn1.x, __uint_as_float(o.z & 0xffff0000u) * gn1.y, __uint_as_float(o.w << 16) * gn1.z, __uint_as_float(o.w & 0xffff0000u) * gn1.w, q)}; } }
        }
        __syncthreads();
    }
}
__device__ __forceinline__ void moe_prefix(const unsigned* cnt, LAS int* pst) {
    if (threadIdx.x == 0) { int acc = 0; for (int e = 0; e < NEXP; ++e) { pst[e] = acc; const int c = (int)cnt[e]; acc += (c + MOE_TM - 1) / MOE_TM * MOE_TM; } pst[NEXP] = acc; }
    __syncthreads();
}
__device__ __forceinline__ int moe_tile_expert(const LAS int* pst, int row0) { int e = 0;
    for (int i = 1; i < NEXP; ++i) if (row0 >= pst[i]) e = i;
    return e; }

__device__ __forceinline__ float shiftcol(const bf16_t* P, int n, int t, int col, const float* mu) {
    const float cur = bf2f(P[(size_t)n * ABC + col]); const float prev = t > 0 ? bf2f(P[(size_t)(n - 1) * ABC + col]) : 0.f;
    return cur + (prev - cur) * mu[col];
}
constexpr int RW_WMF = 0, RW_RF = 2048, RW_BKF = 4096, RW_ARF = 8192, RW_U = 9216, RW_V = 11264, RW_G = 13312, RW_REC = 13568;
__device__ __forceinline__ float fast_sigmoid(float x) { return __builtin_amdgcn_rcpf(1.f + __expf(-x)); }
__device__ __forceinline__ float fast_softplus(float x) { return fmaxf(x, 0.f) + __logf(1.f + __expf(-fabsf(x))); }
__device__ __forceinline__ void tr_acc(LAS float* TBf, const f32x4 (&acc)[4], int lane, float (&out)[16]) {
    const int q4 = lane >> 4, c16 = lane & 15;
#pragma unroll
    for (int ct = 0; ct < 4; ++ct)
#pragma unroll
        for (int r = 0; r < 4; ++r) TBf[(16 * ct + 4 * q4 + r) * 20 + c16] = acc[ct][r];
#pragma unroll
    for (int j = 0; j < 4; ++j) { const f32x4 v = *(const LAS f32x4*)(TBf + lane * 20 + 4 * j); out[4 * j] = v[0]; out[4 * j + 1] = v[1]; out[4 * j + 2] = v[2]; out[4 * j + 3] = v[3]; }
}
__device__ __forceinline__ void ph_l0_prep(const Args& a, LAS float* lds) {
    const bf16_t* P = (const bf16_t*)(a.ws + WS_B);
    unsigned char* FR = a.ws + WS_C;
    bf16_t* Vb = (bf16_t*)a.out; float* Bon = (float*)((unsigned char*)a.out + 32 * MiB);
    bf16_t* LA = (bf16_t*)(a.ws + WS_A); bf16_t* U = LA + (size_t)NTOK * 512;
    const float* mu = a.in[5]; const float* w0 = a.in[6]; const float* a0 = a.in[8];
    const float* k_k = a.in[11]; const float* k_a = a.in[12]; const float* r_k = a.in[13];
    const float* conv_w = a.in[16]; const float* conv_b = a.in[17]; const float* b_a = a.in[19]; const float* b_x = a.in[21]; const float* lam = a.in[22];
    const int lane = threadIdx.x & 63, wave = threadIdx.x >> 6, q4 = lane >> 4, c16 = lane & 15;
    LAS unsigned char* W = (LAS unsigned char*)lds + wave * 15360;
    constexpr int KAP = 0, BT = 2304, KT = 4608, RT = 6912, BTT = 9216, KTT = 11264, AKB = 13312, AKK = 14336, RS = 144;
    constexpr int XS = 0, XS2 = 2304, TB = 4608;
    LAS float* TBf = (LAS float*)(W + TB);
    for (int u = blockIdx.x * 8 + wave; u < (NTOK / 16) * 8; u += gridDim.x * 8) {
        const int tile = u >> 3, h = u & 7, n0 = tile * 16, c = h * 64 + lane;
        const bool first = (n0 & (SEQ - 1)) == 0;
        const unsigned char* PT = (const unsigned char*)(P + (size_t)tile * ABC * 16);
        const unsigned char* PTp = PT - (size_t)ABC * 32;
        unsigned lo32 = (unsigned)lane * 32u; asm volatile("" : "+v"(lo32));
#define LD16(dst, colbase, off) do { const u32x4_t _lo = *(const u32x4_t*)(PT + (colbase) * 32 + lo32), _hi = *(const u32x4_t*)(PT + (colbase) * 32 + 16 + lo32); \
            dst[(off)] = _lo.x; dst[(off) + 1] = _lo.y; dst[(off) + 2] = _lo.z; dst[(off) + 3] = _lo.w; dst[(off) + 4] = _hi.x; dst[(off) + 5] = _hi.y; dst[(off) + 6] = _hi.z; dst[(off) + 7] = _hi.w; } while (0)
        unsigned xbp[10], pwp[9], pap[9], qrp[9], qkp[9], qvp[9];
        { u32x2_t t2 = (u32x2_t){0u, 0u}; if (!first) t2 = *(const u32x2_t*)(PTp + (2304 + h * 64) * 32 + 24 + lo32); xbp[0] = t2.x; xbp[1] = t2.y; LD16(xbp, 2304 + h * 64, 2); }
        pwp[0] = first ? 0u : *(const unsigned*)(PTp + 1536 * 32 + 28 + lo32); LD16(pwp, 1536, 1);
        pap[0] = first ? 0u : *(const unsigned*)(PTp + 1600 * 32 + 28 + lo32); LD16(pap, 1600, 1);
        asm volatile("" ::: "memory");
#define UNPK(arr, i) __uint_as_float(((i) & 1) ? ((arr)[(i) >> 1] & 0xffff0000u) : ((arr)[(i) >> 1] << 16))
        {
            bf16_t* SG = (bf16_t*)((unsigned char*)a.out + DO_SG);
            const int tk = lane >> 2, col = 1664 + 16 * h + (lane & 3) * 4;
            unsigned so = (unsigned)((lane & 3) * 128 + tk * 2); asm volatile("" : "+v"(so));
            float cu[4], pu[4];
#pragma unroll
            for (int i = 0; i < 4; ++i) { cu[i] = bf2f(*(const bf16_t*)(PT + (1664 + 16 * h + i) * 32 + so));
                pu[i] = (tk > 0) ? bf2f(*(const bf16_t*)(PT + (1664 + 16 * h + i) * 32 - 2 + so)) : (first ? 0.f : bf2f(*(const bf16_t*)(PTp + (1664 + 16 * h + i) * 32 + 30 + so))); }
            const f32x4 m4 = *(const f32x4*)(mu + col);
            *(u32x2_t*)(SG + (size_t)(tile * 8 + h) * 256 + lane * 4) = (u32x2_t){pk2(fast_sigmoid(cu[0] + (pu[0] - cu[0]) * m4[0]), fast_sigmoid(cu[1] + (pu[1] - cu[1]) * m4[1])), pk2(fast_sigmoid(cu[2] + (pu[2] - cu[2]) * m4[2]), fast_sigmoid(cu[3] + (pu[3] - cu[3]) * m4[3]))};
        }
        {
            const float cw0 = conv_w[c], cw1 = conv_w[512 + c], cw2 = conv_w[1024 + c], cw3 = conv_w[1536 + c], cb = conv_b[c];
            float xcv[16], xb[19];
#pragma unroll
            for (int i = 0; i < 19; ++i) xb[i] = UNPK(xbp, i + 1);
#pragma unroll
            for (int tk = 0; tk < 16; ++tk) { xcv[tk] = cb + cw0 * xb[tk] + cw1 * xb[tk + 1] + cw2 * xb[tk + 2] + cw3 * xb[tk + 3]; *(LAS bf16_t*)(W + XS + tk * RS + lane * 2) = f2bf(xcv[tk]); }
            f32x4 accr[4], acci[4];
            const bf16_t* FA = (const bf16_t*)(a.ws + FG_WA) + h * 4096; const bf16_t* FX = (const bf16_t*)(a.ws + FG_WX) + h * 4096;
            bf16x8_t xf[2];
#pragma unroll
            for (int ks = 0; ks < 2; ++ks) xf[ks] = *(const LAS bf16x8_t*)(W + XS + c16 * RS + ks * 64 + q4 * 16);
#pragma unroll
            for (int ct = 0; ct < 4; ++ct) { asm volatile("" ::: "memory"); accr[ct] = (f32x4){0.f, 0.f, 0.f, 0.f}; acci[ct] = accr[ct];
#pragma unroll
                for (int ks = 0; ks < 2; ++ks) { accr[ct] = __builtin_amdgcn_mfma_f32_16x16x32_bf16(*(const bf16x8_t*)(FA + ((ct * 2 + ks) * 64 + lane) * 8), xf[ks], accr[ct], 0, 0, 0);
                    acci[ct] = __builtin_amdgcn_mfma_f32_16x16x32_bf16(*(const bf16x8_t*)(FX + ((ct * 2 + ks) * 64 + lane) * 8), xf[ks], acci[ct], 0, 0, 0); } }
            float rp[16], ip[16];
            tr_acc(TBf, accr, lane, rp); tr_acc(TBf, acci, lane, ip);
            const float bac = b_a[c], bxc = b_x[c], sp = fast_softplus(-lam[c]);
            float hloc = 0.f, sla = 0.f;
            unsigned lap[4], uup[4];
#pragma unroll
            for (int tk = 0; tk < 16; ++tk) { const float r = fast_sigmoid(rp[tk] + bac), i = fast_sigmoid(ip[tk] + bxc);
                const float la = -8.f * r * sp; const float uu = __builtin_amdgcn_sqrtf(fmaxf(1.f - __expf(2.f * la), 0.f)) * i * xcv[tk];
                const bf16_t lab = f2bf(la), uub = f2bf(uu); const float lar = bf2f(lab);
                if (tk & 1) { lap[(tk >> 1) & 3] |= (unsigned)lab << 16; uup[(tk >> 1) & 3] |= (unsigned)uub << 16; } else { lap[(tk >> 1) & 3] = lab; uup[(tk >> 1) & 3] = uub; }
                if ((tk & 7) == 7) { *(u32x4_t*)(LA + ((size_t)tile * 512 + c) * 16 + (tk >> 3) * 8) = (u32x4_t){lap[0], lap[1], lap[2], lap[3]}; *(u32x4_t*)(U + ((size_t)tile * 512 + c) * 16 + (tk >> 3) * 8) = (u32x4_t){uup[0], uup[1], uup[2], uup[3]}; }
                hloc = __expf(lar) * hloc + bf2f(uub); sla += lar; }
            ((float*)((unsigned char*)a.out + DO_LRU))[(size_t)tile * 512 + c] = hloc; ((float*)((unsigned char*)a.out + DO_LRU))[(size_t)(2048 + tile) * 512 + c] = sla;
        }
        asm volatile("" ::: "memory");
        asm volatile("" : "+v"(lo32));
        qrp[0] = first ? 0u : *(const unsigned*)(PTp + (h * 64) * 32 + 28 + lo32); LD16(qrp, h * 64, 1);
        qkp[0] = first ? 0u : *(const unsigned*)(PTp + (512 + h * 64) * 32 + 28 + lo32); LD16(qkp, 512 + h * 64, 1);
        qvp[0] = first ? 0u : *(const unsigned*)(PTp + (1024 + h * 64) * 32 + 28 + lo32); LD16(qvp, 1024 + h * 64, 1);
        asm volatile("" ::: "memory");
        float wpre[16], apre[16];
        {
            const float muw = mu[1536 + lane], mua = mu[1600 + lane];
#pragma unroll
            for (int tk = 0; tk < 16; ++tk) { const float pw1 = UNPK(pwp, tk + 2), pw0 = UNPK(pwp, tk + 1), pa1 = UNPK(pap, tk + 2), pa0 = UNPK(pap, tk + 1);
                const float wl = pw1 + (pw0 - pw1) * muw, al = pa1 + (pa0 - pa1) * mua;
                const float th = 1.f - 2.f * __builtin_amdgcn_rcpf(1.f + __expf(2.f * wl));
                *(LAS bf16_t*)(W + XS + tk * RS + lane * 2) = f2bf(th); *(LAS bf16_t*)(W + XS2 + tk * RS + lane * 2) = f2bf(al); }
            f32x4 accw[4], acca[4];
            const bf16_t* F2 = (const bf16_t*)(a.ws + FG_W2) + h * 4096; const bf16_t* FA2 = (const bf16_t*)(a.ws + FG_A2) + h * 4096;
            bf16x8_t wf[2], af[2];
#pragma unroll
            for (int ks = 0; ks < 2; ++ks) { wf[ks] = *(const LAS bf16x8_t*)(W + XS + c16 * RS + ks * 64 + q4 * 16); af[ks] = *(const LAS bf16x8_t*)(W + XS2 + c16 * RS + ks * 64 + q4 * 16); }
#pragma unroll
            for (int ct = 0; ct < 4; ++ct) { asm volatile("" ::: "memory"); accw[ct] = (f32x4){0.f, 0.f, 0.f, 0.f}; acca[ct] = accw[ct];
#pragma unroll
                for (int ks = 0; ks < 2; ++ks) { accw[ct] = __builtin_amdgcn_mfma_f32_16x16x32_bf16(*(const bf16x8_t*)(F2 + ((ct * 2 + ks) * 64 + lane) * 8), wf[ks], accw[ct], 0, 0, 0);
                    acca[ct] = __builtin_amdgcn_mfma_f32_16x16x32_bf16(*(const bf16x8_t*)(FA2 + ((ct * 2 + ks) * 64 + lane) * 8), af[ks], acca[ct], 0, 0, 0); } }
            tr_acc(TBf, accw, lane, wpre); tr_acc(TBf, acca, lane, apre);
        }
        const float w0c = w0[c], a0c = a0[c], kkc = k_k[c], kac = k_a[c], rkc = r_k[c];
        const float mur = mu[c], muk = mu[512 + c], muv = mu[1024 + c];
        unsigned char* rec = FR + ((size_t)tile * 8 + h) * RW_REC;
        float vsv[16];
        unsigned btp[8], ktp[8];
        float cum = 0.f, gC = 1.f;
#pragma unroll
        for (int tk = 0; tk < 16; ++tk) { const int n = n0 + tk;
            const float cr = UNPK(qrp, tk + 2), ck = UNPK(qkp, tk + 2), cv = UNPK(qvp, tk + 2), pr = UNPK(qrp, tk + 1), pk = UNPK(qkp, tk + 1), pv = UNPK(qvp, tk + 1);
            const float rs = cr + (pr - cr) * mur, ks = ck + (pk - ck) * muk, vs = cv + (pv - cv) * muv;
            const float wv = -fast_softplus(-(w0c + wpre[tk])) - 0.5f; const float logdec = -__expf(wv);
            const float av = fast_sigmoid(a0c + apre[tk]);
            const float kkr = ks * kkc; const float ss = wave_sum(kkr * kkr); const float kkn = kkr * rsqrtf(fmaxf(ss, 1e-24f));
            const float kp = ks * (1.f + (av - 1.f) * kac);
            const float bsum = wave_sum(rs * kp * rkc);
            if (lane == 0) Bon[(size_t)n * 8 + h] = bsum;
            Vb[(size_t)n * 512 + c] = f2bf(vs); vsv[tk] = vs;
            const float gprev = __expf(cum); cum += logdec; const float g = __expf(cum), gi = __builtin_amdgcn_rcpf(g); gC = g;
            const float kapv = kkn * gprev, btv = av * kkn * gi, ktv = kp * gi, rtv = rs * g;
            const bf16_t kb = f2bf(kapv), bb = f2bf(btv), kb2 = f2bf(ktv), rb = f2bf(rtv);
            *(LAS bf16_t*)(W + KAP + tk * RS + lane * 2) = kb; *(LAS bf16_t*)(W + BT + tk * RS + lane * 2) = bb;
            *(LAS bf16_t*)(W + KT + tk * RS + lane * 2) = kb2; *(LAS bf16_t*)(W + RT + tk * RS + lane * 2) = rb;
            if (tk & 1) { btp[tk >> 1] |= (unsigned)bb << 16; ktp[tk >> 1] |= (unsigned)kb2 << 16; } else { btp[tk >> 1] = bb; ktp[tk >> 1] = kb2; } }
        *(LAS u32x4_t*)(W + BTT + lane * 32) = (u32x4_t){btp[0], btp[1], btp[2], btp[3]}; *(LAS u32x4_t*)(W + BTT + lane * 32 + 16) = (u32x4_t){btp[4], btp[5], btp[6], btp[7]};
        *(LAS u32x4_t*)(W + KTT + lane * 32) = (u32x4_t){ktp[0], ktp[1], ktp[2], ktp[3]}; *(LAS u32x4_t*)(W + KTT + lane * 32 + 16) = (u32x4_t){ktp[4], ktp[5], ktp[6], ktp[7]};
        *(float*)(rec + RW_G + lane * 4) = gC;
        f32x4 akb = (f32x4){0.f, 0.f, 0.f, 0.f}, akk = akb, arbT = akb, arkT = akb;
#pragma unroll
        for (int ks = 0; ks < 2; ++ks) { const int fo = c16 * RS + ks * 64 + q4 * 16;
            const bf16x8_t fkap = *(const LAS bf16x8_t*)(W + KAP + fo), fbt = *(const LAS bf16x8_t*)(W + BT + fo), fkt = *(const LAS bf16x8_t*)(W + KT + fo), frt = *(const LAS bf16x8_t*)(W + RT + fo);
            akb = __builtin_amdgcn_mfma_f32_16x16x32_bf16(fkap, fbt, akb, 0, 0, 0); akk = __builtin_amdgcn_mfma_f32_16x16x32_bf16(fkap, fkt, akk, 0, 0, 0);
            arbT = __builtin_amdgcn_mfma_f32_16x16x32_bf16(fbt, frt, arbT, 0, 0, 0); arkT = __builtin_amdgcn_mfma_f32_16x16x32_bf16(fkt, frt, arkT, 0, 0, 0); }
#pragma unroll
        for (int r = 0; r < 4; ++r) { const int t = 4 * q4 + r; ((LAS float*)(W + AKB))[t * 16 + c16] = (c16 < t) ? akb[r] : 0.f; ((LAS float*)(W + AKK))[t * 16 + c16] = (c16 < t) ? akk[r] : 0.f;
            const int sidx = 4 * q4 + r; if (sidx > c16) { arbT[r] = 0.f; arkT[r] = 0.f; } }
        *(u32x4_t*)(rec + RW_ARF + lane * 16) = (u32x4_t){pk2(arbT[0], arbT[1]), pk2(arbT[2], arbT[3]), pk2(arkT[0], arkT[1]), pk2(arkT[2], arkT[3])};
#pragma unroll
        for (int i = 0; i < 4; ++i) { const u32x2_t b2 = *(const LAS u32x2_t*)(W + BTT + (16 * i + c16) * 32 + q4 * 8), k2 = *(const LAS u32x2_t*)(W + KTT + (16 * i + c16) * 32 + q4 * 8);
            *(u32x4_t*)(rec + RW_BKF + i * 1024 + lane * 16) = (u32x4_t){b2.x, b2.y, k2.x, k2.y}; }
#pragma unroll
        for (int sx = 0; sx < 2; ++sx) { const u32x2_t lo = *(const LAS u32x2_t*)(W + RT + c16 * RS + (32 * sx + 4 * q4) * 2), hi = *(const LAS u32x2_t*)(W + RT + c16 * RS + (32 * sx + 16 + 4 * q4) * 2);
            *(u32x4_t*)(rec + RW_RF + sx * 1024 + lane * 16) = (u32x4_t){lo.x, lo.y, hi.x, hi.y}; }
        float Wm[16], Uu[16];
#pragma unroll
        for (int t = 0; t < 16; ++t) { float wacc = bf2f(*(const LAS bf16_t*)(W + KAP + t * RS + lane * 2)), uacc = 0.f;
#pragma unroll
            for (int s4 = 0; s4 < 4; ++s4) if (4 * s4 < t) { const f32x4 b4 = *(const LAS f32x4*)(W + AKB + (t * 16 + 4 * s4) * 4), k4 = *(const LAS f32x4*)(W + AKK + (t * 16 + 4 * s4) * 4);
#pragma unroll
                for (int e = 0; e < 4; ++e) { const int sidx = 4 * s4 + e; if (sidx < t) { wacc -= b4[e] * Wm[sidx]; uacc += k4[e] * vsv[sidx] - b4[e] * Uu[sidx]; } } }
            Wm[t] = wacc; Uu[t] = uacc;
            *(LAS bf16_t*)(W + KAP + t * RS + lane * 2) = f2bf(wacc);
        }
        {
            const int ub = ((lane >> 4) * 64 + (lane & 15)) * 8;
#pragma unroll
            for (int q = 0; q < 4; ++q) { *(u32x2_t*)(rec + RW_U + ub + q * 128) = (u32x2_t){pk2(Uu[4 * q], Uu[4 * q + 1]), pk2(Uu[4 * q + 2], Uu[4 * q + 3])};
                *(u32x2_t*)(rec + RW_V + ub + q * 128) = (u32x2_t){pk2(vsv[4 * q], vsv[4 * q + 1]), pk2(vsv[4 * q + 2], vsv[4 * q + 3])}; }
        }
#pragma unroll
        for (int sx = 0; sx < 2; ++sx) { const u32x2_t lo = *(const LAS u32x2_t*)(W + KAP + c16 * RS + (32 * sx + 4 * q4) * 2), hi = *(const LAS u32x2_t*)(W + KAP + c16 * RS + (32 * sx + 16 + 4 * q4) * 2);
            *(u32x4_t*)(rec + RW_WMF + sx * 1024 + lane * 16) = (u32x4_t){lo.x, lo.y, hi.x, hi.y}; }
    }
}
__device__ __forceinline__ void sub_barrier(unsigned* ctr, unsigned target) {
    asm volatile("s_waitcnt vmcnt(0)" ::: "memory");
    __syncthreads();
    if (threadIdx.x == 0) {
        (void)xb_add(ctr, 1u);
        unsigned sp = 0;
        while (xb_ld(ctr) < target) { __builtin_amdgcn_s_sleep(2); if (++sp > (1u << 22)) break; }
        __builtin_amdgcn_fence(__ATOMIC_ACQUIRE, "agent");
        asm volatile("s_waitcnt vmcnt(0)" ::: "memory");
    }
    __syncthreads();
}
__device__ __forceinline__ void st_wt(float* p, float v) { __hip_atomic_store((unsigned*)p, __float_as_uint(v), __ATOMIC_RELAXED, __HIP_MEMORY_SCOPE_AGENT); }
__device__ __forceinline__ void ph_lru_b(const Args& a, int bid, LAS float* lds) {
    if (bid >= 64) return;
    const float* CH = (const float*)((unsigned char*)a.out + DO_LRU); const float* CA = CH + (size_t)2048 * 512; float* CIN = (float*)((unsigned char*)a.out + DO_LRU) + (size_t)4096 * 512;
    const int b = bid >> 4, cg = bid & 15, cl = threadIdx.x & 31, seg = threadIdx.x >> 5, c = cg * 32 + cl;
    float ca[32], chv[32];
#pragma unroll
    for (int i = 0; i < 32; ++i) { const size_t o = (size_t)(b * 512 + seg * 32 + i) * 512 + c; ca[i] = CA[o]; chv[i] = CH[o]; }
    float h = 0.f, sa = 0.f;
#pragma unroll
    for (int i = 0; i < 32; ++i) { h = __expf(ca[i]) * h + chv[i]; sa += ca[i]; }
    lds[seg * 32 + cl] = sa; lds[512 + seg * 32 + cl] = h;
    __syncthreads();
    float hin = 0.f;
    for (int sg = 0; sg < seg; ++sg) hin = __expf(lds[sg * 32 + cl]) * hin + lds[512 + sg * 32 + cl];
    h = hin;
#pragma unroll
    for (int i = 0; i < 32; ++i) { st_wt(CIN + (size_t)(b * 512 + seg * 32 + i) * 512 + c, h); h = __expf(ca[i]) * h + chv[i]; }
}
__device__ __forceinline__ void ph_lru_c(const Args& a, int bid, int nblk) {
    const bf16_t* LA = (const bf16_t*)(a.ws + WS_A); const bf16_t* U = LA + (size_t)NTOK * 512; const bf16_t* P = (const bf16_t*)(a.ws + WS_B);
    const float* CIN = (const float*)((unsigned char*)a.out + DO_LRU) + (size_t)4096 * 512; bf16_t* MIX = (bf16_t*)(a.ws + WS_D);
    const int c = threadIdx.x;
    for (int u = bid; u < NTOK / 16; u += nblk) { float la[16], uv[16], gt[16];
        float h = CIN[(size_t)u * 512 + c];
#pragma unroll
        for (int hf = 0; hf < 2; ++hf) { const u32x4_t l4 = *(const u32x4_t*)(LA + ((size_t)u * 512 + c) * 16 + hf * 8), u4 = *(const u32x4_t*)(U + ((size_t)u * 512 + c) * 16 + hf * 8), g4 = *(const u32x4_t*)(P + ((size_t)u * ABC + 1792 + c) * 16 + hf * 8);
#pragma unroll
            for (int e = 0; e < 4; ++e) { gt[hf * 8 + 2 * e] = __uint_as_float(g4[e] << 16); gt[hf * 8 + 2 * e + 1] = __uint_as_float(g4[e] & 0xffff0000u); la[hf * 8 + 2 * e] = __uint_as_float(l4[e] << 16); la[hf * 8 + 2 * e + 1] = __uint_as_float(l4[e] & 0xffff0000u); uv[hf * 8 + 2 * e] = __uint_as_float(u4[e] << 16); uv[hf * 8 + 2 * e + 1] = __uint_as_float(u4[e] & 0xffff0000u); } }
#pragma unroll
        for (int s = 0; s < 16; ++s) { const int n = u * 16 + s; h = __expf(la[s]) * h + uv[s];
            const float x = gt[s], t2 = 0.7978845608028654f * (x + 0.044715f * x * x * x); const float th = 1.f - 2.f * __builtin_amdgcn_rcpf(1.f + __expf(2.f * t2));
            MIX[(size_t)n * DM + 512 + c] = f2bf(h * 0.5f * x * (1.f + th)); } }
}
#ifndef SP_MODE
#define SP_MODE 0
#endif
#ifndef SP_VAR
#define SP_VAR 0
#endif
constexpr bool SCAN_COOP = true; constexpr int NSCAN = SCAN_COOP ? 64 : 32;
template <int VAR = 0, bool COOP = false>
__device__ __forceinline__ void ph_rwkv_scan(const Args& a, LAS unsigned char* L) {
    if (blockIdx.x >= (COOP ? 64 : 32)) return;
    constexpr int SLOT = 9472, GOFF = 9216, NS = 14, NCH = SEQ / 16; constexpr size_t CSTR = (size_t)8 * RW_REC;
    const unsigned char* FR = a.ws + WS_C; float* Yr = (float*)((unsigned char*)a.out + DO_YR);
    const int chain = COOP ? ((int)blockIdx.x & 31) : (int)blockIdx.x, half = COOP ? ((int)blockIdx.x >> 5) : 0;
    const int b = chain >> 3, h = chain & 7, lane = threadIdx.x & 63, wave = __builtin_amdgcn_readfirstlane(threadIdx.x >> 6), q4 = lane >> 4, c16 = lane & 15;
    const unsigned char* FRb = FR + ((size_t)(b * NCH) * 8 + h) * RW_REC;
#define RW_BARRIER() do { asm volatile("" ::: "memory"); __builtin_amdgcn_s_barrier(); asm volatile("" ::: "memory"); } while (0)
    if (COOP && wave >= 4) {
        const int lw = wave - 4, sub = lw & 1; const bool far = lw < 2;
        const int set = far ? half : (half ^ 1);
        const int p0 = set * 5 + sub * 3, n1k = (sub == 0) ? 3 : (set == 0 ? 2 : 1); const bool hasG = (set == 1) && (sub == 1);
        const unsigned char* rp = FRb + lane * 16 + p0 * 1024; int so = p0 * 1024;
#define RW_CISSUE() do { LAS unsigned char* _slot = L + so; \
            _Pragma("unroll") for (int _j = 0; _j < 3; ++_j) if (_j < n1k) __builtin_amdgcn_global_load_lds((const unsigned*)(rp + _j * 1024), (LAS unsigned*)(_slot + _j * 1024), 16, 0, 0); \
            if (hasG) __builtin_amdgcn_global_load_lds((const unsigned*)(rp - lane * 12 - p0 * 1024 + RW_G), (LAS unsigned*)(_slot - p0 * 1024 + GOFF), 4, 0, 0); \
            rp += CSTR; so += SLOT; if (so >= NS * SLOT) so -= NS * SLOT; } while (0)
        if (far) {
#define RW_CWAIT() do { if (sub == 0) asm volatile("s_waitcnt vmcnt(27)" ::: "memory"); else asm volatile("s_waitcnt vmcnt(18)" ::: "memory"); } while (0)
            for (int p = 0; p < NS - 2; ++p) RW_CISSUE();
            RW_CWAIT(); RW_BARRIER();
#pragma unroll 1
            for (int it = 0; it < NCH / 2; ++it) { RW_CISSUE(); RW_CISSUE(); RW_CWAIT(); RW_BARRIER(); }
#undef RW_CWAIT
        } else {
#define RW_CWAIT() do { if (sub == 0) asm volatile("s_waitcnt vmcnt(6)" ::: "memory"); else asm volatile("s_waitcnt vmcnt(4)" ::: "memory"); } while (0)
            for (int p = 0; p < 5; ++p) RW_CISSUE();
            RW_CWAIT(); RW_BARRIER();
#pragma unroll 1
            for (int it = 0; it < NCH / 2; ++it) { RW_CISSUE(); RW_CISSUE(); RW_CWAIT(); RW_BARRIER(); }
#undef RW_CWAIT
        }
        asm volatile("s_waitcnt vmcnt(0)" ::: "memory");
#undef RW_CISSUE
    } else if (COOP && wave >= 2) {
        RW_BARRIER();
#pragma unroll 1
        for (int it = 0; it < NCH / 2; ++it) RW_BARRIER();
    } else if (wave >= 4) {
        const int lw = wave - 4;
        const unsigned char* rp = FRb + lane * 16; int so = 0;
#define RW_ISSUE1() do { LAS unsigned char* _slot = L + so; \
            if (VAR & 1) { } else if (lw < 2) { _Pragma("unroll") for (int _j = 0; _j < 3; ++_j) __builtin_amdgcn_global_load_lds((const unsigned*)(rp + (lw * 3 + _j) * 1024), (LAS unsigned*)(_slot + (lw * 3 + _j) * 1024), 16, 0, 0); } \
            else if (lw == 2) { _Pragma("unroll") for (int _j = 0; _j < 2; ++_j) __builtin_amdgcn_global_load_lds((const unsigned*)(rp + (6 + _j) * 1024), (LAS unsigned*)(_slot + (6 + _j) * 1024), 16, 0, 0); } \
            else { __builtin_amdgcn_global_load_lds((const unsigned*)(rp + 8 * 1024), (LAS unsigned*)(_slot + 8 * 1024), 16, 0, 0); \
                   __builtin_amdgcn_global_load_lds((const unsigned*)(rp - lane * 12 + RW_G), (LAS unsigned*)(_slot + GOFF), 4, 0, 0); } \
            if (!(VAR & 8)) rp += CSTR; so += SLOT; if (so == NS * SLOT) so = 0; } while (0)
#if SP_MODE & 4
#define RW_ISSUE() do { RW_ISSUE1(); rp -= CSTR; so -= SLOT; if (so < 0) so += NS * SLOT; RW_ISSUE1(); } while (0)
#else
#define RW_ISSUE() RW_ISSUE1()
#endif
#if SP_MODE & 4
#define RW_LWAIT() do { if (lw < 2) asm volatile("s_waitcnt vmcnt(54)" ::: "memory"); else asm volatile("s_waitcnt vmcnt(36)" ::: "memory"); } while (0)
#else
#define RW_LWAIT() do { if (lw < 2) asm volatile("s_waitcnt vmcnt(27)" ::: "memory"); else asm volatile("s_waitcnt vmcnt(18)" ::: "memory"); } while (0)
#endif
        for (int p = 0; p < NS - 2; ++p) RW_ISSUE();
        RW_LWAIT();
        RW_BARRIER();
#pragma unroll 1
        for (int it = 0; it < NCH / 2; ++it) { RW_ISSUE(); RW_ISSUE(); RW_LWAIT(); RW_BARRIER(); }
        asm volatile("s_waitcnt vmcnt(0)" ::: "memory");
#undef RW_ISSUE
#undef RW_ISSUE1
#undef RW_LWAIT
    } else {
        const int vs = COOP ? 2 * half + wave : wave;
#if SP_MODE & 2
        __builtin_amdgcn_s_setprio(3);
#endif
        f32x4 T[4];
#pragma unroll
        for (int i = 0; i < 4; ++i) T[i] = (f32x4){0.f, 0.f, 0.f, 0.f};
        struct Ops { bf16x8_t wmf[2], rf[2], bkf[4], arf; f32x4 g4[4]; };
        const LAS unsigned char* lp = L + lane * 16; const LAS unsigned char* lg = L + GOFF + q4 * 16; int so = 0;
        const unsigned char* up = FRb + RW_U + (vs * 64 + lane) * 8;
        float* yp = Yr + ((size_t)(b * NCH) * 8 + h) * 1024 + vs * 256 + lane * 4;
#if SP_MODE & 8
#define RW_LOAD(O) do { { const LAS unsigned char* _r = lp + so; const LAS unsigned char* _g = lg + so; \
            _Pragma("unroll") for (int _s = 0; _s < 2; ++_s) { bf16x8_t _t0 = *(const LAS bf16x8_t*)(_r + RW_WMF + _s * 1024); bf16x8_t _t1 = *(const LAS bf16x8_t*)(_r + RW_RF + _s * 1024); asm volatile("" :: "v"(_t0), "v"(_t1)); } \
            _Pragma("unroll") for (int _i = 0; _i < 4; ++_i) { bf16x8_t _t0 = *(const LAS bf16x8_t*)(_r + RW_BKF + _i * 1024); f32x4 _t1 = *(const LAS f32x4*)(_g + _i * 64); asm volatile("" :: "v"(_t0), "v"(_t1)); } \
            { bf16x8_t _t0 = *(const LAS bf16x8_t*)(_r + RW_ARF); asm volatile("" :: "v"(_t0)); } asm volatile("" ::: "memory"); } RW_LOAD1(O); } while (0)
#else
#define RW_LOAD(O) RW_LOAD1(O)
#endif
#define RW_LOAD1(O) do { const LAS unsigned char* _r = lp + so; const LAS unsigned char* _g = lg + so; \
            _Pragma("unroll") for (int _s = 0; _s < 2; ++_s) { O.wmf[_s] = *(const LAS bf16x8_t*)(_r + RW_WMF + _s * 1024); O.rf[_s] = *(const LAS bf16x8_t*)(_r + RW_RF + _s * 1024); } \
            _Pragma("unroll") for (int _i = 0; _i < 4; ++_i) O.bkf[_i] = *(const LAS bf16x8_t*)(_r + RW_BKF + _i * 1024); \
            O.arf = *(const LAS bf16x8_t*)(_r + RW_ARF); \
            _Pragma("unroll") for (int _i = 0; _i < 4; ++_i) O.g4[_i] = *(const LAS f32x4*)(_g + _i * 64); \
            so += SLOT; if (so == NS * SLOT) so = 0; \
            __builtin_amdgcn_sched_barrier(0); } while (0)
#define RW_UV(dst) do { if (!(VAR & 2)) { dst[0] = *(const u32x2_t*)up; dst[1] = *(const u32x2_t*)(up + 2048); } else { asm volatile("" : "+v"(dst[0]), "+v"(dst[1])); } if (!(VAR & 16)) up += CSTR; } while (0)
#define RW_STEP(O, uv) do { \
            bf16x8_t _bS[2]; \
            _Pragma("unroll") for (int _s = 0; _s < 2; ++_s) { const u32x4_t _pk = (u32x4_t){pk2(T[2 * _s][0], T[2 * _s][1]), pk2(T[2 * _s][2], T[2 * _s][3]), pk2(T[2 * _s + 1][0], T[2 * _s + 1][1]), pk2(T[2 * _s + 1][2], T[2 * _s + 1][3])}; \
                _bS[_s] = __builtin_bit_cast(bf16x8_t, _pk); } \
            f32x4 _z = (f32x4){__uint_as_float(uv[0].x << 16), __uint_as_float(uv[0].x & 0xffff0000u), __uint_as_float(uv[0].y << 16), __uint_as_float(uv[0].y & 0xffff0000u)}; \
            _z = __builtin_amdgcn_mfma_f32_16x16x32_bf16(O.wmf[0], _bS[0], _z, 0, 0, 0); _z = __builtin_amdgcn_mfma_f32_16x16x32_bf16(O.wmf[1], _bS[1], _z, 0, 0, 0); \
            f32x4 _y = (f32x4){0.f, 0.f, 0.f, 0.f}; \
            _y = __builtin_amdgcn_mfma_f32_16x16x32_bf16(_bS[0], O.rf[0], _y, 0, 0, 0); _y = __builtin_amdgcn_mfma_f32_16x16x32_bf16(_bS[1], O.rf[1], _y, 0, 0, 0); \
            const u32x4_t _zvp = (u32x4_t){pk2(-_z[0], -_z[1]), pk2(-_z[2], -_z[3]), uv[1].x, uv[1].y}; \
            const bf16x8_t _bZV = __builtin_bit_cast(bf16x8_t, _zvp); \
            _Pragma("unroll") for (int _i = 0; _i < 4; ++_i) { T[_i] = __builtin_amdgcn_mfma_f32_16x16x32_bf16(O.bkf[_i], _bZV, T[_i], 0, 0, 0); T[_i] = T[_i] * O.g4[_i]; } \
            _y = __builtin_amdgcn_mfma_f32_16x16x32_bf16(_bZV, O.arf, _y, 0, 0, 0); \
            if (!(VAR & 4)) *(f32x4*)yp = _y; else asm volatile("" :: "v"(_y)); RW_ST2(); yp += 8 * 1024; } while (0)
#if SP_MODE & 16
#define RW_ST2() do { asm volatile("" ::: "memory"); *(f32x4*)yp = _y; } while (0)
#else
#define RW_ST2() do { } while (0)
#endif
#define RW_SYNC() do { asm volatile("s_waitcnt lgkmcnt(0)" ::: "memory"); RW_BARRIER(); } while (0)
        Ops A, B;
        u32x2_t uv0[2], uv1[2], uv2[2], uv3[2], uv4[2], uv5[2], uv6[2], uv7[2];
        RW_UV(uv0); RW_UV(uv1); RW_UV(uv2); RW_UV(uv3); RW_UV(uv4); RW_UV(uv5); RW_UV(uv6); RW_UV(uv7);
        RW_BARRIER();
        RW_LOAD(A);
#pragma unroll 1
        for (int ch = 0; ch < NCH; ch += 8) {
            RW_LOAD(B); RW_STEP(A, uv0); RW_UV(uv0);
            RW_LOAD(A); RW_STEP(B, uv1); RW_UV(uv1); RW_SYNC();
            RW_LOAD(B); RW_STEP(A, uv2); RW_UV(uv2);
            RW_LOAD(A); RW_STEP(B, uv3); RW_UV(uv3); RW_SYNC();
            RW_LOAD(B); RW_STEP(A, uv4); RW_UV(uv4);
            RW_LOAD(A); RW_STEP(B, uv5); RW_UV(uv5); RW_SYNC();
            RW_LOAD(B); RW_STEP(A, uv6); RW_UV(uv6);
            RW_LOAD(A); RW_STEP(B, uv7); RW_UV(uv7); RW_SYNC(); }
#undef RW_SYNC
#undef RW_LOAD
#undef RW_LOAD1
#undef RW_STEP
#undef RW_UV
    }
#undef RW_BARRIER
}
__device__ __forceinline__ void ph_rwkv_post(const Args& a, LAS float* lds) {
    const bf16_t* V = (const bf16_t*)a.out; const float* Bon = (const float*)((const unsigned char*)a.out + DO_BON); const bf16_t* SG = (const bf16_t*)((const unsigned char*)a.out + DO_SG);
    const float* Yr = (const float*)((const unsigned char*)a.out + DO_YR); bf16_t* MIX = (bf16_t*)(a.ws + WS_D);
    const float* ln_w = a.in[14]; const float* ln_b = a.in[15];
    LAS unsigned char* L = (LAS unsigned char*)lds;
    const int c = threadIdx.x, lane = c & 63, h = c >> 6, q4 = lane >> 4, c16 = lane & 15;
    const bf16_t* FG = (const bf16_t*)(a.ws + FG_G2) + h * 8192;
    LAS unsigned char* TW = L + 8192 + h * 2304;
    for (int tile = blockIdx.x; tile < NTOK / 16; tile += gridDim.x) {
        const int n0 = tile * 16;
        __syncthreads();
        { const int tk = c >> 5, j4 = (c & 31) * 4; *(LAS u32x2_t*)(L + tk * 272 + j4 * 2) = *(const u32x2_t*)(SG + (size_t)tile * 2048 + (j4 >> 4) * 256 + tk * 16 + (j4 & 15)); }
        __syncthreads();
        const int n = n0 + c16;
        f32x4 g[4], y[4];
#pragma unroll
        for (int ct = 0; ct < 4; ++ct) { g[ct] = (f32x4){0.f, 0.f, 0.f, 0.f};
#pragma unroll
            for (int ks = 0; ks < 4; ++ks) { const bf16x8_t af = *(const bf16x8_t*)(FG + ((size_t)(ct * 4 + ks) * 64 + lane) * 8); const bf16x8_t bfr = *(const LAS bf16x8_t*)(L + c16 * 272 + ks * 64 + q4 * 16);
                g[ct] = __builtin_amdgcn_mfma_f32_16x16x32_bf16(af, bfr, g[ct], 0, 0, 0); }
            y[ct] = *(const f32x4*)(Yr + (size_t)tile * 8192 + h * 1024 + ct * 256 + lane * 4); }
        float sm = 0.f;
#pragma unroll
        for (int ct = 0; ct < 4; ++ct) sm += (y[ct][0] + y[ct][1]) + (y[ct][2] + y[ct][3]);
        sm = xrow16_sum(sm);
        const float mean = sm * (1.f / 64.f);
        float sv = 0.f;
#pragma unroll
        for (int ct = 0; ct < 4; ++ct) { y[ct] = y[ct] - mean; sv += (y[ct][0] * y[ct][0] + y[ct][1] * y[ct][1]) + (y[ct][2] * y[ct][2] + y[ct][3] * y[ct][3]); }
        sv = xrow16_sum(sv);
        const float rstd = rsqrtf(sv * (1.f / 64.f) + 64e-5f), bsc = Bon[(size_t)n * 8 + h];
#pragma unroll
        for (int ct = 0; ct < 4; ++ct) { const int ch = 64 * h + 16 * ct + 4 * q4;
            const f32x4 lw = *(const f32x4*)(ln_w + ch), lb = *(const f32x4*)(ln_b + ch);
            const u32x2_t vv = *(const u32x2_t*)(V + (size_t)n * 512 + ch);
            const float v0 = __uint_as_float(vv.x << 16), v1 = __uint_as_float(vv.x & 0xffff0000u), v2 = __uint_as_float(vv.y << 16), v3 = __uint_as_float(vv.y & 0xffff0000u);
            const float o0 = (y[ct][0] * rstd * lw[0] + lb[0] + bsc * v0) * g[ct][0], o1 = (y[ct][1] * rstd * lw[1] + lb[1] + bsc * v1) * g[ct][1];
            const float o2 = (y[ct][2] * rstd * lw[2] + lb[2] + bsc * v2) * g[ct][2], o3 = (y[ct][3] * rstd * lw[3] + lb[3] + bsc * v3) * g[ct][3];
            *(LAS u32x2_t*)(TW + c16 * 136 + ct * 32 + q4 * 8) = (u32x2_t){pk2(o0, o1), pk2(o2, o3)}; }
#pragma unroll
        for (int j = 0; j < 2; ++j) { const int tk = 8 * j + (lane >> 3), pc = lane & 7;
            *(u32x4_t*)(MIX + (size_t)(n0 + tk) * DM + 64 * h + pc * 8) = *(const LAS u32x4_t*)(TW + tk * 136 + pc * 16); }
    }
}

namespace gla {
typedef short bf16x8 __attribute__((ext_vector_type(8)));
typedef float f32x16 __attribute__((ext_vector_type(16)));
typedef unsigned u32x4 __attribute__((ext_vector_type(4)));
typedef unsigned u32x2 __attribute__((ext_vector_type(2)));
constexpr int QH_OFF = 0, KH_OFF = 17408, KT_OFF = 34816, VT_OFF = 53248, ST_OFF = 71680, AM_OFF = 106496, EB_OFF = 115712, ER_OFF = 116224, PS_OFF = 116736, SSQ_OFF = 118784, OT_OFF = 119808;
constexpr int QS = 272, TS = 144;
#define GLA_BAR() do { asm volatile("s_waitcnt lgkmcnt(0)" ::: "memory"); __builtin_amdgcn_s_barrier(); asm volatile("" ::: "memory"); } while (0)
template <bool OUT>
__device__ __forceinline__ void unit(const Args& a, LAS unsigned char* L, int u) {
    const int tid = threadIdx.x, lane = tid & 63, w = tid >> 6;
    const int b = u >> 6, h = (u >> 3) & 7, j = u & 7;
    const bf16_t* Q = (const bf16_t*)(a.ws + WS_QFIG) + ((size_t)b * SEQ + (size_t)j * 1024) * 4096 + h * 128;
    float* Lb = (float*)(a.ws + WS_O); float* Db = Lb + (size_t)256 * 16384;
    const int dk = tid & 127, tg = tid >> 7;
    const float c0 = a.in[25][h * 128 + dk], c1 = a.in[25][1024 + h * 128 + dk];
    const float lbv = __builtin_amdgcn_rcpf(1.f + __expf(c0 - c1)), omlb = 1.f - lbv;
    LAS float* PS = (LAS float*)(L + PS_OFF); LAS float* EB = (LAS float*)(L + EB_OFF); LAS float* ER = (LAS float*)(L + ER_OFF); LAS float* SSQ = (LAS float*)(L + SSQ_OFF);
    const int si = w >> 1, sj0 = (w & 1) * 2, l31 = lane & 31, l5 = lane >> 5;
    const int ri = w >> 2, cj = w & 3, odv = 32 * cj + l31;
    f32x16 S[2];
#pragma unroll
    for (int jj = 0; jj < 2; ++jj)
#pragma unroll
        for (int r = 0; r < 16; ++r) S[jj][r] = 0.f;
    if (OUT) {
#pragma unroll 1
        for (int i = 0; i < j; ++i) { const int ui = u - j + i;
#pragma unroll
            for (int jj = 0; jj < 2; ++jj)
#pragma unroll
                for (int rg = 0; rg < 4; ++rg) { const int sdk0 = 32 * si + 8 * rg + 4 * l5, sdv = 32 * (sj0 + jj) + l31; const f32x4 dd = *(const f32x4*)(Db + ui * 128 + sdk0);
#pragma unroll
                    for (int e = 0; e < 4; ++e) S[jj][4 * rg + e] = dd[e] * S[jj][4 * rg + e] + Lb[(size_t)ui * 16384 + (sdk0 + e) * 128 + sdv]; } } }
    const float nwv = OUT ? a.in[26][h * 128 + odv] : 0.f;
    float dsum = 1.f;
    const int prow = tid >> 4, ppc = tid & 15;
    u32x4 pf[2], pv[2], pq[2];
#define GLA_PREFETCH(cx) do { const bf16_t* _q = Q + (size_t)((cx) * 64 + prow) * 4096 + ppc * 8; \
        _Pragma("unroll") for (int _r = 0; _r < 2; ++_r) { pf[_r] = *(const u32x4*)(_q + (size_t)_r * 32 * 4096 + 1024); pv[_r] = *(const u32x4*)(_q + (size_t)_r * 32 * 4096 + 2048); if (OUT) pq[_r] = *(const u32x4*)(_q + (size_t)_r * 32 * 4096); } } while (0)
    GLA_PREFETCH(0);
#pragma unroll 1
    for (int c = 0; c < 16; ++c) {
        int cc = c; asm volatile("" : "+s"(cc));
#pragma unroll
        for (int r = 0; r < 2; ++r) { *(LAS u32x4*)(L + KH_OFF + (prow + 32 * r) * QS + ppc * 16) = pf[r]; *(LAS u32x4*)(L + ST_OFF + (prow + 32 * r) * QS + ppc * 16) = pv[r];
            if (OUT) *(LAS u32x4*)(L + QH_OFF + (prow + 32 * r) * QS + ppc * 16) = pq[r]; }
        if (c + 1 < 16) GLA_PREFETCH(cc + 1);
        u32x4 gq[2];
        if (OUT) { const bf16_t* G = Q + (size_t)(cc * 64) * 4096 + 3072;
            unsigned go = (unsigned)((tid >> 3) * 4096 + (tid & 7) * 16); asm volatile("" : "+v"(go));
            gq[0] = *(const u32x4*)(G + go); gq[1] = *(const u32x4*)(G + go + 8u); }
        GLA_BAR();
        float lf[16], kk[16];
#pragma unroll
        for (int i = 0; i < 16; ++i) { const float fv = bf2f(*(const LAS bf16_t*)(L + KH_OFF + (tg * 16 + i) * QS + dk * 2)); const float sg = __builtin_amdgcn_rcpf(1.f + __expf(-fv));
            lf[i] = lbv + omlb * sg; kk[i] = omlb * (1.f - sg); }
#pragma unroll
        for (int i = 1; i < 16; ++i) lf[i] *= lf[i - 1];
        PS[tg * 128 + dk] = lf[15];
        GLA_BAR();
        const float p0 = PS[dk], p1 = PS[128 + dk], p2 = PS[256 + dk], p3 = PS[384 + dk];
        const float off = (tg > 0 ? p0 : 1.f) * (tg > 1 ? p1 : 1.f) * (tg > 2 ? p2 : 1.f);
        const float pref = p0 * p1, pbl = pref * (p2 * p3), ebr = p2 * p3;
        const float ioff = off * __builtin_amdgcn_rcpf(pref);
        unsigned ktp[8], vtp[8];
#pragma unroll
        for (int i = 0; i < 16; i += 2) {
            float kb[2]; unsigned vv[2];
#pragma unroll
            for (int q = 0; q < 2; ++q) { const float e1 = ioff * lf[i + q]; const float e2 = __builtin_amdgcn_rcpf(e1);
                const float khat = kk[i + q] * e2; kb[q] = khat * ebr; vv[q] = *(const LAS bf16_t*)(L + ST_OFF + (tg * 16 + i + q) * QS + dk * 2);
                if (OUT) { LAS bf16_t* qp = (LAS bf16_t*)(L + QH_OFF + (tg * 16 + i + q) * QS + dk * 2); const float qr = bf2f(*qp); const float qv = qr * __builtin_amdgcn_rcpf(1.f + __expf(-qr));
                    *qp = f2bf(qv * e1); *(LAS bf16_t*)(L + KH_OFF + (tg * 16 + i + q) * QS + dk * 2) = f2bf(khat); } }
            ktp[i >> 1] = pk2(kb[0], kb[1]); vtp[i >> 1] = vv[0] | (vv[1] << 16);
        }
        *(LAS u32x4*)(L + KT_OFF + dk * TS + tg * 32) = (u32x4){ktp[0], ktp[1], ktp[2], ktp[3]}; *(LAS u32x4*)(L + KT_OFF + dk * TS + tg * 32 + 16) = (u32x4){ktp[4], ktp[5], ktp[6], ktp[7]};
        *(LAS u32x4*)(L + VT_OFF + dk * TS + tg * 32) = (u32x4){vtp[0], vtp[1], vtp[2], vtp[3]}; *(LAS u32x4*)(L + VT_OFF + dk * TS + tg * 32 + 16) = (u32x4){vtp[4], vtp[5], vtp[6], vtp[7]};
        if (tg == 0) { EB[dk] = pbl; ER[dk] = pref; dsum *= pbl; }
        GLA_BAR();
        f32x16 o;
        if (OUT) {
#pragma unroll
            for (int jj = 0; jj < 2; ++jj)
#pragma unroll
                for (int rg = 0; rg < 4; ++rg) { const int dk0 = 32 * si + 8 * rg + 4 * l5; const f32x4 er = *(const LAS f32x4*)(ER + dk0);
                    u32x2 pk; pk.x = pk2(S[jj][4 * rg] * er[0], S[jj][4 * rg + 1] * er[1]); pk.y = pk2(S[jj][4 * rg + 2] * er[2], S[jj][4 * rg + 3] * er[3]);
                    *(LAS u32x2*)(L + ST_OFF + (32 * (sj0 + jj) + l31) * QS + dk0 * 2) = pk; }
#pragma unroll
            for (int q = 0; q < 2; ++q) { const int ti = w >> 1, tj = (w & 1) * 2 + q;
                f32x4 sc = (f32x4){0.f, 0.f, 0.f, 0.f};
                if (tj <= ti) {
#pragma unroll
                    for (int ks = 0; ks < 4; ++ks) { const bf16x8 af = *(const LAS bf16x8*)(L + QH_OFF + (16 * ti + (lane & 15)) * QS + ks * 64 + (lane >> 4) * 16);
                        const bf16x8 bfr = *(const LAS bf16x8*)(L + KH_OFF + (16 * tj + (lane & 15)) * QS + ks * 64 + (lane >> 4) * 16);
                        sc = __builtin_amdgcn_mfma_f32_16x16x32_bf16(af, bfr, sc, 0, 0, 0); } }
                const int scol = 16 * tj + (lane & 15);
#pragma unroll
                for (int r = 0; r < 4; ++r) { const int trow = 16 * ti + 4 * (lane >> 4) + r; const float v = (scol <= trow) ? sc[r] : 0.f;
                    *(LAS bf16_t*)(L + AM_OFF + trow * TS + scol * 2) = f2bf(v); } }
            GLA_BAR();
#pragma unroll
            for (int r = 0; r < 16; ++r) o[r] = 0.f;
#pragma unroll
            for (int ks = 0; ks < 4; ++ks) if (ks < 2 * (ri + 1)) {
                const bf16x8 af = *(const LAS bf16x8*)(L + AM_OFF + (32 * ri + l31) * TS + ks * 32 + l5 * 16);
                const bf16x8 bfr = *(const LAS bf16x8*)(L + VT_OFF + (32 * cj + l31) * TS + ks * 32 + l5 * 16);
                o = __builtin_amdgcn_mfma_f32_32x32x16_bf16(af, bfr, o, 0, 0, 0); }
#pragma unroll
            for (int ks = 0; ks < 8; ++ks) { if ((ks & 3) == 0) asm volatile("" ::: "memory");
                const bf16x8 af = *(const LAS bf16x8*)(L + QH_OFF + (32 * ri + l31) * QS + ks * 32 + l5 * 16);
                const bf16x8 bfr = *(const LAS bf16x8*)(L + ST_OFF + (32 * cj + l31) * QS + ks * 32 + l5 * 16);
                o = __builtin_amdgcn_mfma_f32_32x32x16_bf16(af, bfr, o, 0, 0, 0); }
#pragma unroll
            for (int r = 0; r < 16; ++r) { const float q2 = xrow32_sum(row16_sum(o[r] * o[r]));
                if (l31 == 0) SSQ[(32 * ri + (r & 3) + 8 * (r >> 2) + 4 * l5) * 4 + cj] = q2; }
#pragma unroll
            for (int r = 0; r < 16; ++r) *(LAS float*)(L + OT_OFF + (32 * ri + (r & 3) + 8 * (r >> 2) + 4 * l5) * 528 + odv * 4) = o[r] * nwv;
        }
        {
            bf16x8 af[4];
#pragma unroll
            for (int ks = 0; ks < 4; ++ks) af[ks] = *(const LAS bf16x8*)(L + KT_OFF + (32 * si + l31) * TS + ks * 32 + l5 * 16);
#pragma unroll
            for (int jj = 0; jj < 2; ++jj) {
#pragma unroll
                for (int rg = 0; rg < 4; ++rg) { const f32x4 eb = *(const LAS f32x4*)(EB + 32 * si + 8 * rg + 4 * l5);
                    S[jj][4 * rg] *= eb[0]; S[jj][4 * rg + 1] *= eb[1]; S[jj][4 * rg + 2] *= eb[2]; S[jj][4 * rg + 3] *= eb[3]; }
#pragma unroll
                for (int ks = 0; ks < 4; ++ks) { const bf16x8 bfr = *(const LAS bf16x8*)(L + VT_OFF + (32 * (sj0 + jj) + l31) * TS + ks * 32 + l5 * 16);
                    S[jj] = __builtin_amdgcn_mfma_f32_32x32x16_bf16(af[ks], bfr, S[jj], 0, 0, 0); } }
        }
        GLA_BAR();
        if (OUT) {
            const int et = tid >> 3, ep = tid & 7;
            const f32x4 q4 = *(const LAS f32x4*)(SSQ + et * 4);
            const float rs = rsqrtf(((q4[0] + q4[1]) + (q4[2] + q4[3])) * (1.f / 128.f) + 1e-6f);
            bf16_t* MIX = (bf16_t*)(a.ws + WS_MIX1) + ((size_t)b * SEQ + (size_t)j * 1024 + cc * 64) * DM + h * 128;
            unsigned mo = (unsigned)(et * DM + ep * 16); asm volatile("" : "+v"(mo));
#pragma unroll
            for (int hf = 0; hf < 2; ++hf) { unsigned ov[4];
#pragma unroll
                for (int e2 = 0; e2 < 2; ++e2) { const f32x4 o4 = *(const LAS f32x4*)(L + OT_OFF + et * 528 + ep * 64 + hf * 32 + e2 * 16);
#pragma unroll
                    for (int e = 0; e < 2; ++e) { const unsigned gw = gq[hf][e2 * 2 + e]; const float g0 = __uint_as_float(gw << 16), g1 = __uint_as_float(gw & 0xffff0000u);
                        ov[e2 * 2 + e] = pk2(o4[2 * e] * rs * g0 * __builtin_amdgcn_rcpf(1.f + __expf(-g0)), o4[2 * e + 1] * rs * g1 * __builtin_amdgcn_rcpf(1.f + __expf(-g1))); } }
                *(u32x4*)(MIX + mo + hf * 8) = (u32x4){ov[0], ov[1], ov[2], ov[3]}; }
        }
    }
    if (!OUT) {
#pragma unroll
        for (int jj = 0; jj < 2; ++jj)
#pragma unroll
            for (int r = 0; r < 16; ++r) { const int sdk = 32 * si + (r & 3) + 8 * (r >> 2) + 4 * l5, sdv = 32 * (sj0 + jj) + l31; Lb[(size_t)u * 16384 + sdk * 128 + sdv] = S[jj][r]; }
        if (tg == 0) Db[u * 128 + dk] = dsum;
    }
    GLA_BAR();
#undef GLA_PREFETCH
}
__device__ __forceinline__ void pass2(const Args& a) {
    float* Lb = (float*)(a.ws + WS_O); const float* Db = Lb + (size_t)256 * 16384;
    for (int idx = blockIdx.x * NTHREADS + threadIdx.x; idx < 32 * 16384; idx += gridDim.x * NTHREADS) { const int bh = idx >> 14, el = idx & 16383, dkk = el >> 7; float sacc = 0.f;
        for (int j = 0; j < 8; ++j) { const int u = bh * 8 + j; const size_t o = (size_t)u * 16384 + el;
            if (j < 7) { const float tmp = Lb[o]; Lb[o] = sacc; sacc = Db[u * 128 + dkk] * sacc + tmp; } else Lb[o] = sacc; } }
}
}

constexpr int NPHASE = 24;
__global__ void __launch_bounds__(NTHREADS, 2) fwd(Args a) {
    extern __shared__ __attribute__((aligned(16))) unsigned char lds_raw[];
    LAS unsigned char* ldsb = (LAS unsigned char*)lds_raw;
    LAS float* lds = (LAS float*)ldsb;
    LAS int* pst = (LAS int*)(ldsb + LDS_MISC);
    volatile LAS unsigned* xbw = (volatile LAS unsigned*)(ldsb + LDS_MISC + 256);
    if (threadIdx.x == 0) { xbw[0] = 0u; xbw[1] = 0u; }
    __syncthreads();
    unsigned* ctl = (unsigned*)(a.ws + WS_CTL);
    const bool multi = (a.ph_hi - a.ph_lo) > 1;
    XcdBarrier bar; bar.bar = ctl; bar.x = 0; bar.st = xbw;
    if (multi) bar = xcd_barrier_post(ctl, xbw);
    unsigned char* ws = a.ws;
    bf16_t* HN = (bf16_t*)(ws + WS_A);
    bf16_t* XR = (bf16_t*)(ws + WS_XR); float* RSv = (float*)(ws + WS_ROUTE + RT_LRU_CH);
    int* list_slot = (int*)(ws + WS_LIST); float* list_gate = (float*)(ws + WS_LIST + (size_t)NEXP * MOE_CAP * 4);
#ifndef PHSEL
#define PHSEL(k) true
#endif
#ifndef REPMASK
#define REPMASK 0u
#endif
#define NREP(k) (((REPMASK >> (k)) & 1u) ? 2 : 1)
#define IN(k) (PHSEL(k) && a.ph_lo <= (k) && (k) < a.ph_hi)
#define SEAM(k) do { if (IN((k) + 1) && multi) xcd_barrier(bar); } while (0)
    if (IN(0)) { ph_cvt_frags(a); ph_cvt_dense_a(a, lds, ctl + CW_COLMAX, blockIdx.x, gridDim.x, 0); ph_norm0(a.in[0], a.in[1], (unsigned char*)HN, (float*)(ws + WS_ROUTE + RT_LRU_CH + 262144)); xcd_barrier(bar); ph_cvt_dense_b(a, lds, ctl + CW_COLMAX, 0, blockIdx.x, gridDim.x); }
#if (REPMASK >> 0) & 1
    if (IN(0)) { xcd_barrier(bar);  ph_cvt_frags(a); ph_cvt_dense_a(a, lds, ctl + CW_COLMAX, blockIdx.x, gridDim.x, 0); ph_norm0(a.in[0], a.in[1], (unsigned char*)HN, (float*)(ws + WS_ROUTE + RT_LRU_CH + 262144)); xcd_barrier(bar); ph_cvt_dense_b(a, lds, ctl + CW_COLMAX, 0, blockIdx.x, gridDim.x); }
#endif
    if (IN(0)) { SEAM(0); }
    if (IN(1)) { pg8::DenseOrder S; S.init(ABC, NTOK, DM / 2, gridDim.x, blockIdx.x, HN); pg8::EpiBf16IT E{(bf16_t*)(ws + WS_B), ABC, (float*)(ws + WS_ROUTE + RT_LRU_CH + 262144), ctl + CW_COLMAX};
        pg8::gemm_phase<pg8::EpiBf16IT, pg8::DenseOrder, true>(ldsb, (const char*)(ws + WD_ABIN), DM, DM / 2, S, E); }
#if (REPMASK >> 1) & 1
    if (IN(1)) { xcd_barrier(bar);  pg8::DenseOrder S; S.init(ABC, NTOK, DM / 2, gridDim.x, blockIdx.x, HN); pg8::EpiBf16IT E{(bf16_t*)(ws + WS_B), ABC, (float*)(ws + WS_ROUTE + RT_LRU_CH + 262144), ctl + CW_COLMAX};
        pg8::gemm_phase<pg8::EpiBf16IT, pg8::DenseOrder, true>(ldsb, (const char*)(ws + WD_ABIN), DM, DM / 2, S, E);  }
#endif
    if (IN(1)) { SEAM(1); }
    if (IN(2)) { ph_l0_prep(a, lds); }
#if (REPMASK >> 2) & 1
    if (IN(2)) { xcd_barrier(bar);  ph_l0_prep(a, lds);  }
#endif
    if (IN(2)) { SEAM(2); }
    if (IN(6)) {
        if (blockIdx.x < NSCAN) {
#if SP_MODE & 64
            ph_rwkv_scan<0, SCAN_COOP>(a, ldsb); __syncthreads();
#endif
#if SP_VAR
            ph_rwkv_scan<SP_VAR, SCAN_COOP>(a, ldsb); __syncthreads(); ph_rwkv_scan<0, SCAN_COOP>(a, ldsb);
#else
            ph_rwkv_scan<0, SCAN_COOP>(a, ldsb);
#endif
        } else { const int gb = (int)blockIdx.x - NSCAN, gn = (int)gridDim.x - NSCAN; unsigned* sctr = ctl + CW_CNT + 256;
            ph_lru_b(a, gb, lds); sub_barrier(sctr, (unsigned)gn);
#if SP_MODE & 1
            ph_lru_c(a, gb, gn); }
        xcd_barrier(bar); ph_wmax(a.in[32], a.in[33], ctl + CW_WMAX, blockIdx.x, gridDim.x); ph_cvt_dense_a(a, lds, ctl + CW_COLMAX, blockIdx.x, gridDim.x, 1); xcd_barrier(bar);
        ph_cvt_moe(a, 0, lds, blockIdx.x, gridDim.x, 3); ph_cvt_moe(a, 1, lds, blockIdx.x, gridDim.x, 1); ph_cvt_dense_b(a, lds, ctl + CW_COLMAX, 1, blockIdx.x, gridDim.x);
#else
            ph_lru_c(a, gb, gn); ph_wmax(a.in[32], a.in[33], ctl + CW_WMAX, gb, gn); ph_cvt_dense_a(a, lds, ctl + CW_COLMAX, gb, gn, 1); sub_barrier(sctr, 2u * (unsigned)gn);
            ph_cvt_moe(a, 0, lds, gb, gn, 3); ph_cvt_moe(a, 1, lds, gb, gn, 1); ph_cvt_dense_b(a, lds, ctl + CW_COLMAX, 1, gb, gn);
#if SP_MODE & 32
            ph_cvt_moe(a, 1, lds, gb, gn, 1);
#endif
            }
#endif
        SEAM(6); }
    if (IN(7)) { ph_rwkv_post(a, lds); }
#if (REPMASK >> 7) & 1
    if (IN(7)) { xcd_barrier(bar);  ph_rwkv_post(a, lds);  }
#endif
    if (IN(7)) { SEAM(7); }
    if (IN(8)) { pg8::DenseOrder S; S.init(NTOK, DM, DM, gridDim.x, blockIdx.x, ws + WD_ABOUT); pg8::EpiResid<true> E{a.in[0], XR};
        pg8::gemm_phase(ldsb, (const char*)(ws + WS_D), DM * 2, DM, S, E); }
#if (REPMASK >> 8) & 1
    if (IN(8)) { xcd_barrier(bar);  pg8::DenseOrder S; S.init(NTOK, DM, DM, gridDim.x, blockIdx.x, ws + WD_ABOUT); pg8::EpiResid<true> E{a.in[0], XR};
        pg8::gemm_phase(ldsb, (const char*)(ws + WS_D), DM * 2, DM, S, E);  }
#endif
    if (IN(8)) { SEAM(8); }
    if (IN(9)) { ph_route(a, 0, XR, HN, RSv, ctl + CW_CNT, list_slot, list_gate, lds); SEAM(9); }
    if (IN(11)) { moe_prefix(ctl + CW_CNT, pst);
        pg8::MoeOrder S{(int)gridDim.x, (int)blockIdx.x, 4, pst[NEXP] / 256, pst, ctl + CW_CNT, list_slot, (const char*)(ws + WM_GU), (size_t)DM * DM, (size_t)256 * DM}; pg8::EpiSwiGLU E{(bf16_t*)(ws + WS_H), ctl + CW_WMAX};
        pg8::gemm_phase<pg8::EpiSwiGLU, pg8::MoeOrder, true>(ldsb, (const char*)HN, DM, DM / 2, S, E); moe_tail_cvt(a, lds, pst, 0, 13); }
#if (REPMASK >> 11) & 1
    if (IN(11)) { xcd_barrier(bar);  moe_prefix(ctl + CW_CNT, pst);
        pg8::MoeOrder S{(int)gridDim.x, (int)blockIdx.x, 4, pst[NEXP] / 256, pst, ctl + CW_CNT, list_slot, (const char*)(ws + WM_GU), (size_t)DM * DM, (size_t)256 * DM}; pg8::EpiSwiGLU E{(bf16_t*)(ws + WS_H), ctl + CW_WMAX};
        pg8::gemm_phase<pg8::EpiSwiGLU, pg8::MoeOrder, true>(ldsb, (const char*)HN, DM, DM / 2, S, E);  }
#endif
    if (IN(11)) { SEAM(11); }
    if (IN(12)) { moe_prefix(ctl + CW_CNT, pst);
        pg8::MoeOrder S{(int)gridDim.x, (int)blockIdx.x, 4, pst[NEXP] / 256, pst, ctl + CW_CNT, nullptr, (const char*)(ws + WM_DN), (size_t)DM * FF * 2, (size_t)256 * FF * 2}; pg8::EpiDown E{(bf16_t*)(ws + WS_Y), list_slot, list_gate};
        pg8::gemm_phase(ldsb, (const char*)(ws + WS_H), FF * 2, FF, S, E); moe_tail_cvt(a, lds, pst, 13, NEXP); }
#if (REPMASK >> 12) & 1
    if (IN(12)) { xcd_barrier(bar);  moe_prefix(ctl + CW_CNT, pst);
        pg8::MoeOrder S{(int)gridDim.x, (int)blockIdx.x, 4, pst[NEXP] / 256, pst, ctl + CW_CNT, nullptr, (const char*)(ws + WM_DN), (size_t)DM * FF * 2, (size_t)256 * FF * 2}; pg8::EpiDown E{(bf16_t*)(ws + WS_Y), list_slot, list_gate};
        pg8::gemm_phase(ldsb, (const char*)(ws + WS_H), FF * 2, FF, S, E);  }
#endif
    if (IN(12)) { SEAM(12); }
    if (IN(13)) { ph_combine_norm(XR, (const bf16_t*)(ws + WS_Y), a.in[1] + DM, (unsigned char*)HN, (float*)(ws + WS_ROUTE + RT_LRU_CH + 262144)); SEAM(13); }
    if (IN(14)) { pg8::DenseOrder S; S.init(NTOK, 4096, DM / 2, gridDim.x, blockIdx.x, ws + WD_CIN); pg8::EpiBf16I E{(bf16_t*)(ws + WS_QFIG), 4096, (float*)(ws + WS_ROUTE + RT_LRU_CH + 262144), ctl + CW_COLMAX + ABC};
        pg8::gemm_phase<pg8::EpiBf16I, pg8::DenseOrder, true>(ldsb, (const char*)HN, DM, DM / 2, S, E); }
#if (REPMASK >> 14) & 1
    if (IN(14)) { xcd_barrier(bar);  pg8::DenseOrder S; S.init(NTOK, 4096, DM / 2, gridDim.x, blockIdx.x, ws + WD_CIN); pg8::EpiBf16I E{(bf16_t*)(ws + WS_QFIG), 4096, (float*)(ws + WS_ROUTE + RT_LRU_CH + 262144), ctl + CW_COLMAX + ABC};
        pg8::gemm_phase<pg8::EpiBf16I, pg8::DenseOrder, true>(ldsb, (const char*)HN, DM, DM / 2, S, E);  }
#endif
    if (IN(14)) { SEAM(14); }
    if (IN(15)) { for (int u = blockIdx.x; u < 256; u += gridDim.x) if ((u & 7) != 7) gla::unit<false>(a, ldsb, u); }
#if (REPMASK >> 15) & 1
    if (IN(15)) { xcd_barrier(bar);  for (int u = blockIdx.x; u < 256; u += gridDim.x) if ((u & 7) != 7) gla::unit<false>(a, ldsb, u);  }
#endif
    if (IN(15)) { SEAM(15); }
    if (IN(17)) { for (int u = blockIdx.x; u < 256; u += gridDim.x) gla::unit<true>(a, ldsb, u); }
#if (REPMASK >> 17) & 1
    if (IN(17)) { xcd_barrier(bar);  for (int u = blockIdx.x; u < 256; u += gridDim.x) gla::unit<true>(a, ldsb, u);  }
#endif
    if (IN(17)) { SEAM(17); }
    if (IN(18)) { pg8::DenseOrder S; S.init(NTOK, DM, DM, gridDim.x, blockIdx.x, ws + WD_COUT); pg8::EpiResid<false> E{XR, XR};
        pg8::gemm_phase(ldsb, (const char*)(ws + WS_MIX1), DM * 2, DM, S, E); SEAM(18); }
    if (IN(19)) { ph_route(a, 1, XR, HN, RSv, ctl + CW_CNT + 64, list_slot, list_gate, lds); SEAM(19); }
    if (IN(21)) { moe_prefix(ctl + CW_CNT + 64, pst);
        pg8::MoeOrder S{(int)gridDim.x, (int)blockIdx.x, 4, pst[NEXP] / 256, pst, ctl + CW_CNT + 64, list_slot, (const char*)(ws + WM_GU1), (size_t)DM * DM, (size_t)256 * DM}; pg8::EpiSwiGLU E{(bf16_t*)(ws + WS_H), ctl + CW_WMAX + 64};
        pg8::gemm_phase<pg8::EpiSwiGLU, pg8::MoeOrder, true>(ldsb, (const char*)HN, DM, DM / 2, S, E); }
#if (REPMASK >> 21) & 1
    if (IN(21)) { xcd_barrier(bar);  moe_prefix(ctl + CW_CNT + 64, pst);
        pg8::MoeOrder S{(int)gridDim.x, (int)blockIdx.x, 4, pst[NEXP] / 256, pst, ctl + CW_CNT + 64, list_slot, (const char*)(ws + WM_GU1), (size_t)DM * DM, (size_t)256 * DM}; pg8::EpiSwiGLU E{(bf16_t*)(ws + WS_H), ctl + CW_WMAX + 64};
        pg8::gemm_phase<pg8::EpiSwiGLU, pg8::MoeOrder, true>(ldsb, (const char*)HN, DM, DM / 2, S, E);  }
#endif
    if (IN(21)) { SEAM(21); }
    if (IN(22)) { moe_prefix(ctl + CW_CNT + 64, pst);
        pg8::MoeOrder S{(int)gridDim.x, (int)blockIdx.x, 4, pst[NEXP] / 256, pst, ctl + CW_CNT + 64, nullptr, (const char*)a.out, (size_t)DM * FF * 2, (size_t)256 * FF * 2}; pg8::EpiDown E{(bf16_t*)(ws + WS_Y), list_slot, list_gate};
        pg8::gemm_phase(ldsb, (const char*)(ws + WS_H), FF * 2, FF, S, E); }
#if (REPMASK >> 22) & 1
    if (IN(22)) { xcd_barrier(bar);  moe_prefix(ctl + CW_CNT + 64, pst);
        pg8::MoeOrder S{(int)gridDim.x, (int)blockIdx.x, 4, pst[NEXP] / 256, pst, ctl + CW_CNT, nullptr, (const char*)(ws + WM_DN), (size_t)DM * FF * 2, (size_t)256 * FF * 2}; pg8::EpiDown E{(bf16_t*)(ws + WS_Y), list_slot, list_gate};
        pg8::gemm_phase(ldsb, (const char*)(ws + WS_H), FF * 2, FF, S, E);  }
#endif
    if (IN(22)) { SEAM(22); }
    if (IN(23)) { ph_final(XR, (const bf16_t*)(ws + WS_Y), a.in[3], a.out); }
#undef IN
#undef SEAM
}

extern "C" void kernel_launch(void* const* d_in, const int* in_sizes, int n_in, void* d_out, int out_size, void* d_ws, size_t ws_size, hipStream_t stream) {
    static int grid = 0;
    if (grid == 0) {
        if (n_in != 35 || out_size != NTOK * DM || ws_size < WS_END) { fprintf(stderr, "kernel_launch: unexpected shapes (n_in %d out %d ws %zu)\n", n_in, out_size, ws_size); grid = -1; return; }
        int dev = 0, cus = 0;
        if (hipGetDevice(&dev) != hipSuccess || hipDeviceGetAttribute(&cus, hipDeviceAttributeMultiprocessorCount, dev) != hipSuccess) { grid = -1; return; }
        if (hipFuncSetAttribute((const void*)fwd, hipFuncAttributeMaxDynamicSharedMemorySize, LDS_BYTES) != hipSuccess) { fprintf(stderr, "kernel_launch: hipFuncSetAttribute failed\n"); grid = -1; return; }
        int per_cu = 0;
        (void)hipOccupancyMaxActiveBlocksPerMultiprocessor(&per_cu, (const void*)fwd, NTHREADS, LDS_BYTES);
        (void)hipGetLastError();
        grid = cus;
        if (grid < 64) { fprintf(stderr, "kernel_launch: needs >= 64 CUs\n"); grid = -1; return; }
    }
    if (grid < 0) return;
    (void)hipMemsetAsync((char*)d_ws + WS_CTL, 0, CTL_ZERO_BYTES, stream);
    Args a{};
    for (int i = 0; i < 35; ++i) a.in[i] = (const float*)d_in[i];
    a.out = (float*)d_out; a.ws = (unsigned char*)d_ws;
#if 0
    for (int p = 0; p < NPHASE; ++p) { a.ph_lo = p; a.ph_hi = p + 1; hipLaunchKernelGGL(fwd, dim3(grid), dim3(NTHREADS), LDS_BYTES, stream, a); }
#else
    a.ph_lo = 0; a.ph_hi = NPHASE; hipLaunchKernelGGL(fwd, dim3(grid), dim3(NTHREADS), LDS_BYTES, stream, a);
#endif
}
```

```cpp
#include <hip/hip_runtime.h>
#include <cstdio>
#include <cstdint>

typedef unsigned short bf16_t;
#define LAS __attribute__((address_space(3)))
typedef float f32x4 __attribute__((ext_vector_type(4)));
typedef short bf16x8_t __attribute__((ext_vector_type(8)));
typedef unsigned u32x4_t __attribute__((ext_vector_type(4)));
typedef unsigned u32x2_t __attribute__((ext_vector_type(2)));

constexpr int NTOK = 32768, SEQ = 8192, NBATCH = 4, DM = 1024;
constexpr int ABC = 2816, RWC = 1792;
constexpr int NEXP = 32, FF = 512;
constexpr int NASG = NTOK * 2;
constexpr int MOE_TM = 256;
constexpr int MOE_CAP = NTOK;
constexpr int MAXROWS = NASG + NEXP * MOE_TM;
constexpr int NTHREADS = 512;
constexpr int LDS_BYTES = 156 * 1024;
constexpr int LDS_MISC = 155 * 1024;

constexpr size_t MiB = 1024ull * 1024ull;
constexpr size_t WS_CTL = 0;
constexpr size_t CTL_ZERO_BYTES = 64 * 1024;
constexpr size_t WS_ROUTE = 64 * 1024;
constexpr size_t WS_WD = 8 * MiB;
constexpr size_t WD_ABIN = WS_WD, WD_ABOUT = WD_ABIN + (size_t)ABC * DM * 2, WD_CIN = WD_ABOUT + (size_t)DM * DM * 2, WD_COUT = WD_CIN + (size_t)4096 * DM * 2;
constexpr size_t WS_AR = 26 * MiB;
constexpr size_t WS_A = WS_AR;
constexpr size_t WS_B = WS_AR + 64 * MiB;
constexpr size_t WS_C = WS_B + 176 * MiB;
constexpr size_t WS_D = WS_C + 212 * MiB;
constexpr size_t DO_LRU = 112 * MiB;
constexpr size_t WS_XR = WS_AR + 360 * MiB;
constexpr size_t WS_WM = WS_AR + 64 * MiB;
constexpr size_t WM_GU1 = WS_A + 32 * MiB;
constexpr size_t WM_GU = WS_WM, WM_DN = WS_WM + (size_t)NEXP * DM * DM;
constexpr size_t WS_H = WS_WM + 96 * MiB;
constexpr size_t WS_Y = WS_H + 72 * MiB;
constexpr size_t WS_QFIG = WS_AR + 64 * MiB;
constexpr size_t WS_O = WS_QFIG + 256 * MiB;
constexpr size_t WS_MIX1 = WS_O + 128 * MiB;
constexpr size_t WS_LIST = WS_AR + 424 * MiB;
constexpr size_t WS_END = WS_AR + 516 * MiB;
static_assert(WS_D + 64 * MiB <= WS_END && WS_Y + 128 * MiB <= WS_END && WS_MIX1 + 64 * MiB <= WS_END, "arena");

constexpr size_t DO_VB = 0, DO_BON = 32 * MiB, DO_SG = 34 * MiB, DO_YR = 48 * MiB;

constexpr int CW_CNT = 8192;
constexpr int CW_WMAX = CW_CNT + 512;
constexpr int CW_COLMAX = CW_WMAX + 192;
constexpr float ACT_Q = 127.f / 6.f;
constexpr size_t RT_ASG_E = 0;
constexpr size_t RT_ASG_RANK = RT_ASG_E + NASG * 4;
constexpr size_t RT_ASG_GATE = RT_ASG_RANK + NASG * 4;
constexpr size_t RT_ROW_TOK = RT_ASG_GATE + NASG * 4;
constexpr size_t RT_ROW_SLOT = RT_ROW_TOK + MAXROWS * 4;
constexpr size_t RT_ROW_GATE = RT_ROW_SLOT + MAXROWS * 4;
constexpr size_t RT_LRU_CH = RT_ROW_GATE + MAXROWS * 4;
constexpr size_t RT_LRU_CA = RT_LRU_CH + 512 * 512 * 4;
constexpr size_t RT_LRU_CIN = RT_LRU_CA + 512 * 512 * 4;
constexpr size_t RT_END = RT_LRU_CIN + 512 * 512 * 4;
constexpr size_t WS_FRAG = 6 * MiB;
constexpr size_t FG_RT = WS_FRAG + 393216;
constexpr size_t FG_W2 = WS_FRAG, FG_A2 = FG_W2 + 65536, FG_WA = FG_A2 + 65536, FG_WX = FG_WA + 65536, FG_G2 = FG_WX + 65536;
static_assert(WS_ROUTE + RT_END <= 6 * MiB, "routing arrays overflow");

__device__ __forceinline__ float bf2f(bf16_t v) { return __uint_as_float(((unsigned)v) << 16); }
typedef __bf16 bf16x2_hw __attribute__((ext_vector_type(2)));
typedef float f32x2_hw __attribute__((ext_vector_type(2)));
__device__ __forceinline__ unsigned pk2(float lo, float hi) { const f32x2_hw v = {lo, hi}; const bf16x2_hw b = __builtin_convertvector(v, bf16x2_hw); return __builtin_bit_cast(unsigned, b); }
__device__ __forceinline__ bf16_t f2bf(float f) { const __bf16 b = (__bf16)f; return __builtin_bit_cast(bf16_t, b); }
template <int CTRL> __device__ __forceinline__ float dpp_(float x) { return __builtin_bit_cast(float, __builtin_amdgcn_mov_dpp(__builtin_bit_cast(int, x), CTRL, 0xf, 0xf, true)); }
__device__ __forceinline__ float row16_sum(float v) {
    v += dpp_<0xB1>(v); v += dpp_<0x4E>(v); v += dpp_<0x124>(v); v += dpp_<0x128>(v); return v; }
__device__ __forceinline__ float xrow16_sum(float x) {
    auto s = __builtin_amdgcn_permlane16_swap(__float_as_uint(x), __float_as_uint(x), false, false);
    x = __uint_as_float(s[0]) + __uint_as_float(s[1]);
    auto t = __builtin_amdgcn_permlane32_swap(__float_as_uint(x), __float_as_uint(x), false, false);
    return __uint_as_float(t[0]) + __uint_as_float(t[1]); }
__device__ __forceinline__ float xrow32_sum(float x) {
    auto s = __builtin_amdgcn_permlane16_swap(__float_as_uint(x), __float_as_uint(x), false, false);
    return __uint_as_float(s[0]) + __uint_as_float(s[1]); }
__device__ __forceinline__ float wave_sum(float v) { return xrow16_sum(row16_sum(v)); }
__device__ __forceinline__ float sigmoidf_(float x) { return 1.f / (1.f + __expf(-x)); }
__device__ __forceinline__ float softplusf_(float x) { return fmaxf(x, 0.f) + log1pf(__expf(-fabsf(x))); }
__device__ __forceinline__ float siluf_(float x) { return x * sigmoidf_(x); }
__device__ __forceinline__ float gelu_tanhf_(float x) { const float c = 0.7978845608028654f; return 0.5f * x * (1.f + tanhf(c * (x + 0.044715f * x * x * x))); }

struct Args {
    const float* in[35];
    float* out;
    unsigned char* ws;
    int ph_lo, ph_hi;
};

#define XB_TMO      128
#define XB_XCNT(j)  (256  + 64 * (j))
#define XB_XSUB(j)  (1280 + 64 * (j))
#define XB_XGEN(j)  (2304 + 64 * (j))
#define XB_TOP      3328
#define XB_TOPGEN   3392
#define XCD_BAR_WORDS 3456
#define XB_SPIN_CAP (1u << 18)
__device__ __forceinline__ unsigned xb_ld(unsigned* p)              { return __hip_atomic_load(p, __ATOMIC_RELAXED, __HIP_MEMORY_SCOPE_AGENT); }
__device__ __forceinline__ unsigned xb_add(unsigned* p, unsigned v) { return __hip_atomic_fetch_add(p, v, __ATOMIC_RELAXED, __HIP_MEMORY_SCOPE_AGENT); }
__device__ __forceinline__ unsigned xb_xcc_id() { return (unsigned)__builtin_amdgcn_s_getreg((3 << 11) | 20) & 0xFu; }
#define XB_SPIN(cond, bar) do { unsigned _sp = 0; while (cond) { __builtin_amdgcn_s_sleep(1); \
    if ((++_sp & 255u) == 0u) { if (xb_ld(&(bar)[XB_TMO])) break; if (_sp > XB_SPIN_CAP) { atomicAdd(&(bar)[XB_TMO], 1u); break; } } } } while (0)
struct XcdBarrier { unsigned* bar; unsigned x; volatile LAS unsigned* st; };
__device__ __forceinline__ XcdBarrier xcd_barrier_post(unsigned* bar, volatile LAS unsigned* st) {
    XcdBarrier b; b.bar = bar; b.x = xb_xcc_id(); b.st = st;
    if (threadIdx.x == 0) (void)xb_add(&bar[XB_XCNT(b.x)], 1u);
    return b;
}
__device__ __forceinline__ void xcd_barrier_complete(unsigned* bar, unsigned x, unsigned& nloc, unsigned& nx) {
    const unsigned G = gridDim.x * gridDim.y * gridDim.z;
    unsigned sum, cnt, mine, sp = 0u;
    for (;;) {
        sum = 0u; cnt = 0u; mine = 0u;
#pragma unroll
        for (unsigned j = 0; j < 16; ++j) { const unsigned c = xb_ld(&bar[XB_XCNT(j)]); sum += c; cnt += (c > 0u) ? 1u : 0u; mine = (j == x) ? c : mine; }
        if (sum == G) break;
        __builtin_amdgcn_s_sleep(1);
        if ((++sp & 255u) == 0u) { if (xb_ld(&bar[XB_TMO])) break; if (sp > XB_SPIN_CAP) { atomicAdd(&bar[XB_TMO], 1u); break; } }
    }
    nloc = mine > 0u ? mine : 1u; nx = cnt > 0u ? cnt : 1u;
}
__device__ __forceinline__ void xcd_barrier(const XcdBarrier& b) {
    asm volatile("s_waitcnt vmcnt(0)" ::: "memory");
    __syncthreads();
    if (threadIdx.x == 0) {
        unsigned* bar = b.bar;
        __builtin_amdgcn_s_waitcnt(0);
        unsigned nloc = b.st[0], nx = b.st[1];
        if (nloc == 0u) { xcd_barrier_complete(bar, b.x, nloc, nx); b.st[0] = nloc; b.st[1] = nx; }
        const unsigned old = xb_add(&bar[XB_XSUB(b.x)], 1u);
        const unsigned gen = old / nloc;
        if (old + 1u == (gen + 1u) * nloc) {
            __builtin_amdgcn_fence(__ATOMIC_RELEASE, "agent");
            asm volatile("s_waitcnt vmcnt(0)" ::: "memory");
            const unsigned og = xb_add(&bar[XB_TOP], 1u);
            const unsigned tg = og / nx;
            if (og + 1u == (tg + 1u) * nx) xb_add(&bar[XB_TOPGEN], 1u);
            else XB_SPIN(xb_ld(&bar[XB_TOPGEN]) == tg, bar);
            __builtin_amdgcn_fence(__ATOMIC_ACQUIRE, "agent");
            xb_add(&bar[XB_XGEN(b.x)], 1u);
            asm volatile("s_waitcnt vmcnt(0)" ::: "memory");
        } else {
            XB_SPIN(xb_ld(&bar[XB_XGEN(b.x)]) == gen, bar);
            __builtin_amdgcn_fence(__ATOMIC_ACQUIRE, "agent");
            asm volatile("s_waitcnt vmcnt(0)" ::: "memory");
        }
    }
    __syncthreads();
}

namespace pg8 {
typedef short bf16x8 __attribute__((ext_vector_type(8)));
typedef unsigned u32x4 __attribute__((ext_vector_type(4)));
typedef int v4i_t __attribute__((ext_vector_type(4)));
constexpr int BM = 256, BK = 64, HALF = 128, HTB = HALF * BK * 2, STAGE_BYTES = 8 * HTB, NXCD = 8, WGM = 8;
__device__ __forceinline__ int lds_byte(int r, int c) { const int st = (r >> 4) * 2 + (c >> 5), rr = r & 15, cc = c & 31, ob = rr * 64 + cc * 2; return st * 1024 + (ob ^ (((ob >> 9) & 1) << 5)); }
__device__ __forceinline__ void stage_rc(int b, int& R, int& C) { const int st = b / 1024, sb = b % 1024, swz = sb ^ (((sb >> 9) & 1) << 5); R = (st >> 1) * 16 + swz / 64; C = (st & 1) * 32 + (swz % 64) / 2; }
__device__ __forceinline__ int perm32(int rho) { const int n = rho >> 4, i = rho & 15; return 8 * (i >> 2) + 4 * n + (i & 3); }
__device__ __forceinline__ unsigned cvt_pk_bf16(float lo, float hi) { unsigned r; asm volatile("v_cvt_pk_bf16_f32 %0, %1, %2" : "=v"(r) : "v"(lo), "v"(hi)); return r; }

struct Unit { int pm, pn; const char* B; int off, nval, e; };

struct DenseOrder {
    int nM, nN, nwg, G, c; const char* Bt; size_t bstep;
    __device__ void init(int M, int N, int K, int G_, int c_, const void* Bt_) { nM = M / BM; nN = N / BM; nwg = nM * nN; G = G_; c = c_; Bt = (const char*)Bt_; bstep = (size_t)BM * K * 2; }
    __device__ bool next(int i, Unit& u) const {
        const long L = (long)i * G + c; if (L >= nwg) return false;
        int wgid = (int)L; { const int q = nwg / NXCD, r = nwg % NXCD, xcd = wgid % NXCD, off = wgid / NXCD; wgid = (xcd < r ? xcd * (q + 1) : r * (q + 1) + (xcd - r) * q) + off; }
        const int nig = WGM * nN, gid = wgid / nig, fm = gid * WGM, gsz = (nM - fm) < WGM ? (nM - fm) : WGM;
        u.pm = fm + ((wgid % nig) % gsz); u.pn = (wgid % nig) / gsz; u.B = Bt + (size_t)u.pn * bstep; return true;
    }
    __device__ __forceinline__ int arow(const Unit& u, int r) const { return u.pm * BM + r; }
};
struct MoeOrder {
    int G, c, nN, ntiles; const LAS int* pst; const unsigned* cnt; const int* rowslot; const char* Bt; size_t estep, bstep;
    __device__ bool next(int i, Unit& u) const {
        const int cc = (G % NXCD == 0) ? (c % NXCD) * (G / NXCD) + c / NXCD : c;
        const int L = i * G + cc; if (L >= ntiles * nN) return false;
        u.pm = L / nN; u.pn = L % nN; const int row0 = u.pm * BM; int e = 0;
#pragma unroll
        for (int st = NEXP / 2; st > 0; st >>= 1) if (row0 >= pst[e + st]) e += st;
        const int t0 = row0 - pst[e];
        u.e = e; u.off = e * MOE_CAP + t0; u.nval = (int)cnt[e] - t0;
        u.B = Bt + (size_t)e * estep + (size_t)u.pn * bstep; return true;
    }
    __device__ __forceinline__ int arow(const Unit& u, int r) const { if (!rowslot) return u.pm * BM + r; return r < u.nval ? (rowslot[u.off + r] >> 1) : 0; }
};

struct EpiBf16I { static constexpr bool PERM = true; bf16_t* O; int ldc; const float* rowscale; const unsigned* colmax;
    __device__ __forceinline__ void operator()(const f32x4 (&acc)[2][2][4][2], const Unit& u, int wr, int wc, int fr, int fq) const {
        const int row0 = u.pm * BM + wr * 64 + fr, col0 = u.pn * BM + wc * 32 + 8 * fq;
        float rsc[8]; f32x4 cs[2][2];
#pragma unroll
        for (int q = 0; q < 8; ++q) rsc[q] = rowscale[row0 + (q >> 2) * HALF + (q & 3) * 16] * (1.f / 127.f);
#pragma unroll
        for (int bj = 0; bj < 2; ++bj)
#pragma unroll
            for (int n = 0; n < 2; ++n) { const u32x4 c4 = *(const u32x4*)(colmax + col0 + bj * HALF + 4 * n); cs[bj][n] = (f32x4){__uint_as_float(c4.x), __uint_as_float(c4.y), __uint_as_float(c4.z), __uint_as_float(c4.w)} * (1.f / 127.f); }
#pragma unroll
        for (int ai = 0; ai < 2; ++ai)
#pragma unroll
            for (int m = 0; m < 4; ++m) { bf16_t* rowp = O + (size_t)(row0 + ai * HALF + m * 16) * ldc + col0; const float rs = rsc[ai * 4 + m];
#pragma unroll
                for (int bj = 0; bj < 2; ++bj) { const v4i_t i0 = __builtin_bit_cast(v4i_t, acc[ai][bj][m][0]), i1 = __builtin_bit_cast(v4i_t, acc[ai][bj][m][1]);
                    const f32x4 s0 = cs[bj][0] * rs, s1 = cs[bj][1] * rs;
                    u32x4 w; w.x = cvt_pk_bf16((float)i0[0] * s0[0], (float)i0[1] * s0[1]); w.y = cvt_pk_bf16((float)i0[2] * s0[2], (float)i0[3] * s0[3]);
                    w.z = cvt_pk_bf16((float)i1[0] * s1[0], (float)i1[1] * s1[1]); w.w = cvt_pk_bf16((float)i1[2] * s1[2], (float)i1[3] * s1[3]);
                    *(u32x4*)(rowp + bj * HALF) = w; } }
    } };
struct EpiBf16IT { static constexpr bool PERM = true; bf16_t* O; int nf; const float* tokscale; const unsigned* chmax;
    __device__ __forceinline__ void operator()(const f32x4 (&acc)[2][2][4][2], const Unit& u, int wr, int wc, int fr, int fq) const {
        const int row0 = u.pm * BM + wr * 64 + fr, col0 = u.pn * BM + wc * 32 + 8 * fq;
        float rsc[8]; f32x4 cs[2][2];
#pragma unroll
        for (int q = 0; q < 8; ++q) rsc[q] = __uint_as_float(chmax[row0 + (q >> 2) * HALF + (q & 3) * 16]) * (1.f / 127.f);
#pragma unroll
        for (int bj = 0; bj < 2; ++bj)
#pragma unroll
            for (int n = 0; n < 2; ++n) cs[bj][n] = *(const f32x4*)(tokscale + col0 + bj * HALF + 4 * n) * (1.f / 127.f);
#pragma unroll
        for (int ai = 0; ai < 2; ++ai)
#pragma unroll
            for (int m = 0; m < 4; ++m) { const int nidx = row0 + ai * HALF + m * 16; const float rs = rsc[ai * 4 + m];
#pragma unroll
                for (int bj = 0; bj < 2; ++bj) { const v4i_t i0 = __builtin_bit_cast(v4i_t, acc[ai][bj][m][0]), i1 = __builtin_bit_cast(v4i_t, acc[ai][bj][m][1]);
                    const f32x4 s0 = cs[bj][0] * rs, s1 = cs[bj][1] * rs; const int tok0 = col0 + bj * HALF;
                    u32x4 w; w.x = cvt_pk_bf16((float)i0[0] * s0[0], (float)i0[1] * s0[1]); w.y = cvt_pk_bf16((float)i0[2] * s0[2], (float)i0[3] * s0[3]);
                    w.z = cvt_pk_bf16((float)i1[0] * s1[0], (float)i1[1] * s1[1]); w.w = cvt_pk_bf16((float)i1[2] * s1[2], (float)i1[3] * s1[3]);
                    *(u32x4*)(O + ((size_t)(tok0 >> 4) * nf + nidx) * 16 + (tok0 & 8)) = w; } }
    } };
struct EpiBf16 { static constexpr bool PERM = true; bf16_t* O; int ldc;
    __device__ __forceinline__ void operator()(const f32x4 (&acc)[2][2][4][2], const Unit& u, int wr, int wc, int fr, int fq) const {
        const int row0 = u.pm * BM + wr * 64 + fr, col0 = u.pn * BM + wc * 32 + 8 * fq;
#pragma unroll
        for (int ai = 0; ai < 2; ++ai)
#pragma unroll
            for (int m = 0; m < 4; ++m) { bf16_t* rowp = O + (size_t)(row0 + ai * HALF + m * 16) * ldc + col0;
#pragma unroll
                for (int bj = 0; bj < 2; ++bj) { const f32x4 v0 = acc[ai][bj][m][0], v1 = acc[ai][bj][m][1];
                    u32x4 w; w.x = cvt_pk_bf16(v0[0], v0[1]); w.y = cvt_pk_bf16(v0[2], v0[3]); w.z = cvt_pk_bf16(v1[0], v1[1]); w.w = cvt_pk_bf16(v1[2], v1[3]);
                    *(u32x4*)(rowp + bj * HALF) = w; } }
    } };
template <bool XF32> struct EpiResid { static constexpr bool PERM = true; const void* __restrict__ X; bf16_t* __restrict__ O;
    __device__ __forceinline__ void operator()(const f32x4 (&acc)[2][2][4][2], const Unit& u, int wr, int wc, int fr, int fq) const {
        const int row0 = u.pm * BM + wr * 64 + fr, col0 = u.pn * BM + wc * 32 + 8 * fq;
        if constexpr (XF32) {
#pragma unroll
            for (int ai = 0; ai < 2; ++ai)
#pragma unroll
                for (int mp = 0; mp < 2; ++mp) { f32x4 x[2][2][2];
#pragma unroll
                    for (int mm = 0; mm < 2; ++mm)
#pragma unroll
                        for (int bj = 0; bj < 2; ++bj) { const float* xp = (const float*)X + (size_t)(row0 + ai * HALF + (mp * 2 + mm) * 16) * DM + col0 + bj * HALF; x[mm][bj][0] = *(const f32x4*)xp; x[mm][bj][1] = *(const f32x4*)(xp + 4); }
#pragma unroll
                    for (int mm = 0; mm < 2; ++mm)
#pragma unroll
                        for (int bj = 0; bj < 2; ++bj) { const f32x4 v0 = x[mm][bj][0] + acc[ai][bj][mp * 2 + mm][0], v1 = x[mm][bj][1] + acc[ai][bj][mp * 2 + mm][1];
                            u32x4 w; w.x = cvt_pk_bf16(v0[0], v0[1]); w.y = cvt_pk_bf16(v0[2], v0[3]); w.z = cvt_pk_bf16(v1[0], v1[1]); w.w = cvt_pk_bf16(v1[2], v1[3]);
                            *(u32x4*)(O + (size_t)(row0 + ai * HALF + (mp * 2 + mm) * 16) * DM + col0 + bj * HALF) = w; } }
        } else {
#pragma unroll
            for (int ai = 0; ai < 2; ++ai) { u32x4 x[4][2];
#pragma unroll
                for (int m = 0; m < 4; ++m)
#pragma unroll
                    for (int bj = 0; bj < 2; ++bj) x[m][bj] = *(const u32x4*)((const bf16_t*)X + (size_t)(row0 + ai * HALF + m * 16) * DM + col0 + bj * HALF);
#pragma unroll
                for (int m = 0; m < 4; ++m)
#pragma unroll
                    for (int bj = 0; bj < 2; ++bj) { const u32x4 o = x[m][bj];
                        const f32x4 v0 = (f32x4){__uint_as_float(o.x << 16), __uint_as_float(o.x & 0xffff0000u), __uint_as_float(o.y << 16), __uint_as_float(o.y & 0xffff0000u)} + acc[ai][bj][m][0];
                        const f32x4 v1 = (f32x4){__uint_as_float(o.z << 16), __uint_as_float(o.z & 0xffff0000u), __uint_as_float(o.w << 16), __uint_as_float(o.w & 0xffff0000u)} + acc[ai][bj][m][1];
                        u32x4 w; w.x = cvt_pk_bf16(v0[0], v0[1]); w.y = cvt_pk_bf16(v0[2], v0[3]); w.z = cvt_pk_bf16(v1[0], v1[1]); w.w = cvt_pk_bf16(v1[2], v1[3]);
                        *(u32x4*)(O + (size_t)(row0 + ai * HALF + m * 16) * DM + col0 + bj * HALF) = w; } }
        }
    } };
struct EpiSwiGLU { static constexpr bool PERM = true; bf16_t* H; const unsigned* wmax;
    __device__ __forceinline__ void operator()(const f32x4 (&acc)[2][2][4][2], const Unit& u, int wr, int wc, int fr, int fq) const {
        const int row0 = u.pm * BM + wr * 64 + fr, col0 = u.pn * HALF + wc * 32 + 8 * fq;
        const float s0 = __uint_as_float(wmax[2 * u.e]) * (1.f / (127.f * ACT_Q)), s1 = __uint_as_float(wmax[2 * u.e + 1]) * (1.f / (127.f * ACT_Q));
#pragma unroll
        for (int ai = 0; ai < 2; ++ai)
#pragma unroll
            for (int m = 0; m < 4; ++m) { float h[8];
#pragma unroll
                for (int n = 0; n < 2; ++n) { const v4i_t gi = __builtin_bit_cast(v4i_t, acc[ai][0][m][n]), ui = __builtin_bit_cast(v4i_t, acc[ai][1][m][n]);
#pragma unroll
                    for (int j = 0; j < 4; ++j) { const float g = (float)gi[j] * s0; h[n * 4 + j] = g * __builtin_amdgcn_rcpf(1.f + __expf(-g)) * ((float)ui[j] * s1); } }
                u32x4 w; w.x = cvt_pk_bf16(h[0], h[1]); w.y = cvt_pk_bf16(h[2], h[3]); w.z = cvt_pk_bf16(h[4], h[5]); w.w = cvt_pk_bf16(h[6], h[7]);
                *(u32x4*)(H + (size_t)(row0 + ai * HALF + m * 16) * FF + col0) = w; }
    } };
struct EpiDown { static constexpr bool PERM = true; bf16_t* Y; const int* list_slot; const float* list_gate;
    __device__ __forceinline__ void operator()(const f32x4 (&acc)[2][2][4][2], const Unit& u, int wr, int wc, int fr, int fq) const {
        const int rl0 = wr * 64 + fr, col0 = u.pn * BM + wc * 32 + 8 * fq;
        int tk[8], sl[8]; float gt[8];
#pragma unroll
        for (int q = 0; q < 8; ++q) { const int r = rl0 + (q >> 2) * HALF + (q & 3) * 16; sl[q] = list_slot[u.off + r]; gt[q] = list_gate[u.off + r]; tk[q] = (r < u.nval) ? 0 : -1; }
#pragma unroll
        for (int ai = 0; ai < 2; ++ai)
#pragma unroll
            for (int m = 0; m < 4; ++m) { const int q = ai * 4 + m;
                if (tk[q] < 0) continue;
                bf16_t* rowp = Y + (size_t)sl[q] * DM + col0;
#pragma unroll
                for (int bj = 0; bj < 2; ++bj) { const f32x4 v0 = acc[ai][bj][m][0] * gt[q], v1 = acc[ai][bj][m][1] * gt[q];
                    u32x4 w; w.x = cvt_pk_bf16(v0[0], v0[1]); w.y = cvt_pk_bf16(v0[2], v0[3]); w.z = cvt_pk_bf16(v1[0], v1[1]); w.w = cvt_pk_bf16(v1[2], v1[3]);
                    *(u32x4*)(rowp + bj * HALF) = w; } }
    } };

template <class Epi, class Sched, bool I8 = false>
__device__ __forceinline__ void gemm_phase(LAS unsigned char* lds, const char* A, const unsigned lda_b, const int K, const Sched& S, const Epi& E) {
    const int tid = threadIdx.x, wid = __builtin_amdgcn_readfirstlane(tid >> 6), lane = tid & 63, wr = wid >> 2, wc = wid & 3, fr = lane & 15, fq = lane >> 4;
    const int nt = K / BK;
    unsigned voffB[2];
#pragma unroll
    for (int i = 0; i < 2; ++i) { int R, C; stage_rc(tid * 16 + i * 8192, R, C); const int Rb = Epi::PERM ? ((R & ~31) + perm32(R & 31)) : R; voffB[i] = (unsigned)(Rb * K + C) * 2u; }
    const size_t kstep = (size_t)(BK * 2);
    const size_t hstepB = (size_t)HALF * K * 2;
    const unsigned ldsw = (unsigned)wid * 1024u;
    const int aoff = lds_byte(wr * 64 + fr, fq * 8), boff = lds_byte(wc * 32 + fr, fq * 8);
#define PG8_SA(b, h) (((b) * 2 + (h)) * HTB)
#define PG8_SB(b, h) ((4 + (b) * 2 + (h)) * HTB)
#define PG8_STAGE(bufoff, gbase, voff) do { _Pragma("unroll") for (int _i = 0; _i < 2; ++_i) \
        __builtin_amdgcn_global_load_lds((const unsigned*)((const char*)(gbase) + (voff)[_i]), (LAS unsigned*)(lds + (bufoff) + ldsw + _i * 8192), 16, 0, 0); } while (0)
#define PG8_LDA(dst, b, h) do { _Pragma("unroll") for (int m = 0; m < 4; ++m) _Pragma("unroll") for (int k = 0; k < 2; ++k) dst[m][k] = *(const LAS bf16x8*)(lds + PG8_SA(b, h) + aoff + m * 2048 + k * 1024); } while (0)
#define PG8_LDB(dst, b, h) do { _Pragma("unroll") for (int n = 0; n < 2; ++n) _Pragma("unroll") for (int k = 0; k < 2; ++k) dst[n][k] = *(const LAS bf16x8*)(lds + PG8_SB(b, h) + boff + n * 2048 + k * 1024); } while (0)
#define PG8_MMA(ai, bj, At, Bt) do { __builtin_amdgcn_s_setprio(1); _Pragma("unroll") for (int m = 0; m < 4; ++m) _Pragma("unroll") for (int n = 0; n < 2; ++n) _Pragma("unroll") for (int k = 0; k < 2; ++k) { \
        if constexpr (I8) acc[ai][bj][m][n] = __builtin_bit_cast(f32x4, __builtin_amdgcn_mfma_i32_16x16x64_i8(__builtin_bit_cast(v4i_t, Bt[n][k]), __builtin_bit_cast(v4i_t, At[m][k]), __builtin_bit_cast(v4i_t, acc[ai][bj][m][n]), 0, 0, 0)); \
        else acc[ai][bj][m][n] = __builtin_amdgcn_mfma_f32_16x16x32_bf16(Bt[n][k], At[m][k], acc[ai][bj][m][n], 0, 0, 0); } __builtin_amdgcn_s_setprio(0); } while (0)
#define PG8_WAIT_V(n) asm volatile("s_waitcnt vmcnt(" #n ")" ::: "memory")
#define PG8_WAIT_L(n) asm volatile("s_waitcnt lgkmcnt(" #n ")" ::: "memory")
#define PG8_BAR __builtin_amdgcn_s_barrier()
#define PG8_SCHED __builtin_amdgcn_sched_barrier(0)
#define PG8_AOFF(dst, u) do { int _tz = threadIdx.x; asm volatile("" : "+v"(_tz)); _Pragma("unroll") for (int _i = 0; _i < 2; ++_i) { int _R, _C; stage_rc(_tz * 16 + _i * 8192, _R, _C); \
        _Pragma("unroll") for (int _h = 0; _h < 2; ++_h) dst[_h][_i] = (unsigned)S.arow(u, _h * HALF + _R) * lda_b + (unsigned)_C * 2u; } } while (0)
    Unit cur, nxt; int ui = 0;
    if (!S.next(0, cur)) return;
    f32x4 acc[2][2][4][2];
#pragma unroll
    for (int a = 0; a < 2; ++a)
#pragma unroll
        for (int b = 0; b < 2; ++b)
#pragma unroll
            for (int m = 0; m < 4; ++m)
#pragma unroll
                for (int n = 0; n < 2; ++n) acc[a][b][m][n] = (f32x4){0.f, 0.f, 0.f, 0.f};
    bf16x8 At[4][2], B0[2][2], B1[2][2];
    unsigned vA[2][2], vAn[2][2];
    PG8_AOFF(vA, cur);
    const char* cB = cur.B;
    PG8_STAGE(PG8_SB(0, 0), cB, voffB); PG8_STAGE(PG8_SA(0, 0), A, vA[0]); PG8_STAGE(PG8_SB(0, 1), cB + hstepB, voffB); PG8_STAGE(PG8_SA(0, 1), A, vA[1]);
    if (wr == 1) PG8_BAR;
    PG8_WAIT_V(4); PG8_BAR;
    PG8_STAGE(PG8_SB(1, 0), cB + kstep, voffB); PG8_STAGE(PG8_SA(1, 0), A + kstep, vA[0]); PG8_STAGE(PG8_SB(1, 1), cB + hstepB + kstep, voffB);
    PG8_WAIT_V(6); PG8_BAR;
    for (;;) {
        const bool has_next = S.next(ui + 1, nxt);
        if (has_next) { PG8_AOFF(vAn, nxt); } else {
#pragma unroll
            for (int h = 0; h < 2; ++h)
#pragma unroll
                for (int i = 0; i < 2; ++i) vAn[h][i] = vA[h][i]; }
        const char* nB = has_next ? nxt.B : cB;
        for (int t = 0; t < nt; t += 2) {
            const bool last = (t == nt - 2);
            const char* a1 = A + (size_t)(t + 1) * kstep;
            const char* a2 = last ? A : A + (size_t)(t + 2) * kstep; const char* b2 = last ? nB : cB + (size_t)(t + 2) * kstep;
            const char* a3 = a2 + kstep; const char* b3 = b2 + kstep;
            unsigned o2[2][2];
#pragma unroll
            for (int h = 0; h < 2; ++h)
#pragma unroll
                for (int i = 0; i < 2; ++i) o2[h][i] = last ? vAn[h][i] : vA[h][i];
            PG8_LDB(B0, 0, 0); PG8_SCHED; PG8_LDA(At, 0, 0); PG8_STAGE(PG8_SA(1, 1), a1, vA[1]);
            PG8_WAIT_L(8); PG8_BAR; PG8_WAIT_L(0); PG8_MMA(0, 0, At, B0); PG8_BAR; PG8_SCHED;
            PG8_LDB(B1, 0, 1); PG8_STAGE(PG8_SB(0, 0), b2, voffB);
            PG8_BAR; PG8_WAIT_L(0); PG8_MMA(0, 1, At, B1); PG8_BAR;
            PG8_LDA(At, 0, 1); PG8_STAGE(PG8_SA(0, 0), a2, o2[0]);
            PG8_BAR; PG8_WAIT_L(0); PG8_MMA(1, 0, At, B0); PG8_BAR; PG8_SCHED;
            PG8_STAGE(PG8_SB(0, 1), b2 + hstepB, voffB);
            PG8_WAIT_V(6); PG8_BAR; PG8_MMA(1, 1, At, B1); PG8_BAR;
            PG8_LDB(B0, 1, 0); PG8_SCHED; PG8_LDA(At, 1, 0); PG8_STAGE(PG8_SA(0, 1), a2, o2[1]);
            PG8_WAIT_L(8); PG8_BAR; PG8_WAIT_L(0); PG8_MMA(0, 0, At, B0); PG8_BAR; PG8_SCHED;
            PG8_LDB(B1, 1, 1); PG8_STAGE(PG8_SB(1, 0), b3, voffB);
            PG8_BAR; PG8_WAIT_L(0); PG8_MMA(0, 1, At, B1); PG8_BAR;
            PG8_LDA(At, 1, 1); PG8_STAGE(PG8_SA(1, 0), a3, o2[0]);
            PG8_BAR; PG8_WAIT_L(0); PG8_MMA(1, 0, At, B0); PG8_BAR; PG8_SCHED;
            PG8_STAGE(PG8_SB(1, 1), b3 + hstepB, voffB);
            PG8_WAIT_V(6); PG8_BAR; PG8_MMA(1, 1, At, B1); PG8_BAR;
        }
        E(acc, cur, wr, wc, fr, fq);
        if (!has_next) break;
#pragma unroll
        for (int a = 0; a < 2; ++a)
#pragma unroll
            for (int b = 0; b < 2; ++b)
#pragma unroll
                for (int m = 0; m < 4; ++m)
#pragma unroll
                    for (int n = 0; n < 2; ++n) acc[a][b][m][n] = (f32x4){0.f, 0.f, 0.f, 0.f};
        cur = nxt; cB = nB; ++ui;
#pragma unroll
        for (int h = 0; h < 2; ++h)
#pragma unroll
            for (int i = 0; i < 2; ++i) vA[h][i] = vAn[h][i];
    }
    PG8_WAIT_V(0);
    if (wr == 0) PG8_BAR;
    PG8_BAR;
#undef PG8_SA
#undef PG8_SB
#undef PG8_STAGE
#undef PG8_LDA
#undef PG8_LDB
#undef PG8_MMA
#undef PG8_WAIT_V
#undef PG8_WAIT_L
#undef PG8_BAR
#undef PG8_SCHED
#undef PG8_AOFF
}
}

template <int MODE>
__device__ __forceinline__ void transpose_item(const float* W, int K, int N, bf16_t* WT, LAS float* scr, int item, int lane) {
    const int nblk = N / 64, kb = item / nblk, nb = item % nblk, k0 = 64 * kb, n0 = 64 * nb;
    const int lr = lane >> 4, lc = (lane & 15) * 4;
    float4 v[16];
#pragma unroll
    for (int i = 0; i < 16; ++i) v[i] = *(const float4*)(W + (size_t)(k0 + 4 * i + lr) * N + n0 + lc);
#pragma unroll
    for (int i = 0; i < 16; ++i) { LAS float* d = scr + (4 * i + lr) * 66 + lc; *(LAS f32x2_hw*)d = (f32x2_hw){v[i].x, v[i].y}; *(LAS f32x2_hw*)(d + 2) = (f32x2_hw){v[i].z, v[i].w}; }
    asm volatile("s_waitcnt lgkmcnt(0)" ::: "memory");
    const int c = lane & 7;
#pragma unroll
    for (int j = 0; j < 8; ++j) { const int n = (lane >> 3) + 8 * j; const LAS float* sp = scr + (8 * c) * 66 + n;
        pg8::u32x4 o; o.x = pk2(sp[0 * 66], sp[1 * 66]); o.y = pk2(sp[2 * 66], sp[3 * 66]); o.z = pk2(sp[4 * 66], sp[5 * 66]); o.w = pk2(sp[6 * 66], sp[7 * 66]);
        const int nn = n0 + n; const int dr = MODE == 0 ? nn : (256 * (nn >> 7) + (nn & 127) + (MODE == 2 ? 128 : 0));
        *(pg8::u32x4*)(WT + (size_t)dr * K + k0 + 8 * c) = o; }
    asm volatile("s_waitcnt lgkmcnt(0)" ::: "memory");
}
__device__ __forceinline__ float wave_max(float v) {
    v = fmaxf(v, dpp_<0xB1>(v)); v = fmaxf(v, dpp_<0x4E>(v)); v = fmaxf(v, dpp_<0x124>(v)); v = fmaxf(v, dpp_<0x128>(v));
    auto s = __builtin_amdgcn_permlane16_swap(__float_as_uint(v), __float_as_uint(v), false, false); v = fmaxf(__uint_as_float(s[0]), __uint_as_float(s[1]));
    auto t = __builtin_amdgcn_permlane32_swap(__float_as_uint(v), __float_as_uint(v), false, false); return fmaxf(__uint_as_float(t[0]), __uint_as_float(t[1])); }
__device__ __forceinline__ unsigned q8x4(float a, float b, float c, float d, float qs) {
    const int ia = (int)rintf(fminf(fmaxf(a * qs, -127.f), 127.f)), ib = (int)rintf(fminf(fmaxf(b * qs, -127.f), 127.f)), ic = (int)rintf(fminf(fmaxf(c * qs, -127.f), 127.f)), id = (int)rintf(fminf(fmaxf(d * qs, -127.f), 127.f));
    return (unsigned)(ia & 255) | ((unsigned)(ib & 255) << 8) | ((unsigned)(ic & 255) << 16) | ((unsigned)(id & 255) << 24); }
__device__ __noinline__ void ph_wmax(const float* wg, const float* wu, unsigned* wmax, int bid, int nblk) {
    const int wave = threadIdx.x >> 6, lane = threadIdx.x & 63, gw = bid * 8 + wave, NGW = nblk * 8;
    constexpr int IT = (DM / 64) * (FF / 64);
    for (int it = gw; it < 2 * NEXP * 2 * IT; it += NGW) { const int mat = it / IT, tl = it % IT; const int le = mat >> 1, gu = mat & 1;
        const float* W = (gu ? wu : wg) + (size_t)le * DM * FF; const int k0 = 64 * (tl / (FF / 64)), n0 = 64 * (tl % (FF / 64));
        float m = 0.f;
#pragma unroll 4
        for (int i = 0; i < 16; ++i) { const float4 v = *(const float4*)(W + (size_t)(k0 + 4 * i + (lane >> 4)) * FF + n0 + (lane & 15) * 4); m = fmaxf(fmaxf(m, fmaxf(fabsf(v.x), fabsf(v.y))), fmaxf(fabsf(v.z), fabsf(v.w))); }
        m = wave_max(m);
        if (lane == 0) atomicMax(wmax + le * 2 + gu, __float_as_uint(m)); }
}
template <int MODE>
__device__ __forceinline__ void transpose_item_i8(const float* W, int K, int N, unsigned char* WT, LAS float* scr, int item, int lane, float qs) {
    const int nblk = N / 64, kb = item / nblk, nb = item % nblk, k0 = 64 * kb, n0 = 64 * nb;
    const int lr = lane >> 4, lc = (lane & 15) * 4;
    float4 v[16];
#pragma unroll
    for (int i = 0; i < 16; ++i) v[i] = *(const float4*)(W + (size_t)(k0 + 4 * i + lr) * N + n0 + lc);
#pragma unroll
    for (int i = 0; i < 16; ++i) { LAS float* d = scr + (4 * i + lr) * 66 + lc; *(LAS f32x2_hw*)d = (f32x2_hw){v[i].x, v[i].y}; *(LAS f32x2_hw*)(d + 2) = (f32x2_hw){v[i].z, v[i].w}; }
    asm volatile("s_waitcnt lgkmcnt(0)" ::: "memory");
    const int c = lane & 3;
#pragma unroll
    for (int j = 0; j < 4; ++j) { const int n = (lane >> 2) + 16 * j; const LAS float* sp = scr + (16 * c) * 66 + n;
        pg8::u32x4 o;
        o.x = q8x4(sp[0 * 66], sp[1 * 66], sp[2 * 66], sp[3 * 66], qs); o.y = q8x4(sp[4 * 66], sp[5 * 66], sp[6 * 66], sp[7 * 66], qs);
        o.z = q8x4(sp[8 * 66], sp[9 * 66], sp[10 * 66], sp[11 * 66], qs); o.w = q8x4(sp[12 * 66], sp[13 * 66], sp[14 * 66], sp[15 * 66], qs);
        const int nn = n0 + n; const int dr = MODE == 0 ? nn : (256 * (nn >> 7) + (nn & 127) + (MODE == 2 ? 128 : 0));
        *(pg8::u32x4*)(WT + (size_t)dr * K + k0 + 16 * c) = o; }
    asm volatile("s_waitcnt lgkmcnt(0)" ::: "memory");
}
__device__ __forceinline__ void transpose_item_i8c(const float* W, int K, int N, unsigned char* WT, LAS float* scr, int item, int lane, const unsigned* colmax) {
    const int nblk = N / 64, kb = item / nblk, nb = item % nblk, k0 = 64 * kb, n0 = 64 * nb;
    const int lr = lane >> 4, lc = (lane & 15) * 4;
    float4 v[16];
#pragma unroll
    for (int i = 0; i < 16; ++i) v[i] = *(const float4*)(W + (size_t)(k0 + 4 * i + lr) * N + n0 + lc);
#pragma unroll
    for (int i = 0; i < 16; ++i) { LAS float* d = scr + (4 * i + lr) * 66 + lc; *(LAS f32x2_hw*)d = (f32x2_hw){v[i].x, v[i].y}; *(LAS f32x2_hw*)(d + 2) = (f32x2_hw){v[i].z, v[i].w}; }
    asm volatile("s_waitcnt lgkmcnt(0)" ::: "memory");
    const int c = lane & 3;
#pragma unroll
    for (int j = 0; j < 4; ++j) { const int n = (lane >> 2) + 16 * j; const LAS float* sp = scr + (16 * c) * 66 + n;
        const float qs = 127.f / fmaxf(__uint_as_float(colmax[n0 + n]), 1e-30f);
        pg8::u32x4 o;
        o.x = q8x4(sp[0 * 66], sp[1 * 66], sp[2 * 66], sp[3 * 66], qs); o.y = q8x4(sp[4 * 66], sp[5 * 66], sp[6 * 66], sp[7 * 66], qs);
        o.z = q8x4(sp[8 * 66], sp[9 * 66], sp[10 * 66], sp[11 * 66], qs); o.w = q8x4(sp[12 * 66], sp[13 * 66], sp[14 * 66], sp[15 * 66], qs);
        *(pg8::u32x4*)(WT + (size_t)(n0 + n) * K + k0 + 16 * c) = o; }
    asm volatile("s_waitcnt lgkmcnt(0)" ::: "memory");
}
__device__ __forceinline__ void frag_build(const float* W, int ldw, int col0, int nks, bf16_t* dst, int lane) {
    const int q4 = lane >> 4, c16 = lane & 15;
    for (int ct = 0; ct < 4; ++ct) for (int ks = 0; ks < nks; ++ks) { float v[8];
#pragma unroll
        for (int jj = 0; jj < 8; ++jj) v[jj] = W[(size_t)(32 * ks + 8 * q4 + jj) * ldw + col0 + 16 * ct + c16];
        *(pg8::u32x4*)(dst + ((size_t)(ct * nks + ks) * 64 + lane) * 8) = (pg8::u32x4){pk2(v[0], v[1]), pk2(v[2], v[3]), pk2(v[4], v[5]), pk2(v[6], v[7])}; }
}
__device__ __forceinline__ void ph_cvt_frags(const Args& a) {
    const int wave = threadIdx.x >> 6, lane = threadIdx.x & 63, gw = blockIdx.x * 8 + wave;
    if (gw >= 40) {
        const int it = gw - 40; if (it >= 64) return;
        const int L = it >> 5, ks = it & 31, q4 = lane >> 4, c16 = lane & 15;
        const float* gain = a.in[2] + L * DM; const float* wg = a.in[28] + (size_t)L * DM * 4; const float* we = a.in[30] + (size_t)L * DM * 32;
        bf16_t* dh = (bf16_t*)(a.ws + FG_RT) + (size_t)L * 2 * 49152; bf16_t* dl = dh + 49152;
        for (int ct = 0; ct < 3; ++ct) { const int col = 16 * ct + c16; float hi[8], lo[8];
#pragma unroll
            for (int jj = 0; jj < 8; ++jj) { const int k = 32 * ks + 8 * q4 + jj; const float w = col < 4 ? wg[k * 4 + col] : (col < 36 ? we[k * 32 + col - 4] : 0.f); const float v = gain[k] * w;
                hi[jj] = bf2f(f2bf(v)); lo[jj] = v - hi[jj]; }
            const size_t o = ((size_t)(ks * 3 + ct) * 64 + lane) * 8;
            *(pg8::u32x4*)(dh + o) = (pg8::u32x4){pk2(hi[0], hi[1]), pk2(hi[2], hi[3]), pk2(hi[4], hi[5]), pk2(hi[6], hi[7])};
            *(pg8::u32x4*)(dl + o) = (pg8::u32x4){pk2(lo[0], lo[1]), pk2(lo[2], lo[3]), pk2(lo[4], lo[5]), pk2(lo[6], lo[7])}; }
        return; }
    const int arr = gw >> 3, h = gw & 7;
    if (arr == 0) frag_build(a.in[7], 512, 64 * h, 2, (bf16_t*)(a.ws + FG_W2) + h * 4096, lane);
    else if (arr == 1) frag_build(a.in[9], 512, 64 * h, 2, (bf16_t*)(a.ws + FG_A2) + h * 4096, lane);
    else if (arr == 2) frag_build(a.in[18] + h * 4096, 64, 0, 2, (bf16_t*)(a.ws + FG_WA) + h * 4096, lane);
    else if (arr == 3) frag_build(a.in[20] + h * 4096, 64, 0, 2, (bf16_t*)(a.ws + FG_WX) + h * 4096, lane);
    else frag_build(a.in[10], 512, 64 * h, 4, (bf16_t*)(a.ws + FG_G2) + h * 8192, lane);
}
__device__ __forceinline__ void ph_cvt_dense_a(const Args& a, LAS float* lds, unsigned* colmax, int bid, int nblk, int part) {
    const int wave = threadIdx.x >> 6, lane = threadIdx.x & 63, gw = bid * 8 + wave, NGW = nblk * 8;
    LAS float* scr = lds + wave * (64 * 66);
    constexpr int I0 = (DM / 64) * (ABC / 64), I1 = (DM / 64) * (DM / 64), I2 = (DM / 64) * (4096 / 64), I3 = I1;
    for (int it = gw; it < (part ? I1 + I3 + I2 : I0); it += NGW) { int r = part ? it : it + I1 + I3;
        if (r < I1) { transpose_item<0>(a.in[23], DM, DM, (bf16_t*)(a.ws + WD_ABOUT), scr, r, lane); continue; } r -= I1;
        if (r < I3) { transpose_item<0>(a.in[27], DM, DM, (bf16_t*)(a.ws + WD_COUT), scr, r, lane); continue; } r -= I3;
        if (part) r += I0;
        const int m = r < I0 ? 0 : 1; if (m) r -= I0; const int N = m ? 4096 : ABC; const float* W = m ? a.in[24] : a.in[4];
        const int k0 = 64 * (r / (N / 64)), n0 = 64 * (r % (N / 64)); float mx[4] = {0.f, 0.f, 0.f, 0.f};
#pragma unroll 4
        for (int i = 0; i < 16; ++i) { const float4 v = *(const float4*)(W + (size_t)(k0 + 4 * i + (lane >> 4)) * N + n0 + (lane & 15) * 4);
            mx[0] = fmaxf(mx[0], fabsf(v.x)); mx[1] = fmaxf(mx[1], fabsf(v.y)); mx[2] = fmaxf(mx[2], fabsf(v.z)); mx[3] = fmaxf(mx[3], fabsf(v.w)); }
#pragma unroll
        for (int q = 0; q < 4; ++q) { float t = mx[q];
            auto s1 = __builtin_amdgcn_permlane16_swap(__float_as_uint(t), __float_as_uint(t), false, false); t = fmaxf(__uint_as_float(s1[0]), __uint_as_float(s1[1]));
            auto s2 = __builtin_amdgcn_permlane32_swap(__float_as_uint(t), __float_as_uint(t), false, false); t = fmaxf(__uint_as_float(s2[0]), __uint_as_float(s2[1]));
            if (lane < 16) atomicMax(colmax + (m ? ABC : 0) + n0 + lane * 4 + q, __float_as_uint(t)); } }
}
__device__ __forceinline__ void ph_cvt_dense_b(const Args& a, LAS float* lds, const unsigned* colmax, int m, int bid, int nblk) {
    const int wave = threadIdx.x >> 6, lane = threadIdx.x & 63, gw = bid * 8 + wave, NGW = nblk * 8;
    LAS float* scr = lds + wave * (64 * 66);
    const int N = m ? 4096 : ABC; const int NI = (DM / 64) * (N / 64);
    for (int it = gw; it < NI; it += NGW) transpose_item_i8c(m ? a.in[24] : a.in[4], DM, N, a.ws + (m ? WD_CIN : WD_ABIN), scr, it, lane, colmax + (m ? ABC : 0));
}
__device__ __forceinline__ void ph_cvt_down1(const Args& a, LAS float* lds, int bid, int nblk, int e_lo, int e_hi) {
    const int wave = threadIdx.x >> 6, lane = threadIdx.x & 63, gw = bid * 8 + wave, NGW = nblk * 8;
    LAS float* scr = lds + wave * (64 * 66);
    constexpr int ID = (FF / 64) * (DM / 64);
    for (int it = gw; it < (e_hi - e_lo) * ID; it += NGW) { const int e = e_lo + it / ID, r = it % ID;
        transpose_item<0>(a.in[34] + ((size_t)NEXP + e) * DM * FF, FF, DM, (bf16_t*)a.out + (size_t)e * DM * FF, scr, r, lane); }
}
__device__ __forceinline__ void moe_tail_cvt(const Args& a, LAS float* lds, const LAS int* pst, int e_lo, int e_hi) {
    const int G = (int)gridDim.x, c = (int)blockIdx.x, cc = (G % pg8::NXCD == 0) ? (c % pg8::NXCD) * (G / pg8::NXCD) + c / pg8::NXCD : c;
    const int nun = (pst[NEXP] / 256) * 4, last = nun - ((nun - 1) / G) * G, nidle = G - last;
    __syncthreads();
    if (nidle >= 64) { if (cc >= last) ph_cvt_down1(a, lds, cc - last, nidle, e_lo, e_hi); }
    else ph_cvt_down1(a, lds, c, G, e_lo, e_hi);
}
__device__ __forceinline__ void ph_cvt_moe(const Args& a, int L, LAS float* lds, int bid, int nblk, int which) {
    const int wave = threadIdx.x >> 6, lane = threadIdx.x & 63, gw = bid * 8 + wave, NGW = nblk * 8;
    LAS float* scr = lds + wave * (64 * 66);
    constexpr int IG = (DM / 64) * (FF / 64), ID = (FF / 64) * (DM / 64);
    const int i0 = (which & 1) ? 0 : 2 * IG, IE = ((which & 1) ? 2 * IG : 0) + ((which & 2) ? ID : 0);
    unsigned char* gub = a.ws + (L ? WM_GU1 : WM_GU);
    for (int it = gw; it < NEXP * IE; it += NGW) { const int e = it / IE; int r = i0 + it % IE;
        unsigned char* gu = gub + (size_t)e * DM * DM; bf16_t* dn = (bf16_t*)(a.ws + WM_DN) + (size_t)e * DM * FF;
        const unsigned* wm = (const unsigned*)(a.ws + WS_CTL) + CW_WMAX + (L * NEXP + e) * 2;
        const size_t wo = ((size_t)L * NEXP + e) * DM * FF;
        if (r < IG) { transpose_item_i8<1>(a.in[32] + wo, DM, FF, gu, scr, r, lane, 127.f / fmaxf(__uint_as_float(wm[0]), 1e-30f)); continue; } r -= IG;
        if (r < IG) { transpose_item_i8<2>(a.in[33] + wo, DM, FF, gu, scr, r, lane, 127.f / fmaxf(__uint_as_float(wm[1]), 1e-30f)); continue; } r -= IG;
        transpose_item<0>(a.in[34] + wo, FF, DM, dn, scr, r, lane); }
}

__device__ __forceinline__ void load_row16(const float* row, int lane, float4 (&v)[4]) {
#pragma unroll
    for (int j = 0; j < 4; ++j) v[j] = *(const float4*)(row + lane * 4 + 256 * j);
}
__device__ __forceinline__ float row_sumsq(const float4 (&v)[4]) {
    float s = 0.f;
#pragma unroll
    for (int j = 0; j < 4; ++j) s += v[j].x * v[j].x + v[j].y * v[j].y + v[j].z * v[j].z + v[j].w * v[j].w;
    return wave_sum(s);
}
__device__ __forceinline__ void norm_row(float4 (&v)[4], const float* gain, int lane) {
    const float rs = rsqrtf(row_sumsq(v) * (1.f / DM) + 1e-6f);
#pragma unroll
    for (int j = 0; j < 4; ++j) { const float4 g = *(const float4*)(gain + lane * 4 + 256 * j);
        v[j].x *= rs * g.x; v[j].y *= rs * g.y; v[j].z *= rs * g.z; v[j].w *= rs * g.w; }
}
__device__ __forceinline__ void store_row_bf16(bf16_t* row, int lane, const float4 (&v)[4]) {
#pragma unroll
    for (int j = 0; j < 4; ++j) { uint2 o; o.x = f2bf(v[j].x) | ((unsigned)f2bf(v[j].y) << 16); o.y = f2bf(v[j].z) | ((unsigned)f2bf(v[j].w) << 16);
        *(uint2*)(row + lane * 4 + 256 * j) = o; }
}
__device__ __forceinline__ void add_row_bf16(const bf16_t* row, int lane, float4 (&v)[4]) {
#pragma unroll
    for (int j = 0; j < 4; ++j) { const uint2 o = *(const uint2*)(row + lane * 4 + 256 * j);
        v[j].x += __uint_as_float(o.x << 16); v[j].y += __uint_as_float(o.x & 0xffff0000u); v[j].z += __uint_as_float(o.y << 16); v[j].w += __uint_as_float(o.y & 0xffff0000u); }
}

__device__ __forceinline__ void ph_norm0(const float* x, const float* gain, unsigned char* HN8, float* rowscale) {
    const int lane = threadIdx.x & 63, gw = blockIdx.x * 8 + (threadIdx.x >> 6), NGW = gridDim.x * 8;
    float4 nv[4]; if (gw < NTOK) load_row16(x + (size_t)gw * DM, lane, nv);
    for (int n = gw; n < NTOK; n += NGW) { float4 v[4];
#pragma unroll
        for (int j = 0; j < 4; ++j) v[j] = nv[j];
        if (n + NGW < NTOK) load_row16(x + (size_t)(n + NGW) * DM, lane, nv);
        asm volatile("" ::: "memory");
        norm_row(v, gain, lane);
        float mx = 0.f;
#pragma unroll
        for (int j = 0; j < 4; ++j) mx = fmaxf(fmaxf(mx, fmaxf(fabsf(v[j].x), fabsf(v[j].y))), fmaxf(fabsf(v[j].z), fabsf(v[j].w)));
        mx = fmaxf(wave_max(mx), 1e-30f); const float qs = 127.f / mx;
        if (lane == 0) rowscale[n] = mx;
#pragma unroll
        for (int j = 0; j < 4; ++j) *(unsigned*)(HN8 + (size_t)n * DM + lane * 4 + 256 * j) = q8x4(v[j].x, v[j].y, v[j].z, v[j].w, qs); }
}
__device__ __forceinline__ void ld8bf(const bf16_t* p, float (&v)[8]) { const u32x4_t o = *(const u32x4_t*)p;
    v[0] = __uint_as_float(o.x << 16); v[1] = __uint_as_float(o.x & 0xffff0000u); v[2] = __uint_as_float(o.y << 16); v[3] = __uint_as_float(o.y & 0xffff0000u);
    v[4] = __uint_as_float(o.z << 16); v[5] = __uint_as_float(o.z & 0xffff0000u); v[6] = __uint_as_float(o.w << 16); v[7] = __uint_as_float(o.w & 0xffff0000u); }
__device__ __forceinline__ void up8bf(const u32x4_t o, float (&v)[8]) {
    v[0] = __uint_as_float(o.x << 16); v[1] = __uint_as_float(o.x & 0xffff0000u); v[2] = __uint_as_float(o.y << 16); v[3] = __uint_as_float(o.y & 0xffff0000u);
    v[4] = __uint_as_float(o.z << 16); v[5] = __uint_as_float(o.z & 0xffff0000u); v[6] = __uint_as_float(o.w << 16); v[7] = __uint_as_float(o.w & 0xffff0000u); }
struct RowRaw { u32x4_t x[2], y0[2], y1[2]; };
__device__ __forceinline__ void row_fetch(RowRaw& r, const bf16_t* XR, const bf16_t* Y, int n, int lane) {
#pragma unroll
    for (int j = 0; j < 2; ++j) { const int o = lane * 8 + 512 * j; r.x[j] = *(const u32x4_t*)(XR + (size_t)n * DM + o); r.y0[j] = *(const u32x4_t*)(Y + (size_t)(2 * n) * DM + o); r.y1[j] = *(const u32x4_t*)(Y + (size_t)(2 * n + 1) * DM + o); }
}
__device__ __forceinline__ void st8bf(bf16_t* p, const float (&v)[8]) { *(u32x4_t*)p = (u32x4_t){pk2(v[0], v[1]), pk2(v[2], v[3]), pk2(v[4], v[5]), pk2(v[6], v[7])}; }
__device__ __forceinline__ void ph_combine_norm(bf16_t* XR, const bf16_t* Y, const float* gain, unsigned char* HN8, float* rowscale) {
    const int lane = threadIdx.x & 63, gw = blockIdx.x * 8 + (threadIdx.x >> 6), NGW = gridDim.x * 8;
    RowRaw nx; if (gw < NTOK) row_fetch(nx, XR, Y, gw, lane);
    for (int n = gw; n < NTOK; n += NGW) { float x[2][8], y0[2][8], y1[2][8]; float ss = 0.f;
        const RowRaw cr = nx; if (n + NGW < NTOK) row_fetch(nx, XR, Y, n + NGW, lane);
        asm volatile("" ::: "memory");
#pragma unroll
        for (int j = 0; j < 2; ++j) { up8bf(cr.x[j], x[j]); up8bf(cr.y0[j], y0[j]); up8bf(cr.y1[j], y1[j]); }
#pragma unroll
        for (int j = 0; j < 2; ++j) {
#pragma unroll
            for (int i = 0; i < 8; ++i) x[j][i] = bf2f(f2bf(x[j][i] + y0[j][i] + y1[j][i]));
            st8bf(XR + (size_t)n * DM + lane * 8 + 512 * j, x[j]);
#pragma unroll
            for (int i = 0; i < 8; ++i) ss += x[j][i] * x[j][i]; }
        const float rs = rsqrtf(wave_sum(ss) * (1.f / DM) + 1e-6f);
#pragma unroll
        for (int j = 0; j < 2; ++j) { const int o = lane * 8 + 512 * j; const float4 g0 = *(const float4*)(gain + o), g1 = *(const float4*)(gain + o + 4);
            const float gg[8] = {g0.x, g0.y, g0.z, g0.w, g1.x, g1.y, g1.z, g1.w};
#pragma unroll
            for (int i = 0; i < 8; ++i) x[j][i] *= rs * gg[i]; }
        float mx = 0.f;
#pragma unroll
        for (int j = 0; j < 2; ++j)
#pragma unroll
            for (int i = 0; i < 8; ++i) mx = fmaxf(mx, fabsf(x[j][i]));
        mx = fmaxf(wave_max(mx), 1e-30f); const float qs = 127.f / mx;
        if (lane == 0) rowscale[n] = mx;
#pragma unroll
        for (int j = 0; j < 2; ++j) { const int o = lane * 8 + 512 * j;
            *(u32x2_t*)(HN8 + (size_t)n * DM + o) = (u32x2_t){q8x4(x[j][0], x[j][1], x[j][2], x[j][3], qs), q8x4(x[j][4], x[j][5], x[j][6], x[j][7], qs)}; } }
}
__device__ __forceinline__ void ph_final(const bf16_t* XR, const bf16_t* Y, const float* gain, float* out) {
    const int lane = threadIdx.x & 63, gw = blockIdx.x * 8 + (threadIdx.x >> 6), NGW = gridDim.x * 8;
    RowRaw nx; if (gw < NTOK) row_fetch(nx, XR, Y, gw, lane);
    for (int n = gw; n < NTOK; n += NGW) { float x[2][8], y0[2][8], y1[2][8]; float ss = 0.f;
        const RowRaw cr = nx; if (n + NGW < NTOK) row_fetch(nx, XR, Y, n + NGW, lane);
        asm volatile("" ::: "memory");
#pragma unroll
        for (int j = 0; j < 2; ++j) { up8bf(cr.x[j], x[j]); up8bf(cr.y0[j], y0[j]); up8bf(cr.y1[j], y1[j]); }
#pragma unroll
        for (int j = 0; j < 2; ++j)
#pragma unroll
            for (int i = 0; i < 8; ++i) { x[j][i] = x[j][i] + y0[j][i] + y1[j][i]; ss += x[j][i] * x[j][i]; }
        const float rs = rsqrtf(wave_sum(ss) * (1.f / DM) + 1e-6f);
#pragma unroll
        for (int j = 0; j < 2; ++j) { const int o = lane * 8 + 512 * j; const float4 g0 = *(const float4*)(gain + o), g1 = *(const float4*)(gain + o + 4);
            *(float4*)(out + (size_t)n * DM + o) = make_float4(x[j][0] * rs * g0.x, x[j][1] * rs * g0.y, x[j][2] * rs * g0.z, x[j][3] * rs * g0.w);
            *(float4*)(out + (size_t)n * DM + o + 4) = make_float4(x[j][4] * rs * g1.x, x[j][5] * rs * g1.y, x[j][6] * rs * g1.z, x[j][7] * rs * g1.w); } }
}
__device__ __forceinline__ void ph_route(const Args& a, int Lyr, const bf16_t* XR, bf16_t* HN, float* RS, unsigned* cnt, int* list_slot, float* list_gate, LAS float* lds) {
    const float* gain = a.in[2] + Lyr * DM; const float* bg = a.in[29] + Lyr * 4; const float* be = a.in[31] + Lyr * 32;
    const bf16_t* FRh = (const bf16_t*)(a.ws + FG_RT) + (size_t)Lyr * 2 * 49152; const bf16_t* FRl = FRh + 49152;
    const int lane = threadIdx.x & 63, wave = threadIdx.x >> 6, q4 = lane >> 4, c16 = lane & 15, r4 = lane >> 4, cidx = lane & 15;
    LAS unsigned char* Lb = (LAS unsigned char*)lds;
    LAS unsigned char* W = Lb + wave * 12288;
    LAS float* SS = (LAS float*)(W + 8704); LAS float* LG = (LAS float*)(W + 8768);
    LAS unsigned* lcnt = (LAS unsigned*)(Lb + 8 * 12288); LAS unsigned* lbase = lcnt + 32;
    const int NGW = gridDim.x * 8, gw = blockIdx.x * 8 + wave;
    for (int rnd = 0; rnd * NGW < NTOK / 16; ++rnd) {
        const int tile = rnd * NGW + gw; const bool act = tile < NTOK / 16; const int n0 = tile * 16;
        if (threadIdx.x < 32) lcnt[threadIdx.x] = 0u;
        __syncthreads();
        int e0 = 0, e1 = 0, lr0 = 0, lr1 = 0; float g0 = 0.f, g1 = 0.f;
        if (act) {
            f32x4 acc[3], accs = (f32x4){0.f, 0.f, 0.f, 0.f};
#pragma unroll
            for (int ct = 0; ct < 3; ++ct) acc[ct] = accs;
#pragma unroll 1
            for (int kc = 0; kc < 8; ++kc) {
                bf16x8_t bh[4][3], bl[4][3];
#pragma unroll
                for (int ks = 0; ks < 4; ++ks)
#pragma unroll
                    for (int ct = 0; ct < 3; ++ct) { const size_t o = ((size_t)((kc * 4 + ks) * 3 + ct) * 64 + lane) * 8; bh[ks][ct] = *(const bf16x8_t*)(FRh + o); bl[ks][ct] = *(const bf16x8_t*)(FRl + o); }
                u32x4_t xv[4];
#pragma unroll
                for (int j = 0; j < 4; ++j) xv[j] = *(const u32x4_t*)(XR + (size_t)(n0 + 4 * j + r4) * DM + kc * 128 + 8 * cidx);
                __builtin_amdgcn_sched_barrier(0);
#pragma unroll
                for (int j = 0; j < 4; ++j) *(LAS u32x4_t*)(W + (4 * j + r4) * 272 + cidx * 16) = xv[j];
#pragma unroll
                for (int ks = 0; ks < 4; ++ks) { const bf16x8_t ahi = *(const LAS bf16x8_t*)(W + c16 * 272 + ks * 64 + q4 * 16);
                    accs = __builtin_amdgcn_mfma_f32_16x16x32_bf16(ahi, ahi, accs, 0, 0, 0);
#pragma unroll
                    for (int ct = 0; ct < 3; ++ct) { acc[ct] = __builtin_amdgcn_mfma_f32_16x16x32_bf16(ahi, bh[ks][ct], acc[ct], 0, 0, 0); acc[ct] = __builtin_amdgcn_mfma_f32_16x16x32_bf16(ahi, bl[ks][ct], acc[ct], 0, 0, 0); } }
            }
#pragma unroll
            for (int r = 0; r < 4; ++r) if (c16 == 4 * q4 + r) { const float rsv = rsqrtf(accs[r] * (1.f / DM) + 1e-6f); SS[c16] = rsv; RS[n0 + c16] = rsv; }
            const f32x4 s4 = *(const LAS f32x4*)(SS + 4 * q4);
#pragma unroll
            for (int ct = 0; ct < 3; ++ct) { const int col = 16 * ct + c16; const float bias = col < 4 ? bg[col] : (col < 36 ? be[col - 4] : 0.f);
#pragma unroll
                for (int r = 0; r < 4; ++r) LG[(4 * q4 + r) * 48 + col] = acc[ct][r] * s4[r] + bias; }
            if (lane < 16) {
                const LAS float* lg = LG + lane * 48;
                int gs = 0; float gm = lg[0];
#pragma unroll
                for (int i = 1; i < 4; ++i) { const float v = lg[i]; if (v > gm) { gm = v; gs = i; } }
                float gden = 0.f;
#pragma unroll
                for (int i = 0; i < 4; ++i) gden += __expf(lg[i] - gm);
                const float ggate = 1.f / gden;
                const LAS float* l8 = lg + 4 + gs * 8;
                int i0 = 0; float m0 = l8[0];
#pragma unroll
                for (int i = 1; i < 8; ++i) { const float v = l8[i]; if (v > m0) { m0 = v; i0 = i; } }
                int i1 = (i0 == 0) ? 1 : 0; float m1 = l8[i1];
#pragma unroll
                for (int i = 0; i < 8; ++i) { const float v = l8[i]; if (i != i0 && v > m1) { m1 = v; i1 = i; } }
                const float ex = __expf(m1 - m0);
                g0 = ggate / (1.f + ex); g1 = ggate * ex / (1.f + ex);
                e0 = gs * 8 + i0; e1 = gs * 8 + i1;
                lr0 = (int)__hip_atomic_fetch_add(lcnt + e0, 1u, __ATOMIC_RELAXED, __HIP_MEMORY_SCOPE_WORKGROUP); lr1 = (int)__hip_atomic_fetch_add(lcnt + e1, 1u, __ATOMIC_RELAXED, __HIP_MEMORY_SCOPE_WORKGROUP);
            }
        }
        __syncthreads();
        if (threadIdx.x < 32) { const unsigned c = lcnt[threadIdx.x]; lbase[threadIdx.x] = c ? atomicAdd(&cnt[threadIdx.x], c) : 0u; }
        __syncthreads();
        if (act) {
            if (lane < 16) { const int n = n0 + lane;
                const int d0 = e0 * MOE_CAP + (int)lbase[e0] + lr0, d1 = e1 * MOE_CAP + (int)lbase[e1] + lr1;
                list_slot[d0] = 2 * n; list_slot[d1] = 2 * n + 1; list_gate[d0] = g0; list_gate[d1] = g1; }
            unsigned char* H8 = (unsigned char*)HN;
            float rsr[4];
#pragma unroll
            for (int j = 0; j < 4; ++j) rsr[j] = SS[4 * j + r4] * ACT_Q;
#pragma unroll 2
            for (int kc = 0; kc < 8; ++kc) { const float4 gn0 = *(const float4*)(gain + kc * 128 + 8 * cidx), gn1 = *(const float4*)(gain + kc * 128 + 8 * cidx + 4);
                u32x4_t xv[4];
#pragma unroll
                for (int j = 0; j < 4; ++j) xv[j] = *(const u32x4_t*)(XR + (size_t)(n0 + 4 * j + r4) * DM + kc * 128 + 8 * cidx);
#pragma unroll
                for (int j = 0; j < 4; ++j) { const u32x4_t o = xv[j]; const float q = rsr[j];
                    *(u32x2_t*)(H8 + (size_t)(n0 + 4 * j + r4) * DM + kc * 128 + 8 * cidx) = (u32x2_t){
                        q8x4(__uint_as_float(o.x << 16) * gn0.x, __uint_as_float(o.x & 0xffff0000u) * gn0.y, __uint_as_float(o.y << 16) * gn0.z, __uint_as_float(o.y & 0xffff0000u) * gn0.w, q),
                        q8x4(__uint_as_float(o.z << 16) * gn1.x, __uint_as_float(o.z & 0xffff0000u) * gn1.y, __uint_as_float(o.w << 16) * gn1.z, __uint_as_float(o.w & 0xffff0000u) * gn1.w, q)}; } }
        }
        __syncthreads();
    }
}
__device__ __forceinline__ void moe_prefix(const unsigned* cnt, LAS int* pst) {
    if (threadIdx.x == 0) { int acc = 0; for (int e = 0; e < NEXP; ++e) { pst[e] = acc; const int c = (int)cnt[e]; acc += (c + MOE_TM - 1) / MOE_TM * MOE_TM; } pst[NEXP] = acc; }
    __syncthreads();
}
__device__ __forceinline__ int moe_tile_expert(const LAS int* pst, int row0) { int e = 0;
    for (int i = 1; i < NEXP; ++i) if (row0 >= pst[i]) e = i;
    return e; }

__device__ __forceinline__ float shiftcol(const bf16_t* P, int n, int t, int col, const float* mu) {
    const float cur = bf2f(P[(size_t)n * ABC + col]); const float prev = t > 0 ? bf2f(P[(size_t)(n - 1) * ABC + col]) : 0.f;
    return cur + (prev - cur) * mu[col];
}
constexpr int RW_WMF = 0, RW_RF = 2048, RW_BKF = 4096, RW_ARF = 8192, RW_U = 9216, RW_V = 11264, RW_G = 13312, RW_REC = 13568;
__device__ __forceinline__ float fast_sigmoid(float x) { return __builtin_amdgcn_rcpf(1.f + __expf(-x)); }
__device__ __forceinline__ float fast_softplus(float x) { return fmaxf(x, 0.f) + __logf(1.f + __expf(-fabsf(x))); }
__device__ __forceinline__ void tr_acc(LAS float* TBf, const f32x4 (&acc)[4], int lane, float (&out)[16]) {
    const int q4 = lane >> 4, c16 = lane & 15;
#pragma unroll
    for (int ct = 0; ct < 4; ++ct)
#pragma unroll
        for (int r = 0; r < 4; ++r) TBf[(16 * ct + 4 * q4 + r) * 20 + c16] = acc[ct][r];
#pragma unroll
    for (int j = 0; j < 4; ++j) { const f32x4 v = *(const LAS f32x4*)(TBf + lane * 20 + 4 * j); out[4 * j] = v[0]; out[4 * j + 1] = v[1]; out[4 * j + 2] = v[2]; out[4 * j + 3] = v[3]; }
}
__device__ __forceinline__ void ph_l0_prep(const Args& a, LAS float* lds) {
    const bf16_t* P = (const bf16_t*)(a.ws + WS_B);
    unsigned char* FR = a.ws + WS_C;
    bf16_t* Vb = (bf16_t*)a.out; float* Bon = (float*)((unsigned char*)a.out + 32 * MiB);
    bf16_t* LA = (bf16_t*)(a.ws + WS_A); bf16_t* U = LA + (size_t)NTOK * 512;
    const float* mu = a.in[5]; const float* w0 = a.in[6]; const float* a0 = a.in[8];
    const float* k_k = a.in[11]; const float* k_a = a.in[12]; const float* r_k = a.in[13];
    const float* conv_w = a.in[16]; const float* conv_b = a.in[17]; const float* b_a = a.in[19]; const float* b_x = a.in[21]; const float* lam = a.in[22];
    const int lane = threadIdx.x & 63, wave = threadIdx.x >> 6, q4 = lane >> 4, c16 = lane & 15;
    LAS unsigned char* W = (LAS unsigned char*)lds + wave * 15360;
    constexpr int KAP = 0, BT = 2304, KT = 4608, RT = 6912, BTT = 9216, KTT = 11264, AKB = 13312, AKK = 14336, RS = 144;
    constexpr int XS = 0, XS2 = 2304, TB = 4608;
    LAS float* TBf = (LAS float*)(W + TB);
    for (int u = blockIdx.x * 8 + wave; u < (NTOK / 16) * 8; u += gridDim.x * 8) {
        const int tile = u >> 3, h = u & 7, n0 = tile * 16, c = h * 64 + lane;
        const bool first = (n0 & (SEQ - 1)) == 0;
        const unsigned char* PT = (const unsigned char*)(P + (size_t)tile * ABC * 16);
        const unsigned char* PTp = PT - (size_t)ABC * 32;
        unsigned lo32 = (unsigned)lane * 32u; asm volatile("" : "+v"(lo32));
#define LD16(dst, colbase, off) do { const u32x4_t _lo = *(const u32x4_t*)(PT + (colbase) * 32 + lo32), _hi = *(const u32x4_t*)(PT + (colbase) * 32 + 16 + lo32); \
            dst[(off)] = _lo.x; dst[(off) + 1] = _lo.y; dst[(off) + 2] = _lo.z; dst[(off) + 3] = _lo.w; dst[(off) + 4] = _hi.x; dst[(off) + 5] = _hi.y; dst[(off) + 6] = _hi.z; dst[(off) + 7] = _hi.w; } while (0)
        unsigned xbp[10], pwp[9], pap[9], qrp[9], qkp[9], qvp[9];
        { u32x2_t t2 = (u32x2_t){0u, 0u}; if (!first) t2 = *(const u32x2_t*)(PTp + (2304 + h * 64) * 32 + 24 + lo32); xbp[0] = t2.x; xbp[1] = t2.y; LD16(xbp, 2304 + h * 64, 2); }
        pwp[0] = first ? 0u : *(const unsigned*)(PTp + 1536 * 32 + 28 + lo32); LD16(pwp, 1536, 1);
        pap[0] = first ? 0u : *(const unsigned*)(PTp + 1600 * 32 + 28 + lo32); LD16(pap, 1600, 1);
        asm volatile("" ::: "memory");
#define UNPK(arr, i) __uint_as_float(((i) & 1) ? ((arr)[(i) >> 1] & 0xffff0000u) : ((arr)[(i) >> 1] << 16))
        {
            bf16_t* SG = (bf16_t*)((unsigned char*)a.out + DO_SG);
            const int tk = lane >> 2, col = 1664 + 16 * h + (lane & 3) * 4;
            unsigned so = (unsigned)((lane & 3) * 128 + tk * 2); asm volatile("" : "+v"(so));
            float cu[4], pu[4];
#pragma unroll
            for (int i = 0; i < 4; ++i) { cu[i] = bf2f(*(const bf16_t*)(PT + (1664 + 16 * h + i) * 32 + so));
                pu[i] = (tk > 0) ? bf2f(*(const bf16_t*)(PT + (1664 + 16 * h + i) * 32 - 2 + so)) : (first ? 0.f : bf2f(*(const bf16_t*)(PTp + (1664 + 16 * h + i) * 32 + 30 + so))); }
            const f32x4 m4 = *(const f32x4*)(mu + col);
            *(u32x2_t*)(SG + (size_t)(tile * 8 + h) * 256 + lane * 4) = (u32x2_t){pk2(fast_sigmoid(cu[0] + (pu[0] - cu[0]) * m4[0]), fast_sigmoid(cu[1] + (pu[1] - cu[1]) * m4[1])), pk2(fast_sigmoid(cu[2] + (pu[2] - cu[2]) * m4[2]), fast_sigmoid(cu[3] + (pu[3] - cu[3]) * m4[3]))};
        }
        {
            const float cw0 = conv_w[c], cw1 = conv_w[512 + c], cw2 = conv_w[1024 + c], cw3 = conv_w[1536 + c], cb = conv_b[c];
            float xcv[16], xb[19];
#pragma unroll
            for (int i = 0; i < 19; ++i) xb[i] = UNPK(xbp, i + 1);
#pragma unroll
            for (int tk = 0; tk < 16; ++tk) { xcv[tk] = cb + cw0 * xb[tk] + cw1 * xb[tk + 1] + cw2 * xb[tk + 2] + cw3 * xb[tk + 3]; *(LAS bf16_t*)(W + XS + tk * RS + lane * 2) = f2bf(xcv[tk]); }
            f32x4 accr[4], acci[4];
            const bf16_t* FA = (const bf16_t*)(a.ws + FG_WA) + h * 4096; const bf16_t* FX = (const bf16_t*)(a.ws + FG_WX) + h * 4096;
            bf16x8_t xf[2];
#pragma unroll
            for (int ks = 0; ks < 2; ++ks) xf[ks] = *(const LAS bf16x8_t*)(W + XS + c16 * RS + ks * 64 + q4 * 16);
#pragma unroll
            for (int ct = 0; ct < 4; ++ct) { asm volatile("" ::: "memory"); accr[ct] = (f32x4){0.f, 0.f, 0.f, 0.f}; acci[ct] = accr[ct];
#pragma unroll
                for (int ks = 0; ks < 2; ++ks) { accr[ct] = __builtin_amdgcn_mfma_f32_16x16x32_bf16(*(const bf16x8_t*)(FA + ((ct * 2 + ks) * 64 + lane) * 8), xf[ks], accr[ct], 0, 0, 0);
                    acci[ct] = __builtin_amdgcn_mfma_f32_16x16x32_bf16(*(const bf16x8_t*)(FX + ((ct * 2 + ks) * 64 + lane) * 8), xf[ks], acci[ct], 0, 0, 0); } }
            float rp[16], ip[16];
            tr_acc(TBf, accr, lane, rp); tr_acc(TBf, acci, lane, ip);
            const float bac = b_a[c], bxc = b_x[c], sp = fast_softplus(-lam[c]);
            float hloc = 0.f, sla = 0.f;
            unsigned lap[4], uup[4];
#pragma unroll
            for (int tk = 0; tk < 16; ++tk) { const float r = fast_sigmoid(rp[tk] + bac), i = fast_sigmoid(ip[tk] + bxc);
                const float la = -8.f * r * sp; const float uu = __builtin_amdgcn_sqrtf(fmaxf(1.f - __expf(2.f * la), 0.f)) * i * xcv[tk];
                const bf16_t lab = f2bf(la), uub = f2bf(uu); const float lar = bf2f(lab);
                if (tk & 1) { lap[(tk >> 1) & 3] |= (unsigned)lab << 16; uup[(tk >> 1) & 3] |= (unsigned)uub << 16; } else { lap[(tk >> 1) & 3] = lab; uup[(tk >> 1) & 3] = uub; }
                if ((tk & 7) == 7) { *(u32x4_t*)(LA + ((size_t)tile * 512 + c) * 16 + (tk >> 3) * 8) = (u32x4_t){lap[0], lap[1], lap[2], lap[3]}; *(u32x4_t*)(U + ((size_t)tile * 512 + c) * 16 + (tk >> 3) * 8) = (u32x4_t){uup[0], uup[1], uup[2], uup[3]}; }
                hloc = __expf(lar) * hloc + bf2f(uub); sla += lar; }
            ((float*)((unsigned char*)a.out + DO_LRU))[(size_t)tile * 512 + c] = hloc; ((float*)((unsigned char*)a.out + DO_LRU))[(size_t)(2048 + tile) * 512 + c] = sla;
        }
        asm volatile("" ::: "memory");
        asm volatile("" : "+v"(lo32));
        qrp[0] = first ? 0u : *(const unsigned*)(PTp + (h * 64) * 32 + 28 + lo32); LD16(qrp, h * 64, 1);
        qkp[0] = first ? 0u : *(const unsigned*)(PTp + (512 + h * 64) * 32 + 28 + lo32); LD16(qkp, 512 + h * 64, 1);
        qvp[0] = first ? 0u : *(const unsigned*)(PTp + (1024 + h * 64) * 32 + 28 + lo32); LD16(qvp, 1024 + h * 64, 1);
        asm volatile("" ::: "memory");
        float wpre[16], apre[16];
        {
            const float muw = mu[1536 + lane], mua = mu[1600 + lane];
#pragma unroll
            for (int tk = 0; tk < 16; ++tk) { const float pw1 = UNPK(pwp, tk + 2), pw0 = UNPK(pwp, tk + 1), pa1 = UNPK(pap, tk + 2), pa0 = UNPK(pap, tk + 1);
                const float wl = pw1 + (pw0 - pw1) * muw, al = pa1 + (pa0 - pa1) * mua;
                const float th = 1.f - 2.f * __builtin_amdgcn_rcpf(1.f + __expf(2.f * wl));
                *(LAS bf16_t*)(W + XS + tk * RS + lane * 2) = f2bf(th); *(LAS bf16_t*)(W + XS2 + tk * RS + lane * 2) = f2bf(al); }
            f32x4 accw[4], acca[4];
            const bf16_t* F2 = (const bf16_t*)(a.ws + FG_W2) + h * 4096; const bf16_t* FA2 = (const bf16_t*)(a.ws + FG_A2) + h * 4096;
            bf16x8_t wf[2], af[2];
#pragma unroll
            for (int ks = 0; ks < 2; ++ks) { wf[ks] = *(const LAS bf16x8_t*)(W + XS + c16 * RS + ks * 64 + q4 * 16); af[ks] = *(const LAS bf16x8_t*)(W + XS2 + c16 * RS + ks * 64 + q4 * 16); }
#pragma unroll
            for (int ct = 0; ct < 4; ++ct) { asm volatile("" ::: "memory"); accw[ct] = (f32x4){0.f, 0.f, 0.f, 0.f}; acca[ct] = accw[ct];
#pragma unroll
                for (int ks = 0; ks < 2; ++ks) { accw[ct] = __builtin_amdgcn_mfma_f32_16x16x32_bf16(*(const bf16x8_t*)(F2 + ((ct * 2 + ks) * 64 + lane) * 8), wf[ks], accw[ct], 0, 0, 0);
                    acca[ct] = __builtin_amdgcn_mfma_f32_16x16x32_bf16(*(const bf16x8_t*)(FA2 + ((ct * 2 + ks) * 64 + lane) * 8), af[ks], acca[ct], 0, 0, 0); } }
            tr_acc(TBf, accw, lane, wpre); tr_acc(TBf, acca, lane, apre);
        }
        const float w0c = w0[c], a0c = a0[c], kkc = k_k[c], kac = k_a[c], rkc = r_k[c];
        const float mur = mu[c], muk = mu[512 + c], muv = mu[1024 + c];
        unsigned char* rec = FR + ((size_t)tile * 8 + h) * RW_REC;
        float vsv[16];
        unsigned btp[8], ktp[8];
        float cum = 0.f, gC = 1.f;
#pragma unroll
        for (int tk = 0; tk < 16; ++tk) { const int n = n0 + tk;
            const float cr = UNPK(qrp, tk + 2), ck = UNPK(qkp, tk + 2), cv = UNPK(qvp, tk + 2), pr = UNPK(qrp, tk + 1), pk = UNPK(qkp, tk + 1), pv = UNPK(qvp, tk + 1);
            const float rs = cr + (pr - cr) * mur, ks = ck + (pk - ck) * muk, vs = cv + (pv - cv) * muv;
            const float wv = -fast_softplus(-(w0c + wpre[tk])) - 0.5f; const float logdec = -__expf(wv);
            const float av = fast_sigmoid(a0c + apre[tk]);
            const float kkr = ks * kkc; const float ss = wave_sum(kkr * kkr); const float kkn = kkr * rsqrtf(fmaxf(ss, 1e-24f));
            const float kp = ks * (1.f + (av - 1.f) * kac);
            const float bsum = wave_sum(rs * kp * rkc);
            if (lane == 0) Bon[(size_t)n * 8 + h] = bsum;
            Vb[(size_t)n * 512 + c] = f2bf(vs); vsv[tk] = vs;
            const float gprev = __expf(cum); cum += logdec; const float g = __expf(cum), gi = __builtin_amdgcn_rcpf(g); gC = g;
            const float kapv = kkn * gprev, btv = av * kkn * gi, ktv = kp * gi, rtv = rs * g;
            const bf16_t kb = f2bf(kapv), bb = f2bf(btv), kb2 = f2bf(ktv), rb = f2bf(rtv);
            *(LAS bf16_t*)(W + KAP + tk * RS + lane * 2) = kb; *(LAS bf16_t*)(W + BT + tk * RS + lane * 2) = bb;
            *(LAS bf16_t*)(W + KT + tk * RS + lane * 2) = kb2; *(LAS bf16_t*)(W + RT + tk * RS + lane * 2) = rb;
            if (tk & 1) { btp[tk >> 1] |= (unsigned)bb << 16; ktp[tk >> 1] |= (unsigned)kb2 << 16; } else { btp[tk >> 1] = bb; ktp[tk >> 1] = kb2; } }
        *(LAS u32x4_t*)(W + BTT + lane * 32) = (u32x4_t){btp[0], btp[1], btp[2], btp[3]}; *(LAS u32x4_t*)(W + BTT + lane * 32 + 16) = (u32x4_t){btp[4], btp[5], btp[6], btp[7]};
        *(LAS u32x4_t*)(W + KTT + lane * 32) = (u32x4_t){ktp[0], ktp[1], ktp[2], ktp[3]}; *(LAS u32x4_t*)(W + KTT + lane * 32 + 16) = (u32x4_t){ktp[4], ktp[5], ktp[6], ktp[7]};
        *(float*)(rec + RW_G + lane * 4) = gC;
        f32x4 akb = (f32x4){0.f, 0.f, 0.f, 0.f}, akk = akb, arbT = akb, arkT = akb;
#pragma unroll
        for (int ks = 0; ks < 2; ++ks) { const int fo = c16 * RS + ks * 64 + q4 * 16;
            const bf16x8_t fkap = *(const LAS bf16x8_t*)(W + KAP + fo), fbt = *(const LAS bf16x8_t*)(W + BT + fo), fkt = *(const LAS bf16x8_t*)(W + KT + fo), frt = *(const LAS bf16x8_t*)(W + RT + fo);
            akb = __builtin_amdgcn_mfma_f32_16x16x32_bf16(fkap, fbt, akb, 0, 0, 0); akk = __builtin_amdgcn_mfma_f32_16x16x32_bf16(fkap, fkt, akk, 0, 0, 0);
            arbT = __builtin_amdgcn_mfma_f32_16x16x32_bf16(fbt, frt, arbT, 0, 0, 0); arkT = __builtin_amdgcn_mfma_f32_16x16x32_bf16(fkt, frt, arkT, 0, 0, 0); }
#pragma unroll
        for (int r = 0; r < 4; ++r) { const int t = 4 * q4 + r; ((LAS float*)(W + AKB))[t * 16 + c16] = (c16 < t) ? akb[r] : 0.f; ((LAS float*)(W + AKK))[t * 16 + c16] = (c16 < t) ? akk[r] : 0.f;
            const int sidx = 4 * q4 + r; if (sidx > c16) { arbT[r] = 0.f; arkT[r] = 0.f; } }
        *(u32x4_t*)(rec + RW_ARF + lane * 16) = (u32x4_t){pk2(arbT[0], arbT[1]), pk2(arbT[2], arbT[3]), pk2(arkT[0], arkT[1]), pk2(arkT[2], arkT[3])};
#pragma unroll
        for (int i = 0; i < 4; ++i) { const u32x2_t b2 = *(const LAS u32x2_t*)(W + BTT + (16 * i + c16) * 32 + q4 * 8), k2 = *(const LAS u32x2_t*)(W + KTT + (16 * i + c16) * 32 + q4 * 8);
            *(u32x4_t*)(rec + RW_BKF + i * 1024 + lane * 16) = (u32x4_t){b2.x, b2.y, k2.x, k2.y}; }
#pragma unroll
        for (int sx = 0; sx < 2; ++sx) { const u32x2_t lo = *(const LAS u32x2_t*)(W + RT + c16 * RS + (32 * sx + 4 * q4) * 2), hi = *(const LAS u32x2_t*)(W + RT + c16 * RS + (32 * sx + 16 + 4 * q4) * 2);
            *(u32x4_t*)(rec + RW_RF + sx * 1024 + lane * 16) = (u32x4_t){lo.x, lo.y, hi.x, hi.y}; }
        float Wm[16], Uu[16];
#pragma unroll
        for (int t = 0; t < 16; ++t) { float wacc = bf2f(*(const LAS bf16_t*)(W + KAP + t * RS + lane * 2)), uacc = 0.f;
#pragma unroll
            for (int s4 = 0; s4 < 4; ++s4) if (4 * s4 < t) { const f32x4 b4 = *(const LAS f32x4*)(W + AKB + (t * 16 + 4 * s4) * 4), k4 = *(const LAS f32x4*)(W + AKK + (t * 16 + 4 * s4) * 4);
#pragma unroll
                for (int e = 0; e < 4; ++e) { const int sidx = 4 * s4 + e; if (sidx < t) { wacc -= b4[e] * Wm[sidx]; uacc += k4[e] * vsv[sidx] - b4[e] * Uu[sidx]; } } }
            Wm[t] = wacc; Uu[t] = uacc;
            *(LAS bf16_t*)(W + KAP + t * RS + lane * 2) = f2bf(wacc);
        }
        {
            const int ub = ((lane >> 4) * 64 + (lane & 15)) * 8;
#pragma unroll
            for (int q = 0; q < 4; ++q) { *(u32x2_t*)(rec + RW_U + ub + q * 128) = (u32x2_t){pk2(Uu[4 * q], Uu[4 * q + 1]), pk2(Uu[4 * q + 2], Uu[4 * q + 3])};
                *(u32x2_t*)(rec + RW_V + ub + q * 128) = (u32x2_t){pk2(vsv[4 * q], vsv[4 * q + 1]), pk2(vsv[4 * q + 2], vsv[4 * q + 3])}; }
        }
#pragma unroll
        for (int sx = 0; sx < 2; ++sx) { const u32x2_t lo = *(const LAS u32x2_t*)(W + KAP + c16 * RS + (32 * sx + 4 * q4) * 2), hi = *(const LAS u32x2_t*)(W + KAP + c16 * RS + (32 * sx + 16 + 4 * q4) * 2);
            *(u32x4_t*)(rec + RW_WMF + sx * 1024 + lane * 16) = (u32x4_t){lo.x, lo.y, hi.x, hi.y}; }
    }
}
__device__ __forceinline__ void sub_barrier(unsigned* ctr, unsigned target) {
    asm volatile("s_waitcnt vmcnt(0)" ::: "memory");
    __syncthreads();
    if (threadIdx.x == 0) {
        (void)xb_add(ctr, 1u);
        unsigned sp = 0;
        while (xb_ld(ctr) < target) { __builtin_amdgcn_s_sleep(2); if (++sp > (1u << 22)) break; }
        __builtin_amdgcn_fence(__ATOMIC_ACQUIRE, "agent");
        asm volatile("s_waitcnt vmcnt(0)" ::: "memory");
    }
    __syncthreads();
}
__device__ __forceinline__ void st_wt(float* p, float v) { __hip_atomic_store((unsigned*)p, __float_as_uint(v), __ATOMIC_RELAXED, __HIP_MEMORY_SCOPE_AGENT); }
__device__ __forceinline__ void ph_lru_b(const Args& a, int bid, LAS float* lds) {
    if (bid >= 64) return;
    const float* CH = (const float*)((unsigned char*)a.out + DO_LRU); const float* CA = CH + (size_t)2048 * 512; float* CIN = (float*)((unsigned char*)a.out + DO_LRU) + (size_t)4096 * 512;
    const int b = bid >> 4, cg = bid & 15, cl = threadIdx.x & 31, seg = threadIdx.x >> 5, c = cg * 32 + cl;
    float ca[32], chv[32];
#pragma unroll
    for (int i = 0; i < 32; ++i) { const size_t o = (size_t)(b * 512 + seg * 32 + i) * 512 + c; ca[i] = CA[o]; chv[i] = CH[o]; }
    float h = 0.f, sa = 0.f;
#pragma unroll
    for (int i = 0; i < 32; ++i) { h = __expf(ca[i]) * h + chv[i]; sa += ca[i]; }
    lds[seg * 32 + cl] = sa; lds[512 + seg * 32 + cl] = h;
    __syncthreads();
    float hin = 0.f;
    for (int sg = 0; sg < seg; ++sg) hin = __expf(lds[sg * 32 + cl]) * hin + lds[512 + sg * 32 + cl];
    h = hin;
#pragma unroll
    for (int i = 0; i < 32; ++i) { st_wt(CIN + (size_t)(b * 512 + seg * 32 + i) * 512 + c, h); h = __expf(ca[i]) * h + chv[i]; }
}
__device__ __forceinline__ void ph_lru_c(const Args& a, int bid, int nblk) {
    const bf16_t* LA = (const bf16_t*)(a.ws + WS_A); const bf16_t* U = LA + (size_t)NTOK * 512; const bf16_t* P = (const bf16_t*)(a.ws + WS_B);
    const float* CIN = (const float*)((unsigned char*)a.out + DO_LRU) + (size_t)4096 * 512; bf16_t* MIX = (bf16_t*)(a.ws + WS_D);
    const int c = threadIdx.x;
    for (int u = bid; u < NTOK / 16; u += nblk) { float la[16], uv[16], gt[16];
        float h = CIN[(size_t)u * 512 + c];
#pragma unroll
        for (int hf = 0; hf < 2; ++hf) { const u32x4_t l4 = *(const u32x4_t*)(LA + ((size_t)u * 512 + c) * 16 + hf * 8), u4 = *(const u32x4_t*)(U + ((size_t)u * 512 + c) * 16 + hf * 8), g4 = *(const u32x4_t*)(P + ((size_t)u * ABC + 1792 + c) * 16 + hf * 8);
#pragma unroll
            for (int e = 0; e < 4; ++e) { gt[hf * 8 + 2 * e] = __uint_as_float(g4[e] << 16); gt[hf * 8 + 2 * e + 1] = __uint_as_float(g4[e] & 0xffff0000u); la[hf * 8 + 2 * e] = __uint_as_float(l4[e] << 16); la[hf * 8 + 2 * e + 1] = __uint_as_float(l4[e] & 0xffff0000u); uv[hf * 8 + 2 * e] = __uint_as_float(u4[e] << 16); uv[hf * 8 + 2 * e + 1] = __uint_as_float(u4[e] & 0xffff0000u); } }
#pragma unroll
        for (int s = 0; s < 16; ++s) { const int n = u * 16 + s; h = __expf(la[s]) * h + uv[s];
            const float x = gt[s], t2 = 0.7978845608028654f * (x + 0.044715f * x * x * x); const float th = 1.f - 2.f * __builtin_amdgcn_rcpf(1.f + __expf(2.f * t2));
            MIX[(size_t)n * DM + 512 + c] = f2bf(h * 0.5f * x * (1.f + th)); } }
}
#ifndef SP_MODE
#define SP_MODE 0
#endif
#ifndef SP_VAR
#define SP_VAR 0
#endif
constexpr bool SCAN_COOP = true; constexpr int NSCAN = SCAN_COOP ? 64 : 32;
template <int VAR = 0, bool COOP = false>
__device__ __forceinline__ void ph_rwkv_scan(const Args& a, LAS unsigned char* L) {
    if (blockIdx.x >= (COOP ? 64 : 32)) return;
    constexpr int SLOT = 9472, GOFF = 9216, NS = 14, NCH = SEQ / 16; constexpr size_t CSTR = (size_t)8 * RW_REC;
    const unsigned char* FR = a.ws + WS_C; float* Yr = (float*)((unsigned char*)a.out + DO_YR);
    const int chain = COOP ? ((int)blockIdx.x & 31) : (int)blockIdx.x, half = COOP ? ((int)blockIdx.x >> 5) : 0;
    const int b = chain >> 3, h = chain & 7, lane = threadIdx.x & 63, wave = __builtin_amdgcn_readfirstlane(threadIdx.x >> 6), q4 = lane >> 4, c16 = lane & 15;
    const unsigned char* FRb = FR + ((size_t)(b * NCH) * 8 + h) * RW_REC;
#define RW_BARRIER() do { asm volatile("" ::: "memory"); __builtin_amdgcn_s_barrier(); asm volatile("" ::: "memory"); } while (0)
    if (COOP && wave >= 4) {
        const int lw = wave - 4, sub = lw & 1; const bool far = lw < 2;
        const int set = far ? half : (half ^ 1);
        const int p0 = set * 5 + sub * 3, n1k = (sub == 0) ? 3 : (set == 0 ? 2 : 1); const bool hasG = (set == 1) && (sub == 1);
        const unsigned char* rp = FRb + lane * 16 + p0 * 1024; int so = p0 * 1024;
#define RW_CISSUE() do { LAS unsigned char* _slot = L + so; \
            _Pragma("unroll") for (int _j = 0; _j < 3; ++_j) if (_j < n1k) __builtin_amdgcn_global_load_lds((const unsigned*)(rp + _j * 1024), (LAS unsigned*)(_slot + _j * 1024), 16, 0, 0); \
            if (hasG) __builtin_amdgcn_global_load_lds((const unsigned*)(rp - lane * 12 - p0 * 1024 + RW_G), (LAS unsigned*)(_slot - p0 * 1024 + GOFF), 4, 0, 0); \
            rp += CSTR; so += SLOT; if (so >= NS * SLOT) so -= NS * SLOT; } while (0)
        if (far) {
#define RW_CWAIT() do { if (sub == 0) asm volatile("s_waitcnt vmcnt(27)" ::: "memory"); else asm volatile("s_waitcnt vmcnt(18)" ::: "memory"); } while (0)
            for (int p = 0; p < NS - 2; ++p) RW_CISSUE();
            RW_CWAIT(); RW_BARRIER();
#pragma unroll 1
            for (int it = 0; it < NCH / 2; ++it) { RW_CISSUE(); RW_CISSUE(); RW_CWAIT(); RW_BARRIER(); }
#undef RW_CWAIT
        } else {
#define RW_CWAIT() do { if (sub == 0) asm volatile("s_waitcnt vmcnt(6)" ::: "memory"); else asm volatile("s_waitcnt vmcnt(4)" ::: "memory"); } while (0)
            for (int p = 0; p < 5; ++p) RW_CISSUE();
            RW_CWAIT(); RW_BARRIER();
#pragma unroll 1
            for (int it = 0; it < NCH / 2; ++it) { RW_CISSUE(); RW_CISSUE(); RW_CWAIT(); RW_BARRIER(); }
#undef RW_CWAIT
        }
        asm volatile("s_waitcnt vmcnt(0)" ::: "memory");
#undef RW_CISSUE
    } else if (COOP && wave >= 2) {
        RW_BARRIER();
#pragma unroll 1
        for (int it = 0; it < NCH / 2; ++it) RW_BARRIER();
    } else if (wave >= 4) {
        const int lw = wave - 4;
        const unsigned char* rp = FRb + lane * 16; int so = 0;
#define RW_ISSUE1() do { LAS unsigned char* _slot = L + so; \
            if (VAR & 1) { } else if (lw < 2) { _Pragma("unroll") for (int _j = 0; _j < 3; ++_j) __builtin_amdgcn_global_load_lds((const unsigned*)(rp + (lw * 3 + _j) * 1024), (LAS unsigned*)(_slot + (lw * 3 + _j) * 1024), 16, 0, 0); } \
            else if (lw == 2) { _Pragma("unroll") for (int _j = 0; _j < 2; ++_j) __builtin_amdgcn_global_load_lds((const unsigned*)(rp + (6 + _j) * 1024), (LAS unsigned*)(_slot + (6 + _j) * 1024), 16, 0, 0); } \
            else { __builtin_amdgcn_global_load_lds((const unsigned*)(rp + 8 * 1024), (LAS unsigned*)(_slot + 8 * 1024), 16, 0, 0); \
                   __builtin_amdgcn_global_load_lds((const unsigned*)(rp - lane * 12 + RW_G), (LAS unsigned*)(_slot + GOFF), 4, 0, 0); } \
            if (!(VAR & 8)) rp += CSTR; so += SLOT; if (so == NS * SLOT) so = 0; } while (0)
#if SP_MODE & 4
#define RW_ISSUE() do { RW_ISSUE1(); rp -= CSTR; so -= SLOT; if (so < 0) so += NS * SLOT; RW_ISSUE1(); } while (0)
#else
#define RW_ISSUE() RW_ISSUE1()
#endif
#if SP_MODE & 4
#define RW_LWAIT() do { if (lw < 2) asm volatile("s_waitcnt vmcnt(54)" ::: "memory"); else asm volatile("s_waitcnt vmcnt(36)" ::: "memory"); } while (0)
#else
#define RW_LWAIT() do { if (lw < 2) asm volatile("s_waitcnt vmcnt(27)" ::: "memory"); else asm volatile("s_waitcnt vmcnt(18)" ::: "memory"); } while (0)
#endif
        for (int p = 0; p < NS - 2; ++p) RW_ISSUE();
        RW_LWAIT();
        RW_BARRIER();
#pragma unroll 1
        for (int it = 0; it < NCH / 2; ++it) { RW_ISSUE(); RW_ISSUE(); RW_LWAIT(); RW_BARRIER(); }
        asm volatile("s_waitcnt vmcnt(0)" ::: "memory");
#undef RW_ISSUE
#undef RW_ISSUE1
#undef RW_LWAIT
    } else {
        const int vs = COOP ? 2 * half + wave : wave;
#if SP_MODE & 2
        __builtin_amdgcn_s_setprio(3);
#endif
        f32x4 T[4];
#pragma unroll
        for (int i = 0; i < 4; ++i) T[i] = (f32x4){0.f, 0.f, 0.f, 0.f};
        struct Ops { bf16x8_t wmf[2], rf[2], bkf[4], arf; f32x4 g4[4]; };
        const LAS unsigned char* lp = L + lane * 16; const LAS unsigned char* lg = L + GOFF + q4 * 16; int so = 0;
        const unsigned char* up = FRb + RW_U + (vs * 64 + lane) * 8;
        float* yp = Yr + ((size_t)(b * NCH) * 8 + h) * 1024 + vs * 256 + lane * 4;
#if SP_MODE & 8
#define RW_LOAD(O) do { { const LAS unsigned char* _r = lp + so; const LAS unsigned char* _g = lg + so; \
            _Pragma("unroll") for (int _s = 0; _s < 2; ++_s) { bf16x8_t _t0 = *(const LAS bf16x8_t*)(_r + RW_WMF + _s * 1024); bf16x8_t _t1 = *(const LAS bf16x8_t*)(_r + RW_RF + _s * 1024); asm volatile("" :: "v"(_t0), "v"(_t1)); } \
            _Pragma("unroll") for (int _i = 0; _i < 4; ++_i) { bf16x8_t _t0 = *(const LAS bf16x8_t*)(_r + RW_BKF + _i * 1024); f32x4 _t1 = *(const LAS f32x4*)(_g + _i * 64); asm volatile("" :: "v"(_t0), "v"(_t1)); } \
            { bf16x8_t _t0 = *(const LAS bf16x8_t*)(_r + RW_ARF); asm volatile("" :: "v"(_t0)); } asm volatile("" ::: "memory"); } RW_LOAD1(O); } while (0)
#else
#define RW_LOAD(O) RW_LOAD1(O)
#endif
#define RW_LOAD1(O) do { const LAS unsigned char* _r = lp + so; const LAS unsigned char* _g = lg + so; \
            _Pragma("unroll") for (int _s = 0; _s < 2; ++_s) { O.wmf[_s] = *(const LAS bf16x8_t*)(_r + RW_WMF + _s * 1024); O.rf[_s] = *(const LAS bf16x8_t*)(_r + RW_RF + _s * 1024); } \
            _Pragma("unroll") for (int _i = 0; _i < 4; ++_i) O.bkf[_i] = *(const LAS bf16x8_t*)(_r + RW_BKF + _i * 1024); \
            O.arf = *(const LAS bf16x8_t*)(_r + RW_ARF); \
            _Pragma("unroll") for (int _i = 0; _i < 4; ++_i) O.g4[_i] = *(const LAS f32x4*)(_g + _i * 64); \
            so += SLOT; if (so == NS * SLOT) so = 0; \
            __builtin_amdgcn_sched_barrier(0); } while (0)
#define RW_UV(dst) do { if (!(VAR & 2)) { dst[0] = *(const u32x2_t*)up; dst[1] = *(const u32x2_t*)(up + 2048); } else { asm volatile("" : "+v"(dst[0]), "+v"(dst[1])); } if (!(VAR & 16)) up += CSTR; } while (0)
#define RW_STEP(O, uv) do { \
            bf16x8_t _bS[2]; \
            _Pragma("unroll") for (int _s = 0; _s < 2; ++_s) { const u32x4_t _pk = (u32x4_t){pk2(T[2 * _s][0], T[2 * _s][1]), pk2(T[2 * _s][2], T[2 * _s][3]), pk2(T[2 * _s + 1][0], T[2 * _s + 1][1]), pk2(T[2 * _s + 1][2], T[2 * _s + 1][3])}; \
                _bS[_s] = __builtin_bit_cast(bf16x8_t, _pk); } \
            f32x4 _z = (f32x4){__uint_as_float(uv[0].x << 16), __uint_as_float(uv[0].x & 0xffff0000u), __uint_as_float(uv[0].y << 16), __uint_as_float(uv[0].y & 0xffff0000u)}; \
            _z = __builtin_amdgcn_mfma_f32_16x16x32_bf16(O.wmf[0], _bS[0], _z, 0, 0, 0); _z = __builtin_amdgcn_mfma_f32_16x16x32_bf16(O.wmf[1], _bS[1], _z, 0, 0, 0); \
            f32x4 _y = (f32x4){0.f, 0.f, 0.f, 0.f}; \
            _y = __builtin_amdgcn_mfma_f32_16x16x32_bf16(_bS[0], O.rf[0], _y, 0, 0, 0); _y = __builtin_amdgcn_mfma_f32_16x16x32_bf16(_bS[1], O.rf[1], _y, 0, 0, 0); \
            const u32x4_t _zvp = (u32x4_t){pk2(-_z[0], -_z[1]), pk2(-_z[2], -_z[3]), uv[1].x, uv[1].y}; \
            const bf16x8_t _bZV = __builtin_bit_cast(bf16x8_t, _zvp); \
            _Pragma("unroll") for (int _i = 0; _i < 4; ++_i) { T[_i] = __builtin_amdgcn_mfma_f32_16x16x32_bf16(O.bkf[_i], _bZV, T[_i], 0, 0, 0); T[_i] = T[_i] * O.g4[_i]; } \
            _y = __builtin_amdgcn_mfma_f32_16x16x32_bf16(_bZV, O.arf, _y, 0, 0, 0); \
            if (!(VAR & 4)) *(f32x4*)yp = _y; else asm volatile("" :: "v"(_y)); RW_ST2(); yp += 8 * 1024; } while (0)
#if SP_MODE & 16
#define RW_ST2() do { asm volatile("" ::: "memory"); *(f32x4*)yp = _y; } while (0)
#else
#define RW_ST2() do { } while (0)
#endif
#define RW_SYNC() do { asm volatile("s_waitcnt lgkmcnt(0)" ::: "memory"); RW_BARRIER(); } while (0)
        Ops A, B;
        u32x2_t uv0[2], uv1[2], uv2[2], uv3[2], uv4[2], uv5[2], uv6[2], uv7[2];
        RW_UV(uv0); RW_UV(uv1); RW_UV(uv2); RW_UV(uv3); RW_UV(uv4); RW_UV(uv5); RW_UV(uv6); RW_UV(uv7);
        RW_BARRIER();
        RW_LOAD(A);
#pragma unroll 1
        for (int ch = 0; ch < NCH; ch += 8) {
            RW_LOAD(B); RW_STEP(A, uv0); RW_UV(uv0);
            RW_LOAD(A); RW_STEP(B, uv1); RW_UV(uv1); RW_SYNC();
            RW_LOAD(B); RW_STEP(A, uv2); RW_UV(uv2);
            RW_LOAD(A); RW_STEP(B, uv3); RW_UV(uv3); RW_SYNC();
            RW_LOAD(B); RW_STEP(A, uv4); RW_UV(uv4);
            RW_LOAD(A); RW_STEP(B, uv5); RW_UV(uv5); RW_SYNC();
            RW_LOAD(B); RW_STEP(A, uv6); RW_UV(uv6);
            RW_LOAD(A); RW_STEP(B, uv7); RW_UV(uv7); RW_SYNC(); }
#undef RW_SYNC
#undef RW_LOAD
#undef RW_LOAD1
#undef RW_STEP
#undef RW_UV
    }
#undef RW_BARRIER
}
__device__ __forceinline__ void ph_rwkv_post(const Args& a, LAS float* lds) {
    const bf16_t* V = (const bf16_t*)a.out; const float* Bon = (const float*)((const unsigned char*)a.out + DO_BON); const bf16_t* SG = (const bf16_t*)((const unsigned char*)a.out + DO_SG);
    const float* Yr = (const float*)((const unsigned char*)a.out + DO_YR); bf16_t* MIX = (bf16_t*)(a.ws + WS_D);
    const float* ln_w = a.in[14]; const float* ln_b = a.in[15];
    LAS unsigned char* L = (LAS unsigned char*)lds;
    const int c = threadIdx.x, lane = c & 63, h = c >> 6, q4 = lane >> 4, c16 = lane & 15;
    const bf16_t* FG = (const bf16_t*)(a.ws + FG_G2) + h * 8192;
    LAS unsigned char* TW = L + 8192 + h * 2304;
    for (int tile = blockIdx.x; tile < NTOK / 16; tile += gridDim.x) {
        const int n0 = tile * 16;
        __syncthreads();
        { const int tk = c >> 5, j4 = (c & 31) * 4; *(LAS u32x2_t*)(L + tk * 272 + j4 * 2) = *(const u32x2_t*)(SG + (size_t)tile * 2048 + (j4 >> 4) * 256 + tk * 16 + (j4 & 15)); }
        __syncthreads();
        const int n = n0 + c16;
        f32x4 g[4], y[4];
#pragma unroll
        for (int ct = 0; ct < 4; ++ct) { g[ct] = (f32x4){0.f, 0.f, 0.f, 0.f};
#pragma unroll
            for (int ks = 0; ks < 4; ++ks) { const bf16x8_t af = *(const bf16x8_t*)(FG + ((size_t)(ct * 4 + ks) * 64 + lane) * 8); const bf16x8_t bfr = *(const LAS bf16x8_t*)(L + c16 * 272 + ks * 64 + q4 * 16);
                g[ct] = __builtin_amdgcn_mfma_f32_16x16x32_bf16(af, bfr, g[ct], 0, 0, 0); }
            y[ct] = *(const f32x4*)(Yr + (size_t)tile * 8192 + h * 1024 + ct * 256 + lane * 4); }
        float sm = 0.f;
#pragma unroll
        for (int ct = 0; ct < 4; ++ct) sm += (y[ct][0] + y[ct][1]) + (y[ct][2] + y[ct][3]);
        sm = xrow16_sum(sm);
        const float mean = sm * (1.f / 64.f);
        float sv = 0.f;
#pragma unroll
        for (int ct = 0; ct < 4; ++ct) { y[ct] = y[ct] - mean; sv += (y[ct][0] * y[ct][0] + y[ct][1] * y[ct][1]) + (y[ct][2] * y[ct][2] + y[ct][3] * y[ct][3]); }
        sv = xrow16_sum(sv);
        const float rstd = rsqrtf(sv * (1.f / 64.f) + 64e-5f), bsc = Bon[(size_t)n * 8 + h];
#pragma unroll
        for (int ct = 0; ct < 4; ++ct) { const int ch = 64 * h + 16 * ct + 4 * q4;
            const f32x4 lw = *(const f32x4*)(ln_w + ch), lb = *(const f32x4*)(ln_b + ch);
            const u32x2_t vv = *(const u32x2_t*)(V + (size_t)n * 512 + ch);
            const float v0 = __uint_as_float(vv.x << 16), v1 = __uint_as_float(vv.x & 0xffff0000u), v2 = __uint_as_float(vv.y << 16), v3 = __uint_as_float(vv.y & 0xffff0000u);
            const float o0 = (y[ct][0] * rstd * lw[0] + lb[0] + bsc * v0) * g[ct][0], o1 = (y[ct][1] * rstd * lw[1] + lb[1] + bsc * v1) * g[ct][1];
            const float o2 = (y[ct][2] * rstd * lw[2] + lb[2] + bsc * v2) * g[ct][2], o3 = (y[ct][3] * rstd * lw[3] + lb[3] + bsc * v3) * g[ct][3];
            *(LAS u32x2_t*)(TW + c16 * 136 + ct * 32 + q4 * 8) = (u32x2_t){pk2(o0, o1), pk2(o2, o3)}; }
#pragma unroll
        for (int j = 0; j < 2; ++j) { const int tk = 8 * j + (lane >> 3), pc = lane & 7;
            *(u32x4_t*)(MIX + (size_t)(n0 + tk) * DM + 64 * h + pc * 8) = *(const LAS u32x4_t*)(TW + tk * 136 + pc * 16); }
    }
}

namespace gla {
typedef short bf16x8 __attribute__((ext_vector_type(8)));
typedef float f32x16 __attribute__((ext_vector_type(16)));
typedef unsigned u32x4 __attribute__((ext_vector_type(4)));
typedef unsigned u32x2 __attribute__((ext_vector_type(2)));
constexpr int QH_OFF = 0, KH_OFF = 17408, KT_OFF = 34816, VT_OFF = 53248, ST_OFF = 71680, AM_OFF = 106496, EB_OFF = 115712, ER_OFF = 116224, PS_OFF = 116736, SSQ_OFF = 118784, OT_OFF = 119808;
constexpr int QS = 272, TS = 144;
#define GLA_BAR() do { asm volatile("s_waitcnt lgkmcnt(0)" ::: "memory"); __builtin_amdgcn_s_barrier(); asm volatile("" ::: "memory"); } while (0)
template <bool OUT>
__device__ __forceinline__ void unit(const Args& a, LAS unsigned char* L, int u) {
    const int tid = threadIdx.x, lane = tid & 63, w = tid >> 6;
    const int b = u >> 6, h = (u >> 3) & 7, j = u & 7;
    const bf16_t* Q = (const bf16_t*)(a.ws + WS_QFIG) + ((size_t)b * SEQ + (size_t)j * 1024) * 4096 + h * 128;
    float* Lb = (float*)(a.ws + WS_O); float* Db = Lb + (size_t)256 * 16384;
    const int dk = tid & 127, tg = tid >> 7;
    const float c0 = a.in[25][h * 128 + dk], c1 = a.in[25][1024 + h * 128 + dk];
    const float lbv = __builtin_amdgcn_rcpf(1.f + __expf(c0 - c1)), omlb = 1.f - lbv;
    LAS float* PS = (LAS float*)(L + PS_OFF); LAS float* EB = (LAS float*)(L + EB_OFF); LAS float* ER = (LAS float*)(L + ER_OFF); LAS float* SSQ = (LAS float*)(L + SSQ_OFF);
    const int si = w >> 1, sj0 = (w & 1) * 2, l31 = lane & 31, l5 = lane >> 5;
    const int ri = w >> 2, cj = w & 3, odv = 32 * cj + l31;
    f32x16 S[2];
#pragma unroll
    for (int jj = 0; jj < 2; ++jj)
#pragma unroll
        for (int r = 0; r < 16; ++r) S[jj][r] = 0.f;
    if (OUT) {
#pragma unroll 1
        for (int i = 0; i < j; ++i) { const int ui = u - j + i;
#pragma unroll
            for (int jj = 0; jj < 2; ++jj)
#pragma unroll
                for (int rg = 0; rg < 4; ++rg) { const int sdk0 = 32 * si + 8 * rg + 4 * l5, sdv = 32 * (sj0 + jj) + l31; const f32x4 dd = *(const f32x4*)(Db + ui * 128 + sdk0);
#pragma unroll
                    for (int e = 0; e < 4; ++e) S[jj][4 * rg + e] = dd[e] * S[jj][4 * rg + e] + Lb[(size_t)ui * 16384 + (sdk0 + e) * 128 + sdv]; } } }
    if (OUT && tid < 128) SSQ[tid] = a.in[26][h * 128 + tid];
    float dsum = 1.f;
    const int prow = tid >> 4, ppc = tid & 15;
    u32x4 pf[2], pv[2], pq[2];
#define GLA_PREFETCH(cx) do { const bf16_t* _q = Q + (size_t)((cx) * 64 + prow) * 4096 + ppc * 8; \
        _Pragma("unroll") for (int _r = 0; _r < 2; ++_r) { pf[_r] = *(const u32x4*)(_q + (size_t)_r * 32 * 4096 + 1024); pv[_r] = *(const u32x4*)(_q + (size_t)_r * 32 * 4096 + 2048); if (OUT) pq[_r] = *(const u32x4*)(_q + (size_t)_r * 32 * 4096); } } while (0)
    GLA_PREFETCH(0);
#pragma unroll 1
    for (int c = 0; c < 16; ++c) {
        int cc = c; asm volatile("" : "+s"(cc));
#pragma unroll
        for (int r = 0; r < 2; ++r) { *(LAS u32x4*)(L + KH_OFF + (prow + 32 * r) * QS + ppc * 16) = pf[r]; *(LAS u32x4*)(L + ST_OFF + (prow + 32 * r) * QS + ppc * 16) = pv[r];
            if (OUT) *(LAS u32x4*)(L + QH_OFF + (prow + 32 * r) * QS + ppc * 16) = pq[r]; }
        if (c + 1 < 16) GLA_PREFETCH(cc + 1);
        u32x4 gq[2];
        if (OUT) { const bf16_t* G = Q + (size_t)(cc * 64) * 4096 + 3072;
            unsigned go = (unsigned)((tid >> 3) * 4096 + (tid & 7) * 16); asm volatile("" : "+v"(go));
            gq[0] = *(const u32x4*)(G + go); gq[1] = *(const u32x4*)(G + go + 8u); }
        GLA_BAR();
        float lf[16], kk[16];
#pragma unroll
        for (int i = 0; i < 16; ++i) { const float fv = bf2f(*(const LAS bf16_t*)(L + KH_OFF + (tg * 16 + i) * QS + dk * 2)); const float sg = __builtin_amdgcn_rcpf(1.f + __expf(-fv));
            lf[i] = lbv + omlb * sg; kk[i] = omlb * (1.f - sg); }
#pragma unroll
        for (int i = 1; i < 16; ++i) lf[i] *= lf[i - 1];
        PS[tg * 128 + dk] = lf[15];
        GLA_BAR();
        const float p0 = PS[dk], p1 = PS[128 + dk], p2 = PS[256 + dk], p3 = PS[384 + dk];
        const float off = (tg > 0 ? p0 : 1.f) * (tg > 1 ? p1 : 1.f) * (tg > 2 ? p2 : 1.f);
        const float pref = p0 * p1, pbl = pref * (p2 * p3), ebr = p2 * p3;
        const float ioff = off * __builtin_amdgcn_rcpf(pref);
        unsigned ktp[8], vtp[8];
#pragma unroll
        for (int i = 0; i < 16; i += 2) {
            float kb[2]; unsigned vv[2];
#pragma unroll
            for (int q = 0; q < 2; ++q) { const float e1 = ioff * lf[i + q]; const float e2 = __builtin_amdgcn_rcpf(e1);
                const float khat = kk[i + q] * e2; kb[q] = khat * ebr; vv[q] = *(const LAS bf16_t*)(L + ST_OFF + (tg * 16 + i + q) * QS + dk * 2);
                if (OUT) { LAS bf16_t* qp = (LAS bf16_t*)(L + QH_OFF + (tg * 16 + i + q) * QS + dk * 2); const float qr = bf2f(*qp); const float qv = qr * __builtin_amdgcn_rcpf(1.f + __expf(-qr));
                    *qp = f2bf(qv * e1); *(LAS bf16_t*)(L + KH_OFF + (tg * 16 + i + q) * QS + dk * 2) = f2bf(khat); } }
            ktp[i >> 1] = pk2(kb[0], kb[1]); vtp[i >> 1] = vv[0] | (vv[1] << 16);
        }
        *(LAS u32x4*)(L + KT_OFF + dk * TS + tg * 32) = (u32x4){ktp[0], ktp[1], ktp[2], ktp[3]}; *(LAS u32x4*)(L + KT_OFF + dk * TS + tg * 32 + 16) = (u32x4){ktp[4], ktp[5], ktp[6], ktp[7]};
        *(LAS u32x4*)(L + VT_OFF + dk * TS + tg * 32) = (u32x4){vtp[0], vtp[1], vtp[2], vtp[3]}; *(LAS u32x4*)(L + VT_OFF + dk * TS + tg * 32 + 16) = (u32x4){vtp[4], vtp[5], vtp[6], vtp[7]};
        if (tg == 0) { EB[dk] = pbl; ER[dk] = pref; dsum *= pbl; }
        GLA_BAR();
        f32x16 o;
        if (OUT) {
#pragma unroll
            for (int jj = 0; jj < 2; ++jj)
#pragma unroll
                for (int rg = 0; rg < 4; ++rg) { const int dk0 = 32 * si + 8 * rg + 4 * l5; const f32x4 er = *(const LAS f32x4*)(ER + dk0);
                    u32x2 pk; pk.x = pk2(S[jj][4 * rg] * er[0], S[jj][4 * rg + 1] * er[1]); pk.y = pk2(S[jj][4 * rg + 2] * er[2], S[jj][4 * rg + 3] * er[3]);
                    *(LAS u32x2*)(L + ST_OFF + (32 * (sj0 + jj) + l31) * QS + dk0 * 2) = pk; }
#pragma unroll
            for (int q = 0; q < 2; ++q) { const int ti = w >> 1, tj = (w & 1) * 2 + q;
                f32x4 sc = (f32x4){0.f, 0.f, 0.f, 0.f};
                if (tj <= ti) {
#pragma unroll
                    for (int ks = 0; ks < 4; ++ks) { const bf16x8 af = *(const LAS bf16x8*)(L + QH_OFF + (16 * ti + (lane & 15)) * QS + ks * 64 + (lane >> 4) * 16);
                        const bf16x8 bfr = *(const LAS bf16x8*)(L + KH_OFF + (16 * tj + (lane & 15)) * QS + ks * 64 + (lane >> 4) * 16);
                        sc = __builtin_amdgcn_mfma_f32_16x16x32_bf16(af, bfr, sc, 0, 0, 0); } }
                const int scol = 16 * tj + (lane & 15);
#pragma unroll
                for (int r = 0; r < 4; ++r) { const int trow = 16 * ti + 4 * (lane >> 4) + r; const float v = (scol <= trow) ? sc[r] : 0.f;
                    *(LAS bf16_t*)(L + AM_OFF + trow * TS + scol * 2) = f2bf(v); } }
            GLA_BAR();
#pragma unroll
            for (int r = 0; r < 16; ++r) o[r] = 0.f;
#pragma unroll
            for (int ks = 0; ks < 4; ++ks) if (ks < 2 * (ri + 1)) {
                const bf16x8 af = *(const LAS bf16x8*)(L + AM_OFF + (32 * ri + l31) * TS + ks * 32 + l5 * 16);
                const bf16x8 bfr = *(const LAS bf16x8*)(L + VT_OFF + (32 * cj + l31) * TS + ks * 32 + l5 * 16);
                o = __builtin_amdgcn_mfma_f32_32x32x16_bf16(af, bfr, o, 0, 0, 0); }
#pragma unroll
            for (int ks = 0; ks < 8; ++ks) { if ((ks & 3) == 0) asm volatile("" ::: "memory");
                const bf16x8 af = *(const LAS bf16x8*)(L + QH_OFF + (32 * ri + l31) * QS + ks * 32 + l5 * 16);
                const bf16x8 bfr = *(const LAS bf16x8*)(L + ST_OFF + (32 * cj + l31) * QS + ks * 32 + l5 * 16);
                o = __builtin_amdgcn_mfma_f32_32x32x16_bf16(af, bfr, o, 0, 0, 0); }
#pragma unroll
            for (int r = 0; r < 16; ++r) *(LAS float*)(L + OT_OFF + (32 * ri + (r & 3) + 8 * (r >> 2) + 4 * l5) * 528 + odv * 4) = o[r];
        }
        {
            bf16x8 af[4];
#pragma unroll
            for (int ks = 0; ks < 4; ++ks) af[ks] = *(const LAS bf16x8*)(L + KT_OFF + (32 * si + l31) * TS + ks * 32 + l5 * 16);
#pragma unroll
            for (int jj = 0; jj < 2; ++jj) {
#pragma unroll
                for (int rg = 0; rg < 4; ++rg) { const f32x4 eb = *(const LAS f32x4*)(EB + 32 * si + 8 * rg + 4 * l5);
                    S[jj][4 * rg] *= eb[0]; S[jj][4 * rg + 1] *= eb[1]; S[jj][4 * rg + 2] *= eb[2]; S[jj][4 * rg + 3] *= eb[3]; }
#pragma unroll
                for (int ks = 0; ks < 4; ++ks) { const bf16x8 bfr = *(const LAS bf16x8*)(L + VT_OFF + (32 * (sj0 + jj) + l31) * TS + ks * 32 + l5 * 16);
                    S[jj] = __builtin_amdgcn_mfma_f32_32x32x16_bf16(af[ks], bfr, S[jj], 0, 0, 0); } }
        }
        GLA_BAR();
        if (OUT) {
            const int et = tid >> 3, ep = tid & 7;
            f32x4 o4[4];
#pragma unroll
            for (int e4 = 0; e4 < 4; ++e4) o4[e4] = *(const LAS f32x4*)(L + OT_OFF + et * 528 + ep * 64 + e4 * 16);
            float ss = 0.f;
#pragma unroll
            for (int e4 = 0; e4 < 4; ++e4) ss += (o4[e4][0] * o4[e4][0] + o4[e4][1] * o4[e4][1]) + (o4[e4][2] * o4[e4][2] + o4[e4][3] * o4[e4][3]);
            ss += dpp_<0xB1>(ss); ss += dpp_<0x4E>(ss); ss += dpp_<0x141>(ss);
            const float rs = rsqrtf(ss * (1.f / 128.f) + 1e-6f);
            bf16_t* MIX = (bf16_t*)(a.ws + WS_MIX1) + ((size_t)b * SEQ + (size_t)j * 1024 + cc * 64) * DM + h * 128;
            unsigned mo = (unsigned)(et * DM + ep * 16); asm volatile("" : "+v"(mo));
#pragma unroll
            for (int hf = 0; hf < 2; ++hf) { unsigned ov[4];
#pragma unroll
                for (int e2 = 0; e2 < 2; ++e2) { const f32x4 ov4 = o4[hf * 2 + e2] * (*(const LAS f32x4*)(SSQ + ep * 16 + hf * 8 + e2 * 4)) * rs;
#pragma unroll
                    for (int e = 0; e < 2; ++e) { const unsigned gw = gq[hf][e2 * 2 + e]; const float g0 = __uint_as_float(gw << 16), g1 = __uint_as_float(gw & 0xffff0000u);
                        ov[e2 * 2 + e] = pk2(ov4[2 * e] * g0 * __builtin_amdgcn_rcpf(1.f + __expf(-g0)), ov4[2 * e + 1] * g1 * __builtin_amdgcn_rcpf(1.f + __expf(-g1))); } }
                *(u32x4*)(MIX + mo + hf * 8) = (u32x4){ov[0], ov[1], ov[2], ov[3]}; }
        }
    }
    if (!OUT) {
#pragma unroll
        for (int jj = 0; jj < 2; ++jj)
#pragma unroll
            for (int r = 0; r < 16; ++r) { const int sdk = 32 * si + (r & 3) + 8 * (r >> 2) + 4 * l5, sdv = 32 * (sj0 + jj) + l31; Lb[(size_t)u * 16384 + sdk * 128 + sdv] = S[jj][r]; }
        if (tg == 0) Db[u * 128 + dk] = dsum;
    }
    GLA_BAR();
#undef GLA_PREFETCH
}
__device__ __forceinline__ void pass2(const Args& a) {
    float* Lb = (float*)(a.ws + WS_O); const float* Db = Lb + (size_t)256 * 16384;
    for (int idx = blockIdx.x * NTHREADS + threadIdx.x; idx < 32 * 16384; idx += gridDim.x * NTHREADS) { const int bh = idx >> 14, el = idx & 16383, dkk = el >> 7; float sacc = 0.f;
        for (int j = 0; j < 8; ++j) { const int u = bh * 8 + j; const size_t o = (size_t)u * 16384 + el;
            if (j < 7) { const float tmp = Lb[o]; Lb[o] = sacc; sacc = Db[u * 128 + dkk] * sacc + tmp; } else Lb[o] = sacc; } }
}
}

constexpr int NPHASE = 24;
__global__ void __launch_bounds__(NTHREADS, 2) fwd(Args a) {
    extern __shared__ __attribute__((aligned(16))) unsigned char lds_raw[];
    LAS unsigned char* ldsb = (LAS unsigned char*)lds_raw;
    LAS float* lds = (LAS float*)ldsb;
    LAS int* pst = (LAS int*)(ldsb + LDS_MISC);
    volatile LAS unsigned* xbw = (volatile LAS unsigned*)(ldsb + LDS_MISC + 256);
    if (threadIdx.x == 0) { xbw[0] = 0u; xbw[1] = 0u; }
    __syncthreads();
    unsigned* ctl = (unsigned*)(a.ws + WS_CTL);
    const bool multi = (a.ph_hi - a.ph_lo) > 1;
    XcdBarrier bar; bar.bar = ctl; bar.x = 0; bar.st = xbw;
    if (multi) bar = xcd_barrier_post(ctl, xbw);
    unsigned char* ws = a.ws;
    bf16_t* HN = (bf16_t*)(ws + WS_A);
    bf16_t* XR = (bf16_t*)(ws + WS_XR); float* RSv = (float*)(ws + WS_ROUTE + RT_LRU_CH);
    int* list_slot = (int*)(ws + WS_LIST); float* list_gate = (float*)(ws + WS_LIST + (size_t)NEXP * MOE_CAP * 4);
#ifndef PHSEL
#define PHSEL(k) true
#endif
#ifndef REPMASK
#define REPMASK 0u
#endif
#define NREP(k) (((REPMASK >> (k)) & 1u) ? 2 : 1)
#define IN(k) (PHSEL(k) && a.ph_lo <= (k) && (k) < a.ph_hi)
#define SEAM(k) do { if (IN((k) + 1) && multi) xcd_barrier(bar); } while (0)
    if (IN(0)) { ph_cvt_frags(a); ph_cvt_dense_a(a, lds, ctl + CW_COLMAX, blockIdx.x, gridDim.x, 0); ph_norm0(a.in[0], a.in[1], (unsigned char*)HN, (float*)(ws + WS_ROUTE + RT_LRU_CH + 262144)); xcd_barrier(bar); ph_cvt_dense_b(a, lds, ctl + CW_COLMAX, 0, blockIdx.x, gridDim.x); }
#if (REPMASK >> 0) & 1
    if (IN(0)) { xcd_barrier(bar);  ph_cvt_frags(a); ph_cvt_dense_a(a, lds, ctl + CW_COLMAX, blockIdx.x, gridDim.x, 0); ph_norm0(a.in[0], a.in[1], (unsigned char*)HN, (float*)(ws + WS_ROUTE + RT_LRU_CH + 262144)); xcd_barrier(bar); ph_cvt_dense_b(a, lds, ctl + CW_COLMAX, 0, blockIdx.x, gridDim.x); }
#endif
    if (IN(0)) { SEAM(0); }
    if (IN(1)) { pg8::DenseOrder S; S.init(ABC, NTOK, DM / 2, gridDim.x, blockIdx.x, HN); pg8::EpiBf16IT E{(bf16_t*)(ws + WS_B), ABC, (float*)(ws + WS_ROUTE + RT_LRU_CH + 262144), ctl + CW_COLMAX};
        pg8::gemm_phase<pg8::EpiBf16IT, pg8::DenseOrder, true>(ldsb, (const char*)(ws + WD_ABIN), DM, DM / 2, S, E); }
#if (REPMASK >> 1) & 1
    if (IN(1)) { xcd_barrier(bar);  pg8::DenseOrder S; S.init(ABC, NTOK, DM / 2, gridDim.x, blockIdx.x, HN); pg8::EpiBf16IT E{(bf16_t*)(ws + WS_B), ABC, (float*)(ws + WS_ROUTE + RT_LRU_CH + 262144), ctl + CW_COLMAX};
        pg8::gemm_phase<pg8::EpiBf16IT, pg8::DenseOrder, true>(ldsb, (const char*)(ws + WD_ABIN), DM, DM / 2, S, E);  }
#endif
    if (IN(1)) { SEAM(1); }
    if (IN(2)) { ph_l0_prep(a, lds); }
#if (REPMASK >> 2) & 1
    if (IN(2)) { xcd_barrier(bar);  ph_l0_prep(a, lds);  }
#endif
    if (IN(2)) { SEAM(2); }
    if (IN(6)) {
        if (blockIdx.x < NSCAN) {
#if SP_MODE & 64
            ph_rwkv_scan<0, SCAN_COOP>(a, ldsb); __syncthreads();
#endif
#if SP_VAR
            ph_rwkv_scan<SP_VAR, SCAN_COOP>(a, ldsb); __syncthreads(); ph_rwkv_scan<0, SCAN_COOP>(a, ldsb);
#else
            ph_rwkv_scan<0, SCAN_COOP>(a, ldsb);
#endif
        } else { const int gb = (int)blockIdx.x - NSCAN, gn = (int)gridDim.x - NSCAN; unsigned* sctr = ctl + CW_CNT + 256;
            ph_lru_b(a, gb, lds); sub_barrier(sctr, (unsigned)gn);
#if SP_MODE & 1
            ph_lru_c(a, gb, gn); }
        xcd_barrier(bar); ph_wmax(a.in[32], a.in[33], ctl + CW_WMAX, blockIdx.x, gridDim.x); ph_cvt_dense_a(a, lds, ctl + CW_COLMAX, blockIdx.x, gridDim.x, 1); xcd_barrier(bar);
        ph_cvt_moe(a, 0, lds, blockIdx.x, gridDim.x, 3); ph_cvt_moe(a, 1, lds, blockIdx.x, gridDim.x, 1); ph_cvt_dense_b(a, lds, ctl + CW_COLMAX, 1, blockIdx.x, gridDim.x);
#else
            ph_lru_c(a, gb, gn); ph_wmax(a.in[32], a.in[33], ctl + CW_WMAX, gb, gn); ph_cvt_dense_a(a, lds, ctl + CW_COLMAX, gb, gn, 1); sub_barrier(sctr, 2u * (unsigned)gn);
            ph_cvt_moe(a, 0, lds, gb, gn, 3); ph_cvt_moe(a, 1, lds, gb, gn, 1); ph_cvt_dense_b(a, lds, ctl + CW_COLMAX, 1, gb, gn);
#if SP_MODE & 32
            ph_cvt_moe(a, 1, lds, gb, gn, 1);
#endif
            }
#endif
        SEAM(6); }
    if (IN(7)) { ph_rwkv_post(a, lds); }
#if (REPMASK >> 7) & 1
    if (IN(7)) { xcd_barrier(bar);  ph_rwkv_post(a, lds);  }
#endif
    if (IN(7)) { SEAM(7); }
    if (IN(8)) { pg8::DenseOrder S; S.init(NTOK, DM, DM, gridDim.x, blockIdx.x, ws + WD_ABOUT); pg8::EpiResid<true> E{a.in[0], XR};
        pg8::gemm_phase(ldsb, (const char*)(ws + WS_D), DM * 2, DM, S, E); }
#if (REPMASK >> 8) & 1
    if (IN(8)) { xcd_barrier(bar);  pg8::DenseOrder S; S.init(NTOK, DM, DM, gridDim.x, blockIdx.x, ws + WD_ABOUT); pg8::EpiResid<true> E{a.in[0], XR};
        pg8::gemm_phase(ldsb, (const char*)(ws + WS_D), DM * 2, DM, S, E);  }
#endif
    if (IN(8)) { SEAM(8); }
    if (IN(9)) { ph_route(a, 0, XR, HN, RSv, ctl + CW_CNT, list_slot, list_gate, lds); SEAM(9); }
    if (IN(11)) { moe_prefix(ctl + CW_CNT, pst);
        pg8::MoeOrder S{(int)gridDim.x, (int)blockIdx.x, 4, pst[NEXP] / 256, pst, ctl + CW_CNT, list_slot, (const char*)(ws + WM_GU), (size_t)DM * DM, (size_t)256 * DM}; pg8::EpiSwiGLU E{(bf16_t*)(ws + WS_H), ctl + CW_WMAX};
        pg8::gemm_phase<pg8::EpiSwiGLU, pg8::MoeOrder, true>(ldsb, (const char*)HN, DM, DM / 2, S, E); moe_tail_cvt(a, lds, pst, 0, 13); }
#if (REPMASK >> 11) & 1
    if (IN(11)) { xcd_barrier(bar);  moe_prefix(ctl + CW_CNT, pst);
        pg8::MoeOrder S{(int)gridDim.x, (int)blockIdx.x, 4, pst[NEXP] / 256, pst, ctl + CW_CNT, list_slot, (const char*)(ws + WM_GU), (size_t)DM * DM, (size_t)256 * DM}; pg8::EpiSwiGLU E{(bf16_t*)(ws + WS_H), ctl + CW_WMAX};
        pg8::gemm_phase<pg8::EpiSwiGLU, pg8::MoeOrder, true>(ldsb, (const char*)HN, DM, DM / 2, S, E);  }
#endif
    if (IN(11)) { SEAM(11); }
    if (IN(12)) { moe_prefix(ctl + CW_CNT, pst);
        pg8::MoeOrder S{(int)gridDim.x, (int)blockIdx.x, 4, pst[NEXP] / 256, pst, ctl + CW_CNT, nullptr, (const char*)(ws + WM_DN), (size_t)DM * FF * 2, (size_t)256 * FF * 2}; pg8::EpiDown E{(bf16_t*)(ws + WS_Y), list_slot, list_gate};
        pg8::gemm_phase(ldsb, (const char*)(ws + WS_H), FF * 2, FF, S, E); moe_tail_cvt(a, lds, pst, 13, NEXP); }
#if (REPMASK >> 12) & 1
    if (IN(12)) { xcd_barrier(bar);  moe_prefix(ctl + CW_CNT, pst);
        pg8::MoeOrder S{(int)gridDim.x, (int)blockIdx.x, 4, pst[NEXP] / 256, pst, ctl + CW_CNT, nullptr, (const char*)(ws + WM_DN), (size_t)DM * FF * 2, (size_t)256 * FF * 2}; pg8::EpiDown E{(bf16_t*)(ws + WS_Y), list_slot, list_gate};
        pg8::gemm_phase(ldsb, (const char*)(ws + WS_H), FF * 2, FF, S, E);  }
#endif
    if (IN(12)) { SEAM(12); }
    if (IN(13)) { ph_combine_norm(XR, (const bf16_t*)(ws + WS_Y), a.in[1] + DM, (unsigned char*)HN, (float*)(ws + WS_ROUTE + RT_LRU_CH + 262144)); SEAM(13); }
    if (IN(14)) { pg8::DenseOrder S; S.init(NTOK, 4096, DM / 2, gridDim.x, blockIdx.x, ws + WD_CIN); pg8::EpiBf16I E{(bf16_t*)(ws + WS_QFIG), 4096, (float*)(ws + WS_ROUTE + RT_LRU_CH + 262144), ctl + CW_COLMAX + ABC};
        pg8::gemm_phase<pg8::EpiBf16I, pg8::DenseOrder, true>(ldsb, (const char*)HN, DM, DM / 2, S, E); }
#if (REPMASK >> 14) & 1
    if (IN(14)) { xcd_barrier(bar);  pg8::DenseOrder S; S.init(NTOK, 4096, DM / 2, gridDim.x, blockIdx.x, ws + WD_CIN); pg8::EpiBf16I E{(bf16_t*)(ws + WS_QFIG), 4096, (float*)(ws + WS_ROUTE + RT_LRU_CH + 262144), ctl + CW_COLMAX + ABC};
        pg8::gemm_phase<pg8::EpiBf16I, pg8::DenseOrder, true>(ldsb, (const char*)HN, DM, DM / 2, S, E);  }
#endif
    if (IN(14)) { SEAM(14); }
    if (IN(15)) { for (int u = blockIdx.x; u < 256; u += gridDim.x) if ((u & 7) != 7) gla::unit<false>(a, ldsb, u); }
#if (REPMASK >> 15) & 1
    if (IN(15)) { xcd_barrier(bar);  for (int u = blockIdx.x; u < 256; u += gridDim.x) if ((u & 7) != 7) gla::unit<false>(a, ldsb, u);  }
#endif
    if (IN(15)) { SEAM(15); }
    if (IN(17)) { for (int u = blockIdx.x; u < 256; u += gridDim.x) gla::unit<true>(a, ldsb, u); }
#if (REPMASK >> 17) & 1
    if (IN(17)) { xcd_barrier(bar);  for (int u = blockIdx.x; u < 256; u += gridDim.x) gla::unit<true>(a, ldsb, u);  }
#endif
    if (IN(17)) { SEAM(17); }
    if (IN(18)) { pg8::DenseOrder S; S.init(NTOK, DM, DM, gridDim.x, blockIdx.x, ws + WD_COUT); pg8::EpiResid<false> E{XR, XR};
        pg8::gemm_phase(ldsb, (const char*)(ws + WS_MIX1), DM * 2, DM, S, E); SEAM(18); }
    if (IN(19)) { ph_route(a, 1, XR, HN, RSv, ctl + CW_CNT + 64, list_slot, list_gate, lds); SEAM(19); }
    if (IN(21)) { moe_prefix(ctl + CW_CNT + 64, pst);
        pg8::MoeOrder S{(int)gridDim.x, (int)blockIdx.x, 4, pst[NEXP] / 256, pst, ctl + CW_CNT + 64, list_slot, (const char*)(ws + WM_GU1), (size_t)DM * DM, (size_t)256 * DM}; pg8::EpiSwiGLU E{(bf16_t*)(ws + WS_H), ctl + CW_WMAX + 64};
        pg8::gemm_phase<pg8::EpiSwiGLU, pg8::MoeOrder, true>(ldsb, (const char*)HN, DM, DM / 2, S, E); }
#if (REPMASK >> 21) & 1
    if (IN(21)) { xcd_barrier(bar);  moe_prefix(ctl + CW_CNT + 64, pst);
        pg8::MoeOrder S{(int)gridDim.x, (int)blockIdx.x, 4, pst[NEXP] / 256, pst, ctl + CW_CNT + 64, list_slot, (const char*)(ws + WM_GU1), (size_t)DM * DM, (size_t)256 * DM}; pg8::EpiSwiGLU E{(bf16_t*)(ws + WS_H), ctl + CW_WMAX + 64};
        pg8::gemm_phase<pg8::EpiSwiGLU, pg8::MoeOrder, true>(ldsb, (const char*)HN, DM, DM / 2, S, E);  }
#endif
    if (IN(21)) { SEAM(21); }
    if (IN(22)) { moe_prefix(ctl + CW_CNT + 64, pst);
        pg8::MoeOrder S{(int)gridDim.x, (int)blockIdx.x, 4, pst[NEXP] / 256, pst, ctl + CW_CNT + 64, nullptr, (const char*)a.out, (size_t)DM * FF * 2, (size_t)256 * FF * 2}; pg8::EpiDown E{(bf16_t*)(ws + WS_Y), list_slot, list_gate};
        pg8::gemm_phase(ldsb, (const char*)(ws + WS_H), FF * 2, FF, S, E); }
#if (REPMASK >> 22) & 1
    if (IN(22)) { xcd_barrier(bar);  moe_prefix(ctl + CW_CNT + 64, pst);
        pg8::MoeOrder S{(int)gridDim.x, (int)blockIdx.x, 4, pst[NEXP] / 256, pst, ctl + CW_CNT, nullptr, (const char*)(ws + WM_DN), (size_t)DM * FF * 2, (size_t)256 * FF * 2}; pg8::EpiDown E{(bf16_t*)(ws + WS_Y), list_slot, list_gate};
        pg8::gemm_phase(ldsb, (const char*)(ws + WS_H), FF * 2, FF, S, E);  }
#endif
    if (IN(22)) { SEAM(22); }
    if (IN(23)) { ph_final(XR, (const bf16_t*)(ws + WS_Y), a.in[3], a.out); }
#undef IN
#undef SEAM
}

extern "C" void kernel_launch(void* const* d_in, const int* in_sizes, int n_in, void* d_out, int out_size, void* d_ws, size_t ws_size, hipStream_t stream) {
    static int grid = 0;
    if (grid == 0) {
        if (n_in != 35 || out_size != NTOK * DM || ws_size < WS_END) { fprintf(stderr, "kernel_launch: unexpected shapes (n_in %d out %d ws %zu)\n", n_in, out_size, ws_size); grid = -1; return; }
        int dev = 0, cus = 0;
        if (hipGetDevice(&dev) != hipSuccess || hipDeviceGetAttribute(&cus, hipDeviceAttributeMultiprocessorCount, dev) != hipSuccess) { grid = -1; return; }
        if (hipFuncSetAttribute((const void*)fwd, hipFuncAttributeMaxDynamicSharedMemorySize, LDS_BYTES) != hipSuccess) { fprintf(stderr, "kernel_launch: hipFuncSetAttribute failed\n"); grid = -1; return; }
        int per_cu = 0;
        (void)hipOccupancyMaxActiveBlocksPerMultiprocessor(&per_cu, (const void*)fwd, NTHREADS, LDS_BYTES);
        (void)hipGetLastError();
        grid = cus;
        if (grid < 64) { fprintf(stderr, "kernel_launch: needs >= 64 CUs\n"); grid = -1; return; }
    }
    if (grid < 0) return;
    (void)hipMemsetAsync((char*)d_ws + WS_CTL, 0, CTL_ZERO_BYTES, stream);
    Args a{};
    for (int i = 0; i < 35; ++i) a.in[i] = (const float*)d_in[i];
    a.out = (float*)d_out; a.ws = (unsigned char*)d_ws;
#if 0
    for (int p = 0; p < NPHASE; ++p) { a.ph_lo = p; a.ph_hi = p + 1; hipLaunchKernelGGL(fwd, dim3(grid), dim3(NTHREADS), LDS_BYTES, stream, a); }
#else
    a.ph_lo = 0; a.ph_hi = NPHASE; hipLaunchKernelGGL(fwd, dim3(grid), dim3(NTHREADS), LDS_BYTES, stream, a);
#endif
}
```

```cpp
#include <hip/hip_runtime.h>
#include <cstdio>
#include <cstdint>

typedef unsigned short bf16_t;
#define LAS __attribute__((address_space(3)))
typedef float f32x4 __attribute__((ext_vector_type(4)));
typedef short bf16x8_t __attribute__((ext_vector_type(8)));
typedef unsigned u32x4_t __attribute__((ext_vector_type(4)));
typedef unsigned u32x2_t __attribute__((ext_vector_type(2)));

constexpr int NTOK = 32768, SEQ = 8192, NBATCH = 4, DM = 1024;
constexpr int ABC = 2816, RWC = 1792;
constexpr int NEXP = 32, FF = 512;
constexpr int NASG = NTOK * 2;
constexpr int MOE_TM = 256;
constexpr int MOE_CAP = NTOK;
constexpr int MAXROWS = NASG + NEXP * MOE_TM;
constexpr int NTHREADS = 512;
constexpr int LDS_BYTES = 156 * 1024;
constexpr int LDS_MISC = 155 * 1024;

constexpr size_t MiB = 1024ull * 1024ull;
constexpr size_t WS_CTL = 0;
constexpr size_t CTL_ZERO_BYTES = 64 * 1024;
constexpr size_t WS_ROUTE = 64 * 1024;
constexpr size_t WS_WD = 8 * MiB;
constexpr size_t WD_ABIN = WS_WD, WD_ABOUT = WD_ABIN + (size_t)ABC * DM * 2, WD_CIN = WD_ABOUT + (size_t)DM * DM * 2, WD_COUT = WD_CIN + (size_t)4096 * DM * 2;
constexpr size_t WS_AR = 26 * MiB;
constexpr size_t WS_A = WS_AR;
constexpr size_t WS_B = WS_AR + 64 * MiB;
constexpr size_t WS_C = WS_B + 176 * MiB;
constexpr size_t WS_D = WS_C + 212 * MiB;
constexpr size_t DO_LRU = 112 * MiB;
constexpr size_t WS_XR = WS_AR + 360 * MiB;
constexpr size_t WS_WM = WS_AR + 64 * MiB;
constexpr size_t WM_GU1 = WS_A + 32 * MiB;
constexpr size_t WM_GU = WS_WM, WM_DN = WS_WM + (size_t)NEXP * DM * DM;
constexpr size_t WS_H = WS_WM + 96 * MiB;
constexpr size_t WS_Y = WS_H + 72 * MiB;
constexpr size_t WS_QFIG = WS_AR + 64 * MiB;
constexpr size_t WS_O = WS_QFIG + 256 * MiB;
constexpr size_t WS_MIX1 = WS_O + 128 * MiB;
constexpr size_t WS_LIST = WS_AR + 424 * MiB;
constexpr size_t WS_END = WS_AR + 516 * MiB;
static_assert(WS_D + 64 * MiB <= WS_END && WS_Y + 128 * MiB <= WS_END && WS_MIX1 + 64 * MiB <= WS_END, "arena");

constexpr size_t DO_VB = 0, DO_BON = 32 * MiB, DO_SG = 34 * MiB, DO_YR = 48 * MiB;

constexpr int CW_CNT = 8192;
constexpr int CW_WMAX = CW_CNT + 512;
constexpr int CW_COLMAX2 = 4096;
constexpr int CW_COLMAX = CW_WMAX + 192;
constexpr float ACT_Q = 127.f / 6.f;
constexpr size_t RT_ASG_E = 0;
constexpr size_t RT_ASG_RANK = RT_ASG_E + NASG * 4;
constexpr size_t RT_ASG_GATE = RT_ASG_RANK + NASG * 4;
constexpr size_t RT_ROW_TOK = RT_ASG_GATE + NASG * 4;
constexpr size_t RT_ROW_SLOT = RT_ROW_TOK + MAXROWS * 4;
constexpr size_t RT_ROW_GATE = RT_ROW_SLOT + MAXROWS * 4;
constexpr size_t RT_LRU_CH = RT_ROW_GATE + MAXROWS * 4;
constexpr size_t RT_LRU_CA = RT_LRU_CH + 512 * 512 * 4;
constexpr size_t RT_LRU_CIN = RT_LRU_CA + 512 * 512 * 4;
constexpr size_t RT_END = RT_LRU_CIN + 512 * 512 * 4;
constexpr size_t WS_FRAG = 6 * MiB;
constexpr size_t FG_RT = WS_FRAG + 393216;
constexpr size_t FG_W2 = WS_FRAG, FG_A2 = FG_W2 + 65536, FG_WA = FG_A2 + 65536, FG_WX = FG_WA + 65536, FG_G2 = FG_WX + 65536;
static_assert(WS_ROUTE + RT_END <= 6 * MiB, "routing arrays overflow");

__device__ __forceinline__ float bf2f(bf16_t v) { return __uint_as_float(((unsigned)v) << 16); }
typedef __bf16 bf16x2_hw __attribute__((ext_vector_type(2)));
typedef float f32x2_hw __attribute__((ext_vector_type(2)));
__device__ __forceinline__ unsigned pk2(float lo, float hi) { const f32x2_hw v = {lo, hi}; const bf16x2_hw b = __builtin_convertvector(v, bf16x2_hw); return __builtin_bit_cast(unsigned, b); }
__device__ __forceinline__ bf16_t f2bf(float f) { const __bf16 b = (__bf16)f; return __builtin_bit_cast(bf16_t, b); }
template <int CTRL> __device__ __forceinline__ float dpp_(float x) { return __builtin_bit_cast(float, __builtin_amdgcn_mov_dpp(__builtin_bit_cast(int, x), CTRL, 0xf, 0xf, true)); }
__device__ __forceinline__ float row16_sum(float v) {
    v += dpp_<0xB1>(v); v += dpp_<0x4E>(v); v += dpp_<0x124>(v); v += dpp_<0x128>(v); return v; }
__device__ __forceinline__ float xrow16_sum(float x) {
    auto s = __builtin_amdgcn_permlane16_swap(__float_as_uint(x), __float_as_uint(x), false, false);
    x = __uint_as_float(s[0]) + __uint_as_float(s[1]);
    auto t = __builtin_amdgcn_permlane32_swap(__float_as_uint(x), __float_as_uint(x), false, false);
    return __uint_as_float(t[0]) + __uint_as_float(t[1]); }
__device__ __forceinline__ float xrow32_sum(float x) {
    auto s = __builtin_amdgcn_permlane16_swap(__float_as_uint(x), __float_as_uint(x), false, false);
    return __uint_as_float(s[0]) + __uint_as_float(s[1]); }
__device__ __forceinline__ float xrow16_max(float x) {
    auto s = __builtin_amdgcn_permlane16_swap(__float_as_uint(x), __float_as_uint(x), false, false);
    x = fmaxf(__uint_as_float(s[0]), __uint_as_float(s[1]));
    auto t = __builtin_amdgcn_permlane32_swap(__float_as_uint(x), __float_as_uint(x), false, false);
    return fmaxf(__uint_as_float(t[0]), __uint_as_float(t[1])); }
__device__ __forceinline__ float wave_sum(float v) { return xrow16_sum(row16_sum(v)); }
__device__ __forceinline__ float sigmoidf_(float x) { return 1.f / (1.f + __expf(-x)); }
__device__ __forceinline__ float softplusf_(float x) { return fmaxf(x, 0.f) + log1pf(__expf(-fabsf(x))); }
__device__ __forceinline__ float siluf_(float x) { return x * sigmoidf_(x); }
__device__ __forceinline__ float gelu_tanhf_(float x) { const float c = 0.7978845608028654f; return 0.5f * x * (1.f + tanhf(c * (x + 0.044715f * x * x * x))); }

struct Args {
    const float* in[35];
    float* out;
    unsigned char* ws;
    int ph_lo, ph_hi;
};

#define XB_TMO      128
#define XB_XCNT(j)  (256  + 64 * (j))
#define XB_XSUB(j)  (1280 + 64 * (j))
#define XB_XGEN(j)  (2304 + 64 * (j))
#define XB_TOP      3328
#define XB_TOPGEN   3392
#define XCD_BAR_WORDS 3456
#define XB_SPIN_CAP (1u << 18)
__device__ __forceinline__ unsigned xb_ld(unsigned* p)              { return __hip_atomic_load(p, __ATOMIC_RELAXED, __HIP_MEMORY_SCOPE_AGENT); }
__device__ __forceinline__ unsigned xb_add(unsigned* p, unsigned v) { return __hip_atomic_fetch_add(p, v, __ATOMIC_RELAXED, __HIP_MEMORY_SCOPE_AGENT); }
__device__ __forceinline__ unsigned xb_xcc_id() { return (unsigned)__builtin_amdgcn_s_getreg((3 << 11) | 20) & 0xFu; }
#define XB_SPIN(cond, bar) do { unsigned _sp = 0; while (cond) { __builtin_amdgcn_s_sleep(1); \
    if ((++_sp & 255u) == 0u) { if (xb_ld(&(bar)[XB_TMO])) break; if (_sp > XB_SPIN_CAP) { atomicAdd(&(bar)[XB_TMO], 1u); break; } } } } while (0)
struct XcdBarrier { unsigned* bar; unsigned x; volatile LAS unsigned* st; };
__device__ __forceinline__ XcdBarrier xcd_barrier_post(unsigned* bar, volatile LAS unsigned* st) {
    XcdBarrier b; b.bar = bar; b.x = xb_xcc_id(); b.st = st;
    if (threadIdx.x == 0) (void)xb_add(&bar[XB_XCNT(b.x)], 1u);
    return b;
}
__device__ __forceinline__ void xcd_barrier_complete(unsigned* bar, unsigned x, unsigned& nloc, unsigned& nx) {
    const unsigned G = gridDim.x * gridDim.y * gridDim.z;
    unsigned sum, cnt, mine, sp = 0u;
    for (;;) {
        sum = 0u; cnt = 0u; mine = 0u;
#pragma unroll
        for (unsigned j = 0; j < 16; ++j) { const unsigned c = xb_ld(&bar[XB_XCNT(j)]); sum += c; cnt += (c > 0u) ? 1u : 0u; mine = (j == x) ? c : mine; }
        if (sum == G) break;
        __builtin_amdgcn_s_sleep(1);
        if ((++sp & 255u) == 0u) { if (xb_ld(&bar[XB_TMO])) break; if (sp > XB_SPIN_CAP) { atomicAdd(&bar[XB_TMO], 1u); break; } }
    }
    nloc = mine > 0u ? mine : 1u; nx = cnt > 0u ? cnt : 1u;
}
__device__ __forceinline__ void xcd_barrier(const XcdBarrier& b) {
    asm volatile("s_waitcnt vmcnt(0)" ::: "memory");
    __syncthreads();
    if (threadIdx.x == 0) {
        unsigned* bar = b.bar;
        __builtin_amdgcn_s_waitcnt(0);
        unsigned nloc = b.st[0], nx = b.st[1];
        if (nloc == 0u) { xcd_barrier_complete(bar, b.x, nloc, nx); b.st[0] = nloc; b.st[1] = nx; }
        const unsigned old = xb_add(&bar[XB_XSUB(b.x)], 1u);
        const unsigned gen = old / nloc;
        if (old + 1u == (gen + 1u) * nloc) {
            __builtin_amdgcn_fence(__ATOMIC_RELEASE, "agent");
            asm volatile("s_waitcnt vmcnt(0)" ::: "memory");
            const unsigned og = xb_add(&bar[XB_TOP], 1u);
            const unsigned tg = og / nx;
            if (og + 1u == (tg + 1u) * nx) xb_add(&bar[XB_TOPGEN], 1u);
            else XB_SPIN(xb_ld(&bar[XB_TOPGEN]) == tg, bar);
            __builtin_amdgcn_fence(__ATOMIC_ACQUIRE, "agent");
            xb_add(&bar[XB_XGEN(b.x)], 1u);
            asm volatile("s_waitcnt vmcnt(0)" ::: "memory");
        } else {
            XB_SPIN(xb_ld(&bar[XB_XGEN(b.x)]) == gen, bar);
            __builtin_amdgcn_fence(__ATOMIC_ACQUIRE, "agent");
            asm volatile("s_waitcnt vmcnt(0)" ::: "memory");
        }
    }
    __syncthreads();
}

namespace pg8 {
typedef short bf16x8 __attribute__((ext_vector_type(8)));
typedef unsigned u32x4 __attribute__((ext_vector_type(4)));
typedef int v4i_t __attribute__((ext_vector_type(4)));
constexpr int BM = 256, BK = 64, HALF = 128, HTB = HALF * BK * 2, STAGE_BYTES = 8 * HTB, NXCD = 8, WGM = 8;
__device__ __forceinline__ int lds_byte(int r, int c) { const int st = (r >> 4) * 2 + (c >> 5), rr = r & 15, cc = c & 31, ob = rr * 64 + cc * 2; return st * 1024 + (ob ^ (((ob >> 9) & 1) << 5)); }
__device__ __forceinline__ void stage_rc(int b, int& R, int& C) { const int st = b / 1024, sb = b % 1024, swz = sb ^ (((sb >> 9) & 1) << 5); R = (st >> 1) * 16 + swz / 64; C = (st & 1) * 32 + (swz % 64) / 2; }
__device__ __forceinline__ int perm32(int rho) { const int n = rho >> 4, i = rho & 15; return 8 * (i >> 2) + 4 * n + (i & 3); }
__device__ __forceinline__ unsigned cvt_pk_bf16(float lo, float hi) { unsigned r; asm volatile("v_cvt_pk_bf16_f32 %0, %1, %2" : "=v"(r) : "v"(lo), "v"(hi)); return r; }

struct Unit { int pm, pn; const char* B; int off, nval, e; };

struct DenseOrder {
    int nM, nN, nwg, G, c; const char* Bt; size_t bstep;
    __device__ void init(int M, int N, int K, int G_, int c_, const void* Bt_) { nM = M / BM; nN = N / BM; nwg = nM * nN; G = G_; c = c_; Bt = (const char*)Bt_; bstep = (size_t)BM * K * 2; }
    __device__ bool next(int i, Unit& u) const {
        const long L = (long)i * G + c; if (L >= nwg) return false;
        int wgid = (int)L; { const int q = nwg / NXCD, r = nwg % NXCD, xcd = wgid % NXCD, off = wgid / NXCD; wgid = (xcd < r ? xcd * (q + 1) : r * (q + 1) + (xcd - r) * q) + off; }
        const int nig = WGM * nN; int gid, rem;
        if ((nN & (nN - 1)) == 0) { const int sh = 31 - __builtin_clz(nig); gid = wgid >> sh; rem = wgid & (nig - 1); } else { gid = wgid / nig; rem = wgid % nig; }
        const int fm = gid * WGM, gsz = (nM - fm) < WGM ? (nM - fm) : WGM;
        if (gsz == WGM) { u.pm = fm + (rem & (WGM - 1)); u.pn = rem >> 3; } else { u.pm = fm + (rem % gsz); u.pn = rem / gsz; }
        u.B = Bt + (size_t)u.pn * bstep; return true;
    }
    __device__ __forceinline__ int arow(const Unit& u, int r) const { return u.pm * BM + r; }
    __device__ __forceinline__ int araw(const Unit& u, int r) const { return u.pm * BM + r; }
    __device__ __forceinline__ int afix(const Unit&, int, int raw) const { return raw; }
    __device__ __forceinline__ const int* aptr(const Unit&, int) const { return nullptr; }
};
struct MoeOrder {
    int G, c, nN, ntiles; const LAS int* pst; const unsigned* cnt; const int* rowslot; const char* Bt; size_t estep, bstep;
    __device__ bool next(int i, Unit& u) const {
        const int cc = (G % NXCD == 0) ? (c % NXCD) * (G / NXCD) + c / NXCD : c;
        const int L = i * G + cc; if (L >= ntiles * nN) return false;
        if ((nN & (nN - 1)) == 0) { u.pm = L >> (31 - __builtin_clz(nN)); u.pn = L & (nN - 1); } else { u.pm = L / nN; u.pn = L % nN; }
        const int row0 = u.pm * BM; int e = 0;
#pragma unroll
        for (int st = NEXP / 2; st > 0; st >>= 1) if (row0 >= pst[e + st]) e += st;
        const int t0 = row0 - pst[e];
        u.e = e; u.off = e * MOE_CAP + t0; u.nval = pst[96 + e] - t0;
        u.B = Bt + (size_t)e * estep + (size_t)u.pn * bstep; return true;
    }
    __device__ __forceinline__ int arow(const Unit& u, int r) const { if (!rowslot) return u.pm * BM + r; return r < u.nval ? (rowslot[u.off + r] >> 1) : 0; }
    __device__ __forceinline__ int araw(const Unit& u, int r) const { return u.pm * BM + r; }
    __device__ __forceinline__ const int* aptr(const Unit& u, int r) const { return rowslot ? rowslot + u.off + r : nullptr; }
    __device__ __forceinline__ int afix(const Unit& u, int r, int raw) const { if (!rowslot) return raw; return r < u.nval ? (raw >> 1) : 0; }
};

struct EpiBf16I { static constexpr bool PERM = true; bf16_t* O; int ldc; const float* rowscale; const unsigned* colmax; int silu_lo, silu_hi;
    __device__ __forceinline__ void pre(const Unit& u, const void*& p0, const void*& p1) const { p0 = rowscale + u.pm * BM; p1 = colmax + u.pn * BM; }
    __device__ __forceinline__ void operator()(const f32x4 (&acc)[2][2][4][2], const Unit& u, int wr, int wc, int fr, int fq, const LAS unsigned char* side) const {
        const int row0 = u.pm * BM + wr * 64 + fr, col0 = u.pn * BM + wc * 32 + 8 * fq;
        const bool act = (u.pn < silu_lo) || (u.pn >= silu_hi);
        float rsc[8]; f32x4 cs[2][2];
#pragma unroll
        for (int q = 0; q < 8; ++q) rsc[q] = ((const LAS float*)side)[wr * 64 + fr + (q >> 2) * HALF + (q & 3) * 16] * (1.f / 127.f);
#pragma unroll
        for (int bj = 0; bj < 2; ++bj)
#pragma unroll
            for (int n = 0; n < 2; ++n) { const u32x4 c4 = *(const LAS u32x4*)(side + 1024 + (wc * 32 + 8 * fq + bj * HALF + 4 * n) * 4); cs[bj][n] = (f32x4){__uint_as_float(c4.x), __uint_as_float(c4.y), __uint_as_float(c4.z), __uint_as_float(c4.w)} * (1.f / 127.f); }
#pragma unroll
        for (int ai = 0; ai < 2; ++ai)
#pragma unroll
            for (int m = 0; m < 4; ++m) { bf16_t* rowp = O + (size_t)(row0 + ai * HALF + m * 16) * ldc + col0; const float rs = rsc[ai * 4 + m];
#pragma unroll
                for (int bj = 0; bj < 2; ++bj) { const v4i_t i0 = __builtin_bit_cast(v4i_t, acc[ai][bj][m][0]), i1 = __builtin_bit_cast(v4i_t, acc[ai][bj][m][1]);
                    const f32x4 s0 = cs[bj][0] * rs, s1 = cs[bj][1] * rs;
                    float v[8];
#pragma unroll
                    for (int e = 0; e < 4; ++e) { v[e] = (float)i0[e] * s0[e]; v[4 + e] = (float)i1[e] * s1[e]; }
                    if (act) {
#pragma unroll
                        for (int e = 0; e < 8; ++e) v[e] = v[e] * __builtin_amdgcn_rcpf(1.f + __expf(-v[e])); }
                    u32x4 w; w.x = cvt_pk_bf16(v[0], v[1]); w.y = cvt_pk_bf16(v[2], v[3]); w.z = cvt_pk_bf16(v[4], v[5]); w.w = cvt_pk_bf16(v[6], v[7]);
                    *(u32x4*)(rowp + bj * HALF) = w; } }
    } };
struct EpiBf16IT { static constexpr bool PERM = true; bf16_t* O; int nf; const float* tokscale; const unsigned* chmax;
    __device__ __forceinline__ void pre(const Unit& u, const void*& p0, const void*& p1) const { p0 = chmax + u.pm * BM; p1 = tokscale + u.pn * BM; }
    __device__ __forceinline__ void operator()(const f32x4 (&acc)[2][2][4][2], const Unit& u, int wr, int wc, int fr, int fq, const LAS unsigned char* side) const {
        const int row0 = u.pm * BM + wr * 64 + fr, col0 = u.pn * BM + wc * 32 + 8 * fq;
        float rsc[8]; f32x4 cs[2][2];
#pragma unroll
        for (int q = 0; q < 8; ++q) rsc[q] = ((const LAS float*)side)[wr * 64 + fr + (q >> 2) * HALF + (q & 3) * 16] * (1.f / 127.f);
#pragma unroll
        for (int bj = 0; bj < 2; ++bj)
#pragma unroll
            for (int n = 0; n < 2; ++n) cs[bj][n] = *(const LAS f32x4*)(side + 1024 + (wc * 32 + 8 * fq + bj * HALF + 4 * n) * 4) * (1.f / 127.f);
#pragma unroll
        for (int ai = 0; ai < 2; ++ai)
#pragma unroll
            for (int m = 0; m < 4; ++m) { const int nidx = row0 + ai * HALF + m * 16; const float rs = rsc[ai * 4 + m];
#pragma unroll
                for (int bj = 0; bj < 2; ++bj) { const v4i_t i0 = __builtin_bit_cast(v4i_t, acc[ai][bj][m][0]), i1 = __builtin_bit_cast(v4i_t, acc[ai][bj][m][1]);
                    const f32x4 s0 = cs[bj][0] * rs, s1 = cs[bj][1] * rs; const int tok0 = col0 + bj * HALF;
                    u32x4 w; w.x = cvt_pk_bf16((float)i0[0] * s0[0], (float)i0[1] * s0[1]); w.y = cvt_pk_bf16((float)i0[2] * s0[2], (float)i0[3] * s0[3]);
                    w.z = cvt_pk_bf16((float)i1[0] * s1[0], (float)i1[1] * s1[1]); w.w = cvt_pk_bf16((float)i1[2] * s1[2], (float)i1[3] * s1[3]);
                    *(u32x4*)(O + ((size_t)(tok0 >> 4) * nf + nidx) * 16 + (tok0 & 8)) = w; } }
    } };
struct EpiResidI { static constexpr bool PERM = true; const float* __restrict__ X; bf16_t* __restrict__ O; const float* rowscale; const unsigned* colmax;
    __device__ __forceinline__ void pre(const Unit& u, const void*& p0, const void*& p1) const { p0 = rowscale + u.pm * BM; p1 = colmax + u.pn * BM; }
    __device__ __forceinline__ void operator()(const f32x4 (&acc)[2][2][4][2], const Unit& u, int wr, int wc, int fr, int fq, const LAS unsigned char* side) const {
        const int row0 = u.pm * BM + wr * 64 + fr, col0 = u.pn * BM + wc * 32 + 8 * fq;
        f32x4 cs[2][2];
#pragma unroll
        for (int bj = 0; bj < 2; ++bj)
#pragma unroll
            for (int n = 0; n < 2; ++n) { const u32x4 c4 = *(const LAS u32x4*)(side + 1024 + (wc * 32 + 8 * fq + bj * HALF + 4 * n) * 4); cs[bj][n] = (f32x4){__uint_as_float(c4.x), __uint_as_float(c4.y), __uint_as_float(c4.z), __uint_as_float(c4.w)} * (1.f / (127.f * 127.f)); }
        f32x4 xa[2][2], xb[2][2];
#define ERI_LOAD(X_, B) do { const int _ai = (B) >> 2, _m = (B) & 3; _Pragma("unroll") for (int bj = 0; bj < 2; ++bj) { \
            const float* xp = X + (size_t)(row0 + _ai * HALF + _m * 16) * DM + col0 + bj * HALF; X_[bj][0] = *(const f32x4*)xp; X_[bj][1] = *(const f32x4*)(xp + 4); } } while (0)
#define ERI_DO(X_, B) do { const int _ai = (B) >> 2, _m = (B) & 3; const float rsm = ((const LAS float*)side)[wr * 64 + fr + _ai * HALF + _m * 16]; \
            _Pragma("unroll") for (int bj = 0; bj < 2; ++bj) { const v4i_t i0 = __builtin_bit_cast(v4i_t, acc[_ai][bj][_m][0]), i1 = __builtin_bit_cast(v4i_t, acc[_ai][bj][_m][1]); \
                const f32x4 s0 = cs[bj][0] * rsm, s1 = cs[bj][1] * rsm; \
                const f32x4 v0 = X_[bj][0] + (f32x4){(float)i0[0], (float)i0[1], (float)i0[2], (float)i0[3]} * s0, v1 = X_[bj][1] + (f32x4){(float)i1[0], (float)i1[1], (float)i1[2], (float)i1[3]} * s1; \
                u32x4 w; w.x = cvt_pk_bf16(v0[0], v0[1]); w.y = cvt_pk_bf16(v0[2], v0[3]); w.z = cvt_pk_bf16(v1[0], v1[1]); w.w = cvt_pk_bf16(v1[2], v1[3]); \
                *(u32x4*)(O + (size_t)(row0 + _ai * HALF + _m * 16) * DM + col0 + bj * HALF) = w; } } while (0)
        ERI_LOAD(xa, 0); ERI_LOAD(xb, 1);
        asm volatile("" ::: "memory"); ERI_DO(xa, 0); ERI_LOAD(xa, 2);
        asm volatile("" ::: "memory"); ERI_DO(xb, 1); ERI_LOAD(xb, 3);
        asm volatile("" ::: "memory"); ERI_DO(xa, 2); ERI_LOAD(xa, 4);
        asm volatile("" ::: "memory"); ERI_DO(xb, 3); ERI_LOAD(xb, 5);
        asm volatile("" ::: "memory"); ERI_DO(xa, 4); ERI_LOAD(xa, 6);
        asm volatile("" ::: "memory"); ERI_DO(xb, 5); ERI_LOAD(xb, 7);
        asm volatile("" ::: "memory"); ERI_DO(xa, 6);
        ERI_DO(xb, 7);
#undef ERI_LOAD
#undef ERI_DO
    } };
struct EpiBf16 { static constexpr bool PERM = true; bf16_t* O; int ldc;
    __device__ __forceinline__ void pre(const Unit&, const void*& p0, const void*& p1) const { p0 = nullptr; p1 = nullptr; }
    __device__ __forceinline__ void operator()(const f32x4 (&acc)[2][2][4][2], const Unit& u, int wr, int wc, int fr, int fq, const LAS unsigned char* side) const {
        const int row0 = u.pm * BM + wr * 64 + fr, col0 = u.pn * BM + wc * 32 + 8 * fq;
#pragma unroll
        for (int ai = 0; ai < 2; ++ai)
#pragma unroll
            for (int m = 0; m < 4; ++m) { bf16_t* rowp = O + (size_t)(row0 + ai * HALF + m * 16) * ldc + col0;
#pragma unroll
                for (int bj = 0; bj < 2; ++bj) { const f32x4 v0 = acc[ai][bj][m][0], v1 = acc[ai][bj][m][1];
                    u32x4 w; w.x = cvt_pk_bf16(v0[0], v0[1]); w.y = cvt_pk_bf16(v0[2], v0[3]); w.z = cvt_pk_bf16(v1[0], v1[1]); w.w = cvt_pk_bf16(v1[2], v1[3]);
                    *(u32x4*)(rowp + bj * HALF) = w; } }
    } };
template <bool XF32> struct EpiResid { static constexpr bool PERM = true; const void* __restrict__ X; bf16_t* __restrict__ O;
    __device__ __forceinline__ void pre(const Unit&, const void*& p0, const void*& p1) const { p0 = nullptr; p1 = nullptr; }
    __device__ __forceinline__ void operator()(const f32x4 (&acc)[2][2][4][2], const Unit& u, int wr, int wc, int fr, int fq, const LAS unsigned char* side) const {
        const int row0 = u.pm * BM + wr * 64 + fr, col0 = u.pn * BM + wc * 32 + 8 * fq;
        if constexpr (XF32) {
#pragma unroll
            for (int ai = 0; ai < 2; ++ai)
#pragma unroll
                for (int mp = 0; mp < 2; ++mp) { f32x4 x[2][2][2];
#pragma unroll
                    for (int mm = 0; mm < 2; ++mm)
#pragma unroll
                        for (int bj = 0; bj < 2; ++bj) { const float* xp = (const float*)X + (size_t)(row0 + ai * HALF + (mp * 2 + mm) * 16) * DM + col0 + bj * HALF; x[mm][bj][0] = *(const f32x4*)xp; x[mm][bj][1] = *(const f32x4*)(xp + 4); }
#pragma unroll
                    for (int mm = 0; mm < 2; ++mm)
#pragma unroll
                        for (int bj = 0; bj < 2; ++bj) { const f32x4 v0 = x[mm][bj][0] + acc[ai][bj][mp * 2 + mm][0], v1 = x[mm][bj][1] + acc[ai][bj][mp * 2 + mm][1];
                            u32x4 w; w.x = cvt_pk_bf16(v0[0], v0[1]); w.y = cvt_pk_bf16(v0[2], v0[3]); w.z = cvt_pk_bf16(v1[0], v1[1]); w.w = cvt_pk_bf16(v1[2], v1[3]);
                            *(u32x4*)(O + (size_t)(row0 + ai * HALF + (mp * 2 + mm) * 16) * DM + col0 + bj * HALF) = w; } }
        } else {
            u32x4 xa[2], xb[2], xc[2];
#define ERB_LOAD(X_, B) do { const int _ai = (B) >> 2, _m = (B) & 3; _Pragma("unroll") for (int bj = 0; bj < 2; ++bj) X_[bj] = *(const u32x4*)((const bf16_t*)X + (size_t)(row0 + _ai * HALF + _m * 16) * DM + col0 + bj * HALF); } while (0)
#define ERB_DO(X_, B) do { const int _ai = (B) >> 2, _m = (B) & 3; _Pragma("unroll") for (int bj = 0; bj < 2; ++bj) { const u32x4 o = X_[bj]; \
                const f32x4 v0 = (f32x4){__uint_as_float(o.x << 16), __uint_as_float(o.x & 0xffff0000u), __uint_as_float(o.y << 16), __uint_as_float(o.y & 0xffff0000u)} + acc[_ai][bj][_m][0]; \
                const f32x4 v1 = (f32x4){__uint_as_float(o.z << 16), __uint_as_float(o.z & 0xffff0000u), __uint_as_float(o.w << 16), __uint_as_float(o.w & 0xffff0000u)} + acc[_ai][bj][_m][1]; \
                u32x4 w; w.x = cvt_pk_bf16(v0[0], v0[1]); w.y = cvt_pk_bf16(v0[2], v0[3]); w.z = cvt_pk_bf16(v1[0], v1[1]); w.w = cvt_pk_bf16(v1[2], v1[3]); \
                *(u32x4*)(O + (size_t)(row0 + _ai * HALF + _m * 16) * DM + col0 + bj * HALF) = w; } } while (0)
            ERB_LOAD(xa, 0); ERB_LOAD(xb, 1); ERB_LOAD(xc, 2);
            asm volatile("" ::: "memory"); ERB_DO(xa, 0); ERB_LOAD(xa, 3);
            asm volatile("" ::: "memory"); ERB_DO(xb, 1); ERB_LOAD(xb, 4);
            asm volatile("" ::: "memory"); ERB_DO(xc, 2); ERB_LOAD(xc, 5);
            asm volatile("" ::: "memory"); ERB_DO(xa, 3); ERB_LOAD(xa, 6);
            asm volatile("" ::: "memory"); ERB_DO(xb, 4); ERB_LOAD(xb, 7);
            asm volatile("" ::: "memory"); ERB_DO(xc, 5);
            ERB_DO(xa, 6); ERB_DO(xb, 7);
#undef ERB_LOAD
#undef ERB_DO
        }
    } };
struct EpiSwiGLU { static constexpr bool PERM = true; bf16_t* H; const unsigned* wmax;
    __device__ __forceinline__ void pre(const Unit& u, const void*& p0, const void*& p1) const { p0 = wmax + 2 * (u.e & ~1); p1 = nullptr; }
    __device__ __forceinline__ void operator()(const f32x4 (&acc)[2][2][4][2], const Unit& u, int wr, int wc, int fr, int fq, const LAS unsigned char* side) const {
        const int row0 = u.pm * BM + wr * 64 + fr, col0 = u.pn * HALF + wc * 32 + 8 * fq;
        const float s0 = ((const LAS float*)side)[2 * (u.e & 1)] * (1.f / (127.f * ACT_Q)), s1 = ((const LAS float*)side)[2 * (u.e & 1) + 1] * (1.f / (127.f * ACT_Q));
#pragma unroll
        for (int ai = 0; ai < 2; ++ai)
#pragma unroll
            for (int m = 0; m < 4; ++m) { float h[8];
#pragma unroll
                for (int n = 0; n < 2; ++n) { const v4i_t gi = __builtin_bit_cast(v4i_t, acc[ai][0][m][n]), ui = __builtin_bit_cast(v4i_t, acc[ai][1][m][n]);
#pragma unroll
                    for (int j = 0; j < 4; ++j) { const float g = (float)gi[j] * s0; h[n * 4 + j] = g * __builtin_amdgcn_rcpf(1.f + __expf(-g)) * ((float)ui[j] * s1); } }
                u32x4 w; w.x = cvt_pk_bf16(h[0], h[1]); w.y = cvt_pk_bf16(h[2], h[3]); w.z = cvt_pk_bf16(h[4], h[5]); w.w = cvt_pk_bf16(h[6], h[7]);
                *(u32x4*)(H + (size_t)(row0 + ai * HALF + m * 16) * FF + col0) = w; }
    } };
struct EpiDown { static constexpr bool PERM = true; bf16_t* Y; const int* list_slot; const float* list_gate;
    __device__ __forceinline__ void pre(const Unit& u, const void*& p0, const void*& p1) const { p0 = list_slot + u.off; p1 = list_gate + u.off; }
    __device__ __forceinline__ void operator()(const f32x4 (&acc)[2][2][4][2], const Unit& u, int wr, int wc, int fr, int fq, const LAS unsigned char* side) const {
        const int rl0 = wr * 64 + fr, col0 = u.pn * BM + wc * 32 + 8 * fq;
        int tk[8], sl[8]; float gt[8];
#pragma unroll
        for (int q = 0; q < 8; ++q) { const int r = rl0 + (q >> 2) * HALF + (q & 3) * 16; sl[q] = ((const LAS int*)side)[r]; gt[q] = ((const LAS float*)(side + 1024))[r]; tk[q] = (r < u.nval) ? 0 : -1; }
#pragma unroll
        for (int ai = 0; ai < 2; ++ai)
#pragma unroll
            for (int m = 0; m < 4; ++m) { const int q = ai * 4 + m;
                if (tk[q] < 0) continue;
                bf16_t* rowp = Y + (size_t)sl[q] * DM + col0;
#pragma unroll
                for (int bj = 0; bj < 2; ++bj) { const f32x4 v0 = acc[ai][bj][m][0] * gt[q], v1 = acc[ai][bj][m][1] * gt[q];
                    u32x4 w; w.x = cvt_pk_bf16(v0[0], v0[1]); w.y = cvt_pk_bf16(v0[2], v0[3]); w.z = cvt_pk_bf16(v1[0], v1[1]); w.w = cvt_pk_bf16(v1[2], v1[3]);
                    *(u32x4*)(rowp + bj * HALF) = w; } }
    } };

template <class Epi, class Sched, bool I8 = false>
__device__ __forceinline__ void gemm_phase(LAS unsigned char* lds, const char* A, const unsigned lda_b, const int K, const Sched& S, const Epi& E) {
    const int tid = threadIdx.x, wid = __builtin_amdgcn_readfirstlane(tid >> 6), lane = tid & 63, wr = wid >> 2, wc = wid & 3, fr = lane & 15, fq = lane >> 4;
    const int nt = K / BK;
    unsigned voffB[2];
#pragma unroll
    for (int i = 0; i < 2; ++i) { int R, C; stage_rc(tid * 16 + i * 8192, R, C); const int Rb = Epi::PERM ? ((R & ~31) + perm32(R & 31)) : R; voffB[i] = (unsigned)(Rb * K + C) * 2u; }
    const size_t kstep = (size_t)(BK * 2);
    const size_t hstepB = (size_t)HALF * K * 2;
    const unsigned ldsw = (unsigned)wid * 1024u;
    const int aoff = lds_byte(wr * 64 + fr, fq * 8), boff = lds_byte(wc * 32 + fr, fq * 8);
#define PG8_SA(b, h) (((b) * 2 + (h)) * HTB)
#define PG8_SB(b, h) ((4 + (b) * 2 + (h)) * HTB)
#define PG8_STAGE(bufoff, gbase, voff) do { _Pragma("unroll") for (int _i = 0; _i < 2; ++_i) \
        __builtin_amdgcn_global_load_lds((const unsigned*)((const char*)(gbase) + (voff)[_i]), (LAS unsigned*)(lds + (bufoff) + ldsw + _i * 8192), 16, 0, 0); } while (0)
#define PG8_LDA(dst, b, h) do { _Pragma("unroll") for (int m = 0; m < 4; ++m) _Pragma("unroll") for (int k = 0; k < 2; ++k) dst[m][k] = *(const LAS bf16x8*)(lds + PG8_SA(b, h) + aoff + m * 2048 + k * 1024); } while (0)
#define PG8_LDB(dst, b, h) do { _Pragma("unroll") for (int n = 0; n < 2; ++n) _Pragma("unroll") for (int k = 0; k < 2; ++k) dst[n][k] = *(const LAS bf16x8*)(lds + PG8_SB(b, h) + boff + n * 2048 + k * 1024); } while (0)
#define PG8_MMA(ai, bj, At, Bt) do { __builtin_amdgcn_s_setprio(1); _Pragma("unroll") for (int m = 0; m < 4; ++m) _Pragma("unroll") for (int n = 0; n < 2; ++n) _Pragma("unroll") for (int k = 0; k < 2; ++k) { \
        if constexpr (I8) acc[ai][bj][m][n] = __builtin_bit_cast(f32x4, __builtin_amdgcn_mfma_i32_16x16x64_i8(__builtin_bit_cast(v4i_t, Bt[n][k]), __builtin_bit_cast(v4i_t, At[m][k]), __builtin_bit_cast(v4i_t, acc[ai][bj][m][n]), 0, 0, 0)); \
        else acc[ai][bj][m][n] = __builtin_amdgcn_mfma_f32_16x16x32_bf16(Bt[n][k], At[m][k], acc[ai][bj][m][n], 0, 0, 0); } __builtin_amdgcn_s_setprio(0); } while (0)
#define PG8_WAIT_V(n) asm volatile("s_waitcnt vmcnt(" #n ")" ::: "memory")
#define PG8_WAIT_L(n) asm volatile("s_waitcnt lgkmcnt(" #n ")" ::: "memory")
#define PG8_BAR __builtin_amdgcn_s_barrier()
#define PG8_SCHED __builtin_amdgcn_sched_barrier(0)
#define PG8_AOFF(dst, u) do { int _tz = threadIdx.x; asm volatile("" : "+v"(_tz)); _Pragma("unroll") for (int _i = 0; _i < 2; ++_i) { int _R, _C; stage_rc(_tz * 16 + _i * 8192, _R, _C); \
        _Pragma("unroll") for (int _h = 0; _h < 2; ++_h) dst[_h][_i] = (unsigned)S.arow(u, _h * HALF + _R) * lda_b + (unsigned)_C * 2u; } } while (0)
    Unit cur, nxt; int ui = 0;
    if (!S.next(0, cur)) return;
    f32x4 acc[2][2][4][2];
#pragma unroll
    for (int a = 0; a < 2; ++a)
#pragma unroll
        for (int b = 0; b < 2; ++b)
#pragma unroll
            for (int m = 0; m < 4; ++m)
#pragma unroll
                for (int n = 0; n < 2; ++n) acc[a][b][m][n] = (f32x4){0.f, 0.f, 0.f, 0.f};
    bf16x8 At[4][2], B0[2][2], B1[2][2];
    unsigned vA[2][2], vAn[2][2];
    PG8_AOFF(vA, cur);
    const char* cB = cur.B;
    PG8_STAGE(PG8_SB(0, 0), cB, voffB); PG8_STAGE(PG8_SA(0, 0), A, vA[0]); PG8_STAGE(PG8_SB(0, 1), cB + hstepB, voffB); PG8_STAGE(PG8_SA(0, 1), A, vA[1]);
    if (wr == 1) PG8_BAR;
    PG8_WAIT_V(4); PG8_BAR;
    PG8_STAGE(PG8_SB(1, 0), cB + kstep, voffB); PG8_STAGE(PG8_SA(1, 0), A + kstep, vA[0]); PG8_STAGE(PG8_SB(1, 1), cB + hstepB + kstep, voffB);
    PG8_WAIT_V(6); PG8_BAR;
    for (;;) {
        {
            const void* _p0; const void* _p1; E.pre(cur, _p0, _p1);
            if (wid == 0) { LAS unsigned char* _sd = lds + STAGE_BYTES + (ui & 1) * 2048;
                if (_p0) __builtin_amdgcn_global_load_lds((const unsigned*)((const char*)_p0 + lane * 16), (LAS unsigned*)_sd, 16, 0, 0);
                if (_p1) __builtin_amdgcn_global_load_lds((const unsigned*)((const char*)_p1 + lane * 16), (LAS unsigned*)(_sd + 1024), 16, 0, 0); } }
        const bool has_next = S.next(ui + 1, nxt);
        LAS int* gsp = (LAS int*)(lds + STAGE_BYTES + 4096 + wid * 1024);
        bool gath = false;
        if (has_next) { int _tz = threadIdx.x; asm volatile("" : "+v"(_tz));
#pragma unroll
            for (int _i = 0; _i < 2; ++_i) { int _R, _C; stage_rc(_tz * 16 + _i * 8192, _R, _C);
#pragma unroll
                for (int _h = 0; _h < 2; ++_h) { const int* _gp = S.aptr(nxt, _h * HALF + _R); gath = _gp != nullptr;
                    if (_gp) __builtin_amdgcn_global_load_lds((const unsigned*)_gp, (LAS unsigned*)(gsp + (_h * 2 + _i) * 64), 4, 0, 0); } } } else {
#pragma unroll
            for (int h = 0; h < 2; ++h)
#pragma unroll
                for (int i = 0; i < 2; ++i) vAn[h][i] = vA[h][i]; }
        const char* nB = has_next ? nxt.B : cB;
        for (int t = 0; t < nt; t += 2) {
            const bool last = (t == nt - 2);
            const char* a1 = A + (size_t)(t + 1) * kstep;
            const char* a2 = last ? A : A + (size_t)(t + 2) * kstep; const char* b2 = last ? nB : cB + (size_t)(t + 2) * kstep;
            const char* a3 = a2 + kstep; const char* b3 = b2 + kstep;
            PG8_LDB(B0, 0, 0); PG8_SCHED; PG8_LDA(At, 0, 0); PG8_STAGE(PG8_SA(1, 1), a1, vA[1]);
            PG8_WAIT_L(8); PG8_BAR; PG8_WAIT_L(0); PG8_MMA(0, 0, At, B0); PG8_BAR; PG8_SCHED;
            PG8_LDB(B1, 0, 1); PG8_STAGE(PG8_SB(0, 0), b2, voffB);
            PG8_BAR; PG8_WAIT_L(0); PG8_MMA(0, 1, At, B1); PG8_BAR;
            if (last && has_next) { int _tz = threadIdx.x; asm volatile("" : "+v"(_tz));
#pragma unroll
                for (int _i = 0; _i < 2; ++_i) { int _R, _C; stage_rc(_tz * 16 + _i * 8192, _R, _C);
#pragma unroll
                    for (int _h = 0; _h < 2; ++_h) { int _rw = gath ? gsp[(_h * 2 + _i) * 64 + lane] : S.araw(nxt, _h * HALF + _R); asm volatile("" : "+v"(_rw)); vAn[_h][_i] = (unsigned)S.afix(nxt, _h * HALF + _R, _rw) * lda_b + (unsigned)_C * 2u; } } }
            unsigned o2[2][2];
#pragma unroll
            for (int h = 0; h < 2; ++h)
#pragma unroll
                for (int i = 0; i < 2; ++i) o2[h][i] = last ? vAn[h][i] : vA[h][i];
            PG8_LDA(At, 0, 1); PG8_STAGE(PG8_SA(0, 0), a2, o2[0]);
            PG8_BAR; PG8_WAIT_L(0); PG8_MMA(1, 0, At, B0); PG8_BAR; PG8_SCHED;
            PG8_STAGE(PG8_SB(0, 1), b2 + hstepB, voffB);
            PG8_WAIT_V(6); PG8_BAR; PG8_MMA(1, 1, At, B1); PG8_BAR;
            PG8_LDB(B0, 1, 0); PG8_SCHED; PG8_LDA(At, 1, 0); PG8_STAGE(PG8_SA(0, 1), a2, o2[1]);
            PG8_WAIT_L(8); PG8_BAR; PG8_WAIT_L(0); PG8_MMA(0, 0, At, B0); PG8_BAR; PG8_SCHED;
            PG8_LDB(B1, 1, 1); PG8_STAGE(PG8_SB(1, 0), b3, voffB);
            PG8_BAR; PG8_WAIT_L(0); PG8_MMA(0, 1, At, B1); PG8_BAR;
            PG8_LDA(At, 1, 1); PG8_STAGE(PG8_SA(1, 0), a3, o2[0]);
            PG8_BAR; PG8_WAIT_L(0); PG8_MMA(1, 0, At, B0); PG8_BAR; PG8_SCHED;
            PG8_STAGE(PG8_SB(1, 1), b3 + hstepB, voffB);
            PG8_WAIT_V(6); PG8_BAR; PG8_MMA(1, 1, At, B1); PG8_BAR;
        }
        E(acc, cur, wr, wc, fr, fq, lds + STAGE_BYTES + (ui & 1) * 2048);
        if (!has_next) break;
#pragma unroll
        for (int a = 0; a < 2; ++a)
#pragma unroll
            for (int b = 0; b < 2; ++b)
#pragma unroll
                for (int m = 0; m < 4; ++m)
#pragma unroll
                    for (int n = 0; n < 2; ++n) acc[a][b][m][n] = (f32x4){0.f, 0.f, 0.f, 0.f};
        cur = nxt; cB = nB; ++ui;
#pragma unroll
        for (int h = 0; h < 2; ++h)
#pragma unroll
            for (int i = 0; i < 2; ++i) vA[h][i] = vAn[h][i];
    }
    PG8_WAIT_V(0);
    if (wr == 0) PG8_BAR;
    PG8_BAR;
#undef PG8_SA
#undef PG8_SB
#undef PG8_STAGE
#undef PG8_LDA
#undef PG8_LDB
#undef PG8_MMA
#undef PG8_WAIT_V
#undef PG8_WAIT_L
#undef PG8_BAR
#undef PG8_SCHED
#undef PG8_AOFF
}
}

template <int MODE>
__device__ __forceinline__ void transpose_item(const float* W, int K, int N, bf16_t* WT, LAS float* scr, int item, int lane) {
    const int nblk = N / 64, kb = item / nblk, nb = item % nblk, k0 = 64 * kb, n0 = 64 * nb;
    const int lr = lane >> 4, lc = (lane & 15) * 4;
    float4 v[16];
#pragma unroll
    for (int i = 0; i < 16; ++i) v[i] = *(const float4*)(W + (size_t)(k0 + 4 * i + lr) * N + n0 + lc);
#pragma unroll
    for (int i = 0; i < 16; ++i) { LAS float* d = scr + (4 * i + lr) * 66 + lc; *(LAS f32x2_hw*)d = (f32x2_hw){v[i].x, v[i].y}; *(LAS f32x2_hw*)(d + 2) = (f32x2_hw){v[i].z, v[i].w}; }
    asm volatile("s_waitcnt lgkmcnt(0)" ::: "memory");
    const int c = lane & 7;
#pragma unroll
    for (int j = 0; j < 8; ++j) { const int n = (lane >> 3) + 8 * j; const LAS float* sp = scr + (8 * c) * 66 + n;
        pg8::u32x4 o; o.x = pk2(sp[0 * 66], sp[1 * 66]); o.y = pk2(sp[2 * 66], sp[3 * 66]); o.z = pk2(sp[4 * 66], sp[5 * 66]); o.w = pk2(sp[6 * 66], sp[7 * 66]);
        const int nn = n0 + n; const int dr = MODE == 0 ? nn : (256 * (nn >> 7) + (nn & 127) + (MODE == 2 ? 128 : 0));
        *(pg8::u32x4*)(WT + (size_t)dr * K + k0 + 8 * c) = o; }
    asm volatile("s_waitcnt lgkmcnt(0)" ::: "memory");
}
__device__ __forceinline__ float wave_max(float v) {
    v = fmaxf(v, dpp_<0xB1>(v)); v = fmaxf(v, dpp_<0x4E>(v)); v = fmaxf(v, dpp_<0x124>(v)); v = fmaxf(v, dpp_<0x128>(v));
    auto s = __builtin_amdgcn_permlane16_swap(__float_as_uint(v), __float_as_uint(v), false, false); v = fmaxf(__uint_as_float(s[0]), __uint_as_float(s[1]));
    auto t = __builtin_amdgcn_permlane32_swap(__float_as_uint(v), __float_as_uint(v), false, false); return fmaxf(__uint_as_float(t[0]), __uint_as_float(t[1])); }
__device__ __forceinline__ unsigned q8x4(float a, float b, float c, float d, float qs) {
    const int ia = (int)rintf(fminf(fmaxf(a * qs, -127.f), 127.f)), ib = (int)rintf(fminf(fmaxf(b * qs, -127.f), 127.f)), ic = (int)rintf(fminf(fmaxf(c * qs, -127.f), 127.f)), id = (int)rintf(fminf(fmaxf(d * qs, -127.f), 127.f));
    return (unsigned)(ia & 255) | ((unsigned)(ib & 255) << 8) | ((unsigned)(ic & 255) << 16) | ((unsigned)(id & 255) << 24); }
__device__ __noinline__ void ph_wmax(const float* wg, const float* wu, unsigned* wmax, int bid, int nblk) {
    const int wave = threadIdx.x >> 6, lane = threadIdx.x & 63, gw = bid * 8 + wave, NGW = nblk * 8;
    constexpr int IT = (DM / 64) * (FF / 64);
    for (int it = gw; it < 2 * NEXP * 2 * IT; it += NGW) { const int mat = it / IT, tl = it % IT; const int le = mat >> 1, gu = mat & 1;
        const float* W = (gu ? wu : wg) + (size_t)le * DM * FF; const int k0 = 64 * (tl / (FF / 64)), n0 = 64 * (tl % (FF / 64));
        float m = 0.f;
#pragma unroll 4
        for (int i = 0; i < 16; ++i) { const float4 v = *(const float4*)(W + (size_t)(k0 + 4 * i + (lane >> 4)) * FF + n0 + (lane & 15) * 4); m = fmaxf(fmaxf(m, fmaxf(fabsf(v.x), fabsf(v.y))), fmaxf(fabsf(v.z), fabsf(v.w))); }
        m = wave_max(m);
        if (lane == 0) atomicMax(wmax + le * 2 + gu, __float_as_uint(m)); }
}
template <int MODE>
__device__ __forceinline__ void transpose_item_i8(const float* W, int K, int N, unsigned char* WT, LAS float* scr, int item, int lane, float qs) {
    const int nblk = N / 64, kb = item / nblk, nb = item % nblk, k0 = 64 * kb, n0 = 64 * nb;
    const int lr = lane >> 4, lc = (lane & 15) * 4;
    float4 v[16];
#pragma unroll
    for (int i = 0; i < 16; ++i) v[i] = *(const float4*)(W + (size_t)(k0 + 4 * i + lr) * N + n0 + lc);
#pragma unroll
    for (int i = 0; i < 16; ++i) { LAS float* d = scr + (4 * i + lr) * 66 + lc; *(LAS f32x2_hw*)d = (f32x2_hw){v[i].x, v[i].y}; *(LAS f32x2_hw*)(d + 2) = (f32x2_hw){v[i].z, v[i].w}; }
    asm volatile("s_waitcnt lgkmcnt(0)" ::: "memory");
    const int c = lane & 3;
#pragma unroll
    for (int j = 0; j < 4; ++j) { const int n = (lane >> 2) + 16 * j; const LAS float* sp = scr + (16 * c) * 66 + n;
        pg8::u32x4 o;
        o.x = q8x4(sp[0 * 66], sp[1 * 66], sp[2 * 66], sp[3 * 66], qs); o.y = q8x4(sp[4 * 66], sp[5 * 66], sp[6 * 66], sp[7 * 66], qs);
        o.z = q8x4(sp[8 * 66], sp[9 * 66], sp[10 * 66], sp[11 * 66], qs); o.w = q8x4(sp[12 * 66], sp[13 * 66], sp[14 * 66], sp[15 * 66], qs);
        const int nn = n0 + n; const int dr = MODE == 0 ? nn : (256 * (nn >> 7) + (nn & 127) + (MODE == 2 ? 128 : 0));
        *(pg8::u32x4*)(WT + (size_t)dr * K + k0 + 16 * c) = o; }
    asm volatile("s_waitcnt lgkmcnt(0)" ::: "memory");
}
__device__ __forceinline__ void transpose_item_i8c(const float* W, int K, int N, unsigned char* WT, LAS float* scr, int item, int lane, const unsigned* colmax) {
    const int nblk = N / 64, kb = item / nblk, nb = item % nblk, k0 = 64 * kb, n0 = 64 * nb;
    const int lr = lane >> 4, lc = (lane & 15) * 4;
    float4 v[16];
#pragma unroll
    for (int i = 0; i < 16; ++i) v[i] = *(const float4*)(W + (size_t)(k0 + 4 * i + lr) * N + n0 + lc);
#pragma unroll
    for (int i = 0; i < 16; ++i) { LAS float* d = scr + (4 * i + lr) * 66 + lc; *(LAS f32x2_hw*)d = (f32x2_hw){v[i].x, v[i].y}; *(LAS f32x2_hw*)(d + 2) = (f32x2_hw){v[i].z, v[i].w}; }
    asm volatile("s_waitcnt lgkmcnt(0)" ::: "memory");
    const int c = lane & 3;
#pragma unroll
    for (int j = 0; j < 4; ++j) { const int n = (lane >> 2) + 16 * j; const LAS float* sp = scr + (16 * c) * 66 + n;
        const float qs = 127.f / fmaxf(__uint_as_float(colmax[n0 + n]), 1e-30f);
        pg8::u32x4 o;
        o.x = q8x4(sp[0 * 66], sp[1 * 66], sp[2 * 66], sp[3 * 66], qs); o.y = q8x4(sp[4 * 66], sp[5 * 66], sp[6 * 66], sp[7 * 66], qs);
        o.z = q8x4(sp[8 * 66], sp[9 * 66], sp[10 * 66], sp[11 * 66], qs); o.w = q8x4(sp[12 * 66], sp[13 * 66], sp[14 * 66], sp[15 * 66], qs);
        *(pg8::u32x4*)(WT + (size_t)(n0 + n) * K + k0 + 16 * c) = o; }
    asm volatile("s_waitcnt lgkmcnt(0)" ::: "memory");
}
__device__ __forceinline__ void frag_build(const float* W, int ldw, int col0, int nks, bf16_t* dst, int lane) {
    const int q4 = lane >> 4, c16 = lane & 15;
    for (int ct = 0; ct < 4; ++ct) for (int ks = 0; ks < nks; ++ks) { float v[8];
#pragma unroll
        for (int jj = 0; jj < 8; ++jj) v[jj] = W[(size_t)(32 * ks + 8 * q4 + jj) * ldw + col0 + 16 * ct + c16];
        *(pg8::u32x4*)(dst + ((size_t)(ct * nks + ks) * 64 + lane) * 8) = (pg8::u32x4){pk2(v[0], v[1]), pk2(v[2], v[3]), pk2(v[4], v[5]), pk2(v[6], v[7])}; }
}
__device__ __forceinline__ void ph_cvt_frags(const Args& a, int bid, int part) {
    const int wave = threadIdx.x >> 6, lane = threadIdx.x & 63, gw = bid * 8 + wave + (part ? 40 : 0);
    if (!part && gw >= 40) return;
    if (gw >= 40) {
        const int it = gw - 40; if (it >= 64) return;
        const int L = it >> 5, ks = it & 31, q4 = lane >> 4, c16 = lane & 15;
        const float* gain = a.in[2] + L * DM; const float* wg = a.in[28] + (size_t)L * DM * 4; const float* we = a.in[30] + (size_t)L * DM * 32;
        bf16_t* dh = (bf16_t*)(a.ws + FG_RT) + (size_t)L * 2 * 49152; bf16_t* dl = dh + 49152;
        for (int ct = 0; ct < 3; ++ct) { const int col = 16 * ct + c16; float hi[8], lo[8];
#pragma unroll
            for (int jj = 0; jj < 8; ++jj) { const int k = 32 * ks + 8 * q4 + jj; const float w = col < 4 ? wg[k * 4 + col] : (col < 36 ? we[k * 32 + col - 4] : 0.f); const float v = gain[k] * w;
                hi[jj] = bf2f(f2bf(v)); lo[jj] = v - hi[jj]; }
            const size_t o = ((size_t)(ks * 3 + ct) * 64 + lane) * 8;
            *(pg8::u32x4*)(dh + o) = (pg8::u32x4){pk2(hi[0], hi[1]), pk2(hi[2], hi[3]), pk2(hi[4], hi[5]), pk2(hi[6], hi[7])};
            *(pg8::u32x4*)(dl + o) = (pg8::u32x4){pk2(lo[0], lo[1]), pk2(lo[2], lo[3]), pk2(lo[4], lo[5]), pk2(lo[6], lo[7])}; }
        return; }
    const int arr = gw >> 3, h = gw & 7;
    if (arr == 0) frag_build(a.in[7], 512, 64 * h, 2, (bf16_t*)(a.ws + FG_W2) + h * 4096, lane);
    else if (arr == 1) frag_build(a.in[9], 512, 64 * h, 2, (bf16_t*)(a.ws + FG_A2) + h * 4096, lane);
    else if (arr == 2) frag_build(a.in[18] + h * 4096, 64, 0, 2, (bf16_t*)(a.ws + FG_WA) + h * 4096, lane);
    else if (arr == 3) frag_build(a.in[20] + h * 4096, 64, 0, 2, (bf16_t*)(a.ws + FG_WX) + h * 4096, lane);
    else frag_build(a.in[10], 512, 64 * h, 4, (bf16_t*)(a.ws + FG_G2) + h * 8192, lane);
}
__device__ __forceinline__ void ph_cvt_dense_a(const Args& a, LAS float* lds, unsigned* colmax, int bid, int nblk, int part) {
    const int wave = threadIdx.x >> 6, lane = threadIdx.x & 63, gw = bid * 8 + wave, NGW = nblk * 8;
    LAS float* scr = lds + wave * (64 * 66);
    constexpr int I0 = (DM / 64) * (ABC / 64), I1 = (DM / 64) * (DM / 64), I2 = (DM / 64) * (4096 / 64), I3 = I1;
    for (int it = gw; it < (part ? I1 + I3 + I2 : I0); it += NGW) { int r = part ? it : it + I1 + I3; int m = 0;
        if (r < I3) { transpose_item<0>(a.in[27], DM, DM, (bf16_t*)(a.ws + WD_COUT), scr, r, lane); continue; } r -= I3;
        if (r < I1) m = 2; else { r -= I1; if (part) { m = 1; } }
        const int N = m == 1 ? 4096 : (m == 2 ? DM : ABC); const float* W = m == 1 ? a.in[24] : (m == 2 ? a.in[23] : a.in[4]);
        unsigned* cmx = m == 2 ? (colmax - CW_COLMAX + CW_COLMAX2) : (colmax + (m ? ABC : 0));
        const int k0 = 64 * (r / (N / 64)), n0 = 64 * (r % (N / 64)); float mx[4] = {0.f, 0.f, 0.f, 0.f};
#pragma unroll 4
        for (int i = 0; i < 16; ++i) { const float4 v = *(const float4*)(W + (size_t)(k0 + 4 * i + (lane >> 4)) * N + n0 + (lane & 15) * 4);
            mx[0] = fmaxf(mx[0], fabsf(v.x)); mx[1] = fmaxf(mx[1], fabsf(v.y)); mx[2] = fmaxf(mx[2], fabsf(v.z)); mx[3] = fmaxf(mx[3], fabsf(v.w)); }
#pragma unroll
        for (int q = 0; q < 4; ++q) { float t = mx[q];
            auto s1 = __builtin_amdgcn_permlane16_swap(__float_as_uint(t), __float_as_uint(t), false, false); t = fmaxf(__uint_as_float(s1[0]), __uint_as_float(s1[1]));
            auto s2 = __builtin_amdgcn_permlane32_swap(__float_as_uint(t), __float_as_uint(t), false, false); t = fmaxf(__uint_as_float(s2[0]), __uint_as_float(s2[1]));
            if (lane < 16) atomicMax(cmx + n0 + lane * 4 + q, __float_as_uint(t)); } }
}
__device__ __forceinline__ void ph_cvt_dense_b(const Args& a, LAS float* lds, const unsigned* colmax, int m, int bid, int nblk) {
    const int wave = threadIdx.x >> 6, lane = threadIdx.x & 63, gw = bid * 8 + wave, NGW = nblk * 8;
    LAS float* scr = lds + wave * (64 * 66);
    const int N = m == 1 ? 4096 : (m == 2 ? DM : ABC); const int NI = (DM / 64) * (N / 64);
    for (int it = gw; it < NI; it += NGW) transpose_item_i8c(m == 1 ? a.in[24] : (m == 2 ? a.in[23] : a.in[4]), DM, N, a.ws + (m == 1 ? WD_CIN : (m == 2 ? WD_ABOUT : WD_ABIN)), scr, it, lane, m == 2 ? (colmax - CW_COLMAX + CW_COLMAX2) : (colmax + (m ? ABC : 0)));
}
__device__ __forceinline__ void ph_cvt_down1(const Args& a, LAS float* lds, int bid, int nblk, int e_lo, int e_hi) {
    const int wave = threadIdx.x >> 6, lane = threadIdx.x & 63, gw = bid * 8 + wave, NGW = nblk * 8;
    LAS float* scr = lds + wave * (64 * 66);
    constexpr int ID = (FF / 64) * (DM / 64);
    for (int it = gw; it < (e_hi - e_lo) * ID; it += NGW) { const int e = e_lo + it / ID, r = it % ID;
        transpose_item<0>(a.in[34] + ((size_t)NEXP + e) * DM * FF, FF, DM, (bf16_t*)a.out + (size_t)e * DM * FF, scr, r, lane); }
}
__device__ __forceinline__ void moe_tail_cvt(const Args& a, LAS float* lds, const LAS int* pst, int e_lo, int e_hi) {
    const int G = (int)gridDim.x, c = (int)blockIdx.x, cc = (G % pg8::NXCD == 0) ? (c % pg8::NXCD) * (G / pg8::NXCD) + c / pg8::NXCD : c;
    const int nun = (pst[NEXP] / 256) * 4, last = nun - ((nun - 1) / G) * G, nidle = G - last;
    __syncthreads();
    if (nidle >= 64) { if (cc >= last) ph_cvt_down1(a, lds, cc - last, nidle, e_lo, e_hi); }
    else ph_cvt_down1(a, lds, c, G, e_lo, e_hi);
}
__device__ __forceinline__ void ph_cvt_moe(const Args& a, int L, LAS float* lds, int bid, int nblk, int which) {
    const int wave = threadIdx.x >> 6, lane = threadIdx.x & 63, gw = bid * 8 + wave, NGW = nblk * 8;
    LAS float* scr = lds + wave * (64 * 66);
    constexpr int IG = (DM / 64) * (FF / 64), ID = (FF / 64) * (DM / 64);
    const int i0 = (which & 1) ? 0 : 2 * IG, IE = ((which & 1) ? 2 * IG : 0) + ((which & 2) ? ID : 0);
    unsigned char* gub = a.ws + (L ? WM_GU1 : WM_GU);
    for (int it = gw; it < NEXP * IE; it += NGW) { const int e = it / IE; int r = i0 + it % IE;
        unsigned char* gu = gub + (size_t)e * DM * DM; bf16_t* dn = (bf16_t*)(a.ws + WM_DN) + (size_t)e * DM * FF;
        const unsigned* wm = (const unsigned*)(a.ws + WS_CTL) + CW_WMAX + (L * NEXP + e) * 2;
        const size_t wo = ((size_t)L * NEXP + e) * DM * FF;
        if (r < IG) { transpose_item_i8<1>(a.in[32] + wo, DM, FF, gu, scr, r, lane, 127.f / fmaxf(__uint_as_float(wm[0]), 1e-30f)); continue; } r -= IG;
        if (r < IG) { transpose_item_i8<2>(a.in[33] + wo, DM, FF, gu, scr, r, lane, 127.f / fmaxf(__uint_as_float(wm[1]), 1e-30f)); continue; } r -= IG;
        transpose_item<0>(a.in[34] + wo, FF, DM, dn, scr, r, lane); }
}

__device__ __forceinline__ void load_row16(const float* row, int lane, float4 (&v)[4]) {
#pragma unroll
    for (int j = 0; j < 4; ++j) v[j] = *(const float4*)(row + lane * 4 + 256 * j);
}
__device__ __forceinline__ float row_sumsq(const float4 (&v)[4]) {
    float s = 0.f;
#pragma unroll
    for (int j = 0; j < 4; ++j) s += v[j].x * v[j].x + v[j].y * v[j].y + v[j].z * v[j].z + v[j].w * v[j].w;
    return wave_sum(s);
}
__device__ __forceinline__ void norm_row(float4 (&v)[4], const float4 (&g4)[4]) {
    const float rs = rsqrtf(row_sumsq(v) * (1.f / DM) + 1e-6f);
#pragma unroll
    for (int j = 0; j < 4; ++j) { const float4 g = g4[j];
        v[j].x *= rs * g.x; v[j].y *= rs * g.y; v[j].z *= rs * g.z; v[j].w *= rs * g.w; }
}
__device__ __forceinline__ void store_row_bf16(bf16_t* row, int lane, const float4 (&v)[4]) {
#pragma unroll
    for (int j = 0; j < 4; ++j) { uint2 o; o.x = f2bf(v[j].x) | ((unsigned)f2bf(v[j].y) << 16); o.y = f2bf(v[j].z) | ((unsigned)f2bf(v[j].w) << 16);
        *(uint2*)(row + lane * 4 + 256 * j) = o; }
}
__device__ __forceinline__ void add_row_bf16(const bf16_t* row, int lane, float4 (&v)[4]) {
#pragma unroll
    for (int j = 0; j < 4; ++j) { const uint2 o = *(const uint2*)(row + lane * 4 + 256 * j);
        v[j].x += __uint_as_float(o.x << 16); v[j].y += __uint_as_float(o.x & 0xffff0000u); v[j].z += __uint_as_float(o.y << 16); v[j].w += __uint_as_float(o.y & 0xffff0000u); }
}

__device__ __forceinline__ void ph_norm0(const float* x, const float* gain, unsigned char* HN8, float* rowscale) {
    const int lane = threadIdx.x & 63, gw = blockIdx.x * 8 + (threadIdx.x >> 6), NGW = gridDim.x * 8;
    float4 g4[4];
#pragma unroll
    for (int j = 0; j < 4; ++j) g4[j] = *(const float4*)(gain + lane * 4 + 256 * j);
    float4 nv[4]; if (gw < NTOK) load_row16(x + (size_t)gw * DM, lane, nv);
    for (int n = gw; n < NTOK; n += NGW) { float4 v[4];
#pragma unroll
        for (int j = 0; j < 4; ++j) v[j] = nv[j];
        if (n + NGW < NTOK) load_row16(x + (size_t)(n + NGW) * DM, lane, nv);
        asm volatile("" ::: "memory");
        norm_row(v, g4);
        float mx = 0.f;
#pragma unroll
        for (int j = 0; j < 4; ++j) mx = fmaxf(fmaxf(mx, fmaxf(fabsf(v[j].x), fabsf(v[j].y))), fmaxf(fabsf(v[j].z), fabsf(v[j].w)));
        mx = fmaxf(wave_max(mx), 1e-30f); const float qs = 127.f / mx;
        if (lane == 0) rowscale[n] = mx;
#pragma unroll
        for (int j = 0; j < 4; ++j) *(unsigned*)(HN8 + (size_t)n * DM + lane * 4 + 256 * j) = q8x4(v[j].x, v[j].y, v[j].z, v[j].w, qs); }
}
__device__ __forceinline__ void ld8bf(const bf16_t* p, float (&v)[8]) { const u32x4_t o = *(const u32x4_t*)p;
    v[0] = __uint_as_float(o.x << 16); v[1] = __uint_as_float(o.x & 0xffff0000u); v[2] = __uint_as_float(o.y << 16); v[3] = __uint_as_float(o.y & 0xffff0000u);
    v[4] = __uint_as_float(o.z << 16); v[5] = __uint_as_float(o.z & 0xffff0000u); v[6] = __uint_as_float(o.w << 16); v[7] = __uint_as_float(o.w & 0xffff0000u); }
__device__ __forceinline__ void up8bf(const u32x4_t o, float (&v)[8]) {
    v[0] = __uint_as_float(o.x << 16); v[1] = __uint_as_float(o.x & 0xffff0000u); v[2] = __uint_as_float(o.y << 16); v[3] = __uint_as_float(o.y & 0xffff0000u);
    v[4] = __uint_as_float(o.z << 16); v[5] = __uint_as_float(o.z & 0xffff0000u); v[6] = __uint_as_float(o.w << 16); v[7] = __uint_as_float(o.w & 0xffff0000u); }
struct RowRaw { u32x4_t x[2], y0[2], y1[2]; };
__device__ __forceinline__ void row_fetch(RowRaw& r, const bf16_t* XR, const bf16_t* Y, int n, int lane) {
#pragma unroll
    for (int j = 0; j < 2; ++j) { const int o = lane * 8 + 512 * j; r.x[j] = *(const u32x4_t*)(XR + (size_t)n * DM + o); r.y0[j] = *(const u32x4_t*)(Y + (size_t)(2 * n) * DM + o); r.y1[j] = *(const u32x4_t*)(Y + (size_t)(2 * n + 1) * DM + o); }
}
__device__ __forceinline__ void st8bf(bf16_t* p, const float (&v)[8]) { *(u32x4_t*)p = (u32x4_t){pk2(v[0], v[1]), pk2(v[2], v[3]), pk2(v[4], v[5]), pk2(v[6], v[7])}; }
__device__ __forceinline__ void ph_combine_norm(bf16_t* XR, const bf16_t* Y, const float* gain, unsigned char* HN8, float* rowscale) {
    const int lane = threadIdx.x & 63, gw = blockIdx.x * 8 + (threadIdx.x >> 6), NGW = gridDim.x * 8;
    float4 gh[2][2];
#pragma unroll
    for (int j = 0; j < 2; ++j) { gh[j][0] = *(const float4*)(gain + lane * 8 + 512 * j); gh[j][1] = *(const float4*)(gain + lane * 8 + 512 * j + 4); }
    RowRaw nx; if (gw < NTOK) row_fetch(nx, XR, Y, gw, lane);
    for (int n = gw; n < NTOK; n += NGW) { float x[2][8], y0[2][8], y1[2][8]; float ss = 0.f;
        const RowRaw cr = nx; if (n + NGW < NTOK) row_fetch(nx, XR, Y, n + NGW, lane);
        asm volatile("" ::: "memory");
#pragma unroll
        for (int j = 0; j < 2; ++j) { up8bf(cr.x[j], x[j]); up8bf(cr.y0[j], y0[j]); up8bf(cr.y1[j], y1[j]); }
#pragma unroll
        for (int j = 0; j < 2; ++j) {
#pragma unroll
            for (int i = 0; i < 8; ++i) x[j][i] = bf2f(f2bf(x[j][i] + y0[j][i] + y1[j][i]));
            st8bf(XR + (size_t)n * DM + lane * 8 + 512 * j, x[j]);
#pragma unroll
            for (int i = 0; i < 8; ++i) ss += x[j][i] * x[j][i]; }
        const float rs = rsqrtf(wave_sum(ss) * (1.f / DM) + 1e-6f);
#pragma unroll
        for (int j = 0; j < 2; ++j) { const int o = lane * 8 + 512 * j; const float4 g0 = gh[j][0], g1 = gh[j][1];
            const float gg[8] = {g0.x, g0.y, g0.z, g0.w, g1.x, g1.y, g1.z, g1.w};
#pragma unroll
            for (int i = 0; i < 8; ++i) x[j][i] *= rs * gg[i]; }
        float mx = 0.f;
#pragma unroll
        for (int j = 0; j < 2; ++j)
#pragma unroll
            for (int i = 0; i < 8; ++i) mx = fmaxf(mx, fabsf(x[j][i]));
        mx = fmaxf(wave_max(mx), 1e-30f); const float qs = 127.f / mx;
        if (lane == 0) rowscale[n] = mx;
#pragma unroll
        for (int j = 0; j < 2; ++j) { const int o = lane * 8 + 512 * j;
            *(u32x2_t*)(HN8 + (size_t)n * DM + o) = (u32x2_t){q8x4(x[j][0], x[j][1], x[j][2], x[j][3], qs), q8x4(x[j][4], x[j][5], x[j][6], x[j][7], qs)}; } }
}
__device__ __forceinline__ void ph_final(const bf16_t* XR, const bf16_t* Y, const float* gain, float* out) {
    const int lane = threadIdx.x & 63, gw = blockIdx.x * 8 + (threadIdx.x >> 6), NGW = gridDim.x * 8;
    float4 gh[2][2];
#pragma unroll
    for (int j = 0; j < 2; ++j) { gh[j][0] = *(const float4*)(gain + lane * 8 + 512 * j); gh[j][1] = *(const float4*)(gain + lane * 8 + 512 * j + 4); }
    RowRaw nx; if (gw < NTOK) row_fetch(nx, XR, Y, gw, lane);
    for (int n = gw; n < NTOK; n += NGW) { float x[2][8], y0[2][8], y1[2][8]; float ss = 0.f;
        const RowRaw cr = nx; if (n + NGW < NTOK) row_fetch(nx, XR, Y, n + NGW, lane);
        asm volatile("" ::: "memory");
#pragma unroll
        for (int j = 0; j < 2; ++j) { up8bf(cr.x[j], x[j]); up8bf(cr.y0[j], y0[j]); up8bf(cr.y1[j], y1[j]); }
#pragma unroll
        for (int j = 0; j < 2; ++j)
#pragma unroll
            for (int i = 0; i < 8; ++i) { x[j][i] = x[j][i] + y0[j][i] + y1[j][i]; ss += x[j][i] * x[j][i]; }
        const float rs = rsqrtf(wave_sum(ss) * (1.f / DM) + 1e-6f);
#pragma unroll
        for (int j = 0; j < 2; ++j) { const int o = lane * 8 + 512 * j; const float4 g0 = gh[j][0], g1 = gh[j][1];
            *(float4*)(out + (size_t)n * DM + o) = make_float4(x[j][0] * rs * g0.x, x[j][1] * rs * g0.y, x[j][2] * rs * g0.z, x[j][3] * rs * g0.w);
            *(float4*)(out + (size_t)n * DM + o + 4) = make_float4(x[j][4] * rs * g1.x, x[j][5] * rs * g1.y, x[j][6] * rs * g1.z, x[j][7] * rs * g1.w); } }
}
__device__ __forceinline__ void ph_route(const Args& a, int Lyr, const bf16_t* XR, bf16_t* HN, float* RS, unsigned* cnt, int* list_slot, float* list_gate, LAS float* lds) {
    const float* gain = a.in[2] + Lyr * DM; const float* bg = a.in[29] + Lyr * 4; const float* be = a.in[31] + Lyr * 32;
    const bf16_t* FRh = (const bf16_t*)(a.ws + FG_RT) + (size_t)Lyr * 2 * 49152; const bf16_t* FRl = FRh + 49152;
    const int lane = threadIdx.x & 63, wave = threadIdx.x >> 6, q4 = lane >> 4, c16 = lane & 15, r4 = lane >> 4, cidx = lane & 15;
    LAS unsigned char* Lb = (LAS unsigned char*)lds;
    LAS unsigned char* W = Lb + wave * 12288;
    LAS float* SS = (LAS float*)(W + 8704); LAS float* LG = (LAS float*)(W + 8768);
    LAS unsigned* lcnt = (LAS unsigned*)(Lb + 8 * 12288); LAS unsigned* lbase = lcnt + 32;
    const int NGW = gridDim.x * 8, gw = blockIdx.x * 8 + wave;
    for (int rnd = 0; rnd * NGW < NTOK / 16; ++rnd) {
        const int tile = rnd * NGW + gw; const bool act = tile < NTOK / 16; const int n0 = tile * 16;
        if (threadIdx.x < 32) lcnt[threadIdx.x] = 0u;
        __syncthreads();
        int e0 = 0, e1 = 0, lr0 = 0, lr1 = 0; float g0 = 0.f, g1 = 0.f;
        f32x4 acc[3], accs = (f32x4){0.f, 0.f, 0.f, 0.f};
#pragma unroll
        for (int ct = 0; ct < 3; ++ct) acc[ct] = accs;
        float biasv[3];
#pragma unroll
        for (int ct = 0; ct < 3; ++ct) { const int col = 16 * ct + c16; biasv[ct] = col < 4 ? bg[col] : (col < 36 ? be[col - 4] : 0.f); }
        {
            const int n0c = act ? n0 : 0;
            LAS unsigned char* FB = Lb + 100352;
            const int wu = __builtin_amdgcn_readfirstlane(wave);
#define RT_DMA(kcx) do { _Pragma("unroll") for (int _j = 0; _j < 3; ++_j) { const int _p = 3 * wu + _j; const bf16_t* _src = (_p < 12 ? FRh : FRl) + ((size_t)(kcx) * 12 + (_p < 12 ? _p : _p - 12)) * 512 + lane * 8; \
                __builtin_amdgcn_global_load_lds((const unsigned*)_src, (LAS unsigned*)(FB + ((kcx) & 1) * 24576 + _p * 1024), 16, 0, 0); } } while (0)
            RT_DMA(0);
            u32x4_t xn[4];
#pragma unroll
            for (int j = 0; j < 4; ++j) xn[j] = *(const u32x4_t*)(XR + (size_t)(n0c + 4 * j + r4) * DM + 8 * cidx);
#pragma unroll 1
            for (int kc = 0; kc < 8; ++kc) {
                asm volatile("s_waitcnt vmcnt(0)" ::: "memory");
                __syncthreads();
                if (kc < 7) RT_DMA(kc + 1);
                u32x4_t xv[4];
#pragma unroll
                for (int j = 0; j < 4; ++j) xv[j] = xn[j];
                if (kc < 7) {
#pragma unroll
                    for (int j = 0; j < 4; ++j) xn[j] = *(const u32x4_t*)(XR + (size_t)(n0c + 4 * j + r4) * DM + (kc + 1) * 128 + 8 * cidx); }
#pragma unroll
                for (int j = 0; j < 4; ++j) *(LAS u32x4_t*)(W + (4 * j + r4) * 272 + cidx * 16) = xv[j];
                const LAS unsigned char* fb = FB + (kc & 1) * 24576 + lane * 16;
#pragma unroll
                for (int ks = 0; ks < 4; ++ks) { const bf16x8_t ahi = *(const LAS bf16x8_t*)(W + c16 * 272 + ks * 64 + q4 * 16);
                    accs = __builtin_amdgcn_mfma_f32_16x16x32_bf16(ahi, ahi, accs, 0, 0, 0);
#pragma unroll
                    for (int ct = 0; ct < 3; ++ct) { const bf16x8_t bh = *(const LAS bf16x8_t*)(fb + (ks * 3 + ct) * 1024), bl = *(const LAS bf16x8_t*)(fb + 12288 + (ks * 3 + ct) * 1024);
                        acc[ct] = __builtin_amdgcn_mfma_f32_16x16x32_bf16(ahi, bh, acc[ct], 0, 0, 0); acc[ct] = __builtin_amdgcn_mfma_f32_16x16x32_bf16(ahi, bl, acc[ct], 0, 0, 0); } }
            }
#undef RT_DMA
        }
        if (act) {
#pragma unroll
            for (int r = 0; r < 4; ++r) if (c16 == 4 * q4 + r) { const float rsv = rsqrtf(accs[r] * (1.f / DM) + 1e-6f); SS[c16] = rsv; RS[n0 + c16] = rsv; }
            const f32x4 s4 = *(const LAS f32x4*)(SS + 4 * q4);
#pragma unroll
            for (int ct = 0; ct < 3; ++ct) { const int col = 16 * ct + c16; const float bias = biasv[ct];
#pragma unroll
                for (int r = 0; r < 4; ++r) LG[(4 * q4 + r) * 48 + col] = acc[ct][r] * s4[r] + bias; }
            if (lane < 16) {
                const LAS float* lg = LG + lane * 48;
                int gs = 0; float gm = lg[0];
#pragma unroll
                for (int i = 1; i < 4; ++i) { const float v = lg[i]; if (v > gm) { gm = v; gs = i; } }
                float gden = 0.f;
#pragma unroll
                for (int i = 0; i < 4; ++i) gden += __expf(lg[i] - gm);
                const float ggate = 1.f / gden;
                const LAS float* l8 = lg + 4 + gs * 8;
                int i0 = 0; float m0 = l8[0];
#pragma unroll
                for (int i = 1; i < 8; ++i) { const float v = l8[i]; if (v > m0) { m0 = v; i0 = i; } }
                int i1 = (i0 == 0) ? 1 : 0; float m1 = l8[i1];
#pragma unroll
                for (int i = 0; i < 8; ++i) { const float v = l8[i]; if (i != i0 && v > m1) { m1 = v; i1 = i; } }
                const float ex = __expf(m1 - m0);
                g0 = ggate / (1.f + ex); g1 = ggate * ex / (1.f + ex);
                e0 = gs * 8 + i0; e1 = gs * 8 + i1;
                lr0 = (int)__hip_atomic_fetch_add(lcnt + e0, 1u, __ATOMIC_RELAXED, __HIP_MEMORY_SCOPE_WORKGROUP); lr1 = (int)__hip_atomic_fetch_add(lcnt + e1, 1u, __ATOMIC_RELAXED, __HIP_MEMORY_SCOPE_WORKGROUP);
            }
        }
        __syncthreads();
        if (threadIdx.x < 32) { const unsigned c = lcnt[threadIdx.x]; lbase[threadIdx.x] = c ? atomicAdd(&cnt[threadIdx.x], c) : 0u; }
        __syncthreads();
        if (act) {
            if (lane < 16) { const int n = n0 + lane;
                const int d0 = e0 * MOE_CAP + (int)lbase[e0] + lr0, d1 = e1 * MOE_CAP + (int)lbase[e1] + lr1;
                list_slot[d0] = 2 * n; list_slot[d1] = 2 * n + 1; list_gate[d0] = g0; list_gate[d1] = g1; }
            unsigned char* H8 = (unsigned char*)HN;
            float rsr[4];
#pragma unroll
            for (int j = 0; j < 4; ++j) rsr[j] = SS[4 * j + r4] * ACT_Q;
#pragma unroll 2
            for (int kc = 0; kc < 8; ++kc) { const float4 gn0 = *(const float4*)(gain + kc * 128 + 8 * cidx), gn1 = *(const float4*)(gain + kc * 128 + 8 * cidx + 4);
                u32x4_t xv[4];
#pragma unroll
                for (int j = 0; j < 4; ++j) xv[j] = *(const u32x4_t*)(XR + (size_t)(n0 + 4 * j + r4) * DM + kc * 128 + 8 * cidx);
#pragma unroll
                for (int j = 0; j < 4; ++j) { const u32x4_t o = xv[j]; const float q = rsr[j];
                    *(u32x2_t*)(H8 + (size_t)(n0 + 4 * j + r4) * DM + kc * 128 + 8 * cidx) = (u32x2_t){
                        q8x4(__uint_as_float(o.x << 16) * gn0.x, __uint_as_float(o.x & 0xffff0000u) * gn0.y, __uint_as_float(o.y << 16) * gn0.z, __uint_as_float(o.y & 0xffff0000u) * gn0.w, q),
                        q8x4(__uint_as_float(o.z << 16) * gn1.x, __uint_as_float(o.z & 0xffff0000u) * gn1.y, __uint_as_float(o.w << 16) * gn1.z, __uint_as_float(o.w & 0xffff0000u) * gn1.w, q)}; } }
        }
        __syncthreads();
    }
}
__device__ __forceinline__ void moe_prefix(const unsigned* cnt, LAS int* pst) {
    if (threadIdx.x < 64) { const int l = threadIdx.x; const int c = l < NEXP ? (int)cnt[l] : 0; const int pc = (c + MOE_TM - 1) / MOE_TM * MOE_TM; int inc = pc;
#pragma unroll
        for (int d = 1; d < NEXP; d <<= 1) { const int up = __shfl_up(inc, d, 64); if (l >= d) inc += up; }
        if (l < NEXP) { pst[l] = inc - pc; pst[96 + l] = c; }
        if (l == NEXP - 1) pst[NEXP] = inc; }
    __syncthreads();
}
__device__ __forceinline__ int moe_tile_expert(const LAS int* pst, int row0) { int e = 0;
    for (int i = 1; i < NEXP; ++i) if (row0 >= pst[i]) e = i;
    return e; }

__device__ __forceinline__ float shiftcol(const bf16_t* P, int n, int t, int col, const float* mu) {
    const float cur = bf2f(P[(size_t)n * ABC + col]); const float prev = t > 0 ? bf2f(P[(size_t)(n - 1) * ABC + col]) : 0.f;
    return cur + (prev - cur) * mu[col];
}
constexpr int RW_WMF = 0, RW_RF = 2048, RW_BKF = 4096, RW_ARF = 8192, RW_U = 9216, RW_V = 11264, RW_G = 13312, RW_REC = 13568;
__device__ __forceinline__ float fast_sigmoid(float x) { return __builtin_amdgcn_rcpf(1.f + __expf(-x)); }
__device__ __forceinline__ float fast_softplus(float x) { return fmaxf(x, 0.f) + __logf(1.f + __expf(-fabsf(x))); }
__device__ __forceinline__ void tr_acc(LAS float* TBf, const f32x4 (&acc)[4], int lane, float (&out)[16]) {
    const int q4 = lane >> 4, c16 = lane & 15;
#pragma unroll
    for (int ct = 0; ct < 4; ++ct)
#pragma unroll
        for (int r = 0; r < 4; ++r) TBf[(16 * ct + 4 * q4 + r) * 20 + c16] = acc[ct][r];
#pragma unroll
    for (int j = 0; j < 4; ++j) { const f32x4 v = *(const LAS f32x4*)(TBf + lane * 20 + 4 * j); out[4 * j] = v[0]; out[4 * j + 1] = v[1]; out[4 * j + 2] = v[2]; out[4 * j + 3] = v[3]; }
}
template <int PART>
__device__ __forceinline__ void prep_units(const Args& a, LAS float* lds) {
    const bf16_t* P = (const bf16_t*)(a.ws + WS_B);
    unsigned char* FR = a.ws + WS_C;
    bf16_t* Vb = (bf16_t*)a.out; float* Bon = (float*)((unsigned char*)a.out + 32 * MiB);
    bf16_t* LA = (bf16_t*)(a.ws + WS_A); bf16_t* U = LA + (size_t)NTOK * 512;
    const float* mu = a.in[5]; const float* w0 = a.in[6]; const float* a0 = a.in[8];
    const float* k_k = a.in[11]; const float* k_a = a.in[12]; const float* r_k = a.in[13];
    const float* conv_w = a.in[16]; const float* conv_b = a.in[17]; const float* b_a = a.in[19]; const float* b_x = a.in[21]; const float* lam = a.in[22];
    const int lane = threadIdx.x & 63, wave = threadIdx.x >> 6, q4 = lane >> 4, c16 = lane & 15;
    LAS unsigned char* W = (LAS unsigned char*)lds + wave * 15360;
    constexpr int KAP = 0, BT = 2304, KT = 4608, RT = 6912, BTT = 9216, KTT = 11264, AKB = 13312, AKK = 14336, RS = 144;
    constexpr int XS = 0, XS2 = 2304, TB = 4608;
    LAS float* TBf = (LAS float*)(W + TB);
    unsigned xbp[10], pwp[9], pap[9], qrp[9], qkp[9], qvp[9], sgc[4], sgp[4];
#define LD16X(PTx, dst, colbase, off) do { const u32x4_t _lo = *(const u32x4_t*)((PTx) + (colbase) * 32 + lo32), _hi = *(const u32x4_t*)((PTx) + (colbase) * 32 + 16 + lo32); \
        dst[(off)] = _lo.x; dst[(off) + 1] = _lo.y; dst[(off) + 2] = _lo.z; dst[(off) + 3] = _lo.w; dst[(off) + 4] = _hi.x; dst[(off) + 5] = _hi.y; dst[(off) + 6] = _hi.z; dst[(off) + 7] = _hi.w; } while (0)
#define PREP_LOADS(PTx, PTpx, firstx) do { unsigned lo32 = (unsigned)lane * 32u; asm volatile("" : "+v"(lo32)); \
        if constexpr (PART == 0) { u32x2_t t2 = (u32x2_t){0u, 0u}; if (!(firstx)) t2 = *(const u32x2_t*)((PTpx) + (2304 + hh * 64) * 32 + 24 + lo32); xbp[0] = t2.x; xbp[1] = t2.y; LD16X(PTx, xbp, 2304 + hh * 64, 2); \
            { const int _tk = lane >> 2; unsigned _so = (unsigned)((lane & 3) * 128 + _tk * 2); asm volatile("" : "+v"(_so)); \
              _Pragma("unroll") for (int _i = 0; _i < 4; ++_i) { sgc[_i] = *(const bf16_t*)((PTx) + (1664 + 16 * hh + _i) * 32 + _so); \
                sgp[_i] = (_tk > 0) ? (unsigned)*(const bf16_t*)((PTx) + (1664 + 16 * hh + _i) * 32 - 2 + _so) : ((firstx) ? 0u : (unsigned)*(const bf16_t*)((PTpx) + (1664 + 16 * hh + _i) * 32 + 30 + _so)); } } } \
        else { pwp[0] = (firstx) ? 0u : *(const unsigned*)((PTpx) + 1536 * 32 + 28 + lo32); LD16X(PTx, pwp, 1536, 1); \
            pap[0] = (firstx) ? 0u : *(const unsigned*)((PTpx) + 1600 * 32 + 28 + lo32); LD16X(PTx, pap, 1600, 1); } } while (0)
#define PREP_LOADS_B(PTx, PTpx, firstx) do { unsigned lo32 = (unsigned)lane * 32u; asm volatile("" : "+v"(lo32)); \
            qrp[0] = (firstx) ? 0u : *(const unsigned*)((PTpx) + (hh * 64) * 32 + 28 + lo32); LD16X(PTx, qrp, hh * 64, 1); \
            qkp[0] = (firstx) ? 0u : *(const unsigned*)((PTpx) + (512 + hh * 64) * 32 + 28 + lo32); LD16X(PTx, qkp, 512 + hh * 64, 1); \
            qvp[0] = (firstx) ? 0u : *(const unsigned*)((PTpx) + (1024 + hh * 64) * 32 + 28 + lo32); LD16X(PTx, qvp, 1024 + hh * 64, 1); } while (0)
#define PREP_PREFETCH() do { const int _un = u + (int)gridDim.x * 8; if (_un < (NTOK / 16) * 8) { const int _tn = _un >> 3; const unsigned char* _PT = (const unsigned char*)(P + (size_t)_tn * ABC * 16); \
        const bool _f = ((_tn * 16) & (SEQ - 1)) == 0; PREP_LOADS(_PT, _PT - (size_t)ABC * 32, _f); } } while (0)
    const int u0 = blockIdx.x * 8 + wave, hh = u0 & 7;
    const int ch = hh * 64 + lane;
    const float H_cw0 = conv_w[ch], H_cw1 = conv_w[512 + ch], H_cw2 = conv_w[1024 + ch], H_cw3 = conv_w[1536 + ch], H_cb = conv_b[ch], H_bac = b_a[ch], H_bxc = b_x[ch], H_sp = fast_softplus(-lam[ch]);
    const f32x4 H_m4 = *(const f32x4*)(mu + 1664 + 16 * hh + (lane & 3) * 4);
    const float H_muw = mu[1536 + lane], H_mua = mu[1600 + lane], H_w0c = w0[ch], H_a0c = a0[ch], H_kkc = k_k[ch], H_kac = k_a[ch], H_rkc = r_k[ch], H_mur = mu[ch], H_muk = mu[512 + ch], H_muv = mu[1024 + ch];
    for (int u = u0; u < (NTOK / 16) * 8; u += gridDim.x * 8) {
        const int tile = u >> 3, h = u & 7, n0 = tile * 16, c = h * 64 + lane;
        const bool first = (n0 & (SEQ - 1)) == 0;
        const unsigned char* PT = (const unsigned char*)(P + (size_t)tile * ABC * 16);
        const unsigned char* PTp = PT - (size_t)ABC * 32;
        unsigned lo32 = (unsigned)lane * 32u; asm volatile("" : "+v"(lo32));
#define LD16(dst, colbase, off) do { const u32x4_t _lo = *(const u32x4_t*)(PT + (colbase) * 32 + lo32), _hi = *(const u32x4_t*)(PT + (colbase) * 32 + 16 + lo32); \
            dst[(off)] = _lo.x; dst[(off) + 1] = _lo.y; dst[(off) + 2] = _lo.z; dst[(off) + 3] = _lo.w; dst[(off) + 4] = _hi.x; dst[(off) + 5] = _hi.y; dst[(off) + 6] = _hi.z; dst[(off) + 7] = _hi.w; } while (0)
        if (PART == 1 || u == u0) { PREP_LOADS(PT, PTp, first); }
        if constexpr (PART == 1) { PREP_LOADS_B(PT, PTp, first); }
        bf16x8_t fr1[8], fr2[8];
        { const bf16_t* G1 = (const bf16_t*)(a.ws + (PART == 0 ? FG_WA : FG_W2)) + h * 4096; const bf16_t* G2 = (const bf16_t*)(a.ws + (PART == 0 ? FG_WX : FG_A2)) + h * 4096;
#pragma unroll
            for (int i = 0; i < 8; ++i) { fr1[i] = *(const bf16x8_t*)(G1 + (i * 64 + lane) * 8); fr2[i] = *(const bf16x8_t*)(G2 + (i * 64 + lane) * 8); } }
        asm volatile("" ::: "memory");
#define UNPK(arr, i) __uint_as_float(((i) & 1) ? ((arr)[(i) >> 1] & 0xffff0000u) : ((arr)[(i) >> 1] << 16))
        if constexpr (PART == 0) {
        {
            bf16_t* SG = (bf16_t*)((unsigned char*)a.out + DO_SG);
            const int tk = lane >> 2, col = 1664 + 16 * h + (lane & 3) * 4;
            float cu[4], pu[4];
#pragma unroll
            for (int i = 0; i < 4; ++i) { cu[i] = __uint_as_float(sgc[i] << 16); pu[i] = __uint_as_float(sgp[i] << 16); }
            const f32x4 m4 = H_m4;
            *(u32x2_t*)(SG + (size_t)(tile * 8 + h) * 256 + lane * 4) = (u32x2_t){pk2(fast_sigmoid(cu[0] + (pu[0] - cu[0]) * m4[0]), fast_sigmoid(cu[1] + (pu[1] - cu[1]) * m4[1])), pk2(fast_sigmoid(cu[2] + (pu[2] - cu[2]) * m4[2]), fast_sigmoid(cu[3] + (pu[3] - cu[3]) * m4[3]))};
        }
        {
            const float cw0 = H_cw0, cw1 = H_cw1, cw2 = H_cw2, cw3 = H_cw3, cb = H_cb;
            float xcv[16], xb[19];
#pragma unroll
            for (int i = 0; i < 19; ++i) xb[i] = UNPK(xbp, i + 1);
            PREP_PREFETCH();
#pragma unroll
            for (int tk = 0; tk < 16; ++tk) { xcv[tk] = cb + cw0 * xb[tk] + cw1 * xb[tk + 1] + cw2 * xb[tk + 2] + cw3 * xb[tk + 3]; *(LAS bf16_t*)(W + XS + tk * RS + lane * 2) = f2bf(xcv[tk]); }
            f32x4 accr[4], acci[4];
            const bf16_t* FA = (const bf16_t*)(a.ws + FG_WA) + h * 4096; const bf16_t* FX = (const bf16_t*)(a.ws + FG_WX) + h * 4096;
            bf16x8_t xf[2];
#pragma unroll
            for (int ks = 0; ks < 2; ++ks) xf[ks] = *(const LAS bf16x8_t*)(W + XS + c16 * RS + ks * 64 + q4 * 16);
#pragma unroll
            for (int ct = 0; ct < 4; ++ct) { accr[ct] = (f32x4){0.f, 0.f, 0.f, 0.f}; acci[ct] = accr[ct];
#pragma unroll
                for (int ks = 0; ks < 2; ++ks) { accr[ct] = __builtin_amdgcn_mfma_f32_16x16x32_bf16(fr1[ct * 2 + ks], xf[ks], accr[ct], 0, 0, 0);
                    acci[ct] = __builtin_amdgcn_mfma_f32_16x16x32_bf16(fr2[ct * 2 + ks], xf[ks], acci[ct], 0, 0, 0); } }
            float rp[16], ip[16];
            tr_acc(TBf, accr, lane, rp); tr_acc(TBf, acci, lane, ip);
            const float bac = H_bac, bxc = H_bxc, sp = H_sp;
            float hloc = 0.f, sla = 0.f;
            unsigned lap[4], uup[4];
#pragma unroll
            for (int tk = 0; tk < 16; ++tk) { const float r = fast_sigmoid(rp[tk] + bac), i = fast_sigmoid(ip[tk] + bxc);
                const float la = -8.f * r * sp; const float uu = __builtin_amdgcn_sqrtf(fmaxf(1.f - __expf(2.f * la), 0.f)) * i * xcv[tk];
                const bf16_t lab = f2bf(la), uub = f2bf(uu); const float lar = bf2f(lab);
                if (tk & 1) { lap[(tk >> 1) & 3] |= (unsigned)lab << 16; uup[(tk >> 1) & 3] |= (unsigned)uub << 16; } else { lap[(tk >> 1) & 3] = lab; uup[(tk >> 1) & 3] = uub; }
                if ((tk & 7) == 7) { *(u32x4_t*)(LA + ((size_t)tile * 512 + c) * 16 + (tk >> 3) * 8) = (u32x4_t){lap[0], lap[1], lap[2], lap[3]}; *(u32x4_t*)(U + ((size_t)tile * 512 + c) * 16 + (tk >> 3) * 8) = (u32x4_t){uup[0], uup[1], uup[2], uup[3]}; }
                hloc = __expf(lar) * hloc + bf2f(uub); sla += lar; }
            ((float*)((unsigned char*)a.out + DO_LRU))[(size_t)tile * 512 + c] = hloc; ((float*)((unsigned char*)a.out + DO_LRU))[(size_t)(2048 + tile) * 512 + c] = sla;
        }
        } else {
        float wpre[16], apre[16];
        {
            const float muw = H_muw, mua = H_mua;
#pragma unroll
            for (int tk = 0; tk < 16; ++tk) { const float pw1 = UNPK(pwp, tk + 2), pw0 = UNPK(pwp, tk + 1), pa1 = UNPK(pap, tk + 2), pa0 = UNPK(pap, tk + 1);
                const float wl = pw1 + (pw0 - pw1) * muw, al = pa1 + (pa0 - pa1) * mua;
                const float th = 1.f - 2.f * __builtin_amdgcn_rcpf(1.f + __expf(2.f * wl));
                *(LAS bf16_t*)(W + XS + tk * RS + lane * 2) = f2bf(th); *(LAS bf16_t*)(W + XS2 + tk * RS + lane * 2) = f2bf(al); }
            f32x4 accw[4], acca[4];
            const bf16_t* F2 = (const bf16_t*)(a.ws + FG_W2) + h * 4096; const bf16_t* FA2 = (const bf16_t*)(a.ws + FG_A2) + h * 4096;
            bf16x8_t wf[2], af[2];
#pragma unroll
            for (int ks = 0; ks < 2; ++ks) { wf[ks] = *(const LAS bf16x8_t*)(W + XS + c16 * RS + ks * 64 + q4 * 16); af[ks] = *(const LAS bf16x8_t*)(W + XS2 + c16 * RS + ks * 64 + q4 * 16); }
#pragma unroll
            for (int ct = 0; ct < 4; ++ct) { accw[ct] = (f32x4){0.f, 0.f, 0.f, 0.f}; acca[ct] = accw[ct];
#pragma unroll
                for (int ks = 0; ks < 2; ++ks) { accw[ct] = __builtin_amdgcn_mfma_f32_16x16x32_bf16(fr1[ct * 2 + ks], wf[ks], accw[ct], 0, 0, 0);
                    acca[ct] = __builtin_amdgcn_mfma_f32_16x16x32_bf16(fr2[ct * 2 + ks], af[ks], acca[ct], 0, 0, 0); } }
            tr_acc(TBf, accw, lane, wpre); tr_acc(TBf, acca, lane, apre);
        }
        const float w0c = H_w0c, a0c = H_a0c, kkc = H_kkc, kac = H_kac, rkc = H_rkc;
        const float mur = H_mur, muk = H_muk, muv = H_muv;
        unsigned char* rec = FR + ((size_t)tile * 8 + h) * RW_REC;
        float vsv[16];
        unsigned btp[8], ktp[8];
        float cum = 0.f, gC = 1.f;
#pragma unroll
        for (int tk = 0; tk < 16; ++tk) { const int n = n0 + tk;
            const float cr = UNPK(qrp, tk + 2), ck = UNPK(qkp, tk + 2), cv = UNPK(qvp, tk + 2), pr = UNPK(qrp, tk + 1), pk = UNPK(qkp, tk + 1), pv = UNPK(qvp, tk + 1);
            const float rs = cr + (pr - cr) * mur, ks = ck + (pk - ck) * muk, vs = cv + (pv - cv) * muv;
            const float wv = -fast_softplus(-(w0c + wpre[tk])) - 0.5f; const float logdec = -__expf(wv);
            const float av = fast_sigmoid(a0c + apre[tk]);
            const float kkr = ks * kkc; const float ss = wave_sum(kkr * kkr); const float kkn = kkr * rsqrtf(fmaxf(ss, 1e-24f));
            const float kp = ks * (1.f + (av - 1.f) * kac);
            const float bsum = wave_sum(rs * kp * rkc);
            if (lane == 0) Bon[(size_t)n * 8 + h] = bsum;
            Vb[(size_t)n * 512 + c] = f2bf(vs); vsv[tk] = vs;
            const float gprev = __expf(cum); cum += logdec; const float g = __expf(cum), gi = __builtin_amdgcn_rcpf(g); gC = g;
            const float kapv = kkn * gprev, btv = av * kkn * gi, ktv = kp * gi, rtv = rs * g;
            const bf16_t kb = f2bf(kapv), bb = f2bf(btv), kb2 = f2bf(ktv), rb = f2bf(rtv);
            *(LAS bf16_t*)(W + KAP + tk * RS + lane * 2) = kb; *(LAS bf16_t*)(W + BT + tk * RS + lane * 2) = bb;
            *(LAS bf16_t*)(W + KT + tk * RS + lane * 2) = kb2; *(LAS bf16_t*)(W + RT + tk * RS + lane * 2) = rb;
            if (tk & 1) { btp[tk >> 1] |= (unsigned)bb << 16; ktp[tk >> 1] |= (unsigned)kb2 << 16; } else { btp[tk >> 1] = bb; ktp[tk >> 1] = kb2; } }
        *(LAS u32x4_t*)(W + BTT + lane * 32) = (u32x4_t){btp[0], btp[1], btp[2], btp[3]}; *(LAS u32x4_t*)(W + BTT + lane * 32 + 16) = (u32x4_t){btp[4], btp[5], btp[6], btp[7]};
        *(LAS u32x4_t*)(W + KTT + lane * 32) = (u32x4_t){ktp[0], ktp[1], ktp[2], ktp[3]}; *(LAS u32x4_t*)(W + KTT + lane * 32 + 16) = (u32x4_t){ktp[4], ktp[5], ktp[6], ktp[7]};
        *(float*)(rec + RW_G + lane * 4) = gC;
        f32x4 akb = (f32x4){0.f, 0.f, 0.f, 0.f}, akk = akb, arbT = akb, arkT = akb;
#pragma unroll
        for (int ks = 0; ks < 2; ++ks) { const int fo = c16 * RS + ks * 64 + q4 * 16;
            const bf16x8_t fkap = *(const LAS bf16x8_t*)(W + KAP + fo), fbt = *(const LAS bf16x8_t*)(W + BT + fo), fkt = *(const LAS bf16x8_t*)(W + KT + fo), frt = *(const LAS bf16x8_t*)(W + RT + fo);
            akb = __builtin_amdgcn_mfma_f32_16x16x32_bf16(fkap, fbt, akb, 0, 0, 0); akk = __builtin_amdgcn_mfma_f32_16x16x32_bf16(fkap, fkt, akk, 0, 0, 0);
            arbT = __builtin_amdgcn_mfma_f32_16x16x32_bf16(fbt, frt, arbT, 0, 0, 0); arkT = __builtin_amdgcn_mfma_f32_16x16x32_bf16(fkt, frt, arkT, 0, 0, 0); }
#pragma unroll
        for (int r = 0; r < 4; ++r) { const int t = 4 * q4 + r; ((LAS float*)(W + AKB))[t * 16 + c16] = (c16 < t) ? akb[r] : 0.f; ((LAS float*)(W + AKK))[t * 16 + c16] = (c16 < t) ? akk[r] : 0.f;
            const int sidx = 4 * q4 + r; if (sidx > c16) { arbT[r] = 0.f; arkT[r] = 0.f; } }
        *(u32x4_t*)(rec + RW_ARF + lane * 16) = (u32x4_t){pk2(arbT[0], arbT[1]), pk2(arbT[2], arbT[3]), pk2(arkT[0], arkT[1]), pk2(arkT[2], arkT[3])};
#pragma unroll
        for (int i = 0; i < 4; ++i) { const u32x2_t b2 = *(const LAS u32x2_t*)(W + BTT + (16 * i + c16) * 32 + q4 * 8), k2 = *(const LAS u32x2_t*)(W + KTT + (16 * i + c16) * 32 + q4 * 8);
            *(u32x4_t*)(rec + RW_BKF + i * 1024 + lane * 16) = (u32x4_t){b2.x, b2.y, k2.x, k2.y}; }
#pragma unroll
        for (int sx = 0; sx < 2; ++sx) { const u32x2_t lo = *(const LAS u32x2_t*)(W + RT + c16 * RS + (32 * sx + 4 * q4) * 2), hi = *(const LAS u32x2_t*)(W + RT + c16 * RS + (32 * sx + 16 + 4 * q4) * 2);
            *(u32x4_t*)(rec + RW_RF + sx * 1024 + lane * 16) = (u32x4_t){lo.x, lo.y, hi.x, hi.y}; }
        float Wm[16], Uu[16];
#pragma unroll
        for (int t = 0; t < 16; ++t) { float wacc = bf2f(*(const LAS bf16_t*)(W + KAP + t * RS + lane * 2)), uacc = 0.f;
#pragma unroll
            for (int s4 = 0; s4 < 4; ++s4) if (4 * s4 < t) { const f32x4 b4 = *(const LAS f32x4*)(W + AKB + (t * 16 + 4 * s4) * 4), k4 = *(const LAS f32x4*)(W + AKK + (t * 16 + 4 * s4) * 4);
#pragma unroll
                for (int e = 0; e < 4; ++e) { const int sidx = 4 * s4 + e; if (sidx < t) { wacc -= b4[e] * Wm[sidx]; uacc += k4[e] * vsv[sidx] - b4[e] * Uu[sidx]; } } }
            Wm[t] = wacc; Uu[t] = uacc;
            *(LAS bf16_t*)(W + KAP + t * RS + lane * 2) = f2bf(wacc);
        }
        {
            const int ub = ((lane >> 4) * 64 + (lane & 15)) * 8;
#pragma unroll
            for (int q = 0; q < 4; ++q) { *(u32x2_t*)(rec + RW_U + ub + q * 128) = (u32x2_t){pk2(Uu[4 * q], Uu[4 * q + 1]), pk2(Uu[4 * q + 2], Uu[4 * q + 3])};
                *(u32x2_t*)(rec + RW_V + ub + q * 128) = (u32x2_t){pk2(vsv[4 * q], vsv[4 * q + 1]), pk2(vsv[4 * q + 2], vsv[4 * q + 3])}; }
        }
#pragma unroll
        for (int sx = 0; sx < 2; ++sx) { const u32x2_t lo = *(const LAS u32x2_t*)(W + KAP + c16 * RS + (32 * sx + 4 * q4) * 2), hi = *(const LAS u32x2_t*)(W + KAP + c16 * RS + (32 * sx + 16 + 4 * q4) * 2);
            *(u32x4_t*)(rec + RW_WMF + sx * 1024 + lane * 16) = (u32x4_t){lo.x, lo.y, hi.x, hi.y}; }
        }
    }
}
__device__ __forceinline__ void ph_l0_prep(const Args& a, LAS float* lds) { prep_units<0>(a, lds); prep_units<1>(a, lds); }
__device__ __forceinline__ void sub_barrier(unsigned* ctr, unsigned target) {
    asm volatile("s_waitcnt vmcnt(0)" ::: "memory");
    __syncthreads();
    if (threadIdx.x == 0) {
        (void)xb_add(ctr, 1u);
        unsigned sp = 0;
        while (xb_ld(ctr) < target) { __builtin_amdgcn_s_sleep(2); if (++sp > (1u << 22)) break; }
        __builtin_amdgcn_fence(__ATOMIC_ACQUIRE, "agent");
        asm volatile("s_waitcnt vmcnt(0)" ::: "memory");
    }
    __syncthreads();
}
__device__ __forceinline__ void st_wt(float* p, float v) { __hip_atomic_store((unsigned*)p, __float_as_uint(v), __ATOMIC_RELAXED, __HIP_MEMORY_SCOPE_AGENT); }
__device__ __forceinline__ void ph_lru_b(const Args& a, int bid, LAS float* lds) {
    if (bid >= 64) return;
    const float* CH = (const float*)((unsigned char*)a.out + DO_LRU); const float* CA = CH + (size_t)2048 * 512; float* CIN = (float*)((unsigned char*)a.out + DO_LRU) + (size_t)4096 * 512;
    const int b = bid >> 4, cg = bid & 15, cl = threadIdx.x & 31, seg = threadIdx.x >> 5, c = cg * 32 + cl;
    float ca[32], chv[32];
#pragma unroll
    for (int i = 0; i < 32; ++i) { const size_t o = (size_t)(b * 512 + seg * 32 + i) * 512 + c; ca[i] = CA[o]; chv[i] = CH[o]; }
    float h = 0.f, sa = 0.f;
#pragma unroll
    for (int i = 0; i < 32; ++i) { h = __expf(ca[i]) * h + chv[i]; sa += ca[i]; }
    lds[seg * 32 + cl] = sa; lds[512 + seg * 32 + cl] = h;
    __syncthreads();
    float hin = 0.f;
    for (int sg = 0; sg < seg; ++sg) hin = __expf(lds[sg * 32 + cl]) * hin + lds[512 + sg * 32 + cl];
    h = hin;
#pragma unroll
    for (int i = 0; i < 32; ++i) { st_wt(CIN + (size_t)(b * 512 + seg * 32 + i) * 512 + c, h); h = __expf(ca[i]) * h + chv[i]; }
}
__device__ __forceinline__ void ph_lru_c(const Args& a, int bid, int nblk) {
    const bf16_t* LA = (const bf16_t*)(a.ws + WS_A); const bf16_t* U = LA + (size_t)NTOK * 512; const bf16_t* P = (const bf16_t*)(a.ws + WS_B);
    const float* CIN = (const float*)((unsigned char*)a.out + DO_LRU) + (size_t)4096 * 512; bf16_t* MIX = (bf16_t*)(a.ws + WS_D);
    const int c = threadIdx.x;
    for (int u = bid; u < NTOK / 16; u += nblk) { float la[16], uv[16], gt[16];
        float h = CIN[(size_t)u * 512 + c];
#pragma unroll
        for (int hf = 0; hf < 2; ++hf) { const u32x4_t l4 = *(const u32x4_t*)(LA + ((size_t)u * 512 + c) * 16 + hf * 8), u4 = *(const u32x4_t*)(U + ((size_t)u * 512 + c) * 16 + hf * 8), g4 = *(const u32x4_t*)(P + ((size_t)u * ABC + 1792 + c) * 16 + hf * 8);
#pragma unroll
            for (int e = 0; e < 4; ++e) { gt[hf * 8 + 2 * e] = __uint_as_float(g4[e] << 16); gt[hf * 8 + 2 * e + 1] = __uint_as_float(g4[e] & 0xffff0000u); la[hf * 8 + 2 * e] = __uint_as_float(l4[e] << 16); la[hf * 8 + 2 * e + 1] = __uint_as_float(l4[e] & 0xffff0000u); uv[hf * 8 + 2 * e] = __uint_as_float(u4[e] << 16); uv[hf * 8 + 2 * e + 1] = __uint_as_float(u4[e] & 0xffff0000u); } }
#pragma unroll
        for (int s = 0; s < 16; ++s) { const int n = u * 16 + s; h = __expf(la[s]) * h + uv[s];
            const float x = gt[s], t2 = 0.7978845608028654f * (x + 0.044715f * x * x * x); const float th = 1.f - 2.f * __builtin_amdgcn_rcpf(1.f + __expf(2.f * t2));
            MIX[(size_t)n * DM + 512 + c] = f2bf(h * 0.5f * x * (1.f + th)); } }
}
#ifndef SP_MODE
#define SP_MODE 0
#endif
#ifndef SP_VAR
#define SP_VAR 0
#endif
constexpr bool SCAN_COOP = true; constexpr int NSCAN = SCAN_COOP ? 64 : 32;
template <int VAR = 0, bool COOP = false>
__device__ __forceinline__ void ph_rwkv_scan(const Args& a, LAS unsigned char* L) {
    if (blockIdx.x >= (COOP ? 64 : 32)) return;
    constexpr int SLOT = 9472, GOFF = 9216, NS = 14, NCH = SEQ / 16; constexpr size_t CSTR = (size_t)8 * RW_REC;
    const unsigned char* FR = a.ws + WS_C; bf16_t* Yr = (bf16_t*)((unsigned char*)a.out + DO_YR);
    const int chain = COOP ? ((int)blockIdx.x & 31) : (int)blockIdx.x, half = COOP ? ((int)blockIdx.x >> 5) : 0;
    const int b = chain >> 3, h = chain & 7, lane = threadIdx.x & 63, wave = __builtin_amdgcn_readfirstlane(threadIdx.x >> 6), q4 = lane >> 4, c16 = lane & 15;
    const unsigned char* FRb = FR + ((size_t)(b * NCH) * 8 + h) * RW_REC;
#define RW_BARRIER() do { asm volatile("" ::: "memory"); __builtin_amdgcn_s_barrier(); asm volatile("" ::: "memory"); } while (0)
    if (COOP && wave >= 4) {
        const int lw = wave - 4, sub = lw & 1; const bool far = lw < 2;
        const int set = far ? half : (half ^ 1);
        const int p0 = set * 5 + sub * 3, n1k = (sub == 0) ? 3 : (set == 0 ? 2 : 1); const bool hasG = (set == 1) && (sub == 1);
        const unsigned char* rp = FRb + lane * 16 + p0 * 1024; int so = p0 * 1024;
#define RW_CISSUE() do { LAS unsigned char* _slot = L + so; \
            _Pragma("unroll") for (int _j = 0; _j < 3; ++_j) if (_j < n1k) __builtin_amdgcn_global_load_lds((const unsigned*)(rp + _j * 1024), (LAS unsigned*)(_slot + _j * 1024), 16, 0, 0); \
            if (hasG) __builtin_amdgcn_global_load_lds((const unsigned*)(rp - lane * 12 - p0 * 1024 + RW_G), (LAS unsigned*)(_slot - p0 * 1024 + GOFF), 4, 0, 0); \
            rp += CSTR; so += SLOT; if (so >= NS * SLOT) so -= NS * SLOT; } while (0)
        if (far) {
#define RW_CWAIT() do { if (sub == 0) asm volatile("s_waitcnt vmcnt(27)" ::: "memory"); else asm volatile("s_waitcnt vmcnt(18)" ::: "memory"); } while (0)
            for (int p = 0; p < NS - 2; ++p) RW_CISSUE();
            RW_CWAIT(); RW_BARRIER();
#pragma unroll 1
            for (int it = 0; it < NCH / 2; ++it) { RW_CISSUE(); RW_CISSUE(); RW_CWAIT(); RW_BARRIER(); }
#undef RW_CWAIT
        } else {
#define RW_CWAIT() do { if (sub == 0) asm volatile("s_waitcnt vmcnt(6)" ::: "memory"); else asm volatile("s_waitcnt vmcnt(4)" ::: "memory"); } while (0)
            for (int p = 0; p < 5; ++p) RW_CISSUE();
            RW_CWAIT(); RW_BARRIER();
#pragma unroll 1
            for (int it = 0; it < NCH / 2; ++it) { RW_CISSUE(); RW_CISSUE(); RW_CWAIT(); RW_BARRIER(); }
#undef RW_CWAIT
        }
        asm volatile("s_waitcnt vmcnt(0)" ::: "memory");
#undef RW_CISSUE
    } else if (COOP && wave >= 2) {
        RW_BARRIER();
#pragma unroll 1
        for (int it = 0; it < NCH / 2; ++it) RW_BARRIER();
    } else if (wave >= 4) {
        const int lw = wave - 4;
        const unsigned char* rp = FRb + lane * 16; int so = 0;
#define RW_ISSUE1() do { LAS unsigned char* _slot = L + so; \
            if (VAR & 1) { } else if (lw < 2) { _Pragma("unroll") for (int _j = 0; _j < 3; ++_j) __builtin_amdgcn_global_load_lds((const unsigned*)(rp + (lw * 3 + _j) * 1024), (LAS unsigned*)(_slot + (lw * 3 + _j) * 1024), 16, 0, 0); } \
            else if (lw == 2) { _Pragma("unroll") for (int _j = 0; _j < 2; ++_j) __builtin_amdgcn_global_load_lds((const unsigned*)(rp + (6 + _j) * 1024), (LAS unsigned*)(_slot + (6 + _j) * 1024), 16, 0, 0); } \
            else { __builtin_amdgcn_global_load_lds((const unsigned*)(rp + 8 * 1024), (LAS unsigned*)(_slot + 8 * 1024), 16, 0, 0); \
                   __builtin_amdgcn_global_load_lds((const unsigned*)(rp - lane * 12 + RW_G), (LAS unsigned*)(_slot + GOFF), 4, 0, 0); } \
            if (!(VAR & 8)) rp += CSTR; so += SLOT; if (so == NS * SLOT) so = 0; } while (0)
#if SP_MODE & 4
#define RW_ISSUE() do { RW_ISSUE1(); rp -= CSTR; so -= SLOT; if (so < 0) so += NS * SLOT; RW_ISSUE1(); } while (0)
#else
#define RW_ISSUE() RW_ISSUE1()
#endif
#if SP_MODE & 4
#define RW_LWAIT() do { if (lw < 2) asm volatile("s_waitcnt vmcnt(54)" ::: "memory"); else asm volatile("s_waitcnt vmcnt(36)" ::: "memory"); } while (0)
#else
#define RW_LWAIT() do { if (lw < 2) asm volatile("s_waitcnt vmcnt(27)" ::: "memory"); else asm volatile("s_waitcnt vmcnt(18)" ::: "memory"); } while (0)
#endif
        for (int p = 0; p < NS - 2; ++p) RW_ISSUE();
        RW_LWAIT();
        RW_BARRIER();
#pragma unroll 1
        for (int it = 0; it < NCH / 2; ++it) { RW_ISSUE(); RW_ISSUE(); RW_LWAIT(); RW_BARRIER(); }
        asm volatile("s_waitcnt vmcnt(0)" ::: "memory");
#undef RW_ISSUE
#undef RW_ISSUE1
#undef RW_LWAIT
    } else {
        const int vs = COOP ? 2 * half + wave : wave;
#if SP_MODE & 2
        __builtin_amdgcn_s_setprio(3);
#endif
        f32x4 T[4];
#pragma unroll
        for (int i = 0; i < 4; ++i) T[i] = (f32x4){0.f, 0.f, 0.f, 0.f};
        struct Ops { bf16x8_t wmf[2], rf[2], bkf[4], arf; f32x4 g4[4]; };
        const LAS unsigned char* lp = L + lane * 16; const LAS unsigned char* lg = L + GOFF + q4 * 16; int so = 0;
        const unsigned char* up = FRb + RW_U + (vs * 64 + lane) * 8;
        bf16_t* yp = Yr + ((size_t)(b * NCH) * 8 + h) * 1024 + vs * 256 + lane * 4;
#if SP_MODE & 8
#define RW_LOAD(O) do { { const LAS unsigned char* _r = lp + so; const LAS unsigned char* _g = lg + so; \
            _Pragma("unroll") for (int _s = 0; _s < 2; ++_s) { bf16x8_t _t0 = *(const LAS bf16x8_t*)(_r + RW_WMF + _s * 1024); bf16x8_t _t1 = *(const LAS bf16x8_t*)(_r + RW_RF + _s * 1024); asm volatile("" :: "v"(_t0), "v"(_t1)); } \
            _Pragma("unroll") for (int _i = 0; _i < 4; ++_i) { bf16x8_t _t0 = *(const LAS bf16x8_t*)(_r + RW_BKF + _i * 1024); f32x4 _t1 = *(const LAS f32x4*)(_g + _i * 64); asm volatile("" :: "v"(_t0), "v"(_t1)); } \
            { bf16x8_t _t0 = *(const LAS bf16x8_t*)(_r + RW_ARF); asm volatile("" :: "v"(_t0)); } asm volatile("" ::: "memory"); } RW_LOAD1(O); } while (0)
#else
#define RW_LOAD(O) RW_LOAD1(O)
#endif
#define RW_LOAD1(O) do { const LAS unsigned char* _r = lp + so; const LAS unsigned char* _g = lg + so; \
            _Pragma("unroll") for (int _s = 0; _s < 2; ++_s) { O.wmf[_s] = *(const LAS bf16x8_t*)(_r + RW_WMF + _s * 1024); O.rf[_s] = *(const LAS bf16x8_t*)(_r + RW_RF + _s * 1024); } \
            _Pragma("unroll") for (int _i = 0; _i < 4; ++_i) O.bkf[_i] = *(const LAS bf16x8_t*)(_r + RW_BKF + _i * 1024); \
            O.arf = *(const LAS bf16x8_t*)(_r + RW_ARF); \
            _Pragma("unroll") for (int _i = 0; _i < 4; ++_i) O.g4[_i] = *(const LAS f32x4*)(_g + _i * 64); \
            so += SLOT; if (so == NS * SLOT) so = 0; \
            __builtin_amdgcn_sched_barrier(0); } while (0)
#define RW_UV(dst) do { if (!(VAR & 2)) { dst[0] = *(const u32x2_t*)up; dst[1] = *(const u32x2_t*)(up + 2048); } else { asm volatile("" : "+v"(dst[0]), "+v"(dst[1])); } if (!(VAR & 16)) up += CSTR; } while (0)
#define RW_STEP(O, uv) do { \
            bf16x8_t _bS[2]; \
            _Pragma("unroll") for (int _s = 0; _s < 2; ++_s) { const u32x4_t _pk = (u32x4_t){pk2(T[2 * _s][0], T[2 * _s][1]), pk2(T[2 * _s][2], T[2 * _s][3]), pk2(T[2 * _s + 1][0], T[2 * _s + 1][1]), pk2(T[2 * _s + 1][2], T[2 * _s + 1][3])}; \
                _bS[_s] = __builtin_bit_cast(bf16x8_t, _pk); } \
            f32x4 _z = (f32x4){__uint_as_float(uv[0].x << 16), __uint_as_float(uv[0].x & 0xffff0000u), __uint_as_float(uv[0].y << 16), __uint_as_float(uv[0].y & 0xffff0000u)}; \
            _z = __builtin_amdgcn_mfma_f32_16x16x32_bf16(O.wmf[0], _bS[0], _z, 0, 0, 0); _z = __builtin_amdgcn_mfma_f32_16x16x32_bf16(O.wmf[1], _bS[1], _z, 0, 0, 0); \
            f32x4 _y = (f32x4){0.f, 0.f, 0.f, 0.f}; \
            _y = __builtin_amdgcn_mfma_f32_16x16x32_bf16(_bS[0], O.rf[0], _y, 0, 0, 0); _y = __builtin_amdgcn_mfma_f32_16x16x32_bf16(_bS[1], O.rf[1], _y, 0, 0, 0); \
            const u32x4_t _zvp = (u32x4_t){pk2(-_z[0], -_z[1]), pk2(-_z[2], -_z[3]), uv[1].x, uv[1].y}; \
            const bf16x8_t _bZV = __builtin_bit_cast(bf16x8_t, _zvp); \
            _Pragma("unroll") for (int _i = 0; _i < 4; ++_i) { T[_i] = __builtin_amdgcn_mfma_f32_16x16x32_bf16(O.bkf[_i], _bZV, T[_i], 0, 0, 0); T[_i] = T[_i] * O.g4[_i]; } \
            _y = __builtin_amdgcn_mfma_f32_16x16x32_bf16(_bZV, O.arf, _y, 0, 0, 0); \
            if (!(VAR & 4)) *(u32x2_t*)yp = (u32x2_t){pk2(_y[0], _y[1]), pk2(_y[2], _y[3])}; else asm volatile("" :: "v"(_y)); RW_ST2(); yp += 8 * 1024; } while (0)
#if SP_MODE & 16
#define RW_ST2() do { asm volatile("" ::: "memory"); *(u32x2_t*)yp = (u32x2_t){pk2(_y[0], _y[1]), pk2(_y[2], _y[3])}; } while (0)
#else
#define RW_ST2() do { } while (0)
#endif
#define RW_SYNC() do { asm volatile("s_waitcnt lgkmcnt(0)" ::: "memory"); RW_BARRIER(); } while (0)
        Ops A, B;
        u32x2_t uv0[2], uv1[2], uv2[2], uv3[2], uv4[2], uv5[2], uv6[2], uv7[2];
        RW_UV(uv0); RW_UV(uv1); RW_UV(uv2); RW_UV(uv3); RW_UV(uv4); RW_UV(uv5); RW_UV(uv6); RW_UV(uv7);
        RW_BARRIER();
        RW_LOAD(A);
#pragma unroll 1
        for (int ch = 0; ch < NCH; ch += 8) {
            RW_LOAD(B); RW_STEP(A, uv0); RW_UV(uv0);
            RW_LOAD(A); RW_STEP(B, uv1); RW_UV(uv1); RW_SYNC();
            RW_LOAD(B); RW_STEP(A, uv2); RW_UV(uv2);
            RW_LOAD(A); RW_STEP(B, uv3); RW_UV(uv3); RW_SYNC();
            RW_LOAD(B); RW_STEP(A, uv4); RW_UV(uv4);
            RW_LOAD(A); RW_STEP(B, uv5); RW_UV(uv5); RW_SYNC();
            RW_LOAD(B); RW_STEP(A, uv6); RW_UV(uv6);
            RW_LOAD(A); RW_STEP(B, uv7); RW_UV(uv7); RW_SYNC(); }
#undef RW_SYNC
#undef RW_LOAD
#undef RW_LOAD1
#undef RW_STEP
#undef RW_UV
    }
#undef RW_BARRIER
}
__device__ __forceinline__ void ph_rwkv_post(const Args& a, LAS float* lds) {
    const bf16_t* V = (const bf16_t*)a.out; const float* Bon = (const float*)((const unsigned char*)a.out + DO_BON); const bf16_t* SG = (const bf16_t*)((const unsigned char*)a.out + DO_SG);
    const bf16_t* Yr = (const bf16_t*)((const unsigned char*)a.out + DO_YR); const bf16_t* MIX = (const bf16_t*)(a.ws + WS_D);
    const float* ln_w = a.in[14]; const float* ln_b = a.in[15];
    LAS unsigned char* L = (LAS unsigned char*)lds;
    const int c = threadIdx.x, lane = c & 63, h = c >> 6, q4 = lane >> 4, c16 = lane & 15;
    const bf16_t* FG = (const bf16_t*)(a.ws + FG_G2) + h * 8192;
    LAS float* AMf = (LAS float*)(L + 8192); LAS unsigned char* T8 = L + 16384;
    unsigned char* MIX8 = a.ws + WS_A; float* rowscale = (float*)(a.ws + WS_ROUTE + RT_LRU_CH + 262144);
    bf16x8_t fg[16]; f32x4 lwv[4], lbv[4];
#pragma unroll
    for (int i = 0; i < 16; ++i) fg[i] = *(const bf16x8_t*)(FG + ((size_t)i * 64 + lane) * 8);
#pragma unroll
    for (int ct = 0; ct < 4; ++ct) { const int ch = 64 * h + 16 * ct + 4 * q4; lwv[ct] = *(const f32x4*)(ln_w + ch); lbv[ct] = *(const f32x4*)(ln_b + ch); }
    u32x2_t p_sg, p_y[4], p_v[4]; float p_bon; u32x4_t p_l0, p_l1;
#define POST_FETCH(t) do { const int _n0 = (t) * 16; { const int tk = c >> 5, j4 = (c & 31) * 4; p_sg = *(const u32x2_t*)(SG + (size_t)(t) * 2048 + (j4 >> 4) * 256 + tk * 16 + (j4 & 15)); } \
        _Pragma("unroll") for (int ct = 0; ct < 4; ++ct) { p_y[ct] = *(const u32x2_t*)(Yr + (size_t)(t) * 8192 + h * 1024 + ct * 256 + lane * 4); p_v[ct] = *(const u32x2_t*)(V + (size_t)(_n0 + c16) * 512 + 64 * h + 16 * ct + 4 * q4); } \
        p_bon = Bon[(size_t)(_n0 + c16) * 8 + h]; { const bf16_t* yb = MIX + (size_t)(_n0 + (lane >> 2)) * DM + 512 + 64 * h + 16 * (lane & 3); p_l0 = *(const u32x4_t*)yb; p_l1 = *(const u32x4_t*)(yb + 8); } } while (0)
    if ((int)blockIdx.x < NTOK / 16) POST_FETCH((int)blockIdx.x);
    for (int tile = blockIdx.x; tile < NTOK / 16; tile += gridDim.x) {
        const int n0 = tile * 16;
        __syncthreads();
        { const int tk = c >> 5, j4 = (c & 31) * 4; *(LAS u32x2_t*)(L + tk * 272 + j4 * 2) = p_sg; }
        u32x2_t c_y[4], c_v[4]; const float bsc = p_bon; const u32x4_t l0 = p_l0, l1 = p_l1;
#pragma unroll
        for (int ct = 0; ct < 4; ++ct) { c_y[ct] = p_y[ct]; c_v[ct] = p_v[ct]; }
        if (tile + (int)gridDim.x < NTOK / 16) POST_FETCH(tile + (int)gridDim.x);
        __syncthreads();
        const int n = n0 + c16;
        f32x4 g[4], y[4];
#pragma unroll
        for (int ct = 0; ct < 4; ++ct) { g[ct] = (f32x4){0.f, 0.f, 0.f, 0.f};
#pragma unroll
            for (int ks = 0; ks < 4; ++ks) { const bf16x8_t af = fg[ct * 4 + ks]; const bf16x8_t bfr = *(const LAS bf16x8_t*)(L + c16 * 272 + ks * 64 + q4 * 16);
                g[ct] = __builtin_amdgcn_mfma_f32_16x16x32_bf16(af, bfr, g[ct], 0, 0, 0); }
            { const u32x2_t yv = c_y[ct]; y[ct] = (f32x4){__uint_as_float(yv.x << 16), __uint_as_float(yv.x & 0xffff0000u), __uint_as_float(yv.y << 16), __uint_as_float(yv.y & 0xffff0000u)}; } }
        float sm = 0.f;
#pragma unroll
        for (int ct = 0; ct < 4; ++ct) sm += (y[ct][0] + y[ct][1]) + (y[ct][2] + y[ct][3]);
        sm = xrow16_sum(sm);
        const float mean = sm * (1.f / 64.f);
        float sv = 0.f;
#pragma unroll
        for (int ct = 0; ct < 4; ++ct) { y[ct] = y[ct] - mean; sv += (y[ct][0] * y[ct][0] + y[ct][1] * y[ct][1]) + (y[ct][2] * y[ct][2] + y[ct][3] * y[ct][3]); }
        sv = xrow16_sum(sv);
        const float rstd = rsqrtf(sv * (1.f / 64.f) + 64e-5f);
        f32x4 ov[4]; float am = 0.f;
#pragma unroll
        for (int ct = 0; ct < 4; ++ct) { const int ch = 64 * h + 16 * ct + 4 * q4;
            const f32x4 lw = lwv[ct], lb = lbv[ct];
            const u32x2_t vv = c_v[ct];
            const float v0 = __uint_as_float(vv.x << 16), v1 = __uint_as_float(vv.x & 0xffff0000u), v2 = __uint_as_float(vv.y << 16), v3 = __uint_as_float(vv.y & 0xffff0000u);
            const float o0 = (y[ct][0] * rstd * lw[0] + lb[0] + bsc * v0) * g[ct][0], o1 = (y[ct][1] * rstd * lw[1] + lb[1] + bsc * v1) * g[ct][1];
            const float o2 = (y[ct][2] * rstd * lw[2] + lb[2] + bsc * v2) * g[ct][2], o3 = (y[ct][3] * rstd * lw[3] + lb[3] + bsc * v3) * g[ct][3];
            ov[ct] = (f32x4){o0, o1, o2, o3}; am = fmaxf(fmaxf(am, fmaxf(fabsf(o0), fabsf(o1))), fmaxf(fabsf(o2), fabsf(o3))); }
        am = xrow16_max(am);
        float lv[16]; float lm = 0.f;
        {
#pragma unroll
            for (int e = 0; e < 4; ++e) { lv[2 * e] = __uint_as_float(l0[e] << 16); lv[2 * e + 1] = __uint_as_float(l0[e] & 0xffff0000u); lv[8 + 2 * e] = __uint_as_float(l1[e] << 16); lv[8 + 2 * e + 1] = __uint_as_float(l1[e] & 0xffff0000u); }
#pragma unroll
            for (int e = 0; e < 16; ++e) lm = fmaxf(lm, fabsf(lv[e]));
            lm = fmaxf(lm, dpp_<0xB1>(lm)); lm = fmaxf(lm, dpp_<0x4E>(lm)); }
        if (q4 == 0) AMf[c16 * 16 + 2 * h] = am;
        if ((lane & 3) == 0) AMf[(lane >> 2) * 16 + 2 * h + 1] = lm;
        __syncthreads();
        float rmr = 1e-30f, rml = 1e-30f;
#pragma unroll
        for (int e4 = 0; e4 < 4; ++e4) { const f32x4 m1 = *(const LAS f32x4*)(AMf + c16 * 16 + 4 * e4), m2 = *(const LAS f32x4*)(AMf + (lane >> 2) * 16 + 4 * e4);
            rmr = fmaxf(fmaxf(rmr, fmaxf(m1[0], m1[1])), fmaxf(m1[2], m1[3])); rml = fmaxf(fmaxf(rml, fmaxf(m2[0], m2[1])), fmaxf(m2[2], m2[3])); }
        const float qsr = 127.f / rmr, qsl = 127.f / rml;
#pragma unroll
        for (int ct = 0; ct < 4; ++ct) *(LAS unsigned*)(T8 + c16 * 1040 + 64 * h + 16 * ct + 4 * q4) = q8x4(ov[ct][0], ov[ct][1], ov[ct][2], ov[ct][3], qsr);
        *(LAS u32x4_t*)(T8 + (lane >> 2) * 1040 + 512 + 64 * h + 16 * (lane & 3)) = (u32x4_t){q8x4(lv[0], lv[1], lv[2], lv[3], qsl), q8x4(lv[4], lv[5], lv[6], lv[7], qsl), q8x4(lv[8], lv[9], lv[10], lv[11], qsl), q8x4(lv[12], lv[13], lv[14], lv[15], qsl)};
        if (h == 0 && q4 == 0) rowscale[n0 + c16] = rmr;
        __syncthreads();
        { const int tk = c >> 5, pc = (c & 31) * 32;
            const u32x4_t w0 = *(const LAS u32x4_t*)(T8 + tk * 1040 + pc), w1 = *(const LAS u32x4_t*)(T8 + tk * 1040 + pc + 16);
            *(u32x4_t*)(MIX8 + (size_t)(n0 + tk) * DM + pc) = w0; *(u32x4_t*)(MIX8 + (size_t)(n0 + tk) * DM + pc + 16) = w1; }
    }
#undef POST_FETCH
}

namespace gla {
typedef short bf16x8 __attribute__((ext_vector_type(8)));
typedef float f32x16 __attribute__((ext_vector_type(16)));
typedef unsigned u32x4 __attribute__((ext_vector_type(4)));
typedef unsigned u32x2 __attribute__((ext_vector_type(2)));
constexpr int QH_OFF = 0, KH_OFF = 17408, KT_OFF = 34816, VT_OFF = 53248, ST_OFF = 71680, AM_OFF = 106496, EB_OFF = 115712, ER_OFF = 116224, PS_OFF = 153600, SSQ_OFF = 118784, OT_OFF = 119808;
constexpr int QS = 272, TS = 144;
#define GLA_BAR() do { asm volatile("s_waitcnt lgkmcnt(0)" ::: "memory"); __builtin_amdgcn_s_barrier(); asm volatile("" ::: "memory"); } while (0)
template <bool OUT>
__device__ __forceinline__ void unit(const Args& a, LAS unsigned char* L, int u) {
    const int tid = threadIdx.x, lane = tid & 63, w = tid >> 6;
    const int b = u >> 6, h = (u >> 3) & 7, j = u & 7;
    const bf16_t* Q = (const bf16_t*)(a.ws + WS_QFIG) + ((size_t)b * SEQ + (size_t)j * 1024) * 4096 + h * 128;
    float* Lb = (float*)(a.ws + WS_O); float* Db = Lb + (size_t)256 * 16384;
    float lbv[2], omlb[2];
#pragma unroll
    for (int d = 0; d < 2; ++d) { const float c0 = a.in[25][h * 128 + 2 * lane + d], c1 = a.in[25][1024 + h * 128 + 2 * lane + d]; lbv[d] = __builtin_amdgcn_rcpf(1.f + __expf(c0 - c1)); omlb[d] = 1.f - lbv[d]; }
    const f32x2_hw lbv2 = (f32x2_hw){lbv[0], lbv[1]}, omlb2 = (f32x2_hw){omlb[0], omlb[1]};
    LAS float* PS = (LAS float*)(L + PS_OFF); LAS float* EB = (LAS float*)(L + EB_OFF); LAS float* ER = (LAS float*)(L + ER_OFF); LAS float* SSQ = (LAS float*)(L + SSQ_OFF);
    const int si = w >> 1, sj0 = (w & 1) * 2, l31 = lane & 31, l5 = lane >> 5;
    const int ri = w >> 2, cj = w & 3, odv = 32 * cj + l31;
    f32x16 S[2];
#pragma unroll
    for (int jj = 0; jj < 2; ++jj)
#pragma unroll
        for (int r = 0; r < 16; ++r) S[jj][r] = 0.f;
    if (OUT && j > 0) {
        f32x4 dn[4]; float ln[2][16];
#define GLA_LDSTATE(ui) do { _Pragma("unroll") for (int rg = 0; rg < 4; ++rg) { const int sdk0 = 32 * si + 8 * rg + 4 * l5; dn[rg] = *(const f32x4*)(Db + (ui) * 128 + sdk0); \
            _Pragma("unroll") for (int jj = 0; jj < 2; ++jj) _Pragma("unroll") for (int e = 0; e < 4; ++e) ln[jj][4 * rg + e] = Lb[(size_t)(ui) * 16384 + (sdk0 + e) * 128 + 32 * (sj0 + jj) + l31]; } } while (0)
        GLA_LDSTATE(u - j);
#pragma unroll 1
        for (int i = 0; i < j; ++i) { f32x4 dc[4]; float lc[2][16];
#pragma unroll
            for (int rg = 0; rg < 4; ++rg) { dc[rg] = dn[rg];
#pragma unroll
                for (int jj = 0; jj < 2; ++jj)
#pragma unroll
                    for (int e = 0; e < 4; ++e) lc[jj][4 * rg + e] = ln[jj][4 * rg + e]; }
            if (i + 1 < j) GLA_LDSTATE(u - j + i + 1);
            asm volatile("" ::: "memory");
#pragma unroll
            for (int jj = 0; jj < 2; ++jj)
#pragma unroll
                for (int rg = 0; rg < 4; ++rg)
#pragma unroll
                    for (int e = 0; e < 4; ++e) S[jj][4 * rg + e] = dc[rg][e] * S[jj][4 * rg + e] + lc[jj][4 * rg + e]; }
#undef GLA_LDSTATE
    }
    if (OUT && tid < 128) SSQ[tid] = a.in[26][h * 128 + tid];
    float dsum[2] = {1.f, 1.f};
    unsigned fwa[8], vwa[8], qwa[8];
#define GLA_PREFETCH(cx) do { const unsigned char* _q = (const unsigned char*)(Q + (size_t)((cx) * 64) * 4096); unsigned _po = (unsigned)(w * (8 * 8192) + lane * 4); asm volatile("" : "+v"(_po)); \
        _Pragma("unroll") for (int _i = 0; _i < 8; ++_i) { fwa[_i] = *(const unsigned*)(_q + _po + _i * 8192 + 2048); vwa[_i] = *(const unsigned*)(_q + _po + _i * 8192 + 4096); if (OUT) qwa[_i] = *(const unsigned*)(_q + _po + _i * 8192); } } while (0)
    GLA_PREFETCH(0);
#pragma unroll 1
    for (int c = 0; c < 16; ++c) {
        int cc = c; asm volatile("" : "+s"(cc));
        u32x4 gq[2];
        if (OUT) { const bf16_t* G = Q + (size_t)(cc * 64) * 4096 + 3072;
            unsigned go = (unsigned)((tid >> 3) * 4096 + (tid & 7) * 16); asm volatile("" : "+v"(go));
            gq[0] = *(const u32x4*)(G + go); gq[1] = *(const u32x4*)(G + go + 8u); }
        f32x2_hw lf[8], kk[8];
#pragma unroll
        for (int i = 0; i < 8; ++i) { const unsigned fw = fwa[i];
            const f32x2_hw sg = (f32x2_hw){__builtin_amdgcn_rcpf(1.f + __expf(-__uint_as_float(fw << 16))), __builtin_amdgcn_rcpf(1.f + __expf(-__uint_as_float(fw & 0xffff0000u)))};
            lf[i] = lbv2 + omlb2 * sg; kk[i] = omlb2 - omlb2 * sg; }
#pragma unroll
        for (int i = 1; i < 8; ++i) lf[i] *= lf[i - 1];
        *(LAS f32x2_hw*)(PS + w * 128 + 2 * lane) = lf[7];
        GLA_BAR();
        f32x2_hw off = (f32x2_hw){1.f, 1.f}, pref = off, ebr = off;
#pragma unroll
        for (int g = 0; g < 8; ++g) { const f32x2_hw pg = *(const LAS f32x2_hw*)(PS + g * 128 + 2 * lane);
            if (g < w) off *= pg;
            if (g < 4) pref *= pg; else ebr *= pg; }
        const f32x2_hw pbl = pref * ebr, ioff = off * (f32x2_hw){__builtin_amdgcn_rcpf(pref[0]), __builtin_amdgcn_rcpf(pref[1])};
        unsigned ktp[2][4], vtp[2][4];
#pragma unroll
        for (int i = 0; i < 8; i += 2) {
            f32x2_hw kb[2]; unsigned vw[2];
#pragma unroll
            for (int q = 0; q < 2; ++q) { const int row = (8 * w + i + q) * QS + lane * 4;
                vw[q] = vwa[i + q];
                const f32x2_hw e1 = ioff * lf[i + q]; const f32x2_hw khat = kk[i + q] * (f32x2_hw){__builtin_amdgcn_rcpf(e1[0]), __builtin_amdgcn_rcpf(e1[1])}; kb[q] = khat * ebr;
                if (OUT) { LAS unsigned* qp = (LAS unsigned*)(L + QH_OFF + row); const unsigned qw = qwa[i + q];
                    const f32x2_hw qr = (f32x2_hw){__uint_as_float(qw << 16), __uint_as_float(qw & 0xffff0000u)};
                    const f32x2_hw qs = qr * e1;
                    *qp = pk2(qs[0], qs[1]);
                    *(LAS unsigned*)(L + KH_OFF + row) = pk2(khat[0], khat[1]); } }
            ktp[0][i >> 1] = pk2(kb[0][0], kb[1][0]); ktp[1][i >> 1] = pk2(kb[0][1], kb[1][1]);
            vtp[0][i >> 1] = (vw[0] & 0xffffu) | (vw[1] << 16); vtp[1][i >> 1] = (vw[0] >> 16) | (vw[1] & 0xffff0000u);
        }
        if (c + 1 < 16) GLA_PREFETCH(cc + 1);
#pragma unroll
        for (int d = 0; d < 2; ++d) { *(LAS u32x4*)(L + KT_OFF + (2 * lane + d) * TS + w * 16) = (u32x4){ktp[d][0], ktp[d][1], ktp[d][2], ktp[d][3]};
            *(LAS u32x4*)(L + VT_OFF + (2 * lane + d) * TS + w * 16) = (u32x4){vtp[d][0], vtp[d][1], vtp[d][2], vtp[d][3]}; }
        if (w == 0) { *(LAS f32x2_hw*)(EB + 2 * lane) = pbl; *(LAS f32x2_hw*)(ER + 2 * lane) = pref; dsum[0] *= pbl[0]; dsum[1] *= pbl[1]; }
        GLA_BAR();
        f32x16 o;
        if (OUT) {
#pragma unroll
            for (int jj = 0; jj < 2; ++jj)
#pragma unroll
                for (int rg = 0; rg < 4; ++rg) { const int dk0 = 32 * si + 8 * rg + 4 * l5; const f32x4 er = *(const LAS f32x4*)(ER + dk0);
                    u32x2 pk; pk.x = pk2(S[jj][4 * rg] * er[0], S[jj][4 * rg + 1] * er[1]); pk.y = pk2(S[jj][4 * rg + 2] * er[2], S[jj][4 * rg + 3] * er[3]);
                    *(LAS u32x2*)(L + ST_OFF + (32 * (sj0 + jj) + l31) * QS + dk0 * 2) = pk; }
#pragma unroll
            for (int q = 0; q < 2; ++q) { const int ti = w >> 1, tj = (w & 1) * 2 + q;
                f32x4 sc = (f32x4){0.f, 0.f, 0.f, 0.f};
                if (tj <= ti) {
#pragma unroll
                    for (int ks = 0; ks < 4; ++ks) { const bf16x8 af = *(const LAS bf16x8*)(L + QH_OFF + (16 * ti + (lane & 15)) * QS + ks * 64 + (lane >> 4) * 16);
                        const bf16x8 bfr = *(const LAS bf16x8*)(L + KH_OFF + (16 * tj + (lane & 15)) * QS + ks * 64 + (lane >> 4) * 16);
                        sc = __builtin_amdgcn_mfma_f32_16x16x32_bf16(af, bfr, sc, 0, 0, 0); } }
                const int scol = 16 * tj + (lane & 15);
#pragma unroll
                for (int r = 0; r < 4; ++r) { const int trow = 16 * ti + 4 * (lane >> 4) + r; const float v = (scol <= trow) ? sc[r] : 0.f;
                    *(LAS bf16_t*)(L + AM_OFF + trow * TS + scol * 2) = f2bf(v); } }
            GLA_BAR();
#pragma unroll
            for (int r = 0; r < 16; ++r) o[r] = 0.f;
#pragma unroll
            for (int ks = 0; ks < 4; ++ks) if (ks < 2 * (ri + 1)) {
                const bf16x8 af = *(const LAS bf16x8*)(L + AM_OFF + (32 * ri + l31) * TS + ks * 32 + l5 * 16);
                const bf16x8 bfr = *(const LAS bf16x8*)(L + VT_OFF + (32 * cj + l31) * TS + ks * 32 + l5 * 16);
                o = __builtin_amdgcn_mfma_f32_32x32x16_bf16(af, bfr, o, 0, 0, 0); }
#pragma unroll
            for (int ks = 0; ks < 8; ++ks) { if ((ks & 3) == 0) asm volatile("" ::: "memory");
                const bf16x8 af = *(const LAS bf16x8*)(L + QH_OFF + (32 * ri + l31) * QS + ks * 32 + l5 * 16);
                const bf16x8 bfr = *(const LAS bf16x8*)(L + ST_OFF + (32 * cj + l31) * QS + ks * 32 + l5 * 16);
                o = __builtin_amdgcn_mfma_f32_32x32x16_bf16(af, bfr, o, 0, 0, 0); }
#pragma unroll
            for (int r = 0; r < 16; ++r) *(LAS float*)(L + OT_OFF + (32 * ri + (r & 3) + 8 * (r >> 2) + 4 * l5) * 528 + odv * 4) = o[r];
        }
        {
            bf16x8 af[4];
#pragma unroll
            for (int ks = 0; ks < 4; ++ks) af[ks] = *(const LAS bf16x8*)(L + KT_OFF + (32 * si + l31) * TS + ks * 32 + l5 * 16);
#pragma unroll
            for (int jj = 0; jj < 2; ++jj) {
#pragma unroll
                for (int rg = 0; rg < 4; ++rg) { const f32x4 eb = *(const LAS f32x4*)(EB + 32 * si + 8 * rg + 4 * l5);
                    S[jj][4 * rg] *= eb[0]; S[jj][4 * rg + 1] *= eb[1]; S[jj][4 * rg + 2] *= eb[2]; S[jj][4 * rg + 3] *= eb[3]; }
#pragma unroll
                for (int ks = 0; ks < 4; ++ks) { const bf16x8 bfr = *(const LAS bf16x8*)(L + VT_OFF + (32 * (sj0 + jj) + l31) * TS + ks * 32 + l5 * 16);
                    S[jj] = __builtin_amdgcn_mfma_f32_32x32x16_bf16(af[ks], bfr, S[jj], 0, 0, 0); } }
        }
        GLA_BAR();
        if (OUT) {
            const int et = tid >> 3, ep = tid & 7;
            f32x4 o4[4];
#pragma unroll
            for (int e4 = 0; e4 < 4; ++e4) o4[e4] = *(const LAS f32x4*)(L + OT_OFF + et * 528 + ep * 64 + e4 * 16);
            float ss = 0.f;
#pragma unroll
            for (int e4 = 0; e4 < 4; ++e4) ss += (o4[e4][0] * o4[e4][0] + o4[e4][1] * o4[e4][1]) + (o4[e4][2] * o4[e4][2] + o4[e4][3] * o4[e4][3]);
            ss += dpp_<0xB1>(ss); ss += dpp_<0x4E>(ss); ss += dpp_<0x141>(ss);
            const float rs = rsqrtf(ss * (1.f / 128.f) + 1e-6f);
            bf16_t* MIX = (bf16_t*)(a.ws + WS_MIX1) + ((size_t)b * SEQ + (size_t)j * 1024 + cc * 64) * DM + h * 128;
            unsigned mo = (unsigned)(et * DM + ep * 16); asm volatile("" : "+v"(mo));
#pragma unroll
            for (int hf = 0; hf < 2; ++hf) { unsigned ov[4];
#pragma unroll
                for (int e2 = 0; e2 < 2; ++e2) { const f32x4 ov4 = o4[hf * 2 + e2] * (*(const LAS f32x4*)(SSQ + ep * 16 + hf * 8 + e2 * 4)) * rs;
#pragma unroll
                    for (int e = 0; e < 2; ++e) { const unsigned gw = gq[hf][e2 * 2 + e]; const float g0 = __uint_as_float(gw << 16), g1 = __uint_as_float(gw & 0xffff0000u);
                        ov[e2 * 2 + e] = pk2(ov4[2 * e] * g0, ov4[2 * e + 1] * g1); } }
                *(u32x4*)(MIX + mo + hf * 8) = (u32x4){ov[0], ov[1], ov[2], ov[3]}; }
        }
    }
    if (!OUT) {
#pragma unroll
        for (int jj = 0; jj < 2; ++jj)
#pragma unroll
            for (int r = 0; r < 16; ++r) { const int sdk = 32 * si + (r & 3) + 8 * (r >> 2) + 4 * l5, sdv = 32 * (sj0 + jj) + l31; Lb[(size_t)u * 16384 + sdk * 128 + sdv] = S[jj][r]; }
        if (w == 0) { Db[u * 128 + 2 * lane] = dsum[0]; Db[u * 128 + 2 * lane + 1] = dsum[1]; }
    }
    GLA_BAR();
#undef GLA_PREFETCH
}
__device__ __forceinline__ void pass2(const Args& a) {
    float* Lb = (float*)(a.ws + WS_O); const float* Db = Lb + (size_t)256 * 16384;
    for (int idx = blockIdx.x * NTHREADS + threadIdx.x; idx < 32 * 16384; idx += gridDim.x * NTHREADS) { const int bh = idx >> 14, el = idx & 16383, dkk = el >> 7; float sacc = 0.f;
        for (int j = 0; j < 8; ++j) { const int u = bh * 8 + j; const size_t o = (size_t)u * 16384 + el;
            if (j < 7) { const float tmp = Lb[o]; Lb[o] = sacc; sacc = Db[u * 128 + dkk] * sacc + tmp; } else Lb[o] = sacc; } }
}
}

constexpr int NPHASE = 24;
__global__ void __launch_bounds__(NTHREADS, 2) fwd(Args a) {
    extern __shared__ __attribute__((aligned(16))) unsigned char lds_raw[];
    LAS unsigned char* ldsb = (LAS unsigned char*)lds_raw;
    LAS float* lds = (LAS float*)ldsb;
    LAS int* pst = (LAS int*)(ldsb + LDS_MISC);
    volatile LAS unsigned* xbw = (volatile LAS unsigned*)(ldsb + LDS_MISC + 256);
    if (threadIdx.x == 0) { xbw[0] = 0u; xbw[1] = 0u; }
    __syncthreads();
    unsigned* ctl = (unsigned*)(a.ws + WS_CTL);
    const bool multi = (a.ph_hi - a.ph_lo) > 1;
    XcdBarrier bar; bar.bar = ctl; bar.x = 0; bar.st = xbw;
    if (multi) bar = xcd_barrier_post(ctl, xbw);
    unsigned char* ws = a.ws;
    bf16_t* HN = (bf16_t*)(ws + WS_A);
    bf16_t* XR = (bf16_t*)(ws + WS_XR); float* RSv = (float*)(ws + WS_ROUTE + RT_LRU_CH);
    int* list_slot = (int*)(ws + WS_LIST); float* list_gate = (float*)(ws + WS_LIST + (size_t)NEXP * MOE_CAP * 4);
#ifndef PHSEL
#define PHSEL(k) true
#endif
#ifndef REPMASK
#define REPMASK 0u
#endif
#define NREP(k) (((REPMASK >> (k)) & 1u) ? 2 : 1)
#define IN(k) (PHSEL(k) && a.ph_lo <= (k) && (k) < a.ph_hi)
#define SEAM(k) do { if (IN((k) + 1) && multi) xcd_barrier(bar); } while (0)
    if (IN(0)) { ph_cvt_frags(a, blockIdx.x, 0); ph_cvt_dense_a(a, lds, ctl + CW_COLMAX, blockIdx.x, gridDim.x, 0); ph_norm0(a.in[0], a.in[1], (unsigned char*)HN, (float*)(ws + WS_ROUTE + RT_LRU_CH + 262144)); xcd_barrier(bar); ph_cvt_dense_b(a, lds, ctl + CW_COLMAX, 0, blockIdx.x, gridDim.x); }
#if (REPMASK >> 0) & 1
    if (IN(0)) { xcd_barrier(bar);  ph_cvt_frags(a, blockIdx.x, 0); ph_cvt_dense_a(a, lds, ctl + CW_COLMAX, blockIdx.x, gridDim.x, 0); ph_norm0(a.in[0], a.in[1], (unsigned char*)HN, (float*)(ws + WS_ROUTE + RT_LRU_CH + 262144)); xcd_barrier(bar); ph_cvt_dense_b(a, lds, ctl + CW_COLMAX, 0, blockIdx.x, gridDim.x); }
#endif
    if (IN(0)) { SEAM(0); }
    if (IN(1)) { pg8::DenseOrder S; S.init(ABC, NTOK, DM / 2, gridDim.x, blockIdx.x, HN); pg8::EpiBf16IT E{(bf16_t*)(ws + WS_B), ABC, (float*)(ws + WS_ROUTE + RT_LRU_CH + 262144), ctl + CW_COLMAX};
        pg8::gemm_phase<pg8::EpiBf16IT, pg8::DenseOrder, true>(ldsb, (const char*)(ws + WD_ABIN), DM, DM / 2, S, E); }
#if (REPMASK >> 1) & 1
    if (IN(1)) { xcd_barrier(bar);  pg8::DenseOrder S; S.init(ABC, NTOK, DM / 2, gridDim.x, blockIdx.x, HN); pg8::EpiBf16IT E{(bf16_t*)(ws + WS_B), ABC, (float*)(ws + WS_ROUTE + RT_LRU_CH + 262144), ctl + CW_COLMAX};
        pg8::gemm_phase<pg8::EpiBf16IT, pg8::DenseOrder, true>(ldsb, (const char*)(ws + WD_ABIN), DM, DM / 2, S, E);  }
#endif
    if (IN(1)) { SEAM(1); }
    if (IN(2)) { ph_l0_prep(a, lds); }
#if (REPMASK >> 2) & 1
    if (IN(2)) { xcd_barrier(bar);  ph_l0_prep(a, lds);  }
#endif
    if (IN(2)) { SEAM(2); }
    if (IN(6)) {
        if (blockIdx.x < NSCAN) {
#if SP_MODE & 64
            ph_rwkv_scan<0, SCAN_COOP>(a, ldsb); __syncthreads();
#endif
#if SP_VAR
            ph_rwkv_scan<SP_VAR, SCAN_COOP>(a, ldsb); __syncthreads(); ph_rwkv_scan<0, SCAN_COOP>(a, ldsb);
#else
            ph_rwkv_scan<0, SCAN_COOP>(a, ldsb);
#endif
        } else { const int gb = (int)blockIdx.x - NSCAN, gn = (int)gridDim.x - NSCAN; unsigned* sctr = ctl + CW_CNT + 256;
            ph_lru_b(a, gb, lds); sub_barrier(sctr, (unsigned)gn);
#if SP_MODE & 1
            ph_lru_c(a, gb, gn); }
        xcd_barrier(bar); ph_cvt_frags(a, blockIdx.x, 1); ph_wmax(a.in[32], a.in[33], ctl + CW_WMAX, blockIdx.x, gridDim.x); ph_cvt_dense_a(a, lds, ctl + CW_COLMAX, blockIdx.x, gridDim.x, 1); xcd_barrier(bar);
        ph_cvt_dense_b(a, lds, ctl + CW_COLMAX, 2, blockIdx.x, gridDim.x); ph_cvt_moe(a, 0, lds, blockIdx.x, gridDim.x, 3); ph_cvt_moe(a, 1, lds, blockIdx.x, gridDim.x, 1); ph_cvt_dense_b(a, lds, ctl + CW_COLMAX, 1, blockIdx.x, gridDim.x);
#else
            ph_lru_c(a, gb, gn); ph_cvt_frags(a, gb, 1); ph_wmax(a.in[32], a.in[33], ctl + CW_WMAX, gb, gn); ph_cvt_dense_a(a, lds, ctl + CW_COLMAX, gb, gn, 1); sub_barrier(sctr, 2u * (unsigned)gn);
            ph_cvt_dense_b(a, lds, ctl + CW_COLMAX, 2, gb, gn); ph_cvt_moe(a, 0, lds, gb, gn, 3); ph_cvt_moe(a, 1, lds, gb, gn, 1); ph_cvt_dense_b(a, lds, ctl + CW_COLMAX, 1, gb, gn);
#if SP_MODE & 32
            ph_cvt_moe(a, 1, lds, gb, gn, 1);
#endif
            }
#endif
        SEAM(6); }
    if (IN(7)) { ph_rwkv_post(a, lds); }
#if (REPMASK >> 7) & 1
    if (IN(7)) { xcd_barrier(bar);  ph_rwkv_post(a, lds);  }
#endif
    if (IN(7)) { SEAM(7); }
    if (IN(8)) { pg8::DenseOrder S; S.init(NTOK, DM, DM / 2, gridDim.x, blockIdx.x, ws + WD_ABOUT); pg8::EpiResidI E{a.in[0], XR, (float*)(ws + WS_ROUTE + RT_LRU_CH + 262144), ctl + CW_COLMAX2};
        pg8::gemm_phase<pg8::EpiResidI, pg8::DenseOrder, true>(ldsb, (const char*)(ws + WS_A), DM, DM / 2, S, E); }
#if (REPMASK >> 8) & 1
    if (IN(8)) { xcd_barrier(bar);  pg8::DenseOrder S; S.init(NTOK, DM, DM / 2, gridDim.x, blockIdx.x, ws + WD_ABOUT); pg8::EpiResidI E{a.in[0], XR, (float*)(ws + WS_ROUTE + RT_LRU_CH + 262144), ctl + CW_COLMAX2};
        pg8::gemm_phase<pg8::EpiResidI, pg8::DenseOrder, true>(ldsb, (const char*)(ws + WS_A), DM, DM / 2, S, E);  }
#endif
    if (IN(8)) { SEAM(8); }
    if (IN(9)) { ph_route(a, 0, XR, HN, RSv, ctl + CW_CNT, list_slot, list_gate, lds); SEAM(9); }
    if (IN(11)) { moe_prefix(ctl + CW_CNT, pst);
        pg8::MoeOrder S{(int)gridDim.x, (int)blockIdx.x, 4, pst[NEXP] / 256, pst, ctl + CW_CNT, list_slot, (const char*)(ws + WM_GU), (size_t)DM * DM, (size_t)256 * DM}; pg8::EpiSwiGLU E{(bf16_t*)(ws + WS_H), ctl + CW_WMAX};
        pg8::gemm_phase<pg8::EpiSwiGLU, pg8::MoeOrder, true>(ldsb, (const char*)HN, DM, DM / 2, S, E); moe_tail_cvt(a, lds, pst, 0, 13); }
#if (REPMASK >> 11) & 1
    if (IN(11)) { xcd_barrier(bar);  moe_prefix(ctl + CW_CNT, pst);
        pg8::MoeOrder S{(int)gridDim.x, (int)blockIdx.x, 4, pst[NEXP] / 256, pst, ctl + CW_CNT, list_slot, (const char*)(ws + WM_GU), (size_t)DM * DM, (size_t)256 * DM}; pg8::EpiSwiGLU E{(bf16_t*)(ws + WS_H), ctl + CW_WMAX};
        pg8::gemm_phase<pg8::EpiSwiGLU, pg8::MoeOrder, true>(ldsb, (const char*)HN, DM, DM / 2, S, E);  }
#endif
    if (IN(11)) { SEAM(11); }
    if (IN(12)) { moe_prefix(ctl + CW_CNT, pst);
        pg8::MoeOrder S{(int)gridDim.x, (int)blockIdx.x, 4, pst[NEXP] / 256, pst, ctl + CW_CNT, nullptr, (const char*)(ws + WM_DN), (size_t)DM * FF * 2, (size_t)256 * FF * 2}; pg8::EpiDown E{(bf16_t*)(ws + WS_Y), list_slot, list_gate};
        pg8::gemm_phase(ldsb, (const char*)(ws + WS_H), FF * 2, FF, S, E); moe_tail_cvt(a, lds, pst, 13, NEXP); }
#if (REPMASK >> 12) & 1
    if (IN(12)) { xcd_barrier(bar);  moe_prefix(ctl + CW_CNT, pst);
        pg8::MoeOrder S{(int)gridDim.x, (int)blockIdx.x, 4, pst[NEXP] / 256, pst, ctl + CW_CNT, nullptr, (const char*)(ws + WM_DN), (size_t)DM * FF * 2, (size_t)256 * FF * 2}; pg8::EpiDown E{(bf16_t*)(ws + WS_Y), list_slot, list_gate};
        pg8::gemm_phase(ldsb, (const char*)(ws + WS_H), FF * 2, FF, S, E);  }
#endif
    if (IN(12)) { SEAM(12); }
    if (IN(13)) { ph_combine_norm(XR, (const bf16_t*)(ws + WS_Y), a.in[1] + DM, (unsigned char*)HN, (float*)(ws + WS_ROUTE + RT_LRU_CH + 262144)); SEAM(13); }
    if (IN(14)) { pg8::DenseOrder S; S.init(NTOK, 4096, DM / 2, gridDim.x, blockIdx.x, ws + WD_CIN); pg8::EpiBf16I E{(bf16_t*)(ws + WS_QFIG), 4096, (float*)(ws + WS_ROUTE + RT_LRU_CH + 262144), ctl + CW_COLMAX + ABC, 4, 12};
        pg8::gemm_phase<pg8::EpiBf16I, pg8::DenseOrder, true>(ldsb, (const char*)HN, DM, DM / 2, S, E); }
#if (REPMASK >> 14) & 1
    if (IN(14)) { xcd_barrier(bar);  pg8::DenseOrder S; S.init(NTOK, 4096, DM / 2, gridDim.x, blockIdx.x, ws + WD_CIN); pg8::EpiBf16I E{(bf16_t*)(ws + WS_QFIG), 4096, (float*)(ws + WS_ROUTE + RT_LRU_CH + 262144), ctl + CW_COLMAX + ABC, 4, 12};
        pg8::gemm_phase<pg8::EpiBf16I, pg8::DenseOrder, true>(ldsb, (const char*)HN, DM, DM / 2, S, E);  }
#endif
    if (IN(14)) { SEAM(14); }
    if (IN(15)) { for (int u = blockIdx.x; u < 256; u += gridDim.x) if ((u & 7) != 7) gla::unit<false>(a, ldsb, u); }
#if (REPMASK >> 15) & 1
    if (IN(15)) { xcd_barrier(bar);  for (int u = blockIdx.x; u < 256; u += gridDim.x) if ((u & 7) != 7) gla::unit<false>(a, ldsb, u);  }
#endif
    if (IN(15)) { SEAM(15); }
    if (IN(17)) { for (int u = blockIdx.x; u < 256; u += gridDim.x) gla::unit<true>(a, ldsb, u); }
#if (REPMASK >> 17) & 1
    if (IN(17)) { xcd_barrier(bar);  for (int u = blockIdx.x; u < 256; u += gridDim.x) gla::unit<true>(a, ldsb, u);  }
#endif
    if (IN(17)) { SEAM(17); }
    if (IN(18)) { pg8::DenseOrder S; S.init(NTOK, DM, DM, gridDim.x, blockIdx.x, ws + WD_COUT); pg8::EpiResid<false> E{XR, XR};
        pg8::gemm_phase(ldsb, (const char*)(ws + WS_MIX1), DM * 2, DM, S, E); SEAM(18); }
    if (IN(19)) { ph_route(a, 1, XR, HN, RSv, ctl + CW_CNT + 64, list_slot, list_gate, lds); SEAM(19); }
    if (IN(21)) { moe_prefix(ctl + CW_CNT + 64, pst);
        pg8::MoeOrder S{(int)gridDim.x, (int)blockIdx.x, 4, pst[NEXP] / 256, pst, ctl + CW_CNT + 64, list_slot, (const char*)(ws + WM_GU1), (size_t)DM * DM, (size_t)256 * DM}; pg8::EpiSwiGLU E{(bf16_t*)(ws + WS_H), ctl + CW_WMAX + 64};
        pg8::gemm_phase<pg8::EpiSwiGLU, pg8::MoeOrder, true>(ldsb, (const char*)HN, DM, DM / 2, S, E); }
#if (REPMASK >> 21) & 1
    if (IN(21)) { xcd_barrier(bar);  moe_prefix(ctl + CW_CNT + 64, pst);
        pg8::MoeOrder S{(int)gridDim.x, (int)blockIdx.x, 4, pst[NEXP] / 256, pst, ctl + CW_CNT + 64, list_slot, (const char*)(ws + WM_GU1), (size_t)DM * DM, (size_t)256 * DM}; pg8::EpiSwiGLU E{(bf16_t*)(ws + WS_H), ctl + CW_WMAX + 64};
        pg8::gemm_phase<pg8::EpiSwiGLU, pg8::MoeOrder, true>(ldsb, (const char*)HN, DM, DM / 2, S, E);  }
#endif
    if (IN(21)) { SEAM(21); }
    if (IN(22)) { moe_prefix(ctl + CW_CNT + 64, pst);
        pg8::MoeOrder S{(int)gridDim.x, (int)blockIdx.x, 4, pst[NEXP] / 256, pst, ctl + CW_CNT + 64, nullptr, (const char*)a.out, (size_t)DM * FF * 2, (size_t)256 * FF * 2}; pg8::EpiDown E{(bf16_t*)(ws + WS_Y), list_slot, list_gate};
        pg8::gemm_phase(ldsb, (const char*)(ws + WS_H), FF * 2, FF, S, E); }
#if (REPMASK >> 22) & 1
    if (IN(22)) { xcd_barrier(bar);  moe_prefix(ctl + CW_CNT + 64, pst);
        pg8::MoeOrder S{(int)gridDim.x, (int)blockIdx.x, 4, pst[NEXP] / 256, pst, ctl + CW_CNT, nullptr, (const char*)(ws + WM_DN), (size_t)DM * FF * 2, (size_t)256 * FF * 2}; pg8::EpiDown E{(bf16_t*)(ws + WS_Y), list_slot, list_gate};
        pg8::gemm_phase(ldsb, (const char*)(ws + WS_H), FF * 2, FF, S, E);  }
#endif
    if (IN(22)) { SEAM(22); }
    if (IN(23)) { ph_final(XR, (const bf16_t*)(ws + WS_Y), a.in[3], a.out); }
#undef IN
#undef SEAM
}

extern "C" void kernel_launch(void* const* d_in, const int* in_sizes, int n_in, void* d_out, int out_size, void* d_ws, size_t ws_size, hipStream_t stream) {
    static int grid = 0;
    if (grid == 0) {
        if (n_in != 35 || out_size != NTOK * DM || ws_size < WS_END) { fprintf(stderr, "kernel_launch: unexpected shapes (n_in %d out %d ws %zu)\n", n_in, out_size, ws_size); grid = -1; return; }
        int dev = 0, cus = 0;
        if (hipGetDevice(&dev) != hipSuccess || hipDeviceGetAttribute(&cus, hipDeviceAttributeMultiprocessorCount, dev) != hipSuccess) { grid = -1; return; }
        if (hipFuncSetAttribute((const void*)fwd, hipFuncAttributeMaxDynamicSharedMemorySize, LDS_BYTES) != hipSuccess) { fprintf(stderr, "kernel_launch: hipFuncSetAttribute failed\n"); grid = -1; return; }
        int per_cu = 0;
        (void)hipOccupancyMaxActiveBlocksPerMultiprocessor(&per_cu, (const void*)fwd, NTHREADS, LDS_BYTES);
        (void)hipGetLastError();
        grid = cus;
        if (grid < 64) { fprintf(stderr, "kernel_launch: needs >= 64 CUs\n"); grid = -1; return; }
    }
    if (grid < 0) return;
    (void)hipMemsetAsync((char*)d_ws + WS_CTL, 0, CTL_ZERO_BYTES, stream);
    Args a{};
    for (int i = 0; i < 35; ++i) a.in[i] = (const float*)d_in[i];
    a.out = (float*)d_out; a.ws = (unsigned char*)d_ws;
#if 0
    for (int p = 0; p < NPHASE; ++p) { a.ph_lo = p; a.ph_hi = p + 1; hipLaunchKernelGGL(fwd, dim3(grid), dim3(NTHREADS), LDS_BYTES, stream, a); }
#else
    a.ph_lo = 0; a.ph_hi = NPHASE; hipLaunchKernelGGL(fwd, dim3(grid), dim3(NTHREADS), LDS_BYTES, stream, a);
#endif
}
```
